# Optimizing an MI355X kernel written in HIP

```python
import math
import jax
import jax.numpy as jnp
from jax import lax
import numpy as np

D_MODEL = 2048
BATCH = 32
SEQ = 256
DEPTH = 2
DEC_BATCH = 4
DEC_SEQ = 4096
PAST_LEN = 512

GRID_W = 64
N_EVEN = (DEPTH + 1) // 2
N_ODD = DEPTH // 2
EPS = 1e-6

D_HY = D_MODEL // 2
HY_EMB = 33
HY_FH = 64
HY_TARGET = 1e-2
HY_FAST = 0.3
HY_SLOW = 1.5

D_RW = D_MODEL // 2
RW_HEAD = 64
RW_H = D_RW // RW_HEAD
RW_W_LORA = 64
RW_A_LORA = 64
RW_G_LORA = 128
RW_GN_EPS = 64e-5
RW_IN = 3 * D_RW + 2 * RW_W_LORA + 2 * RW_A_LORA + RW_G_LORA
EV_IN = 3 * D_HY + RW_IN

GLA_H = 4
GLA_DK = D_MODEL // 2
GLA_DV = D_MODEL
GLA_HK = GLA_DK // GLA_H
GLA_HV = GLA_DV // GLA_H
GLA_GK_RANK = 16
GLA_GATE_NORM = 16.0
GLA_CHUNK = 64
OD_IN = 2 * GLA_DK + 2 * GLA_DV + 2 * GLA_GK_RANK

D_FF = 5632

kernel_name = 'hybrid_hyena_rwkv7_gla_diffusion_step'


def rms_norm(x, g, eps=EPS):
    xf = x.astype(jnp.float32)
    y = xf * lax.rsqrt(jnp.mean(jnp.square(xf), axis=-1, keepdims=True) + eps)
    return (y * g.astype(jnp.float32)).astype(x.dtype)


def adaln(cond, w, b):
    mod = (jax.nn.silu(cond) @ w + b)[:, None, :]
    return jnp.split(mod, 6, axis=-1)


def modulate(h, shift, scale):
    return h * (1 + scale) + shift


def neighbour_mean(x):
    xp = jnp.pad(x, ((0, 0), (1, 1), (0, 0)))
    return 0.5 * (xp[:, :-2] + xp[:, 2:])


def conv1d_centred(x, w, b):
    xp = jnp.pad(x, ((0, 0), (1, 1), (0, 0)))
    return xp[:, :-2] * w[0] + xp[:, 1:-1] * w[1] + xp[:, 2:] * w[2] + b


def dwconv_grid(x, w, rows, cols):
    B, L, C = x.shape
    gp = jnp.pad(x.reshape(B, rows, cols, C), ((0, 0), (1, 1), (1, 1), (0, 0)))
    y = sum(gp[:, i:i + rows, j:j + cols] * w[i, j] for i in range(3) for j in range(3))
    return y.reshape(B, L, C)


def hyena_filter(L, w1, b1, w2, b2, w3, freq):
    f32 = jnp.float32
    pos = jnp.arange(L, dtype=f32)[:, None]
    t = pos / max(L - 1, 1)
    bands = (HY_EMB - 1) // 2
    fb = jnp.linspace(1e-4, bands - 1, bands, dtype=f32)
    ang = (2.0 * math.pi / L) * pos * fb
    z = jnp.concatenate([t, jnp.cos(ang), -jnp.sin(ang)], axis=-1)
    h = jnp.sin(freq[0].astype(f32) * (z @ w1.astype(f32) + b1.astype(f32)))
    h = jnp.sin(freq[1].astype(f32) * (h @ w2.astype(f32) + b2.astype(f32)))
    h = (h @ w3.astype(f32)).reshape(L, 2, D_HY)
    deltas = jnp.abs(jnp.linspace(math.log(HY_TARGET) / HY_SLOW, math.log(HY_TARGET) / HY_FAST, D_HY, dtype=f32))
    h = h * jnp.exp(-t[:, :, None] * deltas)
    filt = jnp.concatenate([h[:, 0], jnp.zeros((1, D_HY), f32), jnp.flip(h[1:, 1], axis=0)], axis=0)
    return filt / jnp.sum(jnp.abs(filt), axis=0, keepdims=True)


def fft_long_conv(u, filt, bias):
    L = u.shape[1]
    uf = u.astype(jnp.float32)
    y = jnp.fft.irfft(jnp.fft.rfft(uf, n=2 * L, axis=1) * jnp.fft.rfft(filt, n=2 * L, axis=0)[None], n=2 * L, axis=1)[:, :L]
    return (y + uf * bias.astype(jnp.float32)).astype(u.dtype)


def hyena_mixer(P, short_w, short_b, w1, b1, w2, b2, w3, freq, bias):
    L = P.shape[1]
    x0, x1, v = jnp.split(conv1d_centred(P, short_w, short_b), 3, axis=-1)
    filt = hyena_filter(L, w1, b1, w2, b2, w3, freq)
    return x0 * fft_long_conv(x1 * v, filt, bias)


def rwkv7_scan(S0, r, w, k, v, kk, a):
    def step(S, inp):
        r_t, w_t, k_t, v_t, kk_t, a_t = inp
        sa = jnp.einsum('bhvk,bhk->bhv', S, -kk_t)
        S = S * w_t[:, :, None, :] + sa[..., None] * (kk_t * a_t)[:, :, None, :] + v_t[..., None] * k_t[:, :, None, :]
        return S, jnp.einsum('bhvk,bhk->bhv', S, r_t)
    xs = tuple(jnp.moveaxis(t, 1, 0) for t in (r, w, k, v, kk, a))
    S, ys = lax.scan(step, S0.astype(jnp.float32), xs)
    return S, jnp.moveaxis(ys, 0, 1)


def rwkv7_mixer(P, S0, mu, w0, w2, a0, a2, g2, k_k, k_a, r_k, ln_w, ln_b):
    f32 = jnp.float32
    B, L, _ = P.shape
    P = P + mu * (neighbour_mean(P) - P)
    r, k, v, wd, ad, gd = jnp.split(P, [D_RW, 2 * D_RW, 3 * D_RW, 3 * D_RW + 2 * RW_W_LORA, 3 * D_RW + 2 * RW_W_LORA + 2 * RW_A_LORA], axis=-1)
    wd = wd.reshape(B, L, 2, RW_W_LORA)
    ad = ad.reshape(B, L, 2, RW_A_LORA)
    w_log = -jax.nn.softplus(-(w0 + jnp.einsum('bldr,drc->bldc', jnp.tanh(wd), w2)).astype(f32)) - 0.5
    decay = jnp.exp(-jnp.exp(w_log))
    a = jax.nn.sigmoid((a0 + jnp.einsum('bldr,drc->bldc', ad, a2)).astype(f32))
    g = jax.nn.sigmoid(gd) @ g2

    def heads(t):
        return t.astype(f32).reshape(t.shape[:-1] + (RW_H, RW_HEAD))

    r_h, v_h = heads(r), heads(v)
    kk = heads(k * k_k)
    kk = kk * lax.rsqrt(jnp.sum(kk * kk, axis=-1, keepdims=True) + 1e-12)
    k_dir = heads(k[:, :, None, :] * (1 + (a - 1) * k_a))
    decay_h, a_h = heads(decay), heads(a)

    def flip(t):
        return jnp.flip(t, axis=1)

    S_f, y_f = rwkv7_scan(S0[:, 0], r_h, decay_h[:, :, 0], k_dir[:, :, 0], v_h, kk, a_h[:, :, 0])
    S_b, y_b = rwkv7_scan(S0[:, 1], flip(r_h), flip(decay_h[:, :, 1]), flip(k_dir[:, :, 1]), flip(v_h), flip(kk), flip(a_h[:, :, 1]))
    y = y_f + flip(y_b)
    mean = jnp.mean(y, axis=-1, keepdims=True)
    var = jnp.var(y, axis=-1, keepdims=True)
    y = ((y - mean) * lax.rsqrt(var + RW_GN_EPS)).reshape(B, L, D_RW) * ln_w + ln_b
    bonus = jnp.einsum('blhn,bldhn,hn->blh', r_h, k_dir, r_k.astype(f32))[..., None] * v_h
    out = (y + bonus.reshape(B, L, D_RW)) * g
    return out.astype(P.dtype), jnp.stack([S_f, S_b], axis=1).astype(P.dtype)


def gla_chunked(q, k, v, lg, S0):
    f32 = jnp.float32
    B, L, H, K = q.shape
    V = v.shape[-1]
    C = GLA_CHUNK
    n = L // C

    def chunks(t):
        return t.astype(f32).reshape(B, n, C, H, t.shape[-1])

    qc, kc, vc, lgc = chunks(q), chunks(k), chunks(v), chunks(lg)
    b = jnp.cumsum(lgc, axis=2)
    b_ref = b[:, :, C // 2 - 1:C // 2]
    scores = jnp.einsum('bnthk,bnshk->bnhts', qc * jnp.exp(b - b_ref), kc * jnp.exp(b_ref - b))
    causal = jnp.tril(jnp.ones((C, C), dtype=bool))
    scores = jnp.where(causal, scores, 0.0)
    o_intra = jnp.einsum('bnhts,bnshv->bnthv', scores, vc)
    b_last = b[:, :, -1:]
    q_dec = qc * jnp.exp(b)
    k_dec = kc * jnp.exp(b_last - b)
    chunk_decay = jnp.exp(b_last[:, :, 0])

    def step(S, inp):
        q_t, k_t, v_t, d_t = inp
        o = jnp.einsum('bthk,bhkv->bthv', q_t, S)
        S = S * d_t[..., None] + jnp.einsum('bthk,bthv->bhkv', k_t, v_t)
        return S, o

    xs = tuple(jnp.moveaxis(t, 1, 0) for t in (q_dec, k_dec, vc, chunk_decay))
    S, o_inter = lax.scan(step, S0.astype(f32), xs)
    o = o_intra + jnp.moveaxis(o_inter, 0, 1)
    return S, o.reshape(B, L, H, V)


def gla_mixer(P, S0, gk2, gk_b, norm_w):
    f32 = jnp.float32
    B, L, _ = P.shape
    q, k, v, g, gkd = jnp.split(P, [GLA_DK, 2 * GLA_DK, 2 * GLA_DK + GLA_DV, 2 * GLA_DK + 2 * GLA_DV], axis=-1)
    gkd = gkd.reshape(B, L, 2, GLA_GK_RANK)
    lg = jax.nn.log_sigmoid((jnp.einsum('bldr,drk->bldk', gkd, gk2) + gk_b).astype(f32)) / GLA_GATE_NORM
    qh = q.reshape(B, L, GLA_H, GLA_HK) * (GLA_HK ** -0.5)
    kh = k.reshape(B, L, GLA_H, GLA_HK)
    vh = v.reshape(B, L, GLA_H, GLA_HV)
    lgh = lg.reshape(B, L, 2, GLA_H, GLA_HK)

    def flip(t):
        return jnp.flip(t, axis=1)

    S_f, o_f = gla_chunked(qh, kh, vh, lgh[:, :, 0], S0[:, 0])
    S_b, o_b = gla_chunked(flip(qh), flip(kh), flip(vh), flip(lgh[:, :, 1]), S0[:, 1])
    o = o_f + flip(o_b)
    o = o * lax.rsqrt(jnp.mean(o * o, axis=-1, keepdims=True) + EPS) * norm_w.astype(f32)
    out = o.reshape(B, L, GLA_DV) * jax.nn.silu(g.astype(f32))
    return out.astype(P.dtype), jnp.stack([S_f, S_b], axis=1).astype(P.dtype)


def channel_mixer(h, w_up, conv_w, w_down, rows, cols):
    u_gate, u_val = jnp.split(h @ w_up, 2, axis=-1)
    return (jax.nn.silu(dwconv_grid(u_gate, conv_w, rows, cols)) * u_val) @ w_down


def residual_block(x, mods, grid, S0, mixer, g_mix, g_ffn, w_up, conv_w, w_down):
    sh1, sc1, gt1, sh2, sc2, gt2 = mods
    y, S = mixer(modulate(rms_norm(x, g_mix), sh1, sc1), S0)
    x = x + gt1 * y
    h = modulate(rms_norm(x, g_ffn), sh2, sc2)
    x = x + gt2 * channel_mixer(h, w_up, conv_w, w_down, grid[0], grid[1])
    return x, S


def setup_inputs(seed: int = 0) -> dict:
    key = jax.random.key(seed)
    ks = iter(jax.random.split(key, 64))
    f32 = jnp.float32
    D = D_MODEL

    def nrm(shape, scale):
        return scale * jax.random.normal(next(ks), shape, f32)

    def near_one(shape):
        return 1.0 + nrm(shape, 0.05)

    def unif(shape, lo, hi):
        return jax.random.uniform(next(ks), shape, f32, lo, hi)

    return {
        'x_prompt': nrm((BATCH, SEQ, D), 1.0),
        'x_sample': nrm((DEC_BATCH, DEC_SEQ, D), 1.0),
        'state_rwkv': nrm((DEC_BATCH, N_EVEN, 2, RW_H, RW_HEAD, RW_HEAD), 0.5),
        'state_gla': nrm((DEC_BATCH, N_ODD, 2, GLA_H, GLA_HK, GLA_HV), 0.5),
        'c': nrm((DEC_BATCH, D), 1.0),
        'c_ctx': nrm((D,), 1.0),
        'w_ada': nrm((DEPTH, D, 6 * D), 0.5 * D ** -0.5),
        'b_ada': nrm((DEPTH, 6 * D), 0.02),
        'norm_mix': near_one((DEPTH, D)),
        'norm_ffn': near_one((DEPTH, D)),
        'ffn_w_up': nrm((DEPTH, D, 2 * D_FF), D ** -0.5),
        'ffn_conv': nrm((DEPTH, 3, 3, D_FF), 1.0 / 3.0),
        'ffn_w_down': nrm((DEPTH, D_FF, D), D_FF ** -0.5),
        'norm_final': near_one((D,)),
        'ev_w_in': nrm((N_EVEN, D, EV_IN), D ** -0.5),
        'ev_w_out': nrm((N_EVEN, D_HY + D_RW, D), (D_HY + D_RW) ** -0.5),
        'hy_short_w': nrm((N_EVEN, 3, 3 * D_HY), 3 ** -0.5),
        'hy_short_b': nrm((N_EVEN, 3 * D_HY), 0.02),
        'hy_w1': nrm((N_EVEN, HY_EMB, HY_FH), HY_EMB ** -0.5),
        'hy_b1': nrm((N_EVEN, HY_FH), 0.1),
        'hy_w2': nrm((N_EVEN, HY_FH, HY_FH), HY_FH ** -0.5),
        'hy_b2': nrm((N_EVEN, HY_FH), 0.1),
        'hy_w3': nrm((N_EVEN, HY_FH, 2 * D_HY), HY_FH ** -0.5),
        'hy_freq': near_one((N_EVEN, 2, HY_FH)),
        'hy_bias': nrm((N_EVEN, D_HY), 0.5),
        'rw_mu': unif((N_EVEN, RW_IN), 0.0, 1.0),
        'rw_w0': unif((N_EVEN, 2, D_RW), -6.0, 1.0),
        'rw_w2': nrm((N_EVEN, 2, RW_W_LORA, D_RW), 0.1 * RW_W_LORA ** -0.5),
        'rw_a0': nrm((N_EVEN, 2, D_RW), 0.1),
        'rw_a2': nrm((N_EVEN, 2, RW_A_LORA, D_RW), RW_A_LORA ** -0.5),
        'rw_g2': nrm((N_EVEN, RW_G_LORA, D_RW), RW_G_LORA ** -0.5),
        'rw_kk': 0.85 + nrm((N_EVEN, D_RW), 0.05),
        'rw_ka': near_one((N_EVEN, D_RW)),
        'rw_rk': nrm((N_EVEN, RW_H, RW_HEAD), 0.1),
        'rw_ln_w': near_one((N_EVEN, D_RW)),
        'rw_ln_b': nrm((N_EVEN, D_RW), 0.02),
        'od_w_in': nrm((N_ODD, D, OD_IN), D ** -0.5),
        'od_w_out': nrm((N_ODD, GLA_DV, D), GLA_DV ** -0.5),
        'gla_gk2': nrm((N_ODD, 2, GLA_GK_RANK, GLA_DK), GLA_GK_RANK ** -0.5),
        'gla_gk_b': nrm((N_ODD, 2, GLA_DK), 1.0),
        'gla_norm': near_one((N_ODD, GLA_HV)),
    }


def reference(x_prompt, x_sample, state_rwkv, state_gla, c, c_ctx, w_ada, b_ada, norm_mix, norm_ffn,
              ffn_w_up, ffn_conv, ffn_w_down, norm_final, ev_w_in, ev_w_out, hy_short_w, hy_short_b,
              hy_w1, hy_b1, hy_w2, hy_b2, hy_w3, hy_freq, hy_bias, rw_mu, rw_w0, rw_w2, rw_a0, rw_a2,
              rw_g2, rw_kk, rw_ka, rw_rk, rw_ln_w, rw_ln_b, od_w_in, od_w_out, gla_gk2, gla_gk_b, gla_norm):
    B_p, L_p, _ = x_prompt.shape
    L_s = x_sample.shape[1]
    grid_p = (1, L_p)
    grid_s = (L_s // GRID_W, GRID_W)
    xp, xs = x_prompt, x_sample
    rw_ctx_states = []
    gla_ctx_states = []
    for layer in range(DEPTH):
        mods_p = adaln(c_ctx[None, :], w_ada[layer], b_ada[layer])
        mods_s = adaln(c, w_ada[layer], b_ada[layer])
        if layer % 2 == 0:
            e = layer // 2

            def mixer(h, S0, e=e):
                P = h @ ev_w_in[e]
                y_hy = hyena_mixer(P[..., :3 * D_HY], hy_short_w[e], hy_short_b[e], hy_w1[e], hy_b1[e],
                                   hy_w2[e], hy_b2[e], hy_w3[e], hy_freq[e], hy_bias[e])
                y_rw, S = rwkv7_mixer(P[..., 3 * D_HY:], S0, rw_mu[e], rw_w0[e], rw_w2[e], rw_a0[e], rw_a2[e],
                                      rw_g2[e], rw_kk[e], rw_ka[e], rw_rk[e], rw_ln_w[e], rw_ln_b[e])
                return jnp.concatenate([y_hy, y_rw], axis=-1) @ ev_w_out[e], S

            S0_p = jnp.zeros((B_p, 2, RW_H, RW_HEAD, RW_HEAD), x_prompt.dtype)
            S0_s = state_rwkv[:, e]
            store = rw_ctx_states
        else:
            o = layer // 2

            def mixer(h, S0, o=o):
                y, S = gla_mixer(h @ od_w_in[o], S0, gla_gk2[o], gla_gk_b[o], gla_norm[o])
                return y @ od_w_out[o], S

            S0_p = jnp.zeros((B_p, 2, GLA_H, GLA_HK, GLA_HV), x_prompt.dtype)
            S0_s = state_gla[:, o]
            store = gla_ctx_states
        xp, S_ctx = residual_block(xp, mods_p, grid_p, S0_p, mixer, norm_mix[layer], norm_ffn[layer],
                                   ffn_w_up[layer], ffn_conv[layer], ffn_w_down[layer])
        xs, _ = residual_block(xs, mods_s, grid_s, S0_s, mixer, norm_mix[layer], norm_ffn[layer],
                               ffn_w_up[layer], ffn_conv[layer], ffn_w_down[layer])
        store.append(S_ctx)
    y_prompt = rms_norm(xp, norm_final)
    y_sample = rms_norm(xs, norm_final)
    new_state_rwkv = jnp.stack(rw_ctx_states, axis=1)
    new_state_gla = jnp.stack(gla_ctx_states, axis=1)
    return (y_prompt, y_sample, new_state_rwkv, new_state_gla)
```

```cpp
#include <hip/hip_runtime.h>
#include <hip/hip_cooperative_groups.h>
#include <cstdio>
namespace cg = cooperative_groups;

#define DEV __device__ __forceinline__
#define LAS __attribute__((address_space(3)))
typedef unsigned short u16;
typedef short bf16x8 __attribute__((ext_vector_type(8)));
typedef float f32x4 __attribute__((ext_vector_type(4)));
typedef float f32x16 __attribute__((ext_vector_type(16)));
typedef unsigned u32x2 __attribute__((ext_vector_type(2)));
typedef unsigned u32x4 __attribute__((ext_vector_type(4)));

constexpr int NTOK = 24576, NTP = 8192, DM = 2048;
constexpr int LDP0 = 6656, LDP1 = 6400, LDU = 11264, DFF = 5632;
constexpr size_t OFF_WIN = 0, OFF_WOUT = 27262976, OFF_WUP = 35651584, OFF_WDN = OFF_WUP + 46137344;
constexpr size_t OFF_A = 104857600, OFF_BIG = 205520896;
constexpr size_t OFF_P = OFF_BIG, OFF_RW = OFF_BIG + 327155712, OFF_UT = OFF_RW + 201326592, OFF_GS = OFF_UT + 50331648, OFF_GP = OFF_GS + 16777216;
constexpr size_t OFF_U = OFF_BIG, OFF_OF = OFF_BIG + 314572800, OFF_OB = OFF_OF + 100663296;
constexpr size_t OFF_SMALL = OFF_BIG + 600000000, SMALL_BYTES = 491520 + 8192;
constexpr size_t WS_NEED = OFF_SMALL + SMALL_BYTES;
constexpr size_t OUT_RWST = 50331648, OUT_GLAST = 54525952;

struct Params {
    const float* in[41];
    float* out;
    unsigned char* ws;
};

DEV int tidx() { int t = threadIdx.x; asm volatile("" : "+v"(t)); return t; }
DEV Params launder(const Params& p) { Params q = p; asm volatile("" : "+s"(q.ws), "+s"(q.out)); return q; }
DEV float bf2f(unsigned b) { return __uint_as_float(b << 16); }
DEV float bflo(unsigned w) { return __uint_as_float(w << 16); }
DEV float bfhi(unsigned w) { return __uint_as_float(w & 0xffff0000u); }
DEV unsigned pk(float lo, float hi) { unsigned r; asm("v_cvt_pk_bf16_f32 %0, %1, %2" : "=v"(r) : "v"(lo), "v"(hi)); return r; }
DEV u16 f2bf(float f) { return (u16)(pk(f, 0.f) & 0xffffu); }
DEV float wave_sum(float v) {
#pragma unroll
    for (int o = 32; o > 0; o >>= 1) v += __shfl_xor(v, o);
    return v;
}
template <int CTRL> DEV float dppf(float x) { return __builtin_bit_cast(float, __builtin_amdgcn_update_dpp(0, __builtin_bit_cast(int, x), CTRL, 0xf, 0xf, true)); }
DEV float sum8(float v) { v += dppf<0xB1>(v); v += dppf<0x4E>(v); v += dppf<0x141>(v); return v; }
DEV float sum16(float v) { v = sum8(v); v += dppf<0x140>(v); return v; }
DEV float sigm(float x) { return 1.f / (1.f + __expf(-x)); }
DEV int tok_cond(int tok) { return tok < NTP ? 4 : ((tok - NTP) >> 12); }
DEV void tok_tl(int tok, int& t, int& L) { if (tok < NTP) { t = tok & 255; L = 256; } else { t = (tok - NTP) & 4095; L = 4096; } }
DEV void unpack8(u32x4 w, float* o) { o[0] = bflo(w.x); o[1] = bfhi(w.x); o[2] = bflo(w.y); o[3] = bfhi(w.y); o[4] = bflo(w.z); o[5] = bfhi(w.z); o[6] = bflo(w.w); o[7] = bfhi(w.w); }
DEV void unpack4(u32x2 w, float* o) { o[0] = bflo(w.x); o[1] = bfhi(w.x); o[2] = bflo(w.y); o[3] = bfhi(w.y); }

namespace pg8 {
constexpr int BM = 256, BK = 64, HALF = 128, HTB = HALF * BK * 2, NXCD = 8, WGM = 8;
DEV int lds_byte(int r, int c) { const int st = (r >> 4) * 2 + (c >> 5), rr = r & 15, cc = c & 31, ob = rr * 64 + cc * 2; return st * 1024 + (ob ^ (((ob >> 9) & 1) << 5)); }
DEV void stage_rc(int b, int& R, int& C) { const int st = b / 1024, sb = b % 1024, swz = sb ^ (((sb >> 9) & 1) << 5); R = (st >> 1) * 16 + swz / 64; C = (st & 1) * 32 + (swz % 64) / 2; }
DEV int perm32(int rho) { const int n = rho >> 4, i = rho & 15; return 8 * (i >> 2) + 4 * n + (i & 3); }
struct Unit { int pm, pn; };
struct Gemm { const u16* A; const u16* Bt; int M, N, K, lda, ldb; };
struct StaticOrder {
    int nM, nN, nwg, G, c;
    DEV void init(int M, int N, int G_, int c_) { nM = M / BM; nN = N / BM; nwg = nM * nN; G = G_; c = c_; }
    DEV bool next(int i, Unit& u) const {
        const long L = (long)i * G + c; if (L >= nwg) return false;
        int wgid = (int)L; { const int q = nwg / NXCD, r = nwg % NXCD, xcd = wgid % NXCD, off = wgid / NXCD; wgid = (xcd < r ? xcd * (q + 1) : r * (q + 1) + (xcd - r) * q) + off; }
        const int nig = WGM * nN, gid = wgid / nig, fm = gid * WGM, gsz = (nM - fm) < WGM ? (nM - fm) : WGM;
        u.pm = fm + ((wgid % nig) % gsz); u.pn = (wgid % nig) / gsz; return true;
    }
};
struct EpiBf16 {
    static constexpr bool PERM = true;
    u16* O; int ldc;
    DEV void operator()(const f32x4 (&acc)[2][2][4][2], const Unit& u, int wr, int wc, int fr, int fq) const {
        const int row0 = u.pm * BM + wr * 64 + fr; const int col0 = u.pn * BM + wc * 32 + 8 * fq;
#pragma unroll
        for (int ai = 0; ai < 2; ++ai)
#pragma unroll
            for (int m = 0; m < 4; ++m) { u16* rowp = O + (size_t)(row0 + ai * HALF + m * 16) * ldc + col0;
#pragma unroll
                for (int bj = 0; bj < 2; ++bj) { const f32x4 v0 = acc[ai][bj][m][0], v1 = acc[ai][bj][m][1];
                    u32x4 w; w.x = pk(v0[0], v0[1]); w.y = pk(v0[2], v0[3]); w.z = pk(v1[0], v1[1]); w.w = pk(v1[2], v1[3]);
                    *(u32x4*)(rowp + bj * HALF) = w; } }
    }
};
struct EpiRes {
    static constexpr bool PERM = false;
    float* X; const float* gm; const float* gb;
    DEV void operator()(const f32x4 (&acc)[2][2][4][2], const Unit& u, int wr, int wc, int fr, int fq) const {
        const int row0 = u.pm * BM + wr * 64 + fr, col0 = u.pn * BM + wc * 32 + 4 * fq;
        const int cond = u.pm < 32 ? 4 : ((u.pm - 32) >> 4);
        const float* gmc = gm + (size_t)cond * 12288 + col0; const float* gbc = gb + col0;
#pragma unroll
        for (int ai = 0; ai < 2; ++ai)
#pragma unroll
            for (int m = 0; m < 4; ++m) { float* rowp = X + (size_t)(row0 + ai * HALF + m * 16) * DM + col0;
#pragma unroll
                for (int bj = 0; bj < 2; ++bj) {
#pragma unroll
                    for (int n = 0; n < 2; ++n) { f32x4* q = (f32x4*)(rowp + bj * HALF + n * 16);
                        const f32x4 gvv = *(const f32x4*)(gmc + bj * HALF + n * 16) + *(const f32x4*)(gbc + bj * HALF + n * 16);
                        *q = *q + gvv * acc[ai][bj][m][n]; }
                    asm volatile("" ::: "memory"); } }
    }
};

template <class Epi>
DEV void gemm_phase(LAS unsigned char* lds, const Gemm g, const StaticOrder& S, const Epi& E) {
    const int tid = tidx(), wid = __builtin_amdgcn_readfirstlane(tid >> 6), lane = tid & 63, wr = wid >> 2, wc = wid & 3, fr = lane & 15, fq = lane >> 4;
    const int K = g.K, nt = K / BK;
    unsigned voffA[2], voffB[2];
#pragma unroll
    for (int i = 0; i < 2; ++i) { int R, C; stage_rc(tid * 16 + i * 8192, R, C); const int Rb = Epi::PERM ? ((R & ~31) + perm32(R & 31)) : R;
        voffA[i] = (unsigned)(R * g.lda + C) * 2u; voffB[i] = (unsigned)(Rb * g.ldb + C) * 2u; }
    const size_t kstep = (size_t)(BK * 2);
    const size_t hstepA = (size_t)HALF * g.lda * 2, hstepB = (size_t)HALF * g.ldb * 2;
    const size_t tstepA = 2 * hstepA, tstepB = 2 * hstepB;
    const unsigned ldsw = (unsigned)wid * 1024u;
    const int aoff = lds_byte(wr * 64 + fr, fq * 8), boff = lds_byte(wc * 32 + fr, fq * 8);
#define PG8_SA(b, h) (((b) * 2 + (h)) * HTB)
#define PG8_SB(b, h) ((4 + (b) * 2 + (h)) * HTB)
#define PG8_STAGE(bufoff, gbase, voff) do { _Pragma("unroll") for (int _i = 0; _i < 2; ++_i) \
        __builtin_amdgcn_global_load_lds((const unsigned*)((const char*)(gbase) + (voff)[_i]), (LAS unsigned*)(lds + (bufoff) + ldsw + _i * 8192), 16, 0, 0); } while (0)
#define PG8_LDA(dst, b, h) do { _Pragma("unroll") for (int m = 0; m < 4; ++m) _Pragma("unroll") for (int k = 0; k < 2; ++k) dst[m][k] = *(const LAS bf16x8*)(lds + PG8_SA(b, h) + aoff + m * 2048 + k * 1024); } while (0)
#define PG8_LDB(dst, b, h) do { _Pragma("unroll") for (int n = 0; n < 2; ++n) _Pragma("unroll") for (int k = 0; k < 2; ++k) dst[n][k] = *(const LAS bf16x8*)(lds + PG8_SB(b, h) + boff + n * 2048 + k * 1024); } while (0)
#define PG8_MMA(ai, bj, At, Bt) do { __builtin_amdgcn_s_setprio(1); _Pragma("unroll") for (int m = 0; m < 4; ++m) _Pragma("unroll") for (int n = 0; n < 2; ++n) _Pragma("unroll") for (int k = 0; k < 2; ++k) \
        acc[ai][bj][m][n] = __builtin_amdgcn_mfma_f32_16x16x32_bf16(Bt[n][k], At[m][k], acc[ai][bj][m][n], 0, 0, 0); __builtin_amdgcn_s_setprio(0); } while (0)
#define PG8_WAIT_V(n) asm volatile("s_waitcnt vmcnt(" #n ")" ::: "memory")
#define PG8_WAIT_L(n) asm volatile("s_waitcnt lgkmcnt(" #n ")" ::: "memory")
#define PG8_BAR __builtin_amdgcn_s_barrier()
#define PG8_SCHED __builtin_amdgcn_sched_barrier(0)
    Unit cur, nxt; int ui = 0;
    if (!S.next(0, cur)) return;
    f32x4 acc[2][2][4][2];
#pragma unroll
    for (int a = 0; a < 2; ++a)
#pragma unroll
        for (int b = 0; b < 2; ++b)
#pragma unroll
            for (int m = 0; m < 4; ++m)
#pragma unroll
                for (int n = 0; n < 2; ++n) acc[a][b][m][n] = (f32x4){0.f, 0.f, 0.f, 0.f};
    bf16x8 At[4][2], B0[2][2], B1[2][2];
    const char* cA = (const char*)g.A + (size_t)cur.pm * tstepA; const char* cB = (const char*)g.Bt + (size_t)cur.pn * tstepB;
    PG8_STAGE(PG8_SB(0, 0), cB, voffB); PG8_STAGE(PG8_SA(0, 0), cA, voffA); PG8_STAGE(PG8_SB(0, 1), cB + hstepB, voffB); PG8_STAGE(PG8_SA(0, 1), cA + hstepA, voffA);
    if (wr == 1) PG8_BAR;
    PG8_WAIT_V(4); PG8_BAR;
    PG8_STAGE(PG8_SB(1, 0), cB + kstep, voffB); PG8_STAGE(PG8_SA(1, 0), cA + kstep, voffA); PG8_STAGE(PG8_SB(1, 1), cB + hstepB + kstep, voffB);
    PG8_WAIT_V(6); PG8_BAR;
    for (;;) {
        const bool has_next = S.next(ui + 1, nxt);
        const char* nA = has_next ? (const char*)g.A + (size_t)nxt.pm * tstepA : cA; const char* nB = has_next ? (const char*)g.Bt + (size_t)nxt.pn * tstepB : cB;
        for (int t = 0; t < nt; t += 2) {
            const bool last = (t == nt - 2);
            const char* a1 = cA + (size_t)(t + 1) * kstep;
            const char* a2 = last ? nA : cA + (size_t)(t + 2) * kstep; const char* b2 = last ? nB : cB + (size_t)(t + 2) * kstep;
            const char* a3 = a2 + kstep; const char* b3 = b2 + kstep;
            PG8_LDB(B0, 0, 0); PG8_SCHED; PG8_LDA(At, 0, 0); PG8_STAGE(PG8_SA(1, 1), a1 + hstepA, voffA);
            PG8_WAIT_L(8); PG8_BAR; PG8_WAIT_L(0); PG8_MMA(0, 0, At, B0); PG8_BAR; PG8_SCHED;
            PG8_LDB(B1, 0, 1); PG8_STAGE(PG8_SB(0, 0), b2, voffB);
            PG8_BAR; PG8_WAIT_L(0); PG8_MMA(0, 1, At, B1); PG8_BAR;
            PG8_LDA(At, 0, 1); PG8_STAGE(PG8_SA(0, 0), a2, voffA);
            PG8_BAR; PG8_WAIT_L(0); PG8_MMA(1, 0, At, B0); PG8_BAR; PG8_SCHED;
            PG8_STAGE(PG8_SB(0, 1), b2 + hstepB, voffB);
            PG8_WAIT_V(6); PG8_BAR; PG8_MMA(1, 1, At, B1); PG8_BAR;
            PG8_LDB(B0, 1, 0); PG8_SCHED; PG8_LDA(At, 1, 0); PG8_STAGE(PG8_SA(0, 1), a2 + hstepA, voffA);
            PG8_WAIT_L(8); PG8_BAR; PG8_WAIT_L(0); PG8_MMA(0, 0, At, B0); PG8_BAR; PG8_SCHED;
            PG8_LDB(B1, 1, 1); PG8_STAGE(PG8_SB(1, 0), b3, voffB);
            PG8_BAR; PG8_WAIT_L(0); PG8_MMA(0, 1, At, B1); PG8_BAR;
            PG8_LDA(At, 1, 1); PG8_STAGE(PG8_SA(1, 0), a3, voffA);
            PG8_BAR; PG8_WAIT_L(0); PG8_MMA(1, 0, At, B0); PG8_BAR; PG8_SCHED;
            PG8_STAGE(PG8_SB(1, 1), b3 + hstepB, voffB);
            PG8_WAIT_V(6); PG8_BAR; PG8_MMA(1, 1, At, B1); PG8_BAR;
        }
        E(acc, cur, wr, wc, fr, fq);
        if (!has_next) break;
#pragma unroll
        for (int a = 0; a < 2; ++a)
#pragma unroll
            for (int b = 0; b < 2; ++b)
#pragma unroll
                for (int m = 0; m < 4; ++m)
#pragma unroll
                    for (int n = 0; n < 2; ++n) acc[a][b][m][n] = (f32x4){0.f, 0.f, 0.f, 0.f};
        cur = nxt; cA = nA; cB = nB; ++ui;
    }
    PG8_WAIT_V(0);
    if (wr == 0) PG8_BAR;
    PG8_BAR;
#undef PG8_SA
#undef PG8_SB
#undef PG8_STAGE
#undef PG8_LDA
#undef PG8_LDB
#undef PG8_MMA
#undef PG8_WAIT_V
#undef PG8_WAIT_L
#undef PG8_BAR
#undef PG8_SCHED
}
}

template <class Epi>
DEV void run_gemm(unsigned char* shm, const u16* A, int lda, const u16* Bt, int ldb, int N, int K, const Epi& E) {
    asm volatile("" : "+s"(A), "+s"(Bt));
    pg8::Gemm g; g.A = A; g.Bt = Bt; g.M = NTOK; g.N = N; g.K = K; g.lda = lda; g.ldb = ldb;
    pg8::StaticOrder S; S.init(NTOK, N, (int)gridDim.x, (int)blockIdx.x);
    pg8::gemm_phase<Epi>((LAS unsigned char*)shm, g, S, E);
}

DEV void convT_tile(const float* __restrict__ src, u16* __restrict__ dst, int K, int N, int Npad, int tile, float* T) {
    const int tid = tidx(); const int ntn = Npad >> 6; const int k0 = (tile / ntn) << 6, n0 = (tile % ntn) << 6;
#pragma unroll
    for (int j = 0; j < 2; ++j) { const int idx = tid + j * 512; const int r = idx >> 4, c4 = (idx & 15) << 2;
        float4 v = make_float4(0.f, 0.f, 0.f, 0.f); if (n0 + c4 < N) v = *(const float4*)(src + (size_t)(k0 + r) * N + n0 + c4);
        float* t = T + r * 65 + c4; t[0] = v.x; t[1] = v.y; t[2] = v.z; t[3] = v.w; }
    __syncthreads();
    { const int nn = tid >> 3, kq = (tid & 7) << 3; const float* t = T + kq * 65 + nn;
        u32x4 o; o.x = pk(t[0], t[65]); o.y = pk(t[130], t[195]); o.z = pk(t[260], t[325]); o.w = pk(t[390], t[455]);
        *(u32x4*)(dst + (size_t)(n0 + nn) * K + k0 + kq) = o; }
    __syncthreads();
}
DEV int conv_ntiles(int job, int layer) { return job == 0 ? (layer ? 3200 : 3328) : job == 1 ? 1024 : job == 2 ? 5632 : 2816; }
DEV void conv_job(const Params& p, int job, int layer, int tile, float* T) {
    if (job == 0) convT_tile(layer ? p.in[36] : p.in[14], (u16*)(p.ws + OFF_WIN), 2048, layer ? 6176 : 6528, layer ? LDP1 : LDP0, tile, T);
    else if (job == 1) convT_tile(layer ? p.in[37] : p.in[15], (u16*)(p.ws + OFF_WOUT), 2048, 2048, 2048, tile, T);
    else if (job == 2) convT_tile(p.in[10] + (size_t)layer * 2048 * 11264, (u16*)(p.ws + OFF_WUP), 2048, 11264, 11264, tile, T);
    else convT_tile(p.in[12] + (size_t)layer * 5632 * 2048, (u16*)(p.ws + OFF_WDN), 5632, 2048, 2048, tile, T);
}

DEV void adaln_tile(const Params& p, int tile, float* sl) {
    const int tid = tidx(); const int nt = tile % 6, kc = (tile / 6) & 31, layer = tile / 192;
    if (tid < 320) { const int j = tid >> 6, kk = tid & 63; const float cv = (j < 4) ? p.in[4][j * 2048 + kc * 64 + kk] : p.in[5][kc * 64 + kk]; sl[tid] = cv / (1.f + expf(-cv)); }
    __syncthreads();
    const float* w = p.in[6] + ((size_t)layer * 2048 + kc * 64) * 12288 + nt * 2048 + tid * 4;
    float acc[5][4];
#pragma unroll
    for (int j = 0; j < 5; ++j) { acc[j][0] = 0.f; acc[j][1] = 0.f; acc[j][2] = 0.f; acc[j][3] = 0.f; }
#pragma unroll 8
    for (int kk = 0; kk < 64; ++kk) { const float4 wv = *(const float4*)(w + (size_t)kk * 12288);
#pragma unroll
        for (int j = 0; j < 5; ++j) { const float s = sl[j * 64 + kk]; acc[j][0] += s * wv.x; acc[j][1] += s * wv.y; acc[j][2] += s * wv.z; acc[j][3] += s * wv.w; } }
    float* m = (float*)(p.ws + OFF_A) + (size_t)kc * 122880 + (size_t)layer * 5 * 12288 + nt * 2048 + tid * 4;
#pragma unroll
    for (int j = 0; j < 5; ++j) *(float4*)(m + j * 12288) = make_float4(acc[j][0], acc[j][1], acc[j][2], acc[j][3]);
    __syncthreads();
}

DEV void hyfilt_tile(const Params& p, int tile, float* sm) {
    const int tid = tidx();
    int L, p0; u16* G; float* nrm = (float*)(p.ws + OFF_A) + 32 * 122880 + (size_t)tile * 2048;
    if (tile < 128) { L = 4096; p0 = tile * 32; G = (u16*)(p.ws + OFF_GS); }
    else { L = 256; p0 = (tile - 128) * 32; G = (u16*)(p.ws + OFF_GP); }
    float* z = sm; float* h1 = sm + 32 * 33; float* h2 = h1 + 2048;
    const float cang = (float)(6.283185307179586 / (double)L);
    for (int i = tid; i < 32 * 33; i += 512) { const int pp = i / 33, e = i % 33; const float pos = (float)(p0 + pp); float val;
        if (e == 0) val = pos / (float)(L - 1);
        else { const int bi = (e - 1) & 15; const float fb = 1e-4f + (float)bi * ((15.f - 1e-4f) / 15.f); const float ang = (cang * pos) * fb; val = (e <= 16) ? cosf(ang) : -sinf(ang); }
        z[i] = val; }
    __syncthreads();
    for (int i = tid; i < 2048; i += 512) { const int pp = i >> 6, j = i & 63; float a = p.in[19][j];
        for (int e = 0; e < 33; ++e) a += z[pp * 33 + e] * p.in[18][e * 64 + j];
        h1[i] = sinf(p.in[23][j] * a); }
    __syncthreads();
    for (int i = tid; i < 2048; i += 512) { const int pp = i >> 6, j = i & 63; float a = p.in[21][j];
        for (int e = 0; e < 64; ++e) a += h1[pp * 64 + e] * p.in[20][e * 64 + j];
        h2[i] = sinf(p.in[23][64 + j] * a); }
    __syncthreads();
    const float dlo = 3.0701134573253946f, dhi = 15.350567286626973f;
    for (int q = 0; q < 4; ++q) { const int n = tid + 512 * q; const int c = n & 1023; const int back = n >> 10;
        float wcol[64];
#pragma unroll
        for (int e = 0; e < 64; ++e) wcol[e] = p.in[22][e * 2048 + n];
        const float delta = dlo + (dhi - dlo) * ((float)c / 1023.f);
        float asum = 0.f;
        for (int pp = 0; pp < 32; ++pp) { float a = 0.f;
#pragma unroll
            for (int e = 0; e < 64; ++e) a += h2[pp * 64 + e] * wcol[e];
            const int pos = p0 + pp; const float t = (float)pos / (float)(L - 1); a *= expf(-t * delta);
            if (!(back && pos == 0)) { asum += fabsf(a); const int lag = back ? -pos : pos; G[(size_t)c * (2 * L) + (L - lag)] = f2bf(a); } }
        nrm[n] = asum; }
    if (p0 == 0) for (int c = tid; c < 1024; c += 512) G[(size_t)c * (2 * L)] = 0;
    __syncthreads();
}

DEV void phase_prep(const Params& p, unsigned char* shm) {
    const int tid = tidx(); float* sm = (float*)shm;
    { const float4* xp = (const float4*)p.in[0]; const float4* xs = (const float4*)p.in[1]; float4* X = (float4*)p.out;
        const size_t n1 = 16777216 / 4, n = 50331648 / 4;
        for (size_t i = (size_t)blockIdx.x * 512 + tid; i < n; i += (size_t)gridDim.x * 512) X[i] = i < n1 ? xp[i] : xs[i - n1]; }
    const int n0 = 136, n1 = n0 + 384, n2 = n1 + 3328, n3 = n2 + 1024, n4 = n3 + 5632, n5 = n4 + 2816;
    for (int t = blockIdx.x; t < n5; t += gridDim.x) {
        if (t < n0) hyfilt_tile(p, t, sm);
        else if (t < n1) adaln_tile(p, t - n0, sm);
        else if (t < n2) conv_job(p, 0, 0, t - n1, sm);
        else if (t < n3) conv_job(p, 1, 0, t - n2, sm);
        else if (t < n4) conv_job(p, 2, 0, t - n3, sm);
        else conv_job(p, 3, 0, t - n4, sm);
    }
}

DEV void phase_reduce(const Params& p) {
    const float* part = (const float*)(p.ws + OFF_A); float* mods = (float*)(p.ws + OFF_SMALL); float* hn = (float*)(p.ws + OFF_SMALL + 491520);
    for (int i = blockIdx.x * 512 + tidx(); i < 122880 + 2048; i += gridDim.x * 512) {
        if (i < 122880) { float a = 0.f; for (int kc = 0; kc < 32; ++kc) a += part[(size_t)kc * 122880 + i]; mods[i] = a; }
        else { const int j = i - 122880; const int c = j & 1023; const float* hp = part + 32 * 122880; float a = 0.f;
            if (j < 1024) { for (int t = 0; t < 128; ++t) a += hp[(size_t)t * 2048 + c] + hp[(size_t)t * 2048 + 1024 + c]; }
            else { for (int t = 128; t < 136; ++t) a += hp[(size_t)t * 2048 + c] + hp[(size_t)t * 2048 + 1024 + c]; }
            hn[j] = a; }
    }
}

DEV void phase_norm(const Params& p, int layer, int which, unsigned char* shm) {
    const int tid = tidx(), wid = tid >> 6, lane = tid & 63;
    const float* g = p.in[which ? 9 : 8] + layer * 2048;
    const float* X = p.out; u16* A = (u16*)(p.ws + OFF_A);
    const float* mods = (const float*)(p.ws + OFF_SMALL) + (size_t)layer * 5 * 12288; const float* bb = p.in[7] + layer * 12288;
    const int shi = which ? 3 : 0;
    for (int row = blockIdx.x * 8 + wid; row < NTOK; row += gridDim.x * 8) {
        const float4* xr = (const float4*)(X + (size_t)row * DM);
        float4 v[8]; float ss = 0.f;
#pragma unroll
        for (int j = 0; j < 8; ++j) { v[j] = xr[lane + 64 * j]; ss += v[j].x * v[j].x + v[j].y * v[j].y + v[j].z * v[j].z + v[j].w * v[j].w; }
        ss = wave_sum(ss);
        const float rstd = rsqrtf(ss * (1.f / 2048.f) + 1e-6f);
        const float* md = mods + (size_t)tok_cond(row) * 12288;
#pragma unroll
        for (int j = 0; j < 8; ++j) { const int col = (lane + 64 * j) * 4;
            const float4 gg = *(const float4*)(g + col);
            const float4 s1 = *(const float4*)(md + shi * 2048 + col), s2 = *(const float4*)(bb + shi * 2048 + col);
            const float4 c1 = *(const float4*)(md + (shi + 1) * 2048 + col), c2 = *(const float4*)(bb + (shi + 1) * 2048 + col);
            const float o0 = v[j].x * rstd * gg.x * (1.f + c1.x + c2.x) + s1.x + s2.x;
            const float o1 = v[j].y * rstd * gg.y * (1.f + c1.y + c2.y) + s1.y + s2.y;
            const float o2 = v[j].z * rstd * gg.z * (1.f + c1.z + c2.z) + s1.z + s2.z;
            const float o3 = v[j].w * rstd * gg.w * (1.f + c1.w + c2.w) + s1.w + s2.w;
            u32x2 o; o.x = pk(o0, o1); o.y = pk(o2, o3);
            *(u32x2*)(A + (size_t)row * DM + col) = o; }
    }
    if (layer == 0 && which == 1) { const int na = conv_ntiles(0, 1), nb = na + conv_ntiles(1, 1);
        for (int t = blockIdx.x; t < nb; t += gridDim.x) { if (t < na) conv_job(p, 0, 1, t, (float*)shm); else conv_job(p, 1, 1, t - na, (float*)shm); } }
    if (layer == 1 && which == 0) { const int na = conv_ntiles(2, 1), nb = na + conv_ntiles(3, 1);
        for (int t = blockIdx.x; t < nb; t += gridDim.x) { if (t < na) conv_job(p, 2, 1, t, (float*)shm); else conv_job(p, 3, 1, t - na, (float*)shm); } }
}

DEV void sconv8(const u16* prow, bool hm, bool hp, const float* sw, const float* sb, int ch, float* o) {
    float c[8], m[8], q[8];
    unpack8(*(const u32x4*)(prow + ch), c);
    if (hm) unpack8(*(const u32x4*)(prow - LDP0 + ch), m); else { for (int i = 0; i < 8; ++i) m[i] = 0.f; }
    if (hp) unpack8(*(const u32x4*)(prow + LDP0 + ch), q); else { for (int i = 0; i < 8; ++i) q[i] = 0.f; }
#pragma unroll
    for (int i = 0; i < 8; ++i) o[i] = m[i] * sw[ch + i] + c[i] * sw[3072 + ch + i] + q[i] * sw[6144 + ch + i] + sb[ch + i];
}
DEV void hy_pre_tile(const Params& p, int tile, float* T) {
    const int tid = tidx(); const int tok0 = (tile >> 4) << 6, c0 = (tile & 15) << 6;
    const u16* P = (const u16*)(p.ws + OFF_P); u16* uT = (u16*)(p.ws + OFF_UT);
    { const int tk = tid >> 3, c8 = (tid & 7) << 3; const int tok = tok0 + tk; int t, L; tok_tl(tok, t, L);
        const u16* prow = P + (size_t)tok * LDP0; float x1[8], vv[8];
        sconv8(prow, t > 0, t < L - 1, p.in[16], p.in[17], 1024 + c0 + c8, x1);
        sconv8(prow, t > 0, t < L - 1, p.in[16], p.in[17], 2048 + c0 + c8, vv);
#pragma unroll
        for (int i = 0; i < 8; ++i) T[tk * 65 + c8 + i] = x1[i] * vv[i]; }
    __syncthreads();
    { const int ch = tid >> 3, t8 = (tid & 7) << 3; const float* t = T + t8 * 65 + ch;
        u32x4 o; o.x = pk(t[0], t[65]); o.y = pk(t[130], t[195]); o.z = pk(t[260], t[325]); o.w = pk(t[390], t[455]);
        *(u32x4*)(uT + (size_t)(c0 + ch) * NTOK + tok0 + t8) = o; }
    __syncthreads();
}
DEV void hy_post_tile(const Params& p, int tile, float* T) {
    const int tid = tidx(); const int tok0 = (tile >> 4) << 6, c0 = (tile & 15) << 6;
    const u16* P = (const u16*)(p.ws + OFF_P); const u16* uT = (const u16*)(p.ws + OFF_UT); u16* ycat = (u16*)(p.ws + OFF_A);
    { const int ch = tid >> 3, t8 = (tid & 7) << 3; float y[8]; unpack8(*(const u32x4*)(uT + (size_t)(c0 + ch) * NTOK + tok0 + t8), y);
#pragma unroll
        for (int i = 0; i < 8; ++i) T[(t8 + i) * 65 + ch] = y[i]; }
    __syncthreads();
    { const int tk = tid >> 3, c8 = (tid & 7) << 3; const int tok = tok0 + tk; int t, L; tok_tl(tok, t, L);
        const u16* prow = P + (size_t)tok * LDP0; float x0[8], x1[8], vv[8], o[8];
        sconv8(prow, t > 0, t < L - 1, p.in[16], p.in[17], c0 + c8, x0);
        sconv8(prow, t > 0, t < L - 1, p.in[16], p.in[17], 1024 + c0 + c8, x1);
        sconv8(prow, t > 0, t < L - 1, p.in[16], p.in[17], 2048 + c0 + c8, vv);
        const float* nrm = (const float*)(p.ws + OFF_SMALL + 491520) + (tok < NTP ? 1024 : 0);
#pragma unroll
        for (int i = 0; i < 8; ++i) { const int c = c0 + c8 + i; o[i] = x0[i] * (T[tk * 65 + c8 + i] / nrm[c] + x1[i] * vv[i] * p.in[24][c]); }
        u32x4 w; w.x = pk(o[0], o[1]); w.y = pk(o[2], o[3]); w.z = pk(o[4], o[5]); w.w = pk(o[6], o[7]);
        *(u32x4*)(ycat + (size_t)tok * DM + c0 + c8) = w; }
    __syncthreads();
}
DEV void hyconv_task(const Params& p, int task, unsigned char* shm) {
    const int tid = tidx(), wid = tid >> 6, lane = tid & 63;
    const bool sample = task < 1024; const int c = sample ? task : task - 1024;
    const int L = sample ? 4096 : 256, NB = sample ? 4 : 32, lgNB = sample ? 2 : 5, LP = L + 8;
    u16* uL = (u16*)shm; u16* gL = uL + NB * LP;
    const u16* G = sample ? (const u16*)(p.ws + OFF_GS) + (size_t)c * 8192 : (const u16*)(p.ws + OFF_GP) + (size_t)c * 512;
    u16* uT = (u16*)(p.ws + OFF_UT) + (size_t)c * NTOK + (sample ? NTP : 0);
    for (int i = tid * 8; i < NB * L; i += 4096) { const int b = i / L, s = i % L; *(u32x4*)(uL + b * LP + s) = *(const u32x4*)(uT + i); }
    for (int i = tid * 8; i < 2 * L; i += 4096) *(u32x4*)(gL + i) = *(const u32x4*)(G + i);
    __syncthreads();
    const int ntile = (NB * (L >> 5)) >> 5;
    const int r = lane & 31, half = lane >> 5;
    for (int ct = wid; ct < ntile; ct += 8) {
        const int col = ct * 32 + r; const int b = col & (NB - 1), i = col >> lgNB; const int t0 = i * 32;
        const int i_lo = (ct * 32) >> lgNB, i_hi = (ct * 32 + 31) >> lgNB;
        const int d_lo = 32 * i_lo - (L - 16), d_hi = 32 * i_hi;
        f32x16 acc;
#pragma unroll
        for (int j = 0; j < 16; ++j) acc[j] = 0.f;
        const u16* ub = uL + b * LP + 8 * half;
        for (int dl = d_lo; dl <= d_hi; dl += 16) {
            const u16* gq = gL + (L - dl - r + 8 * half);
            bf16x8 a;
#pragma unroll
            for (int j = 0; j < 8; ++j) a[j] = (short)gq[j];
            const int s0 = t0 - dl;
            bf16x8 bv = (bf16x8){0, 0, 0, 0, 0, 0, 0, 0};
            if (s0 >= 0 && s0 <= L - 16) bv = *(const bf16x8*)(ub + s0);
            acc = __builtin_amdgcn_mfma_f32_32x32x16_bf16(a, bv, acc, 0, 0, 0);
        }
#pragma unroll
        for (int g = 0; g < 4; ++g) { u32x2 w; w.x = pk(acc[4 * g], acc[4 * g + 1]); w.y = pk(acc[4 * g + 2], acc[4 * g + 3]);
            *(u32x2*)(uT + (size_t)b * L + t0 + 8 * g + 4 * half) = w; }
    }
    __syncthreads();
}

DEV void rwkv_lora_tile(const Params& p, int tile, float* sm) {
    const int tid = tidx(); const int tok0 = tile * 32;
    const u16* P = (const u16*)(p.ws + OFF_P); u16* RW = (u16*)(p.ws + OFF_RW);
    for (int i = tid; i < 32 * 256; i += 512) { const int tk = i >> 8, cc = i & 255; const int tok = tok0 + tk; int t, L; tok_tl(tok, t, L);
        const u16* pp = P + (size_t)tok * LDP0 + 6144 + cc; float x = bf2f(*pp); const float xm = t > 0 ? bf2f(pp[-LDP0]) : 0.f; const float xp = t < L - 1 ? bf2f(pp[LDP0]) : 0.f;
        const float mu = p.in[25][3072 + cc]; x = x + mu * (0.5f * (xm + xp) - x); if (cc < 128) x = tanhf(x);
        sm[((cc >> 6) * 32 + tk) * 64 + (cc & 63)] = x; }
    __syncthreads();
    for (int mi = 0; mi < 4; ++mi)
        for (int hf = 0; hf < 2; ++hf) { const int n = hf * 512 + tid; const int d = mi & 1;
            const float* W = (mi < 2 ? p.in[27] : p.in[29]) + (size_t)d * 64 * 1024 + n;
            float wc[64];
#pragma unroll
            for (int r = 0; r < 64; ++r) wc[r] = W[r * 1024];
            const float bias = (mi < 2 ? p.in[26] : p.in[28])[d * 1024 + n];
            const float* inp = sm + mi * 2048;
            for (int tk = 0; tk < 32; ++tk) { float a = bias;
#pragma unroll
                for (int r = 0; r < 64; r += 4) { const float4 x = *(const float4*)(inp + tk * 64 + r); a += x.x * wc[r] + x.y * wc[r + 1] + x.z * wc[r + 2] + x.w * wc[r + 3]; }
                const float sg = sigm(a); const float o = mi < 2 ? 0.6065306597f * sg : sg;
                RW[(size_t)(tok0 + tk) * 4096 + mi * 1024 + n] = f2bf(o); } }
    __syncthreads();
}
DEV float mixf(float c, float m, float q, float mu) { return c + mu * (0.5f * (m + q) - c); }
DEV void rwkv_scan_task(const Params& p, int task, float* sm) {
    const bool sample = task < 128; const int tt_ = sample ? task : task - 128;
    const int b = tt_ >> 5, h = (tt_ >> 1) & 15, dir = tt_ & 1;
    const int L = sample ? 4096 : 256; const int tok0 = sample ? NTP + b * 4096 : b * 256;
    const int tid = tidx(), wid = tid >> 6, lane = tid & 63;
    const int row = wid * 8 + (lane >> 3), kl = lane & 7;
    float S[8];
    const size_t soff = ((((size_t)b * 2 + dir) * 16 + h) * 64 + row) * 64 + kl * 8;
    if (sample) { const float4 a = *(const float4*)(p.in[2] + soff), c = *(const float4*)(p.in[2] + soff + 4);
        S[0] = a.x; S[1] = a.y; S[2] = a.z; S[3] = a.w; S[4] = c.x; S[5] = c.y; S[6] = c.z; S[7] = c.w; }
    else {
#pragma unroll
        for (int i = 0; i < 8; ++i) S[i] = 0.f; }
    float* vec = sm; float* vvs = sm + 10240; float* yb = vvs + 2048;
    const int ptt = tid >> 4, pk4 = (tid & 15) * 4; const int ch = h * 64 + pk4;
    const float4 mur = *(const float4*)(p.in[25] + ch), muk = *(const float4*)(p.in[25] + 1024 + ch), muv = *(const float4*)(p.in[25] + 2048 + ch);
    const float4 kkw = *(const float4*)(p.in[31] + ch), kaw = *(const float4*)(p.in[32] + ch);
    const float murA[4] = {mur.x, mur.y, mur.z, mur.w}, mukA[4] = {muk.x, muk.y, muk.z, muk.w}, muvA[4] = {muv.x, muv.y, muv.z, muv.w};
    const float kkwA[4] = {kkw.x, kkw.y, kkw.z, kkw.w}, kawA[4] = {kaw.x, kaw.y, kaw.z, kaw.w};
    const u16* P = (const u16*)(p.ws + OFF_P); const u16* RW = (const u16*)(p.ws + OFF_RW);
    u16* Y = (u16*)(p.out + OUT_GLAST) + (dir ? (size_t)NTOK * 1024 : 0);
    for (int c0 = 0; c0 < L; c0 += 32) {
        { const int t = dir ? (L - 1 - (c0 + ptt)) : (c0 + ptt); const size_t tok = (size_t)tok0 + t;
            const u16* pr = P + tok * LDP0 + 3072 + ch;
            float rc[4], kc[4], vc[4], rm[4], km[4], vm[4], rp[4], kp[4], vp[4], ee[4], aa[4];
            unpack4(*(const u32x2*)(pr), rc); unpack4(*(const u32x2*)(pr + 1024), kc); unpack4(*(const u32x2*)(pr + 2048), vc);
            if (t > 0) { unpack4(*(const u32x2*)(pr - LDP0), rm); unpack4(*(const u32x2*)(pr - LDP0 + 1024), km); unpack4(*(const u32x2*)(pr - LDP0 + 2048), vm); }
            else { for (int i = 0; i < 4; ++i) { rm[i] = 0.f; km[i] = 0.f; vm[i] = 0.f; } }
            if (t < L - 1) { unpack4(*(const u32x2*)(pr + LDP0), rp); unpack4(*(const u32x2*)(pr + LDP0 + 1024), kp); unpack4(*(const u32x2*)(pr + LDP0 + 2048), vp); }
            else { for (int i = 0; i < 4; ++i) { rp[i] = 0.f; kp[i] = 0.f; vp[i] = 0.f; } }
            unpack4(*(const u32x2*)(RW + tok * 4096 + dir * 1024 + ch), ee); unpack4(*(const u32x2*)(RW + tok * 4096 + (2 + dir) * 1024 + ch), aa);
            float r4[4], k4[4], v4[4], kr[4]; float ss = 0.f;
#pragma unroll
            for (int i = 0; i < 4; ++i) { r4[i] = mixf(rc[i], rm[i], rp[i], murA[i]); k4[i] = mixf(kc[i], km[i], kp[i], mukA[i]); v4[i] = mixf(vc[i], vm[i], vp[i], muvA[i]);
                kr[i] = k4[i] * kkwA[i]; ss += kr[i] * kr[i]; }
            ss = sum16(ss); const float inv = rsqrtf(ss + 1e-12f);
            float4 okk, ow, okka, okd, orr, ov;
            float tkk[4], tw[4], tkka[4], tkd[4];
#pragma unroll
            for (int i = 0; i < 4; ++i) { tkk[i] = kr[i] * inv; tw[i] = __expf(-ee[i]); tkka[i] = tkk[i] * aa[i]; tkd[i] = k4[i] * (1.f + (aa[i] - 1.f) * kawA[i]); }
            okk = make_float4(tkk[0], tkk[1], tkk[2], tkk[3]); ow = make_float4(tw[0], tw[1], tw[2], tw[3]); okka = make_float4(tkka[0], tkka[1], tkka[2], tkka[3]);
            okd = make_float4(tkd[0], tkd[1], tkd[2], tkd[3]); orr = make_float4(r4[0], r4[1], r4[2], r4[3]); ov = make_float4(v4[0], v4[1], v4[2], v4[3]);
            float* vj = vec + ptt * 320 + pk4;
            *(float4*)(vj) = okk; *(float4*)(vj + 64) = ow; *(float4*)(vj + 128) = okka; *(float4*)(vj + 192) = okd; *(float4*)(vj + 256) = orr;
            *(float4*)(vvs + ptt * 64 + pk4) = ov; }
        __syncthreads();
        for (int j = 0; j < 32; ++j) {
            const float* vj = vec + j * 320 + kl * 8;
            const float4 a0 = *(const float4*)(vj), a1 = *(const float4*)(vj + 4);
            const float4 w0 = *(const float4*)(vj + 64), w1 = *(const float4*)(vj + 68);
            const float4 b0 = *(const float4*)(vj + 128), b1 = *(const float4*)(vj + 132);
            const float4 d0 = *(const float4*)(vj + 192), d1 = *(const float4*)(vj + 196);
            const float4 r0 = *(const float4*)(vj + 256), r1 = *(const float4*)(vj + 260);
            const float vr = vvs[j * 64 + row];
            float sa = S[0] * a0.x + S[1] * a0.y + S[2] * a0.z + S[3] * a0.w + S[4] * a1.x + S[5] * a1.y + S[6] * a1.z + S[7] * a1.w;
            sa = -sum8(sa);
            S[0] = S[0] * w0.x + sa * b0.x + vr * d0.x; S[1] = S[1] * w0.y + sa * b0.y + vr * d0.y; S[2] = S[2] * w0.z + sa * b0.z + vr * d0.z; S[3] = S[3] * w0.w + sa * b0.w + vr * d0.w;
            S[4] = S[4] * w1.x + sa * b1.x + vr * d1.x; S[5] = S[5] * w1.y + sa * b1.y + vr * d1.y; S[6] = S[6] * w1.z + sa * b1.z + vr * d1.z; S[7] = S[7] * w1.w + sa * b1.w + vr * d1.w;
            float y = S[0] * r0.x + S[1] * r0.y + S[2] * r0.z + S[3] * r0.w + S[4] * r1.x + S[5] * r1.y + S[6] * r1.z + S[7] * r1.w;
            y = sum8(y);
            if (kl == 0) yb[j * 64 + row] = y;
        }
        __syncthreads();
        { const int t = dir ? (L - 1 - (c0 + ptt)) : (c0 + ptt);
            const float4 yv = *(const float4*)(yb + ptt * 64 + pk4); u32x2 w; w.x = pk(yv.x, yv.y); w.y = pk(yv.z, yv.w);
            *(u32x2*)(Y + ((size_t)tok0 + t) * 1024 + ch) = w; }
    }
    if (!sample) { float* so = p.out + OUT_RWST + soff;
        *(float4*)(so) = make_float4(S[0], S[1], S[2], S[3]); *(float4*)(so + 4) = make_float4(S[4], S[5], S[6], S[7]); }
    __syncthreads();
}
DEV void rwkv_post_tile(const Params& p, int tile, float* sm) {
    const int tid = tidx(); const int tok0 = tile * 16;
    const u16* P = (const u16*)(p.ws + OFF_P); const u16* RW = (const u16*)(p.ws + OFF_RW); u16* ycat = (u16*)(p.ws + OFF_A);
    const u16* YF = (const u16*)(p.out + OUT_GLAST); const u16* YB = YF + (size_t)NTOK * 1024;
    for (int i = tid; i < 16 * 128; i += 512) { const int tk = i >> 7, r = i & 127; const int tok = tok0 + tk; int t, L; tok_tl(tok, t, L);
        const u16* pp = P + (size_t)tok * LDP0 + 6400 + r; const float x = bf2f(*pp); const float xm = t > 0 ? bf2f(pp[-LDP0]) : 0.f; const float xp = t < L - 1 ? bf2f(pp[LDP0]) : 0.f;
        sm[i] = sigm(mixf(x, xm, xp, p.in[25][3328 + r])); }
    __syncthreads();
    float g0[16], g1[16];
#pragma unroll
    for (int k = 0; k < 16; ++k) { g0[k] = 0.f; g1[k] = 0.f; }
    const float* g2 = p.in[30];
    for (int r = 0; r < 128; r += 4) {
        float wa[4], wb[4];
#pragma unroll
        for (int q = 0; q < 4; ++q) { wa[q] = g2[(r + q) * 1024 + tid]; wb[q] = g2[(r + q) * 1024 + 512 + tid]; }
#pragma unroll
        for (int k = 0; k < 16; ++k) { const float4 s = *(const float4*)(sm + k * 128 + r);
            g0[k] += s.x * wa[0] + s.y * wa[1] + s.z * wa[2] + s.w * wa[3]; g1[k] += s.x * wb[0] + s.y * wb[1] + s.z * wb[2] + s.w * wb[3]; } }
#pragma unroll
    for (int q = 0; q < 2; ++q) { const int n = q * 512 + tid;
        const float mur = p.in[25][n], muk = p.in[25][1024 + n], muv = p.in[25][2048 + n];
        const float ka = p.in[32][n], rk = p.in[33][n], lw = p.in[34][n], lb = p.in[35][n];
#pragma unroll
        for (int k = 0; k < 16; ++k) { const int tok = tok0 + k; int t, L; tok_tl(tok, t, L);
            const u16* pr = P + (size_t)tok * LDP0 + 3072 + n;
            const bool hm = t > 0, hp = t < L - 1;
            const float r_ = mixf(bf2f(pr[0]), hm ? bf2f(pr[-LDP0]) : 0.f, hp ? bf2f(pr[LDP0]) : 0.f, mur);
            const float k_ = mixf(bf2f(pr[1024]), hm ? bf2f(pr[1024 - LDP0]) : 0.f, hp ? bf2f(pr[1024 + LDP0]) : 0.f, muk);
            const float v_ = mixf(bf2f(pr[2048]), hm ? bf2f(pr[2048 - LDP0]) : 0.f, hp ? bf2f(pr[2048 + LDP0]) : 0.f, muv);
            const float a0 = bf2f(RW[(size_t)tok * 4096 + 2048 + n]), a1 = bf2f(RW[(size_t)tok * 4096 + 3072 + n]);
            const float kd = k_ * (2.f + (a0 + a1 - 2.f) * ka);
            const float bonus = wave_sum(r_ * kd * rk);
            const float y = bf2f(YF[(size_t)tok * 1024 + n]) + bf2f(YB[(size_t)tok * 1024 + n]);
            const float mean = wave_sum(y) * (1.f / 64.f); const float dy = y - mean; const float var = wave_sum(dy * dy) * (1.f / 64.f);
            const float yn = dy * rsqrtf(var + 64e-5f) * lw + lb;
            const float gg = q ? g1[k] : g0[k];
            ycat[(size_t)tok * DM + 1024 + n] = f2bf((yn + bonus * v_) * gg); } }
    __syncthreads();
}

DEV float logsig(float x) { return fminf(x, 0.f) - log1pf(__expf(-fabsf(x))); }
DEV void gla_scan_task(const Params& p, int task, float* sm) {
    const bool sample = task < 256; const int tt_ = sample ? task : task - 256;
    const int seq = tt_ >> 3, vs = tt_ & 7; const int b = seq >> 3, h = (seq >> 1) & 3, dir = seq & 1;
    const int L = sample ? 4096 : 256; const int tok0 = sample ? NTP + b * 4096 : b * 256;
    const int tid = tidx(), kg = tid >> 6, vv = tid & 63;
    const u16* P = (const u16*)(p.ws + OFF_P); u16* O = (u16*)(p.ws + (dir ? OFF_OB : OFF_OF));
    float S[32];
    const size_t soff = ((((size_t)b * 2 + dir) * 4 + h) * 256 + kg * 32) * 512 + vs * 64 + vv;
    if (sample) {
#pragma unroll
        for (int i = 0; i < 32; ++i) S[i] = p.in[3][soff + (size_t)i * 512]; }
    else {
#pragma unroll
        for (int i = 0; i < 32; ++i) S[i] = 0.f; }
    float* qs = sm; float* ks = sm + 4096; float* wsx = sm + 8192; float* ob = sm + 12288;
    const int stt = tid >> 5, k8 = (tid & 31) * 8;
    const float* gk2 = p.in[38] + (size_t)dir * 16 * 1024 + h * 256 + k8; const float* gkb = p.in[39] + dir * 1024 + h * 256 + k8;
    for (int c0 = 0; c0 < L; c0 += 16) {
        { const int t = dir ? (L - 1 - (c0 + stt)) : (c0 + stt); const u16* rowp = P + ((size_t)tok0 + t) * LDP1;
            float q8[8], kk8[8], gd[16];
            unpack8(*(const u32x4*)(rowp + h * 256 + k8), q8); unpack8(*(const u32x4*)(rowp + 1024 + h * 256 + k8), kk8);
            unpack8(*(const u32x4*)(rowp + 6144 + dir * 16), gd); unpack8(*(const u32x4*)(rowp + 6144 + dir * 16 + 8), gd + 8);
            float x[8];
            { const float4 b0 = *(const float4*)(gkb), b1 = *(const float4*)(gkb + 4); x[0] = b0.x; x[1] = b0.y; x[2] = b0.z; x[3] = b0.w; x[4] = b1.x; x[5] = b1.y; x[6] = b1.z; x[7] = b1.w; }
#pragma unroll
            for (int r = 0; r < 16; ++r) { const float4 w0 = *(const float4*)(gk2 + r * 1024), w1 = *(const float4*)(gk2 + r * 1024 + 4);
                x[0] += gd[r] * w0.x; x[1] += gd[r] * w0.y; x[2] += gd[r] * w0.z; x[3] += gd[r] * w0.w; x[4] += gd[r] * w1.x; x[5] += gd[r] * w1.y; x[6] += gd[r] * w1.z; x[7] += gd[r] * w1.w; }
            float w8[8];
#pragma unroll
            for (int i = 0; i < 8; ++i) { w8[i] = __expf(logsig(x[i]) * 0.0625f); q8[i] *= 0.0625f; }
            float* d = qs + stt * 256 + k8; *(float4*)d = make_float4(q8[0], q8[1], q8[2], q8[3]); *(float4*)(d + 4) = make_float4(q8[4], q8[5], q8[6], q8[7]);
            d = ks + stt * 256 + k8; *(float4*)d = make_float4(kk8[0], kk8[1], kk8[2], kk8[3]); *(float4*)(d + 4) = make_float4(kk8[4], kk8[5], kk8[6], kk8[7]);
            d = wsx + stt * 256 + k8; *(float4*)d = make_float4(w8[0], w8[1], w8[2], w8[3]); *(float4*)(d + 4) = make_float4(w8[4], w8[5], w8[6], w8[7]); }
        float vreg[16];
#pragma unroll
        for (int j = 0; j < 16; ++j) { const int t = dir ? (L - 1 - (c0 + j)) : (c0 + j); vreg[j] = bf2f(P[((size_t)tok0 + t) * LDP1 + 2048 + h * 512 + vs * 64 + vv]); }
        __syncthreads();
#pragma unroll
        for (int j = 0; j < 16; ++j) { const float v = vreg[j]; float o = 0.f;
            const float* qj = qs + j * 256 + kg * 32; const float* kj = ks + j * 256 + kg * 32; const float* wj = wsx + j * 256 + kg * 32;
#pragma unroll
            for (int i = 0; i < 32; i += 4) { const float4 w4 = *(const float4*)(wj + i), k4 = *(const float4*)(kj + i), q4 = *(const float4*)(qj + i);
                S[i] = S[i] * w4.x + k4.x * v; o += q4.x * S[i];
                S[i + 1] = S[i + 1] * w4.y + k4.y * v; o += q4.y * S[i + 1];
                S[i + 2] = S[i + 2] * w4.z + k4.z * v; o += q4.z * S[i + 2];
                S[i + 3] = S[i + 3] * w4.w + k4.w * v; o += q4.w * S[i + 3]; }
            ob[(kg * 16 + j) * 64 + vv] = o; }
        __syncthreads();
        { const int idx = tid * 2; const int j = idx >> 6, v2 = idx & 63; float s0 = 0.f, s1 = 0.f;
#pragma unroll
            for (int g = 0; g < 8; ++g) { const float2 x = *(const float2*)(ob + (g * 16 + j) * 64 + v2); s0 += x.x; s1 += x.y; }
            const int t = dir ? (L - 1 - (c0 + j)) : (c0 + j);
            *(unsigned*)(O + ((size_t)tok0 + t) * DM + h * 512 + vs * 64 + v2) = pk(s0, s1); }
    }
    if (!sample) { float* so = p.out + OUT_GLAST + soff;
#pragma unroll
        for (int i = 0; i < 32; ++i) so[(size_t)i * 512] = S[i]; }
    __syncthreads();
}
DEV void phase_gla_post(const Params& p) {
    const int tid = tidx(), wid = tid >> 6, lane = tid & 63;
    const u16* P = (const u16*)(p.ws + OFF_P); const u16* OF = (const u16*)(p.ws + OFF_OF); const u16* OB = (const u16*)(p.ws + OFF_OB); u16* ycat = (u16*)(p.ws + OFF_A);
    for (int it = blockIdx.x * 8 + wid; it < NTOK * 4; it += gridDim.x * 8) { const int tok = it >> 2, h = it & 3; const int v8 = lane * 8;
        float a[8], b[8], g[8]; unpack8(*(const u32x4*)(OF + (size_t)tok * DM + h * 512 + v8), a); unpack8(*(const u32x4*)(OB + (size_t)tok * DM + h * 512 + v8), b);
        unpack8(*(const u32x4*)(P + (size_t)tok * LDP1 + 4096 + h * 512 + v8), g);
        float ss = 0.f;
#pragma unroll
        for (int i = 0; i < 8; ++i) { a[i] += b[i]; ss += a[i] * a[i]; }
        ss = wave_sum(ss); const float sc = rsqrtf(ss * (1.f / 512.f) + 1e-6f);
        float o[8];
#pragma unroll
        for (int i = 0; i < 8; ++i) o[i] = a[i] * sc * p.in[40][v8 + i] * (g[i] * sigm(g[i]));
        u32x4 w; w.x = pk(o[0], o[1]); w.y = pk(o[2], o[3]); w.z = pk(o[4], o[5]); w.w = pk(o[6], o[7]);
        *(u32x4*)(ycat + (size_t)tok * DM + h * 512 + v8) = w; }
}

DEV void phase_ffn_gate(const Params& p, int layer) {
    u16* U = (u16*)(p.ws + OFF_U); const float* cw = p.in[11] + (size_t)layer * 9 * DFF;
    const size_t nitem = (size_t)NTOK * 704;
    for (size_t it = (size_t)blockIdx.x * 512 + tidx(); it < nitem; it += (size_t)gridDim.x * 512) {
        const int tok = (int)(it / 704), c8 = (int)(it % 704) * 8;
        float acc[8];
#pragma unroll
        for (int i = 0; i < 8; ++i) acc[i] = 0.f;
        if (tok < NTP) { const int t = tok & 255;
#pragma unroll
            for (int dj = 0; dj < 3; ++dj) { const int tn = t + dj - 1; if (tn >= 0 && tn < 256) { float g[8]; unpack8(*(const u32x4*)(U + (size_t)(tok + dj - 1) * LDU + c8), g);
                    const float* w = cw + (3 + dj) * DFF + c8;
#pragma unroll
                    for (int i = 0; i < 8; ++i) acc[i] += g[i] * w[i]; } } }
        else { const int rr = ((tok - NTP) >> 6) & 63, cc = tok & 63;
#pragma unroll
            for (int di = 0; di < 3; ++di)
#pragma unroll
                for (int dj = 0; dj < 3; ++dj) { const int r2 = rr + di - 1, c2 = cc + dj - 1;
                    if (r2 >= 0 && r2 < 64 && c2 >= 0 && c2 < 64) { float g[8]; unpack8(*(const u32x4*)(U + (size_t)(tok + (di - 1) * 64 + (dj - 1)) * LDU + c8), g);
                        const float* w = cw + (di * 3 + dj) * DFF + c8;
#pragma unroll
                        for (int i = 0; i < 8; ++i) acc[i] += g[i] * w[i]; } } }
        u16* vp = U + (size_t)tok * LDU + DFF + c8; float v[8]; unpack8(*(const u32x4*)vp, v);
#pragma unroll
        for (int i = 0; i < 8; ++i) v[i] *= acc[i] * sigm(acc[i]);
        u32x4 w; w.x = pk(v[0], v[1]); w.y = pk(v[2], v[3]); w.z = pk(v[4], v[5]); w.w = pk(v[6], v[7]);
        *(u32x4*)vp = w;
    }
}

DEV void phase_final_norm(const Params& p) {
    const int tid = tidx(), wid = tid >> 6, lane = tid & 63; const float* g = p.in[13];
    for (int row = blockIdx.x * 8 + wid; row < NTOK; row += gridDim.x * 8) {
        float4* xr = (float4*)(p.out + (size_t)row * DM);
        float4 v[8]; float ss = 0.f;
#pragma unroll
        for (int j = 0; j < 8; ++j) { v[j] = xr[lane + 64 * j]; ss += v[j].x * v[j].x + v[j].y * v[j].y + v[j].z * v[j].z + v[j].w * v[j].w; }
        ss = wave_sum(ss); const float rstd = rsqrtf(ss * (1.f / 2048.f) + 1e-6f);
#pragma unroll
        for (int j = 0; j < 8; ++j) { const float4 gg = *(const float4*)(g + (lane + 64 * j) * 4);
            xr[lane + 64 * j] = make_float4(v[j].x * rstd * gg.x, v[j].y * rstd * gg.y, v[j].z * rstd * gg.z, v[j].w * rstd * gg.w); }
    }
}

__global__ void __launch_bounds__(512, 2) mega(Params p0) {
    extern __shared__ __attribute__((aligned(16))) unsigned char shm[];
    cg::grid_group grid = cg::this_grid();
    float* sm = (float*)shm;
    const int G = (int)gridDim.x, B = (int)blockIdx.x;

#ifndef SK_PREP
    phase_prep(launder(p0), shm);
#endif
    grid.sync();
    phase_reduce(launder(p0));
    grid.sync();
#pragma unroll 1
    for (int layer = 0; layer < 2; ++layer) {
#ifndef SK_NORM
        phase_norm(launder(p0), layer, 0, shm);
#endif
        grid.sync();
        { const Params p = launder(p0); const u16* A = (const u16*)(p.ws + OFF_A); pg8::EpiBf16 E; E.O = (u16*)(p.ws + OFF_P); E.ldc = layer ? LDP1 : LDP0;
#if !defined(SK_GEMM) && !defined(SK_GBF)
            run_gemm(shm, A, DM, (const u16*)(p.ws + OFF_WIN), DM, layer ? LDP1 : LDP0, DM, E);
#endif
        }
        grid.sync();
        if (layer == 0) {
#ifndef SK_PRE
            { const Params p = launder(p0); for (int t = B; t < 6144 + 768; t += G) { if (t < 6144) hy_pre_tile(p, t, sm); else rwkv_lora_tile(p, t - 6144, sm); } }
#endif
            grid.sync();
#ifndef SK_RSCAN
            { const Params p = launder(p0);
            if (B < 128) rwkv_scan_task(p, B, sm);
            else if (G > 128) { for (int j = B - 128; j < 1024; j += G - 128) rwkv_scan_task(p, 128 + j, sm); }
            if (G <= 128) { for (int j = B; j < 1024; j += G) rwkv_scan_task(p, 128 + j, sm); } }
#endif
#ifndef SK_HCONV
            { const Params p = launder(p0); for (int t = B; t < 2048; t += G) hyconv_task(p, t, shm); }
#endif
            grid.sync();
#ifndef SK_POST
            { const Params p = launder(p0); for (int t = B; t < 6144 + 1536; t += G) { if (t < 6144) hy_post_tile(p, t, sm); else rwkv_post_tile(p, t - 6144, sm); } }
#endif
            grid.sync();
        } else {
#ifndef SK_GLA
            { const Params p = launder(p0); for (int t = B; t < 256 + 2048; t += G) gla_scan_task(p, t, sm); }
#endif
            grid.sync();
#ifndef SK_GLAP
            phase_gla_post(launder(p0));
#endif
            grid.sync();
        }
        { const Params p = launder(p0); const u16* A = (const u16*)(p.ws + OFF_A); const float* mods = (const float*)(p.ws + OFF_SMALL); pg8::EpiRes E; E.X = p.out; E.gm = mods + (size_t)layer * 5 * 12288 + 2 * 2048; E.gb = p.in[7] + layer * 12288 + 2 * 2048;
#if !defined(SK_GEMM) && !defined(SK_GRES)
            run_gemm(shm, A, DM, (const u16*)(p.ws + OFF_WOUT), DM, DM, DM, E);
#endif
        }
        grid.sync();
#ifndef SK_NORM
        phase_norm(launder(p0), layer, 1, shm);
#endif
        grid.sync();
        { const Params p = launder(p0); const u16* A = (const u16*)(p.ws + OFF_A); pg8::EpiBf16 E; E.O = (u16*)(p.ws + OFF_U); E.ldc = LDU;
#if !defined(SK_GEMM) && !defined(SK_GBF)
            run_gemm(shm, A, DM, (const u16*)(p.ws + OFF_WUP), DM, LDU, DM, E);
#endif
        }
        grid.sync();
#ifndef SK_GATE
        phase_ffn_gate(launder(p0), layer);
#endif
        grid.sync();
        { const Params p = launder(p0); const float* mods = (const float*)(p.ws + OFF_SMALL); pg8::EpiRes E; E.X = p.out; E.gm = mods + (size_t)layer * 5 * 12288 + 5 * 2048; E.gb = p.in[7] + layer * 12288 + 5 * 2048;
#if !defined(SK_GEMM) && !defined(SK_GRES)
            run_gemm(shm, (const u16*)(p.ws + OFF_U) + DFF, LDU, (const u16*)(p.ws + OFF_WDN), DFF, DM, DFF, E);
#endif
        }
        grid.sync();
    }
    phase_final_norm(launder(p0));
}

extern "C" void kernel_launch(void* const* d_in, const int* in_sizes, int n_in, void* d_out, int out_size, void* d_ws, size_t ws_size, hipStream_t stream) {
    constexpr size_t kDynLds = 131072;
    static int grid_blocks = 0;
    if (!grid_blocks) {
        int dev = 0, cus = 0, per_cu = 0;
        hipGetDevice(&dev);
        hipDeviceGetAttribute(&cus, hipDeviceAttributeMultiprocessorCount, dev);
        hipFuncSetAttribute((const void*)mega, hipFuncAttributeMaxDynamicSharedMemorySize, (int)kDynLds);
        hipOccupancyMaxActiveBlocksPerMultiprocessor(&per_cu, mega, 512, kDynLds);
        if (per_cu < 1) per_cu = 1;
        grid_blocks = cus * per_cu;
        if (grid_blocks > 256) grid_blocks = 256;
    }
    if (ws_size < WS_NEED || n_in < 41) { fprintf(stderr, "workspace too small: %zu < %zu\n", ws_size, WS_NEED); return; }
    Params p{};
    for (int i = 0; i < 41; ++i) p.in[i] = (const float*)d_in[i];
    p.out = (float*)d_out; p.ws = (unsigned char*)d_ws;
    void* args[] = {&p};
    hipError_t e = hipLaunchCooperativeKernel((const void*)mega, dim3(grid_blocks), dim3(512), args, kDynLds, stream);
    if (e != hipSuccess) fprintf(stderr, "cooperative launch failed: %s (grid %d)\n", hipGetErrorString(e), grid_blocks);
}
```

```cpp
#include <hip/hip_runtime.h>
#include <hip/hip_cooperative_groups.h>
#include <cstdio>
namespace cg = cooperative_groups;

#define DEV __device__ __forceinline__
#define LAS __attribute__((address_space(3)))
typedef unsigned short u16;
typedef short bf16x8 __attribute__((ext_vector_type(8)));
typedef float f32x4 __attribute__((ext_vector_type(4)));
typedef float f32x16 __attribute__((ext_vector_type(16)));
typedef unsigned u32x2 __attribute__((ext_vector_type(2)));
typedef unsigned u32x4 __attribute__((ext_vector_type(4)));

constexpr int NTOK = 24576, NTP = 8192, DM = 2048;
constexpr int LDP0 = 6656, LDP1 = 6400, LDU = 11264, DFF = 5632;
constexpr size_t OFF_WIN = 0, OFF_WOUT = 27262976, OFF_WUP = 35651584, OFF_WDN = OFF_WUP + 46137344;
constexpr size_t OFF_A = 104857600, OFF_BIG = 205520896;
constexpr size_t OFF_P = OFF_BIG, OFF_RW = OFF_BIG + 327155712, OFF_UT = OFF_RW + 201326592, OFF_GS = OFF_UT + 50331648, OFF_GP = OFF_GS + 16777216;
constexpr size_t OFF_U = OFF_BIG, OFF_OF = OFF_BIG + 314572800, OFF_OB = OFF_OF + 100663296, OFF_DB = OFF_OB + 100663296;
constexpr size_t OFF_SMALL = OFF_BIG + 600000000, SMALL_BYTES = 491520 + 8192;
constexpr size_t WS_NEED = OFF_SMALL + SMALL_BYTES;
constexpr size_t OUT_RWST = 50331648, OUT_GLAST = 54525952;

struct Params {
    const float* in[41];
    float* out;
    unsigned char* ws;
};

DEV int tidx() { int t = threadIdx.x; asm volatile("" : "+v"(t)); return t; }
DEV Params launder(const Params& p) { Params q = p; asm volatile("" : "+s"(q.ws), "+s"(q.out)); return q; }
DEV float bf2f(unsigned b) { return __uint_as_float(b << 16); }
DEV float bflo(unsigned w) { return __uint_as_float(w << 16); }
DEV float bfhi(unsigned w) { return __uint_as_float(w & 0xffff0000u); }
DEV unsigned pk(float lo, float hi) { unsigned r; asm("v_cvt_pk_bf16_f32 %0, %1, %2" : "=v"(r) : "v"(lo), "v"(hi)); return r; }
DEV u16 f2bf(float f) { return (u16)(pk(f, 0.f) & 0xffffu); }
DEV float wave_sum(float v) {
#pragma unroll
    for (int o = 32; o > 0; o >>= 1) v += __shfl_xor(v, o);
    return v;
}
template <int CTRL> DEV float dppf(float x) { return __builtin_bit_cast(float, __builtin_amdgcn_update_dpp(0, __builtin_bit_cast(int, x), CTRL, 0xf, 0xf, true)); }
DEV float sum8(float v) { v += dppf<0xB1>(v); v += dppf<0x4E>(v); v += dppf<0x141>(v); return v; }
DEV float sum16(float v) { v = sum8(v); v += dppf<0x140>(v); return v; }
DEV float sigm(float x) { return 1.f / (1.f + __expf(-x)); }
DEV int tok_cond(int tok) { return tok < NTP ? 4 : ((tok - NTP) >> 12); }
DEV void tok_tl(int tok, int& t, int& L) { if (tok < NTP) { t = tok & 255; L = 256; } else { t = (tok - NTP) & 4095; L = 4096; } }
DEV void unpack8(u32x4 w, float* o) { o[0] = bflo(w.x); o[1] = bfhi(w.x); o[2] = bflo(w.y); o[3] = bfhi(w.y); o[4] = bflo(w.z); o[5] = bfhi(w.z); o[6] = bflo(w.w); o[7] = bfhi(w.w); }
DEV void unpack4(u32x2 w, float* o) { o[0] = bflo(w.x); o[1] = bfhi(w.x); o[2] = bflo(w.y); o[3] = bfhi(w.y); }

namespace pg8 {
constexpr int BM = 256, BK = 64, HALF = 128, HTB = HALF * BK * 2, NXCD = 8, WGM = 8;
DEV int lds_byte(int r, int c) { const int st = (r >> 4) * 2 + (c >> 5), rr = r & 15, cc = c & 31, ob = rr * 64 + cc * 2; return st * 1024 + (ob ^ (((ob >> 9) & 1) << 5)); }
DEV void stage_rc(int b, int& R, int& C) { const int st = b / 1024, sb = b % 1024, swz = sb ^ (((sb >> 9) & 1) << 5); R = (st >> 1) * 16 + swz / 64; C = (st & 1) * 32 + (swz % 64) / 2; }
DEV int perm32(int rho) { const int n = rho >> 4, i = rho & 15; return 8 * (i >> 2) + 4 * n + (i & 3); }
struct Unit { int pm, pn; };
struct Gemm { const u16* A; const u16* Bt; int M, N, K, lda, ldb; };
struct StaticOrder {
    int nM, nN, nwg, G, c;
    DEV void init(int M, int N, int G_, int c_) { nM = M / BM; nN = N / BM; nwg = nM * nN; G = G_; c = c_; }
    DEV bool next(int i, Unit& u) const {
        const long L = (long)i * G + c; if (L >= nwg) return false;
        int wgid = (int)L; { const int q = nwg / NXCD, r = nwg % NXCD, xcd = wgid % NXCD, off = wgid / NXCD; wgid = (xcd < r ? xcd * (q + 1) : r * (q + 1) + (xcd - r) * q) + off; }
        const int nig = WGM * nN, gid = wgid / nig, fm = gid * WGM, gsz = (nM - fm) < WGM ? (nM - fm) : WGM;
        u.pm = fm + ((wgid % nig) % gsz); u.pn = (wgid % nig) / gsz; return true;
    }
};
struct EpiBf16 {
    static constexpr bool PERM = true;
    u16* O; int ldc;
    DEV void operator()(const f32x4 (&acc)[2][2][4][2], const Unit& u, int wr, int wc, int fr, int fq) const {
        const int row0 = u.pm * BM + wr * 64 + fr; const int col0 = u.pn * BM + wc * 32 + 8 * fq;
#pragma unroll
        for (int ai = 0; ai < 2; ++ai)
#pragma unroll
            for (int m = 0; m < 4; ++m) { u16* rowp = O + (size_t)(row0 + ai * HALF + m * 16) * ldc + col0;
#pragma unroll
                for (int bj = 0; bj < 2; ++bj) { const f32x4 v0 = acc[ai][bj][m][0], v1 = acc[ai][bj][m][1];
                    u32x4 w; w.x = pk(v0[0], v0[1]); w.y = pk(v0[2], v0[3]); w.z = pk(v1[0], v1[1]); w.w = pk(v1[2], v1[3]);
                    *(u32x4*)(rowp + bj * HALF) = w; } }
    }
};
struct EpiRes {
    static constexpr bool PERM = false;
    float* X; const float* gm; const float* gb;
    DEV void operator()(const f32x4 (&acc)[2][2][4][2], const Unit& u, int wr, int wc, int fr, int fq) const {
        const int row0 = u.pm * BM + wr * 64 + fr, col0 = u.pn * BM + wc * 32 + 4 * fq;
        const int cond = u.pm < 32 ? 4 : ((u.pm - 32) >> 4);
        const float* gmc = gm + (size_t)cond * 12288 + col0; const float* gbc = gb + col0;
#pragma unroll
        for (int ai = 0; ai < 2; ++ai)
#pragma unroll
            for (int m = 0; m < 4; ++m) { float* rowp = X + (size_t)(row0 + ai * HALF + m * 16) * DM + col0;
#pragma unroll
                for (int bj = 0; bj < 2; ++bj) {
#pragma unroll
                    for (int n = 0; n < 2; ++n) { f32x4* q = (f32x4*)(rowp + bj * HALF + n * 16);
                        const f32x4 gvv = *(const f32x4*)(gmc + bj * HALF + n * 16) + *(const f32x4*)(gbc + bj * HALF + n * 16);
                        *q = *q + gvv * acc[ai][bj][m][n]; }
                    asm volatile("" ::: "memory"); } }
    }
};

template <class Epi>
DEV void gemm_phase(LAS unsigned char* lds, const Gemm g, const StaticOrder& S, const Epi& E) {
    const int tid = tidx(), wid = __builtin_amdgcn_readfirstlane(tid >> 6), lane = tid & 63, wr = wid >> 2, wc = wid & 3, fr = lane & 15, fq = lane >> 4;
    const int K = g.K, nt = K / BK;
    unsigned voffA[2], voffB[2];
#pragma unroll
    for (int i = 0; i < 2; ++i) { int R, C; stage_rc(tid * 16 + i * 8192, R, C); const int Rb = Epi::PERM ? ((R & ~31) + perm32(R & 31)) : R;
        voffA[i] = (unsigned)(R * g.lda + C) * 2u; voffB[i] = (unsigned)(Rb * g.ldb + C) * 2u; }
    const size_t kstep = (size_t)(BK * 2);
    const size_t hstepA = (size_t)HALF * g.lda * 2, hstepB = (size_t)HALF * g.ldb * 2;
    const size_t tstepA = 2 * hstepA, tstepB = 2 * hstepB;
    const unsigned ldsw = (unsigned)wid * 1024u;
    const int aoff = lds_byte(wr * 64 + fr, fq * 8), boff = lds_byte(wc * 32 + fr, fq * 8);
#define PG8_SA(b, h) (((b) * 2 + (h)) * HTB)
#define PG8_SB(b, h) ((4 + (b) * 2 + (h)) * HTB)
#define PG8_STAGE(bufoff, gbase, voff) do { _Pragma("unroll") for (int _i = 0; _i < 2; ++_i) \
        __builtin_amdgcn_global_load_lds((const unsigned*)((const char*)(gbase) + (voff)[_i]), (LAS unsigned*)(lds + (bufoff) + ldsw + _i * 8192), 16, 0, 0); } while (0)
#define PG8_LDA(dst, b, h) do { _Pragma("unroll") for (int m = 0; m < 4; ++m) _Pragma("unroll") for (int k = 0; k < 2; ++k) dst[m][k] = *(const LAS bf16x8*)(lds + PG8_SA(b, h) + aoff + m * 2048 + k * 1024); } while (0)
#define PG8_LDB(dst, b, h) do { _Pragma("unroll") for (int n = 0; n < 2; ++n) _Pragma("unroll") for (int k = 0; k < 2; ++k) dst[n][k] = *(const LAS bf16x8*)(lds + PG8_SB(b, h) + boff + n * 2048 + k * 1024); } while (0)
#define PG8_MMA(ai, bj, At, Bt) do { __builtin_amdgcn_s_setprio(1); _Pragma("unroll") for (int m = 0; m < 4; ++m) _Pragma("unroll") for (int n = 0; n < 2; ++n) _Pragma("unroll") for (int k = 0; k < 2; ++k) \
        acc[ai][bj][m][n] = __builtin_amdgcn_mfma_f32_16x16x32_bf16(Bt[n][k], At[m][k], acc[ai][bj][m][n], 0, 0, 0); __builtin_amdgcn_s_setprio(0); } while (0)
#define PG8_WAIT_V(n) asm volatile("s_waitcnt vmcnt(" #n ")" ::: "memory")
#define PG8_WAIT_L(n) asm volatile("s_waitcnt lgkmcnt(" #n ")" ::: "memory")
#define PG8_BAR __builtin_amdgcn_s_barrier()
#define PG8_SCHED __builtin_amdgcn_sched_barrier(0)
    Unit cur, nxt; int ui = 0;
    if (!S.next(0, cur)) return;
    f32x4 acc[2][2][4][2];
#pragma unroll
    for (int a = 0; a < 2; ++a)
#pragma unroll
        for (int b = 0; b < 2; ++b)
#pragma unroll
            for (int m = 0; m < 4; ++m)
#pragma unroll
                for (int n = 0; n < 2; ++n) acc[a][b][m][n] = (f32x4){0.f, 0.f, 0.f, 0.f};
    bf16x8 At[4][2], B0[2][2], B1[2][2];
    const char* cA = (const char*)g.A + (size_t)cur.pm * tstepA; const char* cB = (const char*)g.Bt + (size_t)cur.pn * tstepB;
    PG8_STAGE(PG8_SB(0, 0), cB, voffB); PG8_STAGE(PG8_SA(0, 0), cA, voffA); PG8_STAGE(PG8_SB(0, 1), cB + hstepB, voffB); PG8_STAGE(PG8_SA(0, 1), cA + hstepA, voffA);
    if (wr == 1) PG8_BAR;
    PG8_WAIT_V(4); PG8_BAR;
    PG8_STAGE(PG8_SB(1, 0), cB + kstep, voffB); PG8_STAGE(PG8_SA(1, 0), cA + kstep, voffA); PG8_STAGE(PG8_SB(1, 1), cB + hstepB + kstep, voffB);
    PG8_WAIT_V(6); PG8_BAR;
    for (;;) {
        const bool has_next = S.next(ui + 1, nxt);
        const char* nA = has_next ? (const char*)g.A + (size_t)nxt.pm * tstepA : cA; const char* nB = has_next ? (const char*)g.Bt + (size_t)nxt.pn * tstepB : cB;
        for (int t = 0; t < nt; t += 2) {
            const bool last = (t == nt - 2);
            const char* a1 = cA + (size_t)(t + 1) * kstep;
            const char* a2 = last ? nA : cA + (size_t)(t + 2) * kstep; const char* b2 = last ? nB : cB + (size_t)(t + 2) * kstep;
            const char* a3 = a2 + kstep; const char* b3 = b2 + kstep;
            PG8_LDB(B0, 0, 0); PG8_SCHED; PG8_LDA(At, 0, 0); PG8_STAGE(PG8_SA(1, 1), a1 + hstepA, voffA);
            PG8_WAIT_L(8); PG8_BAR; PG8_WAIT_L(0); PG8_MMA(0, 0, At, B0); PG8_BAR; PG8_SCHED;
            PG8_LDB(B1, 0, 1); PG8_STAGE(PG8_SB(0, 0), b2, voffB);
            PG8_BAR; PG8_WAIT_L(0); PG8_MMA(0, 1, At, B1); PG8_BAR;
            PG8_LDA(At, 0, 1); PG8_STAGE(PG8_SA(0, 0), a2, voffA);
            PG8_BAR; PG8_WAIT_L(0); PG8_MMA(1, 0, At, B0); PG8_BAR; PG8_SCHED;
            PG8_STAGE(PG8_SB(0, 1), b2 + hstepB, voffB);
            PG8_WAIT_V(6); PG8_BAR; PG8_MMA(1, 1, At, B1); PG8_BAR;
            PG8_LDB(B0, 1, 0); PG8_SCHED; PG8_LDA(At, 1, 0); PG8_STAGE(PG8_SA(0, 1), a2 + hstepA, voffA);
            PG8_WAIT_L(8); PG8_BAR; PG8_WAIT_L(0); PG8_MMA(0, 0, At, B0); PG8_BAR; PG8_SCHED;
            PG8_LDB(B1, 1, 1); PG8_STAGE(PG8_SB(1, 0), b3, voffB);
            PG8_BAR; PG8_WAIT_L(0); PG8_MMA(0, 1, At, B1); PG8_BAR;
            PG8_LDA(At, 1, 1); PG8_STAGE(PG8_SA(1, 0), a3, voffA);
            PG8_BAR; PG8_WAIT_L(0); PG8_MMA(1, 0, At, B0); PG8_BAR; PG8_SCHED;
            PG8_STAGE(PG8_SB(1, 1), b3 + hstepB, voffB);
            PG8_WAIT_V(6); PG8_BAR; PG8_MMA(1, 1, At, B1); PG8_BAR;
        }
        E(acc, cur, wr, wc, fr, fq);
        if (!has_next) break;
#pragma unroll
        for (int a = 0; a < 2; ++a)
#pragma unroll
            for (int b = 0; b < 2; ++b)
#pragma unroll
                for (int m = 0; m < 4; ++m)
#pragma unroll
                    for (int n = 0; n < 2; ++n) acc[a][b][m][n] = (f32x4){0.f, 0.f, 0.f, 0.f};
        cur = nxt; cA = nA; cB = nB; ++ui;
    }
    PG8_WAIT_V(0);
    if (wr == 0) PG8_BAR;
    PG8_BAR;
#undef PG8_SA
#undef PG8_SB
#undef PG8_STAGE
#undef PG8_LDA
#undef PG8_LDB
#undef PG8_MMA
#undef PG8_WAIT_V
#undef PG8_WAIT_L
#undef PG8_BAR
#undef PG8_SCHED
}
}

template <class Epi>
DEV void run_gemm(unsigned char* shm, const u16* A, int lda, const u16* Bt, int ldb, int N, int K, const Epi& E) {
    asm volatile("" : "+s"(A), "+s"(Bt));
    pg8::Gemm g; g.A = A; g.Bt = Bt; g.M = NTOK; g.N = N; g.K = K; g.lda = lda; g.ldb = ldb;
    pg8::StaticOrder S; S.init(NTOK, N, (int)gridDim.x, (int)blockIdx.x);
    pg8::gemm_phase<Epi>((LAS unsigned char*)shm, g, S, E);
}

DEV void convT_tile(const float* __restrict__ src, u16* __restrict__ dst, int K, int N, int Npad, int tile, float* T) {
    const int tid = tidx(); const int ntn = Npad >> 6; const int k0 = (tile / ntn) << 6, n0 = (tile % ntn) << 6;
#pragma unroll
    for (int j = 0; j < 2; ++j) { const int idx = tid + j * 512; const int r = idx >> 4, c4 = (idx & 15) << 2;
        float4 v = make_float4(0.f, 0.f, 0.f, 0.f); if (n0 + c4 < N) v = *(const float4*)(src + (size_t)(k0 + r) * N + n0 + c4);
        float* t = T + r * 65 + c4; t[0] = v.x; t[1] = v.y; t[2] = v.z; t[3] = v.w; }
    __syncthreads();
    { const int nn = tid >> 3, kq = (tid & 7) << 3; const float* t = T + kq * 65 + nn;
        u32x4 o; o.x = pk(t[0], t[65]); o.y = pk(t[130], t[195]); o.z = pk(t[260], t[325]); o.w = pk(t[390], t[455]);
        *(u32x4*)(dst + (size_t)(n0 + nn) * K + k0 + kq) = o; }
    __syncthreads();
}
DEV int conv_ntiles(int job, int layer) { return job == 0 ? (layer ? 3200 : 3328) : job == 1 ? 1024 : job == 2 ? 5632 : 2816; }
DEV void conv_job(const Params& p, int job, int layer, int tile, float* T) {
    if (job == 0) convT_tile(layer ? p.in[36] : p.in[14], (u16*)(p.ws + OFF_WIN), 2048, layer ? 6176 : 6528, layer ? LDP1 : LDP0, tile, T);
    else if (job == 1) convT_tile(layer ? p.in[37] : p.in[15], (u16*)(p.ws + OFF_WOUT), 2048, 2048, 2048, tile, T);
    else if (job == 2) convT_tile(p.in[10] + (size_t)layer * 2048 * 11264, (u16*)(p.ws + OFF_WUP), 2048, 11264, 11264, tile, T);
    else convT_tile(p.in[12] + (size_t)layer * 5632 * 2048, (u16*)(p.ws + OFF_WDN), 5632, 2048, 2048, tile, T);
}

DEV void adaln_tile(const Params& p, int tile, float* sl) {
    const int tid = tidx(); const int nt = tile % 6, kc = (tile / 6) & 31, layer = tile / 192;
    if (tid < 320) { const int j = tid >> 6, kk = tid & 63; const float cv = (j < 4) ? p.in[4][j * 2048 + kc * 64 + kk] : p.in[5][kc * 64 + kk]; sl[tid] = cv / (1.f + expf(-cv)); }
    __syncthreads();
    const float* w = p.in[6] + ((size_t)layer * 2048 + kc * 64) * 12288 + nt * 2048 + tid * 4;
    float acc[5][4];
#pragma unroll
    for (int j = 0; j < 5; ++j) { acc[j][0] = 0.f; acc[j][1] = 0.f; acc[j][2] = 0.f; acc[j][3] = 0.f; }
#pragma unroll 8
    for (int kk = 0; kk < 64; ++kk) { const float4 wv = *(const float4*)(w + (size_t)kk * 12288);
#pragma unroll
        for (int j = 0; j < 5; ++j) { const float s = sl[j * 64 + kk]; acc[j][0] += s * wv.x; acc[j][1] += s * wv.y; acc[j][2] += s * wv.z; acc[j][3] += s * wv.w; } }
    float* m = (float*)(p.ws + OFF_A) + (size_t)kc * 122880 + (size_t)layer * 5 * 12288 + nt * 2048 + tid * 4;
#pragma unroll
    for (int j = 0; j < 5; ++j) *(float4*)(m + j * 12288) = make_float4(acc[j][0], acc[j][1], acc[j][2], acc[j][3]);
    __syncthreads();
}

DEV void hyfilt_tile(const Params& p, int tile, float* sm) {
    const int tid = tidx();
    int L, p0; u16* G; float* nrm = (float*)(p.ws + OFF_A) + 32 * 122880 + (size_t)tile * 2048;
    if (tile < 128) { L = 4096; p0 = tile * 32; G = (u16*)(p.ws + OFF_GS); }
    else { L = 256; p0 = (tile - 128) * 32; G = (u16*)(p.ws + OFF_GP); }
    float* z = sm; float* h1 = sm + 32 * 33; float* h2 = h1 + 2048;
    const float cang = (float)(6.283185307179586 / (double)L);
    for (int i = tid; i < 32 * 33; i += 512) { const int pp = i / 33, e = i % 33; const float pos = (float)(p0 + pp); float val;
        if (e == 0) val = pos / (float)(L - 1);
        else { const int bi = (e - 1) & 15; const float fb = 1e-4f + (float)bi * ((15.f - 1e-4f) / 15.f); const float ang = (cang * pos) * fb; val = (e <= 16) ? cosf(ang) : -sinf(ang); }
        z[i] = val; }
    __syncthreads();
    for (int i = tid; i < 2048; i += 512) { const int pp = i >> 6, j = i & 63; float a = p.in[19][j];
        for (int e = 0; e < 33; ++e) a += z[pp * 33 + e] * p.in[18][e * 64 + j];
        h1[i] = sinf(p.in[23][j] * a); }
    __syncthreads();
    for (int i = tid; i < 2048; i += 512) { const int pp = i >> 6, j = i & 63; float a = p.in[21][j];
        for (int e = 0; e < 64; ++e) a += h1[pp * 64 + e] * p.in[20][e * 64 + j];
        h2[i] = sinf(p.in[23][64 + j] * a); }
    __syncthreads();
    const float dlo = 3.0701134573253946f, dhi = 15.350567286626973f;
    for (int q = 0; q < 4; ++q) { const int n = tid + 512 * q; const int c = n & 1023; const int back = n >> 10;
        float wcol[64];
#pragma unroll
        for (int e = 0; e < 64; ++e) wcol[e] = p.in[22][e * 2048 + n];
        const float delta = dlo + (dhi - dlo) * ((float)c / 1023.f);
        float asum = 0.f;
        for (int pp = 0; pp < 32; ++pp) { float a = 0.f;
#pragma unroll
            for (int e = 0; e < 64; ++e) a += h2[pp * 64 + e] * wcol[e];
            const int pos = p0 + pp; const float t = (float)pos / (float)(L - 1); a *= expf(-t * delta);
            if (!(back && pos == 0)) { asum += fabsf(a); const int lag = back ? -pos : pos; G[(size_t)c * (2 * L) + (L - lag)] = f2bf(a); } }
        nrm[n] = asum; }
    if (p0 == 0) for (int c = tid; c < 1024; c += 512) G[(size_t)c * (2 * L)] = 0;
    __syncthreads();
}

DEV void phase_prep(const Params& p, unsigned char* shm) {
    const int tid = tidx(); float* sm = (float*)shm;
    { const float4* xp = (const float4*)p.in[0]; const float4* xs = (const float4*)p.in[1]; float4* X = (float4*)p.out;
        const size_t n1 = 16777216 / 4, n = 50331648 / 4;
        for (size_t i = (size_t)blockIdx.x * 512 + tid; i < n; i += (size_t)gridDim.x * 512) X[i] = i < n1 ? xp[i] : xs[i - n1]; }
    const int n0 = 136, n1 = n0 + 384, n2 = n1 + 3328, n3 = n2 + 1024, n4 = n3 + 5632, n5 = n4 + 2816;
    for (int t = blockIdx.x; t < n5; t += gridDim.x) {
        if (t < n0) hyfilt_tile(p, t, sm);
        else if (t < n1) adaln_tile(p, t - n0, sm);
        else if (t < n2) conv_job(p, 0, 0, t - n1, sm);
        else if (t < n3) conv_job(p, 1, 0, t - n2, sm);
        else if (t < n4) conv_job(p, 2, 0, t - n3, sm);
        else conv_job(p, 3, 0, t - n4, sm);
    }
}

DEV void phase_reduce(const Params& p) {
    const float* part = (const float*)(p.ws + OFF_A); float* mods = (float*)(p.ws + OFF_SMALL); float* hn = (float*)(p.ws + OFF_SMALL + 491520);
    for (int i = blockIdx.x * 512 + tidx(); i < 122880 + 2048; i += gridDim.x * 512) {
        if (i < 122880) { float a = 0.f; for (int kc = 0; kc < 32; ++kc) a += part[(size_t)kc * 122880 + i]; mods[i] = a; }
        else { const int j = i - 122880; const int c = j & 1023; const float* hp = part + 32 * 122880; float a = 0.f;
            if (j < 1024) { for (int t = 0; t < 128; ++t) a += hp[(size_t)t * 2048 + c] + hp[(size_t)t * 2048 + 1024 + c]; }
            else { for (int t = 128; t < 136; ++t) a += hp[(size_t)t * 2048 + c] + hp[(size_t)t * 2048 + 1024 + c]; }
            hn[j] = a; }
    }
}

DEV void phase_norm(const Params& p, int layer, int which, unsigned char* shm) {
    const int tid = tidx(), wid = tid >> 6, lane = tid & 63;
    const float* g = p.in[which ? 9 : 8] + layer * 2048;
    const float* X = p.out; u16* A = (u16*)(p.ws + OFF_A);
    const float* mods = (const float*)(p.ws + OFF_SMALL) + (size_t)layer * 5 * 12288; const float* bb = p.in[7] + layer * 12288;
    const int shi = which ? 3 : 0;
    for (int row = blockIdx.x * 8 + wid; row < NTOK; row += gridDim.x * 8) {
        const float4* xr = (const float4*)(X + (size_t)row * DM);
        float4 v[8]; float ss = 0.f;
#pragma unroll
        for (int j = 0; j < 8; ++j) { v[j] = xr[lane + 64 * j]; ss += v[j].x * v[j].x + v[j].y * v[j].y + v[j].z * v[j].z + v[j].w * v[j].w; }
        ss = wave_sum(ss);
        const float rstd = rsqrtf(ss * (1.f / 2048.f) + 1e-6f);
        const float* md = mods + (size_t)tok_cond(row) * 12288;
#pragma unroll
        for (int j = 0; j < 8; ++j) { const int col = (lane + 64 * j) * 4;
            const float4 gg = *(const float4*)(g + col);
            const float4 s1 = *(const float4*)(md + shi * 2048 + col), s2 = *(const float4*)(bb + shi * 2048 + col);
            const float4 c1 = *(const float4*)(md + (shi + 1) * 2048 + col), c2 = *(const float4*)(bb + (shi + 1) * 2048 + col);
            const float o0 = v[j].x * rstd * gg.x * (1.f + c1.x + c2.x) + s1.x + s2.x;
            const float o1 = v[j].y * rstd * gg.y * (1.f + c1.y + c2.y) + s1.y + s2.y;
            const float o2 = v[j].z * rstd * gg.z * (1.f + c1.z + c2.z) + s1.z + s2.z;
            const float o3 = v[j].w * rstd * gg.w * (1.f + c1.w + c2.w) + s1.w + s2.w;
            u32x2 o; o.x = pk(o0, o1); o.y = pk(o2, o3);
            *(u32x2*)(A + (size_t)row * DM + col) = o; }
    }
    if (layer == 0 && which == 1) { const int na = conv_ntiles(0, 1), nb = na + conv_ntiles(1, 1);
        for (int t = blockIdx.x; t < nb; t += gridDim.x) { if (t < na) conv_job(p, 0, 1, t, (float*)shm); else conv_job(p, 1, 1, t - na, (float*)shm); } }
    if (layer == 1 && which == 0) { const int na = conv_ntiles(2, 1), nb = na + conv_ntiles(3, 1);
        for (int t = blockIdx.x; t < nb; t += gridDim.x) { if (t < na) conv_job(p, 2, 1, t, (float*)shm); else conv_job(p, 3, 1, t - na, (float*)shm); } }
}

DEV void sconv8(const u16* prow, bool hm, bool hp, const float* sw, const float* sb, int ch, float* o) {
    float c[8], m[8], q[8];
    unpack8(*(const u32x4*)(prow + ch), c);
    if (hm) unpack8(*(const u32x4*)(prow - LDP0 + ch), m); else { for (int i = 0; i < 8; ++i) m[i] = 0.f; }
    if (hp) unpack8(*(const u32x4*)(prow + LDP0 + ch), q); else { for (int i = 0; i < 8; ++i) q[i] = 0.f; }
#pragma unroll
    for (int i = 0; i < 8; ++i) o[i] = m[i] * sw[ch + i] + c[i] * sw[3072 + ch + i] + q[i] * sw[6144 + ch + i] + sb[ch + i];
}
DEV void hy_pre_tile(const Params& p, int tile, float* T) {
    const int tid = tidx(); const int tok0 = (tile >> 4) << 6, c0 = (tile & 15) << 6;
    const u16* P = (const u16*)(p.ws + OFF_P); u16* uT = (u16*)(p.ws + OFF_UT);
    { const int tk = tid >> 3, c8 = (tid & 7) << 3; const int tok = tok0 + tk; int t, L; tok_tl(tok, t, L);
        const u16* prow = P + (size_t)tok * LDP0; float x1[8], vv[8];
        sconv8(prow, t > 0, t < L - 1, p.in[16], p.in[17], 1024 + c0 + c8, x1);
        sconv8(prow, t > 0, t < L - 1, p.in[16], p.in[17], 2048 + c0 + c8, vv);
#pragma unroll
        for (int i = 0; i < 8; ++i) T[tk * 65 + c8 + i] = x1[i] * vv[i]; }
    __syncthreads();
    { const int ch = tid >> 3, t8 = (tid & 7) << 3; const float* t = T + t8 * 65 + ch;
        u32x4 o; o.x = pk(t[0], t[65]); o.y = pk(t[130], t[195]); o.z = pk(t[260], t[325]); o.w = pk(t[390], t[455]);
        *(u32x4*)(uT + (size_t)(c0 + ch) * NTOK + tok0 + t8) = o; }
    __syncthreads();
}
DEV void hy_post_tile(const Params& p, int tile, float* T) {
    const int tid = tidx(); const int tok0 = (tile >> 4) << 6, c0 = (tile & 15) << 6;
    const u16* P = (const u16*)(p.ws + OFF_P); const u16* uT = (const u16*)(p.ws + OFF_UT); u16* ycat = (u16*)(p.ws + OFF_A);
    { const int ch = tid >> 3, t8 = (tid & 7) << 3; float y[8]; unpack8(*(const u32x4*)(uT + (size_t)(c0 + ch) * NTOK + tok0 + t8), y);
#pragma unroll
        for (int i = 0; i < 8; ++i) T[(t8 + i) * 65 + ch] = y[i]; }
    __syncthreads();
    { const int tk = tid >> 3, c8 = (tid & 7) << 3; const int tok = tok0 + tk; int t, L; tok_tl(tok, t, L);
        const u16* prow = P + (size_t)tok * LDP0; float x0[8], x1[8], vv[8], o[8];
        sconv8(prow, t > 0, t < L - 1, p.in[16], p.in[17], c0 + c8, x0);
        sconv8(prow, t > 0, t < L - 1, p.in[16], p.in[17], 1024 + c0 + c8, x1);
        sconv8(prow, t > 0, t < L - 1, p.in[16], p.in[17], 2048 + c0 + c8, vv);
        const float* nrm = (const float*)(p.ws + OFF_SMALL + 491520) + (tok < NTP ? 1024 : 0);
#pragma unroll
        for (int i = 0; i < 8; ++i) { const int c = c0 + c8 + i; o[i] = x0[i] * (T[tk * 65 + c8 + i] / nrm[c] + x1[i] * vv[i] * p.in[24][c]); }
        u32x4 w; w.x = pk(o[0], o[1]); w.y = pk(o[2], o[3]); w.z = pk(o[4], o[5]); w.w = pk(o[6], o[7]);
        *(u32x4*)(ycat + (size_t)tok * DM + c0 + c8) = w; }
    __syncthreads();
}
DEV void hyconv_task(const Params& p, int task, unsigned char* shm) {
    const int tid = tidx(), wid = tid >> 6, lane = tid & 63;
    const bool sample = task < 1024; const int c = sample ? task : task - 1024;
    const int L = sample ? 4096 : 256, NB = sample ? 4 : 32, lgNB = sample ? 2 : 5, LP = L + 8;
    u16* uL = (u16*)shm; u16* gL = uL + NB * LP;
    const u16* G = sample ? (const u16*)(p.ws + OFF_GS) + (size_t)c * 8192 : (const u16*)(p.ws + OFF_GP) + (size_t)c * 512;
    u16* uT = (u16*)(p.ws + OFF_UT) + (size_t)c * NTOK + (sample ? NTP : 0);
    for (int i = tid * 8; i < NB * L; i += 4096) { const int b = i / L, s = i % L; *(u32x4*)(uL + b * LP + s) = *(const u32x4*)(uT + i); }
    for (int i = tid * 8; i < 2 * L; i += 4096) *(u32x4*)(gL + i) = *(const u32x4*)(G + i);
    __syncthreads();
    const int ntile = (NB * (L >> 5)) >> 5;
    const int r = lane & 31, half = lane >> 5;
    for (int ct = wid; ct < ntile; ct += 8) {
        const int col = ct * 32 + r; const int b = col & (NB - 1), i = col >> lgNB; const int t0 = i * 32;
        const int i_lo = (ct * 32) >> lgNB, i_hi = (ct * 32 + 31) >> lgNB;
        const int d_lo = 32 * i_lo - (L - 16), d_hi = 32 * i_hi;
        f32x16 acc;
#pragma unroll
        for (int j = 0; j < 16; ++j) acc[j] = 0.f;
        const u16* ub = uL + b * LP + 8 * half;
        for (int dl = d_lo; dl <= d_hi; dl += 16) {
            const u16* gq = gL + (L - dl - r + 8 * half);
            bf16x8 a;
#pragma unroll
            for (int j = 0; j < 8; ++j) a[j] = (short)gq[j];
            const int s0 = t0 - dl;
            bf16x8 bv = (bf16x8){0, 0, 0, 0, 0, 0, 0, 0};
            if (s0 >= 0 && s0 <= L - 16) bv = *(const bf16x8*)(ub + s0);
            acc = __builtin_amdgcn_mfma_f32_32x32x16_bf16(a, bv, acc, 0, 0, 0);
        }
#pragma unroll
        for (int g = 0; g < 4; ++g) { u32x2 w; w.x = pk(acc[4 * g], acc[4 * g + 1]); w.y = pk(acc[4 * g + 2], acc[4 * g + 3]);
            *(u32x2*)(uT + (size_t)b * L + t0 + 8 * g + 4 * half) = w; }
    }
    __syncthreads();
}

DEV void rwkv_lora_tile(const Params& p, int tile, float* sm) {
    const int tid = tidx(); const int tok0 = tile * 32;
    const u16* P = (const u16*)(p.ws + OFF_P); u16* RW = (u16*)(p.ws + OFF_RW);
    for (int i = tid; i < 32 * 256; i += 512) { const int tk = i >> 8, cc = i & 255; const int tok = tok0 + tk; int t, L; tok_tl(tok, t, L);
        const u16* pp = P + (size_t)tok * LDP0 + 6144 + cc; float x = bf2f(*pp); const float xm = t > 0 ? bf2f(pp[-LDP0]) : 0.f; const float xp = t < L - 1 ? bf2f(pp[LDP0]) : 0.f;
        const float mu = p.in[25][3072 + cc]; x = x + mu * (0.5f * (xm + xp) - x); if (cc < 128) x = tanhf(x);
        sm[((cc >> 6) * 32 + tk) * 64 + (cc & 63)] = x; }
    __syncthreads();
    for (int mi = 0; mi < 4; ++mi)
        for (int hf = 0; hf < 2; ++hf) { const int n = hf * 512 + tid; const int d = mi & 1;
            const float* W = (mi < 2 ? p.in[27] : p.in[29]) + (size_t)d * 64 * 1024 + n;
            float wc[64];
#pragma unroll
            for (int r = 0; r < 64; ++r) wc[r] = W[r * 1024];
            const float bias = (mi < 2 ? p.in[26] : p.in[28])[d * 1024 + n];
            const float* inp = sm + mi * 2048;
            for (int tk = 0; tk < 32; ++tk) { float a = bias;
#pragma unroll
                for (int r = 0; r < 64; r += 4) { const float4 x = *(const float4*)(inp + tk * 64 + r); a += x.x * wc[r] + x.y * wc[r + 1] + x.z * wc[r + 2] + x.w * wc[r + 3]; }
                const float sg = sigm(a); const float o = mi < 2 ? 0.6065306597f * sg : sg;
                RW[(size_t)(tok0 + tk) * 4096 + mi * 1024 + n] = f2bf(o); } }
    __syncthreads();
}
DEV float mixf(float c, float m, float q, float mu) { return c + mu * (0.5f * (m + q) - c); }
DEV void rwkv_scan_task(const Params& p, int task, float* sm) {
    const bool sample = task < 128; const int tt_ = sample ? task : task - 128;
    const int b = tt_ >> 5, h = (tt_ >> 1) & 15, dir = tt_ & 1;
    const int L = sample ? 4096 : 256; const int tok0 = sample ? NTP + b * 4096 : b * 256;
    const int tid = tidx(), wid = tid >> 6, lane = tid & 63;
    const int row = wid * 8 + (lane >> 3), kl = lane & 7;
    float S[8];
    const size_t soff = ((((size_t)b * 2 + dir) * 16 + h) * 64 + row) * 64 + kl * 8;
    if (sample) { const float4 a = *(const float4*)(p.in[2] + soff), c = *(const float4*)(p.in[2] + soff + 4);
        S[0] = a.x; S[1] = a.y; S[2] = a.z; S[3] = a.w; S[4] = c.x; S[5] = c.y; S[6] = c.z; S[7] = c.w; }
    else {
#pragma unroll
        for (int i = 0; i < 8; ++i) S[i] = 0.f; }
    float* vec = sm; float* vvs = sm + 10240; float* yb = vvs + 2048;
    const int ptt = tid >> 4, pk4 = (tid & 15) * 4; const int ch = h * 64 + pk4;
    const float4 mur = *(const float4*)(p.in[25] + ch), muk = *(const float4*)(p.in[25] + 1024 + ch), muv = *(const float4*)(p.in[25] + 2048 + ch);
    const float4 kkw = *(const float4*)(p.in[31] + ch), kaw = *(const float4*)(p.in[32] + ch);
    const float murA[4] = {mur.x, mur.y, mur.z, mur.w}, mukA[4] = {muk.x, muk.y, muk.z, muk.w}, muvA[4] = {muv.x, muv.y, muv.z, muv.w};
    const float kkwA[4] = {kkw.x, kkw.y, kkw.z, kkw.w}, kawA[4] = {kaw.x, kaw.y, kaw.z, kaw.w};
    const u16* P = (const u16*)(p.ws + OFF_P); const u16* RW = (const u16*)(p.ws + OFF_RW);
    u16* Y = (u16*)(p.out + OUT_GLAST) + (dir ? (size_t)NTOK * 1024 : 0);
    for (int c0 = 0; c0 < L; c0 += 32) {
        { const int t = dir ? (L - 1 - (c0 + ptt)) : (c0 + ptt); const size_t tok = (size_t)tok0 + t;
            const u16* pr = P + tok * LDP0 + 3072 + ch;
            float rc[4], kc[4], vc[4], rm[4], km[4], vm[4], rp[4], kp[4], vp[4], ee[4], aa[4];
            unpack4(*(const u32x2*)(pr), rc); unpack4(*(const u32x2*)(pr + 1024), kc); unpack4(*(const u32x2*)(pr + 2048), vc);
            if (t > 0) { unpack4(*(const u32x2*)(pr - LDP0), rm); unpack4(*(const u32x2*)(pr - LDP0 + 1024), km); unpack4(*(const u32x2*)(pr - LDP0 + 2048), vm); }
            else { for (int i = 0; i < 4; ++i) { rm[i] = 0.f; km[i] = 0.f; vm[i] = 0.f; } }
            if (t < L - 1) { unpack4(*(const u32x2*)(pr + LDP0), rp); unpack4(*(const u32x2*)(pr + LDP0 + 1024), kp); unpack4(*(const u32x2*)(pr + LDP0 + 2048), vp); }
            else { for (int i = 0; i < 4; ++i) { rp[i] = 0.f; kp[i] = 0.f; vp[i] = 0.f; } }
            unpack4(*(const u32x2*)(RW + tok * 4096 + dir * 1024 + ch), ee); unpack4(*(const u32x2*)(RW + tok * 4096 + (2 + dir) * 1024 + ch), aa);
            float r4[4], k4[4], v4[4], kr[4]; float ss = 0.f;
#pragma unroll
            for (int i = 0; i < 4; ++i) { r4[i] = mixf(rc[i], rm[i], rp[i], murA[i]); k4[i] = mixf(kc[i], km[i], kp[i], mukA[i]); v4[i] = mixf(vc[i], vm[i], vp[i], muvA[i]);
                kr[i] = k4[i] * kkwA[i]; ss += kr[i] * kr[i]; }
            ss = sum16(ss); const float inv = rsqrtf(ss + 1e-12f);
            float4 okk, ow, okka, okd, orr, ov;
            float tkk[4], tw[4], tkka[4], tkd[4];
#pragma unroll
            for (int i = 0; i < 4; ++i) { tkk[i] = kr[i] * inv; tw[i] = __expf(-ee[i]); tkka[i] = tkk[i] * aa[i]; tkd[i] = k4[i] * (1.f + (aa[i] - 1.f) * kawA[i]); }
            okk = make_float4(tkk[0], tkk[1], tkk[2], tkk[3]); ow = make_float4(tw[0], tw[1], tw[2], tw[3]); okka = make_float4(tkka[0], tkka[1], tkka[2], tkka[3]);
            okd = make_float4(tkd[0], tkd[1], tkd[2], tkd[3]); orr = make_float4(r4[0], r4[1], r4[2], r4[3]); ov = make_float4(v4[0], v4[1], v4[2], v4[3]);
            float* vj = vec + ptt * 320 + pk4;
            *(float4*)(vj) = okk; *(float4*)(vj + 64) = ow; *(float4*)(vj + 128) = okka; *(float4*)(vj + 192) = okd; *(float4*)(vj + 256) = orr;
            *(float4*)(vvs + ptt * 64 + pk4) = ov; }
        __syncthreads();
        for (int j = 0; j < 32; ++j) {
            const float* vj = vec + j * 320 + kl * 8;
            const float4 a0 = *(const float4*)(vj), a1 = *(const float4*)(vj + 4);
            const float4 w0 = *(const float4*)(vj + 64), w1 = *(const float4*)(vj + 68);
            const float4 b0 = *(const float4*)(vj + 128), b1 = *(const float4*)(vj + 132);
            const float4 d0 = *(const float4*)(vj + 192), d1 = *(const float4*)(vj + 196);
            const float4 r0 = *(const float4*)(vj + 256), r1 = *(const float4*)(vj + 260);
            const float vr = vvs[j * 64 + row];
            float sa = S[0] * a0.x + S[1] * a0.y + S[2] * a0.z + S[3] * a0.w + S[4] * a1.x + S[5] * a1.y + S[6] * a1.z + S[7] * a1.w;
            sa = -sum8(sa);
            S[0] = S[0] * w0.x + sa * b0.x + vr * d0.x; S[1] = S[1] * w0.y + sa * b0.y + vr * d0.y; S[2] = S[2] * w0.z + sa * b0.z + vr * d0.z; S[3] = S[3] * w0.w + sa * b0.w + vr * d0.w;
            S[4] = S[4] * w1.x + sa * b1.x + vr * d1.x; S[5] = S[5] * w1.y + sa * b1.y + vr * d1.y; S[6] = S[6] * w1.z + sa * b1.z + vr * d1.z; S[7] = S[7] * w1.w + sa * b1.w + vr * d1.w;
            float y = S[0] * r0.x + S[1] * r0.y + S[2] * r0.z + S[3] * r0.w + S[4] * r1.x + S[5] * r1.y + S[6] * r1.z + S[7] * r1.w;
            y = sum8(y);
            if (kl == 0) yb[j * 64 + row] = y;
        }
        __syncthreads();
        { const int t = dir ? (L - 1 - (c0 + ptt)) : (c0 + ptt);
            const float4 yv = *(const float4*)(yb + ptt * 64 + pk4); u32x2 w; w.x = pk(yv.x, yv.y); w.y = pk(yv.z, yv.w);
            *(u32x2*)(Y + ((size_t)tok0 + t) * 1024 + ch) = w; }
    }
    if (!sample) { float* so = p.out + OUT_RWST + soff;
        *(float4*)(so) = make_float4(S[0], S[1], S[2], S[3]); *(float4*)(so + 4) = make_float4(S[4], S[5], S[6], S[7]); }
    __syncthreads();
}
DEV void rwkv_post_tile(const Params& p, int tile, float* sm) {
    const int tid = tidx(); const int tok0 = tile * 16;
    const u16* P = (const u16*)(p.ws + OFF_P); const u16* RW = (const u16*)(p.ws + OFF_RW); u16* ycat = (u16*)(p.ws + OFF_A);
    const u16* YF = (const u16*)(p.out + OUT_GLAST); const u16* YB = YF + (size_t)NTOK * 1024;
    for (int i = tid; i < 16 * 128; i += 512) { const int tk = i >> 7, r = i & 127; const int tok = tok0 + tk; int t, L; tok_tl(tok, t, L);
        const u16* pp = P + (size_t)tok * LDP0 + 6400 + r; const float x = bf2f(*pp); const float xm = t > 0 ? bf2f(pp[-LDP0]) : 0.f; const float xp = t < L - 1 ? bf2f(pp[LDP0]) : 0.f;
        sm[i] = sigm(mixf(x, xm, xp, p.in[25][3328 + r])); }
    __syncthreads();
    float g0[16], g1[16];
#pragma unroll
    for (int k = 0; k < 16; ++k) { g0[k] = 0.f; g1[k] = 0.f; }
    const float* g2 = p.in[30];
    for (int r = 0; r < 128; r += 4) {
        float wa[4], wb[4];
#pragma unroll
        for (int q = 0; q < 4; ++q) { wa[q] = g2[(r + q) * 1024 + tid]; wb[q] = g2[(r + q) * 1024 + 512 + tid]; }
#pragma unroll
        for (int k = 0; k < 16; ++k) { const float4 s = *(const float4*)(sm + k * 128 + r);
            g0[k] += s.x * wa[0] + s.y * wa[1] + s.z * wa[2] + s.w * wa[3]; g1[k] += s.x * wb[0] + s.y * wb[1] + s.z * wb[2] + s.w * wb[3]; } }
#pragma unroll
    for (int q = 0; q < 2; ++q) { const int n = q * 512 + tid;
        const float mur = p.in[25][n], muk = p.in[25][1024 + n], muv = p.in[25][2048 + n];
        const float ka = p.in[32][n], rk = p.in[33][n], lw = p.in[34][n], lb = p.in[35][n];
#pragma unroll
        for (int k = 0; k < 16; ++k) { const int tok = tok0 + k; int t, L; tok_tl(tok, t, L);
            const u16* pr = P + (size_t)tok * LDP0 + 3072 + n;
            const bool hm = t > 0, hp = t < L - 1;
            const float r_ = mixf(bf2f(pr[0]), hm ? bf2f(pr[-LDP0]) : 0.f, hp ? bf2f(pr[LDP0]) : 0.f, mur);
            const float k_ = mixf(bf2f(pr[1024]), hm ? bf2f(pr[1024 - LDP0]) : 0.f, hp ? bf2f(pr[1024 + LDP0]) : 0.f, muk);
            const float v_ = mixf(bf2f(pr[2048]), hm ? bf2f(pr[2048 - LDP0]) : 0.f, hp ? bf2f(pr[2048 + LDP0]) : 0.f, muv);
            const float a0 = bf2f(RW[(size_t)tok * 4096 + 2048 + n]), a1 = bf2f(RW[(size_t)tok * 4096 + 3072 + n]);
            const float kd = k_ * (2.f + (a0 + a1 - 2.f) * ka);
            const float bonus = wave_sum(r_ * kd * rk);
            const float y = bf2f(YF[(size_t)tok * 1024 + n]) + bf2f(YB[(size_t)tok * 1024 + n]);
            const float mean = wave_sum(y) * (1.f / 64.f); const float dy = y - mean; const float var = wave_sum(dy * dy) * (1.f / 64.f);
            const float yn = dy * rsqrtf(var + 64e-5f) * lw + lb;
            const float gg = q ? g1[k] : g0[k];
            ycat[(size_t)tok * DM + 1024 + n] = f2bf((yn + bonus * v_) * gg); } }
    __syncthreads();
}

DEV float logsig(float x) { return fminf(x, 0.f) - log1pf(__expf(-fabsf(x))); }
DEV f32x4 mfma16(bf16x8 a, bf16x8 b, f32x4 c) { return __builtin_amdgcn_mfma_f32_16x16x32_bf16(a, b, c, 0, 0, 0); }
DEV void gla_intra_task(const Params& p, int task, unsigned char* shm) {
    const int tid = tidx(), wid = tid >> 6, lane = tid & 63, l15 = lane & 15, quad = lane >> 4;
    const int cidx = task >> 2, h = task & 3; const int tok0 = cidx * 64;
    u16* P = (u16*)(p.ws + OFF_P); u16* QB = (u16*)(p.ws + OFF_A); float* Dbuf = (float*)(p.ws + OFF_DB);
    u16* qi = (u16*)shm; u16* ki = qi + 64 * 264; u16* vl = (u16*)shm; u16* Pl = (u16*)(shm + 67584); float* gl = (float*)(shm + 76800); float* tot = (float*)(shm + 84992);
    for (int i = tid; i < 2048; i += 512) { const int tl = i >> 5, c = i & 31; gl[i] = bf2f(P[(size_t)(tok0 + tl) * LDP1 + 6144 + c]); }
    __syncthreads();
    const int k = tid & 255, jh = tid >> 8;
#pragma unroll 1
    for (int dd = 0; dd < 2; ++dd) { const int dir = 1 - dd;
        float g2r[16];
#pragma unroll
        for (int r = 0; r < 16; ++r) g2r[r] = p.in[38][(size_t)(dir * 16 + r) * 1024 + h * 256 + k];
        const float gb = p.in[39][dir * 1024 + h * 256 + k];
        float bl[32]; float run = 0.f;
#pragma unroll
        for (int jj = 0; jj < 32; ++jj) { const int j = jh * 32 + jj; const int tl = dir ? 63 - j : j; const float* gr = gl + tl * 32 + dir * 16;
            float x = gb;
#pragma unroll
            for (int r = 0; r < 16; r += 4) { const float4 g4 = *(const float4*)(gr + r); x += g4.x * g2r[r] + g4.y * g2r[r + 1] + g4.z * g2r[r + 2] + g4.w * g2r[r + 3]; }
            run += logsig(x) * 0.0625f; bl[jj] = run; }
        tot[jh * 256 + k] = run;
        __syncthreads();
        const float t0v = tot[k], t1v = tot[256 + k]; const float off = jh ? t0v : 0.f; const float bref = t0v, blast = t0v + t1v;
        if (jh == 0) Dbuf[((size_t)cidx * 2 + dir) * 1024 + h * 256 + k] = __expf(blast);
        u16* qdst; u16* kdst; size_t ldd;
        if (dir == 0) { qdst = P + h * 256 + k; kdst = P + 1024 + h * 256 + k; ldd = LDP1; } else { qdst = QB + h * 256 + k; kdst = QB + 1024 + h * 256 + k; ldd = 2048; }
#pragma unroll
        for (int jj = 0; jj < 32; ++jj) { const int j = jh * 32 + jj; const int tl = dir ? 63 - j : j; const size_t tok = (size_t)tok0 + tl;
            const float qv = bf2f(P[tok * LDP1 + h * 256 + k]) * 0.0625f, kv = bf2f(P[tok * LDP1 + 1024 + h * 256 + k]);
            const float b = bl[jj] + off;
            qi[j * 264 + k] = f2bf(qv * __expf(b - bref)); ki[j * 264 + k] = f2bf(kv * __expf(bref - b));
            qdst[tok * ldd] = f2bf(qv * __expf(b)); kdst[tok * ldd] = f2bf(kv * __expf(blast - b)); }
        __syncthreads();
        { const int tt = wid >> 1;
#pragma unroll
            for (int q2 = 0; q2 < 2; ++q2) { const int st = (wid & 1) * 2 + q2; f32x4 acc = (f32x4){0.f, 0.f, 0.f, 0.f};
                if (st <= tt) {
#pragma unroll
                    for (int ks = 0; ks < 8; ++ks) { const bf16x8 a = *(const bf16x8*)(qi + (tt * 16 + l15) * 264 + ks * 32 + quad * 8); const bf16x8 b = *(const bf16x8*)(ki + (st * 16 + l15) * 264 + ks * 32 + quad * 8);
                        acc = mfma16(a, b, acc); } }
#pragma unroll
                for (int r = 0; r < 4; ++r) { const int t = tt * 16 + quad * 4 + r, s_ = st * 16 + l15; Pl[t * 72 + s_] = f2bf(s_ <= t ? acc[r] : 0.f); } } }
        __syncthreads();
#pragma unroll
        for (int i = 0; i < 8; ++i) { const int piece = tid + 512 * i; const int j = piece >> 6, c8 = (piece & 63) * 8; const int tl = dir ? 63 - j : j;
            *(u32x4*)(vl + j * 520 + c8) = *(const u32x4*)(P + (size_t)(tok0 + tl) * LDP1 + 2048 + h * 512 + c8); }
        __syncthreads();
        u16* O = (u16*)(p.ws + (dir ? OFF_OB : OFF_OF)) + h * 512;
#pragma unroll 1
        for (int q4 = 0; q4 < 4; ++q4) { const int vt = wid * 4 + q4; f32x4 acc[4];
#pragma unroll
            for (int tt = 0; tt < 4; ++tt) acc[tt] = (f32x4){0.f, 0.f, 0.f, 0.f};
#pragma unroll
            for (int ss = 0; ss < 2; ++ss) { bf16x8 bfr;
#pragma unroll
                for (int jj = 0; jj < 8; ++jj) bfr[jj] = (short)vl[(ss * 32 + quad * 8 + jj) * 520 + vt * 16 + l15];
#pragma unroll
                for (int tt = 0; tt < 4; ++tt) { if (ss * 32 <= tt * 16 + 15) { const bf16x8 a = *(const bf16x8*)(Pl + (tt * 16 + l15) * 72 + ss * 32 + quad * 8); acc[tt] = mfma16(a, bfr, acc[tt]); } } }
#pragma unroll
            for (int tt = 0; tt < 4; ++tt)
#pragma unroll
                for (int r = 0; r < 4; ++r) { const int t = tt * 16 + quad * 4 + r; const int tl = dir ? 63 - t : t; O[(size_t)(tok0 + tl) * DM + vt * 16 + l15] = f2bf(acc[tt][r]); } }
        __syncthreads();
    }
}
DEV void gla_inter_task(const Params& p, int task, unsigned char* shm) {
    const bool sample = task < 256; const int tt_ = sample ? task : task - 256;
    const int seq = tt_ >> 3, vs = tt_ & 7; const int b = seq >> 3, h = (seq >> 1) & 3, dir = seq & 1;
    const int L = sample ? 4096 : 256; const int tok0 = sample ? NTP + b * 4096 : b * 256;
    const int nch = L >> 6, cbase = tok0 >> 6;
    const int tid = tidx(), wid = tid >> 6, lane = tid & 63, l15 = lane & 15, quad = lane >> 4;
    const u16* P = (const u16*)(p.ws + OFF_P); const u16* QB = (const u16*)(p.ws + OFF_A); const float* Dbuf = (const float*)(p.ws + OFF_DB);
    u16* ST = (u16*)shm; u16* qdl = (u16*)(shm + 33792); u16* kdl = (u16*)(shm + 67584); u16* vl = (u16*)(shm + 101376); float* dl = (float*)(shm + 110592);
    f32x4 S[2][4];
    const size_t sbase = (((size_t)b * 2 + dir) * 4 + h) * 256 * 512 + vs * 64;
#pragma unroll
    for (int kt = 0; kt < 2; ++kt)
#pragma unroll
        for (int vt = 0; vt < 4; ++vt)
#pragma unroll
            for (int r = 0; r < 4; ++r) { const int kk = wid * 32 + kt * 16 + quad * 4 + r; S[kt][vt][r] = sample ? p.in[3][sbase + (size_t)kk * 512 + vt * 16 + l15] : 0.f; }
    const u16* qsrc; const u16* ksrc; size_t lds_;
    if (dir == 0) { qsrc = P + h * 256; ksrc = P + 1024 + h * 256; lds_ = LDP1; } else { qsrc = QB + h * 256; ksrc = QB + 1024 + h * 256; lds_ = 2048; }
    const u16* vsrc = P + 2048 + h * 512 + vs * 64;
    u16* O = (u16*)(p.ws + (dir ? OFF_OB : OFF_OF)) + h * 512 + vs * 64;
    u32x4 rq[4], rk[4], rv; float rd = 0.f;
    const int vrow = tid >> 3, vc8 = (tid & 7) * 8;
#define GLA_ISSUE(n_) do { const int cidx_ = cbase + (dir ? nch - 1 - (n_) : (n_)); \
        _Pragma("unroll") for (int i = 0; i < 4; ++i) { const int piece = tid + 512 * i; const int j = piece >> 5, c8 = (piece & 31) * 8; const size_t tok = (size_t)cidx_ * 64 + (dir ? 63 - j : j); \
            rq[i] = *(const u32x4*)(qsrc + tok * lds_ + c8); rk[i] = *(const u32x4*)(ksrc + tok * lds_ + c8); } \
        { const size_t tok = (size_t)cidx_ * 64 + (dir ? 63 - vrow : vrow); rv = *(const u32x4*)(vsrc + tok * LDP1 + vc8); } \
        if (tid < 256) rd = Dbuf[((size_t)cidx_ * 2 + dir) * 1024 + h * 256 + tid]; } while (0)
#define GLA_WRITE_ST() do { _Pragma("unroll") for (int kt = 0; kt < 2; ++kt) _Pragma("unroll") for (int vt = 0; vt < 4; ++vt) { u32x2 w; w.x = pk(S[kt][vt][0], S[kt][vt][1]); w.y = pk(S[kt][vt][2], S[kt][vt][3]); \
            *(u32x2*)(ST + (vt * 16 + l15) * 264 + wid * 32 + kt * 16 + quad * 4) = w; } } while (0)
    GLA_WRITE_ST();
    GLA_ISSUE(0);
    const int tt = wid >> 1, vb = (wid & 1) * 2;
#pragma unroll 1
    for (int n = 0; n < nch; ++n) {
        const int cidx = cbase + (dir ? nch - 1 - n : n);
#pragma unroll
        for (int i = 0; i < 4; ++i) { const int piece = tid + 512 * i; const int j = piece >> 5, c8 = (piece & 31) * 8; *(u32x4*)(qdl + j * 264 + c8) = rq[i]; *(u32x4*)(kdl + j * 264 + c8) = rk[i]; }
        *(u32x4*)(vl + vrow * 72 + vc8) = rv; if (tid < 256) dl[tid] = rd;
        __syncthreads();
        if (n + 1 < nch) GLA_ISSUE(n + 1);
        float oi[2][4];
#pragma unroll
        for (int q2 = 0; q2 < 2; ++q2)
#pragma unroll
            for (int r = 0; r < 4; ++r) { const int j = tt * 16 + quad * 4 + r; const size_t tok = (size_t)cidx * 64 + (dir ? 63 - j : j); oi[q2][r] = bf2f(O[tok * DM + (vb + q2) * 16 + l15]); }
        f32x4 oacc[2]; oacc[0] = (f32x4){0.f, 0.f, 0.f, 0.f}; oacc[1] = oacc[0];
#pragma unroll
        for (int ks = 0; ks < 8; ++ks) { const bf16x8 a = *(const bf16x8*)(qdl + (tt * 16 + l15) * 264 + ks * 32 + quad * 8);
#pragma unroll
            for (int q2 = 0; q2 < 2; ++q2) { const bf16x8 bfr = *(const bf16x8*)(ST + ((vb + q2) * 16 + l15) * 264 + ks * 32 + quad * 8); oacc[q2] = mfma16(a, bfr, oacc[q2]); } }
#pragma unroll
        for (int kt = 0; kt < 2; ++kt) { const f32x4 dv = *(const f32x4*)(dl + wid * 32 + kt * 16 + quad * 4);
#pragma unroll
            for (int vt = 0; vt < 4; ++vt) S[kt][vt] = S[kt][vt] * dv; }
#pragma unroll
        for (int ts = 0; ts < 2; ++ts) { bf16x8 af[2];
#pragma unroll
            for (int kt = 0; kt < 2; ++kt)
#pragma unroll
                for (int jj = 0; jj < 8; ++jj) af[kt][jj] = (short)kdl[(ts * 32 + quad * 8 + jj) * 264 + wid * 32 + kt * 16 + l15];
#pragma unroll
            for (int vt = 0; vt < 4; ++vt) { bf16x8 bfr;
#pragma unroll
                for (int jj = 0; jj < 8; ++jj) bfr[jj] = (short)vl[(ts * 32 + quad * 8 + jj) * 72 + vt * 16 + l15];
#pragma unroll
                for (int kt = 0; kt < 2; ++kt) S[kt][vt] = mfma16(af[kt], bfr, S[kt][vt]); } }
#pragma unroll
        for (int q2 = 0; q2 < 2; ++q2)
#pragma unroll
            for (int r = 0; r < 4; ++r) { const int j = tt * 16 + quad * 4 + r; const size_t tok = (size_t)cidx * 64 + (dir ? 63 - j : j); O[tok * DM + (vb + q2) * 16 + l15] = f2bf(oi[q2][r] + oacc[q2][r]); }
        __syncthreads();
        GLA_WRITE_ST();
        __syncthreads();
    }
#undef GLA_ISSUE
#undef GLA_WRITE_ST
    if (!sample) { float* so = p.out + OUT_GLAST + sbase;
#pragma unroll
        for (int kt = 0; kt < 2; ++kt)
#pragma unroll
            for (int vt = 0; vt < 4; ++vt)
#pragma unroll
                for (int r = 0; r < 4; ++r) { const int kk = wid * 32 + kt * 16 + quad * 4 + r; so[(size_t)kk * 512 + vt * 16 + l15] = S[kt][vt][r]; } }
    __syncthreads();
}
DEV void phase_gla_post(const Params& p) {
    const int tid = tidx(), wid = tid >> 6, lane = tid & 63;
    const u16* P = (const u16*)(p.ws + OFF_P); const u16* OF = (const u16*)(p.ws + OFF_OF); const u16* OB = (const u16*)(p.ws + OFF_OB); u16* ycat = (u16*)(p.ws + OFF_A);
    for (int it = blockIdx.x * 8 + wid; it < NTOK * 4; it += gridDim.x * 8) { const int tok = it >> 2, h = it & 3; const int v8 = lane * 8;
        float a[8], b[8], g[8]; unpack8(*(const u32x4*)(OF + (size_t)tok * DM + h * 512 + v8), a); unpack8(*(const u32x4*)(OB + (size_t)tok * DM + h * 512 + v8), b);
        unpack8(*(const u32x4*)(P + (size_t)tok * LDP1 + 4096 + h * 512 + v8), g);
        float ss = 0.f;
#pragma unroll
        for (int i = 0; i < 8; ++i) { a[i] += b[i]; ss += a[i] * a[i]; }
        ss = wave_sum(ss); const float sc = rsqrtf(ss * (1.f / 512.f) + 1e-6f);
        float o[8];
#pragma unroll
        for (int i = 0; i < 8; ++i) o[i] = a[i] * sc * p.in[40][v8 + i] * (g[i] * sigm(g[i]));
        u32x4 w; w.x = pk(o[0], o[1]); w.y = pk(o[2], o[3]); w.z = pk(o[4], o[5]); w.w = pk(o[6], o[7]);
        *(u32x4*)(ycat + (size_t)tok * DM + h * 512 + v8) = w; }
}

DEV void phase_ffn_gate(const Params& p, int layer) {
    u16* U = (u16*)(p.ws + OFF_U); const float* cw = p.in[11] + (size_t)layer * 9 * DFF;
    const size_t nitem = (size_t)NTOK * 704;
    for (size_t it = (size_t)blockIdx.x * 512 + tidx(); it < nitem; it += (size_t)gridDim.x * 512) {
        const int tok = (int)(it / 704), c8 = (int)(it % 704) * 8;
        float acc[8];
#pragma unroll
        for (int i = 0; i < 8; ++i) acc[i] = 0.f;
        if (tok < NTP) { const int t = tok & 255;
#pragma unroll
            for (int dj = 0; dj < 3; ++dj) { const int tn = t + dj - 1; if (tn >= 0 && tn < 256) { float g[8]; unpack8(*(const u32x4*)(U + (size_t)(tok + dj - 1) * LDU + c8), g);
                    const float* w = cw + (3 + dj) * DFF + c8;
#pragma unroll
                    for (int i = 0; i < 8; ++i) acc[i] += g[i] * w[i]; } } }
        else { const int rr = ((tok - NTP) >> 6) & 63, cc = tok & 63;
#pragma unroll
            for (int di = 0; di < 3; ++di)
#pragma unroll
                for (int dj = 0; dj < 3; ++dj) { const int r2 = rr + di - 1, c2 = cc + dj - 1;
                    if (r2 >= 0 && r2 < 64 && c2 >= 0 && c2 < 64) { float g[8]; unpack8(*(const u32x4*)(U + (size_t)(tok + (di - 1) * 64 + (dj - 1)) * LDU + c8), g);
                        const float* w = cw + (di * 3 + dj) * DFF + c8;
#pragma unroll
                        for (int i = 0; i < 8; ++i) acc[i] += g[i] * w[i]; } } }
        u16* vp = U + (size_t)tok * LDU + DFF + c8; float v[8]; unpack8(*(const u32x4*)vp, v);
#pragma unroll
        for (int i = 0; i < 8; ++i) v[i] *= acc[i] * sigm(acc[i]);
        u32x4 w; w.x = pk(v[0], v[1]); w.y = pk(v[2], v[3]); w.z = pk(v[4], v[5]); w.w = pk(v[6], v[7]);
        *(u32x4*)vp = w;
    }
}

DEV void phase_final_norm(const Params& p) {
    const int tid = tidx(), wid = tid >> 6, lane = tid & 63; const float* g = p.in[13];
    for (int row = blockIdx.x * 8 + wid; row < NTOK; row += gridDim.x * 8) {
        float4* xr = (float4*)(p.out + (size_t)row * DM);
        float4 v[8]; float ss = 0.f;
#pragma unroll
        for (int j = 0; j < 8; ++j) { v[j] = xr[lane + 64 * j]; ss += v[j].x * v[j].x + v[j].y * v[j].y + v[j].z * v[j].z + v[j].w * v[j].w; }
        ss = wave_sum(ss); const float rstd = rsqrtf(ss * (1.f / 2048.f) + 1e-6f);
#pragma unroll
        for (int j = 0; j < 8; ++j) { const float4 gg = *(const float4*)(g + (lane + 64 * j) * 4);
            xr[lane + 64 * j] = make_float4(v[j].x * rstd * gg.x, v[j].y * rstd * gg.y, v[j].z * rstd * gg.z, v[j].w * rstd * gg.w); }
    }
}

__global__ void __launch_bounds__(512, 2) mega(Params p0) {
    extern __shared__ __attribute__((aligned(16))) unsigned char shm[];
    cg::grid_group grid = cg::this_grid();
    float* sm = (float*)shm;
    const int G = (int)gridDim.x, B = (int)blockIdx.x;

#ifndef SK_PREP
    phase_prep(launder(p0), shm);
#ifdef PROBE_MISC
    __syncthreads(); phase_prep(launder(p0), shm);
#endif
#endif
    grid.sync();
    phase_reduce(launder(p0));
    grid.sync();
#pragma unroll 1
    for (int layer = 0; layer < 2; ++layer) {
#ifndef SK_NORM
        phase_norm(launder(p0), layer, 0, shm);
#ifdef PROBE_MISC
        __syncthreads(); phase_norm(launder(p0), layer, 0, shm);
#endif
#endif
        grid.sync();
        { const Params p = launder(p0); const u16* A = (const u16*)(p.ws + OFF_A); pg8::EpiBf16 E; E.O = (u16*)(p.ws + OFF_P); E.ldc = layer ? LDP1 : LDP0;
#if !defined(SK_GEMM) && !defined(SK_GBF)
            run_gemm(shm, A, DM, (const u16*)(p.ws + OFF_WIN), DM, layer ? LDP1 : LDP0, DM, E);
#ifdef PROBE_GEMM
            __syncthreads(); run_gemm(shm, A, DM, (const u16*)(p.ws + OFF_WIN), DM, layer ? LDP1 : LDP0, DM, E);
#endif
#endif
        }
        grid.sync();
        if (layer == 0) {
#ifndef SK_PRE
            { const Params p = launder(p0); for (int t = B; t < 6144 + 768; t += G) { if (t < 6144) hy_pre_tile(p, t, sm); else rwkv_lora_tile(p, t - 6144, sm); } }
#ifdef PROBE_MISC
            { const Params p = launder(p0); for (int t = B; t < 6144 + 768; t += G) { if (t < 6144) hy_pre_tile(p, t, sm); else rwkv_lora_tile(p, t - 6144, sm); } }
#endif
#endif
            grid.sync();
#ifndef SK_RSCAN
            { const Params p = launder(p0);
            if (B < 128) rwkv_scan_task(p, B, sm);
            else if (G > 128) { for (int j = B - 128; j < 1024; j += G - 128) rwkv_scan_task(p, 128 + j, sm); }
            if (G <= 128) { for (int j = B; j < 1024; j += G) rwkv_scan_task(p, 128 + j, sm); }
#ifdef PROBE_RSCAN
            if (B < 128) rwkv_scan_task(p, B, sm);
            else if (G > 128) { for (int j = B - 128; j < 1024; j += G - 128) rwkv_scan_task(p, 128 + j, sm); }
#endif
            }
#endif
#ifndef SK_HCONV
            { const Params p = launder(p0); for (int t = B; t < 2048; t += G) hyconv_task(p, t, shm); }
#endif
            grid.sync();
#ifndef SK_POST
            { const Params p = launder(p0); for (int t = B; t < 6144 + 1536; t += G) { if (t < 6144) hy_post_tile(p, t, sm); else rwkv_post_tile(p, t - 6144, sm); } }
#ifdef PROBE_MISC
            { const Params p = launder(p0); for (int t = B; t < 6144 + 1536; t += G) { if (t < 6144) hy_post_tile(p, t, sm); else rwkv_post_tile(p, t - 6144, sm); } }
#endif
#endif
            grid.sync();
        } else {
#ifndef SK_GLA
            { const Params p = launder(p0); for (int t = B; t < 1536; t += G) gla_intra_task(p, t, shm); }
            grid.sync();
            { const Params p = launder(p0); for (int t = B; t < 256 + 2048; t += G) gla_inter_task(p, t, shm); }
#endif
            grid.sync();
#ifndef SK_GLAP
            phase_gla_post(launder(p0));
#ifdef PROBE_MISC
            phase_gla_post(launder(p0));
#endif
#endif
            grid.sync();
        }
        { const Params p = launder(p0); const u16* A = (const u16*)(p.ws + OFF_A); const float* mods = (const float*)(p.ws + OFF_SMALL); pg8::EpiRes E; E.X = p.out; E.gm = mods + (size_t)layer * 5 * 12288 + 2 * 2048; E.gb = p.in[7] + layer * 12288 + 2 * 2048;
#if !defined(SK_GEMM) && !defined(SK_GRES)
            run_gemm(shm, A, DM, (const u16*)(p.ws + OFF_WOUT), DM, DM, DM, E);
#endif
        }
        grid.sync();
#ifndef SK_NORM
        phase_norm(launder(p0), layer, 1, shm);
#ifdef PROBE_MISC
        __syncthreads(); phase_norm(launder(p0), layer, 1, shm);
#endif
#endif
        grid.sync();
        { const Params p = launder(p0); const u16* A = (const u16*)(p.ws + OFF_A); pg8::EpiBf16 E; E.O = (u16*)(p.ws + OFF_U); E.ldc = LDU;
#if !defined(SK_GEMM) && !defined(SK_GBF)
            run_gemm(shm, A, DM, (const u16*)(p.ws + OFF_WUP), DM, LDU, DM, E);
#ifdef PROBE_GEMM
            __syncthreads(); run_gemm(shm, A, DM, (const u16*)(p.ws + OFF_WUP), DM, LDU, DM, E);
#endif
#endif
        }
        grid.sync();
#ifndef SK_GATE
        phase_ffn_gate(launder(p0), layer);
#endif
        grid.sync();
        { const Params p = launder(p0); const float* mods = (const float*)(p.ws + OFF_SMALL); pg8::EpiRes E; E.X = p.out; E.gm = mods + (size_t)layer * 5 * 12288 + 5 * 2048; E.gb = p.in[7] + layer * 12288 + 5 * 2048;
#if !defined(SK_GEMM) && !defined(SK_GRES)
            run_gemm(shm, (const u16*)(p.ws + OFF_U) + DFF, LDU, (const u16*)(p.ws + OFF_WDN), DFF, DM, DFF, E);
#endif
        }
        grid.sync();
    }
    phase_final_norm(launder(p0));
}

extern "C" void kernel_launch(void* const* d_in, const int* in_sizes, int n_in, void* d_out, int out_size, void* d_ws, size_t ws_size, hipStream_t stream) {
    constexpr size_t kDynLds = 131072;
    static int grid_blocks = 0;
    if (!grid_blocks) {
        int dev = 0, cus = 0, per_cu = 0;
        hipGetDevice(&dev);
        hipDeviceGetAttribute(&cus, hipDeviceAttributeMultiprocessorCount, dev);
        hipFuncSetAttribute((const void*)mega, hipFuncAttributeMaxDynamicSharedMemorySize, (int)kDynLds);
        hipOccupancyMaxActiveBlocksPerMultiprocessor(&per_cu, mega, 512, kDynLds);
        if (per_cu < 1) per_cu = 1;
        grid_blocks = cus * per_cu;
        if (grid_blocks > 256) grid_blocks = 256;
    }
    if (ws_size < WS_NEED || n_in < 41) { fprintf(stderr, "workspace too small: %zu < %zu\n", ws_size, WS_NEED); return; }
    Params p{};
    for (int i = 0; i < 41; ++i) p.in[i] = (const float*)d_in[i];
    p.out = (float*)d_out; p.ws = (unsigned char*)d_ws;
    void* args[] = {&p};
    hipError_t e = hipLaunchCooperativeKernel((const void*)mega, dim3(grid_blocks), dim3(512), args, kDynLds, stream);
    if (e != hipSuccess) fprintf(stderr, "cooperative launch failed: %s (grid %d)\n", hipGetErrorString(e), grid_blocks);
}
```

```cpp
#include <hip/hip_runtime.h>
#include <hip/hip_cooperative_groups.h>
#include <cstdio>
namespace cg = cooperative_groups;

#define DEV __device__ __forceinline__
#define LAS __attribute__((address_space(3)))
typedef unsigned short u16;
typedef short bf16x8 __attribute__((ext_vector_type(8)));
typedef float f32x4 __attribute__((ext_vector_type(4)));
typedef float f32x16 __attribute__((ext_vector_type(16)));
typedef unsigned u32x2 __attribute__((ext_vector_type(2)));
typedef unsigned u32x4 __attribute__((ext_vector_type(4)));

constexpr int NTOK = 24576, NTP = 8192, DM = 2048;
constexpr int LDP0 = 6656, LDP1 = 6400, LDU = 11264, DFF = 5632;
constexpr size_t OFF_WIN = 0, OFF_WOUT = 27262976, OFF_WUP = 35651584, OFF_WDN = OFF_WUP + 46137344;
constexpr size_t OFF_A = 104857600, OFF_BIG = 205520896;
constexpr size_t OFF_P = OFF_BIG, OFF_RW = OFF_BIG + 327155712, OFF_UT = OFF_RW + 201326592, OFF_GS = OFF_UT + 50331648, OFF_GP = OFF_GS + 16777216;
constexpr size_t OFF_U = OFF_BIG, OFF_OF = OFF_BIG + 314572800, OFF_OB = OFF_OF + 100663296, OFF_DB = OFF_OB + 100663296;
constexpr size_t OFF_SMALL = OFF_BIG + 600000000, SMALL_BYTES = 491520 + 8192;
constexpr size_t XCD_BAR_BYTES = 3456 * 4;
constexpr size_t WS_NEED = OFF_SMALL + SMALL_BYTES + 256 + XCD_BAR_BYTES;
constexpr size_t OUT_RWST = 50331648, OUT_GLAST = 54525952;

struct Params {
    const float* in[41];
    float* out;
    unsigned char* ws;
};

DEV int tidx() { int t = threadIdx.x; asm volatile("" : "+v"(t)); return t; }
DEV Params launder(const Params& p) { Params q = p; asm volatile("" : "+s"(q.ws), "+s"(q.out)); return q; }
DEV float bf2f(unsigned b) { return __uint_as_float(b << 16); }
DEV float bflo(unsigned w) { return __uint_as_float(w << 16); }
DEV float bfhi(unsigned w) { return __uint_as_float(w & 0xffff0000u); }
DEV unsigned pk(float lo, float hi) { unsigned r; asm("v_cvt_pk_bf16_f32 %0, %1, %2" : "=v"(r) : "v"(lo), "v"(hi)); return r; }
DEV u16 f2bf(float f) { return (u16)(pk(f, 0.f) & 0xffffu); }
DEV float wave_sum(float v) {
#pragma unroll
    for (int o = 32; o > 0; o >>= 1) v += __shfl_xor(v, o);
    return v;
}
template <int CTRL> DEV float dppf(float x) { return __builtin_bit_cast(float, __builtin_amdgcn_update_dpp(0, __builtin_bit_cast(int, x), CTRL, 0xf, 0xf, true)); }
DEV float sum8(float v) { v += dppf<0xB1>(v); v += dppf<0x4E>(v); v += dppf<0x141>(v); return v; }
DEV float sum16(float v) { v = sum8(v); v += dppf<0x140>(v); return v; }
DEV float sigm(float x) { return 1.f / (1.f + __expf(-x)); }
DEV int tok_cond(int tok) { return tok < NTP ? 4 : ((tok - NTP) >> 12); }
DEV void tok_tl(int tok, int& t, int& L) { if (tok < NTP) { t = tok & 255; L = 256; } else { t = (tok - NTP) & 4095; L = 4096; } }
DEV void unpack8(u32x4 w, float* o) { o[0] = bflo(w.x); o[1] = bfhi(w.x); o[2] = bflo(w.y); o[3] = bfhi(w.y); o[4] = bflo(w.z); o[5] = bfhi(w.z); o[6] = bflo(w.w); o[7] = bfhi(w.w); }
DEV void unpack4(u32x2 w, float* o) { o[0] = bflo(w.x); o[1] = bfhi(w.x); o[2] = bflo(w.y); o[3] = bfhi(w.y); }

namespace pg8 {
constexpr int BM = 256, BK = 64, HALF = 128, HTB = HALF * BK * 2, NXCD = 8, WGM = 8;
DEV int lds_byte(int r, int c) { const int st = (r >> 4) * 2 + (c >> 5), rr = r & 15, cc = c & 31, ob = rr * 64 + cc * 2; return st * 1024 + (ob ^ (((ob >> 9) & 1) << 5)); }
DEV void stage_rc(int b, int& R, int& C) { const int st = b / 1024, sb = b % 1024, swz = sb ^ (((sb >> 9) & 1) << 5); R = (st >> 1) * 16 + swz / 64; C = (st & 1) * 32 + (swz % 64) / 2; }
DEV int perm32(int rho) { const int n = rho >> 4, i = rho & 15; return 8 * (i >> 2) + 4 * n + (i & 3); }
struct Unit { int pm, pn; };
struct Gemm { const u16* A; const u16* Bt; int M, N, K, lda, ldb; };
struct StaticOrder {
    int nM, nN, nwg, G, c;
    DEV void init(int M, int N, int G_, int c_) { nM = M / BM; nN = N / BM; nwg = nM * nN; G = G_; c = c_; }
    DEV bool next(int i, Unit& u) const {
        const long L = (long)i * G + c; if (L >= nwg) return false;
        int wgid = (int)L; { const int q = nwg / NXCD, r = nwg % NXCD, xcd = wgid % NXCD, off = wgid / NXCD; wgid = (xcd < r ? xcd * (q + 1) : r * (q + 1) + (xcd - r) * q) + off; }
        const int nig = WGM * nN, gid = wgid / nig, fm = gid * WGM, gsz = (nM - fm) < WGM ? (nM - fm) : WGM;
        u.pm = fm + ((wgid % nig) % gsz); u.pn = (wgid % nig) / gsz; return true;
    }
};
struct EpiBf16 {
    static constexpr bool PERM = true;
    u16* O; int ldc;
    DEV void operator()(const f32x4 (&acc)[2][2][4][2], const Unit& u, int wr, int wc, int fr, int fq) const {
        const int row0 = u.pm * BM + wr * 64 + fr; const int col0 = u.pn * BM + wc * 32 + 8 * fq;
#pragma unroll
        for (int ai = 0; ai < 2; ++ai)
#pragma unroll
            for (int m = 0; m < 4; ++m) { u16* rowp = O + (size_t)(row0 + ai * HALF + m * 16) * ldc + col0;
#pragma unroll
                for (int bj = 0; bj < 2; ++bj) { const f32x4 v0 = acc[ai][bj][m][0], v1 = acc[ai][bj][m][1];
                    u32x4 w; w.x = pk(v0[0], v0[1]); w.y = pk(v0[2], v0[3]); w.z = pk(v1[0], v1[1]); w.w = pk(v1[2], v1[3]);
                    *(u32x4*)(rowp + bj * HALF) = w; } }
    }
};
struct EpiRes {
    static constexpr bool PERM = false;
    float* X; const float* gm; const float* gb;
    DEV void operator()(const f32x4 (&acc)[2][2][4][2], const Unit& u, int wr, int wc, int fr, int fq) const {
        const int row0 = u.pm * BM + wr * 64 + fr, col0 = u.pn * BM + wc * 32 + 4 * fq;
        const int cond = u.pm < 32 ? 4 : ((u.pm - 32) >> 4);
        const float* gmc = gm + (size_t)cond * 12288 + col0; const float* gbc = gb + col0;
#pragma unroll
        for (int ai = 0; ai < 2; ++ai)
#pragma unroll
            for (int m = 0; m < 4; ++m) { float* rowp = X + (size_t)(row0 + ai * HALF + m * 16) * DM + col0;
#pragma unroll
                for (int bj = 0; bj < 2; ++bj) {
#pragma unroll
                    for (int n = 0; n < 2; ++n) { f32x4* q = (f32x4*)(rowp + bj * HALF + n * 16);
                        const f32x4 gvv = *(const f32x4*)(gmc + bj * HALF + n * 16) + *(const f32x4*)(gbc + bj * HALF + n * 16);
                        *q = *q + gvv * acc[ai][bj][m][n]; }
                    asm volatile("" ::: "memory"); } }
    }
};

template <class Epi>
DEV void gemm_phase(LAS unsigned char* lds, const Gemm g, const StaticOrder& S, const Epi& E) {
    const int tid = tidx(), wid = __builtin_amdgcn_readfirstlane(tid >> 6), lane = tid & 63, wr = wid >> 2, wc = wid & 3, fr = lane & 15, fq = lane >> 4;
    const int K = g.K, nt = K / BK;
    unsigned voffA[2], voffB[2];
#pragma unroll
    for (int i = 0; i < 2; ++i) { int R, C; stage_rc(tid * 16 + i * 8192, R, C); const int Rb = Epi::PERM ? ((R & ~31) + perm32(R & 31)) : R;
        voffA[i] = (unsigned)(R * g.lda + C) * 2u; voffB[i] = (unsigned)(Rb * g.ldb + C) * 2u; }
    const size_t kstep = (size_t)(BK * 2);
    const size_t hstepA = (size_t)HALF * g.lda * 2, hstepB = (size_t)HALF * g.ldb * 2;
    const size_t tstepA = 2 * hstepA, tstepB = 2 * hstepB;
    const unsigned ldsw = (unsigned)wid * 1024u;
    const int aoff = lds_byte(wr * 64 + fr, fq * 8), boff = lds_byte(wc * 32 + fr, fq * 8);
#define PG8_SA(b, h) (((b) * 2 + (h)) * HTB)
#define PG8_SB(b, h) ((4 + (b) * 2 + (h)) * HTB)
#define PG8_STAGE(bufoff, gbase, voff) do { _Pragma("unroll") for (int _i = 0; _i < 2; ++_i) \
        __builtin_amdgcn_global_load_lds((const unsigned*)((const char*)(gbase) + (voff)[_i]), (LAS unsigned*)(lds + (bufoff) + ldsw + _i * 8192), 16, 0, 0); } while (0)
#define PG8_LDA(dst, b, h) do { _Pragma("unroll") for (int m = 0; m < 4; ++m) _Pragma("unroll") for (int k = 0; k < 2; ++k) dst[m][k] = *(const LAS bf16x8*)(lds + PG8_SA(b, h) + aoff + m * 2048 + k * 1024); } while (0)
#define PG8_LDB(dst, b, h) do { _Pragma("unroll") for (int n = 0; n < 2; ++n) _Pragma("unroll") for (int k = 0; k < 2; ++k) dst[n][k] = *(const LAS bf16x8*)(lds + PG8_SB(b, h) + boff + n * 2048 + k * 1024); } while (0)
#define PG8_MMA(ai, bj, At, Bt) do { __builtin_amdgcn_s_setprio(1); _Pragma("unroll") for (int m = 0; m < 4; ++m) _Pragma("unroll") for (int n = 0; n < 2; ++n) _Pragma("unroll") for (int k = 0; k < 2; ++k) \
        acc[ai][bj][m][n] = __builtin_amdgcn_mfma_f32_16x16x32_bf16(Bt[n][k], At[m][k], acc[ai][bj][m][n], 0, 0, 0); __builtin_amdgcn_s_setprio(0); } while (0)
#define PG8_WAIT_V(n) asm volatile("s_waitcnt vmcnt(" #n ")" ::: "memory")
#define PG8_WAIT_L(n) asm volatile("s_waitcnt lgkmcnt(" #n ")" ::: "memory")
#define PG8_BAR __builtin_amdgcn_s_barrier()
#define PG8_SCHED __builtin_amdgcn_sched_barrier(0)
    Unit cur, nxt; int ui = 0;
    if (!S.next(0, cur)) return;
    f32x4 acc[2][2][4][2];
#pragma unroll
    for (int a = 0; a < 2; ++a)
#pragma unroll
        for (int b = 0; b < 2; ++b)
#pragma unroll
            for (int m = 0; m < 4; ++m)
#pragma unroll
                for (int n = 0; n < 2; ++n) acc[a][b][m][n] = (f32x4){0.f, 0.f, 0.f, 0.f};
    bf16x8 At[4][2], B0[2][2], B1[2][2];
    const char* cA = (const char*)g.A + (size_t)cur.pm * tstepA; const char* cB = (const char*)g.Bt + (size_t)cur.pn * tstepB;
    PG8_STAGE(PG8_SB(0, 0), cB, voffB); PG8_STAGE(PG8_SA(0, 0), cA, voffA); PG8_STAGE(PG8_SB(0, 1), cB + hstepB, voffB); PG8_STAGE(PG8_SA(0, 1), cA + hstepA, voffA);
    if (wr == 1) PG8_BAR;
    PG8_WAIT_V(4); PG8_BAR;
    PG8_STAGE(PG8_SB(1, 0), cB + kstep, voffB); PG8_STAGE(PG8_SA(1, 0), cA + kstep, voffA); PG8_STAGE(PG8_SB(1, 1), cB + hstepB + kstep, voffB);
    PG8_WAIT_V(6); PG8_BAR;
    for (;;) {
        const bool has_next = S.next(ui + 1, nxt);
        const char* nA = has_next ? (const char*)g.A + (size_t)nxt.pm * tstepA : cA; const char* nB = has_next ? (const char*)g.Bt + (size_t)nxt.pn * tstepB : cB;
        for (int t = 0; t < nt; t += 2) {
            const bool last = (t == nt - 2);
            const char* a1 = cA + (size_t)(t + 1) * kstep;
            const char* a2 = last ? nA : cA + (size_t)(t + 2) * kstep; const char* b2 = last ? nB : cB + (size_t)(t + 2) * kstep;
            const char* a3 = a2 + kstep; const char* b3 = b2 + kstep;
            PG8_LDB(B0, 0, 0); PG8_SCHED; PG8_LDA(At, 0, 0); PG8_STAGE(PG8_SA(1, 1), a1 + hstepA, voffA);
            PG8_WAIT_L(8); PG8_BAR; PG8_WAIT_L(0); PG8_MMA(0, 0, At, B0); PG8_BAR; PG8_SCHED;
            PG8_LDB(B1, 0, 1); PG8_STAGE(PG8_SB(0, 0), b2, voffB);
            PG8_BAR; PG8_WAIT_L(0); PG8_MMA(0, 1, At, B1); PG8_BAR;
            PG8_LDA(At, 0, 1); PG8_STAGE(PG8_SA(0, 0), a2, voffA);
            PG8_BAR; PG8_WAIT_L(0); PG8_MMA(1, 0, At, B0); PG8_BAR; PG8_SCHED;
            PG8_STAGE(PG8_SB(0, 1), b2 + hstepB, voffB);
            PG8_WAIT_V(6); PG8_BAR; PG8_MMA(1, 1, At, B1); PG8_BAR;
            PG8_LDB(B0, 1, 0); PG8_SCHED; PG8_LDA(At, 1, 0); PG8_STAGE(PG8_SA(0, 1), a2 + hstepA, voffA);
            PG8_WAIT_L(8); PG8_BAR; PG8_WAIT_L(0); PG8_MMA(0, 0, At, B0); PG8_BAR; PG8_SCHED;
            PG8_LDB(B1, 1, 1); PG8_STAGE(PG8_SB(1, 0), b3, voffB);
            PG8_BAR; PG8_WAIT_L(0); PG8_MMA(0, 1, At, B1); PG8_BAR;
            PG8_LDA(At, 1, 1); PG8_STAGE(PG8_SA(1, 0), a3, voffA);
            PG8_BAR; PG8_WAIT_L(0); PG8_MMA(1, 0, At, B0); PG8_BAR; PG8_SCHED;
            PG8_STAGE(PG8_SB(1, 1), b3 + hstepB, voffB);
            PG8_WAIT_V(6); PG8_BAR; PG8_MMA(1, 1, At, B1); PG8_BAR;
        }
        E(acc, cur, wr, wc, fr, fq);
        if (!has_next) break;
#pragma unroll
        for (int a = 0; a < 2; ++a)
#pragma unroll
            for (int b = 0; b < 2; ++b)
#pragma unroll
                for (int m = 0; m < 4; ++m)
#pragma unroll
                    for (int n = 0; n < 2; ++n) acc[a][b][m][n] = (f32x4){0.f, 0.f, 0.f, 0.f};
        cur = nxt; cA = nA; cB = nB; ++ui;
    }
    PG8_WAIT_V(0);
    if (wr == 0) PG8_BAR;
    PG8_BAR;
#undef PG8_SA
#undef PG8_SB
#undef PG8_STAGE
#undef PG8_LDA
#undef PG8_LDB
#undef PG8_MMA
#undef PG8_WAIT_V
#undef PG8_WAIT_L
#undef PG8_BAR
#undef PG8_SCHED
}
}

template <class Epi>
DEV void run_gemm(unsigned char* shm, const u16* A, int lda, const u16* Bt, int ldb, int N, int K, const Epi& E) {
    asm volatile("" : "+s"(A), "+s"(Bt));
    pg8::Gemm g; g.A = A; g.Bt = Bt; g.M = NTOK; g.N = N; g.K = K; g.lda = lda; g.ldb = ldb;
    pg8::StaticOrder S; S.init(NTOK, N, (int)gridDim.x, (int)blockIdx.x);
    pg8::gemm_phase<Epi>((LAS unsigned char*)shm, g, S, E);
}

DEV void convT_tile(const float* __restrict__ src, u16* __restrict__ dst, int K, int N, int Npad, int tile, float* T) {
    const int tid = tidx(); const int ntn = Npad >> 6; const int k0 = (tile / ntn) << 6, n0 = (tile % ntn) << 6;
#pragma unroll
    for (int j = 0; j < 2; ++j) { const int idx = tid + j * 512; const int r = idx >> 4, c4 = (idx & 15) << 2;
        float4 v = make_float4(0.f, 0.f, 0.f, 0.f); if (n0 + c4 < N) v = *(const float4*)(src + (size_t)(k0 + r) * N + n0 + c4);
        float* t = T + r * 65 + c4; t[0] = v.x; t[1] = v.y; t[2] = v.z; t[3] = v.w; }
    __syncthreads();
    { const int nn = tid >> 3, kq = (tid & 7) << 3; const float* t = T + kq * 65 + nn;
        u32x4 o; o.x = pk(t[0], t[65]); o.y = pk(t[130], t[195]); o.z = pk(t[260], t[325]); o.w = pk(t[390], t[455]);
        *(u32x4*)(dst + (size_t)(n0 + nn) * K + k0 + kq) = o; }
    __syncthreads();
}
DEV int conv_ntiles(int job, int layer) { return job == 0 ? (layer ? 3200 : 3328) : job == 1 ? 1024 : job == 2 ? 5632 : 2816; }
DEV void conv_job(const Params& p, int job, int layer, int tile, float* T) {
    if (job == 0) convT_tile(layer ? p.in[36] : p.in[14], (u16*)(p.ws + OFF_WIN), 2048, layer ? 6176 : 6528, layer ? LDP1 : LDP0, tile, T);
    else if (job == 1) convT_tile(layer ? p.in[37] : p.in[15], (u16*)(p.ws + OFF_WOUT), 2048, 2048, 2048, tile, T);
    else if (job == 2) convT_tile(p.in[10] + (size_t)layer * 2048 * 11264, (u16*)(p.ws + OFF_WUP), 2048, 11264, 11264, tile, T);
    else convT_tile(p.in[12] + (size_t)layer * 5632 * 2048, (u16*)(p.ws + OFF_WDN), 5632, 2048, 2048, tile, T);
}

DEV void adaln_tile(const Params& p, int tile, float* sl) {
    const int tid = tidx(); const int nt = tile % 6, kc = (tile / 6) & 31, layer = tile / 192;
    if (tid < 320) { const int j = tid >> 6, kk = tid & 63; const float cv = (j < 4) ? p.in[4][j * 2048 + kc * 64 + kk] : p.in[5][kc * 64 + kk]; sl[tid] = cv / (1.f + expf(-cv)); }
    __syncthreads();
    const float* w = p.in[6] + ((size_t)layer * 2048 + kc * 64) * 12288 + nt * 2048 + tid * 4;
    float acc[5][4];
#pragma unroll
    for (int j = 0; j < 5; ++j) { acc[j][0] = 0.f; acc[j][1] = 0.f; acc[j][2] = 0.f; acc[j][3] = 0.f; }
#pragma unroll 8
    for (int kk = 0; kk < 64; ++kk) { const float4 wv = *(const float4*)(w + (size_t)kk * 12288);
#pragma unroll
        for (int j = 0; j < 5; ++j) { const float s = sl[j * 64 + kk]; acc[j][0] += s * wv.x; acc[j][1] += s * wv.y; acc[j][2] += s * wv.z; acc[j][3] += s * wv.w; } }
    float* m = (float*)(p.ws + OFF_A) + (size_t)kc * 122880 + (size_t)layer * 5 * 12288 + nt * 2048 + tid * 4;
#pragma unroll
    for (int j = 0; j < 5; ++j) *(float4*)(m + j * 12288) = make_float4(acc[j][0], acc[j][1], acc[j][2], acc[j][3]);
    __syncthreads();
}

DEV void hyfilt_tile(const Params& p, int tile, float* sm) {
    const int tid = tidx();
    int L, p0; u16* G; float* nrm = (float*)(p.ws + OFF_A) + 32 * 122880 + (size_t)tile * 2048;
    if (tile < 128) { L = 4096; p0 = tile * 32; G = (u16*)(p.ws + OFF_GS); }
    else { L = 256; p0 = (tile - 128) * 32; G = (u16*)(p.ws + OFF_GP); }
    float* z = sm; float* h1 = sm + 32 * 33; float* h2 = h1 + 2048;
    const float cang = (float)(6.283185307179586 / (double)L);
    for (int i = tid; i < 32 * 33; i += 512) { const int pp = i / 33, e = i % 33; const float pos = (float)(p0 + pp); float val;
        if (e == 0) val = pos / (float)(L - 1);
        else { const int bi = (e - 1) & 15; const float fb = 1e-4f + (float)bi * ((15.f - 1e-4f) / 15.f); const float ang = (cang * pos) * fb; val = (e <= 16) ? cosf(ang) : -sinf(ang); }
        z[i] = val; }
    __syncthreads();
    for (int i = tid; i < 2048; i += 512) { const int pp = i >> 6, j = i & 63; float a = p.in[19][j];
        for (int e = 0; e < 33; ++e) a += z[pp * 33 + e] * p.in[18][e * 64 + j];
        h1[i] = sinf(p.in[23][j] * a); }
    __syncthreads();
    for (int i = tid; i < 2048; i += 512) { const int pp = i >> 6, j = i & 63; float a = p.in[21][j];
        for (int e = 0; e < 64; ++e) a += h1[pp * 64 + e] * p.in[20][e * 64 + j];
        h2[i] = sinf(p.in[23][64 + j] * a); }
    __syncthreads();
    const float dlo = 3.0701134573253946f, dhi = 15.350567286626973f;
    for (int q = 0; q < 4; ++q) { const int n = tid + 512 * q; const int c = n & 1023; const int back = n >> 10;
        float wcol[64];
#pragma unroll
        for (int e = 0; e < 64; ++e) wcol[e] = p.in[22][e * 2048 + n];
        const float delta = dlo + (dhi - dlo) * ((float)c / 1023.f);
        float asum = 0.f;
        for (int pp = 0; pp < 32; ++pp) { float a = 0.f;
#pragma unroll
            for (int e = 0; e < 64; ++e) a += h2[pp * 64 + e] * wcol[e];
            const int pos = p0 + pp; const float t = (float)pos / (float)(L - 1); a *= expf(-t * delta);
            if (!(back && pos == 0)) { asum += fabsf(a); const int lag = back ? -pos : pos; G[(size_t)c * (2 * L) + (L - lag)] = f2bf(a); } }
        nrm[n] = asum; }
    if (p0 == 0) for (int c = tid; c < 1024; c += 512) G[(size_t)c * (2 * L)] = 0;
    __syncthreads();
}

DEV void phase_prep(const Params& p, unsigned char* shm) {
    const int tid = tidx(); float* sm = (float*)shm;
    { const float4* xp = (const float4*)p.in[0]; const float4* xs = (const float4*)p.in[1]; float4* X = (float4*)p.out;
        const size_t n1 = 16777216 / 4, n = 50331648 / 4;
        for (size_t i = (size_t)blockIdx.x * 512 + tid; i < n; i += (size_t)gridDim.x * 512) X[i] = i < n1 ? xp[i] : xs[i - n1]; }
    if (blockIdx.x == 0 && tid == 0) *(unsigned*)(p.ws + OFF_SMALL + SMALL_BYTES) = 0u;
    const int n0 = 136, n1 = n0 + 384, n2 = n1 + 3328, n3 = n2 + 1024, n4 = n3 + 5632, n5 = n4 + 2816;
    for (int t = blockIdx.x; t < n5; t += gridDim.x) {
        if (t < n0) hyfilt_tile(p, t, sm);
        else if (t < n1) adaln_tile(p, t - n0, sm);
        else if (t < n2) conv_job(p, 0, 0, t - n1, sm);
        else if (t < n3) conv_job(p, 1, 0, t - n2, sm);
        else if (t < n4) conv_job(p, 2, 0, t - n3, sm);
        else conv_job(p, 3, 0, t - n4, sm);
    }
}

DEV void phase_reduce(const Params& p) {
    const float* part = (const float*)(p.ws + OFF_A); float* mods = (float*)(p.ws + OFF_SMALL); float* hn = (float*)(p.ws + OFF_SMALL + 491520);
    for (int i = blockIdx.x * 512 + tidx(); i < 122880 + 2048; i += gridDim.x * 512) {
        if (i < 122880) { float a = 0.f; for (int kc = 0; kc < 32; ++kc) a += part[(size_t)kc * 122880 + i]; mods[i] = a; }
        else { const int j = i - 122880; const int c = j & 1023; const float* hp = part + 32 * 122880; float a = 0.f;
            if (j < 1024) { for (int t = 0; t < 128; ++t) a += hp[(size_t)t * 2048 + c] + hp[(size_t)t * 2048 + 1024 + c]; }
            else { for (int t = 128; t < 136; ++t) a += hp[(size_t)t * 2048 + c] + hp[(size_t)t * 2048 + 1024 + c]; }
            hn[j] = a; }
    }
}

DEV void phase_norm(const Params& p, int layer, int which, unsigned char* shm) {
    const int tid = tidx(), wid = tid >> 6, lane = tid & 63;
    const float* g = p.in[which ? 9 : 8] + layer * 2048;
    const float* X = p.out; u16* A = (u16*)(p.ws + OFF_A);
    const float* mods = (const float*)(p.ws + OFF_SMALL) + (size_t)layer * 5 * 12288; const float* bb = p.in[7] + layer * 12288;
    const int shi = which ? 3 : 0;
    for (int row = blockIdx.x * 8 + wid; row < NTOK; row += gridDim.x * 8) {
        const float4* xr = (const float4*)(X + (size_t)row * DM);
        float4 v[8]; float ss = 0.f;
#pragma unroll
        for (int j = 0; j < 8; ++j) { v[j] = xr[lane + 64 * j]; ss += v[j].x * v[j].x + v[j].y * v[j].y + v[j].z * v[j].z + v[j].w * v[j].w; }
        ss = wave_sum(ss);
        const float rstd = rsqrtf(ss * (1.f / 2048.f) + 1e-6f);
        const float* md = mods + (size_t)tok_cond(row) * 12288;
#pragma unroll
        for (int j = 0; j < 8; ++j) { const int col = (lane + 64 * j) * 4;
            const float4 gg = *(const float4*)(g + col);
            const float4 s1 = *(const float4*)(md + shi * 2048 + col), s2 = *(const float4*)(bb + shi * 2048 + col);
            const float4 c1 = *(const float4*)(md + (shi + 1) * 2048 + col), c2 = *(const float4*)(bb + (shi + 1) * 2048 + col);
            const float o0 = v[j].x * rstd * gg.x * (1.f + c1.x + c2.x) + s1.x + s2.x;
            const float o1 = v[j].y * rstd * gg.y * (1.f + c1.y + c2.y) + s1.y + s2.y;
            const float o2 = v[j].z * rstd * gg.z * (1.f + c1.z + c2.z) + s1.z + s2.z;
            const float o3 = v[j].w * rstd * gg.w * (1.f + c1.w + c2.w) + s1.w + s2.w;
            u32x2 o; o.x = pk(o0, o1); o.y = pk(o2, o3);
            *(u32x2*)(A + (size_t)row * DM + col) = o; }
    }
    if (layer == 0 && which == 1) { const int na = conv_ntiles(0, 1), nb = na + conv_ntiles(1, 1);
        for (int t = blockIdx.x; t < nb; t += gridDim.x) { if (t < na) conv_job(p, 0, 1, t, (float*)shm); else conv_job(p, 1, 1, t - na, (float*)shm); } }
    if (layer == 1 && which == 0) { const int na = conv_ntiles(2, 1), nb = na + conv_ntiles(3, 1);
        for (int t = blockIdx.x; t < nb; t += gridDim.x) { if (t < na) conv_job(p, 2, 1, t, (float*)shm); else conv_job(p, 3, 1, t - na, (float*)shm); } }
}

DEV void sconv8(const u16* prow, bool hm, bool hp, const float* sw, const float* sb, int ch, float* o) {
    float c[8], m[8], q[8];
    unpack8(*(const u32x4*)(prow + ch), c);
    if (hm) unpack8(*(const u32x4*)(prow - LDP0 + ch), m); else { for (int i = 0; i < 8; ++i) m[i] = 0.f; }
    if (hp) unpack8(*(const u32x4*)(prow + LDP0 + ch), q); else { for (int i = 0; i < 8; ++i) q[i] = 0.f; }
#pragma unroll
    for (int i = 0; i < 8; ++i) o[i] = m[i] * sw[ch + i] + c[i] * sw[3072 + ch + i] + q[i] * sw[6144 + ch + i] + sb[ch + i];
}
DEV void hy_pre_tile(const Params& p, int tile, float* T) {
    const int tid = tidx(); const int tok0 = (tile >> 4) << 6, c0 = (tile & 15) << 6;
    const u16* P = (const u16*)(p.ws + OFF_P); u16* uT = (u16*)(p.ws + OFF_UT);
    { const int tk = tid >> 3, c8 = (tid & 7) << 3; const int tok = tok0 + tk; int t, L; tok_tl(tok, t, L);
        const u16* prow = P + (size_t)tok * LDP0; float x1[8], vv[8];
        sconv8(prow, t > 0, t < L - 1, p.in[16], p.in[17], 1024 + c0 + c8, x1);
        sconv8(prow, t > 0, t < L - 1, p.in[16], p.in[17], 2048 + c0 + c8, vv);
#pragma unroll
        for (int i = 0; i < 8; ++i) T[tk * 65 + c8 + i] = x1[i] * vv[i]; }
    __syncthreads();
    { const int ch = tid >> 3, t8 = (tid & 7) << 3; const float* t = T + t8 * 65 + ch;
        u32x4 o; o.x = pk(t[0], t[65]); o.y = pk(t[130], t[195]); o.z = pk(t[260], t[325]); o.w = pk(t[390], t[455]);
        *(u32x4*)(uT + (size_t)(c0 + ch) * NTOK + tok0 + t8) = o; }
    __syncthreads();
}
DEV void hy_post_tile(const Params& p, int tile, float* T) {
    const int tid = tidx(); const int tok0 = (tile >> 4) << 6, c0 = (tile & 15) << 6;
    const u16* P = (const u16*)(p.ws + OFF_P); const u16* uT = (const u16*)(p.ws + OFF_UT); u16* ycat = (u16*)(p.ws + OFF_A);
    { const int ch = tid >> 3, t8 = (tid & 7) << 3; float y[8]; unpack8(*(const u32x4*)(uT + (size_t)(c0 + ch) * NTOK + tok0 + t8), y);
#pragma unroll
        for (int i = 0; i < 8; ++i) T[(t8 + i) * 65 + ch] = y[i]; }
    __syncthreads();
    { const int tk = tid >> 3, c8 = (tid & 7) << 3; const int tok = tok0 + tk; int t, L; tok_tl(tok, t, L);
        const u16* prow = P + (size_t)tok * LDP0; float x0[8], x1[8], vv[8], o[8];
        sconv8(prow, t > 0, t < L - 1, p.in[16], p.in[17], c0 + c8, x0);
        sconv8(prow, t > 0, t < L - 1, p.in[16], p.in[17], 1024 + c0 + c8, x1);
        sconv8(prow, t > 0, t < L - 1, p.in[16], p.in[17], 2048 + c0 + c8, vv);
        const float* nrm = (const float*)(p.ws + OFF_SMALL + 491520) + (tok < NTP ? 1024 : 0);
#pragma unroll
        for (int i = 0; i < 8; ++i) { const int c = c0 + c8 + i; o[i] = x0[i] * (T[tk * 65 + c8 + i] / nrm[c] + x1[i] * vv[i] * p.in[24][c]); }
        u32x4 w; w.x = pk(o[0], o[1]); w.y = pk(o[2], o[3]); w.z = pk(o[4], o[5]); w.w = pk(o[6], o[7]);
        *(u32x4*)(ycat + (size_t)tok * DM + c0 + c8) = w; }
    __syncthreads();
}
DEV void hyconv_task(const Params& p, int task, unsigned char* shm) {
    const int tid = tidx(), wid = tid >> 6, lane = tid & 63;
    const bool sample = task < 1024; const int c = sample ? task : task - 1024;
    const int L = sample ? 4096 : 256, NB = sample ? 4 : 32, lgNB = sample ? 2 : 5, LP = L + 8;
    u16* uL = (u16*)shm; u16* gL = uL + NB * LP; u16* gS = gL + 2 * L;
    const u16* G = sample ? (const u16*)(p.ws + OFF_GS) + (size_t)c * 8192 : (const u16*)(p.ws + OFF_GP) + (size_t)c * 512;
    u16* uT = (u16*)(p.ws + OFF_UT) + (size_t)c * NTOK + (sample ? NTP : 0);
    for (int i = tid * 8; i < NB * L; i += 4096) { const int b = i / L, s = i % L; *(u32x4*)(uL + b * LP + s) = *(const u32x4*)(uT + i); }
    for (int i = tid * 8; i < 2 * L; i += 4096) { const u32x4 w = *(const u32x4*)(G + i); *(u32x4*)(gL + i) = w;
        const unsigned nx = (i + 8 < 2 * L) ? (unsigned)G[i + 8] : 0u;
        u32x4 sft; sft.x = (w.x >> 16) | (w.y << 16); sft.y = (w.y >> 16) | (w.z << 16); sft.z = (w.z >> 16) | (w.w << 16); sft.w = (w.w >> 16) | (nx << 16);
        *(u32x4*)(gS + i) = sft; }
    __syncthreads();
    const int ntile = (NB * (L >> 5)) >> 5;
    const int npair = sample ? 8 : 8; const bool two = sample;
    const int r = lane & 31, half = lane >> 5;
    {
        const int ct0 = two ? 2 * wid : wid;
        const int colA = ct0 * 32 + r, colB = colA + 32;
        const int bA = colA & (NB - 1), iA = colA >> lgNB, bB = colB & (NB - 1), iB = colB >> lgNB; const int tA = iA * 32, tB = iB * 32;
        const int i_lo = (ct0 * 32) >> lgNB, i_hi = ((two ? ct0 + 1 : ct0) * 32 + 31) >> lgNB;
        const int d_lo = 32 * i_lo - (L - 16), d_hi = 32 * i_hi;
        f32x16 accA, accB;
#pragma unroll
        for (int j = 0; j < 16; ++j) { accA[j] = 0.f; accB[j] = 0.f; }
        const u16* ubA = uL + bA * LP + 8 * half; const u16* ubB = uL + bB * LP + 8 * half;
        const u16* gsel = (r & 1) ? gS : gL;
        const int qb = (L - r + 8 * half) & ~1;
        for (int dl = d_lo; dl <= d_hi; dl += 16) {
            const unsigned* gq = (const unsigned*)(gsel + (qb - dl));
            u32x4 aw; aw.x = gq[0]; aw.y = gq[1]; aw.z = gq[2]; aw.w = gq[3];
            const bf16x8 a = __builtin_bit_cast(bf16x8, aw);
            const int sA = tA - dl, sB = tB - dl;
            bf16x8 bvA = (bf16x8){0, 0, 0, 0, 0, 0, 0, 0}, bvB = bvA;
            if (sA >= 0 && sA <= L - 16) bvA = *(const bf16x8*)(ubA + sA);
            accA = __builtin_amdgcn_mfma_f32_32x32x16_bf16(a, bvA, accA, 0, 0, 0);
            if (two) { if (sB >= 0 && sB <= L - 16) bvB = *(const bf16x8*)(ubB + sB);
                accB = __builtin_amdgcn_mfma_f32_32x32x16_bf16(a, bvB, accB, 0, 0, 0); }
        }
#pragma unroll
        for (int g = 0; g < 4; ++g) { u32x2 w; w.x = pk(accA[4 * g], accA[4 * g + 1]); w.y = pk(accA[4 * g + 2], accA[4 * g + 3]);
            *(u32x2*)(uT + (size_t)bA * L + tA + 8 * g + 4 * half) = w; }
        if (two) {
#pragma unroll
            for (int g = 0; g < 4; ++g) { u32x2 w; w.x = pk(accB[4 * g], accB[4 * g + 1]); w.y = pk(accB[4 * g + 2], accB[4 * g + 3]);
                *(u32x2*)(uT + (size_t)bB * L + tB + 8 * g + 4 * half) = w; } }
    }
    (void)ntile; (void)npair;
    __syncthreads();
}

DEV void rwkv_lora_tile(const Params& p, int tile, float* sm) {
    const int tid = tidx(); const int tok0 = tile * 32;
    const u16* P = (const u16*)(p.ws + OFF_P); u16* RW = (u16*)(p.ws + OFF_RW);
    for (int i = tid; i < 32 * 256; i += 512) { const int tk = i >> 8, cc = i & 255; const int tok = tok0 + tk; int t, L; tok_tl(tok, t, L);
        const u16* pp = P + (size_t)tok * LDP0 + 6144 + cc; float x = bf2f(*pp); const float xm = t > 0 ? bf2f(pp[-LDP0]) : 0.f; const float xp = t < L - 1 ? bf2f(pp[LDP0]) : 0.f;
        const float mu = p.in[25][3072 + cc]; x = x + mu * (0.5f * (xm + xp) - x); if (cc < 128) x = tanhf(x);
        sm[((cc >> 6) * 32 + tk) * 64 + (cc & 63)] = x; }
    __syncthreads();
    for (int mi = 0; mi < 4; ++mi)
        for (int hf = 0; hf < 2; ++hf) { const int n = hf * 512 + tid; const int d = mi & 1;
            const float* W = (mi < 2 ? p.in[27] : p.in[29]) + (size_t)d * 64 * 1024 + n;
            float wc[64];
#pragma unroll
            for (int r = 0; r < 64; ++r) wc[r] = W[r * 1024];
            const float bias = (mi < 2 ? p.in[26] : p.in[28])[d * 1024 + n];
            const float* inp = sm + mi * 2048;
            for (int tk = 0; tk < 32; ++tk) { float a = bias;
#pragma unroll
                for (int r = 0; r < 64; r += 4) { const float4 x = *(const float4*)(inp + tk * 64 + r); a += x.x * wc[r] + x.y * wc[r + 1] + x.z * wc[r + 2] + x.w * wc[r + 3]; }
                const float sg = sigm(a); const float o = mi < 2 ? 0.6065306597f * sg : sg;
                RW[(size_t)(tok0 + tk) * 4096 + mi * 1024 + n] = f2bf(o); } }
    __syncthreads();
}
DEV float mixf(float c, float m, float q, float mu) { return c + mu * (0.5f * (m + q) - c); }
DEV void rwkv_scan_task(const Params& p, int task, float* sm) {
    const bool sample = task < 128; const int tt_ = sample ? task : task - 128;
    const int b = tt_ >> 5, h = (tt_ >> 1) & 15, dir = tt_ & 1;
    const int L = sample ? 4096 : 256; const int tok0 = sample ? NTP + b * 4096 : b * 256;
    const int tid = tidx(), wid = tid >> 6, lane = tid & 63;
    const int row = wid * 8 + (lane >> 3), kl = lane & 7;
    float S[8];
    const size_t soff = ((((size_t)b * 2 + dir) * 16 + h) * 64 + row) * 64 + kl * 8;
    if (sample) { const float4 a = *(const float4*)(p.in[2] + soff), c = *(const float4*)(p.in[2] + soff + 4);
        S[0] = a.x; S[1] = a.y; S[2] = a.z; S[3] = a.w; S[4] = c.x; S[5] = c.y; S[6] = c.z; S[7] = c.w; }
    else {
#pragma unroll
        for (int i = 0; i < 8; ++i) S[i] = 0.f; }
    float* vec = sm; float* vvs = sm + 10240; float* yb = vvs + 2048;
    const int ptt = tid >> 4, pk4 = (tid & 15) * 4; const int ch = h * 64 + pk4;
    const float4 mur = *(const float4*)(p.in[25] + ch), muk = *(const float4*)(p.in[25] + 1024 + ch), muv = *(const float4*)(p.in[25] + 2048 + ch);
    const float4 kkw = *(const float4*)(p.in[31] + ch), kaw = *(const float4*)(p.in[32] + ch);
    const float murA[4] = {mur.x, mur.y, mur.z, mur.w}, mukA[4] = {muk.x, muk.y, muk.z, muk.w}, muvA[4] = {muv.x, muv.y, muv.z, muv.w};
    const float kkwA[4] = {kkw.x, kkw.y, kkw.z, kkw.w}, kawA[4] = {kaw.x, kaw.y, kaw.z, kaw.w};
    const u16* P = (const u16*)(p.ws + OFF_P); const u16* RW = (const u16*)(p.ws + OFF_RW);
    u16* Y = (u16*)(p.out + OUT_GLAST) + (dir ? (size_t)NTOK * 1024 : 0);
    for (int c0 = 0; c0 < L; c0 += 32) {
        { const int t = dir ? (L - 1 - (c0 + ptt)) : (c0 + ptt); const size_t tok = (size_t)tok0 + t;
            const u16* pr = P + tok * LDP0 + 3072 + ch;
            float rc[4], kc[4], vc[4], rm[4], km[4], vm[4], rp[4], kp[4], vp[4], ee[4], aa[4];
            unpack4(*(const u32x2*)(pr), rc); unpack4(*(const u32x2*)(pr + 1024), kc); unpack4(*(const u32x2*)(pr + 2048), vc);
            if (t > 0) { unpack4(*(const u32x2*)(pr - LDP0), rm); unpack4(*(const u32x2*)(pr - LDP0 + 1024), km); unpack4(*(const u32x2*)(pr - LDP0 + 2048), vm); }
            else { for (int i = 0; i < 4; ++i) { rm[i] = 0.f; km[i] = 0.f; vm[i] = 0.f; } }
            if (t < L - 1) { unpack4(*(const u32x2*)(pr + LDP0), rp); unpack4(*(const u32x2*)(pr + LDP0 + 1024), kp); unpack4(*(const u32x2*)(pr + LDP0 + 2048), vp); }
            else { for (int i = 0; i < 4; ++i) { rp[i] = 0.f; kp[i] = 0.f; vp[i] = 0.f; } }
            unpack4(*(const u32x2*)(RW + tok * 4096 + dir * 1024 + ch), ee); unpack4(*(const u32x2*)(RW + tok * 4096 + (2 + dir) * 1024 + ch), aa);
            float r4[4], k4[4], v4[4], kr[4]; float ss = 0.f;
#pragma unroll
            for (int i = 0; i < 4; ++i) { r4[i] = mixf(rc[i], rm[i], rp[i], murA[i]); k4[i] = mixf(kc[i], km[i], kp[i], mukA[i]); v4[i] = mixf(vc[i], vm[i], vp[i], muvA[i]);
                kr[i] = k4[i] * kkwA[i]; ss += kr[i] * kr[i]; }
            ss = sum16(ss); const float inv = rsqrtf(ss + 1e-12f);
            float4 okk, ow, okka, okd, orr, ov;
            float tkk[4], tw[4], tkka[4], tkd[4];
#pragma unroll
            for (int i = 0; i < 4; ++i) { tkk[i] = kr[i] * inv; tw[i] = __expf(-ee[i]); tkka[i] = tkk[i] * aa[i]; tkd[i] = k4[i] * (1.f + (aa[i] - 1.f) * kawA[i]); }
            okk = make_float4(tkk[0], tkk[1], tkk[2], tkk[3]); ow = make_float4(tw[0], tw[1], tw[2], tw[3]); okka = make_float4(tkka[0], tkka[1], tkka[2], tkka[3]);
            okd = make_float4(tkd[0], tkd[1], tkd[2], tkd[3]); orr = make_float4(r4[0], r4[1], r4[2], r4[3]); ov = make_float4(v4[0], v4[1], v4[2], v4[3]);
            float* vj = vec + ptt * 320 + pk4;
            *(float4*)(vj) = okk; *(float4*)(vj + 64) = ow; *(float4*)(vj + 128) = okka; *(float4*)(vj + 192) = okd; *(float4*)(vj + 256) = orr;
            *(float4*)(vvs + ptt * 64 + pk4) = ov; }
        __syncthreads();
        for (int j = 0; j < 32; ++j) {
            const float* vj = vec + j * 320 + kl * 8;
            const float4 a0 = *(const float4*)(vj), a1 = *(const float4*)(vj + 4);
            const float4 w0 = *(const float4*)(vj + 64), w1 = *(const float4*)(vj + 68);
            const float4 b0 = *(const float4*)(vj + 128), b1 = *(const float4*)(vj + 132);
            const float4 d0 = *(const float4*)(vj + 192), d1 = *(const float4*)(vj + 196);
            const float4 r0 = *(const float4*)(vj + 256), r1 = *(const float4*)(vj + 260);
            const float vr = vvs[j * 64 + row];
            float sa = S[0] * a0.x + S[1] * a0.y + S[2] * a0.z + S[3] * a0.w + S[4] * a1.x + S[5] * a1.y + S[6] * a1.z + S[7] * a1.w;
            sa = -sum8(sa);
            S[0] = S[0] * w0.x + sa * b0.x + vr * d0.x; S[1] = S[1] * w0.y + sa * b0.y + vr * d0.y; S[2] = S[2] * w0.z + sa * b0.z + vr * d0.z; S[3] = S[3] * w0.w + sa * b0.w + vr * d0.w;
            S[4] = S[4] * w1.x + sa * b1.x + vr * d1.x; S[5] = S[5] * w1.y + sa * b1.y + vr * d1.y; S[6] = S[6] * w1.z + sa * b1.z + vr * d1.z; S[7] = S[7] * w1.w + sa * b1.w + vr * d1.w;
            float y = S[0] * r0.x + S[1] * r0.y + S[2] * r0.z + S[3] * r0.w + S[4] * r1.x + S[5] * r1.y + S[6] * r1.z + S[7] * r1.w;
            y = sum8(y);
            if (kl == 0) yb[j * 64 + row] = y;
        }
        __syncthreads();
        { const int t = dir ? (L - 1 - (c0 + ptt)) : (c0 + ptt);
            const float4 yv = *(const float4*)(yb + ptt * 64 + pk4); u32x2 w; w.x = pk(yv.x, yv.y); w.y = pk(yv.z, yv.w);
            *(u32x2*)(Y + ((size_t)tok0 + t) * 1024 + ch) = w; }
    }
    if (!sample) { float* so = p.out + OUT_RWST + soff;
        *(float4*)(so) = make_float4(S[0], S[1], S[2], S[3]); *(float4*)(so + 4) = make_float4(S[4], S[5], S[6], S[7]); }
    __syncthreads();
}
DEV void rwkv_post_tile(const Params& p, int tile, float* sm) {
    const int tid = tidx(); const int tok0 = tile * 16;
    const u16* P = (const u16*)(p.ws + OFF_P); const u16* RW = (const u16*)(p.ws + OFF_RW); u16* ycat = (u16*)(p.ws + OFF_A);
    const u16* YF = (const u16*)(p.out + OUT_GLAST); const u16* YB = YF + (size_t)NTOK * 1024;
    for (int i = tid; i < 16 * 128; i += 512) { const int tk = i >> 7, r = i & 127; const int tok = tok0 + tk; int t, L; tok_tl(tok, t, L);
        const u16* pp = P + (size_t)tok * LDP0 + 6400 + r; const float x = bf2f(*pp); const float xm = t > 0 ? bf2f(pp[-LDP0]) : 0.f; const float xp = t < L - 1 ? bf2f(pp[LDP0]) : 0.f;
        sm[i] = sigm(mixf(x, xm, xp, p.in[25][3328 + r])); }
    __syncthreads();
    float g0[16], g1[16];
#pragma unroll
    for (int k = 0; k < 16; ++k) { g0[k] = 0.f; g1[k] = 0.f; }
    const float* g2 = p.in[30];
    for (int r = 0; r < 128; r += 4) {
        float wa[4], wb[4];
#pragma unroll
        for (int q = 0; q < 4; ++q) { wa[q] = g2[(r + q) * 1024 + tid]; wb[q] = g2[(r + q) * 1024 + 512 + tid]; }
#pragma unroll
        for (int k = 0; k < 16; ++k) { const float4 s = *(const float4*)(sm + k * 128 + r);
            g0[k] += s.x * wa[0] + s.y * wa[1] + s.z * wa[2] + s.w * wa[3]; g1[k] += s.x * wb[0] + s.y * wb[1] + s.z * wb[2] + s.w * wb[3]; } }
#pragma unroll
    for (int q = 0; q < 2; ++q) { const int n = q * 512 + tid;
        const float mur = p.in[25][n], muk = p.in[25][1024 + n], muv = p.in[25][2048 + n];
        const float ka = p.in[32][n], rk = p.in[33][n], lw = p.in[34][n], lb = p.in[35][n];
#pragma unroll
        for (int k = 0; k < 16; ++k) { const int tok = tok0 + k; int t, L; tok_tl(tok, t, L);
            const u16* pr = P + (size_t)tok * LDP0 + 3072 + n;
            const bool hm = t > 0, hp = t < L - 1;
            const float r_ = mixf(bf2f(pr[0]), hm ? bf2f(pr[-LDP0]) : 0.f, hp ? bf2f(pr[LDP0]) : 0.f, mur);
            const float k_ = mixf(bf2f(pr[1024]), hm ? bf2f(pr[1024 - LDP0]) : 0.f, hp ? bf2f(pr[1024 + LDP0]) : 0.f, muk);
            const float v_ = mixf(bf2f(pr[2048]), hm ? bf2f(pr[2048 - LDP0]) : 0.f, hp ? bf2f(pr[2048 + LDP0]) : 0.f, muv);
            const float a0 = bf2f(RW[(size_t)tok * 4096 + 2048 + n]), a1 = bf2f(RW[(size_t)tok * 4096 + 3072 + n]);
            const float kd = k_ * (2.f + (a0 + a1 - 2.f) * ka);
            const float bonus = wave_sum(r_ * kd * rk);
            const float y = bf2f(YF[(size_t)tok * 1024 + n]) + bf2f(YB[(size_t)tok * 1024 + n]);
            const float mean = wave_sum(y) * (1.f / 64.f); const float dy = y - mean; const float var = wave_sum(dy * dy) * (1.f / 64.f);
            const float yn = dy * rsqrtf(var + 64e-5f) * lw + lb;
            const float gg = q ? g1[k] : g0[k];
            ycat[(size_t)tok * DM + 1024 + n] = f2bf((yn + bonus * v_) * gg); } }
    __syncthreads();
}

DEV float logsig(float x) { return fminf(x, 0.f) - log1pf(__expf(-fabsf(x))); }
DEV f32x4 mfma16(bf16x8 a, bf16x8 b, f32x4 c) { return __builtin_amdgcn_mfma_f32_16x16x32_bf16(a, b, c, 0, 0, 0); }
DEV void gla_intra_task(const Params& p, int task, unsigned char* shm) {
    const int tid = tidx(), wid = tid >> 6, lane = tid & 63, l15 = lane & 15, quad = lane >> 4;
    const int cidx = task >> 2, h = task & 3; const int tok0 = cidx * 64;
    u16* P = (u16*)(p.ws + OFF_P); u16* QB = (u16*)(p.ws + OFF_A); float* Dbuf = (float*)(p.ws + OFF_DB);
    u16* qi = (u16*)shm; u16* ki = qi + 64 * 264; u16* vl = (u16*)shm; u16* Pl = (u16*)(shm + 67584); float* gl = (float*)(shm + 76800); float* tot = (float*)(shm + 84992);
    for (int i = tid; i < 2048; i += 512) { const int tl = i >> 5, c = i & 31; gl[i] = bf2f(P[(size_t)(tok0 + tl) * LDP1 + 6144 + c]); }
    __syncthreads();
    const int k = tid & 255, jh = tid >> 8;
#pragma unroll 1
    for (int dd = 0; dd < 2; ++dd) { const int dir = 1 - dd;
        float g2r[16];
#pragma unroll
        for (int r = 0; r < 16; ++r) g2r[r] = p.in[38][(size_t)(dir * 16 + r) * 1024 + h * 256 + k];
        const float gb = p.in[39][dir * 1024 + h * 256 + k];
        float bl[32]; float run = 0.f;
#pragma unroll
        for (int jj = 0; jj < 32; ++jj) { const int j = jh * 32 + jj; const int tl = dir ? 63 - j : j; const float* gr = gl + tl * 32 + dir * 16;
            float x = gb;
#pragma unroll
            for (int r = 0; r < 16; r += 4) { const float4 g4 = *(const float4*)(gr + r); x += g4.x * g2r[r] + g4.y * g2r[r + 1] + g4.z * g2r[r + 2] + g4.w * g2r[r + 3]; }
            run += logsig(x) * 0.0625f; bl[jj] = run; }
        tot[jh * 256 + k] = run;
        __syncthreads();
        const float t0v = tot[k], t1v = tot[256 + k]; const float off = jh ? t0v : 0.f; const float bref = t0v, blast = t0v + t1v;
        if (jh == 0) Dbuf[((size_t)cidx * 2 + dir) * 1024 + h * 256 + k] = __expf(blast);
        u16* qdst; u16* kdst; size_t ldd;
        if (dir == 0) { qdst = P + h * 256 + k; kdst = P + 1024 + h * 256 + k; ldd = LDP1; } else { qdst = QB + h * 256 + k; kdst = QB + 1024 + h * 256 + k; ldd = 2048; }
#pragma unroll
        for (int jj = 0; jj < 32; ++jj) { const int j = jh * 32 + jj; const int tl = dir ? 63 - j : j; const size_t tok = (size_t)tok0 + tl;
            const float qv = bf2f(P[tok * LDP1 + h * 256 + k]) * 0.0625f, kv = bf2f(P[tok * LDP1 + 1024 + h * 256 + k]);
            const float b = bl[jj] + off;
            qi[j * 264 + k] = f2bf(qv * __expf(b - bref)); ki[j * 264 + k] = f2bf(kv * __expf(bref - b));
            qdst[tok * ldd] = f2bf(qv * __expf(b)); kdst[tok * ldd] = f2bf(kv * __expf(blast - b)); }
        __syncthreads();
        { const int tt = wid >> 1;
#pragma unroll
            for (int q2 = 0; q2 < 2; ++q2) { const int st = (wid & 1) * 2 + q2; f32x4 acc = (f32x4){0.f, 0.f, 0.f, 0.f};
                if (st <= tt) {
#pragma unroll
                    for (int ks = 0; ks < 8; ++ks) { const bf16x8 a = *(const bf16x8*)(qi + (tt * 16 + l15) * 264 + ks * 32 + quad * 8); const bf16x8 b = *(const bf16x8*)(ki + (st * 16 + l15) * 264 + ks * 32 + quad * 8);
                        acc = mfma16(a, b, acc); } }
#pragma unroll
                for (int r = 0; r < 4; ++r) { const int t = tt * 16 + quad * 4 + r, s_ = st * 16 + l15; Pl[t * 72 + s_] = f2bf(s_ <= t ? acc[r] : 0.f); } } }
        __syncthreads();
#pragma unroll
        for (int i = 0; i < 8; ++i) { const int piece = tid + 512 * i; const int j = piece >> 6, c8 = (piece & 63) * 8; const int tl = dir ? 63 - j : j;
            *(u32x4*)(vl + j * 520 + c8) = *(const u32x4*)(P + (size_t)(tok0 + tl) * LDP1 + 2048 + h * 512 + c8); }
        __syncthreads();
        u16* O = (u16*)(p.ws + (dir ? OFF_OB : OFF_OF)) + h * 512;
#pragma unroll 1
        for (int q4 = 0; q4 < 4; ++q4) { const int vt = wid * 4 + q4; f32x4 acc[4];
#pragma unroll
            for (int tt = 0; tt < 4; ++tt) acc[tt] = (f32x4){0.f, 0.f, 0.f, 0.f};
#pragma unroll
            for (int ss = 0; ss < 2; ++ss) { bf16x8 bfr;
#pragma unroll
                for (int jj = 0; jj < 8; ++jj) bfr[jj] = (short)vl[(ss * 32 + quad * 8 + jj) * 520 + vt * 16 + l15];
#pragma unroll
                for (int tt = 0; tt < 4; ++tt) { if (ss * 32 <= tt * 16 + 15) { const bf16x8 a = *(const bf16x8*)(Pl + (tt * 16 + l15) * 72 + ss * 32 + quad * 8); acc[tt] = mfma16(a, bfr, acc[tt]); } } }
#pragma unroll
            for (int tt = 0; tt < 4; ++tt)
#pragma unroll
                for (int r = 0; r < 4; ++r) { const int t = tt * 16 + quad * 4 + r; const int tl = dir ? 63 - t : t; O[(size_t)(tok0 + tl) * DM + vt * 16 + l15] = f2bf(acc[tt][r]); } }
        __syncthreads();
    }
}
DEV void gla_inter_task(const Params& p, int task, unsigned char* shm) {
    const bool sample = task < 256; const int tt_ = sample ? task : task - 256;
    const int seq = tt_ >> 3, vs = tt_ & 7; const int b = seq >> 3, h = (seq >> 1) & 3, dir = seq & 1;
    const int L = sample ? 4096 : 256; const int tok0 = sample ? NTP + b * 4096 : b * 256;
    const int nch = L >> 6, cbase = tok0 >> 6;
    const int tid = tidx(), wid = tid >> 6, lane = tid & 63, l15 = lane & 15, quad = lane >> 4;
    const u16* P = (const u16*)(p.ws + OFF_P); const u16* QB = (const u16*)(p.ws + OFF_A); const float* Dbuf = (const float*)(p.ws + OFF_DB);
    u16* ST = (u16*)shm; u16* qdl = (u16*)(shm + 33792); u16* kdl = (u16*)(shm + 67584); u16* vl = (u16*)(shm + 101376); float* dl = (float*)(shm + 110592);
    f32x4 S[2][4];
    const size_t sbase = (((size_t)b * 2 + dir) * 4 + h) * 256 * 512 + vs * 64;
#pragma unroll
    for (int kt = 0; kt < 2; ++kt)
#pragma unroll
        for (int vt = 0; vt < 4; ++vt)
#pragma unroll
            for (int r = 0; r < 4; ++r) { const int kk = wid * 32 + kt * 16 + quad * 4 + r; S[kt][vt][r] = sample ? p.in[3][sbase + (size_t)kk * 512 + vt * 16 + l15] : 0.f; }
    const u16* qsrc; const u16* ksrc; size_t lds_;
    if (dir == 0) { qsrc = P + h * 256; ksrc = P + 1024 + h * 256; lds_ = LDP1; } else { qsrc = QB + h * 256; ksrc = QB + 1024 + h * 256; lds_ = 2048; }
    const u16* vsrc = P + 2048 + h * 512 + vs * 64;
    u16* O = (u16*)(p.ws + (dir ? OFF_OB : OFF_OF)) + h * 512 + vs * 64;
    u32x4 rq[4], rk[4], rv; float rd = 0.f;
    const int vrow = tid >> 3, vc8 = (tid & 7) * 8;
#define GLA_ISSUE(n_) do { const int cidx_ = cbase + (dir ? nch - 1 - (n_) : (n_)); \
        _Pragma("unroll") for (int i = 0; i < 4; ++i) { const int piece = tid + 512 * i; const int j = piece >> 5, c8 = (piece & 31) * 8; const size_t tok = (size_t)cidx_ * 64 + (dir ? 63 - j : j); \
            rq[i] = *(const u32x4*)(qsrc + tok * lds_ + c8); rk[i] = *(const u32x4*)(ksrc + tok * lds_ + c8); } \
        { const size_t tok = (size_t)cidx_ * 64 + (dir ? 63 - vrow : vrow); rv = *(const u32x4*)(vsrc + tok * LDP1 + vc8); } \
        if (tid < 256) rd = Dbuf[((size_t)cidx_ * 2 + dir) * 1024 + h * 256 + tid]; } while (0)
#define GLA_WRITE_ST() do { _Pragma("unroll") for (int kt = 0; kt < 2; ++kt) _Pragma("unroll") for (int vt = 0; vt < 4; ++vt) { u32x2 w; w.x = pk(S[kt][vt][0], S[kt][vt][1]); w.y = pk(S[kt][vt][2], S[kt][vt][3]); \
            *(u32x2*)(ST + (vt * 16 + l15) * 264 + wid * 32 + kt * 16 + quad * 4) = w; } } while (0)
    GLA_WRITE_ST();
    GLA_ISSUE(0);
    const int tt = wid >> 1, vb = (wid & 1) * 2;
#pragma unroll 1
    for (int n = 0; n < nch; ++n) {
        const int cidx = cbase + (dir ? nch - 1 - n : n);
#pragma unroll
        for (int i = 0; i < 4; ++i) { const int piece = tid + 512 * i; const int j = piece >> 5, c8 = (piece & 31) * 8; *(u32x4*)(qdl + j * 264 + c8) = rq[i]; *(u32x4*)(kdl + j * 264 + c8) = rk[i]; }
        *(u32x4*)(vl + vrow * 72 + vc8) = rv; if (tid < 256) dl[tid] = rd;
        __syncthreads();
        if (n + 1 < nch) GLA_ISSUE(n + 1);
        float oi[2][4];
#pragma unroll
        for (int q2 = 0; q2 < 2; ++q2)
#pragma unroll
            for (int r = 0; r < 4; ++r) { const int j = tt * 16 + quad * 4 + r; const size_t tok = (size_t)cidx * 64 + (dir ? 63 - j : j); oi[q2][r] = bf2f(O[tok * DM + (vb + q2) * 16 + l15]); }
        f32x4 oacc[2]; oacc[0] = (f32x4){0.f, 0.f, 0.f, 0.f}; oacc[1] = oacc[0];
#pragma unroll
        for (int ks = 0; ks < 8; ++ks) { const bf16x8 a = *(const bf16x8*)(qdl + (tt * 16 + l15) * 264 + ks * 32 + quad * 8);
#pragma unroll
            for (int q2 = 0; q2 < 2; ++q2) { const bf16x8 bfr = *(const bf16x8*)(ST + ((vb + q2) * 16 + l15) * 264 + ks * 32 + quad * 8); oacc[q2] = mfma16(a, bfr, oacc[q2]); } }
#pragma unroll
        for (int kt = 0; kt < 2; ++kt) { const f32x4 dv = *(const f32x4*)(dl + wid * 32 + kt * 16 + quad * 4);
#pragma unroll
            for (int vt = 0; vt < 4; ++vt) S[kt][vt] = S[kt][vt] * dv; }
#pragma unroll
        for (int ts = 0; ts < 2; ++ts) { bf16x8 af[2];
#pragma unroll
            for (int kt = 0; kt < 2; ++kt)
#pragma unroll
                for (int jj = 0; jj < 8; ++jj) af[kt][jj] = (short)kdl[(ts * 32 + quad * 8 + jj) * 264 + wid * 32 + kt * 16 + l15];
#pragma unroll
            for (int vt = 0; vt < 4; ++vt) { bf16x8 bfr;
#pragma unroll
                for (int jj = 0; jj < 8; ++jj) bfr[jj] = (short)vl[(ts * 32 + quad * 8 + jj) * 72 + vt * 16 + l15];
#pragma unroll
                for (int kt = 0; kt < 2; ++kt) S[kt][vt] = mfma16(af[kt], bfr, S[kt][vt]); } }
#pragma unroll
        for (int q2 = 0; q2 < 2; ++q2)
#pragma unroll
            for (int r = 0; r < 4; ++r) { const int j = tt * 16 + quad * 4 + r; const size_t tok = (size_t)cidx * 64 + (dir ? 63 - j : j); O[tok * DM + (vb + q2) * 16 + l15] = f2bf(oi[q2][r] + oacc[q2][r]); }
        __syncthreads();
        GLA_WRITE_ST();
        __syncthreads();
    }
#undef GLA_ISSUE
#undef GLA_WRITE_ST
    if (!sample) { float* so = p.out + OUT_GLAST + sbase;
#pragma unroll
        for (int kt = 0; kt < 2; ++kt)
#pragma unroll
            for (int vt = 0; vt < 4; ++vt)
#pragma unroll
                for (int r = 0; r < 4; ++r) { const int kk = wid * 32 + kt * 16 + quad * 4 + r; so[(size_t)kk * 512 + vt * 16 + l15] = S[kt][vt][r]; } }
    __syncthreads();
}
DEV void phase_gla_post(const Params& p) {
    const int tid = tidx(), wid = tid >> 6, lane = tid & 63;
    const u16* P = (const u16*)(p.ws + OFF_P); const u16* OF = (const u16*)(p.ws + OFF_OF); const u16* OB = (const u16*)(p.ws + OFF_OB); u16* ycat = (u16*)(p.ws + OFF_A);
    for (int it = blockIdx.x * 8 + wid; it < NTOK * 4; it += gridDim.x * 8) { const int tok = it >> 2, h = it & 3; const int v8 = lane * 8;
        float a[8], b[8], g[8]; unpack8(*(const u32x4*)(OF + (size_t)tok * DM + h * 512 + v8), a); unpack8(*(const u32x4*)(OB + (size_t)tok * DM + h * 512 + v8), b);
        unpack8(*(const u32x4*)(P + (size_t)tok * LDP1 + 4096 + h * 512 + v8), g);
        float ss = 0.f;
#pragma unroll
        for (int i = 0; i < 8; ++i) { a[i] += b[i]; ss += a[i] * a[i]; }
        ss = wave_sum(ss); const float sc = rsqrtf(ss * (1.f / 512.f) + 1e-6f);
        float o[8];
#pragma unroll
        for (int i = 0; i < 8; ++i) o[i] = a[i] * sc * p.in[40][v8 + i] * (g[i] * sigm(g[i]));
        u32x4 w; w.x = pk(o[0], o[1]); w.y = pk(o[2], o[3]); w.z = pk(o[4], o[5]); w.w = pk(o[6], o[7]);
        *(u32x4*)(ycat + (size_t)tok * DM + h * 512 + v8) = w; }
}

DEV void gate_loadcol(const u16* U, long tokc, int c8, bool colok, bool up, bool dn, int W, float (*dst)[8]) {
    if (colok && up) unpack8(*(const u32x4*)(U + (size_t)(tokc - W) * LDU + c8), dst[0]); else { for (int i = 0; i < 8; ++i) dst[0][i] = 0.f; }
    if (colok) unpack8(*(const u32x4*)(U + (size_t)tokc * LDU + c8), dst[1]); else { for (int i = 0; i < 8; ++i) dst[1][i] = 0.f; }
    if (colok && dn) unpack8(*(const u32x4*)(U + (size_t)(tokc + W) * LDU + c8), dst[2]); else { for (int i = 0; i < 8; ++i) dst[2][i] = 0.f; }
}
DEV void phase_ffn_gate(const Params& p, int layer) {
    u16* U = (u16*)(p.ws + OFF_U); const float* cw = p.in[11] + (size_t)layer * 9 * DFF;
    const int nunit = 768 * 704;
    for (int u = blockIdx.x * 512 + tidx(); u < nunit; u += gridDim.x * 512) {
        const int seg = u / 704, c8 = (u % 704) * 8; const int tokS = seg * 32;
        int W, colS; bool up, dn;
        if (tokS < NTP) { W = 256; colS = tokS & 255; up = false; dn = false; }
        else { W = 64; colS = tokS & 63; const int rr = ((tokS - NTP) >> 6) & 63; up = rr > 0; dn = rr < 63; }
        float wt[9][8];
#pragma unroll
        for (int q = 0; q < 9; ++q) { const float4 a = *(const float4*)(cw + q * DFF + c8), b = *(const float4*)(cw + q * DFF + c8 + 4);
            wt[q][0] = a.x; wt[q][1] = a.y; wt[q][2] = a.z; wt[q][3] = a.w; wt[q][4] = b.x; wt[q][5] = b.y; wt[q][6] = b.z; wt[q][7] = b.w; }
        float w0[3][8], w1[3][8], w2[3][8];
        gate_loadcol(U, (long)tokS - 1, c8, colS > 0, up, dn, W, w0);
        gate_loadcol(U, (long)tokS, c8, true, up, dn, W, w1);
#pragma unroll 4
        for (int s_ = 0; s_ < 32; ++s_) {
            const long tok = (long)tokS + s_;
            gate_loadcol(U, tok + 1, c8, colS + s_ + 1 < W, up, dn, W, w2);
            u16* vp = U + (size_t)tok * LDU + DFF + c8; float v[8]; unpack8(*(const u32x4*)vp, v);
#pragma unroll
            for (int i = 0; i < 8; ++i) { float a = 0.f;
#pragma unroll
                for (int di = 0; di < 3; ++di) a += w0[di][i] * wt[di * 3][i] + w1[di][i] * wt[di * 3 + 1][i] + w2[di][i] * wt[di * 3 + 2][i];
                v[i] *= a * sigm(a); }
            u32x4 w; w.x = pk(v[0], v[1]); w.y = pk(v[2], v[3]); w.z = pk(v[4], v[5]); w.w = pk(v[6], v[7]);
            *(u32x4*)vp = w;
#pragma unroll
            for (int di = 0; di < 3; ++di)
#pragma unroll
                for (int i = 0; i < 8; ++i) { w0[di][i] = w1[di][i]; w1[di][i] = w2[di][i]; }
        }
    }
}

DEV void phase_final_norm(const Params& p) {
    const int tid = tidx(), wid = tid >> 6, lane = tid & 63; const float* g = p.in[13];
    for (int row = blockIdx.x * 8 + wid; row < NTOK; row += gridDim.x * 8) {
        float4* xr = (float4*)(p.out + (size_t)row * DM);
        float4 v[8]; float ss = 0.f;
#pragma unroll
        for (int j = 0; j < 8; ++j) { v[j] = xr[lane + 64 * j]; ss += v[j].x * v[j].x + v[j].y * v[j].y + v[j].z * v[j].z + v[j].w * v[j].w; }
        ss = wave_sum(ss); const float rstd = rsqrtf(ss * (1.f / 2048.f) + 1e-6f);
#pragma unroll
        for (int j = 0; j < 8; ++j) { const float4 gg = *(const float4*)(g + (lane + 64 * j) * 4);
            xr[lane + 64 * j] = make_float4(v[j].x * rstd * gg.x, v[j].y * rstd * gg.y, v[j].z * rstd * gg.z, v[j].w * rstd * gg.w); }
    }
}


#define XB_TMO      128
#define XB_XCNT(j)  (256  + 64 * (j))
#define XB_XSUB(j)  (1280 + 64 * (j))
#define XB_XGEN(j)  (2304 + 64 * (j))
#define XB_TOP      3328
#define XB_TOPGEN   3392
#define XCD_BAR_WORDS 3456
#define XB_SPIN_CAP (1u << 18)
DEV unsigned xb_ld(unsigned* p)              { return __hip_atomic_load(p, __ATOMIC_RELAXED, __HIP_MEMORY_SCOPE_AGENT); }
DEV unsigned xb_add(unsigned* p, unsigned v) { return __hip_atomic_fetch_add(p, v, __ATOMIC_RELAXED, __HIP_MEMORY_SCOPE_AGENT); }
DEV unsigned xb_xcc_id() { return (unsigned)__builtin_amdgcn_s_getreg((3 << 11) | 20) & 0xFu; }
#define XB_SPIN(cond, bar) do { unsigned _sp = 0; while (cond) { __builtin_amdgcn_s_sleep(1); \
    if ((++_sp & 255u) == 0u) { if (xb_ld(&(bar)[XB_TMO])) break; if (_sp > XB_SPIN_CAP) { atomicAdd(&(bar)[XB_TMO], 1u); break; } } } } while (0)
struct XcdBarrier { unsigned* bar; unsigned x; volatile LAS unsigned* st; };
DEV XcdBarrier xcd_barrier_post(unsigned* bar, volatile LAS unsigned* st) {
    XcdBarrier b; b.bar = bar; b.x = xb_xcc_id(); b.st = st;
    if (threadIdx.x == 0) (void)xb_add(&bar[XB_XCNT(b.x)], 1u);
    return b;
}
DEV void xcd_barrier_complete(unsigned* bar, unsigned x, unsigned& nloc, unsigned& nx) {
    const unsigned G = gridDim.x * gridDim.y * gridDim.z;
    unsigned sum, cnt, mine, sp = 0u;
    for (;;) {
        sum = 0u; cnt = 0u; mine = 0u;
#pragma unroll
        for (unsigned j = 0; j < 16; ++j) { const unsigned c = xb_ld(&bar[XB_XCNT(j)]); sum += c; cnt += (c > 0u) ? 1u : 0u; mine = (j == x) ? c : mine; }
        if (sum == G) break;
        __builtin_amdgcn_s_sleep(1);
        if ((++sp & 255u) == 0u) { if (xb_ld(&bar[XB_TMO])) break; if (sp > XB_SPIN_CAP) { atomicAdd(&bar[XB_TMO], 1u); break; } }
    }
    nloc = mine > 0u ? mine : 1u; nx = cnt > 0u ? cnt : 1u;
}
DEV void xcd_barrier(const XcdBarrier& b) {
    asm volatile("s_waitcnt vmcnt(0)" ::: "memory");
    __syncthreads();
    if (threadIdx.x == 0) {
        unsigned* bar = b.bar;
        __builtin_amdgcn_s_waitcnt(0);
        unsigned nloc = b.st[0], nx = b.st[1];
        if (nloc == 0u) { xcd_barrier_complete(bar, b.x, nloc, nx); b.st[0] = nloc; b.st[1] = nx; }
        const unsigned old = xb_add(&bar[XB_XSUB(b.x)], 1u);
        const unsigned gen = old / nloc;
        if (old + 1u == (gen + 1u) * nloc) {
            __builtin_amdgcn_fence(__ATOMIC_RELEASE, "agent");
            asm volatile("s_waitcnt vmcnt(0)" ::: "memory");
            const unsigned og = xb_add(&bar[XB_TOP], 1u);
            const unsigned tg = og / nx;
            if (og + 1u == (tg + 1u) * nx) xb_add(&bar[XB_TOPGEN], 1u);
            else XB_SPIN(xb_ld(&bar[XB_TOPGEN]) == tg, bar);
            __builtin_amdgcn_fence(__ATOMIC_ACQUIRE, "agent");
            xb_add(&bar[XB_XGEN(b.x)], 1u);
            asm volatile("s_waitcnt vmcnt(0)" ::: "memory");
        } else {
            XB_SPIN(xb_ld(&bar[XB_XGEN(b.x)]) == gen, bar);
            __builtin_amdgcn_fence(__ATOMIC_ACQUIRE, "agent");
            asm volatile("s_waitcnt vmcnt(0)" ::: "memory");
        }
    }
    __syncthreads();
}

__global__ void __launch_bounds__(512, 2) mega(Params p0) {
    extern __shared__ __attribute__((aligned(16))) unsigned char shm[];
    cg::grid_group grid = cg::this_grid();
    __shared__ uint4 xb_words;
    if (threadIdx.x == 0) xb_words = make_uint4(0u, 0u, 0u, 0u);
    __syncthreads();
    (void)xcd_barrier_post((unsigned*)(p0.ws + OFF_SMALL + SMALL_BYTES + 256), (volatile LAS unsigned*)&xb_words);
#define XBAR() do { XcdBarrier xb_; xb_.bar = (unsigned*)(launder(p0).ws + OFF_SMALL + SMALL_BYTES + 256); xb_.x = xb_xcc_id(); xb_.st = (volatile LAS unsigned*)&xb_words; xcd_barrier(xb_); } while (0)
    float* sm = (float*)shm;
    const int G = (int)gridDim.x, B = (int)blockIdx.x;

#ifndef SK_PREP
    phase_prep(launder(p0), shm);
#ifdef PROBE_MISC
    __syncthreads(); phase_prep(launder(p0), shm);
#endif
#endif
    grid.sync();
    phase_reduce(launder(p0));
    XBAR();
#pragma unroll 1
    for (int layer = 0; layer < 2; ++layer) {
#ifndef SK_NORM
        phase_norm(launder(p0), layer, 0, shm);
#ifdef PROBE_MISC
        __syncthreads(); phase_norm(launder(p0), layer, 0, shm);
#endif
#endif
        XBAR();
        { const Params p = launder(p0); const u16* A = (const u16*)(p.ws + OFF_A); pg8::EpiBf16 E; E.O = (u16*)(p.ws + OFF_P); E.ldc = layer ? LDP1 : LDP0;
#if !defined(SK_GEMM) && !defined(SK_GBF)
            run_gemm(shm, A, DM, (const u16*)(p.ws + OFF_WIN), DM, layer ? LDP1 : LDP0, DM, E);
#ifdef PROBE_GEMM
            __syncthreads(); run_gemm(shm, A, DM, (const u16*)(p.ws + OFF_WIN), DM, layer ? LDP1 : LDP0, DM, E);
#endif
#endif
        }
        XBAR();
        if (layer == 0) {
#ifndef SK_PRE
            { const Params p = launder(p0); for (int t = B; t < 6144 + 768; t += G) { if (t < 6144) hy_pre_tile(p, t, sm); else rwkv_lora_tile(p, t - 6144, sm); } }
#ifdef PROBE_MISC
            { const Params p = launder(p0); for (int t = B; t < 6144 + 768; t += G) { if (t < 6144) hy_pre_tile(p, t, sm); else rwkv_lora_tile(p, t - 6144, sm); } }
#endif
#endif
            XBAR();
#ifndef SK_RSCAN
            { const Params p = launder(p0);
            if (B < 128) rwkv_scan_task(p, B, sm);
            else if (G > 128) { for (int j = B - 128; j < 1024; j += G - 128) rwkv_scan_task(p, 128 + j, sm); }
            if (G <= 128) { for (int j = B; j < 1024; j += G) rwkv_scan_task(p, 128 + j, sm); }
#ifdef PROBE_RSCAN
            if (B < 128) rwkv_scan_task(p, B, sm);
            else if (G > 128) { for (int j = B - 128; j < 1024; j += G - 128) rwkv_scan_task(p, 128 + j, sm); }
#endif
            }
#endif
#ifndef SK_HCONV
            { const Params p = launder(p0); unsigned* ctr = (unsigned*)(p.ws + OFF_SMALL + SMALL_BYTES);
                for (;;) { if (tidx() == 0) *(volatile unsigned*)shm = atomicAdd(ctr, 1u); __syncthreads(); const unsigned t = *(volatile unsigned*)shm; __syncthreads(); if (t >= 2048u) break; hyconv_task(p, (int)t, shm); } }
#endif
            XBAR();
#ifndef SK_POST
            { const Params p = launder(p0); for (int t = B; t < 6144 + 1536; t += G) { if (t < 6144) hy_post_tile(p, t, sm); else rwkv_post_tile(p, t - 6144, sm); } }
#ifdef PROBE_MISC
            { const Params p = launder(p0); for (int t = B; t < 6144 + 1536; t += G) { if (t < 6144) hy_post_tile(p, t, sm); else rwkv_post_tile(p, t - 6144, sm); } }
#endif
#endif
            XBAR();
        } else {
#ifndef SK_GLA
            { const Params p = launder(p0); for (int t = B; t < 1536; t += G) gla_intra_task(p, t, shm); }
            XBAR();
            { const Params p = launder(p0); for (int t = B; t < 256 + 2048; t += G) gla_inter_task(p, t, shm); }
#endif
            XBAR();
#ifndef SK_GLAP
            phase_gla_post(launder(p0));
#ifdef PROBE_MISC
            phase_gla_post(launder(p0));
#endif
#endif
            XBAR();
        }
        { const Params p = launder(p0); const u16* A = (const u16*)(p.ws + OFF_A); const float* mods = (const float*)(p.ws + OFF_SMALL); pg8::EpiRes E; E.X = p.out; E.gm = mods + (size_t)layer * 5 * 12288 + 2 * 2048; E.gb = p.in[7] + layer * 12288 + 2 * 2048;
#if !defined(SK_GEMM) && !defined(SK_GRES)
            run_gemm(shm, A, DM, (const u16*)(p.ws + OFF_WOUT), DM, DM, DM, E);
#endif
        }
        XBAR();
#ifndef SK_NORM
        phase_norm(launder(p0), layer, 1, shm);
#ifdef PROBE_MISC
        __syncthreads(); phase_norm(launder(p0), layer, 1, shm);
#endif
#endif
        XBAR();
        { const Params p = launder(p0); const u16* A = (const u16*)(p.ws + OFF_A); pg8::EpiBf16 E; E.O = (u16*)(p.ws + OFF_U); E.ldc = LDU;
#if !defined(SK_GEMM) && !defined(SK_GBF)
            run_gemm(shm, A, DM, (const u16*)(p.ws + OFF_WUP), DM, LDU, DM, E);
#ifdef PROBE_GEMM
            __syncthreads(); run_gemm(shm, A, DM, (const u16*)(p.ws + OFF_WUP), DM, LDU, DM, E);
#endif
#endif
        }
        XBAR();
#ifndef SK_GATE
        phase_ffn_gate(launder(p0), layer);
#endif
        XBAR();
        { const Params p = launder(p0); const float* mods = (const float*)(p.ws + OFF_SMALL); pg8::EpiRes E; E.X = p.out; E.gm = mods + (size_t)layer * 5 * 12288 + 5 * 2048; E.gb = p.in[7] + layer * 12288 + 5 * 2048;
#if !defined(SK_GEMM) && !defined(SK_GRES)
            run_gemm(shm, (const u16*)(p.ws + OFF_U) + DFF, LDU, (const u16*)(p.ws + OFF_WDN), DFF, DM, DFF, E);
#endif
        }
        XBAR();
    }
    phase_final_norm(launder(p0));
}

extern "C" void kernel_launch(void* const* d_in, const int* in_sizes, int n_in, void* d_out, int out_size, void* d_ws, size_t ws_size, hipStream_t stream) {
    constexpr size_t kDynLds = 131072;
    static int grid_blocks = 0;
    if (!grid_blocks) {
        int dev = 0, cus = 0, per_cu = 0;
        hipGetDevice(&dev);
        hipDeviceGetAttribute(&cus, hipDeviceAttributeMultiprocessorCount, dev);
        hipFuncSetAttribute((const void*)mega, hipFuncAttributeMaxDynamicSharedMemorySize, (int)kDynLds);
        hipOccupancyMaxActiveBlocksPerMultiprocessor(&per_cu, mega, 512, kDynLds);
        if (per_cu < 1) per_cu = 1;
        grid_blocks = cus * per_cu;
        if (grid_blocks > 256) grid_blocks = 256;
    }
    if (ws_size < WS_NEED || n_in < 41) { fprintf(stderr, "workspace too small: %zu < %zu\n", ws_size, WS_NEED); return; }
    Params p{};
    for (int i = 0; i < 41; ++i) p.in[i] = (const float*)d_in[i];
    p.out = (float*)d_out; p.ws = (unsigned char*)d_ws;
    hipMemsetAsync((unsigned char*)d_ws + OFF_SMALL + SMALL_BYTES, 0, 256 + XCD_BAR_BYTES, stream);
    void* args[] = {&p};
    hipError_t e = hipLaunchCooperativeKernel((const void*)mega, dim3(grid_blocks), dim3(512), args, kDynLds, stream);
    if (e != hipSuccess) fprintf(stderr, "cooperative launch failed: %s (grid %d)\n", hipGetErrorString(e), grid_blocks);
}
```

```cpp
#include <hip/hip_runtime.h>
#include <hip/hip_cooperative_groups.h>
#include <cstdio>
namespace cg = cooperative_groups;

#define DEV __device__ __forceinline__
#define LAS __attribute__((address_space(3)))
typedef unsigned short u16;
typedef short bf16x8 __attribute__((ext_vector_type(8)));
typedef float f32x4 __attribute__((ext_vector_type(4)));
typedef float f32x16 __attribute__((ext_vector_type(16)));
typedef unsigned u32x2 __attribute__((ext_vector_type(2)));
typedef unsigned u32x4 __attribute__((ext_vector_type(4)));

constexpr int NTOK = 24576, NTP = 8192, DM = 2048;
constexpr int LDP0 = 6656, LDP1 = 6400, LDU = 11264, DFF = 5632;
constexpr size_t OFF_WIN = 0, OFF_WOUT = 27262976, OFF_WUP = 35651584, OFF_WDN = OFF_WUP + 46137344;
constexpr size_t OFF_A = 104857600, OFF_BIG = 205520896;
constexpr size_t OFF_P = OFF_BIG, OFF_RW = OFF_BIG + 327155712, OFF_UT = OFF_RW + 201326592, OFF_GS = OFF_UT + 50331648, OFF_GP = OFF_GS + 16777216;
constexpr size_t OFF_U = OFF_BIG, OFF_OF = OFF_BIG + 314572800, OFF_OB = OFF_OF + 100663296, OFF_DB = OFF_OB + 100663296;
constexpr size_t OFF_SMALL = OFF_BIG + 600000000, SMALL_BYTES = 491520 + 8192;
constexpr size_t XCD_BAR_BYTES = 3456 * 4;
constexpr size_t OFF_LW = OFF_SMALL + SMALL_BYTES + 256 + XCD_BAR_BYTES;
constexpr size_t OFF_G2T = OFF_LW + 524288;
constexpr size_t WS_NEED = OFF_G2T + 262144;
constexpr size_t OUT_RWST = 50331648, OUT_GLAST = 54525952;

struct Params {
    const float* in[41];
    float* out;
    unsigned char* ws;
};

DEV int tidx() { int t = threadIdx.x; asm volatile("" : "+v"(t)); return t; }
DEV Params launder(const Params& p) { Params q = p; asm volatile("" : "+s"(q.ws), "+s"(q.out)); return q; }
DEV float bf2f(unsigned b) { return __uint_as_float(b << 16); }
DEV float bflo(unsigned w) { return __uint_as_float(w << 16); }
DEV float bfhi(unsigned w) { return __uint_as_float(w & 0xffff0000u); }
DEV unsigned pk(float lo, float hi) { unsigned r; asm("v_cvt_pk_bf16_f32 %0, %1, %2" : "=v"(r) : "v"(lo), "v"(hi)); return r; }
DEV u16 f2bf(float f) { return (u16)(pk(f, 0.f) & 0xffffu); }
DEV float wave_sum(float v) {
#pragma unroll
    for (int o = 32; o > 0; o >>= 1) v += __shfl_xor(v, o);
    return v;
}
template <int CTRL> DEV float dppf(float x) { return __builtin_bit_cast(float, __builtin_amdgcn_update_dpp(0, __builtin_bit_cast(int, x), CTRL, 0xf, 0xf, true)); }
DEV float sum8(float v) { v += dppf<0xB1>(v); v += dppf<0x4E>(v); v += dppf<0x141>(v); return v; }
DEV float sum16(float v) { v = sum8(v); v += dppf<0x140>(v); return v; }
DEV f32x4 mfma16(bf16x8 a, bf16x8 b, f32x4 c) { return __builtin_amdgcn_mfma_f32_16x16x32_bf16(a, b, c, 0, 0, 0); }
DEV float sigm(float x) { return 1.f / (1.f + __expf(-x)); }
DEV int tok_cond(int tok) { return tok < NTP ? 4 : ((tok - NTP) >> 12); }
DEV void tok_tl(int tok, int& t, int& L) { if (tok < NTP) { t = tok & 255; L = 256; } else { t = (tok - NTP) & 4095; L = 4096; } }
DEV void unpack8(u32x4 w, float* o) { o[0] = bflo(w.x); o[1] = bfhi(w.x); o[2] = bflo(w.y); o[3] = bfhi(w.y); o[4] = bflo(w.z); o[5] = bfhi(w.z); o[6] = bflo(w.w); o[7] = bfhi(w.w); }
DEV void unpack4(u32x2 w, float* o) { o[0] = bflo(w.x); o[1] = bfhi(w.x); o[2] = bflo(w.y); o[3] = bfhi(w.y); }

namespace pg8 {
constexpr int BM = 256, BK = 64, HALF = 128, HTB = HALF * BK * 2, NXCD = 8, WGM = 8;
DEV int lds_byte(int r, int c) { const int st = (r >> 4) * 2 + (c >> 5), rr = r & 15, cc = c & 31, ob = rr * 64 + cc * 2; return st * 1024 + (ob ^ (((ob >> 9) & 1) << 5)); }
DEV void stage_rc(int b, int& R, int& C) { const int st = b / 1024, sb = b % 1024, swz = sb ^ (((sb >> 9) & 1) << 5); R = (st >> 1) * 16 + swz / 64; C = (st & 1) * 32 + (swz % 64) / 2; }
DEV int perm32(int rho) { const int n = rho >> 4, i = rho & 15; return 8 * (i >> 2) + 4 * n + (i & 3); }
struct Unit { int pm, pn; };
struct Gemm { const u16* A; const u16* Bt; int M, N, K, lda, ldb; };
struct StaticOrder {
    int nM, nN, nwg, G, c;
    DEV void init(int M, int N, int G_, int c_) { nM = M / BM; nN = N / BM; nwg = nM * nN; G = G_; c = c_; }
    DEV bool next(int i, Unit& u) const {
        const long L = (long)i * G + c; if (L >= nwg) return false;
        int wgid = (int)L; { const int q = nwg / NXCD, r = nwg % NXCD, xcd = wgid % NXCD, off = wgid / NXCD; wgid = (xcd < r ? xcd * (q + 1) : r * (q + 1) + (xcd - r) * q) + off; }
        const int nig = WGM * nN, gid = wgid / nig, fm = gid * WGM, gsz = (nM - fm) < WGM ? (nM - fm) : WGM;
        u.pm = fm + ((wgid % nig) % gsz); u.pn = (wgid % nig) / gsz; return true;
    }
};
struct EpiBf16 {
    static constexpr bool PERM = true;
    u16* O; int ldc;
    DEV void operator()(const f32x4 (&acc)[2][2][4][2], const Unit& u, int wr, int wc, int fr, int fq) const {
        const int row0 = u.pm * BM + wr * 64 + fr; const int col0 = u.pn * BM + wc * 32 + 8 * fq;
#pragma unroll
        for (int ai = 0; ai < 2; ++ai)
#pragma unroll
            for (int m = 0; m < 4; ++m) { u16* rowp = O + (size_t)(row0 + ai * HALF + m * 16) * ldc + col0;
#pragma unroll
                for (int bj = 0; bj < 2; ++bj) { const f32x4 v0 = acc[ai][bj][m][0], v1 = acc[ai][bj][m][1];
                    u32x4 w; w.x = pk(v0[0], v0[1]); w.y = pk(v0[2], v0[3]); w.z = pk(v1[0], v1[1]); w.w = pk(v1[2], v1[3]);
                    *(u32x4*)(rowp + bj * HALF) = w; } }
    }
};
struct EpiRes {
    static constexpr bool PERM = false;
    float* X; const float* gm; const float* gb;
    DEV void operator()(const f32x4 (&acc)[2][2][4][2], const Unit& u, int wr, int wc, int fr, int fq) const {
        const int row0 = u.pm * BM + wr * 64 + fr, col0 = u.pn * BM + wc * 32 + 4 * fq;
        const int cond = u.pm < 32 ? 4 : ((u.pm - 32) >> 4);
        const float* gmc = gm + (size_t)cond * 12288 + col0; const float* gbc = gb + col0;
#pragma unroll
        for (int ai = 0; ai < 2; ++ai)
#pragma unroll
            for (int m = 0; m < 4; ++m) { float* rowp = X + (size_t)(row0 + ai * HALF + m * 16) * DM + col0;
#pragma unroll
                for (int bj = 0; bj < 2; ++bj) {
#pragma unroll
                    for (int n = 0; n < 2; ++n) { f32x4* q = (f32x4*)(rowp + bj * HALF + n * 16);
                        const f32x4 gvv = *(const f32x4*)(gmc + bj * HALF + n * 16) + *(const f32x4*)(gbc + bj * HALF + n * 16);
                        *q = *q + gvv * acc[ai][bj][m][n]; }
                    asm volatile("" ::: "memory"); } }
    }
};

template <class Epi>
DEV void gemm_phase(LAS unsigned char* lds, const Gemm g, const StaticOrder& S, const Epi& E) {
    const int tid = tidx(), wid = __builtin_amdgcn_readfirstlane(tid >> 6), lane = tid & 63, wr = wid >> 2, wc = wid & 3, fr = lane & 15, fq = lane >> 4;
    const int K = g.K, nt = K / BK;
    unsigned voffA[2], voffB[2];
#pragma unroll
    for (int i = 0; i < 2; ++i) { int R, C; stage_rc(tid * 16 + i * 8192, R, C); const int Rb = Epi::PERM ? ((R & ~31) + perm32(R & 31)) : R;
        voffA[i] = (unsigned)(R * g.lda + C) * 2u; voffB[i] = (unsigned)(Rb * g.ldb + C) * 2u; }
    const size_t kstep = (size_t)(BK * 2);
    const size_t hstepA = (size_t)HALF * g.lda * 2, hstepB = (size_t)HALF * g.ldb * 2;
    const size_t tstepA = 2 * hstepA, tstepB = 2 * hstepB;
    const unsigned ldsw = (unsigned)wid * 1024u;
    const int aoff = lds_byte(wr * 64 + fr, fq * 8), boff = lds_byte(wc * 32 + fr, fq * 8);
#define PG8_SA(b, h) (((b) * 2 + (h)) * HTB)
#define PG8_SB(b, h) ((4 + (b) * 2 + (h)) * HTB)
#define PG8_STAGE(bufoff, gbase, voff) do { _Pragma("unroll") for (int _i = 0; _i < 2; ++_i) \
        __builtin_amdgcn_global_load_lds((const unsigned*)((const char*)(gbase) + (voff)[_i]), (LAS unsigned*)(lds + (bufoff) + ldsw + _i * 8192), 16, 0, 0); } while (0)
#define PG8_LDA(dst, b, h) do { _Pragma("unroll") for (int m = 0; m < 4; ++m) _Pragma("unroll") for (int k = 0; k < 2; ++k) dst[m][k] = *(const LAS bf16x8*)(lds + PG8_SA(b, h) + aoff + m * 2048 + k * 1024); } while (0)
#define PG8_LDB(dst, b, h) do { _Pragma("unroll") for (int n = 0; n < 2; ++n) _Pragma("unroll") for (int k = 0; k < 2; ++k) dst[n][k] = *(const LAS bf16x8*)(lds + PG8_SB(b, h) + boff + n * 2048 + k * 1024); } while (0)
#define PG8_MMA(ai, bj, At, Bt) do { __builtin_amdgcn_s_setprio(1); _Pragma("unroll") for (int m = 0; m < 4; ++m) _Pragma("unroll") for (int n = 0; n < 2; ++n) _Pragma("unroll") for (int k = 0; k < 2; ++k) \
        acc[ai][bj][m][n] = __builtin_amdgcn_mfma_f32_16x16x32_bf16(Bt[n][k], At[m][k], acc[ai][bj][m][n], 0, 0, 0); __builtin_amdgcn_s_setprio(0); } while (0)
#define PG8_WAIT_V(n) asm volatile("s_waitcnt vmcnt(" #n ")" ::: "memory")
#define PG8_WAIT_L(n) asm volatile("s_waitcnt lgkmcnt(" #n ")" ::: "memory")
#define PG8_BAR __builtin_amdgcn_s_barrier()
#define PG8_SCHED __builtin_amdgcn_sched_barrier(0)
    Unit cur, nxt; int ui = 0;
    if (!S.next(0, cur)) return;
    f32x4 acc[2][2][4][2];
#pragma unroll
    for (int a = 0; a < 2; ++a)
#pragma unroll
        for (int b = 0; b < 2; ++b)
#pragma unroll
            for (int m = 0; m < 4; ++m)
#pragma unroll
                for (int n = 0; n < 2; ++n) acc[a][b][m][n] = (f32x4){0.f, 0.f, 0.f, 0.f};
    bf16x8 At[4][2], B0[2][2], B1[2][2];
    const char* cA = (const char*)g.A + (size_t)cur.pm * tstepA; const char* cB = (const char*)g.Bt + (size_t)cur.pn * tstepB;
    PG8_STAGE(PG8_SB(0, 0), cB, voffB); PG8_STAGE(PG8_SA(0, 0), cA, voffA); PG8_STAGE(PG8_SB(0, 1), cB + hstepB, voffB); PG8_STAGE(PG8_SA(0, 1), cA + hstepA, voffA);
    if (wr == 1) PG8_BAR;
    PG8_WAIT_V(4); PG8_BAR;
    PG8_STAGE(PG8_SB(1, 0), cB + kstep, voffB); PG8_STAGE(PG8_SA(1, 0), cA + kstep, voffA); PG8_STAGE(PG8_SB(1, 1), cB + hstepB + kstep, voffB);
    PG8_WAIT_V(6); PG8_BAR;
    for (;;) {
        const bool has_next = S.next(ui + 1, nxt);
        const char* nA = has_next ? (const char*)g.A + (size_t)nxt.pm * tstepA : cA; const char* nB = has_next ? (const char*)g.Bt + (size_t)nxt.pn * tstepB : cB;
        for (int t = 0; t < nt; t += 2) {
            const bool last = (t == nt - 2);
            const char* a1 = cA + (size_t)(t + 1) * kstep;
            const char* a2 = last ? nA : cA + (size_t)(t + 2) * kstep; const char* b2 = last ? nB : cB + (size_t)(t + 2) * kstep;
            const char* a3 = a2 + kstep; const char* b3 = b2 + kstep;
            PG8_LDB(B0, 0, 0); PG8_SCHED; PG8_LDA(At, 0, 0); PG8_STAGE(PG8_SA(1, 1), a1 + hstepA, voffA);
            PG8_WAIT_L(8); PG8_BAR; PG8_WAIT_L(0); PG8_MMA(0, 0, At, B0); PG8_BAR; PG8_SCHED;
            PG8_LDB(B1, 0, 1); PG8_STAGE(PG8_SB(0, 0), b2, voffB);
            PG8_BAR; PG8_WAIT_L(0); PG8_MMA(0, 1, At, B1); PG8_BAR;
            PG8_LDA(At, 0, 1); PG8_STAGE(PG8_SA(0, 0), a2, voffA);
            PG8_BAR; PG8_WAIT_L(0); PG8_MMA(1, 0, At, B0); PG8_BAR; PG8_SCHED;
            PG8_STAGE(PG8_SB(0, 1), b2 + hstepB, voffB);
            PG8_WAIT_V(6); PG8_BAR; PG8_MMA(1, 1, At, B1); PG8_BAR;
            PG8_LDB(B0, 1, 0); PG8_SCHED; PG8_LDA(At, 1, 0); PG8_STAGE(PG8_SA(0, 1), a2 + hstepA, voffA);
            PG8_WAIT_L(8); PG8_BAR; PG8_WAIT_L(0); PG8_MMA(0, 0, At, B0); PG8_BAR; PG8_SCHED;
            PG8_LDB(B1, 1, 1); PG8_STAGE(PG8_SB(1, 0), b3, voffB);
            PG8_BAR; PG8_WAIT_L(0); PG8_MMA(0, 1, At, B1); PG8_BAR;
            PG8_LDA(At, 1, 1); PG8_STAGE(PG8_SA(1, 0), a3, voffA);
            PG8_BAR; PG8_WAIT_L(0); PG8_MMA(1, 0, At, B0); PG8_BAR; PG8_SCHED;
            PG8_STAGE(PG8_SB(1, 1), b3 + hstepB, voffB);
            PG8_WAIT_V(6); PG8_BAR; PG8_MMA(1, 1, At, B1); PG8_BAR;
        }
        E(acc, cur, wr, wc, fr, fq);
        if (!has_next) break;
#pragma unroll
        for (int a = 0; a < 2; ++a)
#pragma unroll
            for (int b = 0; b < 2; ++b)
#pragma unroll
                for (int m = 0; m < 4; ++m)
#pragma unroll
                    for (int n = 0; n < 2; ++n) acc[a][b][m][n] = (f32x4){0.f, 0.f, 0.f, 0.f};
        cur = nxt; cA = nA; cB = nB; ++ui;
    }
    PG8_WAIT_V(0);
    if (wr == 0) PG8_BAR;
    PG8_BAR;
#undef PG8_SA
#undef PG8_SB
#undef PG8_STAGE
#undef PG8_LDA
#undef PG8_LDB
#undef PG8_MMA
#undef PG8_WAIT_V
#undef PG8_WAIT_L
#undef PG8_BAR
#undef PG8_SCHED
}
}

template <class Epi>
DEV void run_gemm(unsigned char* shm, const u16* A, int lda, const u16* Bt, int ldb, int N, int K, const Epi& E) {
    asm volatile("" : "+s"(A), "+s"(Bt));
    pg8::Gemm g; g.A = A; g.Bt = Bt; g.M = NTOK; g.N = N; g.K = K; g.lda = lda; g.ldb = ldb;
    pg8::StaticOrder S; S.init(NTOK, N, (int)gridDim.x, (int)blockIdx.x);
    pg8::gemm_phase<Epi>((LAS unsigned char*)shm, g, S, E);
}

DEV void convT_tile(const float* __restrict__ src, u16* __restrict__ dst, int K, int N, int Npad, int tile, float* T) {
    const int tid = tidx(); const int ntn = Npad >> 6; const int k0 = (tile / ntn) << 6, n0 = (tile % ntn) << 6;
#pragma unroll
    for (int j = 0; j < 2; ++j) { const int idx = tid + j * 512; const int r = idx >> 4, c4 = (idx & 15) << 2;
        float4 v = make_float4(0.f, 0.f, 0.f, 0.f); if (n0 + c4 < N) v = *(const float4*)(src + (size_t)(k0 + r) * N + n0 + c4);
        float* t = T + r * 65 + c4; t[0] = v.x; t[1] = v.y; t[2] = v.z; t[3] = v.w; }
    __syncthreads();
    { const int nn = tid >> 3, kq = (tid & 7) << 3; const float* t = T + kq * 65 + nn;
        u32x4 o; o.x = pk(t[0], t[65]); o.y = pk(t[130], t[195]); o.z = pk(t[260], t[325]); o.w = pk(t[390], t[455]);
        *(u32x4*)(dst + (size_t)(n0 + nn) * K + k0 + kq) = o; }
    __syncthreads();
}
DEV int conv_ntiles(int job, int layer) { return job == 0 ? (layer ? 3200 : 3328) : job == 1 ? 1024 : job == 2 ? 5632 : 2816; }
DEV void conv_job(const Params& p, int job, int layer, int tile, float* T) {
    if (job == 0) convT_tile(layer ? p.in[36] : p.in[14], (u16*)(p.ws + OFF_WIN), 2048, layer ? 6176 : 6528, layer ? LDP1 : LDP0, tile, T);
    else if (job == 1) convT_tile(layer ? p.in[37] : p.in[15], (u16*)(p.ws + OFF_WOUT), 2048, 2048, 2048, tile, T);
    else if (job == 2) convT_tile(p.in[10] + (size_t)layer * 2048 * 11264, (u16*)(p.ws + OFF_WUP), 2048, 11264, 11264, tile, T);
    else convT_tile(p.in[12] + (size_t)layer * 5632 * 2048, (u16*)(p.ws + OFF_WDN), 5632, 2048, 2048, tile, T);
}

DEV void adaln_tile(const Params& p, int tile, float* sl) {
    const int tid = tidx(); const int nt = tile % 6, kc = (tile / 6) & 31, layer = tile / 192;
    if (tid < 320) { const int j = tid >> 6, kk = tid & 63; const float cv = (j < 4) ? p.in[4][j * 2048 + kc * 64 + kk] : p.in[5][kc * 64 + kk]; sl[tid] = cv / (1.f + expf(-cv)); }
    __syncthreads();
    const float* w = p.in[6] + ((size_t)layer * 2048 + kc * 64) * 12288 + nt * 2048 + tid * 4;
    float acc[5][4];
#pragma unroll
    for (int j = 0; j < 5; ++j) { acc[j][0] = 0.f; acc[j][1] = 0.f; acc[j][2] = 0.f; acc[j][3] = 0.f; }
#pragma unroll 8
    for (int kk = 0; kk < 64; ++kk) { const float4 wv = *(const float4*)(w + (size_t)kk * 12288);
#pragma unroll
        for (int j = 0; j < 5; ++j) { const float s = sl[j * 64 + kk]; acc[j][0] += s * wv.x; acc[j][1] += s * wv.y; acc[j][2] += s * wv.z; acc[j][3] += s * wv.w; } }
    float* m = (float*)(p.ws + OFF_A) + (size_t)kc * 122880 + (size_t)layer * 5 * 12288 + nt * 2048 + tid * 4;
#pragma unroll
    for (int j = 0; j < 5; ++j) *(float4*)(m + j * 12288) = make_float4(acc[j][0], acc[j][1], acc[j][2], acc[j][3]);
    __syncthreads();
}

DEV void hyfilt_tile(const Params& p, int tile, float* sm) {
    const int tid = tidx();
    int L, p0; u16* G; float* nrm = (float*)(p.ws + OFF_A) + 32 * 122880 + (size_t)tile * 2048;
    if (tile < 128) { L = 4096; p0 = tile * 32; G = (u16*)(p.ws + OFF_GS); }
    else { L = 256; p0 = (tile - 128) * 32; G = (u16*)(p.ws + OFF_GP); }
    float* z = sm; float* h1 = sm + 32 * 33; float* h2 = h1 + 2048;
    const float cang = (float)(6.283185307179586 / (double)L);
    for (int i = tid; i < 32 * 33; i += 512) { const int pp = i / 33, e = i % 33; const float pos = (float)(p0 + pp); float val;
        if (e == 0) val = pos / (float)(L - 1);
        else { const int bi = (e - 1) & 15; const float fb = 1e-4f + (float)bi * ((15.f - 1e-4f) / 15.f); const float ang = (cang * pos) * fb; val = (e <= 16) ? cosf(ang) : -sinf(ang); }
        z[i] = val; }
    __syncthreads();
    for (int i = tid; i < 2048; i += 512) { const int pp = i >> 6, j = i & 63; float a = p.in[19][j];
        for (int e = 0; e < 33; ++e) a += z[pp * 33 + e] * p.in[18][e * 64 + j];
        h1[i] = sinf(p.in[23][j] * a); }
    __syncthreads();
    for (int i = tid; i < 2048; i += 512) { const int pp = i >> 6, j = i & 63; float a = p.in[21][j];
        for (int e = 0; e < 64; ++e) a += h1[pp * 64 + e] * p.in[20][e * 64 + j];
        h2[i] = sinf(p.in[23][64 + j] * a); }
    __syncthreads();
    const float dlo = 3.0701134573253946f, dhi = 15.350567286626973f;
    for (int q = 0; q < 4; ++q) { const int n = tid + 512 * q; const int c = n & 1023; const int back = n >> 10;
        float wcol[64];
#pragma unroll
        for (int e = 0; e < 64; ++e) wcol[e] = p.in[22][e * 2048 + n];
        const float delta = dlo + (dhi - dlo) * ((float)c / 1023.f);
        float asum = 0.f;
        for (int pp = 0; pp < 32; ++pp) { float a = 0.f;
#pragma unroll
            for (int e = 0; e < 64; ++e) a += h2[pp * 64 + e] * wcol[e];
            const int pos = p0 + pp; const float t = (float)pos / (float)(L - 1); a *= expf(-t * delta);
            if (!(back && pos == 0)) { asum += fabsf(a); const int lag = back ? -pos : pos; G[(size_t)c * (2 * L) + (L - lag)] = f2bf(a); } }
        nrm[n] = asum; }
    if (p0 == 0) for (int c = tid; c < 1024; c += 512) G[(size_t)c * (2 * L)] = 0;
    __syncthreads();
}

DEV void phase_prep(const Params& p, unsigned char* shm) {
    const int tid = tidx(); float* sm = (float*)shm;
    { const float4* xp = (const float4*)p.in[0]; const float4* xs = (const float4*)p.in[1]; float4* X = (float4*)p.out;
        const size_t n1 = 16777216 / 4, n = 50331648 / 4;
        for (size_t i = (size_t)blockIdx.x * 512 + tid; i < n; i += (size_t)gridDim.x * 512) X[i] = i < n1 ? xp[i] : xs[i - n1]; }
    if (blockIdx.x == 0 && tid == 0) *(unsigned*)(p.ws + OFF_SMALL + SMALL_BYTES) = 0u;
    { u16* LW = (u16*)(p.ws + OFF_LW); u16* G2T = (u16*)(p.ws + OFF_G2T);
        for (int i = blockIdx.x * 512 + tid; i < 4 * 1024 * 64 + 1024 * 128; i += gridDim.x * 512) {
            if (i < 262144) { const int mi = i >> 16, n = (i >> 6) & 1023, r = i & 63; LW[i] = f2bf((mi < 2 ? p.in[27] : p.in[29])[((size_t)(mi & 1) * 64 + r) * 1024 + n]); }
            else { const int j = i - 262144; const int n = j >> 7, r = j & 127; G2T[j] = f2bf(p.in[30][(size_t)r * 1024 + n]); } } }
    const int n0 = 136, n1 = n0 + 384, n2 = n1 + 3328, n3 = n2 + 1024, n4 = n3 + 5632, n5 = n4 + 2816;
    for (int t = blockIdx.x; t < n5; t += gridDim.x) {
        if (t < n0) hyfilt_tile(p, t, sm);
        else if (t < n1) adaln_tile(p, t - n0, sm);
        else if (t < n2) conv_job(p, 0, 0, t - n1, sm);
        else if (t < n3) conv_job(p, 1, 0, t - n2, sm);
        else if (t < n4) conv_job(p, 2, 0, t - n3, sm);
        else conv_job(p, 3, 0, t - n4, sm);
    }
}

DEV void phase_reduce(const Params& p) {
    const float* part = (const float*)(p.ws + OFF_A); float* mods = (float*)(p.ws + OFF_SMALL); float* hn = (float*)(p.ws + OFF_SMALL + 491520);
    for (int i = blockIdx.x * 512 + tidx(); i < 122880 + 2048; i += gridDim.x * 512) {
        if (i < 122880) { float a = 0.f; for (int kc = 0; kc < 32; ++kc) a += part[(size_t)kc * 122880 + i]; mods[i] = a; }
        else { const int j = i - 122880; const int c = j & 1023; const float* hp = part + 32 * 122880; float a = 0.f;
            if (j < 1024) { for (int t = 0; t < 128; ++t) a += hp[(size_t)t * 2048 + c] + hp[(size_t)t * 2048 + 1024 + c]; }
            else { for (int t = 128; t < 136; ++t) a += hp[(size_t)t * 2048 + c] + hp[(size_t)t * 2048 + 1024 + c]; }
            hn[j] = a; }
    }
}

DEV void phase_norm(const Params& p, int layer, int which, unsigned char* shm) {
    const int tid = tidx(), wid = tid >> 6, lane = tid & 63;
    const float* g = p.in[which ? 9 : 8] + layer * 2048;
    const float* X = p.out; u16* A = (u16*)(p.ws + OFF_A);
    const float* mods = (const float*)(p.ws + OFF_SMALL) + (size_t)layer * 5 * 12288; const float* bb = p.in[7] + layer * 12288;
    const int shi = which ? 3 : 0;
    for (int row = blockIdx.x * 8 + wid; row < NTOK; row += gridDim.x * 8) {
        const float4* xr = (const float4*)(X + (size_t)row * DM);
        float4 v[8]; float ss = 0.f;
#pragma unroll
        for (int j = 0; j < 8; ++j) { v[j] = xr[lane + 64 * j]; ss += v[j].x * v[j].x + v[j].y * v[j].y + v[j].z * v[j].z + v[j].w * v[j].w; }
        ss = wave_sum(ss);
        const float rstd = rsqrtf(ss * (1.f / 2048.f) + 1e-6f);
        const float* md = mods + (size_t)tok_cond(row) * 12288;
#pragma unroll
        for (int j = 0; j < 8; ++j) { const int col = (lane + 64 * j) * 4;
            const float4 gg = *(const float4*)(g + col);
            const float4 s1 = *(const float4*)(md + shi * 2048 + col), s2 = *(const float4*)(bb + shi * 2048 + col);
            const float4 c1 = *(const float4*)(md + (shi + 1) * 2048 + col), c2 = *(const float4*)(bb + (shi + 1) * 2048 + col);
            const float o0 = v[j].x * rstd * gg.x * (1.f + c1.x + c2.x) + s1.x + s2.x;
            const float o1 = v[j].y * rstd * gg.y * (1.f + c1.y + c2.y) + s1.y + s2.y;
            const float o2 = v[j].z * rstd * gg.z * (1.f + c1.z + c2.z) + s1.z + s2.z;
            const float o3 = v[j].w * rstd * gg.w * (1.f + c1.w + c2.w) + s1.w + s2.w;
            u32x2 o; o.x = pk(o0, o1); o.y = pk(o2, o3);
            *(u32x2*)(A + (size_t)row * DM + col) = o; }
    }
    if (layer == 0 && which == 1) { const int na = conv_ntiles(0, 1), nb = na + conv_ntiles(1, 1);
        for (int t = blockIdx.x; t < nb; t += gridDim.x) { if (t < na) conv_job(p, 0, 1, t, (float*)shm); else conv_job(p, 1, 1, t - na, (float*)shm); } }
    if (layer == 1 && which == 0) { const int na = conv_ntiles(2, 1), nb = na + conv_ntiles(3, 1);
        for (int t = blockIdx.x; t < nb; t += gridDim.x) { if (t < na) conv_job(p, 2, 1, t, (float*)shm); else conv_job(p, 3, 1, t - na, (float*)shm); } }
}

DEV void sconv8(const u16* prow, bool hm, bool hp, const float* sw, const float* sb, int ch, float* o) {
    float c[8], m[8], q[8];
    unpack8(*(const u32x4*)(prow + ch), c);
    if (hm) unpack8(*(const u32x4*)(prow - LDP0 + ch), m); else { for (int i = 0; i < 8; ++i) m[i] = 0.f; }
    if (hp) unpack8(*(const u32x4*)(prow + LDP0 + ch), q); else { for (int i = 0; i < 8; ++i) q[i] = 0.f; }
#pragma unroll
    for (int i = 0; i < 8; ++i) o[i] = m[i] * sw[ch + i] + c[i] * sw[3072 + ch + i] + q[i] * sw[6144 + ch + i] + sb[ch + i];
}
DEV void hy_pre_tile(const Params& p, int tile, float* T) {
    const int tid = tidx(); const int tok0 = (tile >> 4) << 6, c0 = (tile & 15) << 6;
    const u16* P = (const u16*)(p.ws + OFF_P); u16* uT = (u16*)(p.ws + OFF_UT);
    { const int tk = tid >> 3, c8 = (tid & 7) << 3; const int tok = tok0 + tk; int t, L; tok_tl(tok, t, L);
        const u16* prow = P + (size_t)tok * LDP0; float x1[8], vv[8];
        sconv8(prow, t > 0, t < L - 1, p.in[16], p.in[17], 1024 + c0 + c8, x1);
        sconv8(prow, t > 0, t < L - 1, p.in[16], p.in[17], 2048 + c0 + c8, vv);
#pragma unroll
        for (int i = 0; i < 8; ++i) T[tk * 65 + c8 + i] = x1[i] * vv[i]; }
    __syncthreads();
    { const int ch = tid >> 3, t8 = (tid & 7) << 3; const float* t = T + t8 * 65 + ch;
        u32x4 o; o.x = pk(t[0], t[65]); o.y = pk(t[130], t[195]); o.z = pk(t[260], t[325]); o.w = pk(t[390], t[455]);
        *(u32x4*)(uT + (size_t)(c0 + ch) * NTOK + tok0 + t8) = o; }
    __syncthreads();
}
DEV void hy_post_tile(const Params& p, int tile, float* T) {
    const int tid = tidx(); const int tok0 = (tile >> 4) << 6, c0 = (tile & 15) << 6;
    const u16* P = (const u16*)(p.ws + OFF_P); const u16* uT = (const u16*)(p.ws + OFF_UT); u16* ycat = (u16*)(p.ws + OFF_A);
    { const int ch = tid >> 3, t8 = (tid & 7) << 3; float y[8]; unpack8(*(const u32x4*)(uT + (size_t)(c0 + ch) * NTOK + tok0 + t8), y);
#pragma unroll
        for (int i = 0; i < 8; ++i) T[(t8 + i) * 65 + ch] = y[i]; }
    __syncthreads();
    { const int tk = tid >> 3, c8 = (tid & 7) << 3; const int tok = tok0 + tk; int t, L; tok_tl(tok, t, L);
        const u16* prow = P + (size_t)tok * LDP0; float x0[8], x1[8], vv[8], o[8];
        sconv8(prow, t > 0, t < L - 1, p.in[16], p.in[17], c0 + c8, x0);
        sconv8(prow, t > 0, t < L - 1, p.in[16], p.in[17], 1024 + c0 + c8, x1);
        sconv8(prow, t > 0, t < L - 1, p.in[16], p.in[17], 2048 + c0 + c8, vv);
        const float* nrm = (const float*)(p.ws + OFF_SMALL + 491520) + (tok < NTP ? 1024 : 0);
#pragma unroll
        for (int i = 0; i < 8; ++i) { const int c = c0 + c8 + i; o[i] = x0[i] * (T[tk * 65 + c8 + i] / nrm[c] + x1[i] * vv[i] * p.in[24][c]); }
        u32x4 w; w.x = pk(o[0], o[1]); w.y = pk(o[2], o[3]); w.z = pk(o[4], o[5]); w.w = pk(o[6], o[7]);
        *(u32x4*)(ycat + (size_t)tok * DM + c0 + c8) = w; }
    __syncthreads();
}
DEV void hyconv_task(const Params& p, int task, unsigned char* shm) {
    const int tid = tidx(), wid = tid >> 6, lane = tid & 63;
    const bool sample = task < 1024; const int c = sample ? task : task - 1024;
    const int L = sample ? 4096 : 256, NB = sample ? 4 : 32, lgNB = sample ? 2 : 5, LP = L + 8;
    u16* uL = (u16*)shm; u16* gL = uL + NB * LP; u16* gS = gL + 2 * L;
    const u16* G = sample ? (const u16*)(p.ws + OFF_GS) + (size_t)c * 8192 : (const u16*)(p.ws + OFF_GP) + (size_t)c * 512;
    u16* uT = (u16*)(p.ws + OFF_UT) + (size_t)c * NTOK + (sample ? NTP : 0);
    for (int i = tid * 8; i < NB * L; i += 4096) { const int b = i / L, s = i % L; *(u32x4*)(uL + b * LP + s) = *(const u32x4*)(uT + i); }
    for (int i = tid * 8; i < 2 * L; i += 4096) { const u32x4 w = *(const u32x4*)(G + i); *(u32x4*)(gL + i) = w;
        const unsigned nx = (i + 8 < 2 * L) ? (unsigned)G[i + 8] : 0u;
        u32x4 sft; sft.x = (w.x >> 16) | (w.y << 16); sft.y = (w.y >> 16) | (w.z << 16); sft.z = (w.z >> 16) | (w.w << 16); sft.w = (w.w >> 16) | (nx << 16);
        *(u32x4*)(gS + i) = sft; }
    __syncthreads();
    const int ntile = (NB * (L >> 5)) >> 5;
    const int npair = sample ? 8 : 8; const bool two = sample;
    const int r = lane & 31, half = lane >> 5;
    {
        const int ct0 = two ? 2 * wid : wid;
        const int colA = ct0 * 32 + r, colB = colA + 32;
        const int bA = colA & (NB - 1), iA = colA >> lgNB, bB = colB & (NB - 1), iB = colB >> lgNB; const int tA = iA * 32, tB = iB * 32;
        const int i_lo = (ct0 * 32) >> lgNB, i_hi = ((two ? ct0 + 1 : ct0) * 32 + 31) >> lgNB;
        const int d_lo = 32 * i_lo - (L - 16), d_hi = 32 * i_hi;
        f32x16 accA, accB;
#pragma unroll
        for (int j = 0; j < 16; ++j) { accA[j] = 0.f; accB[j] = 0.f; }
        const u16* ubA = uL + bA * LP + 8 * half; const u16* ubB = uL + bB * LP + 8 * half;
        const u16* gsel = (r & 1) ? gS : gL;
        const int qb = (L - r + 8 * half) & ~1;
        for (int dl = d_lo; dl <= d_hi; dl += 16) {
            const unsigned* gq = (const unsigned*)(gsel + (qb - dl));
            u32x4 aw; aw.x = gq[0]; aw.y = gq[1]; aw.z = gq[2]; aw.w = gq[3];
            const bf16x8 a = __builtin_bit_cast(bf16x8, aw);
            const int sA = tA - dl, sB = tB - dl;
            bf16x8 bvA = (bf16x8){0, 0, 0, 0, 0, 0, 0, 0}, bvB = bvA;
            if (sA >= 0 && sA <= L - 16) bvA = *(const bf16x8*)(ubA + sA);
            accA = __builtin_amdgcn_mfma_f32_32x32x16_bf16(a, bvA, accA, 0, 0, 0);
            if (two) { if (sB >= 0 && sB <= L - 16) bvB = *(const bf16x8*)(ubB + sB);
                accB = __builtin_amdgcn_mfma_f32_32x32x16_bf16(a, bvB, accB, 0, 0, 0); }
        }
#pragma unroll
        for (int g = 0; g < 4; ++g) { u32x2 w; w.x = pk(accA[4 * g], accA[4 * g + 1]); w.y = pk(accA[4 * g + 2], accA[4 * g + 3]);
            *(u32x2*)(uT + (size_t)bA * L + tA + 8 * g + 4 * half) = w; }
        if (two) {
#pragma unroll
            for (int g = 0; g < 4; ++g) { u32x2 w; w.x = pk(accB[4 * g], accB[4 * g + 1]); w.y = pk(accB[4 * g + 2], accB[4 * g + 3]);
                *(u32x2*)(uT + (size_t)bB * L + tB + 8 * g + 4 * half) = w; } }
    }
    (void)ntile; (void)npair;
    __syncthreads();
}

DEV void rwkv_lora_tile(const Params& p, int tile, unsigned char* shm) {
    const int tid = tidx(), wid = tid >> 6, lane = tid & 63, l15 = lane & 15, quad = lane >> 4; const int tok0 = tile * 32;
    const u16* P = (const u16*)(p.ws + OFF_P); u16* RW = (u16*)(p.ws + OFF_RW); const u16* LW = (const u16*)(p.ws + OFF_LW);
    u16* Ain = (u16*)shm;
    u16* Ol = (u16*)(shm + 18432);
    for (int i = tid; i < 32 * 256; i += 512) { const int tk = i >> 8, cc = i & 255; const int tok = tok0 + tk; int t, L; tok_tl(tok, t, L);
        const u16* pp = P + (size_t)tok * LDP0 + 6144 + cc; float x = bf2f(*pp); const float xm = t > 0 ? bf2f(pp[-LDP0]) : 0.f; const float xp = t < L - 1 ? bf2f(pp[LDP0]) : 0.f;
        const float mu = p.in[25][3072 + cc]; x = x + mu * (0.5f * (xm + xp) - x); if (cc < 128) x = tanhf(x);
        Ain[((cc >> 6) * 32 + tk) * 72 + (cc & 63)] = f2bf(x); }
    __syncthreads();
#pragma unroll 1
    for (int mi = 0; mi < 4; ++mi) {
        const float* bias = (mi < 2 ? p.in[26] : p.in[28]) + (mi & 1) * 1024;
        const float osc = mi < 2 ? 0.6065306597f : 1.f;
        bf16x8 af[2][2];
#pragma unroll
        for (int tt = 0; tt < 2; ++tt)
#pragma unroll
            for (int ks = 0; ks < 2; ++ks) af[tt][ks] = *(const bf16x8*)(Ain + (mi * 32 + tt * 16 + l15) * 72 + ks * 32 + quad * 8);
#pragma unroll 2
        for (int q = 0; q < 8; ++q) { const int nt = wid * 8 + q; const int n = nt * 16 + l15;
            const bf16x8 b0 = *(const bf16x8*)(LW + ((size_t)mi * 1024 + n) * 64 + quad * 8), b1 = *(const bf16x8*)(LW + ((size_t)mi * 1024 + n) * 64 + 32 + quad * 8);
            const float bs = bias[n];
#pragma unroll
            for (int tt = 0; tt < 2; ++tt) { f32x4 acc = (f32x4){0.f, 0.f, 0.f, 0.f}; acc = mfma16(af[tt][0], b0, acc); acc = mfma16(af[tt][1], b1, acc);
#pragma unroll
                for (int r = 0; r < 4; ++r) Ol[(tt * 16 + quad * 4 + r) * 1032 + n] = f2bf(osc * sigm(acc[r] + bs)); } }
        __syncthreads();
#pragma unroll
        for (int i = 0; i < 8; ++i) { const int piece = tid + 512 * i; const int tk = piece >> 7, c8 = (piece & 127) * 8;
            *(u32x4*)(RW + (size_t)(tok0 + tk) * 4096 + mi * 1024 + c8) = *(const u32x4*)(Ol + tk * 1032 + c8); }
        __syncthreads();
    }
}
DEV float mixf(float c, float m, float q, float mu) { return c + mu * (0.5f * (m + q) - c); }
DEV void rwkv_scan_task(const Params& p, int task, float* sm) {
    const bool sample = task < 128; const int tt_ = sample ? task : task - 128;
    const int b = tt_ >> 5, h = (tt_ >> 1) & 15, dir = tt_ & 1;
    const int L = sample ? 4096 : 256; const int tok0 = sample ? NTP + b * 4096 : b * 256;
    const int tid = tidx(), wid = tid >> 6, lane = tid & 63;
    const int row = wid * 8 + (lane >> 3), kl = lane & 7;
    float S[8];
    const size_t soff = ((((size_t)b * 2 + dir) * 16 + h) * 64 + row) * 64 + kl * 8;
    if (sample) { const float4 a = *(const float4*)(p.in[2] + soff), c = *(const float4*)(p.in[2] + soff + 4);
        S[0] = a.x; S[1] = a.y; S[2] = a.z; S[3] = a.w; S[4] = c.x; S[5] = c.y; S[6] = c.z; S[7] = c.w; }
    else {
#pragma unroll
        for (int i = 0; i < 8; ++i) S[i] = 0.f; }
    float* vec = sm; float* vvs = sm + 10240; float* yb = vvs + 2048;
    const int ptt = tid >> 4, pk4 = (tid & 15) * 4; const int ch = h * 64 + pk4;
    const float4 mur = *(const float4*)(p.in[25] + ch), muk = *(const float4*)(p.in[25] + 1024 + ch), muv = *(const float4*)(p.in[25] + 2048 + ch);
    const float4 kkw = *(const float4*)(p.in[31] + ch), kaw = *(const float4*)(p.in[32] + ch);
    const float murA[4] = {mur.x, mur.y, mur.z, mur.w}, mukA[4] = {muk.x, muk.y, muk.z, muk.w}, muvA[4] = {muv.x, muv.y, muv.z, muv.w};
    const float kkwA[4] = {kkw.x, kkw.y, kkw.z, kkw.w}, kawA[4] = {kaw.x, kaw.y, kaw.z, kaw.w};
    const u16* P = (const u16*)(p.ws + OFF_P); const u16* RW = (const u16*)(p.ws + OFF_RW);
    u16* Y = (u16*)(p.out + OUT_GLAST) + (dir ? (size_t)NTOK * 1024 : 0);
    for (int c0 = 0; c0 < L; c0 += 32) {
        { const int t = dir ? (L - 1 - (c0 + ptt)) : (c0 + ptt); const size_t tok = (size_t)tok0 + t;
            const u16* pr = P + tok * LDP0 + 3072 + ch;
            float rc[4], kc[4], vc[4], rm[4], km[4], vm[4], rp[4], kp[4], vp[4], ee[4], aa[4];
            unpack4(*(const u32x2*)(pr), rc); unpack4(*(const u32x2*)(pr + 1024), kc); unpack4(*(const u32x2*)(pr + 2048), vc);
            if (t > 0) { unpack4(*(const u32x2*)(pr - LDP0), rm); unpack4(*(const u32x2*)(pr - LDP0 + 1024), km); unpack4(*(const u32x2*)(pr - LDP0 + 2048), vm); }
            else { for (int i = 0; i < 4; ++i) { rm[i] = 0.f; km[i] = 0.f; vm[i] = 0.f; } }
            if (t < L - 1) { unpack4(*(const u32x2*)(pr + LDP0), rp); unpack4(*(const u32x2*)(pr + LDP0 + 1024), kp); unpack4(*(const u32x2*)(pr + LDP0 + 2048), vp); }
            else { for (int i = 0; i < 4; ++i) { rp[i] = 0.f; kp[i] = 0.f; vp[i] = 0.f; } }
            unpack4(*(const u32x2*)(RW + tok * 4096 + dir * 1024 + ch), ee); unpack4(*(const u32x2*)(RW + tok * 4096 + (2 + dir) * 1024 + ch), aa);
            float r4[4], k4[4], v4[4], kr[4]; float ss = 0.f;
#pragma unroll
            for (int i = 0; i < 4; ++i) { r4[i] = mixf(rc[i], rm[i], rp[i], murA[i]); k4[i] = mixf(kc[i], km[i], kp[i], mukA[i]); v4[i] = mixf(vc[i], vm[i], vp[i], muvA[i]);
                kr[i] = k4[i] * kkwA[i]; ss += kr[i] * kr[i]; }
            ss = sum16(ss); const float inv = rsqrtf(ss + 1e-12f);
            float4 okk, ow, okka, okd, orr, ov;
            float tkk[4], tw[4], tkka[4], tkd[4];
#pragma unroll
            for (int i = 0; i < 4; ++i) { tkk[i] = kr[i] * inv; tw[i] = __expf(-ee[i]); tkka[i] = tkk[i] * aa[i]; tkd[i] = k4[i] * (1.f + (aa[i] - 1.f) * kawA[i]); }
            okk = make_float4(tkk[0], tkk[1], tkk[2], tkk[3]); ow = make_float4(tw[0], tw[1], tw[2], tw[3]); okka = make_float4(tkka[0], tkka[1], tkka[2], tkka[3]);
            okd = make_float4(tkd[0], tkd[1], tkd[2], tkd[3]); orr = make_float4(r4[0], r4[1], r4[2], r4[3]); ov = make_float4(v4[0], v4[1], v4[2], v4[3]);
            float* vj = vec + ptt * 320 + pk4;
            *(float4*)(vj) = okk; *(float4*)(vj + 64) = ow; *(float4*)(vj + 128) = okka; *(float4*)(vj + 192) = okd; *(float4*)(vj + 256) = orr;
            *(float4*)(vvs + ptt * 64 + pk4) = ov; }
        __syncthreads();
        for (int j = 0; j < 32; ++j) {
            const float* vj = vec + j * 320 + kl * 8;
            const float4 a0 = *(const float4*)(vj), a1 = *(const float4*)(vj + 4);
            const float4 w0 = *(const float4*)(vj + 64), w1 = *(const float4*)(vj + 68);
            const float4 b0 = *(const float4*)(vj + 128), b1 = *(const float4*)(vj + 132);
            const float4 d0 = *(const float4*)(vj + 192), d1 = *(const float4*)(vj + 196);
            const float4 r0 = *(const float4*)(vj + 256), r1 = *(const float4*)(vj + 260);
            const float vr = vvs[j * 64 + row];
            float sa = S[0] * a0.x + S[1] * a0.y + S[2] * a0.z + S[3] * a0.w + S[4] * a1.x + S[5] * a1.y + S[6] * a1.z + S[7] * a1.w;
            sa = -sum8(sa);
            S[0] = S[0] * w0.x + sa * b0.x + vr * d0.x; S[1] = S[1] * w0.y + sa * b0.y + vr * d0.y; S[2] = S[2] * w0.z + sa * b0.z + vr * d0.z; S[3] = S[3] * w0.w + sa * b0.w + vr * d0.w;
            S[4] = S[4] * w1.x + sa * b1.x + vr * d1.x; S[5] = S[5] * w1.y + sa * b1.y + vr * d1.y; S[6] = S[6] * w1.z + sa * b1.z + vr * d1.z; S[7] = S[7] * w1.w + sa * b1.w + vr * d1.w;
            float y = S[0] * r0.x + S[1] * r0.y + S[2] * r0.z + S[3] * r0.w + S[4] * r1.x + S[5] * r1.y + S[6] * r1.z + S[7] * r1.w;
            y = sum8(y);
            if (kl == 0) yb[j * 64 + row] = y;
        }
        __syncthreads();
        { const int t = dir ? (L - 1 - (c0 + ptt)) : (c0 + ptt);
            const float4 yv = *(const float4*)(yb + ptt * 64 + pk4); u32x2 w; w.x = pk(yv.x, yv.y); w.y = pk(yv.z, yv.w);
            *(u32x2*)(Y + ((size_t)tok0 + t) * 1024 + ch) = w; }
    }
    if (!sample) { float* so = p.out + OUT_RWST + soff;
        *(float4*)(so) = make_float4(S[0], S[1], S[2], S[3]); *(float4*)(so + 4) = make_float4(S[4], S[5], S[6], S[7]); }
    __syncthreads();
}
DEV void rwkv_post_tile(const Params& p, int tile, float* sm) {
    const int tid = tidx(); const int tok0 = tile * 16;
    const u16* P = (const u16*)(p.ws + OFF_P); const u16* RW = (const u16*)(p.ws + OFF_RW); u16* ycat = (u16*)(p.ws + OFF_A);
    const u16* YF = (const u16*)(p.out + OUT_GLAST); const u16* YB = YF + (size_t)NTOK * 1024;
    for (int i = tid; i < 16 * 128; i += 512) { const int tk = i >> 7, r = i & 127; const int tok = tok0 + tk; int t, L; tok_tl(tok, t, L);
        const u16* pp = P + (size_t)tok * LDP0 + 6400 + r; const float x = bf2f(*pp); const float xm = t > 0 ? bf2f(pp[-LDP0]) : 0.f; const float xp = t < L - 1 ? bf2f(pp[LDP0]) : 0.f;
        sm[i] = sigm(mixf(x, xm, xp, p.in[25][3328 + r])); }
    __syncthreads();
    float g0[16], g1[16];
#pragma unroll
    for (int k = 0; k < 16; ++k) { g0[k] = 0.f; g1[k] = 0.f; }
    const float* g2 = p.in[30];
    for (int r = 0; r < 128; r += 4) {
        float wa[4], wb[4];
#pragma unroll
        for (int q = 0; q < 4; ++q) { wa[q] = g2[(r + q) * 1024 + tid]; wb[q] = g2[(r + q) * 1024 + 512 + tid]; }
#pragma unroll
        for (int k = 0; k < 16; ++k) { const float4 s = *(const float4*)(sm + k * 128 + r);
            g0[k] += s.x * wa[0] + s.y * wa[1] + s.z * wa[2] + s.w * wa[3]; g1[k] += s.x * wb[0] + s.y * wb[1] + s.z * wb[2] + s.w * wb[3]; } }
#pragma unroll
    for (int q = 0; q < 2; ++q) { const int n = q * 512 + tid;
        const float mur = p.in[25][n], muk = p.in[25][1024 + n], muv = p.in[25][2048 + n];
        const float ka = p.in[32][n], rk = p.in[33][n], lw = p.in[34][n], lb = p.in[35][n];
#pragma unroll
        for (int k = 0; k < 16; ++k) { const int tok = tok0 + k; int t, L; tok_tl(tok, t, L);
            const u16* pr = P + (size_t)tok * LDP0 + 3072 + n;
            const bool hm = t > 0, hp = t < L - 1;
            const float r_ = mixf(bf2f(pr[0]), hm ? bf2f(pr[-LDP0]) : 0.f, hp ? bf2f(pr[LDP0]) : 0.f, mur);
            const float k_ = mixf(bf2f(pr[1024]), hm ? bf2f(pr[1024 - LDP0]) : 0.f, hp ? bf2f(pr[1024 + LDP0]) : 0.f, muk);
            const float v_ = mixf(bf2f(pr[2048]), hm ? bf2f(pr[2048 - LDP0]) : 0.f, hp ? bf2f(pr[2048 + LDP0]) : 0.f, muv);
            const float a0 = bf2f(RW[(size_t)tok * 4096 + 2048 + n]), a1 = bf2f(RW[(size_t)tok * 4096 + 3072 + n]);
            const float kd = k_ * (2.f + (a0 + a1 - 2.f) * ka);
            const float bonus = wave_sum(r_ * kd * rk);
            const float y = bf2f(YF[(size_t)tok * 1024 + n]) + bf2f(YB[(size_t)tok * 1024 + n]);
            const float mean = wave_sum(y) * (1.f / 64.f); const float dy = y - mean; const float var = wave_sum(dy * dy) * (1.f / 64.f);
            const float yn = dy * rsqrtf(var + 64e-5f) * lw + lb;
            const float gg = q ? g1[k] : g0[k];
            ycat[(size_t)tok * DM + 1024 + n] = f2bf((yn + bonus * v_) * gg); } }
    __syncthreads();
}

DEV float logsig(float x) { return fminf(x, 0.f) - log1pf(__expf(-fabsf(x))); }
DEV void gla_intra_task(const Params& p, int task, unsigned char* shm) {
    const int tid = tidx(), wid = tid >> 6, lane = tid & 63, l15 = lane & 15, quad = lane >> 4;
    const int cidx = task >> 2, h = task & 3; const int tok0 = cidx * 64;
    u16* P = (u16*)(p.ws + OFF_P); u16* QB = (u16*)(p.ws + OFF_A); float* Dbuf = (float*)(p.ws + OFF_DB);
    u16* qi = (u16*)shm; u16* ki = qi + 64 * 264; u16* vl = (u16*)shm; u16* Pl = (u16*)(shm + 67584); float* gl = (float*)(shm + 76800); float* tot = (float*)(shm + 84992);
    for (int i = tid; i < 2048; i += 512) { const int tl = i >> 5, c = i & 31; gl[i] = bf2f(P[(size_t)(tok0 + tl) * LDP1 + 6144 + c]); }
    __syncthreads();
    const int k = tid & 255, jh = tid >> 8;
#pragma unroll 1
    for (int dd = 0; dd < 2; ++dd) { const int dir = 1 - dd;
        float g2r[16];
#pragma unroll
        for (int r = 0; r < 16; ++r) g2r[r] = p.in[38][(size_t)(dir * 16 + r) * 1024 + h * 256 + k];
        const float gb = p.in[39][dir * 1024 + h * 256 + k];
        float bl[32]; float run = 0.f;
#pragma unroll
        for (int jj = 0; jj < 32; ++jj) { const int j = jh * 32 + jj; const int tl = dir ? 63 - j : j; const float* gr = gl + tl * 32 + dir * 16;
            float x = gb;
#pragma unroll
            for (int r = 0; r < 16; r += 4) { const float4 g4 = *(const float4*)(gr + r); x += g4.x * g2r[r] + g4.y * g2r[r + 1] + g4.z * g2r[r + 2] + g4.w * g2r[r + 3]; }
            run += logsig(x) * 0.0625f; bl[jj] = run; }
        tot[jh * 256 + k] = run;
        __syncthreads();
        const float t0v = tot[k], t1v = tot[256 + k]; const float off = jh ? t0v : 0.f; const float bref = t0v, blast = t0v + t1v;
        if (jh == 0) Dbuf[((size_t)cidx * 2 + dir) * 1024 + h * 256 + k] = __expf(blast);
        u16* qdst; u16* kdst; size_t ldd;
        if (dir == 0) { qdst = P + h * 256 + k; kdst = P + 1024 + h * 256 + k; ldd = LDP1; } else { qdst = QB + h * 256 + k; kdst = QB + 1024 + h * 256 + k; ldd = 2048; }
#pragma unroll
        for (int jj = 0; jj < 32; ++jj) { const int j = jh * 32 + jj; const int tl = dir ? 63 - j : j; const size_t tok = (size_t)tok0 + tl;
            const float qv = bf2f(P[tok * LDP1 + h * 256 + k]) * 0.0625f, kv = bf2f(P[tok * LDP1 + 1024 + h * 256 + k]);
            const float b = bl[jj] + off;
            qi[j * 264 + k] = f2bf(qv * __expf(b - bref)); ki[j * 264 + k] = f2bf(kv * __expf(bref - b));
            qdst[tok * ldd] = f2bf(qv * __expf(b)); kdst[tok * ldd] = f2bf(kv * __expf(blast - b)); }
        __syncthreads();
        { const int tt = wid >> 1;
#pragma unroll
            for (int q2 = 0; q2 < 2; ++q2) { const int st = (wid & 1) * 2 + q2; f32x4 acc = (f32x4){0.f, 0.f, 0.f, 0.f};
                if (st <= tt) {
#pragma unroll
                    for (int ks = 0; ks < 8; ++ks) { const bf16x8 a = *(const bf16x8*)(qi + (tt * 16 + l15) * 264 + ks * 32 + quad * 8); const bf16x8 b = *(const bf16x8*)(ki + (st * 16 + l15) * 264 + ks * 32 + quad * 8);
                        acc = mfma16(a, b, acc); } }
#pragma unroll
                for (int r = 0; r < 4; ++r) { const int t = tt * 16 + quad * 4 + r, s_ = st * 16 + l15; Pl[t * 72 + s_] = f2bf(s_ <= t ? acc[r] : 0.f); } } }
        __syncthreads();
#pragma unroll
        for (int i = 0; i < 8; ++i) { const int piece = tid + 512 * i; const int j = piece >> 6, c8 = (piece & 63) * 8; const int tl = dir ? 63 - j : j;
            *(u32x4*)(vl + j * 520 + c8) = *(const u32x4*)(P + (size_t)(tok0 + tl) * LDP1 + 2048 + h * 512 + c8); }
        __syncthreads();
        u16* O = (u16*)(p.ws + (dir ? OFF_OB : OFF_OF)) + h * 512;
#pragma unroll 1
        for (int q4 = 0; q4 < 4; ++q4) { const int vt = wid * 4 + q4; f32x4 acc[4];
#pragma unroll
            for (int tt = 0; tt < 4; ++tt) acc[tt] = (f32x4){0.f, 0.f, 0.f, 0.f};
#pragma unroll
            for (int ss = 0; ss < 2; ++ss) { bf16x8 bfr;
#pragma unroll
                for (int jj = 0; jj < 8; ++jj) bfr[jj] = (short)vl[(ss * 32 + quad * 8 + jj) * 520 + vt * 16 + l15];
#pragma unroll
                for (int tt = 0; tt < 4; ++tt) { if (ss * 32 <= tt * 16 + 15) { const bf16x8 a = *(const bf16x8*)(Pl + (tt * 16 + l15) * 72 + ss * 32 + quad * 8); acc[tt] = mfma16(a, bfr, acc[tt]); } } }
#pragma unroll
            for (int tt = 0; tt < 4; ++tt)
#pragma unroll
                for (int r = 0; r < 4; ++r) { const int t = tt * 16 + quad * 4 + r; const int tl = dir ? 63 - t : t; O[(size_t)(tok0 + tl) * DM + vt * 16 + l15] = f2bf(acc[tt][r]); } }
        __syncthreads();
    }
}
DEV void gla_inter_task(const Params& p, int task, unsigned char* shm) {
    const bool sample = task < 256; const int tt_ = sample ? task : task - 256;
    const int seq = tt_ >> 3, vs = tt_ & 7; const int b = seq >> 3, h = (seq >> 1) & 3, dir = seq & 1;
    const int L = sample ? 4096 : 256; const int tok0 = sample ? NTP + b * 4096 : b * 256;
    const int nch = L >> 6, cbase = tok0 >> 6;
    const int tid = tidx(), wid = tid >> 6, lane = tid & 63, l15 = lane & 15, quad = lane >> 4;
    const u16* P = (const u16*)(p.ws + OFF_P); const u16* QB = (const u16*)(p.ws + OFF_A); const float* Dbuf = (const float*)(p.ws + OFF_DB);
    u16* ST = (u16*)shm; u16* qdl = (u16*)(shm + 33792); u16* kdl = (u16*)(shm + 67584); u16* vl = (u16*)(shm + 101376); float* dl = (float*)(shm + 110592);
    f32x4 S[2][4];
    const size_t sbase = (((size_t)b * 2 + dir) * 4 + h) * 256 * 512 + vs * 64;
#pragma unroll
    for (int kt = 0; kt < 2; ++kt)
#pragma unroll
        for (int vt = 0; vt < 4; ++vt)
#pragma unroll
            for (int r = 0; r < 4; ++r) { const int kk = wid * 32 + kt * 16 + quad * 4 + r; S[kt][vt][r] = sample ? p.in[3][sbase + (size_t)kk * 512 + vt * 16 + l15] : 0.f; }
    const u16* qsrc; const u16* ksrc; size_t lds_;
    if (dir == 0) { qsrc = P + h * 256; ksrc = P + 1024 + h * 256; lds_ = LDP1; } else { qsrc = QB + h * 256; ksrc = QB + 1024 + h * 256; lds_ = 2048; }
    const u16* vsrc = P + 2048 + h * 512 + vs * 64;
    u16* O = (u16*)(p.ws + (dir ? OFF_OB : OFF_OF)) + h * 512 + vs * 64;
    u32x4 rq[4], rk[4], rv; float rd = 0.f;
    const int vrow = tid >> 3, vc8 = (tid & 7) * 8;
#define GLA_ISSUE(n_) do { const int cidx_ = cbase + (dir ? nch - 1 - (n_) : (n_)); \
        _Pragma("unroll") for (int i = 0; i < 4; ++i) { const int piece = tid + 512 * i; const int j = piece >> 5, c8 = (piece & 31) * 8; const size_t tok = (size_t)cidx_ * 64 + (dir ? 63 - j : j); \
            rq[i] = *(const u32x4*)(qsrc + tok * lds_ + c8); rk[i] = *(const u32x4*)(ksrc + tok * lds_ + c8); } \
        { const size_t tok = (size_t)cidx_ * 64 + (dir ? 63 - vrow : vrow); rv = *(const u32x4*)(vsrc + tok * LDP1 + vc8); } \
        if (tid < 256) rd = Dbuf[((size_t)cidx_ * 2 + dir) * 1024 + h * 256 + tid]; } while (0)
#define GLA_WRITE_ST() do { _Pragma("unroll") for (int kt = 0; kt < 2; ++kt) _Pragma("unroll") for (int vt = 0; vt < 4; ++vt) { u32x2 w; w.x = pk(S[kt][vt][0], S[kt][vt][1]); w.y = pk(S[kt][vt][2], S[kt][vt][3]); \
            *(u32x2*)(ST + (vt * 16 + l15) * 264 + wid * 32 + kt * 16 + quad * 4) = w; } } while (0)
    GLA_WRITE_ST();
    GLA_ISSUE(0);
    const int tt = wid >> 1, vb = (wid & 1) * 2;
#pragma unroll 1
    for (int n = 0; n < nch; ++n) {
        const int cidx = cbase + (dir ? nch - 1 - n : n);
#pragma unroll
        for (int i = 0; i < 4; ++i) { const int piece = tid + 512 * i; const int j = piece >> 5, c8 = (piece & 31) * 8; *(u32x4*)(qdl + j * 264 + c8) = rq[i]; *(u32x4*)(kdl + j * 264 + c8) = rk[i]; }
        *(u32x4*)(vl + vrow * 72 + vc8) = rv; if (tid < 256) dl[tid] = rd;
        __syncthreads();
        if (n + 1 < nch) GLA_ISSUE(n + 1);
        float oi[2][4];
#pragma unroll
        for (int q2 = 0; q2 < 2; ++q2)
#pragma unroll
            for (int r = 0; r < 4; ++r) { const int j = tt * 16 + quad * 4 + r; const size_t tok = (size_t)cidx * 64 + (dir ? 63 - j : j); oi[q2][r] = bf2f(O[tok * DM + (vb + q2) * 16 + l15]); }
        f32x4 oacc[2]; oacc[0] = (f32x4){0.f, 0.f, 0.f, 0.f}; oacc[1] = oacc[0];
#pragma unroll
        for (int ks = 0; ks < 8; ++ks) { const bf16x8 a = *(const bf16x8*)(qdl + (tt * 16 + l15) * 264 + ks * 32 + quad * 8);
#pragma unroll
            for (int q2 = 0; q2 < 2; ++q2) { const bf16x8 bfr = *(const bf16x8*)(ST + ((vb + q2) * 16 + l15) * 264 + ks * 32 + quad * 8); oacc[q2] = mfma16(a, bfr, oacc[q2]); } }
#pragma unroll
        for (int kt = 0; kt < 2; ++kt) { const f32x4 dv = *(const f32x4*)(dl + wid * 32 + kt * 16 + quad * 4);
#pragma unroll
            for (int vt = 0; vt < 4; ++vt) S[kt][vt] = S[kt][vt] * dv; }
#pragma unroll
        for (int ts = 0; ts < 2; ++ts) { bf16x8 af[2];
#pragma unroll
            for (int kt = 0; kt < 2; ++kt)
#pragma unroll
                for (int jj = 0; jj < 8; ++jj) af[kt][jj] = (short)kdl[(ts * 32 + quad * 8 + jj) * 264 + wid * 32 + kt * 16 + l15];
#pragma unroll
            for (int vt = 0; vt < 4; ++vt) { bf16x8 bfr;
#pragma unroll
                for (int jj = 0; jj < 8; ++jj) bfr[jj] = (short)vl[(ts * 32 + quad * 8 + jj) * 72 + vt * 16 + l15];
#pragma unroll
                for (int kt = 0; kt < 2; ++kt) S[kt][vt] = mfma16(af[kt], bfr, S[kt][vt]); } }
#pragma unroll
        for (int q2 = 0; q2 < 2; ++q2)
#pragma unroll
            for (int r = 0; r < 4; ++r) { const int j = tt * 16 + quad * 4 + r; const size_t tok = (size_t)cidx * 64 + (dir ? 63 - j : j); O[tok * DM + (vb + q2) * 16 + l15] = f2bf(oi[q2][r] + oacc[q2][r]); }
        __syncthreads();
        GLA_WRITE_ST();
        __syncthreads();
    }
#undef GLA_ISSUE
#undef GLA_WRITE_ST
    if (!sample) { float* so = p.out + OUT_GLAST + sbase;
#pragma unroll
        for (int kt = 0; kt < 2; ++kt)
#pragma unroll
            for (int vt = 0; vt < 4; ++vt)
#pragma unroll
                for (int r = 0; r < 4; ++r) { const int kk = wid * 32 + kt * 16 + quad * 4 + r; so[(size_t)kk * 512 + vt * 16 + l15] = S[kt][vt][r]; } }
    __syncthreads();
}
DEV void phase_gla_post(const Params& p) {
    const int tid = tidx(), wid = tid >> 6, lane = tid & 63;
    const u16* P = (const u16*)(p.ws + OFF_P); const u16* OF = (const u16*)(p.ws + OFF_OF); const u16* OB = (const u16*)(p.ws + OFF_OB); u16* ycat = (u16*)(p.ws + OFF_A);
    for (int it = blockIdx.x * 8 + wid; it < NTOK * 4; it += gridDim.x * 8) { const int tok = it >> 2, h = it & 3; const int v8 = lane * 8;
        float a[8], b[8], g[8]; unpack8(*(const u32x4*)(OF + (size_t)tok * DM + h * 512 + v8), a); unpack8(*(const u32x4*)(OB + (size_t)tok * DM + h * 512 + v8), b);
        unpack8(*(const u32x4*)(P + (size_t)tok * LDP1 + 4096 + h * 512 + v8), g);
        float ss = 0.f;
#pragma unroll
        for (int i = 0; i < 8; ++i) { a[i] += b[i]; ss += a[i] * a[i]; }
        ss = wave_sum(ss); const float sc = rsqrtf(ss * (1.f / 512.f) + 1e-6f);
        float o[8];
#pragma unroll
        for (int i = 0; i < 8; ++i) o[i] = a[i] * sc * p.in[40][v8 + i] * (g[i] * sigm(g[i]));
        u32x4 w; w.x = pk(o[0], o[1]); w.y = pk(o[2], o[3]); w.z = pk(o[4], o[5]); w.w = pk(o[6], o[7]);
        *(u32x4*)(ycat + (size_t)tok * DM + h * 512 + v8) = w; }
}

DEV void gate_loadcol(const u16* U, long tokc, int c8, bool colok, bool up, bool dn, int W, float (*dst)[8]) {
    if (colok && up) unpack8(*(const u32x4*)(U + (size_t)(tokc - W) * LDU + c8), dst[0]); else { for (int i = 0; i < 8; ++i) dst[0][i] = 0.f; }
    if (colok) unpack8(*(const u32x4*)(U + (size_t)tokc * LDU + c8), dst[1]); else { for (int i = 0; i < 8; ++i) dst[1][i] = 0.f; }
    if (colok && dn) unpack8(*(const u32x4*)(U + (size_t)(tokc + W) * LDU + c8), dst[2]); else { for (int i = 0; i < 8; ++i) dst[2][i] = 0.f; }
}
DEV void phase_ffn_gate(const Params& p, int layer) {
    u16* U = (u16*)(p.ws + OFF_U); const float* cw = p.in[11] + (size_t)layer * 9 * DFF;
    const int nunit = 768 * 704;
    for (int u = blockIdx.x * 512 + tidx(); u < nunit; u += gridDim.x * 512) {
        const int seg = u / 704, c8 = (u % 704) * 8; const int tokS = seg * 32;
        int W, colS; bool up, dn;
        if (tokS < NTP) { W = 256; colS = tokS & 255; up = false; dn = false; }
        else { W = 64; colS = tokS & 63; const int rr = ((tokS - NTP) >> 6) & 63; up = rr > 0; dn = rr < 63; }
        float wt[9][8];
#pragma unroll
        for (int q = 0; q < 9; ++q) { const float4 a = *(const float4*)(cw + q * DFF + c8), b = *(const float4*)(cw + q * DFF + c8 + 4);
            wt[q][0] = a.x; wt[q][1] = a.y; wt[q][2] = a.z; wt[q][3] = a.w; wt[q][4] = b.x; wt[q][5] = b.y; wt[q][6] = b.z; wt[q][7] = b.w; }
        float w0[3][8], w1[3][8], w2[3][8];
        gate_loadcol(U, (long)tokS - 1, c8, colS > 0, up, dn, W, w0);
        gate_loadcol(U, (long)tokS, c8, true, up, dn, W, w1);
#pragma unroll 4
        for (int s_ = 0; s_ < 32; ++s_) {
            const long tok = (long)tokS + s_;
            gate_loadcol(U, tok + 1, c8, colS + s_ + 1 < W, up, dn, W, w2);
            u16* vp = U + (size_t)tok * LDU + DFF + c8; float v[8]; unpack8(*(const u32x4*)vp, v);
#pragma unroll
            for (int i = 0; i < 8; ++i) { float a = 0.f;
#pragma unroll
                for (int di = 0; di < 3; ++di) a += w0[di][i] * wt[di * 3][i] + w1[di][i] * wt[di * 3 + 1][i] + w2[di][i] * wt[di * 3 + 2][i];
                v[i] *= a * sigm(a); }
            u32x4 w; w.x = pk(v[0], v[1]); w.y = pk(v[2], v[3]); w.z = pk(v[4], v[5]); w.w = pk(v[6], v[7]);
            *(u32x4*)vp = w;
#pragma unroll
            for (int di = 0; di < 3; ++di)
#pragma unroll
                for (int i = 0; i < 8; ++i) { w0[di][i] = w1[di][i]; w1[di][i] = w2[di][i]; }
        }
    }
}

DEV void phase_final_norm(const Params& p) {
    const int tid = tidx(), wid = tid >> 6, lane = tid & 63; const float* g = p.in[13];
    for (int row = blockIdx.x * 8 + wid; row < NTOK; row += gridDim.x * 8) {
        float4* xr = (float4*)(p.out + (size_t)row * DM);
        float4 v[8]; float ss = 0.f;
#pragma unroll
        for (int j = 0; j < 8; ++j) { v[j] = xr[lane + 64 * j]; ss += v[j].x * v[j].x + v[j].y * v[j].y + v[j].z * v[j].z + v[j].w * v[j].w; }
        ss = wave_sum(ss); const float rstd = rsqrtf(ss * (1.f / 2048.f) + 1e-6f);
#pragma unroll
        for (int j = 0; j < 8; ++j) { const float4 gg = *(const float4*)(g + (lane + 64 * j) * 4);
            xr[lane + 64 * j] = make_float4(v[j].x * rstd * gg.x, v[j].y * rstd * gg.y, v[j].z * rstd * gg.z, v[j].w * rstd * gg.w); }
    }
}


#define XB_TMO      128
#define XB_XCNT(j)  (256  + 64 * (j))
#define XB_XSUB(j)  (1280 + 64 * (j))
#define XB_XGEN(j)  (2304 + 64 * (j))
#define XB_TOP      3328
#define XB_TOPGEN   3392
#define XCD_BAR_WORDS 3456
#define XB_SPIN_CAP (1u << 18)
DEV unsigned xb_ld(unsigned* p)              { return __hip_atomic_load(p, __ATOMIC_RELAXED, __HIP_MEMORY_SCOPE_AGENT); }
DEV unsigned xb_add(unsigned* p, unsigned v) { return __hip_atomic_fetch_add(p, v, __ATOMIC_RELAXED, __HIP_MEMORY_SCOPE_AGENT); }
DEV unsigned xb_xcc_id() { return (unsigned)__builtin_amdgcn_s_getreg((3 << 11) | 20) & 0xFu; }
#define XB_SPIN(cond, bar) do { unsigned _sp = 0; while (cond) { __builtin_amdgcn_s_sleep(1); \
    if ((++_sp & 255u) == 0u) { if (xb_ld(&(bar)[XB_TMO])) break; if (_sp > XB_SPIN_CAP) { atomicAdd(&(bar)[XB_TMO], 1u); break; } } } } while (0)
struct XcdBarrier { unsigned* bar; unsigned x; volatile LAS unsigned* st; };
DEV XcdBarrier xcd_barrier_post(unsigned* bar, volatile LAS unsigned* st) {
    XcdBarrier b; b.bar = bar; b.x = xb_xcc_id(); b.st = st;
    if (threadIdx.x == 0) (void)xb_add(&bar[XB_XCNT(b.x)], 1u);
    return b;
}
DEV void xcd_barrier_complete(unsigned* bar, unsigned x, unsigned& nloc, unsigned& nx) {
    const unsigned G = gridDim.x * gridDim.y * gridDim.z;
    unsigned sum, cnt, mine, sp = 0u;
    for (;;) {
        sum = 0u; cnt = 0u; mine = 0u;
#pragma unroll
        for (unsigned j = 0; j < 16; ++j) { const unsigned c = xb_ld(&bar[XB_XCNT(j)]); sum += c; cnt += (c > 0u) ? 1u : 0u; mine = (j == x) ? c : mine; }
        if (sum == G) break;
        __builtin_amdgcn_s_sleep(1);
        if ((++sp & 255u) == 0u) { if (xb_ld(&bar[XB_TMO])) break; if (sp > XB_SPIN_CAP) { atomicAdd(&bar[XB_TMO], 1u); break; } }
    }
    nloc = mine > 0u ? mine : 1u; nx = cnt > 0u ? cnt : 1u;
}
DEV void xcd_barrier(const XcdBarrier& b) {
    asm volatile("s_waitcnt vmcnt(0)" ::: "memory");
    __syncthreads();
    if (threadIdx.x == 0) {
        unsigned* bar = b.bar;
        __builtin_amdgcn_s_waitcnt(0);
        unsigned nloc = b.st[0], nx = b.st[1];
        if (nloc == 0u) { xcd_barrier_complete(bar, b.x, nloc, nx); b.st[0] = nloc; b.st[1] = nx; }
        const unsigned old = xb_add(&bar[XB_XSUB(b.x)], 1u);
        const unsigned gen = old / nloc;
        if (old + 1u == (gen + 1u) * nloc) {
            __builtin_amdgcn_fence(__ATOMIC_RELEASE, "agent");
            asm volatile("s_waitcnt vmcnt(0)" ::: "memory");
            const unsigned og = xb_add(&bar[XB_TOP], 1u);
            const unsigned tg = og / nx;
            if (og + 1u == (tg + 1u) * nx) xb_add(&bar[XB_TOPGEN], 1u);
            else XB_SPIN(xb_ld(&bar[XB_TOPGEN]) == tg, bar);
            __builtin_amdgcn_fence(__ATOMIC_ACQUIRE, "agent");
            xb_add(&bar[XB_XGEN(b.x)], 1u);
            asm volatile("s_waitcnt vmcnt(0)" ::: "memory");
        } else {
            XB_SPIN(xb_ld(&bar[XB_XGEN(b.x)]) == gen, bar);
            __builtin_amdgcn_fence(__ATOMIC_ACQUIRE, "agent");
            asm volatile("s_waitcnt vmcnt(0)" ::: "memory");
        }
    }
    __syncthreads();
}

__global__ void __launch_bounds__(512, 2) mega(Params p0) {
    extern __shared__ __attribute__((aligned(16))) unsigned char shm[];
    cg::grid_group grid = cg::this_grid();
    __shared__ uint4 xb_words;
    if (threadIdx.x == 0) xb_words = make_uint4(0u, 0u, 0u, 0u);
    __syncthreads();
    (void)xcd_barrier_post((unsigned*)(p0.ws + OFF_SMALL + SMALL_BYTES + 256), (volatile LAS unsigned*)&xb_words);
#define XBAR() do { XcdBarrier xb_; xb_.bar = (unsigned*)(launder(p0).ws + OFF_SMALL + SMALL_BYTES + 256); xb_.x = xb_xcc_id(); xb_.st = (volatile LAS unsigned*)&xb_words; xcd_barrier(xb_); } while (0)
    float* sm = (float*)shm;
    const int G = (int)gridDim.x, B = (int)blockIdx.x;

#ifndef SK_PREP
    phase_prep(launder(p0), shm);
#ifdef PROBE_MISC
    __syncthreads(); phase_prep(launder(p0), shm);
#endif
#endif
    grid.sync();
    phase_reduce(launder(p0));
    XBAR();
#pragma unroll 1
    for (int layer = 0; layer < 2; ++layer) {
#ifndef SK_NORM
        phase_norm(launder(p0), layer, 0, shm);
#ifdef PROBE_MISC
        __syncthreads(); phase_norm(launder(p0), layer, 0, shm);
#endif
#endif
        XBAR();
        { const Params p = launder(p0); const u16* A = (const u16*)(p.ws + OFF_A); pg8::EpiBf16 E; E.O = (u16*)(p.ws + OFF_P); E.ldc = layer ? LDP1 : LDP0;
#if !defined(SK_GEMM) && !defined(SK_GBF)
            run_gemm(shm, A, DM, (const u16*)(p.ws + OFF_WIN), DM, layer ? LDP1 : LDP0, DM, E);
#ifdef PROBE_GEMM
            __syncthreads(); run_gemm(shm, A, DM, (const u16*)(p.ws + OFF_WIN), DM, layer ? LDP1 : LDP0, DM, E);
#endif
#endif
        }
        XBAR();
        if (layer == 0) {
#ifndef SK_PRE
            { const Params p = launder(p0); for (int t = B; t < 6144 + 768; t += G) { if (t < 6144) hy_pre_tile(p, t, sm); else rwkv_lora_tile(p, t - 6144, shm); } }
#ifdef PROBE_MISC
            { const Params p = launder(p0); for (int t = B; t < 6144 + 768; t += G) { if (t < 6144) hy_pre_tile(p, t, sm); else rwkv_lora_tile(p, t - 6144, shm); } }
#endif
#endif
            XBAR();
#ifndef SK_RSCAN
            { const Params p = launder(p0);
            if (B < 128) rwkv_scan_task(p, B, sm);
            else if (G > 128) { for (int j = B - 128; j < 1024; j += G - 128) rwkv_scan_task(p, 128 + j, sm); }
            if (G <= 128) { for (int j = B; j < 1024; j += G) rwkv_scan_task(p, 128 + j, sm); }
#ifdef PROBE_RSCAN
            if (B < 128) rwkv_scan_task(p, B, sm);
            else if (G > 128) { for (int j = B - 128; j < 1024; j += G - 128) rwkv_scan_task(p, 128 + j, sm); }
#endif
            }
#endif
#ifndef SK_HCONV
            { const Params p = launder(p0); unsigned* ctr = (unsigned*)(p.ws + OFF_SMALL + SMALL_BYTES);
                for (;;) { if (tidx() == 0) *(volatile unsigned*)shm = atomicAdd(ctr, 1u); __syncthreads(); const unsigned t = *(volatile unsigned*)shm; __syncthreads(); if (t >= 2048u) break; hyconv_task(p, (int)t, shm); } }
#endif
            XBAR();
#ifndef SK_POST
            { const Params p = launder(p0); for (int t = B; t < 6144 + 1536; t += G) { if (t < 6144) hy_post_tile(p, t, sm); else rwkv_post_tile(p, t - 6144, sm); } }
#ifdef PROBE_MISC
            { const Params p = launder(p0); for (int t = B; t < 6144 + 1536; t += G) { if (t < 6144) hy_post_tile(p, t, sm); else rwkv_post_tile(p, t - 6144, sm); } }
#endif
#endif
            XBAR();
        } else {
#ifndef SK_GLA
            { const Params p = launder(p0); for (int t = B; t < 1536; t += G) gla_intra_task(p, t, shm); }
            XBAR();
            { const Params p = launder(p0); for (int t = B; t < 256 + 2048; t += G) gla_inter_task(p, t, shm); }
#endif
            XBAR();
#ifndef SK_GLAP
            phase_gla_post(launder(p0));
#ifdef PROBE_MISC
            phase_gla_post(launder(p0));
#endif
#endif
            XBAR();
        }
        { const Params p = launder(p0); const u16* A = (const u16*)(p.ws + OFF_A); const float* mods = (const float*)(p.ws + OFF_SMALL); pg8::EpiRes E; E.X = p.out; E.gm = mods + (size_t)layer * 5 * 12288 + 2 * 2048; E.gb = p.in[7] + layer * 12288 + 2 * 2048;
#if !defined(SK_GEMM) && !defined(SK_GRES)
            run_gemm(shm, A, DM, (const u16*)(p.ws + OFF_WOUT), DM, DM, DM, E);
#endif
        }
        XBAR();
#ifndef SK_NORM
        phase_norm(launder(p0), layer, 1, shm);
#ifdef PROBE_MISC
        __syncthreads(); phase_norm(launder(p0), layer, 1, shm);
#endif
#endif
        XBAR();
        { const Params p = launder(p0); const u16* A = (const u16*)(p.ws + OFF_A); pg8::EpiBf16 E; E.O = (u16*)(p.ws + OFF_U); E.ldc = LDU;
#if !defined(SK_GEMM) && !defined(SK_GBF)
            run_gemm(shm, A, DM, (const u16*)(p.ws + OFF_WUP), DM, LDU, DM, E);
#ifdef PROBE_GEMM
            __syncthreads(); run_gemm(shm, A, DM, (const u16*)(p.ws + OFF_WUP), DM, LDU, DM, E);
#endif
#endif
        }
        XBAR();
#ifndef SK_GATE
        phase_ffn_gate(launder(p0), layer);
#endif
        XBAR();
        { const Params p = launder(p0); const float* mods = (const float*)(p.ws + OFF_SMALL); pg8::EpiRes E; E.X = p.out; E.gm = mods + (size_t)layer * 5 * 12288 + 5 * 2048; E.gb = p.in[7] + layer * 12288 + 5 * 2048;
#if !defined(SK_GEMM) && !defined(SK_GRES)
            run_gemm(shm, (const u16*)(p.ws + OFF_U) + DFF, LDU, (const u16*)(p.ws + OFF_WDN), DFF, DM, DFF, E);
#endif
        }
        XBAR();
    }
    phase_final_norm(launder(p0));
}

extern "C" void kernel_launch(void* const* d_in, const int* in_sizes, int n_in, void* d_out, int out_size, void* d_ws, size_t ws_size, hipStream_t stream) {
    constexpr size_t kDynLds = 131072;
    static int grid_blocks = 0;
    if (!grid_blocks) {
        int dev = 0, cus = 0, per_cu = 0;
        hipGetDevice(&dev);
        hipDeviceGetAttribute(&cus, hipDeviceAttributeMultiprocessorCount, dev);
        hipFuncSetAttribute((const void*)mega, hipFuncAttributeMaxDynamicSharedMemorySize, (int)kDynLds);
        hipOccupancyMaxActiveBlocksPerMultiprocessor(&per_cu, mega, 512, kDynLds);
        if (per_cu < 1) per_cu = 1;
        grid_blocks = cus * per_cu;
        if (grid_blocks > 256) grid_blocks = 256;
    }
    if (ws_size < WS_NEED || n_in < 41) { fprintf(stderr, "workspace too small: %zu < %zu\n", ws_size, WS_NEED); return; }
    Params p{};
    for (int i = 0; i < 41; ++i) p.in[i] = (const float*)d_in[i];
    p.out = (float*)d_out; p.ws = (unsigned char*)d_ws;
    hipMemsetAsync((unsigned char*)d_ws + OFF_SMALL + SMALL_BYTES, 0, 256 + XCD_BAR_BYTES, stream);
    void* args[] = {&p};
    hipError_t e = hipLaunchCooperativeKernel((const void*)mega, dim3(grid_blocks), dim3(512), args, kDynLds, stream);
    if (e != hipSuccess) fprintf(stderr, "cooperative launch failed: %s (grid %d)\n", hipGetErrorString(e), grid_blocks);
}
```

```cpp
#include <hip/hip_runtime.h>
#include <hip/hip_cooperative_groups.h>
#include <cstdio>
namespace cg = cooperative_groups;

#define DEV __device__ __forceinline__
#define LAS __attribute__((address_space(3)))
typedef unsigned short u16;
typedef short bf16x8 __attribute__((ext_vector_type(8)));
typedef float f32x4 __attribute__((ext_vector_type(4)));
typedef float f32x16 __attribute__((ext_vector_type(16)));
typedef unsigned u32x2 __attribute__((ext_vector_type(2)));
typedef unsigned u32x4 __attribute__((ext_vector_type(4)));

constexpr int NTOK = 24576, NTP = 8192, DM = 2048;
constexpr int LDP0 = 6656, LDP1 = 6400, LDU = 11264, DFF = 5632;
constexpr size_t OFF_WIN = 0, OFF_WOUT = 27262976, OFF_WUP = 35651584, OFF_WDN = OFF_WUP + 46137344;
constexpr size_t OFF_A = 104857600, OFF_BIG = 205520896;
constexpr size_t OFF_P = OFF_BIG, OFF_RW = OFF_BIG + 327155712, OFF_UT = OFF_RW + 201326592, OFF_GS = OFF_UT + 50331648, OFF_GP = OFF_GS + 16777216;
constexpr size_t OFF_U = OFF_BIG, OFF_OF = OFF_BIG + 314572800, OFF_OB = OFF_OF + 100663296, OFF_DB = OFF_OB + 100663296;
constexpr size_t OFF_SMALL = OFF_BIG + 600000000, SMALL_BYTES = 491520 + 8192;
constexpr size_t XCD_BAR_BYTES = 3456 * 4;
constexpr size_t OFF_LW = OFF_SMALL + SMALL_BYTES + 256 + XCD_BAR_BYTES;
constexpr size_t OFF_G2T = OFF_LW + 524288;
constexpr size_t WS_NEED = OFF_G2T + 262144;
constexpr size_t OUT_RWST = 50331648, OUT_GLAST = 54525952;

struct Params {
    const float* in[41];
    float* out;
    unsigned char* ws;
};

DEV int tidx() { int t = threadIdx.x; asm volatile("" : "+v"(t)); return t; }
DEV Params launder(const Params& p) { Params q = p; asm volatile("" : "+s"(q.ws), "+s"(q.out)); return q; }
DEV float bf2f(unsigned b) { return __uint_as_float(b << 16); }
DEV float bflo(unsigned w) { return __uint_as_float(w << 16); }
DEV float bfhi(unsigned w) { return __uint_as_float(w & 0xffff0000u); }
DEV unsigned pk(float lo, float hi) { unsigned r; asm("v_cvt_pk_bf16_f32 %0, %1, %2" : "=v"(r) : "v"(lo), "v"(hi)); return r; }
DEV u16 f2bf(float f) { return (u16)(pk(f, 0.f) & 0xffffu); }
DEV float wave_sum(float v) {
#pragma unroll
    for (int o = 32; o > 0; o >>= 1) v += __shfl_xor(v, o);
    return v;
}
template <int CTRL> DEV float dppf(float x) { return __builtin_bit_cast(float, __builtin_amdgcn_update_dpp(0, __builtin_bit_cast(int, x), CTRL, 0xf, 0xf, true)); }
DEV float sum8(float v) { v += dppf<0xB1>(v); v += dppf<0x4E>(v); v += dppf<0x141>(v); return v; }
DEV float sum16(float v) { v = sum8(v); v += dppf<0x140>(v); return v; }
DEV f32x4 mfma16(bf16x8 a, bf16x8 b, f32x4 c) { return __builtin_amdgcn_mfma_f32_16x16x32_bf16(a, b, c, 0, 0, 0); }
DEV float sigm(float x) { return 1.f / (1.f + __expf(-x)); }
DEV int tok_cond(int tok) { return tok < NTP ? 4 : ((tok - NTP) >> 12); }
DEV void tok_tl(int tok, int& t, int& L) { if (tok < NTP) { t = tok & 255; L = 256; } else { t = (tok - NTP) & 4095; L = 4096; } }
DEV void unpack8(u32x4 w, float* o) { o[0] = bflo(w.x); o[1] = bfhi(w.x); o[2] = bflo(w.y); o[3] = bfhi(w.y); o[4] = bflo(w.z); o[5] = bfhi(w.z); o[6] = bflo(w.w); o[7] = bfhi(w.w); }
DEV void unpack4(u32x2 w, float* o) { o[0] = bflo(w.x); o[1] = bfhi(w.x); o[2] = bflo(w.y); o[3] = bfhi(w.y); }

namespace pg8 {
constexpr int BM = 256, BK = 64, HALF = 128, HTB = HALF * BK * 2, NXCD = 8, WGM = 8;
DEV int lds_byte(int r, int c) { const int st = (r >> 4) * 2 + (c >> 5), rr = r & 15, cc = c & 31, ob = rr * 64 + cc * 2; return st * 1024 + (ob ^ (((ob >> 9) & 1) << 5)); }
DEV void stage_rc(int b, int& R, int& C) { const int st = b / 1024, sb = b % 1024, swz = sb ^ (((sb >> 9) & 1) << 5); R = (st >> 1) * 16 + swz / 64; C = (st & 1) * 32 + (swz % 64) / 2; }
DEV int perm32(int rho) { const int n = rho >> 4, i = rho & 15; return 8 * (i >> 2) + 4 * n + (i & 3); }
struct Unit { int pm, pn; };
struct Gemm { const u16* A; const u16* Bt; int M, N, K, lda, ldb; };
struct StaticOrder {
    int nM, nN, nwg, G, c;
    DEV void init(int M, int N, int G_, int c_) { nM = M / BM; nN = N / BM; nwg = nM * nN; G = G_; c = c_; }
    DEV bool next(int i, Unit& u) const {
        const long L = (long)i * G + c; if (L >= nwg) return false;
        int wgid = (int)L; { const int q = nwg / NXCD, r = nwg % NXCD, xcd = wgid % NXCD, off = wgid / NXCD; wgid = (xcd < r ? xcd * (q + 1) : r * (q + 1) + (xcd - r) * q) + off; }
        const int nig = WGM * nN, gid = wgid / nig, fm = gid * WGM, gsz = (nM - fm) < WGM ? (nM - fm) : WGM;
        u.pm = fm + ((wgid % nig) % gsz); u.pn = (wgid % nig) / gsz; return true;
    }
};
struct EpiBf16 {
    static constexpr bool PERM = true;
    u16* O; int ldc;
    DEV void operator()(const f32x4 (&acc)[2][2][4][2], const Unit& u, int wr, int wc, int fr, int fq) const {
        const int row0 = u.pm * BM + wr * 64 + fr; const int col0 = u.pn * BM + wc * 32 + 8 * fq;
#pragma unroll
        for (int ai = 0; ai < 2; ++ai)
#pragma unroll
            for (int m = 0; m < 4; ++m) { u16* rowp = O + (size_t)(row0 + ai * HALF + m * 16) * ldc + col0;
#pragma unroll
                for (int bj = 0; bj < 2; ++bj) { const f32x4 v0 = acc[ai][bj][m][0], v1 = acc[ai][bj][m][1];
                    u32x4 w; w.x = pk(v0[0], v0[1]); w.y = pk(v0[2], v0[3]); w.z = pk(v1[0], v1[1]); w.w = pk(v1[2], v1[3]);
                    *(u32x4*)(rowp + bj * HALF) = w; } }
    }
};
struct EpiRes {
    static constexpr bool PERM = false;
    float* X; const float* gm; const float* gb;
    DEV void operator()(const f32x4 (&acc)[2][2][4][2], const Unit& u, int wr, int wc, int fr, int fq) const {
        const int row0 = u.pm * BM + wr * 64 + fr, col0 = u.pn * BM + wc * 32 + 4 * fq;
        const int cond = u.pm < 32 ? 4 : ((u.pm - 32) >> 4);
        const float* gmc = gm + (size_t)cond * 12288 + col0; const float* gbc = gb + col0;
#pragma unroll
        for (int ai = 0; ai < 2; ++ai)
#pragma unroll
            for (int m = 0; m < 4; ++m) { float* rowp = X + (size_t)(row0 + ai * HALF + m * 16) * DM + col0;
#pragma unroll
                for (int bj = 0; bj < 2; ++bj) {
#pragma unroll
                    for (int n = 0; n < 2; ++n) { f32x4* q = (f32x4*)(rowp + bj * HALF + n * 16);
                        const f32x4 gvv = *(const f32x4*)(gmc + bj * HALF + n * 16) + *(const f32x4*)(gbc + bj * HALF + n * 16);
                        *q = *q + gvv * acc[ai][bj][m][n]; }
                    asm volatile("" ::: "memory"); } }
    }
};

template <class Epi>
DEV void gemm_phase(LAS unsigned char* lds, const Gemm g, const StaticOrder& S, const Epi& E) {
    const int tid = tidx(), wid = __builtin_amdgcn_readfirstlane(tid >> 6), lane = tid & 63, wr = wid >> 2, wc = wid & 3, fr = lane & 15, fq = lane >> 4;
    const int K = g.K, nt = K / BK;
    unsigned voffA[2], voffB[2];
#pragma unroll
    for (int i = 0; i < 2; ++i) { int R, C; stage_rc(tid * 16 + i * 8192, R, C); const int Rb = Epi::PERM ? ((R & ~31) + perm32(R & 31)) : R;
        voffA[i] = (unsigned)(R * g.lda + C) * 2u; voffB[i] = (unsigned)(Rb * g.ldb + C) * 2u; }
    const size_t kstep = (size_t)(BK * 2);
    const size_t hstepA = (size_t)HALF * g.lda * 2, hstepB = (size_t)HALF * g.ldb * 2;
    const size_t tstepA = 2 * hstepA, tstepB = 2 * hstepB;
    const unsigned ldsw = (unsigned)wid * 1024u;
    const int aoff = lds_byte(wr * 64 + fr, fq * 8), boff = lds_byte(wc * 32 + fr, fq * 8);
#define PG8_SA(b, h) (((b) * 2 + (h)) * HTB)
#define PG8_SB(b, h) ((4 + (b) * 2 + (h)) * HTB)
#define PG8_STAGE(bufoff, gbase, voff) do { _Pragma("unroll") for (int _i = 0; _i < 2; ++_i) \
        __builtin_amdgcn_global_load_lds((const unsigned*)((const char*)(gbase) + (voff)[_i]), (LAS unsigned*)(lds + (bufoff) + ldsw + _i * 8192), 16, 0, 0); } while (0)
#define PG8_LDA(dst, b, h) do { _Pragma("unroll") for (int m = 0; m < 4; ++m) _Pragma("unroll") for (int k = 0; k < 2; ++k) dst[m][k] = *(const LAS bf16x8*)(lds + PG8_SA(b, h) + aoff + m * 2048 + k * 1024); } while (0)
#define PG8_LDB(dst, b, h) do { _Pragma("unroll") for (int n = 0; n < 2; ++n) _Pragma("unroll") for (int k = 0; k < 2; ++k) dst[n][k] = *(const LAS bf16x8*)(lds + PG8_SB(b, h) + boff + n * 2048 + k * 1024); } while (0)
#define PG8_MMA(ai, bj, At, Bt) do { __builtin_amdgcn_s_setprio(1); _Pragma("unroll") for (int m = 0; m < 4; ++m) _Pragma("unroll") for (int n = 0; n < 2; ++n) _Pragma("unroll") for (int k = 0; k < 2; ++k) \
        acc[ai][bj][m][n] = __builtin_amdgcn_mfma_f32_16x16x32_bf16(Bt[n][k], At[m][k], acc[ai][bj][m][n], 0, 0, 0); __builtin_amdgcn_s_setprio(0); } while (0)
#define PG8_WAIT_V(n) asm volatile("s_waitcnt vmcnt(" #n ")" ::: "memory")
#define PG8_WAIT_L(n) asm volatile("s_waitcnt lgkmcnt(" #n ")" ::: "memory")
#define PG8_BAR __builtin_amdgcn_s_barrier()
#define PG8_SCHED __builtin_amdgcn_sched_barrier(0)
    Unit cur, nxt; int ui = 0;
    if (!S.next(0, cur)) return;
    f32x4 acc[2][2][4][2];
#pragma unroll
    for (int a = 0; a < 2; ++a)
#pragma unroll
        for (int b = 0; b < 2; ++b)
#pragma unroll
            for (int m = 0; m < 4; ++m)
#pragma unroll
                for (int n = 0; n < 2; ++n) acc[a][b][m][n] = (f32x4){0.f, 0.f, 0.f, 0.f};
    bf16x8 At[4][2], B0[2][2], B1[2][2];
    const char* cA = (const char*)g.A + (size_t)cur.pm * tstepA; const char* cB = (const char*)g.Bt + (size_t)cur.pn * tstepB;
    PG8_STAGE(PG8_SB(0, 0), cB, voffB); PG8_STAGE(PG8_SA(0, 0), cA, voffA); PG8_STAGE(PG8_SB(0, 1), cB + hstepB, voffB); PG8_STAGE(PG8_SA(0, 1), cA + hstepA, voffA);
    if (wr == 1) PG8_BAR;
    PG8_WAIT_V(4); PG8_BAR;
    PG8_STAGE(PG8_SB(1, 0), cB + kstep, voffB); PG8_STAGE(PG8_SA(1, 0), cA + kstep, voffA); PG8_STAGE(PG8_SB(1, 1), cB + hstepB + kstep, voffB);
    PG8_WAIT_V(6); PG8_BAR;
    for (;;) {
        const bool has_next = S.next(ui + 1, nxt);
        const char* nA = has_next ? (const char*)g.A + (size_t)nxt.pm * tstepA : cA; const char* nB = has_next ? (const char*)g.Bt + (size_t)nxt.pn * tstepB : cB;
        for (int t = 0; t < nt; t += 2) {
            const bool last = (t == nt - 2);
            const char* a1 = cA + (size_t)(t + 1) * kstep;
            const char* a2 = last ? nA : cA + (size_t)(t + 2) * kstep; const char* b2 = last ? nB : cB + (size_t)(t + 2) * kstep;
            const char* a3 = a2 + kstep; const char* b3 = b2 + kstep;
            PG8_LDB(B0, 0, 0); PG8_SCHED; PG8_LDA(At, 0, 0); PG8_STAGE(PG8_SA(1, 1), a1 + hstepA, voffA);
            PG8_WAIT_L(8); PG8_BAR; PG8_WAIT_L(0); PG8_MMA(0, 0, At, B0); PG8_BAR; PG8_SCHED;
            PG8_LDB(B1, 0, 1); PG8_STAGE(PG8_SB(0, 0), b2, voffB);
            PG8_BAR; PG8_WAIT_L(0); PG8_MMA(0, 1, At, B1); PG8_BAR;
            PG8_LDA(At, 0, 1); PG8_STAGE(PG8_SA(0, 0), a2, voffA);
            PG8_BAR; PG8_WAIT_L(0); PG8_MMA(1, 0, At, B0); PG8_BAR; PG8_SCHED;
            PG8_STAGE(PG8_SB(0, 1), b2 + hstepB, voffB);
            PG8_WAIT_V(6); PG8_BAR; PG8_MMA(1, 1, At, B1); PG8_BAR;
            PG8_LDB(B0, 1, 0); PG8_SCHED; PG8_LDA(At, 1, 0); PG8_STAGE(PG8_SA(0, 1), a2 + hstepA, voffA);
            PG8_WAIT_L(8); PG8_BAR; PG8_WAIT_L(0); PG8_MMA(0, 0, At, B0); PG8_BAR; PG8_SCHED;
            PG8_LDB(B1, 1, 1); PG8_STAGE(PG8_SB(1, 0), b3, voffB);
            PG8_BAR; PG8_WAIT_L(0); PG8_MMA(0, 1, At, B1); PG8_BAR;
            PG8_LDA(At, 1, 1); PG8_STAGE(PG8_SA(1, 0), a3, voffA);
            PG8_BAR; PG8_WAIT_L(0); PG8_MMA(1, 0, At, B0); PG8_BAR; PG8_SCHED;
            PG8_STAGE(PG8_SB(1, 1), b3 + hstepB, voffB);
            PG8_WAIT_V(6); PG8_BAR; PG8_MMA(1, 1, At, B1); PG8_BAR;
        }
        E(acc, cur, wr, wc, fr, fq);
        if (!has_next) break;
#pragma unroll
        for (int a = 0; a < 2; ++a)
#pragma unroll
            for (int b = 0; b < 2; ++b)
#pragma unroll
                for (int m = 0; m < 4; ++m)
#pragma unroll
                    for (int n = 0; n < 2; ++n) acc[a][b][m][n] = (f32x4){0.f, 0.f, 0.f, 0.f};
        cur = nxt; cA = nA; cB = nB; ++ui;
    }
    PG8_WAIT_V(0);
    if (wr == 0) PG8_BAR;
    PG8_BAR;
#undef PG8_SA
#undef PG8_SB
#undef PG8_STAGE
#undef PG8_LDA
#undef PG8_LDB
#undef PG8_MMA
#undef PG8_WAIT_V
#undef PG8_WAIT_L
#undef PG8_BAR
#undef PG8_SCHED
}
}

template <class Epi>
DEV void run_gemm(unsigned char* shm, const u16* A, int lda, const u16* Bt, int ldb, int N, int K, const Epi& E) {
    asm volatile("" : "+s"(A), "+s"(Bt));
    pg8::Gemm g; g.A = A; g.Bt = Bt; g.M = NTOK; g.N = N; g.K = K; g.lda = lda; g.ldb = ldb;
    pg8::StaticOrder S; S.init(NTOK, N, (int)gridDim.x, (int)blockIdx.x);
    pg8::gemm_phase<Epi>((LAS unsigned char*)shm, g, S, E);
}

DEV void convT_tile(const float* __restrict__ src, u16* __restrict__ dst, int K, int N, int Npad, int tile, float* T) {
    const int tid = tidx(); const int ntn = Npad >> 6; const int k0 = (tile / ntn) << 6, n0 = (tile % ntn) << 6;
#pragma unroll
    for (int j = 0; j < 2; ++j) { const int idx = tid + j * 512; const int r = idx >> 4, c4 = (idx & 15) << 2;
        float4 v = make_float4(0.f, 0.f, 0.f, 0.f); if (n0 + c4 < N) v = *(const float4*)(src + (size_t)(k0 + r) * N + n0 + c4);
        float* t = T + r * 65 + c4; t[0] = v.x; t[1] = v.y; t[2] = v.z; t[3] = v.w; }
    __syncthreads();
    { const int nn = tid >> 3, kq = (tid & 7) << 3; const float* t = T + kq * 65 + nn;
        u32x4 o; o.x = pk(t[0], t[65]); o.y = pk(t[130], t[195]); o.z = pk(t[260], t[325]); o.w = pk(t[390], t[455]);
        *(u32x4*)(dst + (size_t)(n0 + nn) * K + k0 + kq) = o; }
    __syncthreads();
}
DEV int conv_ntiles(int job, int layer) { return job == 0 ? (layer ? 3200 : 3328) : job == 1 ? 1024 : job == 2 ? 5632 : 2816; }
DEV void conv_job(const Params& p, int job, int layer, int tile, float* T) {
    if (job == 0) convT_tile(layer ? p.in[36] : p.in[14], (u16*)(p.ws + OFF_WIN), 2048, layer ? 6176 : 6528, layer ? LDP1 : LDP0, tile, T);
    else if (job == 1) convT_tile(layer ? p.in[37] : p.in[15], (u16*)(p.ws + OFF_WOUT), 2048, 2048, 2048, tile, T);
    else if (job == 2) convT_tile(p.in[10] + (size_t)layer * 2048 * 11264, (u16*)(p.ws + OFF_WUP), 2048, 11264, 11264, tile, T);
    else convT_tile(p.in[12] + (size_t)layer * 5632 * 2048, (u16*)(p.ws + OFF_WDN), 5632, 2048, 2048, tile, T);
}

DEV void adaln_tile(const Params& p, int tile, float* sl) {
    const int tid = tidx(); const int nt = tile % 6, kc = (tile / 6) & 31, layer = tile / 192;
    if (tid < 320) { const int j = tid >> 6, kk = tid & 63; const float cv = (j < 4) ? p.in[4][j * 2048 + kc * 64 + kk] : p.in[5][kc * 64 + kk]; sl[tid] = cv / (1.f + expf(-cv)); }
    __syncthreads();
    const float* w = p.in[6] + ((size_t)layer * 2048 + kc * 64) * 12288 + nt * 2048 + tid * 4;
    float acc[5][4];
#pragma unroll
    for (int j = 0; j < 5; ++j) { acc[j][0] = 0.f; acc[j][1] = 0.f; acc[j][2] = 0.f; acc[j][3] = 0.f; }
#pragma unroll 8
    for (int kk = 0; kk < 64; ++kk) { const float4 wv = *(const float4*)(w + (size_t)kk * 12288);
#pragma unroll
        for (int j = 0; j < 5; ++j) { const float s = sl[j * 64 + kk]; acc[j][0] += s * wv.x; acc[j][1] += s * wv.y; acc[j][2] += s * wv.z; acc[j][3] += s * wv.w; } }
    float* m = (float*)(p.ws + OFF_A) + (size_t)kc * 122880 + (size_t)layer * 5 * 12288 + nt * 2048 + tid * 4;
#pragma unroll
    for (int j = 0; j < 5; ++j) *(float4*)(m + j * 12288) = make_float4(acc[j][0], acc[j][1], acc[j][2], acc[j][3]);
    __syncthreads();
}

DEV void hyfilt_tile(const Params& p, int tile, float* sm) {
    const int tid = tidx();
    int L, p0; u16* G; float* nrm = (float*)(p.ws + OFF_A) + 32 * 122880 + (size_t)tile * 2048;
    if (tile < 128) { L = 4096; p0 = tile * 32; G = (u16*)(p.ws + OFF_GS); }
    else { L = 256; p0 = (tile - 128) * 32; G = (u16*)(p.ws + OFF_GP); }
    float* z = sm; float* h1 = sm + 32 * 33; float* h2 = h1 + 2048;
    const float cang = (float)(6.283185307179586 / (double)L);
    for (int i = tid; i < 32 * 33; i += 512) { const int pp = i / 33, e = i % 33; const float pos = (float)(p0 + pp); float val;
        if (e == 0) val = pos / (float)(L - 1);
        else { const int bi = (e - 1) & 15; const float fb = 1e-4f + (float)bi * ((15.f - 1e-4f) / 15.f); const float ang = (cang * pos) * fb; val = (e <= 16) ? cosf(ang) : -sinf(ang); }
        z[i] = val; }
    __syncthreads();
    for (int i = tid; i < 2048; i += 512) { const int pp = i >> 6, j = i & 63; float a = p.in[19][j];
        for (int e = 0; e < 33; ++e) a += z[pp * 33 + e] * p.in[18][e * 64 + j];
        h1[i] = sinf(p.in[23][j] * a); }
    __syncthreads();
    for (int i = tid; i < 2048; i += 512) { const int pp = i >> 6, j = i & 63; float a = p.in[21][j];
        for (int e = 0; e < 64; ++e) a += h1[pp * 64 + e] * p.in[20][e * 64 + j];
        h2[i] = sinf(p.in[23][64 + j] * a); }
    __syncthreads();
    const float dlo = 3.0701134573253946f, dhi = 15.350567286626973f;
    for (int q = 0; q < 4; ++q) { const int n = tid + 512 * q; const int c = n & 1023; const int back = n >> 10;
        float wcol[64];
#pragma unroll
        for (int e = 0; e < 64; ++e) wcol[e] = p.in[22][e * 2048 + n];
        const float delta = dlo + (dhi - dlo) * ((float)c / 1023.f);
        float asum = 0.f;
        for (int pp = 0; pp < 32; ++pp) { float a = 0.f;
#pragma unroll
            for (int e = 0; e < 64; ++e) a += h2[pp * 64 + e] * wcol[e];
            const int pos = p0 + pp; const float t = (float)pos / (float)(L - 1); a *= expf(-t * delta);
            if (!(back && pos == 0)) { asum += fabsf(a); const int lag = back ? -pos : pos; G[(size_t)c * (2 * L) + (L - lag)] = f2bf(a); } }
        nrm[n] = asum; }
    if (p0 == 0) for (int c = tid; c < 1024; c += 512) G[(size_t)c * (2 * L)] = 0;
    __syncthreads();
}

DEV void phase_prep(const Params& p, unsigned char* shm) {
    const int tid = tidx(); float* sm = (float*)shm;
    if (blockIdx.x == 0 && tid == 0) *(unsigned*)(p.ws + OFF_SMALL + SMALL_BYTES) = 0u;
    { u16* LW = (u16*)(p.ws + OFF_LW); u16* G2T = (u16*)(p.ws + OFF_G2T);
        for (int i = blockIdx.x * 512 + tid; i < 4 * 1024 * 64 + 1024 * 128; i += gridDim.x * 512) {
            if (i < 262144) { const int mi = i >> 16, n = (i >> 6) & 1023, r = i & 63; LW[i] = f2bf((mi < 2 ? p.in[27] : p.in[29])[((size_t)(mi & 1) * 64 + r) * 1024 + n]); }
            else { const int j = i - 262144; const int n = j >> 7, r = j & 127; G2T[j] = f2bf(p.in[30][(size_t)r * 1024 + n]); } } }
    const int n0 = 136, n1 = n0 + 384, n2 = n1 + 3328, n3 = n2 + 1024, n4 = n3 + 5632, n5 = n4 + 2816;
    for (int t = blockIdx.x; t < n5; t += gridDim.x) {
        if (t < n0) hyfilt_tile(p, t, sm);
        else if (t < n1) adaln_tile(p, t - n0, sm);
        else if (t < n2) conv_job(p, 0, 0, t - n1, sm);
        else if (t < n3) conv_job(p, 1, 0, t - n2, sm);
        else if (t < n4) conv_job(p, 2, 0, t - n3, sm);
        else conv_job(p, 3, 0, t - n4, sm);
    }
}

DEV void phase_reduce(const Params& p) {
    const float* part = (const float*)(p.ws + OFF_A); float* mods = (float*)(p.ws + OFF_SMALL); float* hn = (float*)(p.ws + OFF_SMALL + 491520);
    for (int i = blockIdx.x * 512 + tidx(); i < 122880 + 2048; i += gridDim.x * 512) {
        if (i < 122880) { float a = 0.f; for (int kc = 0; kc < 32; ++kc) a += part[(size_t)kc * 122880 + i]; mods[i] = a; }
        else { const int j = i - 122880; const int c = j & 1023; const float* hp = part + 32 * 122880; float a = 0.f;
            if (j < 1024) { for (int t = 0; t < 128; ++t) a += hp[(size_t)t * 2048 + c] + hp[(size_t)t * 2048 + 1024 + c]; }
            else { for (int t = 128; t < 136; ++t) a += hp[(size_t)t * 2048 + c] + hp[(size_t)t * 2048 + 1024 + c]; }
            hn[j] = a; }
    }
}

DEV void phase_norm(const Params& p, int layer, int which, unsigned char* shm) {
    const int tid = tidx(), wid = tid >> 6, lane = tid & 63;
    const float* g = p.in[which ? 9 : 8] + layer * 2048;
    const float* X = p.out; u16* A = (u16*)(p.ws + OFF_A);
    const float* mods = (const float*)(p.ws + OFF_SMALL) + (size_t)layer * 5 * 12288; const float* bb = p.in[7] + layer * 12288;
    const int shi = which ? 3 : 0;
    for (int row = blockIdx.x * 8 + wid; row < NTOK; row += gridDim.x * 8) {
        const bool first = (layer == 0 && which == 0);
        const float* xsrc = X + (size_t)row * DM; if (first) xsrc = row < NTP ? p.in[0] + (size_t)row * DM : p.in[1] + (size_t)(row - NTP) * DM;
        const float4* xr = (const float4*)xsrc;
        float4 v[8]; float ss = 0.f;
#pragma unroll
        for (int j = 0; j < 8; ++j) { v[j] = xr[lane + 64 * j]; ss += v[j].x * v[j].x + v[j].y * v[j].y + v[j].z * v[j].z + v[j].w * v[j].w; }
        if (first) {
#pragma unroll
            for (int j = 0; j < 8; ++j) ((float4*)(p.out + (size_t)row * DM))[lane + 64 * j] = v[j]; }
        ss = wave_sum(ss);
        const float rstd = rsqrtf(ss * (1.f / 2048.f) + 1e-6f);
        const float* md = mods + (size_t)tok_cond(row) * 12288;
#pragma unroll
        for (int j = 0; j < 8; ++j) { const int col = (lane + 64 * j) * 4;
            const float4 gg = *(const float4*)(g + col);
            const float4 s1 = *(const float4*)(md + shi * 2048 + col), s2 = *(const float4*)(bb + shi * 2048 + col);
            const float4 c1 = *(const float4*)(md + (shi + 1) * 2048 + col), c2 = *(const float4*)(bb + (shi + 1) * 2048 + col);
            const float o0 = v[j].x * rstd * gg.x * (1.f + c1.x + c2.x) + s1.x + s2.x;
            const float o1 = v[j].y * rstd * gg.y * (1.f + c1.y + c2.y) + s1.y + s2.y;
            const float o2 = v[j].z * rstd * gg.z * (1.f + c1.z + c2.z) + s1.z + s2.z;
            const float o3 = v[j].w * rstd * gg.w * (1.f + c1.w + c2.w) + s1.w + s2.w;
            u32x2 o; o.x = pk(o0, o1); o.y = pk(o2, o3);
            *(u32x2*)(A + (size_t)row * DM + col) = o; }
    }
    if (layer == 0 && which == 1) { const int na = conv_ntiles(0, 1), nb = na + conv_ntiles(1, 1);
        for (int t = blockIdx.x; t < nb; t += gridDim.x) { if (t < na) conv_job(p, 0, 1, t, (float*)shm); else conv_job(p, 1, 1, t - na, (float*)shm); } }
    if (layer == 1 && which == 0) { const int na = conv_ntiles(2, 1), nb = na + conv_ntiles(3, 1);
        for (int t = blockIdx.x; t < nb; t += gridDim.x) { if (t < na) conv_job(p, 2, 1, t, (float*)shm); else conv_job(p, 3, 1, t - na, (float*)shm); } }
}

DEV void sconv8(const u16* prow, bool hm, bool hp, const float* sw, const float* sb, int ch, float* o) {
    float c[8], m[8], q[8];
    unpack8(*(const u32x4*)(prow + ch), c);
    if (hm) unpack8(*(const u32x4*)(prow - LDP0 + ch), m); else { for (int i = 0; i < 8; ++i) m[i] = 0.f; }
    if (hp) unpack8(*(const u32x4*)(prow + LDP0 + ch), q); else { for (int i = 0; i < 8; ++i) q[i] = 0.f; }
#pragma unroll
    for (int i = 0; i < 8; ++i) o[i] = m[i] * sw[ch + i] + c[i] * sw[3072 + ch + i] + q[i] * sw[6144 + ch + i] + sb[ch + i];
}
DEV void hy_pre_tile(const Params& p, int tile, float* T) {
    const int tid = tidx(); const int tok0 = (tile >> 4) << 6, c0 = (tile & 15) << 6;
    const u16* P = (const u16*)(p.ws + OFF_P); u16* uT = (u16*)(p.ws + OFF_UT);
    { const int tk = tid >> 3, c8 = (tid & 7) << 3; const int tok = tok0 + tk; int t, L; tok_tl(tok, t, L);
        const u16* prow = P + (size_t)tok * LDP0; float x1[8], vv[8];
        sconv8(prow, t > 0, t < L - 1, p.in[16], p.in[17], 1024 + c0 + c8, x1);
        sconv8(prow, t > 0, t < L - 1, p.in[16], p.in[17], 2048 + c0 + c8, vv);
#pragma unroll
        for (int i = 0; i < 8; ++i) T[tk * 65 + c8 + i] = x1[i] * vv[i]; }
    __syncthreads();
    { const int ch = tid >> 3, t8 = (tid & 7) << 3; const float* t = T + t8 * 65 + ch;
        u32x4 o; o.x = pk(t[0], t[65]); o.y = pk(t[130], t[195]); o.z = pk(t[260], t[325]); o.w = pk(t[390], t[455]);
        *(u32x4*)(uT + (size_t)(c0 + ch) * NTOK + tok0 + t8) = o; }
    __syncthreads();
}
DEV void hy_post_tile(const Params& p, int tile, float* T) {
    const int tid = tidx(); const int tok0 = (tile >> 4) << 6, c0 = (tile & 15) << 6;
    const u16* P = (const u16*)(p.ws + OFF_P); const u16* uT = (const u16*)(p.ws + OFF_UT); u16* ycat = (u16*)(p.ws + OFF_A);
    { const int ch = tid >> 3, t8 = (tid & 7) << 3; float y[8]; unpack8(*(const u32x4*)(uT + (size_t)(c0 + ch) * NTOK + tok0 + t8), y);
#pragma unroll
        for (int i = 0; i < 8; ++i) T[(t8 + i) * 65 + ch] = y[i]; }
    __syncthreads();
    { const int tk = tid >> 3, c8 = (tid & 7) << 3; const int tok = tok0 + tk; int t, L; tok_tl(tok, t, L);
        const u16* prow = P + (size_t)tok * LDP0; float x0[8], x1[8], vv[8], o[8];
        sconv8(prow, t > 0, t < L - 1, p.in[16], p.in[17], c0 + c8, x0);
        sconv8(prow, t > 0, t < L - 1, p.in[16], p.in[17], 1024 + c0 + c8, x1);
        sconv8(prow, t > 0, t < L - 1, p.in[16], p.in[17], 2048 + c0 + c8, vv);
        const float* nrm = (const float*)(p.ws + OFF_SMALL + 491520) + (tok < NTP ? 1024 : 0);
#pragma unroll
        for (int i = 0; i < 8; ++i) { const int c = c0 + c8 + i; o[i] = x0[i] * (T[tk * 65 + c8 + i] / nrm[c] + x1[i] * vv[i] * p.in[24][c]); }
        u32x4 w; w.x = pk(o[0], o[1]); w.y = pk(o[2], o[3]); w.z = pk(o[4], o[5]); w.w = pk(o[6], o[7]);
        *(u32x4*)(ycat + (size_t)tok * DM + c0 + c8) = w; }
    __syncthreads();
}
DEV void hyconv_task(const Params& p, int task, unsigned char* shm) {
    const int tid = tidx(), wid = tid >> 6, lane = tid & 63;
    const bool sample = task < 1024; const int c = sample ? task : task - 1024;
    const int L = sample ? 4096 : 256, NB = sample ? 4 : 32, lgNB = sample ? 2 : 5, LP = L + 8;
    u16* uL = (u16*)shm; u16* gL = uL + NB * LP; u16* gS = gL + 2 * L;
    const u16* G = sample ? (const u16*)(p.ws + OFF_GS) + (size_t)c * 8192 : (const u16*)(p.ws + OFF_GP) + (size_t)c * 512;
    u16* uT = (u16*)(p.ws + OFF_UT) + (size_t)c * NTOK + (sample ? NTP : 0);
    for (int i = tid * 8; i < NB * L; i += 4096) { const int b = i / L, s = i % L; *(u32x4*)(uL + b * LP + s) = *(const u32x4*)(uT + i); }
    for (int i = tid * 8; i < 2 * L; i += 4096) { const u32x4 w = *(const u32x4*)(G + i); *(u32x4*)(gL + i) = w;
        const unsigned nx = (i + 8 < 2 * L) ? (unsigned)G[i + 8] : 0u;
        u32x4 sft; sft.x = (w.x >> 16) | (w.y << 16); sft.y = (w.y >> 16) | (w.z << 16); sft.z = (w.z >> 16) | (w.w << 16); sft.w = (w.w >> 16) | (nx << 16);
        *(u32x4*)(gS + i) = sft; }
    __syncthreads();
    const int ntile = (NB * (L >> 5)) >> 5;
    const int npair = sample ? 8 : 8; const bool two = sample;
    const int r = lane & 31, half = lane >> 5;
    {
        const int ct0 = two ? 2 * wid : wid;
        const int colA = ct0 * 32 + r, colB = colA + 32;
        const int bA = colA & (NB - 1), iA = colA >> lgNB, bB = colB & (NB - 1), iB = colB >> lgNB; const int tA = iA * 32, tB = iB * 32;
        const int i_lo = (ct0 * 32) >> lgNB, i_hi = ((two ? ct0 + 1 : ct0) * 32 + 31) >> lgNB;
        const int d_lo = 32 * i_lo - (L - 16), d_hi = 32 * i_hi;
        f32x16 accA, accB;
#pragma unroll
        for (int j = 0; j < 16; ++j) { accA[j] = 0.f; accB[j] = 0.f; }
        const u16* ubA = uL + bA * LP + 8 * half; const u16* ubB = uL + bB * LP + 8 * half;
        const u16* gsel = (r & 1) ? gS : gL;
        const int qb = (L - r + 8 * half) & ~1;
        for (int dl = d_lo; dl <= d_hi; dl += 16) {
            const unsigned* gq = (const unsigned*)(gsel + (qb - dl));
            u32x4 aw; aw.x = gq[0]; aw.y = gq[1]; aw.z = gq[2]; aw.w = gq[3];
            const bf16x8 a = __builtin_bit_cast(bf16x8, aw);
            const int sA = tA - dl, sB = tB - dl;
            bf16x8 bvA = (bf16x8){0, 0, 0, 0, 0, 0, 0, 0}, bvB = bvA;
            if (sA >= 0 && sA <= L - 16) bvA = *(const bf16x8*)(ubA + sA);
            accA = __builtin_amdgcn_mfma_f32_32x32x16_bf16(a, bvA, accA, 0, 0, 0);
            if (two) { if (sB >= 0 && sB <= L - 16) bvB = *(const bf16x8*)(ubB + sB);
                accB = __builtin_amdgcn_mfma_f32_32x32x16_bf16(a, bvB, accB, 0, 0, 0); }
        }
#pragma unroll
        for (int g = 0; g < 4; ++g) { u32x2 w; w.x = pk(accA[4 * g], accA[4 * g + 1]); w.y = pk(accA[4 * g + 2], accA[4 * g + 3]);
            *(u32x2*)(uT + (size_t)bA * L + tA + 8 * g + 4 * half) = w; }
        if (two) {
#pragma unroll
            for (int g = 0; g < 4; ++g) { u32x2 w; w.x = pk(accB[4 * g], accB[4 * g + 1]); w.y = pk(accB[4 * g + 2], accB[4 * g + 3]);
                *(u32x2*)(uT + (size_t)bB * L + tB + 8 * g + 4 * half) = w; } }
    }
    (void)ntile; (void)npair;
    __syncthreads();
}

DEV void rwkv_lora_tile(const Params& p, int tile, unsigned char* shm) {
    const int tid = tidx(), wid = tid >> 6, lane = tid & 63, l15 = lane & 15, quad = lane >> 4; const int tok0 = tile * 32;
    const u16* P = (const u16*)(p.ws + OFF_P); u16* RW = (u16*)(p.ws + OFF_RW); const u16* LW = (const u16*)(p.ws + OFF_LW);
    u16* Ain = (u16*)shm;
    u16* Ol = (u16*)(shm + 18432);
    for (int i = tid; i < 32 * 256; i += 512) { const int tk = i >> 8, cc = i & 255; const int tok = tok0 + tk; int t, L; tok_tl(tok, t, L);
        const u16* pp = P + (size_t)tok * LDP0 + 6144 + cc; float x = bf2f(*pp); const float xm = t > 0 ? bf2f(pp[-LDP0]) : 0.f; const float xp = t < L - 1 ? bf2f(pp[LDP0]) : 0.f;
        const float mu = p.in[25][3072 + cc]; x = x + mu * (0.5f * (xm + xp) - x); if (cc < 128) x = tanhf(x);
        Ain[((cc >> 6) * 32 + tk) * 72 + (cc & 63)] = f2bf(x); }
    __syncthreads();
#pragma unroll 1
    for (int mi = 0; mi < 4; ++mi) {
        const float* bias = (mi < 2 ? p.in[26] : p.in[28]) + (mi & 1) * 1024;
        const float osc = mi < 2 ? 0.6065306597f : 1.f;
        bf16x8 af[2][2];
#pragma unroll
        for (int tt = 0; tt < 2; ++tt)
#pragma unroll
            for (int ks = 0; ks < 2; ++ks) af[tt][ks] = *(const bf16x8*)(Ain + (mi * 32 + tt * 16 + l15) * 72 + ks * 32 + quad * 8);
#pragma unroll 2
        for (int q = 0; q < 8; ++q) { const int nt = wid * 8 + q; const int n = nt * 16 + l15;
            const bf16x8 b0 = *(const bf16x8*)(LW + ((size_t)mi * 1024 + n) * 64 + quad * 8), b1 = *(const bf16x8*)(LW + ((size_t)mi * 1024 + n) * 64 + 32 + quad * 8);
            const float bs = bias[n];
#pragma unroll
            for (int tt = 0; tt < 2; ++tt) { f32x4 acc = (f32x4){0.f, 0.f, 0.f, 0.f}; acc = mfma16(af[tt][0], b0, acc); acc = mfma16(af[tt][1], b1, acc);
#pragma unroll
                for (int r = 0; r < 4; ++r) Ol[(tt * 16 + quad * 4 + r) * 1032 + n] = f2bf(osc * sigm(acc[r] + bs)); } }
        __syncthreads();
#pragma unroll
        for (int i = 0; i < 8; ++i) { const int piece = tid + 512 * i; const int tk = piece >> 7, c8 = (piece & 127) * 8;
            *(u32x4*)(RW + (size_t)(tok0 + tk) * 4096 + mi * 1024 + c8) = *(const u32x4*)(Ol + tk * 1032 + c8); }
        __syncthreads();
    }
}
DEV float mixf(float c, float m, float q, float mu) { return c + mu * (0.5f * (m + q) - c); }
DEV void rwkv_scan_task(const Params& p, int task, float* sm) {
    const bool sample = task < 128; const int tt_ = sample ? task : task - 128;
    const int b = tt_ >> 5, h = (tt_ >> 1) & 15, dir = tt_ & 1;
    const int L = sample ? 4096 : 256; const int tok0 = sample ? NTP + b * 4096 : b * 256;
    const int tid = tidx(), wid = tid >> 6, lane = tid & 63;
    const int row = wid * 8 + (lane >> 3), kl = lane & 7;
    float S[8];
    const size_t soff = ((((size_t)b * 2 + dir) * 16 + h) * 64 + row) * 64 + kl * 8;
    if (sample) { const float4 a = *(const float4*)(p.in[2] + soff), c = *(const float4*)(p.in[2] + soff + 4);
        S[0] = a.x; S[1] = a.y; S[2] = a.z; S[3] = a.w; S[4] = c.x; S[5] = c.y; S[6] = c.z; S[7] = c.w; }
    else {
#pragma unroll
        for (int i = 0; i < 8; ++i) S[i] = 0.f; }
    float* vec = sm; float* vvs = sm + 10240; float* yb = vvs + 2048;
    const int ptt = tid >> 4, pk4 = (tid & 15) * 4; const int ch = h * 64 + pk4;
    const float4 mur = *(const float4*)(p.in[25] + ch), muk = *(const float4*)(p.in[25] + 1024 + ch), muv = *(const float4*)(p.in[25] + 2048 + ch);
    const float4 kkw = *(const float4*)(p.in[31] + ch), kaw = *(const float4*)(p.in[32] + ch);
    const float murA[4] = {mur.x, mur.y, mur.z, mur.w}, mukA[4] = {muk.x, muk.y, muk.z, muk.w}, muvA[4] = {muv.x, muv.y, muv.z, muv.w};
    const float kkwA[4] = {kkw.x, kkw.y, kkw.z, kkw.w}, kawA[4] = {kaw.x, kaw.y, kaw.z, kaw.w};
    const u16* P = (const u16*)(p.ws + OFF_P); const u16* RW = (const u16*)(p.ws + OFF_RW);
    u16* Y = (u16*)(p.out + OUT_GLAST) + (dir ? (size_t)NTOK * 1024 : 0);
    for (int c0 = 0; c0 < L; c0 += 32) {
        { const int t = dir ? (L - 1 - (c0 + ptt)) : (c0 + ptt); const size_t tok = (size_t)tok0 + t;
            const u16* pr = P + tok * LDP0 + 3072 + ch;
            float rc[4], kc[4], vc[4], rm[4], km[4], vm[4], rp[4], kp[4], vp[4], ee[4], aa[4];
            unpack4(*(const u32x2*)(pr), rc); unpack4(*(const u32x2*)(pr + 1024), kc); unpack4(*(const u32x2*)(pr + 2048), vc);
            if (t > 0) { unpack4(*(const u32x2*)(pr - LDP0), rm); unpack4(*(const u32x2*)(pr - LDP0 + 1024), km); unpack4(*(const u32x2*)(pr - LDP0 + 2048), vm); }
            else { for (int i = 0; i < 4; ++i) { rm[i] = 0.f; km[i] = 0.f; vm[i] = 0.f; } }
            if (t < L - 1) { unpack4(*(const u32x2*)(pr + LDP0), rp); unpack4(*(const u32x2*)(pr + LDP0 + 1024), kp); unpack4(*(const u32x2*)(pr + LDP0 + 2048), vp); }
            else { for (int i = 0; i < 4; ++i) { rp[i] = 0.f; kp[i] = 0.f; vp[i] = 0.f; } }
            unpack4(*(const u32x2*)(RW + tok * 4096 + dir * 1024 + ch), ee); unpack4(*(const u32x2*)(RW + tok * 4096 + (2 + dir) * 1024 + ch), aa);
            float r4[4], k4[4], v4[4], kr[4]; float ss = 0.f;
#pragma unroll
            for (int i = 0; i < 4; ++i) { r4[i] = mixf(rc[i], rm[i], rp[i], murA[i]); k4[i] = mixf(kc[i], km[i], kp[i], mukA[i]); v4[i] = mixf(vc[i], vm[i], vp[i], muvA[i]);
                kr[i] = k4[i] * kkwA[i]; ss += kr[i] * kr[i]; }
            ss = sum16(ss); const float inv = rsqrtf(ss + 1e-12f);
            float4 okk, ow, okka, okd, orr, ov;
            float tkk[4], tw[4], tkka[4], tkd[4];
#pragma unroll
            for (int i = 0; i < 4; ++i) { tkk[i] = kr[i] * inv; tw[i] = __expf(-ee[i]); tkka[i] = tkk[i] * aa[i]; tkd[i] = k4[i] * (1.f + (aa[i] - 1.f) * kawA[i]); }
            okk = make_float4(tkk[0], tkk[1], tkk[2], tkk[3]); ow = make_float4(tw[0], tw[1], tw[2], tw[3]); okka = make_float4(tkka[0], tkka[1], tkka[2], tkka[3]);
            okd = make_float4(tkd[0], tkd[1], tkd[2], tkd[3]); orr = make_float4(r4[0], r4[1], r4[2], r4[3]); ov = make_float4(v4[0], v4[1], v4[2], v4[3]);
            float* vj = vec + ptt * 320 + pk4;
            *(float4*)(vj) = okk; *(float4*)(vj + 64) = ow; *(float4*)(vj + 128) = okka; *(float4*)(vj + 192) = okd; *(float4*)(vj + 256) = orr;
            *(float4*)(vvs + ptt * 64 + pk4) = ov; }
        __syncthreads();
        for (int j = 0; j < 32; ++j) {
            const float* vj = vec + j * 320 + kl * 8;
            const float4 a0 = *(const float4*)(vj), a1 = *(const float4*)(vj + 4);
            const float4 w0 = *(const float4*)(vj + 64), w1 = *(const float4*)(vj + 68);
            const float4 b0 = *(const float4*)(vj + 128), b1 = *(const float4*)(vj + 132);
            const float4 d0 = *(const float4*)(vj + 192), d1 = *(const float4*)(vj + 196);
            const float4 r0 = *(const float4*)(vj + 256), r1 = *(const float4*)(vj + 260);
            const float vr = vvs[j * 64 + row];
            float sa = S[0] * a0.x + S[1] * a0.y + S[2] * a0.z + S[3] * a0.w + S[4] * a1.x + S[5] * a1.y + S[6] * a1.z + S[7] * a1.w;
            sa = -sum8(sa);
            S[0] = S[0] * w0.x + sa * b0.x + vr * d0.x; S[1] = S[1] * w0.y + sa * b0.y + vr * d0.y; S[2] = S[2] * w0.z + sa * b0.z + vr * d0.z; S[3] = S[3] * w0.w + sa * b0.w + vr * d0.w;
            S[4] = S[4] * w1.x + sa * b1.x + vr * d1.x; S[5] = S[5] * w1.y + sa * b1.y + vr * d1.y; S[6] = S[6] * w1.z + sa * b1.z + vr * d1.z; S[7] = S[7] * w1.w + sa * b1.w + vr * d1.w;
            float y = S[0] * r0.x + S[1] * r0.y + S[2] * r0.z + S[3] * r0.w + S[4] * r1.x + S[5] * r1.y + S[6] * r1.z + S[7] * r1.w;
            y = sum8(y);
            if (kl == 0) yb[j * 64 + row] = y;
        }
        __syncthreads();
        { const int t = dir ? (L - 1 - (c0 + ptt)) : (c0 + ptt);
            const float4 yv = *(const float4*)(yb + ptt * 64 + pk4); u32x2 w; w.x = pk(yv.x, yv.y); w.y = pk(yv.z, yv.w);
            *(u32x2*)(Y + ((size_t)tok0 + t) * 1024 + ch) = w; }
    }
    if (!sample) { float* so = p.out + OUT_RWST + soff;
        *(float4*)(so) = make_float4(S[0], S[1], S[2], S[3]); *(float4*)(so + 4) = make_float4(S[4], S[5], S[6], S[7]); }
    __syncthreads();
}
DEV void rwkv_post_tile(const Params& p, int tile, float* sm) {
    const int tid = tidx(); const int tok0 = tile * 16;
    const u16* P = (const u16*)(p.ws + OFF_P); const u16* RW = (const u16*)(p.ws + OFF_RW); u16* ycat = (u16*)(p.ws + OFF_A);
    const u16* YF = (const u16*)(p.out + OUT_GLAST); const u16* YB = YF + (size_t)NTOK * 1024;
    float* Gf = sm + 2048;
    for (int i = tid; i < 16 * 128; i += 512) { const int tk = i >> 7, r = i & 127; const int tok = tok0 + tk; int t, L; tok_tl(tok, t, L);
        const u16* pp = P + (size_t)tok * LDP0 + 6400 + r; const float x = bf2f(*pp); const float xm = t > 0 ? bf2f(pp[-LDP0]) : 0.f; const float xp = t < L - 1 ? bf2f(pp[LDP0]) : 0.f;
        sm[i] = sigm(mixf(x, xm, xp, p.in[25][3328 + r])); }
    __syncthreads();
    { float g0[16], g1[16];
#pragma unroll
        for (int k = 0; k < 16; ++k) { g0[k] = 0.f; g1[k] = 0.f; }
        const float* g2 = p.in[30];
        for (int r = 0; r < 128; r += 4) {
            float wa[4], wb[4];
#pragma unroll
            for (int q = 0; q < 4; ++q) { wa[q] = g2[(r + q) * 1024 + tid]; wb[q] = g2[(r + q) * 1024 + 512 + tid]; }
#pragma unroll
            for (int k = 0; k < 16; ++k) { const float4 s4 = *(const float4*)(sm + k * 128 + r);
                g0[k] += s4.x * wa[0] + s4.y * wa[1] + s4.z * wa[2] + s4.w * wa[3]; g1[k] += s4.x * wb[0] + s4.y * wb[1] + s4.z * wb[2] + s4.w * wb[3]; } }
#pragma unroll
        for (int k = 0; k < 16; ++k) { Gf[k * 1024 + tid] = g0[k]; Gf[k * 1024 + 512 + tid] = g1[k]; } }
    __syncthreads();
    const int c8 = (tid & 127) * 8;
    float mur[8], muk[8], muv[8], ka[8], rk[8], lw[8], lb[8];
#pragma unroll
    for (int i = 0; i < 8; ++i) { mur[i] = p.in[25][c8 + i]; muk[i] = p.in[25][1024 + c8 + i]; muv[i] = p.in[25][2048 + c8 + i]; ka[i] = p.in[32][c8 + i]; rk[i] = p.in[33][c8 + i]; lw[i] = p.in[34][c8 + i]; lb[i] = p.in[35][c8 + i]; }
#pragma unroll 1
    for (int it = 0; it < 4; ++it) { const int tk = (tid >> 7) + 4 * it; const int tok = tok0 + tk; int t, L; tok_tl(tok, t, L);
        const u16* pr = P + (size_t)tok * LDP0 + 3072 + c8; const bool hm = t > 0, hp = t < L - 1;
        float rc[8], rm[8], rp[8], kc[8], km[8], kp[8], vc[8], vm[8], vp[8], a0[8], a1[8], yf[8], yb[8], gg[8];
        unpack8(*(const u32x4*)pr, rc); unpack8(*(const u32x4*)(pr + 1024), kc); unpack8(*(const u32x4*)(pr + 2048), vc);
        if (hm) { const u16* pm = P + (size_t)(tok - 1) * LDP0 + 3072 + c8; unpack8(*(const u32x4*)(pm), rm); unpack8(*(const u32x4*)(pm + 1024), km); unpack8(*(const u32x4*)(pm + 2048), vm); }
        else { for (int i = 0; i < 8; ++i) { rm[i] = 0.f; km[i] = 0.f; vm[i] = 0.f; } }
        if (hp) { unpack8(*(const u32x4*)(pr + LDP0), rp); unpack8(*(const u32x4*)(pr + LDP0 + 1024), kp); unpack8(*(const u32x4*)(pr + LDP0 + 2048), vp); }
        else { for (int i = 0; i < 8; ++i) { rp[i] = 0.f; kp[i] = 0.f; vp[i] = 0.f; } }
        unpack8(*(const u32x4*)(RW + (size_t)tok * 4096 + 2048 + c8), a0); unpack8(*(const u32x4*)(RW + (size_t)tok * 4096 + 3072 + c8), a1);
        unpack8(*(const u32x4*)(YF + (size_t)tok * 1024 + c8), yf); unpack8(*(const u32x4*)(YB + (size_t)tok * 1024 + c8), yb);
        { const float4 ga = *(const float4*)(Gf + tk * 1024 + c8), gb = *(const float4*)(Gf + tk * 1024 + c8 + 4); gg[0] = ga.x; gg[1] = ga.y; gg[2] = ga.z; gg[3] = ga.w; gg[4] = gb.x; gg[5] = gb.y; gg[6] = gb.z; gg[7] = gb.w; }
        float y[8], v_[8]; float bon = 0.f, sy = 0.f;
#pragma unroll
        for (int i = 0; i < 8; ++i) { const float r_ = mixf(rc[i], rm[i], rp[i], mur[i]), k_ = mixf(kc[i], km[i], kp[i], muk[i]); v_[i] = mixf(vc[i], vm[i], vp[i], muv[i]);
            bon += r_ * k_ * (2.f + (a0[i] + a1[i] - 2.f) * ka[i]) * rk[i]; y[i] = yf[i] + yb[i]; sy += y[i]; }
        bon = sum8(bon); const float mean = sum8(sy) * (1.f / 64.f);
        float sv = 0.f;
#pragma unroll
        for (int i = 0; i < 8; ++i) { y[i] -= mean; sv += y[i] * y[i]; }
        const float rstd = rsqrtf(sum8(sv) * (1.f / 64.f) + 64e-5f);
        float o[8];
#pragma unroll
        for (int i = 0; i < 8; ++i) o[i] = (y[i] * rstd * lw[i] + lb[i] + bon * v_[i]) * gg[i];
        u32x4 w; w.x = pk(o[0], o[1]); w.y = pk(o[2], o[3]); w.z = pk(o[4], o[5]); w.w = pk(o[6], o[7]);
        *(u32x4*)(ycat + (size_t)tok * DM + 1024 + c8) = w; }
    __syncthreads();
}

DEV float logsig(float x) { return fminf(x, 0.f) - __logf(1.f + __expf(-fabsf(x))); }
DEV void gla_intra_task(const Params& p, int task, unsigned char* shm) {
    const int tid = tidx(), wid = tid >> 6, lane = tid & 63, l15 = lane & 15, quad = lane >> 4;
    const int cidx = task >> 2, h = task & 3; const int tok0 = cidx * 64;
    u16* P = (u16*)(p.ws + OFF_P); u16* QB = (u16*)(p.ws + OFF_A); float* Dbuf = (float*)(p.ws + OFF_DB);
    u16* qi = (u16*)shm; u16* ki = qi + 64 * 264; u16* vl = (u16*)shm; u16* Pl = (u16*)(shm + 67584); float* gl = (float*)(shm + 76800); float* tot = (float*)(shm + 84992);
    for (int i = tid; i < 2048; i += 512) { const int tl = i >> 5, c = i & 31; gl[i] = bf2f(P[(size_t)(tok0 + tl) * LDP1 + 6144 + c]); }
    __syncthreads();
    const int k = tid & 255, jh = tid >> 8;
#pragma unroll 1
    for (int dd = 0; dd < 2; ++dd) { const int dir = 1 - dd;
        float g2r[16];
#pragma unroll
        for (int r = 0; r < 16; ++r) g2r[r] = p.in[38][(size_t)(dir * 16 + r) * 1024 + h * 256 + k];
        const float gb = p.in[39][dir * 1024 + h * 256 + k];
        float bl[32]; float run = 0.f;
#pragma unroll
        for (int jj = 0; jj < 32; ++jj) { const int j = jh * 32 + jj; const int tl = dir ? 63 - j : j; const float* gr = gl + tl * 32 + dir * 16;
            float x = gb;
#pragma unroll
            for (int r = 0; r < 16; r += 4) { const float4 g4 = *(const float4*)(gr + r); x += g4.x * g2r[r] + g4.y * g2r[r + 1] + g4.z * g2r[r + 2] + g4.w * g2r[r + 3]; }
            run += logsig(x) * 0.0625f; bl[jj] = run; }
        tot[jh * 256 + k] = run;
        __syncthreads();
        const float t0v = tot[k], t1v = tot[256 + k]; const float off = jh ? t0v : 0.f; const float bref = t0v, blast = t0v + t1v;
        if (jh == 0) Dbuf[((size_t)cidx * 2 + dir) * 1024 + h * 256 + k] = __expf(blast);
        u16* qdst; u16* kdst; size_t ldd;
        if (dir == 0) { qdst = P + h * 256 + k; kdst = P + 1024 + h * 256 + k; ldd = LDP1; } else { qdst = QB + h * 256 + k; kdst = QB + 1024 + h * 256 + k; ldd = 2048; }
#pragma unroll
        for (int jj = 0; jj < 32; ++jj) { const int j = jh * 32 + jj; const int tl = dir ? 63 - j : j; const size_t tok = (size_t)tok0 + tl;
            const float qv = bf2f(P[tok * LDP1 + h * 256 + k]) * 0.0625f, kv = bf2f(P[tok * LDP1 + 1024 + h * 256 + k]);
            const float b = bl[jj] + off;
            qi[j * 264 + k] = f2bf(qv * __expf(b - bref)); ki[j * 264 + k] = f2bf(kv * __expf(bref - b));
            qdst[tok * ldd] = f2bf(qv * __expf(b)); kdst[tok * ldd] = f2bf(kv * __expf(blast - b)); }
        __syncthreads();
        { const int tt = wid >> 1;
#pragma unroll
            for (int q2 = 0; q2 < 2; ++q2) { const int st = (wid & 1) * 2 + q2; f32x4 acc = (f32x4){0.f, 0.f, 0.f, 0.f};
                if (st <= tt) {
#pragma unroll
                    for (int ks = 0; ks < 8; ++ks) { const bf16x8 a = *(const bf16x8*)(qi + (tt * 16 + l15) * 264 + ks * 32 + quad * 8); const bf16x8 b = *(const bf16x8*)(ki + (st * 16 + l15) * 264 + ks * 32 + quad * 8);
                        acc = mfma16(a, b, acc); } }
#pragma unroll
                for (int r = 0; r < 4; ++r) { const int t = tt * 16 + quad * 4 + r, s_ = st * 16 + l15; Pl[t * 72 + s_] = f2bf(s_ <= t ? acc[r] : 0.f); } } }
        __syncthreads();
#pragma unroll
        for (int i = 0; i < 8; ++i) { const int piece = tid + 512 * i; const int j = piece >> 6, c8 = (piece & 63) * 8; const int tl = dir ? 63 - j : j;
            *(u32x4*)(vl + j * 520 + c8) = *(const u32x4*)(P + (size_t)(tok0 + tl) * LDP1 + 2048 + h * 512 + c8); }
        __syncthreads();
        u16* O = (u16*)(p.ws + (dir ? OFF_OB : OFF_OF)) + h * 512;
#pragma unroll 1
        for (int q4 = 0; q4 < 4; ++q4) { const int vt = wid * 4 + q4; f32x4 acc[4];
#pragma unroll
            for (int tt = 0; tt < 4; ++tt) acc[tt] = (f32x4){0.f, 0.f, 0.f, 0.f};
#pragma unroll
            for (int ss = 0; ss < 2; ++ss) { bf16x8 bfr;
#pragma unroll
                for (int jj = 0; jj < 8; ++jj) bfr[jj] = (short)vl[(ss * 32 + quad * 8 + jj) * 520 + vt * 16 + l15];
#pragma unroll
                for (int tt = 0; tt < 4; ++tt) { if (ss * 32 <= tt * 16 + 15) { const bf16x8 a = *(const bf16x8*)(Pl + (tt * 16 + l15) * 72 + ss * 32 + quad * 8); acc[tt] = mfma16(a, bfr, acc[tt]); } } }
#pragma unroll
            for (int tt = 0; tt < 4; ++tt)
#pragma unroll
                for (int r = 0; r < 4; ++r) { const int t = tt * 16 + quad * 4 + r; const int tl = dir ? 63 - t : t; O[(size_t)(tok0 + tl) * DM + vt * 16 + l15] = f2bf(acc[tt][r]); } }
        __syncthreads();
    }
}
DEV void gla_inter_task(const Params& p, int task, unsigned char* shm) {
    const bool sample = task < 256; const int tt_ = sample ? task : task - 256;
    const int seq = tt_ >> 3, vs = tt_ & 7; const int b = seq >> 3, h = (seq >> 1) & 3, dir = seq & 1;
    const int L = sample ? 4096 : 256; const int tok0 = sample ? NTP + b * 4096 : b * 256;
    const int nch = L >> 6, cbase = tok0 >> 6;
    const int tid = tidx(), wid = tid >> 6, lane = tid & 63, l15 = lane & 15, quad = lane >> 4;
    const u16* P = (const u16*)(p.ws + OFF_P); const u16* QB = (const u16*)(p.ws + OFF_A); const float* Dbuf = (const float*)(p.ws + OFF_DB);
    u16* ST = (u16*)shm; u16* qdl = (u16*)(shm + 33792); u16* kdl = (u16*)(shm + 67584); u16* vl = (u16*)(shm + 101376); float* dl = (float*)(shm + 110592);
    f32x4 S[2][4];
    const size_t sbase = (((size_t)b * 2 + dir) * 4 + h) * 256 * 512 + vs * 64;
#pragma unroll
    for (int kt = 0; kt < 2; ++kt)
#pragma unroll
        for (int vt = 0; vt < 4; ++vt)
#pragma unroll
            for (int r = 0; r < 4; ++r) { const int kk = wid * 32 + kt * 16 + quad * 4 + r; S[kt][vt][r] = sample ? p.in[3][sbase + (size_t)kk * 512 + vt * 16 + l15] : 0.f; }
    const u16* qsrc; const u16* ksrc; size_t lds_;
    if (dir == 0) { qsrc = P + h * 256; ksrc = P + 1024 + h * 256; lds_ = LDP1; } else { qsrc = QB + h * 256; ksrc = QB + 1024 + h * 256; lds_ = 2048; }
    const u16* vsrc = P + 2048 + h * 512 + vs * 64;
    u16* O = (u16*)(p.ws + (dir ? OFF_OB : OFF_OF)) + h * 512 + vs * 64;
    u32x4 rq[4], rk[4], rv; float rd = 0.f;
    const int vrow = tid >> 3, vc8 = (tid & 7) * 8;
#define GLA_ISSUE(n_) do { const int cidx_ = cbase + (dir ? nch - 1 - (n_) : (n_)); \
        _Pragma("unroll") for (int i = 0; i < 4; ++i) { const int piece = tid + 512 * i; const int j = piece >> 5, c8 = (piece & 31) * 8; const size_t tok = (size_t)cidx_ * 64 + (dir ? 63 - j : j); \
            rq[i] = *(const u32x4*)(qsrc + tok * lds_ + c8); rk[i] = *(const u32x4*)(ksrc + tok * lds_ + c8); } \
        { const size_t tok = (size_t)cidx_ * 64 + (dir ? 63 - vrow : vrow); rv = *(const u32x4*)(vsrc + tok * LDP1 + vc8); } \
        if (tid < 256) rd = Dbuf[((size_t)cidx_ * 2 + dir) * 1024 + h * 256 + tid]; } while (0)
#define GLA_WRITE_ST() do { _Pragma("unroll") for (int kt = 0; kt < 2; ++kt) _Pragma("unroll") for (int vt = 0; vt < 4; ++vt) { u32x2 w; w.x = pk(S[kt][vt][0], S[kt][vt][1]); w.y = pk(S[kt][vt][2], S[kt][vt][3]); \
            *(u32x2*)(ST + (vt * 16 + l15) * 264 + wid * 32 + kt * 16 + quad * 4) = w; } } while (0)
    GLA_WRITE_ST();
    GLA_ISSUE(0);
    const int tt = wid >> 1, vb = (wid & 1) * 2;
#pragma unroll 1
    for (int n = 0; n < nch; ++n) {
        const int cidx = cbase + (dir ? nch - 1 - n : n);
#pragma unroll
        for (int i = 0; i < 4; ++i) { const int piece = tid + 512 * i; const int j = piece >> 5, c8 = (piece & 31) * 8; *(u32x4*)(qdl + j * 264 + c8) = rq[i]; *(u32x4*)(kdl + j * 264 + c8) = rk[i]; }
        *(u32x4*)(vl + vrow * 72 + vc8) = rv; if (tid < 256) dl[tid] = rd;
        __syncthreads();
        if (n + 1 < nch) GLA_ISSUE(n + 1);
        float oi[2][4];
#pragma unroll
        for (int q2 = 0; q2 < 2; ++q2)
#pragma unroll
            for (int r = 0; r < 4; ++r) { const int j = tt * 16 + quad * 4 + r; const size_t tok = (size_t)cidx * 64 + (dir ? 63 - j : j); oi[q2][r] = bf2f(O[tok * DM + (vb + q2) * 16 + l15]); }
        f32x4 oacc[2]; oacc[0] = (f32x4){0.f, 0.f, 0.f, 0.f}; oacc[1] = oacc[0];
#pragma unroll
        for (int ks = 0; ks < 8; ++ks) { const bf16x8 a = *(const bf16x8*)(qdl + (tt * 16 + l15) * 264 + ks * 32 + quad * 8);
#pragma unroll
            for (int q2 = 0; q2 < 2; ++q2) { const bf16x8 bfr = *(const bf16x8*)(ST + ((vb + q2) * 16 + l15) * 264 + ks * 32 + quad * 8); oacc[q2] = mfma16(a, bfr, oacc[q2]); } }
#pragma unroll
        for (int kt = 0; kt < 2; ++kt) { const f32x4 dv = *(const f32x4*)(dl + wid * 32 + kt * 16 + quad * 4);
#pragma unroll
            for (int vt = 0; vt < 4; ++vt) S[kt][vt] = S[kt][vt] * dv; }
#pragma unroll
        for (int ts = 0; ts < 2; ++ts) { bf16x8 af[2];
#pragma unroll
            for (int kt = 0; kt < 2; ++kt)
#pragma unroll
                for (int jj = 0; jj < 8; ++jj) af[kt][jj] = (short)kdl[(ts * 32 + quad * 8 + jj) * 264 + wid * 32 + kt * 16 + l15];
#pragma unroll
            for (int vt = 0; vt < 4; ++vt) { bf16x8 bfr;
#pragma unroll
                for (int jj = 0; jj < 8; ++jj) bfr[jj] = (short)vl[(ts * 32 + quad * 8 + jj) * 72 + vt * 16 + l15];
#pragma unroll
                for (int kt = 0; kt < 2; ++kt) S[kt][vt] = mfma16(af[kt], bfr, S[kt][vt]); } }
#pragma unroll
        for (int q2 = 0; q2 < 2; ++q2)
#pragma unroll
            for (int r = 0; r < 4; ++r) { const int j = tt * 16 + quad * 4 + r; const size_t tok = (size_t)cidx * 64 + (dir ? 63 - j : j); O[tok * DM + (vb + q2) * 16 + l15] = f2bf(oi[q2][r] + oacc[q2][r]); }
        __syncthreads();
        GLA_WRITE_ST();
        __syncthreads();
    }
#undef GLA_ISSUE
#undef GLA_WRITE_ST
    if (!sample) { float* so = p.out + OUT_GLAST + sbase;
#pragma unroll
        for (int kt = 0; kt < 2; ++kt)
#pragma unroll
            for (int vt = 0; vt < 4; ++vt)
#pragma unroll
                for (int r = 0; r < 4; ++r) { const int kk = wid * 32 + kt * 16 + quad * 4 + r; so[(size_t)kk * 512 + vt * 16 + l15] = S[kt][vt][r]; } }
    __syncthreads();
}
DEV void phase_gla_post(const Params& p) {
    const int tid = tidx(), wid = tid >> 6, lane = tid & 63;
    const u16* P = (const u16*)(p.ws + OFF_P); const u16* OF = (const u16*)(p.ws + OFF_OF); const u16* OB = (const u16*)(p.ws + OFF_OB); u16* ycat = (u16*)(p.ws + OFF_A);
    for (int it = blockIdx.x * 8 + wid; it < NTOK * 4; it += gridDim.x * 8) { const int tok = it >> 2, h = it & 3; const int v8 = lane * 8;
        float a[8], b[8], g[8]; unpack8(*(const u32x4*)(OF + (size_t)tok * DM + h * 512 + v8), a); unpack8(*(const u32x4*)(OB + (size_t)tok * DM + h * 512 + v8), b);
        unpack8(*(const u32x4*)(P + (size_t)tok * LDP1 + 4096 + h * 512 + v8), g);
        float ss = 0.f;
#pragma unroll
        for (int i = 0; i < 8; ++i) { a[i] += b[i]; ss += a[i] * a[i]; }
        ss = wave_sum(ss); const float sc = rsqrtf(ss * (1.f / 512.f) + 1e-6f);
        float o[8];
#pragma unroll
        for (int i = 0; i < 8; ++i) o[i] = a[i] * sc * p.in[40][v8 + i] * (g[i] * sigm(g[i]));
        u32x4 w; w.x = pk(o[0], o[1]); w.y = pk(o[2], o[3]); w.z = pk(o[4], o[5]); w.w = pk(o[6], o[7]);
        *(u32x4*)(ycat + (size_t)tok * DM + h * 512 + v8) = w; }
}

DEV void gate_loadcol(const u16* U, long tokc, int c8, bool colok, bool up, bool dn, int W, float (*dst)[8]) {
    if (colok && up) unpack8(*(const u32x4*)(U + (size_t)(tokc - W) * LDU + c8), dst[0]); else { for (int i = 0; i < 8; ++i) dst[0][i] = 0.f; }
    if (colok) unpack8(*(const u32x4*)(U + (size_t)tokc * LDU + c8), dst[1]); else { for (int i = 0; i < 8; ++i) dst[1][i] = 0.f; }
    if (colok && dn) unpack8(*(const u32x4*)(U + (size_t)(tokc + W) * LDU + c8), dst[2]); else { for (int i = 0; i < 8; ++i) dst[2][i] = 0.f; }
}
DEV void phase_ffn_gate(const Params& p, int layer) {
    u16* U = (u16*)(p.ws + OFF_U); const float* cw = p.in[11] + (size_t)layer * 9 * DFF;
    const int nunit = 768 * 704;
    for (int u = blockIdx.x * 512 + tidx(); u < nunit; u += gridDim.x * 512) {
        const int seg = u / 704, c8 = (u % 704) * 8; const int tokS = seg * 32;
        int W, colS; bool up, dn;
        if (tokS < NTP) { W = 256; colS = tokS & 255; up = false; dn = false; }
        else { W = 64; colS = tokS & 63; const int rr = ((tokS - NTP) >> 6) & 63; up = rr > 0; dn = rr < 63; }
        float wt[9][8];
#pragma unroll
        for (int q = 0; q < 9; ++q) { const float4 a = *(const float4*)(cw + q * DFF + c8), b = *(const float4*)(cw + q * DFF + c8 + 4);
            wt[q][0] = a.x; wt[q][1] = a.y; wt[q][2] = a.z; wt[q][3] = a.w; wt[q][4] = b.x; wt[q][5] = b.y; wt[q][6] = b.z; wt[q][7] = b.w; }
        float w0[3][8], w1[3][8], w2[3][8];
        gate_loadcol(U, (long)tokS - 1, c8, colS > 0, up, dn, W, w0);
        gate_loadcol(U, (long)tokS, c8, true, up, dn, W, w1);
#pragma unroll 4
        for (int s_ = 0; s_ < 32; ++s_) {
            const long tok = (long)tokS + s_;
            gate_loadcol(U, tok + 1, c8, colS + s_ + 1 < W, up, dn, W, w2);
            u16* vp = U + (size_t)tok * LDU + DFF + c8; float v[8]; unpack8(*(const u32x4*)vp, v);
#pragma unroll
            for (int i = 0; i < 8; ++i) { float a = 0.f;
#pragma unroll
                for (int di = 0; di < 3; ++di) a += w0[di][i] * wt[di * 3][i] + w1[di][i] * wt[di * 3 + 1][i] + w2[di][i] * wt[di * 3 + 2][i];
                v[i] *= a * sigm(a); }
            u32x4 w; w.x = pk(v[0], v[1]); w.y = pk(v[2], v[3]); w.z = pk(v[4], v[5]); w.w = pk(v[6], v[7]);
            *(u32x4*)vp = w;
#pragma unroll
            for (int di = 0; di < 3; ++di)
#pragma unroll
                for (int i = 0; i < 8; ++i) { w0[di][i] = w1[di][i]; w1[di][i] = w2[di][i]; }
        }
    }
}

DEV void phase_final_norm(const Params& p) {
    const int tid = tidx(), wid = tid >> 6, lane = tid & 63; const float* g = p.in[13];
    for (int row = blockIdx.x * 8 + wid; row < NTOK; row += gridDim.x * 8) {
        float4* xr = (float4*)(p.out + (size_t)row * DM);
        float4 v[8]; float ss = 0.f;
#pragma unroll
        for (int j = 0; j < 8; ++j) { v[j] = xr[lane + 64 * j]; ss += v[j].x * v[j].x + v[j].y * v[j].y + v[j].z * v[j].z + v[j].w * v[j].w; }
        ss = wave_sum(ss); const float rstd = rsqrtf(ss * (1.f / 2048.f) + 1e-6f);
#pragma unroll
        for (int j = 0; j < 8; ++j) { const float4 gg = *(const float4*)(g + (lane + 64 * j) * 4);
            xr[lane + 64 * j] = make_float4(v[j].x * rstd * gg.x, v[j].y * rstd * gg.y, v[j].z * rstd * gg.z, v[j].w * rstd * gg.w); }
    }
}


#define XB_TMO      128
#define XB_XCNT(j)  (256  + 64 * (j))
#define XB_XSUB(j)  (1280 + 64 * (j))
#define XB_XGEN(j)  (2304 + 64 * (j))
#define XB_TOP      3328
#define XB_TOPGEN   3392
#define XCD_BAR_WORDS 3456
#define XB_SPIN_CAP (1u << 18)
DEV unsigned xb_ld(unsigned* p)              { return __hip_atomic_load(p, __ATOMIC_RELAXED, __HIP_MEMORY_SCOPE_AGENT); }
DEV unsigned xb_add(unsigned* p, unsigned v) { return __hip_atomic_fetch_add(p, v, __ATOMIC_RELAXED, __HIP_MEMORY_SCOPE_AGENT); }
DEV unsigned xb_xcc_id() { return (unsigned)__builtin_amdgcn_s_getreg((3 << 11) | 20) & 0xFu; }
#define XB_SPIN(cond, bar) do { unsigned _sp = 0; while (cond) { __builtin_amdgcn_s_sleep(1); \
    if ((++_sp & 255u) == 0u) { if (xb_ld(&(bar)[XB_TMO])) break; if (_sp > XB_SPIN_CAP) { atomicAdd(&(bar)[XB_TMO], 1u); break; } } } } while (0)
struct XcdBarrier { unsigned* bar; unsigned x; volatile LAS unsigned* st; };
DEV XcdBarrier xcd_barrier_post(unsigned* bar, volatile LAS unsigned* st) {
    XcdBarrier b; b.bar = bar; b.x = xb_xcc_id(); b.st = st;
    if (threadIdx.x == 0) (void)xb_add(&bar[XB_XCNT(b.x)], 1u);
    return b;
}
DEV void xcd_barrier_complete(unsigned* bar, unsigned x, unsigned& nloc, unsigned& nx) {
    const unsigned G = gridDim.x * gridDim.y * gridDim.z;
    unsigned sum, cnt, mine, sp = 0u;
    for (;;) {
        sum = 0u; cnt = 0u; mine = 0u;
#pragma unroll
        for (unsigned j = 0; j < 16; ++j) { const unsigned c = xb_ld(&bar[XB_XCNT(j)]); sum += c; cnt += (c > 0u) ? 1u : 0u; mine = (j == x) ? c : mine; }
        if (sum == G) break;
        __builtin_amdgcn_s_sleep(1);
        if ((++sp & 255u) == 0u) { if (xb_ld(&bar[XB_TMO])) break; if (sp > XB_SPIN_CAP) { atomicAdd(&bar[XB_TMO], 1u); break; } }
    }
    nloc = mine > 0u ? mine : 1u; nx = cnt > 0u ? cnt : 1u;
}
DEV void xcd_barrier(const XcdBarrier& b) {
    asm volatile("s_waitcnt vmcnt(0)" ::: "memory");
    __syncthreads();
    if (threadIdx.x == 0) {
        unsigned* bar = b.bar;
        __builtin_amdgcn_s_waitcnt(0);
        unsigned nloc = b.st[0], nx = b.st[1];
        if (nloc == 0u) { xcd_barrier_complete(bar, b.x, nloc, nx); b.st[0] = nloc; b.st[1] = nx; }
        const unsigned old = xb_add(&bar[XB_XSUB(b.x)], 1u);
        const unsigned gen = old / nloc;
        if (old + 1u == (gen + 1u) * nloc) {
            __builtin_amdgcn_fence(__ATOMIC_RELEASE, "agent");
            asm volatile("s_waitcnt vmcnt(0)" ::: "memory");
            const unsigned og = xb_add(&bar[XB_TOP], 1u);
            const unsigned tg = og / nx;
            if (og + 1u == (tg + 1u) * nx) xb_add(&bar[XB_TOPGEN], 1u);
            else XB_SPIN(xb_ld(&bar[XB_TOPGEN]) == tg, bar);
            __builtin_amdgcn_fence(__ATOMIC_ACQUIRE, "agent");
            xb_add(&bar[XB_XGEN(b.x)], 1u);
            asm volatile("s_waitcnt vmcnt(0)" ::: "memory");
        } else {
            XB_SPIN(xb_ld(&bar[XB_XGEN(b.x)]) == gen, bar);
            __builtin_amdgcn_fence(__ATOMIC_ACQUIRE, "agent");
            asm volatile("s_waitcnt vmcnt(0)" ::: "memory");
        }
    }
    __syncthreads();
}

__global__ void __launch_bounds__(512, 2) mega(Params p0) {
    extern __shared__ __attribute__((aligned(16))) unsigned char shm[];
    cg::grid_group grid = cg::this_grid();
    __shared__ uint4 xb_words;
    if (threadIdx.x == 0) xb_words = make_uint4(0u, 0u, 0u, 0u);
    __syncthreads();
    (void)xcd_barrier_post((unsigned*)(p0.ws + OFF_SMALL + SMALL_BYTES + 256), (volatile LAS unsigned*)&xb_words);
#define XBAR() do { XcdBarrier xb_; xb_.bar = (unsigned*)(launder(p0).ws + OFF_SMALL + SMALL_BYTES + 256); xb_.x = xb_xcc_id(); xb_.st = (volatile LAS unsigned*)&xb_words; xcd_barrier(xb_); } while (0)
    float* sm = (float*)shm;
    const int G = (int)gridDim.x, B = (int)blockIdx.x;

#ifndef SK_PREP
    phase_prep(launder(p0), shm);
#ifdef PROBE_MISC
    __syncthreads(); phase_prep(launder(p0), shm);
#endif
#endif
    grid.sync();
    phase_reduce(launder(p0));
    XBAR();
#pragma unroll 1
    for (int layer = 0; layer < 2; ++layer) {
#ifndef SK_NORM
        phase_norm(launder(p0), layer, 0, shm);
#ifdef PROBE_MISC
        __syncthreads(); phase_norm(launder(p0), layer, 0, shm);
#endif
#endif
        XBAR();
        { const Params p = launder(p0); const u16* A = (const u16*)(p.ws + OFF_A); pg8::EpiBf16 E; E.O = (u16*)(p.ws + OFF_P); E.ldc = layer ? LDP1 : LDP0;
#if !defined(SK_GEMM) && !defined(SK_GBF)
            run_gemm(shm, A, DM, (const u16*)(p.ws + OFF_WIN), DM, layer ? LDP1 : LDP0, DM, E);
#ifdef PROBE_GEMM
            __syncthreads(); run_gemm(shm, A, DM, (const u16*)(p.ws + OFF_WIN), DM, layer ? LDP1 : LDP0, DM, E);
#endif
#endif
        }
        XBAR();
        if (layer == 0) {
#ifndef SK_PRE
            { const Params p = launder(p0); for (int t = B; t < 6144 + 768; t += G) { if (t < 6144) hy_pre_tile(p, t, sm); else rwkv_lora_tile(p, t - 6144, shm); } }
#ifdef PROBE_MISC
            { const Params p = launder(p0); for (int t = B; t < 6144 + 768; t += G) { if (t < 6144) hy_pre_tile(p, t, sm); else rwkv_lora_tile(p, t - 6144, shm); } }
#endif
#endif
            XBAR();
#ifndef SK_RSCAN
            { const Params p = launder(p0);
            if (B < 128) rwkv_scan_task(p, B, sm);
            else if (G > 128) { for (int j = B - 128; j < 1024; j += G - 128) rwkv_scan_task(p, 128 + j, sm); }
            if (G <= 128) { for (int j = B; j < 1024; j += G) rwkv_scan_task(p, 128 + j, sm); }
#ifdef PROBE_RSCAN
            if (B < 128) rwkv_scan_task(p, B, sm);
            else if (G > 128) { for (int j = B - 128; j < 1024; j += G - 128) rwkv_scan_task(p, 128 + j, sm); }
#endif
            }
#endif
#ifndef SK_HCONV
            { const Params p = launder(p0); unsigned* ctr = (unsigned*)(p.ws + OFF_SMALL + SMALL_BYTES);
                for (;;) { if (tidx() == 0) *(volatile unsigned*)shm = atomicAdd(ctr, 1u); __syncthreads(); const unsigned t = *(volatile unsigned*)shm; __syncthreads(); if (t >= 2048u) break; hyconv_task(p, (int)t, shm); } }
#endif
            XBAR();
#ifndef SK_POST
            { const Params p = launder(p0); for (int t = B; t < 6144 + 1536; t += G) { if (t < 6144) hy_post_tile(p, t, sm); else rwkv_post_tile(p, t - 6144, sm); } }
#ifdef PROBE_MISC
            { const Params p = launder(p0); for (int t = B; t < 6144 + 1536; t += G) { if (t < 6144) hy_post_tile(p, t, sm); else rwkv_post_tile(p, t - 6144, sm); } }
#endif
#endif
            XBAR();
        } else {
#ifndef SK_GLA
            { const Params p = launder(p0); for (int t = B; t < 1536; t += G) gla_intra_task(p, t, shm); }
            XBAR();
            { const Params p = launder(p0); for (int t = B; t < 256 + 2048; t += G) gla_inter_task(p, t, shm); }
#endif
            XBAR();
#ifndef SK_GLAP
            phase_gla_post(launder(p0));
#ifdef PROBE_MISC
            phase_gla_post(launder(p0));
#endif
#endif
            XBAR();
        }
        { const Params p = launder(p0); const u16* A = (const u16*)(p.ws + OFF_A); const float* mods = (const float*)(p.ws + OFF_SMALL); pg8::EpiRes E; E.X = p.out; E.gm = mods + (size_t)layer * 5 * 12288 + 2 * 2048; E.gb = p.in[7] + layer * 12288 + 2 * 2048;
#if !defined(SK_GEMM) && !defined(SK_GRES)
            run_gemm(shm, A, DM, (const u16*)(p.ws + OFF_WOUT), DM, DM, DM, E);
#endif
        }
        XBAR();
#ifndef SK_NORM
        phase_norm(launder(p0), layer, 1, shm);
#ifdef PROBE_MISC
        __syncthreads(); phase_norm(launder(p0), layer, 1, shm);
#endif
#endif
        XBAR();
        { const Params p = launder(p0); const u16* A = (const u16*)(p.ws + OFF_A); pg8::EpiBf16 E; E.O = (u16*)(p.ws + OFF_U); E.ldc = LDU;
#if !defined(SK_GEMM) && !defined(SK_GBF)
            run_gemm(shm, A, DM, (const u16*)(p.ws + OFF_WUP), DM, LDU, DM, E);
#ifdef PROBE_GEMM
            __syncthreads(); run_gemm(shm, A, DM, (const u16*)(p.ws + OFF_WUP), DM, LDU, DM, E);
#endif
#endif
        }
        XBAR();
#ifndef SK_GATE
        phase_ffn_gate(launder(p0), layer);
#endif
        XBAR();
        { const Params p = launder(p0); const float* mods = (const float*)(p.ws + OFF_SMALL); pg8::EpiRes E; E.X = p.out; E.gm = mods + (size_t)layer * 5 * 12288 + 5 * 2048; E.gb = p.in[7] + layer * 12288 + 5 * 2048;
#if !defined(SK_GEMM) && !defined(SK_GRES)
            run_gemm(shm, (const u16*)(p.ws + OFF_U) + DFF, LDU, (const u16*)(p.ws + OFF_WDN), DFF, DM, DFF, E);
#endif
        }
        XBAR();
    }
    phase_final_norm(launder(p0));
}

extern "C" void kernel_launch(void* const* d_in, const int* in_sizes, int n_in, void* d_out, int out_size, void* d_ws, size_t ws_size, hipStream_t stream) {
    constexpr size_t kDynLds = 131072;
    static int grid_blocks = 0;
    if (!grid_blocks) {
        int dev = 0, cus = 0, per_cu = 0;
        hipGetDevice(&dev);
        hipDeviceGetAttribute(&cus, hipDeviceAttributeMultiprocessorCount, dev);
        hipFuncSetAttribute((const void*)mega, hipFuncAttributeMaxDynamicSharedMemorySize, (int)kDynLds);
        hipOccupancyMaxActiveBlocksPerMultiprocessor(&per_cu, mega, 512, kDynLds);
        if (per_cu < 1) per_cu = 1;
        grid_blocks = cus * per_cu;
        if (grid_blocks > 256) grid_blocks = 256;
    }
    if (ws_size < WS_NEED || n_in < 41) { fprintf(stderr, "workspace too small: %zu < %zu\n", ws_size, WS_NEED); return; }
    Params p{};
    for (int i = 0; i < 41; ++i) p.in[i] = (const float*)d_in[i];
    p.out = (float*)d_out; p.ws = (unsigned char*)d_ws;
    hipMemsetAsync((unsigned char*)d_ws + OFF_SMALL + SMALL_BYTES, 0, 256 + XCD_BAR_BYTES, stream);
    void* args[] = {&p};
    hipError_t e = hipLaunchCooperativeKernel((const void*)mega, dim3(grid_blocks), dim3(512), args, kDynLds, stream);
    if (e != hipSuccess) fprintf(stderr, "cooperative launch failed: %s (grid %d)\n", hipGetErrorString(e), grid_blocks);
}
```

```cpp
#include <hip/hip_runtime.h>
#include <hip/hip_cooperative_groups.h>
#include <cstdio>
namespace cg = cooperative_groups;

#define DEV __device__ __forceinline__
#define LAS __attribute__((address_space(3)))
typedef unsigned short u16;
typedef short bf16x8 __attribute__((ext_vector_type(8)));
typedef float f32x4 __attribute__((ext_vector_type(4)));
typedef float f32x16 __attribute__((ext_vector_type(16)));
typedef unsigned u32x2 __attribute__((ext_vector_type(2)));
typedef unsigned u32x4 __attribute__((ext_vector_type(4)));

constexpr int NTOK = 24576, NTP = 8192, DM = 2048;
constexpr int LDP0 = 6656, LDP1 = 6400, LDU = 11264, DFF = 5632;
constexpr size_t OFF_WIN = 0, OFF_WOUT = 27262976, OFF_WUP = 35651584, OFF_WDN = OFF_WUP + 46137344;
constexpr size_t OFF_A = 104857600, OFF_BIG = 205520896;
constexpr size_t OFF_P = OFF_BIG, OFF_RW = OFF_BIG + 327155712, OFF_UT = OFF_RW + 201326592, OFF_GS = OFF_UT + 50331648, OFF_GP = OFF_GS + 16777216;
constexpr size_t OFF_U = OFF_BIG, OFF_OF = OFF_BIG + 314572800, OFF_OB = OFF_OF + 100663296, OFF_DB = OFF_OB + 100663296;
constexpr size_t OFF_SMALL = OFF_BIG + 600000000, SMALL_BYTES = 491520 + 8192;
constexpr size_t XCD_BAR_BYTES = 3456 * 4;
constexpr size_t OFF_LW = OFF_SMALL + SMALL_BYTES + 256 + XCD_BAR_BYTES;
constexpr size_t OFF_G2T = OFF_LW + 524288;
constexpr size_t WS_NEED = OFF_G2T + 262144;
constexpr size_t OUT_RWST = 50331648, OUT_GLAST = 54525952;

struct Params {
    const float* in[41];
    float* out;
    unsigned char* ws;
};

DEV int tidx() { int t = threadIdx.x; asm volatile("" : "+v"(t)); return t; }
DEV Params launder(const Params& p) { Params q = p; asm volatile("" : "+s"(q.ws), "+s"(q.out)); return q; }
DEV float bf2f(unsigned b) { return __uint_as_float(b << 16); }
DEV float bflo(unsigned w) { return __uint_as_float(w << 16); }
DEV float bfhi(unsigned w) { return __uint_as_float(w & 0xffff0000u); }
DEV unsigned pk(float lo, float hi) { unsigned r; asm("v_cvt_pk_bf16_f32 %0, %1, %2" : "=v"(r) : "v"(lo), "v"(hi)); return r; }
DEV u16 f2bf(float f) { return (u16)(pk(f, 0.f) & 0xffffu); }
DEV float wave_sum(float v) {
#pragma unroll
    for (int o = 32; o > 0; o >>= 1) v += __shfl_xor(v, o);
    return v;
}
template <int CTRL> DEV float dppf(float x) { return __builtin_bit_cast(float, __builtin_amdgcn_update_dpp(0, __builtin_bit_cast(int, x), CTRL, 0xf, 0xf, true)); }
DEV float sum8(float v) { v += dppf<0xB1>(v); v += dppf<0x4E>(v); v += dppf<0x141>(v); return v; }
DEV float sum16(float v) { v = sum8(v); v += dppf<0x140>(v); return v; }
DEV f32x4 mfma16(bf16x8 a, bf16x8 b, f32x4 c) { return __builtin_amdgcn_mfma_f32_16x16x32_bf16(a, b, c, 0, 0, 0); }
DEV float sigm(float x) { return 1.f / (1.f + __expf(-x)); }
DEV int tok_cond(int tok) { return tok < NTP ? 4 : ((tok - NTP) >> 12); }
DEV void tok_tl(int tok, int& t, int& L) { if (tok < NTP) { t = tok & 255; L = 256; } else { t = (tok - NTP) & 4095; L = 4096; } }
DEV void unpack8(u32x4 w, float* o) { o[0] = bflo(w.x); o[1] = bfhi(w.x); o[2] = bflo(w.y); o[3] = bfhi(w.y); o[4] = bflo(w.z); o[5] = bfhi(w.z); o[6] = bflo(w.w); o[7] = bfhi(w.w); }
DEV void unpack4(u32x2 w, float* o) { o[0] = bflo(w.x); o[1] = bfhi(w.x); o[2] = bflo(w.y); o[3] = bfhi(w.y); }

namespace pg8 {
constexpr int BM = 256, BK = 64, HALF = 128, HTB = HALF * BK * 2, NXCD = 8, WGM = 8;
DEV int lds_byte(int r, int c) { const int st = (r >> 4) * 2 + (c >> 5), rr = r & 15, cc = c & 31, ob = rr * 64 + cc * 2; return st * 1024 + (ob ^ (((ob >> 9) & 1) << 5)); }
DEV void stage_rc(int b, int& R, int& C) { const int st = b / 1024, sb = b % 1024, swz = sb ^ (((sb >> 9) & 1) << 5); R = (st >> 1) * 16 + swz / 64; C = (st & 1) * 32 + (swz % 64) / 2; }
DEV int perm32(int rho) { const int n = rho >> 4, i = rho & 15; return 8 * (i >> 2) + 4 * n + (i & 3); }
struct Unit { int pm, pn; };
struct Gemm { const u16* A; const u16* Bt; int M, N, K, lda, ldb; };
struct StaticOrder {
    int nM, nN, nwg, G, c;
    DEV void init(int M, int N, int G_, int c_) { nM = M / BM; nN = N / BM; nwg = nM * nN; G = G_; c = c_; }
    DEV bool next(int i, Unit& u) const {
        const long L = (long)i * G + c; if (L >= nwg) return false;
        int wgid = (int)L; { const int q = nwg / NXCD, r = nwg % NXCD, xcd = wgid % NXCD, off = wgid / NXCD; wgid = (xcd < r ? xcd * (q + 1) : r * (q + 1) + (xcd - r) * q) + off; }
        const int nig = WGM * nN, gid = wgid / nig, fm = gid * WGM, gsz = (nM - fm) < WGM ? (nM - fm) : WGM;
        u.pm = fm + ((wgid % nig) % gsz); u.pn = (wgid % nig) / gsz; return true;
    }
};
struct EpiBf16 {
    static constexpr bool PERM = true;
    u16* O; int ldc;
    DEV void operator()(const f32x4 (&acc)[2][2][4][2], const Unit& u, int wr, int wc, int fr, int fq) const {
        const int row0 = u.pm * BM + wr * 64 + fr; const int col0 = u.pn * BM + wc * 32 + 8 * fq;
#pragma unroll
        for (int ai = 0; ai < 2; ++ai)
#pragma unroll
            for (int m = 0; m < 4; ++m) { u16* rowp = O + (size_t)(row0 + ai * HALF + m * 16) * ldc + col0;
#pragma unroll
                for (int bj = 0; bj < 2; ++bj) { const f32x4 v0 = acc[ai][bj][m][0], v1 = acc[ai][bj][m][1];
                    u32x4 w; w.x = pk(v0[0], v0[1]); w.y = pk(v0[2], v0[3]); w.z = pk(v1[0], v1[1]); w.w = pk(v1[2], v1[3]);
                    *(u32x4*)(rowp + bj * HALF) = w; } }
    }
};
struct EpiRes {
    static constexpr bool PERM = false;
    float* X; const float* gm; const float* gb;
    DEV void operator()(const f32x4 (&acc)[2][2][4][2], const Unit& u, int wr, int wc, int fr, int fq) const {
        const int row0 = u.pm * BM + wr * 64 + fr, col0 = u.pn * BM + wc * 32 + 4 * fq;
        const int cond = u.pm < 32 ? 4 : ((u.pm - 32) >> 4);
        const float* gmc = gm + (size_t)cond * 12288 + col0; const float* gbc = gb + col0;
#pragma unroll
        for (int ai = 0; ai < 2; ++ai)
#pragma unroll
            for (int m = 0; m < 4; ++m) { float* rowp = X + (size_t)(row0 + ai * HALF + m * 16) * DM + col0;
#pragma unroll
                for (int bj = 0; bj < 2; ++bj) {
#pragma unroll
                    for (int n = 0; n < 2; ++n) { f32x4* q = (f32x4*)(rowp + bj * HALF + n * 16);
                        const f32x4 gvv = *(const f32x4*)(gmc + bj * HALF + n * 16) + *(const f32x4*)(gbc + bj * HALF + n * 16);
                        *q = *q + gvv * acc[ai][bj][m][n]; }
                    asm volatile("" ::: "memory"); } }
    }
};

template <class Epi>
DEV void gemm_phase(LAS unsigned char* lds, const Gemm g, const StaticOrder& S, const Epi& E) {
    const int tid = tidx(), wid = __builtin_amdgcn_readfirstlane(tid >> 6), lane = tid & 63, wr = wid >> 2, wc = wid & 3, fr = lane & 15, fq = lane >> 4;
    const int K = g.K, nt = K / BK;
    unsigned voffA[2], voffB[2];
#pragma unroll
    for (int i = 0; i < 2; ++i) { int R, C; stage_rc(tid * 16 + i * 8192, R, C); const int Rb = Epi::PERM ? ((R & ~31) + perm32(R & 31)) : R;
        voffA[i] = (unsigned)(R * g.lda + C) * 2u; voffB[i] = (unsigned)(Rb * g.ldb + C) * 2u; }
    const size_t kstep = (size_t)(BK * 2);
    const size_t hstepA = (size_t)HALF * g.lda * 2, hstepB = (size_t)HALF * g.ldb * 2;
    const size_t tstepA = 2 * hstepA, tstepB = 2 * hstepB;
    const unsigned ldsw = (unsigned)wid * 1024u;
    const int aoff = lds_byte(wr * 64 + fr, fq * 8), boff = lds_byte(wc * 32 + fr, fq * 8);
#define PG8_SA(b, h) (((b) * 2 + (h)) * HTB)
#define PG8_SB(b, h) ((4 + (b) * 2 + (h)) * HTB)
#define PG8_STAGE(bufoff, gbase, voff) do { _Pragma("unroll") for (int _i = 0; _i < 2; ++_i) \
        __builtin_amdgcn_global_load_lds((const unsigned*)((const char*)(gbase) + (voff)[_i]), (LAS unsigned*)(lds + (bufoff) + ldsw + _i * 8192), 16, 0, 0); } while (0)
#define PG8_LDA(dst, b, h) do { _Pragma("unroll") for (int m = 0; m < 4; ++m) _Pragma("unroll") for (int k = 0; k < 2; ++k) dst[m][k] = *(const LAS bf16x8*)(lds + PG8_SA(b, h) + aoff + m * 2048 + k * 1024); } while (0)
#define PG8_LDB(dst, b, h) do { _Pragma("unroll") for (int n = 0; n < 2; ++n) _Pragma("unroll") for (int k = 0; k < 2; ++k) dst[n][k] = *(const LAS bf16x8*)(lds + PG8_SB(b, h) + boff + n * 2048 + k * 1024); } while (0)
#define PG8_MMA(ai, bj, At, Bt) do { __builtin_amdgcn_s_setprio(1); _Pragma("unroll") for (int m = 0; m < 4; ++m) _Pragma("unroll") for (int n = 0; n < 2; ++n) _Pragma("unroll") for (int k = 0; k < 2; ++k) \
        acc[ai][bj][m][n] = __builtin_amdgcn_mfma_f32_16x16x32_bf16(Bt[n][k], At[m][k], acc[ai][bj][m][n], 0, 0, 0); __builtin_amdgcn_s_setprio(0); } while (0)
#define PG8_WAIT_V(n) asm volatile("s_waitcnt vmcnt(" #n ")" ::: "memory")
#define PG8_WAIT_L(n) asm volatile("s_waitcnt lgkmcnt(" #n ")" ::: "memory")
#define PG8_BAR __builtin_amdgcn_s_barrier()
#define PG8_SCHED __builtin_amdgcn_sched_barrier(0)
    Unit cur, nxt; int ui = 0;
    if (!S.next(0, cur)) return;
    f32x4 acc[2][2][4][2];
#pragma unroll
    for (int a = 0; a < 2; ++a)
#pragma unroll
        for (int b = 0; b < 2; ++b)
#pragma unroll
            for (int m = 0; m < 4; ++m)
#pragma unroll
                for (int n = 0; n < 2; ++n) acc[a][b][m][n] = (f32x4){0.f, 0.f, 0.f, 0.f};
    bf16x8 At[4][2], B0[2][2], B1[2][2];
    const char* cA = (const char*)g.A + (size_t)cur.pm * tstepA; const char* cB = (const char*)g.Bt + (size_t)cur.pn * tstepB;
    PG8_STAGE(PG8_SB(0, 0), cB, voffB); PG8_STAGE(PG8_SA(0, 0), cA, voffA); PG8_STAGE(PG8_SB(0, 1), cB + hstepB, voffB); PG8_STAGE(PG8_SA(0, 1), cA + hstepA, voffA);
    if (wr == 1) PG8_BAR;
    PG8_WAIT_V(4); PG8_BAR;
    PG8_STAGE(PG8_SB(1, 0), cB + kstep, voffB); PG8_STAGE(PG8_SA(1, 0), cA + kstep, voffA); PG8_STAGE(PG8_SB(1, 1), cB + hstepB + kstep, voffB);
    PG8_WAIT_V(6); PG8_BAR;
    for (;;) {
        const bool has_next = S.next(ui + 1, nxt);
        const char* nA = has_next ? (const char*)g.A + (size_t)nxt.pm * tstepA : cA; const char* nB = has_next ? (const char*)g.Bt + (size_t)nxt.pn * tstepB : cB;
        for (int t = 0; t < nt; t += 2) {
            const bool last = (t == nt - 2);
            const char* a1 = cA + (size_t)(t + 1) * kstep;
            const char* a2 = last ? nA : cA + (size_t)(t + 2) * kstep; const char* b2 = last ? nB : cB + (size_t)(t + 2) * kstep;
            const char* a3 = a2 + kstep; const char* b3 = b2 + kstep;
            PG8_LDB(B0, 0, 0); PG8_SCHED; PG8_LDA(At, 0, 0); PG8_STAGE(PG8_SA(1, 1), a1 + hstepA, voffA);
            PG8_WAIT_L(8); PG8_BAR; PG8_WAIT_L(0); PG8_MMA(0, 0, At, B0); PG8_BAR; PG8_SCHED;
            PG8_LDB(B1, 0, 1); PG8_STAGE(PG8_SB(0, 0), b2, voffB);
            PG8_BAR; PG8_WAIT_L(0); PG8_MMA(0, 1, At, B1); PG8_BAR;
            PG8_LDA(At, 0, 1); PG8_STAGE(PG8_SA(0, 0), a2, voffA);
            PG8_BAR; PG8_WAIT_L(0); PG8_MMA(1, 0, At, B0); PG8_BAR; PG8_SCHED;
            PG8_STAGE(PG8_SB(0, 1), b2 + hstepB, voffB);
            PG8_WAIT_V(6); PG8_BAR; PG8_MMA(1, 1, At, B1); PG8_BAR;
            PG8_LDB(B0, 1, 0); PG8_SCHED; PG8_LDA(At, 1, 0); PG8_STAGE(PG8_SA(0, 1), a2 + hstepA, voffA);
            PG8_WAIT_L(8); PG8_BAR; PG8_WAIT_L(0); PG8_MMA(0, 0, At, B0); PG8_BAR; PG8_SCHED;
            PG8_LDB(B1, 1, 1); PG8_STAGE(PG8_SB(1, 0), b3, voffB);
            PG8_BAR; PG8_WAIT_L(0); PG8_MMA(0, 1, At, B1); PG8_BAR;
            PG8_LDA(At, 1, 1); PG8_STAGE(PG8_SA(1, 0), a3, voffA);
            PG8_BAR; PG8_WAIT_L(0); PG8_MMA(1, 0, At, B0); PG8_BAR; PG8_SCHED;
            PG8_STAGE(PG8_SB(1, 1), b3 + hstepB, voffB);
            PG8_WAIT_V(6); PG8_BAR; PG8_MMA(1, 1, At, B1); PG8_BAR;
        }
        E(acc, cur, wr, wc, fr, fq);
        if (!has_next) break;
#pragma unroll
        for (int a = 0; a < 2; ++a)
#pragma unroll
            for (int b = 0; b < 2; ++b)
#pragma unroll
                for (int m = 0; m < 4; ++m)
#pragma unroll
                    for (int n = 0; n < 2; ++n) acc[a][b][m][n] = (f32x4){0.f, 0.f, 0.f, 0.f};
        cur = nxt; cA = nA; cB = nB; ++ui;
    }
    PG8_WAIT_V(0);
    if (wr == 0) PG8_BAR;
    PG8_BAR;
#undef PG8_SA
#undef PG8_SB
#undef PG8_STAGE
#undef PG8_LDA
#undef PG8_LDB
#undef PG8_MMA
#undef PG8_WAIT_V
#undef PG8_WAIT_L
#undef PG8_BAR
#undef PG8_SCHED
}
}

template <class Epi>
DEV void run_gemm(unsigned char* shm, const u16* A, int lda, const u16* Bt, int ldb, int N, int K, const Epi& E) {
    asm volatile("" : "+s"(A), "+s"(Bt));
    pg8::Gemm g; g.A = A; g.Bt = Bt; g.M = NTOK; g.N = N; g.K = K; g.lda = lda; g.ldb = ldb;
    pg8::StaticOrder S; S.init(NTOK, N, (int)gridDim.x, (int)blockIdx.x);
    pg8::gemm_phase<Epi>((LAS unsigned char*)shm, g, S, E);
}

DEV void convT_tile(const float* __restrict__ src, u16* __restrict__ dst, int K, int N, int Npad, int tile, float* T) {
    const int tid = tidx(); const int ntn = Npad >> 6; const int k0 = (tile / ntn) << 6, n0 = (tile % ntn) << 6;
#pragma unroll
    for (int j = 0; j < 2; ++j) { const int idx = tid + j * 512; const int r = idx >> 4, c4 = (idx & 15) << 2;
        float4 v = make_float4(0.f, 0.f, 0.f, 0.f); if (n0 + c4 < N) v = *(const float4*)(src + (size_t)(k0 + r) * N + n0 + c4);
        float* t = T + r * 65 + c4; t[0] = v.x; t[1] = v.y; t[2] = v.z; t[3] = v.w; }
    __syncthreads();
    { const int nn = tid >> 3, kq = (tid & 7) << 3; const float* t = T + kq * 65 + nn;
        u32x4 o; o.x = pk(t[0], t[65]); o.y = pk(t[130], t[195]); o.z = pk(t[260], t[325]); o.w = pk(t[390], t[455]);
        *(u32x4*)(dst + (size_t)(n0 + nn) * K + k0 + kq) = o; }
    __syncthreads();
}
DEV int conv_ntiles(int job, int layer) { return job == 0 ? (layer ? 3200 : 3328) : job == 1 ? 1024 : job == 2 ? 5632 : 2816; }
DEV void conv_job(const Params& p, int job, int layer, int tile, float* T) {
    if (job == 0) convT_tile(layer ? p.in[36] : p.in[14], (u16*)(p.ws + OFF_WIN), 2048, layer ? 6176 : 6528, layer ? LDP1 : LDP0, tile, T);
    else if (job == 1) convT_tile(layer ? p.in[37] : p.in[15], (u16*)(p.ws + OFF_WOUT), 2048, 2048, 2048, tile, T);
    else if (job == 2) convT_tile(p.in[10] + (size_t)layer * 2048 * 11264, (u16*)(p.ws + OFF_WUP), 2048, 11264, 11264, tile, T);
    else convT_tile(p.in[12] + (size_t)layer * 5632 * 2048, (u16*)(p.ws + OFF_WDN), 5632, 2048, 2048, tile, T);
}

DEV void adaln_tile(const Params& p, int tile, float* sl) {
    const int tid = tidx(); const int nt = tile % 6, kc = (tile / 6) & 31, layer = tile / 192;
    if (tid < 320) { const int j = tid >> 6, kk = tid & 63; const float cv = (j < 4) ? p.in[4][j * 2048 + kc * 64 + kk] : p.in[5][kc * 64 + kk]; sl[tid] = cv / (1.f + expf(-cv)); }
    __syncthreads();
    const float* w = p.in[6] + ((size_t)layer * 2048 + kc * 64) * 12288 + nt * 2048 + tid * 4;
    float acc[5][4];
#pragma unroll
    for (int j = 0; j < 5; ++j) { acc[j][0] = 0.f; acc[j][1] = 0.f; acc[j][2] = 0.f; acc[j][3] = 0.f; }
#pragma unroll 8
    for (int kk = 0; kk < 64; ++kk) { const float4 wv = *(const float4*)(w + (size_t)kk * 12288);
#pragma unroll
        for (int j = 0; j < 5; ++j) { const float s = sl[j * 64 + kk]; acc[j][0] += s * wv.x; acc[j][1] += s * wv.y; acc[j][2] += s * wv.z; acc[j][3] += s * wv.w; } }
    float* m = (float*)(p.ws + OFF_A) + (size_t)kc * 122880 + (size_t)layer * 5 * 12288 + nt * 2048 + tid * 4;
#pragma unroll
    for (int j = 0; j < 5; ++j) *(float4*)(m + j * 12288) = make_float4(acc[j][0], acc[j][1], acc[j][2], acc[j][3]);
    __syncthreads();
}

DEV void hyfilt_tile(const Params& p, int tile, float* sm) {
    const int tid = tidx();
    int L, p0; u16* G; float* nrm = (float*)(p.ws + OFF_A) + 32 * 122880 + (size_t)tile * 2048;
    if (tile < 128) { L = 4096; p0 = tile * 32; G = (u16*)(p.ws + OFF_GS); }
    else { L = 256; p0 = (tile - 128) * 32; G = (u16*)(p.ws + OFF_GP); }
    float* z = sm; float* h1 = sm + 32 * 33; float* h2 = h1 + 2048;
    const float cang = (float)(6.283185307179586 / (double)L);
    for (int i = tid; i < 32 * 33; i += 512) { const int pp = i / 33, e = i % 33; const float pos = (float)(p0 + pp); float val;
        if (e == 0) val = pos / (float)(L - 1);
        else { const int bi = (e - 1) & 15; const float fb = 1e-4f + (float)bi * ((15.f - 1e-4f) / 15.f); const float ang = (cang * pos) * fb; val = (e <= 16) ? cosf(ang) : -sinf(ang); }
        z[i] = val; }
    __syncthreads();
    for (int i = tid; i < 2048; i += 512) { const int pp = i >> 6, j = i & 63; float a = p.in[19][j];
        for (int e = 0; e < 33; ++e) a += z[pp * 33 + e] * p.in[18][e * 64 + j];
        h1[i] = sinf(p.in[23][j] * a); }
    __syncthreads();
    for (int i = tid; i < 2048; i += 512) { const int pp = i >> 6, j = i & 63; float a = p.in[21][j];
        for (int e = 0; e < 64; ++e) a += h1[pp * 64 + e] * p.in[20][e * 64 + j];
        h2[i] = sinf(p.in[23][64 + j] * a); }
    __syncthreads();
    const float dlo = 3.0701134573253946f, dhi = 15.350567286626973f;
    for (int q = 0; q < 4; ++q) { const int n = tid + 512 * q; const int c = n & 1023; const int back = n >> 10;
        float wcol[64];
#pragma unroll
        for (int e = 0; e < 64; ++e) wcol[e] = p.in[22][e * 2048 + n];
        const float delta = dlo + (dhi - dlo) * ((float)c / 1023.f);
        float asum = 0.f;
        for (int pp = 0; pp < 32; ++pp) { float a = 0.f;
#pragma unroll
            for (int e = 0; e < 64; ++e) a += h2[pp * 64 + e] * wcol[e];
            const int pos = p0 + pp; const float t = (float)pos / (float)(L - 1); a *= expf(-t * delta);
            if (!(back && pos == 0)) { asum += fabsf(a); const int lag = back ? -pos : pos; G[(size_t)c * (2 * L) + (L - lag)] = f2bf(a); } }
        nrm[n] = asum; }
    if (p0 == 0) for (int c = tid; c < 1024; c += 512) G[(size_t)c * (2 * L)] = 0;
    __syncthreads();
}

DEV void phase_prep(const Params& p, unsigned char* shm) {
    const int tid = tidx(); float* sm = (float*)shm;
    if (blockIdx.x == 0 && tid == 0) *(unsigned*)(p.ws + OFF_SMALL + SMALL_BYTES) = 0u;
    { u16* LW = (u16*)(p.ws + OFF_LW); u16* G2T = (u16*)(p.ws + OFF_G2T);
        for (int i = blockIdx.x * 512 + tid; i < 4 * 1024 * 64 + 1024 * 128; i += gridDim.x * 512) {
            if (i < 262144) { const int mi = i >> 16, n = (i >> 6) & 1023, r = i & 63; LW[i] = f2bf((mi < 2 ? p.in[27] : p.in[29])[((size_t)(mi & 1) * 64 + r) * 1024 + n]); }
            else { const int j = i - 262144; const int n = j >> 7, r = j & 127; G2T[j] = f2bf(p.in[30][(size_t)r * 1024 + n]); } } }
    const int n0 = 136, n1 = n0 + 384, n2 = n1 + 3328, n3 = n2 + 1024, n4 = n3 + 5632, n5 = n4 + 2816;
    for (int t = blockIdx.x; t < n5; t += gridDim.x) {
        if (t < n0) hyfilt_tile(p, t, sm);
        else if (t < n1) adaln_tile(p, t - n0, sm);
        else if (t < n2) conv_job(p, 0, 0, t - n1, sm);
        else if (t < n3) conv_job(p, 1, 0, t - n2, sm);
        else if (t < n4) conv_job(p, 2, 0, t - n3, sm);
        else conv_job(p, 3, 0, t - n4, sm);
    }
}

DEV void phase_reduce(const Params& p) {
    const float* part = (const float*)(p.ws + OFF_A); float* mods = (float*)(p.ws + OFF_SMALL); float* hn = (float*)(p.ws + OFF_SMALL + 491520);
    for (int i = blockIdx.x * 512 + tidx(); i < 122880 + 2048; i += gridDim.x * 512) {
        if (i < 122880) { float a = 0.f; for (int kc = 0; kc < 32; ++kc) a += part[(size_t)kc * 122880 + i]; mods[i] = a; }
        else { const int j = i - 122880; const int c = j & 1023; const float* hp = part + 32 * 122880; float a = 0.f;
            if (j < 1024) { for (int t = 0; t < 128; ++t) a += hp[(size_t)t * 2048 + c] + hp[(size_t)t * 2048 + 1024 + c]; }
            else { for (int t = 128; t < 136; ++t) a += hp[(size_t)t * 2048 + c] + hp[(size_t)t * 2048 + 1024 + c]; }
            hn[j] = a; }
    }
}

DEV void phase_norm(const Params& p, int layer, int which, unsigned char* shm) {
    const int tid = tidx(), wid = tid >> 6, lane = tid & 63;
    const float* g = p.in[which ? 9 : 8] + layer * 2048;
    const float* X = p.out; u16* A = (u16*)(p.ws + OFF_A);
    const float* mods = (const float*)(p.ws + OFF_SMALL) + (size_t)layer * 5 * 12288; const float* bb = p.in[7] + layer * 12288;
    const int shi = which ? 3 : 0;
    for (int row = blockIdx.x * 8 + wid; row < NTOK; row += gridDim.x * 8) {
        const bool first = (layer == 0 && which == 0);
        const float* xsrc = X + (size_t)row * DM; if (first) xsrc = row < NTP ? p.in[0] + (size_t)row * DM : p.in[1] + (size_t)(row - NTP) * DM;
        const float4* xr = (const float4*)xsrc;
        float4 v[8]; float ss = 0.f;
#pragma unroll
        for (int j = 0; j < 8; ++j) { v[j] = xr[lane + 64 * j]; ss += v[j].x * v[j].x + v[j].y * v[j].y + v[j].z * v[j].z + v[j].w * v[j].w; }
        if (first) {
#pragma unroll
            for (int j = 0; j < 8; ++j) ((float4*)(p.out + (size_t)row * DM))[lane + 64 * j] = v[j]; }
        ss = wave_sum(ss);
        const float rstd = rsqrtf(ss * (1.f / 2048.f) + 1e-6f);
        const float* md = mods + (size_t)tok_cond(row) * 12288;
#pragma unroll
        for (int j = 0; j < 8; ++j) { const int col = (lane + 64 * j) * 4;
            const float4 gg = *(const float4*)(g + col);
            const float4 s1 = *(const float4*)(md + shi * 2048 + col), s2 = *(const float4*)(bb + shi * 2048 + col);
            const float4 c1 = *(const float4*)(md + (shi + 1) * 2048 + col), c2 = *(const float4*)(bb + (shi + 1) * 2048 + col);
            const float o0 = v[j].x * rstd * gg.x * (1.f + c1.x + c2.x) + s1.x + s2.x;
            const float o1 = v[j].y * rstd * gg.y * (1.f + c1.y + c2.y) + s1.y + s2.y;
            const float o2 = v[j].z * rstd * gg.z * (1.f + c1.z + c2.z) + s1.z + s2.z;
            const float o3 = v[j].w * rstd * gg.w * (1.f + c1.w + c2.w) + s1.w + s2.w;
            u32x2 o; o.x = pk(o0, o1); o.y = pk(o2, o3);
            *(u32x2*)(A + (size_t)row * DM + col) = o; }
    }
    if (layer == 0 && which == 1) { const int na = conv_ntiles(0, 1), nb = na + conv_ntiles(1, 1);
        for (int t = blockIdx.x; t < nb; t += gridDim.x) { if (t < na) conv_job(p, 0, 1, t, (float*)shm); else conv_job(p, 1, 1, t - na, (float*)shm); } }
    if (layer == 1 && which == 0) { const int na = conv_ntiles(2, 1), nb = na + conv_ntiles(3, 1);
        for (int t = blockIdx.x; t < nb; t += gridDim.x) { if (t < na) conv_job(p, 2, 1, t, (float*)shm); else conv_job(p, 3, 1, t - na, (float*)shm); } }
}

DEV void sconv8(const u16* prow, bool hm, bool hp, const float* sw, const float* sb, int ch, float* o) {
    float c[8], m[8], q[8];
    unpack8(*(const u32x4*)(prow + ch), c);
    if (hm) unpack8(*(const u32x4*)(prow - LDP0 + ch), m); else { for (int i = 0; i < 8; ++i) m[i] = 0.f; }
    if (hp) unpack8(*(const u32x4*)(prow + LDP0 + ch), q); else { for (int i = 0; i < 8; ++i) q[i] = 0.f; }
#pragma unroll
    for (int i = 0; i < 8; ++i) o[i] = m[i] * sw[ch + i] + c[i] * sw[3072 + ch + i] + q[i] * sw[6144 + ch + i] + sb[ch + i];
}
DEV void hy_pre_tile(const Params& p, int tile, float* T) {
    const int tid = tidx(); const int tok0 = (tile >> 4) << 6, c0 = (tile & 15) << 6;
    const u16* P = (const u16*)(p.ws + OFF_P); u16* uT = (u16*)(p.ws + OFF_UT);
    { const int tk = tid >> 3, c8 = (tid & 7) << 3; const int tok = tok0 + tk; int t, L; tok_tl(tok, t, L);
        const u16* prow = P + (size_t)tok * LDP0; float x1[8], vv[8];
        sconv8(prow, t > 0, t < L - 1, p.in[16], p.in[17], 1024 + c0 + c8, x1);
        sconv8(prow, t > 0, t < L - 1, p.in[16], p.in[17], 2048 + c0 + c8, vv);
#pragma unroll
        for (int i = 0; i < 8; ++i) T[tk * 65 + c8 + i] = x1[i] * vv[i]; }
    __syncthreads();
    { const int ch = tid >> 3, t8 = (tid & 7) << 3; const float* t = T + t8 * 65 + ch;
        u32x4 o; o.x = pk(t[0], t[65]); o.y = pk(t[130], t[195]); o.z = pk(t[260], t[325]); o.w = pk(t[390], t[455]);
        *(u32x4*)(uT + (size_t)(c0 + ch) * NTOK + tok0 + t8) = o; }
    __syncthreads();
}
DEV void hy_post_tile(const Params& p, int tile, float* T) {
    const int tid = tidx(); const int tok0 = (tile >> 4) << 6, c0 = (tile & 15) << 6;
    const u16* P = (const u16*)(p.ws + OFF_P); const u16* uT = (const u16*)(p.ws + OFF_UT); u16* ycat = (u16*)(p.ws + OFF_A);
    { const int ch = tid >> 3, t8 = (tid & 7) << 3; float y[8]; unpack8(*(const u32x4*)(uT + (size_t)(c0 + ch) * NTOK + tok0 + t8), y);
#pragma unroll
        for (int i = 0; i < 8; ++i) T[(t8 + i) * 65 + ch] = y[i]; }
    __syncthreads();
    { const int tk = tid >> 3, c8 = (tid & 7) << 3; const int tok = tok0 + tk; int t, L; tok_tl(tok, t, L);
        const u16* prow = P + (size_t)tok * LDP0; float x0[8], x1[8], vv[8], o[8];
        sconv8(prow, t > 0, t < L - 1, p.in[16], p.in[17], c0 + c8, x0);
        sconv8(prow, t > 0, t < L - 1, p.in[16], p.in[17], 1024 + c0 + c8, x1);
        sconv8(prow, t > 0, t < L - 1, p.in[16], p.in[17], 2048 + c0 + c8, vv);
        const float* nrm = (const float*)(p.ws + OFF_SMALL + 491520) + (tok < NTP ? 1024 : 0);
#pragma unroll
        for (int i = 0; i < 8; ++i) { const int c = c0 + c8 + i; o[i] = x0[i] * (T[tk * 65 + c8 + i] / nrm[c] + x1[i] * vv[i] * p.in[24][c]); }
        u32x4 w; w.x = pk(o[0], o[1]); w.y = pk(o[2], o[3]); w.z = pk(o[4], o[5]); w.w = pk(o[6], o[7]);
        *(u32x4*)(ycat + (size_t)tok * DM + c0 + c8) = w; }
    __syncthreads();
}
DEV void hyconv_task(const Params& p, int task, unsigned char* shm) {
    const int tid = tidx(), wid = tid >> 6, lane = tid & 63;
    const bool sample = task < 1024; const int c = sample ? task : task - 1024;
    const int L = sample ? 4096 : 256, NB = sample ? 4 : 32, lgNB = sample ? 2 : 5, LP = L + 8;
    u16* uL = (u16*)shm; u16* gL = uL + NB * LP; u16* gS = gL + 2 * L;
    const u16* G = sample ? (const u16*)(p.ws + OFF_GS) + (size_t)c * 8192 : (const u16*)(p.ws + OFF_GP) + (size_t)c * 512;
    u16* uT = (u16*)(p.ws + OFF_UT) + (size_t)c * NTOK + (sample ? NTP : 0);
    for (int i = tid * 8; i < NB * L; i += 4096) { const int b = i / L, s = i % L; *(u32x4*)(uL + b * LP + s) = *(const u32x4*)(uT + i); }
    for (int i = tid * 8; i < 2 * L; i += 4096) { const u32x4 w = *(const u32x4*)(G + i); *(u32x4*)(gL + i) = w;
        const unsigned nx = (i + 8 < 2 * L) ? (unsigned)G[i + 8] : 0u;
        u32x4 sft; sft.x = (w.x >> 16) | (w.y << 16); sft.y = (w.y >> 16) | (w.z << 16); sft.z = (w.z >> 16) | (w.w << 16); sft.w = (w.w >> 16) | (nx << 16);
        *(u32x4*)(gS + i) = sft; }
    __syncthreads();
    const int ntile = (NB * (L >> 5)) >> 5;
    const int npair = sample ? 8 : 8; const bool two = sample;
    const int r = lane & 31, half = lane >> 5;
    {
        const int ct0 = two ? 2 * wid : wid;
        const int colA = ct0 * 32 + r, colB = colA + 32;
        const int bA = colA & (NB - 1), iA = colA >> lgNB, bB = colB & (NB - 1), iB = colB >> lgNB; const int tA = iA * 32, tB = iB * 32;
        const int i_lo = (ct0 * 32) >> lgNB, i_hi = ((two ? ct0 + 1 : ct0) * 32 + 31) >> lgNB;
        const int d_lo = 32 * i_lo - (L - 16), d_hi = 32 * i_hi;
        f32x16 accA, accB;
#pragma unroll
        for (int j = 0; j < 16; ++j) { accA[j] = 0.f; accB[j] = 0.f; }
        const u16* ubA = uL + bA * LP + 8 * half; const u16* ubB = uL + bB * LP + 8 * half;
        const u16* gsel = (r & 1) ? gS : gL;
        const int qb = (L - r + 8 * half) & ~1;
        for (int dl = d_lo; dl <= d_hi; dl += 16) {
            const unsigned* gq = (const unsigned*)(gsel + (qb - dl));
            u32x4 aw; aw.x = gq[0]; aw.y = gq[1]; aw.z = gq[2]; aw.w = gq[3];
            const bf16x8 a = __builtin_bit_cast(bf16x8, aw);
            const int sA = tA - dl, sB = tB - dl;
            bf16x8 bvA = (bf16x8){0, 0, 0, 0, 0, 0, 0, 0}, bvB = bvA;
            if (sA >= 0 && sA <= L - 16) bvA = *(const bf16x8*)(ubA + sA);
            accA = __builtin_amdgcn_mfma_f32_32x32x16_bf16(a, bvA, accA, 0, 0, 0);
            if (two) { if (sB >= 0 && sB <= L - 16) bvB = *(const bf16x8*)(ubB + sB);
                accB = __builtin_amdgcn_mfma_f32_32x32x16_bf16(a, bvB, accB, 0, 0, 0); }
        }
#pragma unroll
        for (int g = 0; g < 4; ++g) { u32x2 w; w.x = pk(accA[4 * g], accA[4 * g + 1]); w.y = pk(accA[4 * g + 2], accA[4 * g + 3]);
            *(u32x2*)(uT + (size_t)bA * L + tA + 8 * g + 4 * half) = w; }
        if (two) {
#pragma unroll
            for (int g = 0; g < 4; ++g) { u32x2 w; w.x = pk(accB[4 * g], accB[4 * g + 1]); w.y = pk(accB[4 * g + 2], accB[4 * g + 3]);
                *(u32x2*)(uT + (size_t)bB * L + tB + 8 * g + 4 * half) = w; } }
    }
    (void)ntile; (void)npair;
    __syncthreads();
}

DEV void rwkv_lora_tile(const Params& p, int tile, unsigned char* shm) {
    const int tid = tidx(), wid = tid >> 6, lane = tid & 63, l15 = lane & 15, quad = lane >> 4; const int tok0 = tile * 32;
    const u16* P = (const u16*)(p.ws + OFF_P); u16* RW = (u16*)(p.ws + OFF_RW); const u16* LW = (const u16*)(p.ws + OFF_LW);
    u16* Ain = (u16*)shm;
    u16* Ol = (u16*)(shm + 18432);
    for (int i = tid; i < 32 * 256; i += 512) { const int tk = i >> 8, cc = i & 255; const int tok = tok0 + tk; int t, L; tok_tl(tok, t, L);
        const u16* pp = P + (size_t)tok * LDP0 + 6144 + cc; float x = bf2f(*pp); const float xm = t > 0 ? bf2f(pp[-LDP0]) : 0.f; const float xp = t < L - 1 ? bf2f(pp[LDP0]) : 0.f;
        const float mu = p.in[25][3072 + cc]; x = x + mu * (0.5f * (xm + xp) - x); if (cc < 128) x = tanhf(x);
        Ain[((cc >> 6) * 32 + tk) * 72 + (cc & 63)] = f2bf(x); }
    __syncthreads();
#pragma unroll 1
    for (int mi = 0; mi < 4; ++mi) {
        const float* bias = (mi < 2 ? p.in[26] : p.in[28]) + (mi & 1) * 1024;
        const float osc = mi < 2 ? 0.6065306597f : 1.f;
        bf16x8 af[2][2];
#pragma unroll
        for (int tt = 0; tt < 2; ++tt)
#pragma unroll
            for (int ks = 0; ks < 2; ++ks) af[tt][ks] = *(const bf16x8*)(Ain + (mi * 32 + tt * 16 + l15) * 72 + ks * 32 + quad * 8);
#pragma unroll 2
        for (int q = 0; q < 8; ++q) { const int nt = wid * 8 + q; const int n = nt * 16 + l15;
            const bf16x8 b0 = *(const bf16x8*)(LW + ((size_t)mi * 1024 + n) * 64 + quad * 8), b1 = *(const bf16x8*)(LW + ((size_t)mi * 1024 + n) * 64 + 32 + quad * 8);
            const float bs = bias[n];
#pragma unroll
            for (int tt = 0; tt < 2; ++tt) { f32x4 acc = (f32x4){0.f, 0.f, 0.f, 0.f}; acc = mfma16(af[tt][0], b0, acc); acc = mfma16(af[tt][1], b1, acc);
#pragma unroll
                for (int r = 0; r < 4; ++r) Ol[(tt * 16 + quad * 4 + r) * 1032 + n] = f2bf(osc * sigm(acc[r] + bs)); } }
        __syncthreads();
#pragma unroll
        for (int i = 0; i < 8; ++i) { const int piece = tid + 512 * i; const int tk = piece >> 7, c8 = (piece & 127) * 8;
            *(u32x4*)(RW + (size_t)(tok0 + tk) * 4096 + mi * 1024 + c8) = *(const u32x4*)(Ol + tk * 1032 + c8); }
        __syncthreads();
    }
}
DEV float mixf(float c, float m, float q, float mu) { return c + mu * (0.5f * (m + q) - c); }
DEV void rwkv_scan_task(const Params& p, int task, float* sm) {
    const bool sample = task < 128; const int tt_ = sample ? task : task - 128;
    const int b = tt_ >> 5, h = (tt_ >> 1) & 15, dir = tt_ & 1;
    const int L = sample ? 4096 : 256; const int tok0 = sample ? NTP + b * 4096 : b * 256;
    const int tid = tidx(), wid = tid >> 6, lane = tid & 63;
    const int kl = lane & 7;
    const int row2 = (wid & 3) * 16 + (lane >> 3) * 2;
    float S[8], T[8];
    const size_t so2 = ((((size_t)b * 2 + dir) * 16 + h) * 64 + row2) * 64 + kl * 8;
    if (sample) {
        const float4 a = *(const float4*)(p.in[2] + so2), c = *(const float4*)(p.in[2] + so2 + 4), d = *(const float4*)(p.in[2] + so2 + 64), e = *(const float4*)(p.in[2] + so2 + 68);
        S[0] = a.x; S[1] = a.y; S[2] = a.z; S[3] = a.w; S[4] = c.x; S[5] = c.y; S[6] = c.z; S[7] = c.w;
        T[0] = d.x; T[1] = d.y; T[2] = d.z; T[3] = d.w; T[4] = e.x; T[5] = e.y; T[6] = e.z; T[7] = e.w; }
    else {
#pragma unroll
        for (int i = 0; i < 8; ++i) { S[i] = 0.f; T[i] = 0.f; } }
    const int pk4 = (tid & 15) * 4; const int ch = h * 64 + pk4; const int plt = (tid & 255) >> 4;
    const float4 mur = *(const float4*)(p.in[25] + ch), muk = *(const float4*)(p.in[25] + 1024 + ch), muv = *(const float4*)(p.in[25] + 2048 + ch);
    const float4 kkw = *(const float4*)(p.in[31] + ch), kaw = *(const float4*)(p.in[32] + ch);
    const float murA[4] = {mur.x, mur.y, mur.z, mur.w}, mukA[4] = {muk.x, muk.y, muk.z, muk.w}, muvA[4] = {muv.x, muv.y, muv.z, muv.w};
    const float kkwA[4] = {kkw.x, kkw.y, kkw.z, kkw.w}, kawA[4] = {kaw.x, kaw.y, kaw.z, kaw.w};
    const u16* P = (const u16*)(p.ws + OFF_P); const u16* RW = (const u16*)(p.ws + OFF_RW);
    u16* Y = (u16*)(p.out + OUT_GLAST) + (dir ? (size_t)NTOK * 1024 : 0);
#define RW_PREP(c0_, buf_) do { float* vec_ = sm + (buf_) * 14336; float* vvs_ = vec_ + 10240; \
        _Pragma("unroll 1") for (int ps = 0; ps < 2; ++ps) { const int ptt = plt + 16 * ps; \
            const int t = dir ? (L - 1 - ((c0_) + ptt)) : ((c0_) + ptt); const size_t tok = (size_t)tok0 + t; \
            const u16* pr = P + tok * LDP0 + 3072 + ch; \
            float rc[4], kc[4], vc[4], rm[4], km[4], vm[4], rp[4], kp[4], vp[4], ee[4], aa[4]; \
            unpack4(*(const u32x2*)(pr), rc); unpack4(*(const u32x2*)(pr + 1024), kc); unpack4(*(const u32x2*)(pr + 2048), vc); \
            if (t > 0) { const u16* pm = P + (tok - 1) * LDP0 + 3072 + ch; unpack4(*(const u32x2*)(pm), rm); unpack4(*(const u32x2*)(pm + 1024), km); unpack4(*(const u32x2*)(pm + 2048), vm); } \
            else { for (int i = 0; i < 4; ++i) { rm[i] = 0.f; km[i] = 0.f; vm[i] = 0.f; } } \
            if (t < L - 1) { unpack4(*(const u32x2*)(pr + LDP0), rp); unpack4(*(const u32x2*)(pr + LDP0 + 1024), kp); unpack4(*(const u32x2*)(pr + LDP0 + 2048), vp); } \
            else { for (int i = 0; i < 4; ++i) { rp[i] = 0.f; kp[i] = 0.f; vp[i] = 0.f; } } \
            unpack4(*(const u32x2*)(RW + tok * 4096 + dir * 1024 + ch), ee); unpack4(*(const u32x2*)(RW + tok * 4096 + (2 + dir) * 1024 + ch), aa); \
            float r4[4], k4[4], v4[4], kr[4]; float ss = 0.f; \
            _Pragma("unroll") for (int i = 0; i < 4; ++i) { r4[i] = mixf(rc[i], rm[i], rp[i], murA[i]); k4[i] = mixf(kc[i], km[i], kp[i], mukA[i]); v4[i] = mixf(vc[i], vm[i], vp[i], muvA[i]); \
                kr[i] = k4[i] * kkwA[i]; ss += kr[i] * kr[i]; } \
            ss = sum16(ss); const float inv = rsqrtf(ss + 1e-12f); \
            float tkk[4], tw[4], tkka[4], tkd[4]; \
            _Pragma("unroll") for (int i = 0; i < 4; ++i) { tkk[i] = kr[i] * inv; tw[i] = __expf(-ee[i]); tkka[i] = tkk[i] * aa[i]; tkd[i] = k4[i] * (1.f + (aa[i] - 1.f) * kawA[i]); } \
            float* vj = vec_ + ptt * 320 + pk4; \
            *(float4*)(vj) = make_float4(tkk[0], tkk[1], tkk[2], tkk[3]); *(float4*)(vj + 64) = make_float4(tw[0], tw[1], tw[2], tw[3]); *(float4*)(vj + 128) = make_float4(tkka[0], tkka[1], tkka[2], tkka[3]); \
            *(float4*)(vj + 192) = make_float4(tkd[0], tkd[1], tkd[2], tkd[3]); *(float4*)(vj + 256) = make_float4(r4[0], r4[1], r4[2], r4[3]); \
            *(float4*)(vvs_ + ptt * 64 + pk4) = make_float4(v4[0], v4[1], v4[2], v4[3]); } } while (0)
#define RW_YOUT(c0_, buf_) do { const float* yb_ = sm + (buf_) * 14336 + 12288; \
        _Pragma("unroll 1") for (int ps = 0; ps < 2; ++ps) { const int ptt = plt + 16 * ps; const int t = dir ? (L - 1 - ((c0_) + ptt)) : ((c0_) + ptt); \
            const float4 yv = *(const float4*)(yb_ + ptt * 64 + pk4); u32x2 w; w.x = pk(yv.x, yv.y); w.y = pk(yv.z, yv.w); \
            *(u32x2*)(Y + ((size_t)tok0 + t) * 1024 + ch) = w; } } while (0)
    const int nchunk = L >> 5;
    if (wid >= 4) RW_PREP(0, 0);
    __syncthreads();
#pragma unroll 1
    for (int c = 0; c < nchunk; ++c) {
        if (wid < 4) {
            const float* vec = sm + (c & 1) * 14336; const float* vvs = vec + 10240; float* yb = sm + (c & 1) * 14336 + 12288;
            for (int j = 0; j < 32; ++j) {
                const float* vj = vec + j * 320 + kl * 8;
                const float4 a0 = *(const float4*)(vj), a1 = *(const float4*)(vj + 4);
                const float4 w0 = *(const float4*)(vj + 64), w1 = *(const float4*)(vj + 68);
                const float4 b0 = *(const float4*)(vj + 128), b1 = *(const float4*)(vj + 132);
                const float4 d0 = *(const float4*)(vj + 192), d1 = *(const float4*)(vj + 196);
                const float4 r0 = *(const float4*)(vj + 256), r1 = *(const float4*)(vj + 260);
                const float2 vr = *(const float2*)(vvs + j * 64 + row2);
                float sa = S[0] * a0.x + S[1] * a0.y + S[2] * a0.z + S[3] * a0.w + S[4] * a1.x + S[5] * a1.y + S[6] * a1.z + S[7] * a1.w;
                float sb = T[0] * a0.x + T[1] * a0.y + T[2] * a0.z + T[3] * a0.w + T[4] * a1.x + T[5] * a1.y + T[6] * a1.z + T[7] * a1.w;
                sa = -sum8(sa); sb = -sum8(sb);
                S[0] = S[0] * w0.x + sa * b0.x + vr.x * d0.x; S[1] = S[1] * w0.y + sa * b0.y + vr.x * d0.y; S[2] = S[2] * w0.z + sa * b0.z + vr.x * d0.z; S[3] = S[3] * w0.w + sa * b0.w + vr.x * d0.w;
                S[4] = S[4] * w1.x + sa * b1.x + vr.x * d1.x; S[5] = S[5] * w1.y + sa * b1.y + vr.x * d1.y; S[6] = S[6] * w1.z + sa * b1.z + vr.x * d1.z; S[7] = S[7] * w1.w + sa * b1.w + vr.x * d1.w;
                T[0] = T[0] * w0.x + sb * b0.x + vr.y * d0.x; T[1] = T[1] * w0.y + sb * b0.y + vr.y * d0.y; T[2] = T[2] * w0.z + sb * b0.z + vr.y * d0.z; T[3] = T[3] * w0.w + sb * b0.w + vr.y * d0.w;
                T[4] = T[4] * w1.x + sb * b1.x + vr.y * d1.x; T[5] = T[5] * w1.y + sb * b1.y + vr.y * d1.y; T[6] = T[6] * w1.z + sb * b1.z + vr.y * d1.z; T[7] = T[7] * w1.w + sb * b1.w + vr.y * d1.w;
                float y0 = S[0] * r0.x + S[1] * r0.y + S[2] * r0.z + S[3] * r0.w + S[4] * r1.x + S[5] * r1.y + S[6] * r1.z + S[7] * r1.w;
                float y1 = T[0] * r0.x + T[1] * r0.y + T[2] * r0.z + T[3] * r0.w + T[4] * r1.x + T[5] * r1.y + T[6] * r1.z + T[7] * r1.w;
                y0 = sum8(y0); y1 = sum8(y1);
                if (kl == 0) *(float2*)(yb + j * 64 + row2) = make_float2(y0, y1);
            }
        } else {
            if (c > 0) RW_YOUT((c - 1) * 32, (c - 1) & 1);
            if (c + 1 < nchunk) RW_PREP((c + 1) * 32, (c + 1) & 1);
        }
        __syncthreads();
    }
    if (wid >= 4) RW_YOUT((nchunk - 1) * 32, (nchunk - 1) & 1);
#undef RW_PREP
#undef RW_YOUT
    if (!sample && wid < 4) { float* so = p.out + OUT_RWST + so2;
        *(float4*)(so) = make_float4(S[0], S[1], S[2], S[3]); *(float4*)(so + 4) = make_float4(S[4], S[5], S[6], S[7]);
        *(float4*)(so + 64) = make_float4(T[0], T[1], T[2], T[3]); *(float4*)(so + 68) = make_float4(T[4], T[5], T[6], T[7]); }
    __syncthreads();
}
DEV void rwkv_post_tile(const Params& p, int tile, float* sm) {
    const int tid = tidx(); const int tok0 = tile * 16;
    const u16* P = (const u16*)(p.ws + OFF_P); const u16* RW = (const u16*)(p.ws + OFF_RW); u16* ycat = (u16*)(p.ws + OFF_A);
    const u16* YF = (const u16*)(p.out + OUT_GLAST); const u16* YB = YF + (size_t)NTOK * 1024;
    float* Gf = sm + 2048;
    for (int i = tid; i < 16 * 128; i += 512) { const int tk = i >> 7, r = i & 127; const int tok = tok0 + tk; int t, L; tok_tl(tok, t, L);
        const u16* pp = P + (size_t)tok * LDP0 + 6400 + r; const float x = bf2f(*pp); const float xm = t > 0 ? bf2f(pp[-LDP0]) : 0.f; const float xp = t < L - 1 ? bf2f(pp[LDP0]) : 0.f;
        sm[i] = sigm(mixf(x, xm, xp, p.in[25][3328 + r])); }
    __syncthreads();
    { float g0[16], g1[16];
#pragma unroll
        for (int k = 0; k < 16; ++k) { g0[k] = 0.f; g1[k] = 0.f; }
        const float* g2 = p.in[30];
        for (int r = 0; r < 128; r += 4) {
            float wa[4], wb[4];
#pragma unroll
            for (int q = 0; q < 4; ++q) { wa[q] = g2[(r + q) * 1024 + tid]; wb[q] = g2[(r + q) * 1024 + 512 + tid]; }
#pragma unroll
            for (int k = 0; k < 16; ++k) { const float4 s4 = *(const float4*)(sm + k * 128 + r);
                g0[k] += s4.x * wa[0] + s4.y * wa[1] + s4.z * wa[2] + s4.w * wa[3]; g1[k] += s4.x * wb[0] + s4.y * wb[1] + s4.z * wb[2] + s4.w * wb[3]; } }
#pragma unroll
        for (int k = 0; k < 16; ++k) { Gf[k * 1024 + tid] = g0[k]; Gf[k * 1024 + 512 + tid] = g1[k]; } }
    __syncthreads();
    const int c8 = (tid & 127) * 8;
    float mur[8], muk[8], muv[8], ka[8], rk[8], lw[8], lb[8];
#pragma unroll
    for (int i = 0; i < 8; ++i) { mur[i] = p.in[25][c8 + i]; muk[i] = p.in[25][1024 + c8 + i]; muv[i] = p.in[25][2048 + c8 + i]; ka[i] = p.in[32][c8 + i]; rk[i] = p.in[33][c8 + i]; lw[i] = p.in[34][c8 + i]; lb[i] = p.in[35][c8 + i]; }
#pragma unroll 1
    for (int it = 0; it < 4; ++it) { const int tk = (tid >> 7) + 4 * it; const int tok = tok0 + tk; int t, L; tok_tl(tok, t, L);
        const u16* pr = P + (size_t)tok * LDP0 + 3072 + c8; const bool hm = t > 0, hp = t < L - 1;
        float rc[8], rm[8], rp[8], kc[8], km[8], kp[8], vc[8], vm[8], vp[8], a0[8], a1[8], yf[8], yb[8], gg[8];
        unpack8(*(const u32x4*)pr, rc); unpack8(*(const u32x4*)(pr + 1024), kc); unpack8(*(const u32x4*)(pr + 2048), vc);
        if (hm) { const u16* pm = P + (size_t)(tok - 1) * LDP0 + 3072 + c8; unpack8(*(const u32x4*)(pm), rm); unpack8(*(const u32x4*)(pm + 1024), km); unpack8(*(const u32x4*)(pm + 2048), vm); }
        else { for (int i = 0; i < 8; ++i) { rm[i] = 0.f; km[i] = 0.f; vm[i] = 0.f; } }
        if (hp) { unpack8(*(const u32x4*)(pr + LDP0), rp); unpack8(*(const u32x4*)(pr + LDP0 + 1024), kp); unpack8(*(const u32x4*)(pr + LDP0 + 2048), vp); }
        else { for (int i = 0; i < 8; ++i) { rp[i] = 0.f; kp[i] = 0.f; vp[i] = 0.f; } }
        unpack8(*(const u32x4*)(RW + (size_t)tok * 4096 + 2048 + c8), a0); unpack8(*(const u32x4*)(RW + (size_t)tok * 4096 + 3072 + c8), a1);
        unpack8(*(const u32x4*)(YF + (size_t)tok * 1024 + c8), yf); unpack8(*(const u32x4*)(YB + (size_t)tok * 1024 + c8), yb);
        { const float4 ga = *(const float4*)(Gf + tk * 1024 + c8), gb = *(const float4*)(Gf + tk * 1024 + c8 + 4); gg[0] = ga.x; gg[1] = ga.y; gg[2] = ga.z; gg[3] = ga.w; gg[4] = gb.x; gg[5] = gb.y; gg[6] = gb.z; gg[7] = gb.w; }
        float y[8], v_[8]; float bon = 0.f, sy = 0.f;
#pragma unroll
        for (int i = 0; i < 8; ++i) { const float r_ = mixf(rc[i], rm[i], rp[i], mur[i]), k_ = mixf(kc[i], km[i], kp[i], muk[i]); v_[i] = mixf(vc[i], vm[i], vp[i], muv[i]);
            bon += r_ * k_ * (2.f + (a0[i] + a1[i] - 2.f) * ka[i]) * rk[i]; y[i] = yf[i] + yb[i]; sy += y[i]; }
        bon = sum8(bon); const float mean = sum8(sy) * (1.f / 64.f);
        float sv = 0.f;
#pragma unroll
        for (int i = 0; i < 8; ++i) { y[i] -= mean; sv += y[i] * y[i]; }
        const float rstd = rsqrtf(sum8(sv) * (1.f / 64.f) + 64e-5f);
        float o[8];
#pragma unroll
        for (int i = 0; i < 8; ++i) o[i] = (y[i] * rstd * lw[i] + lb[i] + bon * v_[i]) * gg[i];
        u32x4 w; w.x = pk(o[0], o[1]); w.y = pk(o[2], o[3]); w.z = pk(o[4], o[5]); w.w = pk(o[6], o[7]);
        *(u32x4*)(ycat + (size_t)tok * DM + 1024 + c8) = w; }
    __syncthreads();
}

DEV float logsig(float x) { return fminf(x, 0.f) - __logf(1.f + __expf(-fabsf(x))); }
DEV void gla_intra_task(const Params& p, int task, unsigned char* shm) {
    const int tid = tidx(), wid = tid >> 6, lane = tid & 63, l15 = lane & 15, quad = lane >> 4;
    const int cidx = task >> 2, h = task & 3; const int tok0 = cidx * 64;
    u16* P = (u16*)(p.ws + OFF_P); u16* QB = (u16*)(p.ws + OFF_A); float* Dbuf = (float*)(p.ws + OFF_DB);
    u16* qi = (u16*)shm; u16* ki = qi + 64 * 264; u16* vl = (u16*)shm; u16* Pl = (u16*)(shm + 67584); float* gl = (float*)(shm + 76800); float* tot = (float*)(shm + 84992);
    for (int i = tid; i < 2048; i += 512) { const int tl = i >> 5, c = i & 31; gl[i] = bf2f(P[(size_t)(tok0 + tl) * LDP1 + 6144 + c]); }
    __syncthreads();
    const int k = tid & 255, jh = tid >> 8;
#pragma unroll 1
    for (int dd = 0; dd < 2; ++dd) { const int dir = 1 - dd;
        float g2r[16];
#pragma unroll
        for (int r = 0; r < 16; ++r) g2r[r] = p.in[38][(size_t)(dir * 16 + r) * 1024 + h * 256 + k];
        const float gb = p.in[39][dir * 1024 + h * 256 + k];
        float bl[32]; float run = 0.f;
#pragma unroll
        for (int jj = 0; jj < 32; ++jj) { const int j = jh * 32 + jj; const int tl = dir ? 63 - j : j; const float* gr = gl + tl * 32 + dir * 16;
            float x = gb;
#pragma unroll
            for (int r = 0; r < 16; r += 4) { const float4 g4 = *(const float4*)(gr + r); x += g4.x * g2r[r] + g4.y * g2r[r + 1] + g4.z * g2r[r + 2] + g4.w * g2r[r + 3]; }
            run += logsig(x) * 0.0625f; bl[jj] = run; }
        tot[jh * 256 + k] = run;
        __syncthreads();
        const float t0v = tot[k], t1v = tot[256 + k]; const float off = jh ? t0v : 0.f; const float bref = t0v, blast = t0v + t1v;
        if (jh == 0) Dbuf[((size_t)cidx * 2 + dir) * 1024 + h * 256 + k] = __expf(blast);
        u16* qdst; u16* kdst; size_t ldd;
        if (dir == 0) { qdst = P + h * 256 + k; kdst = P + 1024 + h * 256 + k; ldd = LDP1; } else { qdst = QB + h * 256 + k; kdst = QB + 1024 + h * 256 + k; ldd = 2048; }
#pragma unroll
        for (int jj = 0; jj < 32; ++jj) { const int j = jh * 32 + jj; const int tl = dir ? 63 - j : j; const size_t tok = (size_t)tok0 + tl;
            const float qv = bf2f(P[tok * LDP1 + h * 256 + k]) * 0.0625f, kv = bf2f(P[tok * LDP1 + 1024 + h * 256 + k]);
            const float b = bl[jj] + off;
            qi[j * 264 + k] = f2bf(qv * __expf(b - bref)); ki[j * 264 + k] = f2bf(kv * __expf(bref - b));
            qdst[tok * ldd] = f2bf(qv * __expf(b)); kdst[tok * ldd] = f2bf(kv * __expf(blast - b)); }
        __syncthreads();
        { const int tt = wid >> 1;
#pragma unroll
            for (int q2 = 0; q2 < 2; ++q2) { const int st = (wid & 1) * 2 + q2; f32x4 acc = (f32x4){0.f, 0.f, 0.f, 0.f};
                if (st <= tt) {
#pragma unroll
                    for (int ks = 0; ks < 8; ++ks) { const bf16x8 a = *(const bf16x8*)(qi + (tt * 16 + l15) * 264 + ks * 32 + quad * 8); const bf16x8 b = *(const bf16x8*)(ki + (st * 16 + l15) * 264 + ks * 32 + quad * 8);
                        acc = mfma16(a, b, acc); } }
#pragma unroll
                for (int r = 0; r < 4; ++r) { const int t = tt * 16 + quad * 4 + r, s_ = st * 16 + l15; Pl[t * 72 + s_] = f2bf(s_ <= t ? acc[r] : 0.f); } } }
        __syncthreads();
#pragma unroll
        for (int i = 0; i < 8; ++i) { const int piece = tid + 512 * i; const int j = piece >> 6, c8 = (piece & 63) * 8; const int tl = dir ? 63 - j : j;
            *(u32x4*)(vl + j * 520 + c8) = *(const u32x4*)(P + (size_t)(tok0 + tl) * LDP1 + 2048 + h * 512 + c8); }
        __syncthreads();
        u16* O = (u16*)(p.ws + (dir ? OFF_OB : OFF_OF)) + h * 512;
#pragma unroll 1
        for (int q4 = 0; q4 < 4; ++q4) { const int vt = wid * 4 + q4; f32x4 acc[4];
#pragma unroll
            for (int tt = 0; tt < 4; ++tt) acc[tt] = (f32x4){0.f, 0.f, 0.f, 0.f};
#pragma unroll
            for (int ss = 0; ss < 2; ++ss) { bf16x8 bfr;
#pragma unroll
                for (int jj = 0; jj < 8; ++jj) bfr[jj] = (short)vl[(ss * 32 + quad * 8 + jj) * 520 + vt * 16 + l15];
#pragma unroll
                for (int tt = 0; tt < 4; ++tt) { if (ss * 32 <= tt * 16 + 15) { const bf16x8 a = *(const bf16x8*)(Pl + (tt * 16 + l15) * 72 + ss * 32 + quad * 8); acc[tt] = mfma16(a, bfr, acc[tt]); } } }
#pragma unroll
            for (int tt = 0; tt < 4; ++tt)
#pragma unroll
                for (int r = 0; r < 4; ++r) { const int t = tt * 16 + quad * 4 + r; const int tl = dir ? 63 - t : t; O[(size_t)(tok0 + tl) * DM + vt * 16 + l15] = f2bf(acc[tt][r]); } }
        __syncthreads();
    }
}
DEV void gla_inter_task(const Params& p, int task, unsigned char* shm) {
    const bool sample = task < 256; const int tt_ = sample ? task : task - 256;
    const int seq = tt_ >> 3, vs = tt_ & 7; const int b = seq >> 3, h = (seq >> 1) & 3, dir = seq & 1;
    const int L = sample ? 4096 : 256; const int tok0 = sample ? NTP + b * 4096 : b * 256;
    const int nch = L >> 6, cbase = tok0 >> 6;
    const int tid = tidx(), wid = tid >> 6, lane = tid & 63, l15 = lane & 15, quad = lane >> 4;
    const u16* P = (const u16*)(p.ws + OFF_P); const u16* QB = (const u16*)(p.ws + OFF_A); const float* Dbuf = (const float*)(p.ws + OFF_DB);
    u16* ST = (u16*)shm; u16* qdl = (u16*)(shm + 33792); u16* kdl = (u16*)(shm + 67584); u16* vl = (u16*)(shm + 101376); float* dl = (float*)(shm + 110592);
    f32x4 S[2][4];
    const size_t sbase = (((size_t)b * 2 + dir) * 4 + h) * 256 * 512 + vs * 64;
#pragma unroll
    for (int kt = 0; kt < 2; ++kt)
#pragma unroll
        for (int vt = 0; vt < 4; ++vt)
#pragma unroll
            for (int r = 0; r < 4; ++r) { const int kk = wid * 32 + kt * 16 + quad * 4 + r; S[kt][vt][r] = sample ? p.in[3][sbase + (size_t)kk * 512 + vt * 16 + l15] : 0.f; }
    const u16* qsrc; const u16* ksrc; size_t lds_;
    if (dir == 0) { qsrc = P + h * 256; ksrc = P + 1024 + h * 256; lds_ = LDP1; } else { qsrc = QB + h * 256; ksrc = QB + 1024 + h * 256; lds_ = 2048; }
    const u16* vsrc = P + 2048 + h * 512 + vs * 64;
    u16* O = (u16*)(p.ws + (dir ? OFF_OB : OFF_OF)) + h * 512 + vs * 64;
    u32x4 rq[4], rk[4], rv; float rd = 0.f;
    const int vrow = tid >> 3, vc8 = (tid & 7) * 8;
#define GLA_ISSUE(n_) do { const int cidx_ = cbase + (dir ? nch - 1 - (n_) : (n_)); \
        _Pragma("unroll") for (int i = 0; i < 4; ++i) { const int piece = tid + 512 * i; const int j = piece >> 5, c8 = (piece & 31) * 8; const size_t tok = (size_t)cidx_ * 64 + (dir ? 63 - j : j); \
            rq[i] = *(const u32x4*)(qsrc + tok * lds_ + c8); rk[i] = *(const u32x4*)(ksrc + tok * lds_ + c8); } \
        { const size_t tok = (size_t)cidx_ * 64 + (dir ? 63 - vrow : vrow); rv = *(const u32x4*)(vsrc + tok * LDP1 + vc8); } \
        if (tid < 256) rd = Dbuf[((size_t)cidx_ * 2 + dir) * 1024 + h * 256 + tid]; } while (0)
#define GLA_WRITE_ST() do { _Pragma("unroll") for (int kt = 0; kt < 2; ++kt) _Pragma("unroll") for (int vt = 0; vt < 4; ++vt) { u32x2 w; w.x = pk(S[kt][vt][0], S[kt][vt][1]); w.y = pk(S[kt][vt][2], S[kt][vt][3]); \
            *(u32x2*)(ST + (vt * 16 + l15) * 264 + wid * 32 + kt * 16 + quad * 4) = w; } } while (0)
    GLA_WRITE_ST();
    GLA_ISSUE(0);
    const int tt = wid >> 1, vb = (wid & 1) * 2;
#pragma unroll 1
    for (int n = 0; n < nch; ++n) {
        const int cidx = cbase + (dir ? nch - 1 - n : n);
#pragma unroll
        for (int i = 0; i < 4; ++i) { const int piece = tid + 512 * i; const int j = piece >> 5, c8 = (piece & 31) * 8; *(u32x4*)(qdl + j * 264 + c8) = rq[i]; *(u32x4*)(kdl + j * 264 + c8) = rk[i]; }
        *(u32x4*)(vl + vrow * 72 + vc8) = rv; if (tid < 256) dl[tid] = rd;
        __syncthreads();
        if (n + 1 < nch) GLA_ISSUE(n + 1);
        float oi[2][4];
#pragma unroll
        for (int q2 = 0; q2 < 2; ++q2)
#pragma unroll
            for (int r = 0; r < 4; ++r) { const int j = tt * 16 + quad * 4 + r; const size_t tok = (size_t)cidx * 64 + (dir ? 63 - j : j); oi[q2][r] = bf2f(O[tok * DM + (vb + q2) * 16 + l15]); }
        f32x4 oacc[2]; oacc[0] = (f32x4){0.f, 0.f, 0.f, 0.f}; oacc[1] = oacc[0];
#pragma unroll
        for (int ks = 0; ks < 8; ++ks) { const bf16x8 a = *(const bf16x8*)(qdl + (tt * 16 + l15) * 264 + ks * 32 + quad * 8);
#pragma unroll
            for (int q2 = 0; q2 < 2; ++q2) { const bf16x8 bfr = *(const bf16x8*)(ST + ((vb + q2) * 16 + l15) * 264 + ks * 32 + quad * 8); oacc[q2] = mfma16(a, bfr, oacc[q2]); } }
#pragma unroll
        for (int kt = 0; kt < 2; ++kt) { const f32x4 dv = *(const f32x4*)(dl + wid * 32 + kt * 16 + quad * 4);
#pragma unroll
            for (int vt = 0; vt < 4; ++vt) S[kt][vt] = S[kt][vt] * dv; }
#pragma unroll
        for (int ts = 0; ts < 2; ++ts) { bf16x8 af[2];
#pragma unroll
            for (int kt = 0; kt < 2; ++kt)
#pragma unroll
                for (int jj = 0; jj < 8; ++jj) af[kt][jj] = (short)kdl[(ts * 32 + quad * 8 + jj) * 264 + wid * 32 + kt * 16 + l15];
#pragma unroll
            for (int vt = 0; vt < 4; ++vt) { bf16x8 bfr;
#pragma unroll
                for (int jj = 0; jj < 8; ++jj) bfr[jj] = (short)vl[(ts * 32 + quad * 8 + jj) * 72 + vt * 16 + l15];
#pragma unroll
                for (int kt = 0; kt < 2; ++kt) S[kt][vt] = mfma16(af[kt], bfr, S[kt][vt]); } }
#pragma unroll
        for (int q2 = 0; q2 < 2; ++q2)
#pragma unroll
            for (int r = 0; r < 4; ++r) { const int j = tt * 16 + quad * 4 + r; const size_t tok = (size_t)cidx * 64 + (dir ? 63 - j : j); O[tok * DM + (vb + q2) * 16 + l15] = f2bf(oi[q2][r] + oacc[q2][r]); }
        __syncthreads();
        GLA_WRITE_ST();
        __syncthreads();
    }
#undef GLA_ISSUE
#undef GLA_WRITE_ST
    if (!sample) { float* so = p.out + OUT_GLAST + sbase;
#pragma unroll
        for (int kt = 0; kt < 2; ++kt)
#pragma unroll
            for (int vt = 0; vt < 4; ++vt)
#pragma unroll
                for (int r = 0; r < 4; ++r) { const int kk = wid * 32 + kt * 16 + quad * 4 + r; so[(size_t)kk * 512 + vt * 16 + l15] = S[kt][vt][r]; } }
    __syncthreads();
}
DEV void phase_gla_post(const Params& p) {
    const int tid = tidx(), wid = tid >> 6, lane = tid & 63;
    const u16* P = (const u16*)(p.ws + OFF_P); const u16* OF = (const u16*)(p.ws + OFF_OF); const u16* OB = (const u16*)(p.ws + OFF_OB); u16* ycat = (u16*)(p.ws + OFF_A);
    for (int it = blockIdx.x * 8 + wid; it < NTOK * 4; it += gridDim.x * 8) { const int tok = it >> 2, h = it & 3; const int v8 = lane * 8;
        float a[8], b[8], g[8]; unpack8(*(const u32x4*)(OF + (size_t)tok * DM + h * 512 + v8), a); unpack8(*(const u32x4*)(OB + (size_t)tok * DM + h * 512 + v8), b);
        unpack8(*(const u32x4*)(P + (size_t)tok * LDP1 + 4096 + h * 512 + v8), g);
        float ss = 0.f;
#pragma unroll
        for (int i = 0; i < 8; ++i) { a[i] += b[i]; ss += a[i] * a[i]; }
        ss = wave_sum(ss); const float sc = rsqrtf(ss * (1.f / 512.f) + 1e-6f);
        float o[8];
#pragma unroll
        for (int i = 0; i < 8; ++i) o[i] = a[i] * sc * p.in[40][v8 + i] * (g[i] * sigm(g[i]));
        u32x4 w; w.x = pk(o[0], o[1]); w.y = pk(o[2], o[3]); w.z = pk(o[4], o[5]); w.w = pk(o[6], o[7]);
        *(u32x4*)(ycat + (size_t)tok * DM + h * 512 + v8) = w; }
}

DEV void gate_loadcol(const u16* U, long tokc, int c8, bool colok, bool up, bool dn, int W, float (*dst)[8]) {
    if (colok && up) unpack8(*(const u32x4*)(U + (size_t)(tokc - W) * LDU + c8), dst[0]); else { for (int i = 0; i < 8; ++i) dst[0][i] = 0.f; }
    if (colok) unpack8(*(const u32x4*)(U + (size_t)tokc * LDU + c8), dst[1]); else { for (int i = 0; i < 8; ++i) dst[1][i] = 0.f; }
    if (colok && dn) unpack8(*(const u32x4*)(U + (size_t)(tokc + W) * LDU + c8), dst[2]); else { for (int i = 0; i < 8; ++i) dst[2][i] = 0.f; }
}
DEV void phase_ffn_gate(const Params& p, int layer) {
    u16* U = (u16*)(p.ws + OFF_U); const float* cw = p.in[11] + (size_t)layer * 9 * DFF;
    const int nunit = 768 * 704;
    for (int u = blockIdx.x * 512 + tidx(); u < nunit; u += gridDim.x * 512) {
        const int seg = u / 704, c8 = (u % 704) * 8; const int tokS = seg * 32;
        int W, colS; bool up, dn;
        if (tokS < NTP) { W = 256; colS = tokS & 255; up = false; dn = false; }
        else { W = 64; colS = tokS & 63; const int rr = ((tokS - NTP) >> 6) & 63; up = rr > 0; dn = rr < 63; }
        float wt[9][8];
#pragma unroll
        for (int q = 0; q < 9; ++q) { const float4 a = *(const float4*)(cw + q * DFF + c8), b = *(const float4*)(cw + q * DFF + c8 + 4);
            wt[q][0] = a.x; wt[q][1] = a.y; wt[q][2] = a.z; wt[q][3] = a.w; wt[q][4] = b.x; wt[q][5] = b.y; wt[q][6] = b.z; wt[q][7] = b.w; }
        float w0[3][8], w1[3][8], w2[3][8];
        gate_loadcol(U, (long)tokS - 1, c8, colS > 0, up, dn, W, w0);
        gate_loadcol(U, (long)tokS, c8, true, up, dn, W, w1);
#pragma unroll 4
        for (int s_ = 0; s_ < 32; ++s_) {
            const long tok = (long)tokS + s_;
            gate_loadcol(U, tok + 1, c8, colS + s_ + 1 < W, up, dn, W, w2);
            u16* vp = U + (size_t)tok * LDU + DFF + c8; float v[8]; unpack8(*(const u32x4*)vp, v);
#pragma unroll
            for (int i = 0; i < 8; ++i) { float a = 0.f;
#pragma unroll
                for (int di = 0; di < 3; ++di) a += w0[di][i] * wt[di * 3][i] + w1[di][i] * wt[di * 3 + 1][i] + w2[di][i] * wt[di * 3 + 2][i];
                v[i] *= a * sigm(a); }
            u32x4 w; w.x = pk(v[0], v[1]); w.y = pk(v[2], v[3]); w.z = pk(v[4], v[5]); w.w = pk(v[6], v[7]);
            *(u32x4*)vp = w;
#pragma unroll
            for (int di = 0; di < 3; ++di)
#pragma unroll
                for (int i = 0; i < 8; ++i) { w0[di][i] = w1[di][i]; w1[di][i] = w2[di][i]; }
        }
    }
}

DEV void phase_final_norm(const Params& p) {
    const int tid = tidx(), wid = tid >> 6, lane = tid & 63; const float* g = p.in[13];
    for (int row = blockIdx.x * 8 + wid; row < NTOK; row += gridDim.x * 8) {
        float4* xr = (float4*)(p.out + (size_t)row * DM);
        float4 v[8]; float ss = 0.f;
#pragma unroll
        for (int j = 0; j < 8; ++j) { v[j] = xr[lane + 64 * j]; ss += v[j].x * v[j].x + v[j].y * v[j].y + v[j].z * v[j].z + v[j].w * v[j].w; }
        ss = wave_sum(ss); const float rstd = rsqrtf(ss * (1.f / 2048.f) + 1e-6f);
#pragma unroll
        for (int j = 0; j < 8; ++j) { const float4 gg = *(const float4*)(g + (lane + 64 * j) * 4);
            xr[lane + 64 * j] = make_float4(v[j].x * rstd * gg.x, v[j].y * rstd * gg.y, v[j].z * rstd * gg.z, v[j].w * rstd * gg.w); }
    }
}


#define XB_TMO      128
#define XB_XCNT(j)  (256  + 64 * (j))
#define XB_XSUB(j)  (1280 + 64 * (j))
#define XB_XGEN(j)  (2304 + 64 * (j))
#define XB_TOP      3328
#define XB_TOPGEN   3392
#define XCD_BAR_WORDS 3456
#define XB_SPIN_CAP (1u << 18)
DEV unsigned xb_ld(unsigned* p)              { return __hip_atomic_load(p, __ATOMIC_RELAXED, __HIP_MEMORY_SCOPE_AGENT); }
DEV unsigned xb_add(unsigned* p, unsigned v) { return __hip_atomic_fetch_add(p, v, __ATOMIC_RELAXED, __HIP_MEMORY_SCOPE_AGENT); }
DEV unsigned xb_xcc_id() { return (unsigned)__builtin_amdgcn_s_getreg((3 << 11) | 20) & 0xFu; }
#define XB_SPIN(cond, bar) do { unsigned _sp = 0; while (cond) { __builtin_amdgcn_s_sleep(1); \
    if ((++_sp & 255u) == 0u) { if (xb_ld(&(bar)[XB_TMO])) break; if (_sp > XB_SPIN_CAP) { atomicAdd(&(bar)[XB_TMO], 1u); break; } } } } while (0)
struct XcdBarrier { unsigned* bar; unsigned x; volatile LAS unsigned* st; };
DEV XcdBarrier xcd_barrier_post(unsigned* bar, volatile LAS unsigned* st) {
    XcdBarrier b; b.bar = bar; b.x = xb_xcc_id(); b.st = st;
    if (threadIdx.x == 0) (void)xb_add(&bar[XB_XCNT(b.x)], 1u);
    return b;
}
DEV void xcd_barrier_complete(unsigned* bar, unsigned x, unsigned& nloc, unsigned& nx) {
    const unsigned G = gridDim.x * gridDim.y * gridDim.z;
    unsigned sum, cnt, mine, sp = 0u;
    for (;;) {
        sum = 0u; cnt = 0u; mine = 0u;
#pragma unroll
        for (unsigned j = 0; j < 16; ++j) { const unsigned c = xb_ld(&bar[XB_XCNT(j)]); sum += c; cnt += (c > 0u) ? 1u : 0u; mine = (j == x) ? c : mine; }
        if (sum == G) break;
        __builtin_amdgcn_s_sleep(1);
        if ((++sp & 255u) == 0u) { if (xb_ld(&bar[XB_TMO])) break; if (sp > XB_SPIN_CAP) { atomicAdd(&bar[XB_TMO], 1u); break; } }
    }
    nloc = mine > 0u ? mine : 1u; nx = cnt > 0u ? cnt : 1u;
}
DEV void xcd_barrier(const XcdBarrier& b) {
    asm volatile("s_waitcnt vmcnt(0)" ::: "memory");
    __syncthreads();
    if (threadIdx.x == 0) {
        unsigned* bar = b.bar;
        __builtin_amdgcn_s_waitcnt(0);
        unsigned nloc = b.st[0], nx = b.st[1];
        if (nloc == 0u) { xcd_barrier_complete(bar, b.x, nloc, nx); b.st[0] = nloc; b.st[1] = nx; }
        const unsigned old = xb_add(&bar[XB_XSUB(b.x)], 1u);
        const unsigned gen = old / nloc;
        if (old + 1u == (gen + 1u) * nloc) {
            __builtin_amdgcn_fence(__ATOMIC_RELEASE, "agent");
            asm volatile("s_waitcnt vmcnt(0)" ::: "memory");
            const unsigned og = xb_add(&bar[XB_TOP], 1u);
            const unsigned tg = og / nx;
            if (og + 1u == (tg + 1u) * nx) xb_add(&bar[XB_TOPGEN], 1u);
            else XB_SPIN(xb_ld(&bar[XB_TOPGEN]) == tg, bar);
            __builtin_amdgcn_fence(__ATOMIC_ACQUIRE, "agent");
            xb_add(&bar[XB_XGEN(b.x)], 1u);
            asm volatile("s_waitcnt vmcnt(0)" ::: "memory");
        } else {
            XB_SPIN(xb_ld(&bar[XB_XGEN(b.x)]) == gen, bar);
            __builtin_amdgcn_fence(__ATOMIC_ACQUIRE, "agent");
            asm volatile("s_waitcnt vmcnt(0)" ::: "memory");
        }
    }
    __syncthreads();
}

__global__ void __launch_bounds__(512, 2) mega(Params p0) {
    extern __shared__ __attribute__((aligned(16))) unsigned char shm[];
    cg::grid_group grid = cg::this_grid();
    __shared__ uint4 xb_words;
    if (threadIdx.x == 0) xb_words = make_uint4(0u, 0u, 0u, 0u);
    __syncthreads();
    (void)xcd_barrier_post((unsigned*)(p0.ws + OFF_SMALL + SMALL_BYTES + 256), (volatile LAS unsigned*)&xb_words);
#define XBAR() do { XcdBarrier xb_; xb_.bar = (unsigned*)(launder(p0).ws + OFF_SMALL + SMALL_BYTES + 256); xb_.x = xb_xcc_id(); xb_.st = (volatile LAS unsigned*)&xb_words; xcd_barrier(xb_); } while (0)
    float* sm = (float*)shm;
    const int G = (int)gridDim.x, B = (int)blockIdx.x;

#ifndef SK_PREP
    phase_prep(launder(p0), shm);
#ifdef PROBE_MISC
    __syncthreads(); phase_prep(launder(p0), shm);
#endif
#endif
    grid.sync();
    phase_reduce(launder(p0));
    XBAR();
#pragma unroll 1
    for (int layer = 0; layer < 2; ++layer) {
#ifndef SK_NORM
        phase_norm(launder(p0), layer, 0, shm);
#ifdef PROBE_MISC
        __syncthreads(); phase_norm(launder(p0), layer, 0, shm);
#endif
#endif
        XBAR();
        { const Params p = launder(p0); const u16* A = (const u16*)(p.ws + OFF_A); pg8::EpiBf16 E; E.O = (u16*)(p.ws + OFF_P); E.ldc = layer ? LDP1 : LDP0;
#if !defined(SK_GEMM) && !defined(SK_GBF)
            run_gemm(shm, A, DM, (const u16*)(p.ws + OFF_WIN), DM, layer ? LDP1 : LDP0, DM, E);
#ifdef PROBE_GEMM
            __syncthreads(); run_gemm(shm, A, DM, (const u16*)(p.ws + OFF_WIN), DM, layer ? LDP1 : LDP0, DM, E);
#endif
#endif
        }
        XBAR();
        if (layer == 0) {
#ifndef SK_PRE
            { const Params p = launder(p0); for (int t = B; t < 6144 + 768; t += G) { if (t < 6144) hy_pre_tile(p, t, sm); else rwkv_lora_tile(p, t - 6144, shm); } }
#ifdef PROBE_MISC
            { const Params p = launder(p0); for (int t = B; t < 6144 + 768; t += G) { if (t < 6144) hy_pre_tile(p, t, sm); else rwkv_lora_tile(p, t - 6144, shm); } }
#endif
#endif
            XBAR();
            { const Params p = launder(p0); unsigned* ctr = (unsigned*)(p.ws + OFF_SMALL + SMALL_BYTES);
                if (B < 128) rwkv_scan_task(p, B, sm);
                for (;;) { if (tidx() == 0) *(volatile unsigned*)shm = atomicAdd(ctr, 1u); __syncthreads(); const unsigned t = *(volatile unsigned*)shm; __syncthreads();
                    if (t >= 1024u + 2048u) break;
                    if (t < 1024u) rwkv_scan_task(p, 128 + (int)t, sm); else hyconv_task(p, (int)t - 1024, shm); } }
            XBAR();
#ifndef SK_POST
            { const Params p = launder(p0); for (int t = B; t < 6144 + 1536; t += G) { if (t < 6144) hy_post_tile(p, t, sm); else rwkv_post_tile(p, t - 6144, sm); } }
#ifdef PROBE_MISC
            { const Params p = launder(p0); for (int t = B; t < 6144 + 1536; t += G) { if (t < 6144) hy_post_tile(p, t, sm); else rwkv_post_tile(p, t - 6144, sm); } }
#endif
#endif
            XBAR();
        } else {
#ifndef SK_GLA
            { const Params p = launder(p0); for (int t = B; t < 1536; t += G) gla_intra_task(p, t, shm); }
            XBAR();
            { const Params p = launder(p0); for (int t = B; t < 256 + 2048; t += G) gla_inter_task(p, t, shm); }
#endif
            XBAR();
#ifndef SK_GLAP
            phase_gla_post(launder(p0));
#ifdef PROBE_MISC
            phase_gla_post(launder(p0));
#endif
#endif
            XBAR();
        }
        { const Params p = launder(p0); const u16* A = (const u16*)(p.ws + OFF_A); const float* mods = (const float*)(p.ws + OFF_SMALL); pg8::EpiRes E; E.X = p.out; E.gm = mods + (size_t)layer * 5 * 12288 + 2 * 2048; E.gb = p.in[7] + layer * 12288 + 2 * 2048;
#if !defined(SK_GEMM) && !defined(SK_GRES)
            run_gemm(shm, A, DM, (const u16*)(p.ws + OFF_WOUT), DM, DM, DM, E);
#endif
        }
        XBAR();
#ifndef SK_NORM
        phase_norm(launder(p0), layer, 1, shm);
#ifdef PROBE_MISC
        __syncthreads(); phase_norm(launder(p0), layer, 1, shm);
#endif
#endif
        XBAR();
        { const Params p = launder(p0); const u16* A = (const u16*)(p.ws + OFF_A); pg8::EpiBf16 E; E.O = (u16*)(p.ws + OFF_U); E.ldc = LDU;
#if !defined(SK_GEMM) && !defined(SK_GBF)
            run_gemm(shm, A, DM, (const u16*)(p.ws + OFF_WUP), DM, LDU, DM, E);
#ifdef PROBE_GEMM
            __syncthreads(); run_gemm(shm, A, DM, (const u16*)(p.ws + OFF_WUP), DM, LDU, DM, E);
#endif
#endif
        }
        XBAR();
#ifndef SK_GATE
        phase_ffn_gate(launder(p0), layer);
#endif
        XBAR();
        { const Params p = launder(p0); const float* mods = (const float*)(p.ws + OFF_SMALL); pg8::EpiRes E; E.X = p.out; E.gm = mods + (size_t)layer * 5 * 12288 + 5 * 2048; E.gb = p.in[7] + layer * 12288 + 5 * 2048;
#if !defined(SK_GEMM) && !defined(SK_GRES)
            run_gemm(shm, (const u16*)(p.ws + OFF_U) + DFF, LDU, (const u16*)(p.ws + OFF_WDN), DFF, DM, DFF, E);
#endif
        }
        XBAR();
    }
    phase_final_norm(launder(p0));
}

extern "C" void kernel_launch(void* const* d_in, const int* in_sizes, int n_in, void* d_out, int out_size, void* d_ws, size_t ws_size, hipStream_t stream) {
    constexpr size_t kDynLds = 131072;
    static int grid_blocks = 0;
    if (!grid_blocks) {
        int dev = 0, cus = 0, per_cu = 0;
        hipGetDevice(&dev);
        hipDeviceGetAttribute(&cus, hipDeviceAttributeMultiprocessorCount, dev);
        hipFuncSetAttribute((const void*)mega, hipFuncAttributeMaxDynamicSharedMemorySize, (int)kDynLds);
        hipOccupancyMaxActiveBlocksPerMultiprocessor(&per_cu, mega, 512, kDynLds);
        if (per_cu < 1) per_cu = 1;
        grid_blocks = cus * per_cu;
        if (grid_blocks > 256) grid_blocks = 256;
    }
    if (ws_size < WS_NEED || n_in < 41) { fprintf(stderr, "workspace too small: %zu < %zu\n", ws_size, WS_NEED); return; }
    Params p{};
    for (int i = 0; i < 41; ++i) p.in[i] = (const float*)d_in[i];
    p.out = (float*)d_out; p.ws = (unsigned char*)d_ws;
    hipMemsetAsync((unsigned char*)d_ws + OFF_SMALL + SMALL_BYTES, 0, 256 + XCD_BAR_BYTES, stream);
    void* args[] = {&p};
    hipError_t e = hipLaunchCooperativeKernel((const void*)mega, dim3(grid_blocks), dim3(512), args, kDynLds, stream);
    if (e != hipSuccess) fprintf(stderr, "cooperative launch failed: %s (grid %d)\n", hipGetErrorString(e), grid_blocks);
}
```

```cpp
#include <hip/hip_runtime.h>
#include <hip/hip_cooperative_groups.h>
#include <cstdio>
namespace cg = cooperative_groups;

#define DEV __device__ __forceinline__
#define LAS __attribute__((address_space(3)))
typedef unsigned short u16;
typedef short bf16x8 __attribute__((ext_vector_type(8)));
typedef float f32x4 __attribute__((ext_vector_type(4)));
typedef float f32x2 __attribute__((ext_vector_type(2)));
typedef float f32x16 __attribute__((ext_vector_type(16)));
typedef unsigned u32x2 __attribute__((ext_vector_type(2)));
typedef unsigned u32x4 __attribute__((ext_vector_type(4)));

constexpr int NTOK = 24576, NTP = 8192, DM = 2048;
constexpr int LDP0 = 6656, LDP1 = 6400, LDU = 11264, DFF = 5632;
constexpr size_t OFF_WIN = 0, OFF_WOUT = 27262976, OFF_WUP = 35651584, OFF_WDN = OFF_WUP + 46137344;
constexpr size_t OFF_A = 104857600, OFF_BIG = 205520896;
constexpr size_t OFF_P = OFF_BIG, OFF_RW = OFF_BIG + 327155712, OFF_UT = OFF_RW + 201326592, OFF_GS = OFF_UT + 50331648, OFF_GP = OFF_GS + 16777216;
constexpr size_t OFF_U = OFF_BIG, OFF_OF = OFF_BIG + 314572800, OFF_OB = OFF_OF + 100663296, OFF_DB = OFF_OB + 100663296;
constexpr size_t OFF_SMALL = OFF_BIG + 600000000, SMALL_BYTES = 491520 + 8192;
constexpr size_t XCD_BAR_BYTES = 3456 * 4;
constexpr size_t OFF_LW = OFF_SMALL + SMALL_BYTES + 256 + XCD_BAR_BYTES;
constexpr size_t OFF_G2T = OFF_LW + 524288;
constexpr size_t WS_NEED = OFF_G2T + 262144;
constexpr size_t OUT_RWST = 50331648, OUT_GLAST = 54525952;

struct Params {
    const float* in[41];
    float* out;
    unsigned char* ws;
};

DEV int tidx() { int t = threadIdx.x; asm volatile("" : "+v"(t)); return t; }
DEV Params launder(const Params& p) { Params q = p; asm volatile("" : "+s"(q.ws), "+s"(q.out)); return q; }
DEV float bf2f(unsigned b) { return __uint_as_float(b << 16); }
DEV float bflo(unsigned w) { return __uint_as_float(w << 16); }
DEV float bfhi(unsigned w) { return __uint_as_float(w & 0xffff0000u); }
DEV unsigned pk(float lo, float hi) { unsigned r; asm("v_cvt_pk_bf16_f32 %0, %1, %2" : "=v"(r) : "v"(lo), "v"(hi)); return r; }
DEV u16 f2bf(float f) { return (u16)(pk(f, 0.f) & 0xffffu); }
DEV float wave_sum(float v) {
#pragma unroll
    for (int o = 32; o > 0; o >>= 1) v += __shfl_xor(v, o);
    return v;
}
template <int CTRL> DEV float dppf(float x) { return __builtin_bit_cast(float, __builtin_amdgcn_update_dpp(0, __builtin_bit_cast(int, x), CTRL, 0xf, 0xf, true)); }
DEV float sum8(float v) { v += dppf<0xB1>(v); v += dppf<0x4E>(v); v += dppf<0x141>(v); return v; }
DEV float sum16(float v) { v = sum8(v); v += dppf<0x140>(v); return v; }
DEV f32x4 mfma16(bf16x8 a, bf16x8 b, f32x4 c) { return __builtin_amdgcn_mfma_f32_16x16x32_bf16(a, b, c, 0, 0, 0); }
DEV float sigm(float x) { return 1.f / (1.f + __expf(-x)); }
DEV int tok_cond(int tok) { return tok < NTP ? 4 : ((tok - NTP) >> 12); }
DEV void tok_tl(int tok, int& t, int& L) { if (tok < NTP) { t = tok & 255; L = 256; } else { t = (tok - NTP) & 4095; L = 4096; } }
DEV void unpack8(u32x4 w, float* o) { o[0] = bflo(w.x); o[1] = bfhi(w.x); o[2] = bflo(w.y); o[3] = bfhi(w.y); o[4] = bflo(w.z); o[5] = bfhi(w.z); o[6] = bflo(w.w); o[7] = bfhi(w.w); }
DEV void unpack4(u32x2 w, float* o) { o[0] = bflo(w.x); o[1] = bfhi(w.x); o[2] = bflo(w.y); o[3] = bfhi(w.y); }

namespace pg8 {
constexpr int BM = 256, BK = 64, HALF = 128, HTB = HALF * BK * 2, NXCD = 8, WGM = 8;
DEV int lds_byte(int r, int c) { const int st = (r >> 4) * 2 + (c >> 5), rr = r & 15, cc = c & 31, ob = rr * 64 + cc * 2; return st * 1024 + (ob ^ (((ob >> 9) & 1) << 5)); }
DEV void stage_rc(int b, int& R, int& C) { const int st = b / 1024, sb = b % 1024, swz = sb ^ (((sb >> 9) & 1) << 5); R = (st >> 1) * 16 + swz / 64; C = (st & 1) * 32 + (swz % 64) / 2; }
DEV int perm32(int rho) { const int n = rho >> 4, i = rho & 15; return 8 * (i >> 2) + 4 * n + (i & 3); }
struct Unit { int pm, pn; };
struct Gemm { const u16* A; const u16* Bt; int M, N, K, lda, ldb; };
struct StaticOrder {
    int nM, nN, nwg, G, c;
    DEV void init(int M, int N, int G_, int c_) { nM = M / BM; nN = N / BM; nwg = nM * nN; G = G_; c = c_; }
    DEV bool next(int i, Unit& u) const {
        const long L = (long)i * G + c; if (L >= nwg) return false;
        int wgid = (int)L; { const int q = nwg / NXCD, r = nwg % NXCD, xcd = wgid % NXCD, off = wgid / NXCD; wgid = (xcd < r ? xcd * (q + 1) : r * (q + 1) + (xcd - r) * q) + off; }
        const int nig = WGM * nN, gid = wgid / nig, fm = gid * WGM, gsz = (nM - fm) < WGM ? (nM - fm) : WGM;
        u.pm = fm + ((wgid % nig) % gsz); u.pn = (wgid % nig) / gsz; return true;
    }
};
struct EpiBf16 {
    static constexpr bool PERM = true;
    u16* O; int ldc;
    DEV void operator()(const f32x4 (&acc)[2][2][4][2], const Unit& u, int wr, int wc, int fr, int fq) const {
        const int row0 = u.pm * BM + wr * 64 + fr; const int col0 = u.pn * BM + wc * 32 + 8 * fq;
#pragma unroll
        for (int ai = 0; ai < 2; ++ai)
#pragma unroll
            for (int m = 0; m < 4; ++m) { u16* rowp = O + (size_t)(row0 + ai * HALF + m * 16) * ldc + col0;
#pragma unroll
                for (int bj = 0; bj < 2; ++bj) { const f32x4 v0 = acc[ai][bj][m][0], v1 = acc[ai][bj][m][1];
                    u32x4 w; w.x = pk(v0[0], v0[1]); w.y = pk(v0[2], v0[3]); w.z = pk(v1[0], v1[1]); w.w = pk(v1[2], v1[3]);
                    *(u32x4*)(rowp + bj * HALF) = w; } }
    }
};
struct EpiRes {
    static constexpr bool PERM = false;
    float* X; const float* gm; const float* gb;
    DEV void operator()(const f32x4 (&acc)[2][2][4][2], const Unit& u, int wr, int wc, int fr, int fq) const {
        const int row0 = u.pm * BM + wr * 64 + fr, col0 = u.pn * BM + wc * 32 + 4 * fq;
        const int cond = u.pm < 32 ? 4 : ((u.pm - 32) >> 4);
        const float* gmc = gm + (size_t)cond * 12288 + col0; const float* gbc = gb + col0;
#pragma unroll
        for (int ai = 0; ai < 2; ++ai)
#pragma unroll
            for (int m = 0; m < 4; ++m) { float* rowp = X + (size_t)(row0 + ai * HALF + m * 16) * DM + col0;
#pragma unroll
                for (int bj = 0; bj < 2; ++bj) {
#pragma unroll
                    for (int n = 0; n < 2; ++n) { f32x4* q = (f32x4*)(rowp + bj * HALF + n * 16);
                        const f32x4 gvv = *(const f32x4*)(gmc + bj * HALF + n * 16) + *(const f32x4*)(gbc + bj * HALF + n * 16);
                        *q = *q + gvv * acc[ai][bj][m][n]; }
                    asm volatile("" ::: "memory"); } }
    }
};

template <class Epi>
DEV void gemm_phase(LAS unsigned char* lds, const Gemm g, const StaticOrder& S, const Epi& E) {
    const int tid = tidx(), wid = __builtin_amdgcn_readfirstlane(tid >> 6), lane = tid & 63, wr = wid >> 2, wc = wid & 3, fr = lane & 15, fq = lane >> 4;
    const int K = g.K, nt = K / BK;
    unsigned voffA[2], voffB[2];
#pragma unroll
    for (int i = 0; i < 2; ++i) { int R, C; stage_rc(tid * 16 + i * 8192, R, C); const int Rb = Epi::PERM ? ((R & ~31) + perm32(R & 31)) : R;
        voffA[i] = (unsigned)(R * g.lda + C) * 2u; voffB[i] = (unsigned)(Rb * g.ldb + C) * 2u; }
    const size_t kstep = (size_t)(BK * 2);
    const size_t hstepA = (size_t)HALF * g.lda * 2, hstepB = (size_t)HALF * g.ldb * 2;
    const size_t tstepA = 2 * hstepA, tstepB = 2 * hstepB;
    const unsigned ldsw = (unsigned)wid * 1024u;
    const int aoff = lds_byte(wr * 64 + fr, fq * 8), boff = lds_byte(wc * 32 + fr, fq * 8);
#define PG8_SA(b, h) (((b) * 2 + (h)) * HTB)
#define PG8_SB(b, h) ((4 + (b) * 2 + (h)) * HTB)
#define PG8_STAGE(bufoff, gbase, voff) do { _Pragma("unroll") for (int _i = 0; _i < 2; ++_i) \
        __builtin_amdgcn_global_load_lds((const unsigned*)((const char*)(gbase) + (voff)[_i]), (LAS unsigned*)(lds + (bufoff) + ldsw + _i * 8192), 16, 0, 0); } while (0)
#define PG8_LDA(dst, b, h) do { _Pragma("unroll") for (int m = 0; m < 4; ++m) _Pragma("unroll") for (int k = 0; k < 2; ++k) dst[m][k] = *(const LAS bf16x8*)(lds + PG8_SA(b, h) + aoff + m * 2048 + k * 1024); } while (0)
#define PG8_LDB(dst, b, h) do { _Pragma("unroll") for (int n = 0; n < 2; ++n) _Pragma("unroll") for (int k = 0; k < 2; ++k) dst[n][k] = *(const LAS bf16x8*)(lds + PG8_SB(b, h) + boff + n * 2048 + k * 1024); } while (0)
#define PG8_MMA(ai, bj, At, Bt) do { __builtin_amdgcn_s_setprio(1); _Pragma("unroll") for (int m = 0; m < 4; ++m) _Pragma("unroll") for (int n = 0; n < 2; ++n) _Pragma("unroll") for (int k = 0; k < 2; ++k) \
        acc[ai][bj][m][n] = __builtin_amdgcn_mfma_f32_16x16x32_bf16(Bt[n][k], At[m][k], acc[ai][bj][m][n], 0, 0, 0); __builtin_amdgcn_s_setprio(0); } while (0)
#define PG8_WAIT_V(n) asm volatile("s_waitcnt vmcnt(" #n ")" ::: "memory")
#define PG8_WAIT_L(n) asm volatile("s_waitcnt lgkmcnt(" #n ")" ::: "memory")
#define PG8_BAR __builtin_amdgcn_s_barrier()
#define PG8_SCHED __builtin_amdgcn_sched_barrier(0)
    Unit cur, nxt; int ui = 0;
    if (!S.next(0, cur)) return;
    f32x4 acc[2][2][4][2];
#pragma unroll
    for (int a = 0; a < 2; ++a)
#pragma unroll
        for (int b = 0; b < 2; ++b)
#pragma unroll
            for (int m = 0; m < 4; ++m)
#pragma unroll
                for (int n = 0; n < 2; ++n) acc[a][b][m][n] = (f32x4){0.f, 0.f, 0.f, 0.f};
    bf16x8 At[4][2], B0[2][2], B1[2][2];
    const char* cA = (const char*)g.A + (size_t)cur.pm * tstepA; const char* cB = (const char*)g.Bt + (size_t)cur.pn * tstepB;
    PG8_STAGE(PG8_SB(0, 0), cB, voffB); PG8_STAGE(PG8_SA(0, 0), cA, voffA); PG8_STAGE(PG8_SB(0, 1), cB + hstepB, voffB); PG8_STAGE(PG8_SA(0, 1), cA + hstepA, voffA);
    if (wr == 1) PG8_BAR;
    PG8_WAIT_V(4); PG8_BAR;
    PG8_STAGE(PG8_SB(1, 0), cB + kstep, voffB); PG8_STAGE(PG8_SA(1, 0), cA + kstep, voffA); PG8_STAGE(PG8_SB(1, 1), cB + hstepB + kstep, voffB);
    PG8_WAIT_V(6); PG8_BAR;
    for (;;) {
        const bool has_next = S.next(ui + 1, nxt);
        const char* nA = has_next ? (const char*)g.A + (size_t)nxt.pm * tstepA : cA; const char* nB = has_next ? (const char*)g.Bt + (size_t)nxt.pn * tstepB : cB;
        for (int t = 0; t < nt; t += 2) {
            const bool last = (t == nt - 2);
            const char* a1 = cA + (size_t)(t + 1) * kstep;
            const char* a2 = last ? nA : cA + (size_t)(t + 2) * kstep; const char* b2 = last ? nB : cB + (size_t)(t + 2) * kstep;
            const char* a3 = a2 + kstep; const char* b3 = b2 + kstep;
            PG8_LDB(B0, 0, 0); PG8_SCHED; PG8_LDA(At, 0, 0); PG8_STAGE(PG8_SA(1, 1), a1 + hstepA, voffA);
            PG8_WAIT_L(8); PG8_BAR; PG8_WAIT_L(0); PG8_MMA(0, 0, At, B0); PG8_BAR; PG8_SCHED;
            PG8_LDB(B1, 0, 1); PG8_STAGE(PG8_SB(0, 0), b2, voffB);
            PG8_BAR; PG8_WAIT_L(0); PG8_MMA(0, 1, At, B1); PG8_BAR;
            PG8_LDA(At, 0, 1); PG8_STAGE(PG8_SA(0, 0), a2, voffA);
            PG8_BAR; PG8_WAIT_L(0); PG8_MMA(1, 0, At, B0); PG8_BAR; PG8_SCHED;
            PG8_STAGE(PG8_SB(0, 1), b2 + hstepB, voffB);
            PG8_WAIT_V(6); PG8_BAR; PG8_MMA(1, 1, At, B1); PG8_BAR;
            PG8_LDB(B0, 1, 0); PG8_SCHED; PG8_LDA(At, 1, 0); PG8_STAGE(PG8_SA(0, 1), a2 + hstepA, voffA);
            PG8_WAIT_L(8); PG8_BAR; PG8_WAIT_L(0); PG8_MMA(0, 0, At, B0); PG8_BAR; PG8_SCHED;
            PG8_LDB(B1, 1, 1); PG8_STAGE(PG8_SB(1, 0), b3, voffB);
            PG8_BAR; PG8_WAIT_L(0); PG8_MMA(0, 1, At, B1); PG8_BAR;
            PG8_LDA(At, 1, 1); PG8_STAGE(PG8_SA(1, 0), a3, voffA);
            PG8_BAR; PG8_WAIT_L(0); PG8_MMA(1, 0, At, B0); PG8_BAR; PG8_SCHED;
            PG8_STAGE(PG8_SB(1, 1), b3 + hstepB, voffB);
            PG8_WAIT_V(6); PG8_BAR; PG8_MMA(1, 1, At, B1); PG8_BAR;
        }
        E(acc, cur, wr, wc, fr, fq);
        if (!has_next) break;
#pragma unroll
        for (int a = 0; a < 2; ++a)
#pragma unroll
            for (int b = 0; b < 2; ++b)
#pragma unroll
                for (int m = 0; m < 4; ++m)
#pragma unroll
                    for (int n = 0; n < 2; ++n) acc[a][b][m][n] = (f32x4){0.f, 0.f, 0.f, 0.f};
        cur = nxt; cA = nA; cB = nB; ++ui;
    }
    PG8_WAIT_V(0);
    if (wr == 0) PG8_BAR;
    PG8_BAR;
#undef PG8_SA
#undef PG8_SB
#undef PG8_STAGE
#undef PG8_LDA
#undef PG8_LDB
#undef PG8_MMA
#undef PG8_WAIT_V
#undef PG8_WAIT_L
#undef PG8_BAR
#undef PG8_SCHED
}
}

template <class Epi>
DEV void run_gemm(unsigned char* shm, const u16* A, int lda, const u16* Bt, int ldb, int N, int K, const Epi& E) {
    asm volatile("" : "+s"(A), "+s"(Bt));
    pg8::Gemm g; g.A = A; g.Bt = Bt; g.M = NTOK; g.N = N; g.K = K; g.lda = lda; g.ldb = ldb;
    pg8::StaticOrder S; S.init(NTOK, N, (int)gridDim.x, (int)blockIdx.x);
    pg8::gemm_phase<Epi>((LAS unsigned char*)shm, g, S, E);
}

DEV void convT_tile(const float* __restrict__ src, u16* __restrict__ dst, int K, int N, int Npad, int tile, float* T) {
    const int tid = tidx(); const int ntn = Npad >> 6; const int k0 = (tile / ntn) << 6, n0 = (tile % ntn) << 6;
#pragma unroll
    for (int j = 0; j < 2; ++j) { const int idx = tid + j * 512; const int r = idx >> 4, c4 = (idx & 15) << 2;
        float4 v = make_float4(0.f, 0.f, 0.f, 0.f); if (n0 + c4 < N) v = *(const float4*)(src + (size_t)(k0 + r) * N + n0 + c4);
        float* t = T + r * 65 + c4; t[0] = v.x; t[1] = v.y; t[2] = v.z; t[3] = v.w; }
    __syncthreads();
    { const int nn = tid >> 3, kq = (tid & 7) << 3; const float* t = T + kq * 65 + nn;
        u32x4 o; o.x = pk(t[0], t[65]); o.y = pk(t[130], t[195]); o.z = pk(t[260], t[325]); o.w = pk(t[390], t[455]);
        *(u32x4*)(dst + (size_t)(n0 + nn) * K + k0 + kq) = o; }
    __syncthreads();
}
DEV int conv_ntiles(int job, int layer) { return job == 0 ? (layer ? 3200 : 3328) : job == 1 ? 1024 : job == 2 ? 5632 : 2816; }
DEV void conv_job(const Params& p, int job, int layer, int tile, float* T) {
    if (job == 0) convT_tile(layer ? p.in[36] : p.in[14], (u16*)(p.ws + OFF_WIN), 2048, layer ? 6176 : 6528, layer ? LDP1 : LDP0, tile, T);
    else if (job == 1) convT_tile(layer ? p.in[37] : p.in[15], (u16*)(p.ws + OFF_WOUT), 2048, 2048, 2048, tile, T);
    else if (job == 2) convT_tile(p.in[10] + (size_t)layer * 2048 * 11264, (u16*)(p.ws + OFF_WUP), 2048, 11264, 11264, tile, T);
    else convT_tile(p.in[12] + (size_t)layer * 5632 * 2048, (u16*)(p.ws + OFF_WDN), 5632, 2048, 2048, tile, T);
}

DEV void adaln_tile(const Params& p, int tile, float* sl) {
    const int tid = tidx(); const int nt = tile % 6, kc = (tile / 6) & 31, layer = tile / 192;
    if (tid < 320) { const int j = tid >> 6, kk = tid & 63; const float cv = (j < 4) ? p.in[4][j * 2048 + kc * 64 + kk] : p.in[5][kc * 64 + kk]; sl[tid] = cv / (1.f + expf(-cv)); }
    __syncthreads();
    const float* w = p.in[6] + ((size_t)layer * 2048 + kc * 64) * 12288 + nt * 2048 + tid * 4;
    float acc[5][4];
#pragma unroll
    for (int j = 0; j < 5; ++j) { acc[j][0] = 0.f; acc[j][1] = 0.f; acc[j][2] = 0.f; acc[j][3] = 0.f; }
#pragma unroll 8
    for (int kk = 0; kk < 64; ++kk) { const float4 wv = *(const float4*)(w + (size_t)kk * 12288);
#pragma unroll
        for (int j = 0; j < 5; ++j) { const float s = sl[j * 64 + kk]; acc[j][0] += s * wv.x; acc[j][1] += s * wv.y; acc[j][2] += s * wv.z; acc[j][3] += s * wv.w; } }
    float* m = (float*)(p.ws + OFF_A) + (size_t)kc * 122880 + (size_t)layer * 5 * 12288 + nt * 2048 + tid * 4;
#pragma unroll
    for (int j = 0; j < 5; ++j) *(float4*)(m + j * 12288) = make_float4(acc[j][0], acc[j][1], acc[j][2], acc[j][3]);
    __syncthreads();
}

DEV void hyfilt_tile(const Params& p, int tile, float* sm) {
    const int tid = tidx();
    int L, p0; u16* G; float* nrm = (float*)(p.ws + OFF_A) + 32 * 122880 + (size_t)tile * 2048;
    if (tile < 128) { L = 4096; p0 = tile * 32; G = (u16*)(p.ws + OFF_GS); }
    else { L = 256; p0 = (tile - 128) * 32; G = (u16*)(p.ws + OFF_GP); }
    float* z = sm; float* h1 = sm + 32 * 33; float* h2 = h1 + 2048;
    const float cang = (float)(6.283185307179586 / (double)L);
    for (int i = tid; i < 32 * 33; i += 512) { const int pp = i / 33, e = i % 33; const float pos = (float)(p0 + pp); float val;
        if (e == 0) val = pos / (float)(L - 1);
        else { const int bi = (e - 1) & 15; const float fb = 1e-4f + (float)bi * ((15.f - 1e-4f) / 15.f); const float ang = (cang * pos) * fb; val = (e <= 16) ? cosf(ang) : -sinf(ang); }
        z[i] = val; }
    __syncthreads();
    for (int i = tid; i < 2048; i += 512) { const int pp = i >> 6, j = i & 63; float a = p.in[19][j];
        for (int e = 0; e < 33; ++e) a += z[pp * 33 + e] * p.in[18][e * 64 + j];
        h1[i] = sinf(p.in[23][j] * a); }
    __syncthreads();
    for (int i = tid; i < 2048; i += 512) { const int pp = i >> 6, j = i & 63; float a = p.in[21][j];
        for (int e = 0; e < 64; ++e) a += h1[pp * 64 + e] * p.in[20][e * 64 + j];
        h2[i] = sinf(p.in[23][64 + j] * a); }
    __syncthreads();
    const float dlo = 3.0701134573253946f, dhi = 15.350567286626973f;
    for (int q = 0; q < 4; ++q) { const int n = tid + 512 * q; const int c = n & 1023; const int back = n >> 10;
        float wcol[64];
#pragma unroll
        for (int e = 0; e < 64; ++e) wcol[e] = p.in[22][e * 2048 + n];
        const float delta = dlo + (dhi - dlo) * ((float)c / 1023.f);
        float asum = 0.f;
        for (int pp = 0; pp < 32; ++pp) { float a = 0.f;
#pragma unroll
            for (int e = 0; e < 64; ++e) a += h2[pp * 64 + e] * wcol[e];
            const int pos = p0 + pp; const float t = (float)pos / (float)(L - 1); a *= expf(-t * delta);
            if (!(back && pos == 0)) { asum += fabsf(a); const int lag = back ? -pos : pos; G[(size_t)c * (2 * L) + (L - lag)] = f2bf(a); } }
        nrm[n] = asum; }
    if (p0 == 0) for (int c = tid; c < 1024; c += 512) G[(size_t)c * (2 * L)] = 0;
    __syncthreads();
}

DEV void phase_prep(const Params& p, unsigned char* shm) {
    const int tid = tidx(); float* sm = (float*)shm;
    if (blockIdx.x == 0 && tid == 0) *(unsigned*)(p.ws + OFF_SMALL + SMALL_BYTES) = 0u;
    { u16* LW = (u16*)(p.ws + OFF_LW); u16* G2T = (u16*)(p.ws + OFF_G2T);
        for (int i = blockIdx.x * 512 + tid; i < 4 * 1024 * 64 + 1024 * 128; i += gridDim.x * 512) {
            if (i < 262144) { const int mi = i >> 16, n = (i >> 6) & 1023, r = i & 63; LW[i] = f2bf((mi < 2 ? p.in[27] : p.in[29])[((size_t)(mi & 1) * 64 + r) * 1024 + n]); }
            else { const int j = i - 262144; const int n = j >> 7, r = j & 127; G2T[j] = f2bf(p.in[30][(size_t)r * 1024 + n]); } } }
    const int n0 = 136, n1 = n0 + 384, n2 = n1 + 3328, n3 = n2 + 1024, n4 = n3 + 5632, n5 = n4 + 2816;
    for (int t = blockIdx.x; t < n5; t += gridDim.x) {
        if (t < n0) hyfilt_tile(p, t, sm);
        else if (t < n1) adaln_tile(p, t - n0, sm);
        else if (t < n2) conv_job(p, 0, 0, t - n1, sm);
        else if (t < n3) conv_job(p, 1, 0, t - n2, sm);
        else if (t < n4) conv_job(p, 2, 0, t - n3, sm);
        else conv_job(p, 3, 0, t - n4, sm);
    }
}

DEV void phase_reduce(const Params& p) {
    const float* part = (const float*)(p.ws + OFF_A); float* mods = (float*)(p.ws + OFF_SMALL); float* hn = (float*)(p.ws + OFF_SMALL + 491520);
    for (int i = blockIdx.x * 512 + tidx(); i < 122880 + 2048; i += gridDim.x * 512) {
        if (i < 122880) { float a = 0.f; for (int kc = 0; kc < 32; ++kc) a += part[(size_t)kc * 122880 + i]; mods[i] = a; }
        else { const int j = i - 122880; const int c = j & 1023; const float* hp = part + 32 * 122880; float a = 0.f;
            if (j < 1024) { for (int t = 0; t < 128; ++t) a += hp[(size_t)t * 2048 + c] + hp[(size_t)t * 2048 + 1024 + c]; }
            else { for (int t = 128; t < 136; ++t) a += hp[(size_t)t * 2048 + c] + hp[(size_t)t * 2048 + 1024 + c]; }
            hn[j] = a; }
    }
}

DEV void phase_norm(const Params& p, int layer, int which, unsigned char* shm) {
    const int tid = tidx(), wid = tid >> 6, lane = tid & 63;
    const float* g = p.in[which ? 9 : 8] + layer * 2048;
    const float* X = p.out; u16* A = (u16*)(p.ws + OFF_A);
    const float* mods = (const float*)(p.ws + OFF_SMALL) + (size_t)layer * 5 * 12288; const float* bb = p.in[7] + layer * 12288;
    const int shi = which ? 3 : 0;
    for (int row = blockIdx.x * 8 + wid; row < NTOK; row += gridDim.x * 8) {
        const bool first = (layer == 0 && which == 0);
        const float* xsrc = X + (size_t)row * DM; if (first) xsrc = row < NTP ? p.in[0] + (size_t)row * DM : p.in[1] + (size_t)(row - NTP) * DM;
        const float4* xr = (const float4*)xsrc;
        float4 v[8]; float ss = 0.f;
#pragma unroll
        for (int j = 0; j < 8; ++j) { v[j] = xr[lane + 64 * j]; ss += v[j].x * v[j].x + v[j].y * v[j].y + v[j].z * v[j].z + v[j].w * v[j].w; }
        if (first) {
#pragma unroll
            for (int j = 0; j < 8; ++j) ((float4*)(p.out + (size_t)row * DM))[lane + 64 * j] = v[j]; }
        ss = wave_sum(ss);
        const float rstd = rsqrtf(ss * (1.f / 2048.f) + 1e-6f);
        const float* md = mods + (size_t)tok_cond(row) * 12288;
#pragma unroll
        for (int j = 0; j < 8; ++j) { const int col = (lane + 64 * j) * 4;
            const float4 gg = *(const float4*)(g + col);
            const float4 s1 = *(const float4*)(md + shi * 2048 + col), s2 = *(const float4*)(bb + shi * 2048 + col);
            const float4 c1 = *(const float4*)(md + (shi + 1) * 2048 + col), c2 = *(const float4*)(bb + (shi + 1) * 2048 + col);
            const float o0 = v[j].x * rstd * gg.x * (1.f + c1.x + c2.x) + s1.x + s2.x;
            const float o1 = v[j].y * rstd * gg.y * (1.f + c1.y + c2.y) + s1.y + s2.y;
            const float o2 = v[j].z * rstd * gg.z * (1.f + c1.z + c2.z) + s1.z + s2.z;
            const float o3 = v[j].w * rstd * gg.w * (1.f + c1.w + c2.w) + s1.w + s2.w;
            u32x2 o; o.x = pk(o0, o1); o.y = pk(o2, o3);
            *(u32x2*)(A + (size_t)row * DM + col) = o; }
    }
    if (layer == 0 && which == 1) { const int na = conv_ntiles(0, 1), nb = na + conv_ntiles(1, 1);
        for (int t = blockIdx.x; t < nb; t += gridDim.x) { if (t < na) conv_job(p, 0, 1, t, (float*)shm); else conv_job(p, 1, 1, t - na, (float*)shm); } }
    if (layer == 1 && which == 0) { const int na = conv_ntiles(2, 1), nb = na + conv_ntiles(3, 1);
        for (int t = blockIdx.x; t < nb; t += gridDim.x) { if (t < na) conv_job(p, 2, 1, t, (float*)shm); else conv_job(p, 3, 1, t - na, (float*)shm); } }
}

DEV void sconv8(const u16* prow, bool hm, bool hp, const float* sw, const float* sb, int ch, float* o) {
    float c[8], m[8], q[8];
    unpack8(*(const u32x4*)(prow + ch), c);
    if (hm) unpack8(*(const u32x4*)(prow - LDP0 + ch), m); else { for (int i = 0; i < 8; ++i) m[i] = 0.f; }
    if (hp) unpack8(*(const u32x4*)(prow + LDP0 + ch), q); else { for (int i = 0; i < 8; ++i) q[i] = 0.f; }
#pragma unroll
    for (int i = 0; i < 8; ++i) o[i] = m[i] * sw[ch + i] + c[i] * sw[3072 + ch + i] + q[i] * sw[6144 + ch + i] + sb[ch + i];
}
DEV void hy_pre_tile(const Params& p, int tile, float* T) {
    const int tid = tidx(); const int tok0 = (tile >> 4) << 6, c0 = (tile & 15) << 6;
    const u16* P = (const u16*)(p.ws + OFF_P); u16* uT = (u16*)(p.ws + OFF_UT);
    { const int tk = tid >> 3, c8 = (tid & 7) << 3; const int tok = tok0 + tk; int t, L; tok_tl(tok, t, L);
        const u16* prow = P + (size_t)tok * LDP0; float x1[8], vv[8];
        sconv8(prow, t > 0, t < L - 1, p.in[16], p.in[17], 1024 + c0 + c8, x1);
        sconv8(prow, t > 0, t < L - 1, p.in[16], p.in[17], 2048 + c0 + c8, vv);
#pragma unroll
        for (int i = 0; i < 8; ++i) T[tk * 65 + c8 + i] = x1[i] * vv[i]; }
    __syncthreads();
    { const int ch = tid >> 3, t8 = (tid & 7) << 3; const float* t = T + t8 * 65 + ch;
        u32x4 o; o.x = pk(t[0], t[65]); o.y = pk(t[130], t[195]); o.z = pk(t[260], t[325]); o.w = pk(t[390], t[455]);
        *(u32x4*)(uT + (size_t)(c0 + ch) * NTOK + tok0 + t8) = o; }
    __syncthreads();
}
DEV void hy_post_tile(const Params& p, int tile, float* T) {
    const int tid = tidx(); const int tok0 = (tile >> 4) << 6, c0 = (tile & 15) << 6;
    const u16* P = (const u16*)(p.ws + OFF_P); const u16* uT = (const u16*)(p.ws + OFF_UT); u16* ycat = (u16*)(p.ws + OFF_A);
    { const int ch = tid >> 3, t8 = (tid & 7) << 3; float y[8]; unpack8(*(const u32x4*)(uT + (size_t)(c0 + ch) * NTOK + tok0 + t8), y);
#pragma unroll
        for (int i = 0; i < 8; ++i) T[(t8 + i) * 65 + ch] = y[i]; }
    __syncthreads();
    { const int tk = tid >> 3, c8 = (tid & 7) << 3; const int tok = tok0 + tk; int t, L; tok_tl(tok, t, L);
        const u16* prow = P + (size_t)tok * LDP0; float x0[8], x1[8], vv[8], o[8];
        sconv8(prow, t > 0, t < L - 1, p.in[16], p.in[17], c0 + c8, x0);
        sconv8(prow, t > 0, t < L - 1, p.in[16], p.in[17], 1024 + c0 + c8, x1);
        sconv8(prow, t > 0, t < L - 1, p.in[16], p.in[17], 2048 + c0 + c8, vv);
        const float* nrm = (const float*)(p.ws + OFF_SMALL + 491520) + (tok < NTP ? 1024 : 0);
#pragma unroll
        for (int i = 0; i < 8; ++i) { const int c = c0 + c8 + i; o[i] = x0[i] * (T[tk * 65 + c8 + i] / nrm[c] + x1[i] * vv[i] * p.in[24][c]); }
        u32x4 w; w.x = pk(o[0], o[1]); w.y = pk(o[2], o[3]); w.z = pk(o[4], o[5]); w.w = pk(o[6], o[7]);
        *(u32x4*)(ycat + (size_t)tok * DM + c0 + c8) = w; }
    __syncthreads();
}
DEV void hyconv_task(const Params& p, int task, unsigned char* shm) {
    const int tid = tidx(), wid = tid >> 6, lane = tid & 63;
    const bool sample = task < 1024; const int c = sample ? task : task - 1024;
    const int L = sample ? 4096 : 256, NB = sample ? 4 : 32, lgNB = sample ? 2 : 5, LP = L + 8;
    u16* uL = (u16*)shm; u16* gL = uL + NB * LP; u16* gS = gL + 2 * L;
    const u16* G = sample ? (const u16*)(p.ws + OFF_GS) + (size_t)c * 8192 : (const u16*)(p.ws + OFF_GP) + (size_t)c * 512;
    u16* uT = (u16*)(p.ws + OFF_UT) + (size_t)c * NTOK + (sample ? NTP : 0);
    for (int i = tid * 8; i < NB * L; i += 4096) { const int b = i / L, s = i % L; *(u32x4*)(uL + b * LP + s) = *(const u32x4*)(uT + i); }
    for (int i = tid * 8; i < 2 * L; i += 4096) { const u32x4 w = *(const u32x4*)(G + i); *(u32x4*)(gL + i) = w;
        const unsigned nx = (i + 8 < 2 * L) ? (unsigned)G[i + 8] : 0u;
        u32x4 sft; sft.x = (w.x >> 16) | (w.y << 16); sft.y = (w.y >> 16) | (w.z << 16); sft.z = (w.z >> 16) | (w.w << 16); sft.w = (w.w >> 16) | (nx << 16);
        *(u32x4*)(gS + i) = sft; }
    __syncthreads();
    const int ntile = (NB * (L >> 5)) >> 5;
    const int npair = sample ? 8 : 8; const bool two = sample;
    const int r = lane & 31, half = lane >> 5;
    {
        const int ct0 = two ? 2 * wid : wid;
        const int colA = ct0 * 32 + r, colB = colA + 32;
        const int bA = colA & (NB - 1), iA = colA >> lgNB, bB = colB & (NB - 1), iB = colB >> lgNB; const int tA = iA * 32, tB = iB * 32;
        const int i_lo = (ct0 * 32) >> lgNB, i_hi = ((two ? ct0 + 1 : ct0) * 32 + 31) >> lgNB;
        const int d_lo = 32 * i_lo - (L - 16), d_hi = 32 * i_hi;
        f32x16 accA, accB;
#pragma unroll
        for (int j = 0; j < 16; ++j) { accA[j] = 0.f; accB[j] = 0.f; }
        const u16* ubA = uL + bA * LP + 8 * half; const u16* ubB = uL + bB * LP + 8 * half;
        const u16* gsel = (r & 1) ? gS : gL;
        const int qb = (L - r + 8 * half) & ~1;
        for (int dl = d_lo; dl <= d_hi; dl += 16) {
            const unsigned* gq = (const unsigned*)(gsel + (qb - dl));
            u32x4 aw; aw.x = gq[0]; aw.y = gq[1]; aw.z = gq[2]; aw.w = gq[3];
            const bf16x8 a = __builtin_bit_cast(bf16x8, aw);
            const int sA = tA - dl, sB = tB - dl;
            bf16x8 bvA = (bf16x8){0, 0, 0, 0, 0, 0, 0, 0}, bvB = bvA;
            if (sA >= 0 && sA <= L - 16) bvA = *(const bf16x8*)(ubA + sA);
            accA = __builtin_amdgcn_mfma_f32_32x32x16_bf16(a, bvA, accA, 0, 0, 0);
            if (two) { if (sB >= 0 && sB <= L - 16) bvB = *(const bf16x8*)(ubB + sB);
                accB = __builtin_amdgcn_mfma_f32_32x32x16_bf16(a, bvB, accB, 0, 0, 0); }
        }
#pragma unroll
        for (int g = 0; g < 4; ++g) { u32x2 w; w.x = pk(accA[4 * g], accA[4 * g + 1]); w.y = pk(accA[4 * g + 2], accA[4 * g + 3]);
            *(u32x2*)(uT + (size_t)bA * L + tA + 8 * g + 4 * half) = w; }
        if (two) {
#pragma unroll
            for (int g = 0; g < 4; ++g) { u32x2 w; w.x = pk(accB[4 * g], accB[4 * g + 1]); w.y = pk(accB[4 * g + 2], accB[4 * g + 3]);
                *(u32x2*)(uT + (size_t)bB * L + tB + 8 * g + 4 * half) = w; } }
    }
    (void)ntile; (void)npair;
    __syncthreads();
}

DEV void rwkv_lora_tile(const Params& p, int tile, unsigned char* shm) {
    const int tid = tidx(), wid = tid >> 6, lane = tid & 63, l15 = lane & 15, quad = lane >> 4; const int tok0 = tile * 32;
    const u16* P = (const u16*)(p.ws + OFF_P); u16* RW = (u16*)(p.ws + OFF_RW); const u16* LW = (const u16*)(p.ws + OFF_LW);
    u16* Ain = (u16*)shm;
    u16* Ol = (u16*)(shm + 18432);
    for (int i = tid; i < 32 * 256; i += 512) { const int tk = i >> 8, cc = i & 255; const int tok = tok0 + tk; int t, L; tok_tl(tok, t, L);
        const u16* pp = P + (size_t)tok * LDP0 + 6144 + cc; float x = bf2f(*pp); const float xm = t > 0 ? bf2f(pp[-LDP0]) : 0.f; const float xp = t < L - 1 ? bf2f(pp[LDP0]) : 0.f;
        const float mu = p.in[25][3072 + cc]; x = x + mu * (0.5f * (xm + xp) - x); if (cc < 128) x = tanhf(x);
        Ain[((cc >> 6) * 32 + tk) * 72 + (cc & 63)] = f2bf(x); }
    __syncthreads();
#pragma unroll 1
    for (int mi = 0; mi < 4; ++mi) {
        const float* bias = (mi < 2 ? p.in[26] : p.in[28]) + (mi & 1) * 1024;
        const float osc = mi < 2 ? 0.6065306597f : 1.f;
        bf16x8 af[2][2];
#pragma unroll
        for (int tt = 0; tt < 2; ++tt)
#pragma unroll
            for (int ks = 0; ks < 2; ++ks) af[tt][ks] = *(const bf16x8*)(Ain + (mi * 32 + tt * 16 + l15) * 72 + ks * 32 + quad * 8);
#pragma unroll 2
        for (int q = 0; q < 8; ++q) { const int nt = wid * 8 + q; const int n = nt * 16 + l15;
            const bf16x8 b0 = *(const bf16x8*)(LW + ((size_t)mi * 1024 + n) * 64 + quad * 8), b1 = *(const bf16x8*)(LW + ((size_t)mi * 1024 + n) * 64 + 32 + quad * 8);
            const float bs = bias[n];
#pragma unroll
            for (int tt = 0; tt < 2; ++tt) { f32x4 acc = (f32x4){0.f, 0.f, 0.f, 0.f}; acc = mfma16(af[tt][0], b0, acc); acc = mfma16(af[tt][1], b1, acc);
#pragma unroll
                for (int r = 0; r < 4; ++r) Ol[(tt * 16 + quad * 4 + r) * 1032 + n] = f2bf(osc * sigm(acc[r] + bs)); } }
        __syncthreads();
#pragma unroll
        for (int i = 0; i < 8; ++i) { const int piece = tid + 512 * i; const int tk = piece >> 7, c8 = (piece & 127) * 8;
            *(u32x4*)(RW + (size_t)(tok0 + tk) * 4096 + mi * 1024 + c8) = *(const u32x4*)(Ol + tk * 1032 + c8); }
        __syncthreads();
    }
}
DEV float mixf(float c, float m, float q, float mu) { return c + mu * (0.5f * (m + q) - c); }
DEV void rwkv_scan_task(const Params& p, int task, float* sm) {
    const bool sample = task < 128; const int tt_ = sample ? task : task - 128;
    const int b = tt_ >> 5, h = (tt_ >> 1) & 15, dir = tt_ & 1;
    const int L = sample ? 4096 : 256; const int tok0 = sample ? NTP + b * 4096 : b * 256;
    const int tid = tidx(), wid = tid >> 6, lane = tid & 63;
    const int kl = lane & 7;
    const int row2 = (wid & 3) * 16 + (lane >> 3) * 2;
    float S[8], T[8];
    const size_t so2 = ((((size_t)b * 2 + dir) * 16 + h) * 64 + row2) * 64 + kl * 8;
    if (sample) {
        const float4 a = *(const float4*)(p.in[2] + so2), c = *(const float4*)(p.in[2] + so2 + 4), d = *(const float4*)(p.in[2] + so2 + 64), e = *(const float4*)(p.in[2] + so2 + 68);
        S[0] = a.x; S[1] = a.y; S[2] = a.z; S[3] = a.w; S[4] = c.x; S[5] = c.y; S[6] = c.z; S[7] = c.w;
        T[0] = d.x; T[1] = d.y; T[2] = d.z; T[3] = d.w; T[4] = e.x; T[5] = e.y; T[6] = e.z; T[7] = e.w; }
    else {
#pragma unroll
        for (int i = 0; i < 8; ++i) { S[i] = 0.f; T[i] = 0.f; } }
    f32x2 S2[4], T2[4];
#pragma unroll
    for (int i = 0; i < 4; ++i) { S2[i] = (f32x2){S[2 * i], S[2 * i + 1]}; T2[i] = (f32x2){T[2 * i], T[2 * i + 1]}; }
    const int pk4 = (tid & 15) * 4; const int ch = h * 64 + pk4; const int plt = (tid & 255) >> 4;
    const float4 mur = *(const float4*)(p.in[25] + ch), muk = *(const float4*)(p.in[25] + 1024 + ch), muv = *(const float4*)(p.in[25] + 2048 + ch);
    const float4 kkw = *(const float4*)(p.in[31] + ch), kaw = *(const float4*)(p.in[32] + ch);
    const float murA[4] = {mur.x, mur.y, mur.z, mur.w}, mukA[4] = {muk.x, muk.y, muk.z, muk.w}, muvA[4] = {muv.x, muv.y, muv.z, muv.w};
    const float kkwA[4] = {kkw.x, kkw.y, kkw.z, kkw.w}, kawA[4] = {kaw.x, kaw.y, kaw.z, kaw.w};
    const u16* P = (const u16*)(p.ws + OFF_P); const u16* RW = (const u16*)(p.ws + OFF_RW);
    u16* Y = (u16*)(p.out + OUT_GLAST) + (dir ? (size_t)NTOK * 1024 : 0);
#define RW_PREP(c0_, buf_) do { float* vec_ = sm + (buf_) * 14336; float* vvs_ = vec_ + 10240; \
        _Pragma("unroll 1") for (int ps = 0; ps < 2; ++ps) { const int ptt = plt + 16 * ps; \
            const int t = dir ? (L - 1 - ((c0_) + ptt)) : ((c0_) + ptt); const size_t tok = (size_t)tok0 + t; \
            const u16* pr = P + tok * LDP0 + 3072 + ch; \
            float rc[4], kc[4], vc[4], rm[4], km[4], vm[4], rp[4], kp[4], vp[4], ee[4], aa[4]; \
            unpack4(*(const u32x2*)(pr), rc); unpack4(*(const u32x2*)(pr + 1024), kc); unpack4(*(const u32x2*)(pr + 2048), vc); \
            if (t > 0) { const u16* pm = P + (tok - 1) * LDP0 + 3072 + ch; unpack4(*(const u32x2*)(pm), rm); unpack4(*(const u32x2*)(pm + 1024), km); unpack4(*(const u32x2*)(pm + 2048), vm); } \
            else { for (int i = 0; i < 4; ++i) { rm[i] = 0.f; km[i] = 0.f; vm[i] = 0.f; } } \
            if (t < L - 1) { unpack4(*(const u32x2*)(pr + LDP0), rp); unpack4(*(const u32x2*)(pr + LDP0 + 1024), kp); unpack4(*(const u32x2*)(pr + LDP0 + 2048), vp); } \
            else { for (int i = 0; i < 4; ++i) { rp[i] = 0.f; kp[i] = 0.f; vp[i] = 0.f; } } \
            unpack4(*(const u32x2*)(RW + tok * 4096 + dir * 1024 + ch), ee); unpack4(*(const u32x2*)(RW + tok * 4096 + (2 + dir) * 1024 + ch), aa); \
            float r4[4], k4[4], v4[4], kr[4]; float ss = 0.f; \
            _Pragma("unroll") for (int i = 0; i < 4; ++i) { r4[i] = mixf(rc[i], rm[i], rp[i], murA[i]); k4[i] = mixf(kc[i], km[i], kp[i], mukA[i]); v4[i] = mixf(vc[i], vm[i], vp[i], muvA[i]); \
                kr[i] = k4[i] * kkwA[i]; ss += kr[i] * kr[i]; } \
            ss = sum16(ss); const float inv = rsqrtf(ss + 1e-12f); \
            float tkk[4], tw[4], tkka[4], tkd[4]; \
            _Pragma("unroll") for (int i = 0; i < 4; ++i) { tkk[i] = kr[i] * inv; tw[i] = __expf(-ee[i]); tkka[i] = tkk[i] * aa[i]; tkd[i] = k4[i] * (1.f + (aa[i] - 1.f) * kawA[i]); } \
            float* vj = vec_ + ptt * 320 + pk4; \
            *(float4*)(vj) = make_float4(tkk[0], tkk[1], tkk[2], tkk[3]); *(float4*)(vj + 64) = make_float4(tw[0], tw[1], tw[2], tw[3]); *(float4*)(vj + 128) = make_float4(tkka[0], tkka[1], tkka[2], tkka[3]); \
            *(float4*)(vj + 192) = make_float4(tkd[0], tkd[1], tkd[2], tkd[3]); *(float4*)(vj + 256) = make_float4(r4[0], r4[1], r4[2], r4[3]); \
            *(float4*)(vvs_ + ptt * 64 + pk4) = make_float4(v4[0], v4[1], v4[2], v4[3]); } } while (0)
#define RW_YOUT(c0_, buf_) do { const float* yb_ = sm + (buf_) * 14336 + 12288; \
        _Pragma("unroll 1") for (int ps = 0; ps < 2; ++ps) { const int ptt = plt + 16 * ps; const int t = dir ? (L - 1 - ((c0_) + ptt)) : ((c0_) + ptt); \
            const float4 yv = *(const float4*)(yb_ + ptt * 64 + pk4); u32x2 w; w.x = pk(yv.x, yv.y); w.y = pk(yv.z, yv.w); \
            *(u32x2*)(Y + ((size_t)tok0 + t) * 1024 + ch) = w; } } while (0)
    const int nchunk = L >> 5;
    if (wid >= 4) RW_PREP(0, 0);
    __syncthreads();
#pragma unroll 1
    for (int c = 0; c < nchunk; ++c) {
        if (wid < 4) {
            const float* vec = sm + (c & 1) * 14336; const float* vvs = vec + 10240; float* yb = sm + (c & 1) * 14336 + 12288;
#pragma unroll
            for (int j = 0; j < 32; ++j) {
                const float* vj = vec + j * 320 + kl * 8;
                const f32x4 a0 = *(const f32x4*)(vj), a1 = *(const f32x4*)(vj + 4);
                const f32x4 w0 = *(const f32x4*)(vj + 64), w1 = *(const f32x4*)(vj + 68);
                const f32x4 b0 = *(const f32x4*)(vj + 128), b1 = *(const f32x4*)(vj + 132);
                const f32x4 d0 = *(const f32x4*)(vj + 192), d1 = *(const f32x4*)(vj + 196);
                const f32x4 r0 = *(const f32x4*)(vj + 256), r1 = *(const f32x4*)(vj + 260);
                const float2 vr = *(const float2*)(vvs + j * 64 + row2);
                const f32x2 kk0 = a0.lo, kk1 = a0.hi, kk2 = a1.lo, kk3 = a1.hi;
                f32x2 pa = S2[0] * kk0; pa += S2[1] * kk1; pa += S2[2] * kk2; pa += S2[3] * kk3;
                f32x2 pb = T2[0] * kk0; pb += T2[1] * kk1; pb += T2[2] * kk2; pb += T2[3] * kk3;
                const float sa = -sum8(pa.x + pa.y), sb = -sum8(pb.x + pb.y);
                const f32x2 sa2 = (f32x2){sa, sa}, sb2 = (f32x2){sb, sb}, vx2 = (f32x2){vr.x, vr.x}, vy2 = (f32x2){vr.y, vr.y};
                S2[0] = S2[0] * w0.lo + (sa2 * b0.lo + vx2 * d0.lo); S2[1] = S2[1] * w0.hi + (sa2 * b0.hi + vx2 * d0.hi);
                S2[2] = S2[2] * w1.lo + (sa2 * b1.lo + vx2 * d1.lo); S2[3] = S2[3] * w1.hi + (sa2 * b1.hi + vx2 * d1.hi);
                T2[0] = T2[0] * w0.lo + (sb2 * b0.lo + vy2 * d0.lo); T2[1] = T2[1] * w0.hi + (sb2 * b0.hi + vy2 * d0.hi);
                T2[2] = T2[2] * w1.lo + (sb2 * b1.lo + vy2 * d1.lo); T2[3] = T2[3] * w1.hi + (sb2 * b1.hi + vy2 * d1.hi);
                f32x2 qa = S2[0] * r0.lo; qa += S2[1] * r0.hi; qa += S2[2] * r1.lo; qa += S2[3] * r1.hi;
                f32x2 qb = T2[0] * r0.lo; qb += T2[1] * r0.hi; qb += T2[2] * r1.lo; qb += T2[3] * r1.hi;
                const float y0 = sum8(qa.x + qa.y), y1 = sum8(qb.x + qb.y);
                if (kl == 0) *(float2*)(yb + j * 64 + row2) = make_float2(y0, y1);
            }
        } else {
            if (c > 0) RW_YOUT((c - 1) * 32, (c - 1) & 1);
            if (c + 1 < nchunk) RW_PREP((c + 1) * 32, (c + 1) & 1);
        }
        __syncthreads();
    }
    if (wid >= 4) RW_YOUT((nchunk - 1) * 32, (nchunk - 1) & 1);
#undef RW_PREP
#undef RW_YOUT
#pragma unroll
    for (int i = 0; i < 4; ++i) { S[2 * i] = S2[i].x; S[2 * i + 1] = S2[i].y; T[2 * i] = T2[i].x; T[2 * i + 1] = T2[i].y; }
    if (!sample && wid < 4) { float* so = p.out + OUT_RWST + so2;
        *(float4*)(so) = make_float4(S[0], S[1], S[2], S[3]); *(float4*)(so + 4) = make_float4(S[4], S[5], S[6], S[7]);
        *(float4*)(so + 64) = make_float4(T[0], T[1], T[2], T[3]); *(float4*)(so + 68) = make_float4(T[4], T[5], T[6], T[7]); }
    __syncthreads();
}
DEV void rwkv_post_tile(const Params& p, int tile, float* sm) {
    const int tid = tidx(); const int tok0 = tile * 32;
    const u16* P = (const u16*)(p.ws + OFF_P); const u16* RW = (const u16*)(p.ws + OFF_RW); u16* ycat = (u16*)(p.ws + OFF_A);
    const u16* YF = (const u16*)(p.out + OUT_GLAST); const u16* YB = YF + (size_t)NTOK * 1024;
    u16* Gh = (u16*)(sm + 4096);
    for (int i = tid; i < 32 * 128; i += 512) { const int tk = i >> 7, r = i & 127; const int tok = tok0 + tk; int t, L; tok_tl(tok, t, L);
        const u16* pp = P + (size_t)tok * LDP0 + 6400 + r; const float x = bf2f(*pp); const float xm = t > 0 ? bf2f(pp[-LDP0]) : 0.f; const float xp = t < L - 1 ? bf2f(pp[LDP0]) : 0.f;
        sm[i] = sigm(mixf(x, xm, xp, p.in[25][3328 + r])); }
    __syncthreads();
    { float g0[32], g1[32];
#pragma unroll
        for (int k = 0; k < 32; ++k) { g0[k] = 0.f; g1[k] = 0.f; }
        const float* g2 = p.in[30];
        for (int r = 0; r < 128; r += 4) {
            float wa[4], wb[4];
#pragma unroll
            for (int q = 0; q < 4; ++q) { wa[q] = g2[(r + q) * 1024 + tid]; wb[q] = g2[(r + q) * 1024 + 512 + tid]; }
#pragma unroll
            for (int k = 0; k < 32; ++k) { const float4 s4 = *(const float4*)(sm + k * 128 + r);
                g0[k] += s4.x * wa[0] + s4.y * wa[1] + s4.z * wa[2] + s4.w * wa[3]; g1[k] += s4.x * wb[0] + s4.y * wb[1] + s4.z * wb[2] + s4.w * wb[3]; } }
#pragma unroll
        for (int k = 0; k < 32; ++k) { Gh[k * 1024 + tid] = f2bf(g0[k]); Gh[k * 1024 + 512 + tid] = f2bf(g1[k]); } }
    __syncthreads();
    const int c8 = (tid & 127) * 8;
    float mur[8], muk[8], muv[8], ka[8], rk[8], lw[8], lb[8];
#pragma unroll
    for (int i = 0; i < 8; ++i) { mur[i] = p.in[25][c8 + i]; muk[i] = p.in[25][1024 + c8 + i]; muv[i] = p.in[25][2048 + c8 + i]; ka[i] = p.in[32][c8 + i]; rk[i] = p.in[33][c8 + i]; lw[i] = p.in[34][c8 + i]; lb[i] = p.in[35][c8 + i]; }
#pragma unroll 1
    for (int it = 0; it < 8; ++it) { const int tk = (tid >> 7) + 4 * it; const int tok = tok0 + tk; int t, L; tok_tl(tok, t, L);
        const u16* pr = P + (size_t)tok * LDP0 + 3072 + c8; const bool hm = t > 0, hp = t < L - 1;
        float rc[8], rm[8], rp[8], kc[8], km[8], kp[8], vc[8], vm[8], vp[8], a0[8], a1[8], yf[8], yb[8], gg[8];
        unpack8(*(const u32x4*)pr, rc); unpack8(*(const u32x4*)(pr + 1024), kc); unpack8(*(const u32x4*)(pr + 2048), vc);
        if (hm) { const u16* pm = P + (size_t)(tok - 1) * LDP0 + 3072 + c8; unpack8(*(const u32x4*)(pm), rm); unpack8(*(const u32x4*)(pm + 1024), km); unpack8(*(const u32x4*)(pm + 2048), vm); }
        else { for (int i = 0; i < 8; ++i) { rm[i] = 0.f; km[i] = 0.f; vm[i] = 0.f; } }
        if (hp) { unpack8(*(const u32x4*)(pr + LDP0), rp); unpack8(*(const u32x4*)(pr + LDP0 + 1024), kp); unpack8(*(const u32x4*)(pr + LDP0 + 2048), vp); }
        else { for (int i = 0; i < 8; ++i) { rp[i] = 0.f; kp[i] = 0.f; vp[i] = 0.f; } }
        unpack8(*(const u32x4*)(RW + (size_t)tok * 4096 + 2048 + c8), a0); unpack8(*(const u32x4*)(RW + (size_t)tok * 4096 + 3072 + c8), a1);
        unpack8(*(const u32x4*)(YF + (size_t)tok * 1024 + c8), yf); unpack8(*(const u32x4*)(YB + (size_t)tok * 1024 + c8), yb);
        unpack8(*(const u32x4*)(Gh + tk * 1024 + c8), gg);
        float y[8], v_[8]; float bon = 0.f, sy = 0.f;
#pragma unroll
        for (int i = 0; i < 8; ++i) { const float r_ = mixf(rc[i], rm[i], rp[i], mur[i]), k_ = mixf(kc[i], km[i], kp[i], muk[i]); v_[i] = mixf(vc[i], vm[i], vp[i], muv[i]);
            bon += r_ * k_ * (2.f + (a0[i] + a1[i] - 2.f) * ka[i]) * rk[i]; y[i] = yf[i] + yb[i]; sy += y[i]; }
        bon = sum8(bon); const float mean = sum8(sy) * (1.f / 64.f);
        float sv = 0.f;
#pragma unroll
        for (int i = 0; i < 8; ++i) { y[i] -= mean; sv += y[i] * y[i]; }
        const float rstd = rsqrtf(sum8(sv) * (1.f / 64.f) + 64e-5f);
        float o[8];
#pragma unroll
        for (int i = 0; i < 8; ++i) o[i] = (y[i] * rstd * lw[i] + lb[i] + bon * v_[i]) * gg[i];
        u32x4 w; w.x = pk(o[0], o[1]); w.y = pk(o[2], o[3]); w.z = pk(o[4], o[5]); w.w = pk(o[6], o[7]);
        *(u32x4*)(ycat + (size_t)tok * DM + 1024 + c8) = w; }
    __syncthreads();
}

DEV float logsig(float x) { return fminf(x, 0.f) - __logf(1.f + __expf(-fabsf(x))); }
DEV void gla_intra_task(const Params& p, int task, unsigned char* shm) {
    const int tid = tidx(), wid = tid >> 6, lane = tid & 63, l15 = lane & 15, quad = lane >> 4;
    const int cidx = task >> 2, h = task & 3; const int tok0 = cidx * 64;
    u16* P = (u16*)(p.ws + OFF_P); u16* QB = (u16*)(p.ws + OFF_A); float* Dbuf = (float*)(p.ws + OFF_DB);
    u16* qi = (u16*)shm; u16* ki = qi + 64 * 264; u16* vl = (u16*)shm; u16* Pl = (u16*)(shm + 67584); float* gl = (float*)(shm + 76800); float* tot = (float*)(shm + 84992);
    for (int i = tid; i < 2048; i += 512) { const int tl = i >> 5, c = i & 31; gl[i] = bf2f(P[(size_t)(tok0 + tl) * LDP1 + 6144 + c]); }
    __syncthreads();
    const int k = tid & 255, jh = tid >> 8;
#pragma unroll 1
    for (int dd = 0; dd < 2; ++dd) { const int dir = 1 - dd;
        float g2r[16];
#pragma unroll
        for (int r = 0; r < 16; ++r) g2r[r] = p.in[38][(size_t)(dir * 16 + r) * 1024 + h * 256 + k];
        const float gb = p.in[39][dir * 1024 + h * 256 + k];
        float bl[32]; float run = 0.f;
#pragma unroll
        for (int jj = 0; jj < 32; ++jj) { const int j = jh * 32 + jj; const int tl = dir ? 63 - j : j; const float* gr = gl + tl * 32 + dir * 16;
            float x = gb;
#pragma unroll
            for (int r = 0; r < 16; r += 4) { const float4 g4 = *(const float4*)(gr + r); x += g4.x * g2r[r] + g4.y * g2r[r + 1] + g4.z * g2r[r + 2] + g4.w * g2r[r + 3]; }
            run += logsig(x) * 0.0625f; bl[jj] = run; }
        tot[jh * 256 + k] = run;
        __syncthreads();
        const float t0v = tot[k], t1v = tot[256 + k]; const float off = jh ? t0v : 0.f; const float bref = t0v, blast = t0v + t1v;
        if (jh == 0) Dbuf[((size_t)cidx * 2 + dir) * 1024 + h * 256 + k] = __expf(blast);
        u16* qdst; u16* kdst; size_t ldd;
        if (dir == 0) { qdst = P + h * 256 + k; kdst = P + 1024 + h * 256 + k; ldd = LDP1; } else { qdst = QB + h * 256 + k; kdst = QB + 1024 + h * 256 + k; ldd = 2048; }
#pragma unroll
        for (int jj = 0; jj < 32; ++jj) { const int j = jh * 32 + jj; const int tl = dir ? 63 - j : j; const size_t tok = (size_t)tok0 + tl;
            const float qv = bf2f(P[tok * LDP1 + h * 256 + k]) * 0.0625f, kv = bf2f(P[tok * LDP1 + 1024 + h * 256 + k]);
            const float b = bl[jj] + off;
            qi[j * 264 + k] = f2bf(qv * __expf(b - bref)); ki[j * 264 + k] = f2bf(kv * __expf(bref - b));
            qdst[tok * ldd] = f2bf(qv * __expf(b)); kdst[tok * ldd] = f2bf(kv * __expf(blast - b)); }
        __syncthreads();
        { const int tt = wid >> 1;
#pragma unroll
            for (int q2 = 0; q2 < 2; ++q2) { const int st = (wid & 1) * 2 + q2; f32x4 acc = (f32x4){0.f, 0.f, 0.f, 0.f};
                if (st <= tt) {
#pragma unroll
                    for (int ks = 0; ks < 8; ++ks) { const bf16x8 a = *(const bf16x8*)(qi + (tt * 16 + l15) * 264 + ks * 32 + quad * 8); const bf16x8 b = *(const bf16x8*)(ki + (st * 16 + l15) * 264 + ks * 32 + quad * 8);
                        acc = mfma16(a, b, acc); } }
#pragma unroll
                for (int r = 0; r < 4; ++r) { const int t = tt * 16 + quad * 4 + r, s_ = st * 16 + l15; Pl[t * 72 + s_] = f2bf(s_ <= t ? acc[r] : 0.f); } } }
        __syncthreads();
#pragma unroll
        for (int i = 0; i < 8; ++i) { const int piece = tid + 512 * i; const int j = piece >> 6, c8 = (piece & 63) * 8; const int tl = dir ? 63 - j : j;
            *(u32x4*)(vl + j * 520 + c8) = *(const u32x4*)(P + (size_t)(tok0 + tl) * LDP1 + 2048 + h * 512 + c8); }
        __syncthreads();
        u16* O = (u16*)(p.ws + (dir ? OFF_OB : OFF_OF)) + h * 512;
#pragma unroll 1
        for (int q4 = 0; q4 < 4; ++q4) { const int vt = wid * 4 + q4; f32x4 acc[4];
#pragma unroll
            for (int tt = 0; tt < 4; ++tt) acc[tt] = (f32x4){0.f, 0.f, 0.f, 0.f};
#pragma unroll
            for (int ss = 0; ss < 2; ++ss) { bf16x8 bfr;
#pragma unroll
                for (int jj = 0; jj < 8; ++jj) bfr[jj] = (short)vl[(ss * 32 + quad * 8 + jj) * 520 + vt * 16 + l15];
#pragma unroll
                for (int tt = 0; tt < 4; ++tt) { if (ss * 32 <= tt * 16 + 15) { const bf16x8 a = *(const bf16x8*)(Pl + (tt * 16 + l15) * 72 + ss * 32 + quad * 8); acc[tt] = mfma16(a, bfr, acc[tt]); } } }
#pragma unroll
            for (int tt = 0; tt < 4; ++tt)
#pragma unroll
                for (int r = 0; r < 4; ++r) { const int t = tt * 16 + quad * 4 + r; const int tl = dir ? 63 - t : t; O[(size_t)(tok0 + tl) * DM + vt * 16 + l15] = f2bf(acc[tt][r]); } }
        __syncthreads();
    }
}
DEV void gla_inter_task(const Params& p, int task, unsigned char* shm) {
    const bool sample = task < 256; const int tt_ = sample ? task : task - 256;
    const int seq = tt_ >> 3, vs = tt_ & 7; const int b = seq >> 3, h = (seq >> 1) & 3, dir = seq & 1;
    const int L = sample ? 4096 : 256; const int tok0 = sample ? NTP + b * 4096 : b * 256;
    const int nch = L >> 6, cbase = tok0 >> 6;
    const int tid = tidx(), wid = tid >> 6, lane = tid & 63, l15 = lane & 15, quad = lane >> 4;
    const u16* P = (const u16*)(p.ws + OFF_P); const u16* QB = (const u16*)(p.ws + OFF_A); const float* Dbuf = (const float*)(p.ws + OFF_DB);
    u16* ST = (u16*)shm; u16* qdl = (u16*)(shm + 33792); u16* kdl = (u16*)(shm + 67584); u16* vl = (u16*)(shm + 101376); float* dl = (float*)(shm + 110592);
    f32x4 S[2][4];
    const size_t sbase = (((size_t)b * 2 + dir) * 4 + h) * 256 * 512 + vs * 64;
#pragma unroll
    for (int kt = 0; kt < 2; ++kt)
#pragma unroll
        for (int vt = 0; vt < 4; ++vt)
#pragma unroll
            for (int r = 0; r < 4; ++r) { const int kk = wid * 32 + kt * 16 + quad * 4 + r; S[kt][vt][r] = sample ? p.in[3][sbase + (size_t)kk * 512 + vt * 16 + l15] : 0.f; }
    const u16* qsrc; const u16* ksrc; size_t lds_;
    if (dir == 0) { qsrc = P + h * 256; ksrc = P + 1024 + h * 256; lds_ = LDP1; } else { qsrc = QB + h * 256; ksrc = QB + 1024 + h * 256; lds_ = 2048; }
    const u16* vsrc = P + 2048 + h * 512 + vs * 64;
    u16* O = (u16*)(p.ws + (dir ? OFF_OB : OFF_OF)) + h * 512 + vs * 64;
    u32x4 rq[4], rk[4], rv; float rd = 0.f;
    const int vrow = tid >> 3, vc8 = (tid & 7) * 8;
#define GLA_ISSUE(n_) do { const int cidx_ = cbase + (dir ? nch - 1 - (n_) : (n_)); \
        _Pragma("unroll") for (int i = 0; i < 4; ++i) { const int piece = tid + 512 * i; const int j = piece >> 5, c8 = (piece & 31) * 8; const size_t tok = (size_t)cidx_ * 64 + (dir ? 63 - j : j); \
            rq[i] = *(const u32x4*)(qsrc + tok * lds_ + c8); rk[i] = *(const u32x4*)(ksrc + tok * lds_ + c8); } \
        { const size_t tok = (size_t)cidx_ * 64 + (dir ? 63 - vrow : vrow); rv = *(const u32x4*)(vsrc + tok * LDP1 + vc8); } \
        if (tid < 256) rd = Dbuf[((size_t)cidx_ * 2 + dir) * 1024 + h * 256 + tid]; } while (0)
#define GLA_WRITE_ST() do { _Pragma("unroll") for (int kt = 0; kt < 2; ++kt) _Pragma("unroll") for (int vt = 0; vt < 4; ++vt) { u32x2 w; w.x = pk(S[kt][vt][0], S[kt][vt][1]); w.y = pk(S[kt][vt][2], S[kt][vt][3]); \
            *(u32x2*)(ST + (vt * 16 + l15) * 264 + wid * 32 + kt * 16 + quad * 4) = w; } } while (0)
    GLA_WRITE_ST();
    GLA_ISSUE(0);
    const int tt = wid >> 1, vb = (wid & 1) * 2;
#pragma unroll 1
    for (int n = 0; n < nch; ++n) {
        const int cidx = cbase + (dir ? nch - 1 - n : n);
#pragma unroll
        for (int i = 0; i < 4; ++i) { const int piece = tid + 512 * i; const int j = piece >> 5, c8 = (piece & 31) * 8; *(u32x4*)(qdl + j * 264 + c8) = rq[i]; *(u32x4*)(kdl + j * 264 + c8) = rk[i]; }
        *(u32x4*)(vl + vrow * 72 + vc8) = rv; if (tid < 256) dl[tid] = rd;
        __syncthreads();
        if (n + 1 < nch) GLA_ISSUE(n + 1);
        float oi[2][4];
#pragma unroll
        for (int q2 = 0; q2 < 2; ++q2)
#pragma unroll
            for (int r = 0; r < 4; ++r) { const int j = tt * 16 + quad * 4 + r; const size_t tok = (size_t)cidx * 64 + (dir ? 63 - j : j); oi[q2][r] = bf2f(O[tok * DM + (vb + q2) * 16 + l15]); }
        f32x4 oacc[2]; oacc[0] = (f32x4){0.f, 0.f, 0.f, 0.f}; oacc[1] = oacc[0];
#pragma unroll
        for (int ks = 0; ks < 8; ++ks) { const bf16x8 a = *(const bf16x8*)(qdl + (tt * 16 + l15) * 264 + ks * 32 + quad * 8);
#pragma unroll
            for (int q2 = 0; q2 < 2; ++q2) { const bf16x8 bfr = *(const bf16x8*)(ST + ((vb + q2) * 16 + l15) * 264 + ks * 32 + quad * 8); oacc[q2] = mfma16(a, bfr, oacc[q2]); } }
#pragma unroll
        for (int kt = 0; kt < 2; ++kt) { const f32x4 dv = *(const f32x4*)(dl + wid * 32 + kt * 16 + quad * 4);
#pragma unroll
            for (int vt = 0; vt < 4; ++vt) S[kt][vt] = S[kt][vt] * dv; }
#pragma unroll
        for (int ts = 0; ts < 2; ++ts) { bf16x8 af[2];
#pragma unroll
            for (int kt = 0; kt < 2; ++kt)
#pragma unroll
                for (int jj = 0; jj < 8; ++jj) af[kt][jj] = (short)kdl[(ts * 32 + quad * 8 + jj) * 264 + wid * 32 + kt * 16 + l15];
#pragma unroll
            for (int vt = 0; vt < 4; ++vt) { bf16x8 bfr;
#pragma unroll
                for (int jj = 0; jj < 8; ++jj) bfr[jj] = (short)vl[(ts * 32 + quad * 8 + jj) * 72 + vt * 16 + l15];
#pragma unroll
                for (int kt = 0; kt < 2; ++kt) S[kt][vt] = mfma16(af[kt], bfr, S[kt][vt]); } }
#pragma unroll
        for (int q2 = 0; q2 < 2; ++q2)
#pragma unroll
            for (int r = 0; r < 4; ++r) { const int j = tt * 16 + quad * 4 + r; const size_t tok = (size_t)cidx * 64 + (dir ? 63 - j : j); O[tok * DM + (vb + q2) * 16 + l15] = f2bf(oi[q2][r] + oacc[q2][r]); }
        __syncthreads();
        GLA_WRITE_ST();
        __syncthreads();
    }
#undef GLA_ISSUE
#undef GLA_WRITE_ST
    if (!sample) { float* so = p.out + OUT_GLAST + sbase;
#pragma unroll
        for (int kt = 0; kt < 2; ++kt)
#pragma unroll
            for (int vt = 0; vt < 4; ++vt)
#pragma unroll
                for (int r = 0; r < 4; ++r) { const int kk = wid * 32 + kt * 16 + quad * 4 + r; so[(size_t)kk * 512 + vt * 16 + l15] = S[kt][vt][r]; } }
    __syncthreads();
}
DEV void phase_gla_post(const Params& p) {
    const int tid = tidx(), wid = tid >> 6, lane = tid & 63;
    const u16* P = (const u16*)(p.ws + OFF_P); const u16* OF = (const u16*)(p.ws + OFF_OF); const u16* OB = (const u16*)(p.ws + OFF_OB); u16* ycat = (u16*)(p.ws + OFF_A);
    for (int it = blockIdx.x * 8 + wid; it < NTOK * 4; it += gridDim.x * 8) { const int tok = it >> 2, h = it & 3; const int v8 = lane * 8;
        float a[8], b[8], g[8]; unpack8(*(const u32x4*)(OF + (size_t)tok * DM + h * 512 + v8), a); unpack8(*(const u32x4*)(OB + (size_t)tok * DM + h * 512 + v8), b);
        unpack8(*(const u32x4*)(P + (size_t)tok * LDP1 + 4096 + h * 512 + v8), g);
        float ss = 0.f;
#pragma unroll
        for (int i = 0; i < 8; ++i) { a[i] += b[i]; ss += a[i] * a[i]; }
        ss = wave_sum(ss); const float sc = rsqrtf(ss * (1.f / 512.f) + 1e-6f);
        float o[8];
#pragma unroll
        for (int i = 0; i < 8; ++i) o[i] = a[i] * sc * p.in[40][v8 + i] * (g[i] * sigm(g[i]));
        u32x4 w; w.x = pk(o[0], o[1]); w.y = pk(o[2], o[3]); w.z = pk(o[4], o[5]); w.w = pk(o[6], o[7]);
        *(u32x4*)(ycat + (size_t)tok * DM + h * 512 + v8) = w; }
}

DEV void gate_loadcol(const u16* U, long tokc, int c8, bool colok, bool up, bool dn, int W, float (*dst)[8]) {
    if (colok && up) unpack8(*(const u32x4*)(U + (size_t)(tokc - W) * LDU + c8), dst[0]); else { for (int i = 0; i < 8; ++i) dst[0][i] = 0.f; }
    if (colok) unpack8(*(const u32x4*)(U + (size_t)tokc * LDU + c8), dst[1]); else { for (int i = 0; i < 8; ++i) dst[1][i] = 0.f; }
    if (colok && dn) unpack8(*(const u32x4*)(U + (size_t)(tokc + W) * LDU + c8), dst[2]); else { for (int i = 0; i < 8; ++i) dst[2][i] = 0.f; }
}
DEV void phase_ffn_gate(const Params& p, int layer) {
    u16* U = (u16*)(p.ws + OFF_U); const float* cw = p.in[11] + (size_t)layer * 9 * DFF;
    const int nunit = 768 * 704;
    for (int u = blockIdx.x * 512 + tidx(); u < nunit; u += gridDim.x * 512) {
        const int seg = u / 704, c8 = (u % 704) * 8; const int tokS = seg * 32;
        int W, colS; bool up, dn;
        if (tokS < NTP) { W = 256; colS = tokS & 255; up = false; dn = false; }
        else { W = 64; colS = tokS & 63; const int rr = ((tokS - NTP) >> 6) & 63; up = rr > 0; dn = rr < 63; }
        float wt[9][8];
#pragma unroll
        for (int q = 0; q < 9; ++q) { const float4 a = *(const float4*)(cw + q * DFF + c8), b = *(const float4*)(cw + q * DFF + c8 + 4);
            wt[q][0] = a.x; wt[q][1] = a.y; wt[q][2] = a.z; wt[q][3] = a.w; wt[q][4] = b.x; wt[q][5] = b.y; wt[q][6] = b.z; wt[q][7] = b.w; }
        float w0[3][8], w1[3][8], w2[3][8];
        gate_loadcol(U, (long)tokS - 1, c8, colS > 0, up, dn, W, w0);
        gate_loadcol(U, (long)tokS, c8, true, up, dn, W, w1);
#pragma unroll 8
        for (int s_ = 0; s_ < 32; ++s_) {
            const long tok = (long)tokS + s_;
            gate_loadcol(U, tok + 1, c8, colS + s_ + 1 < W, up, dn, W, w2);
            u16* vp = U + (size_t)tok * LDU + DFF + c8; float v[8]; unpack8(*(const u32x4*)vp, v);
#pragma unroll
            for (int i = 0; i < 8; ++i) { float a = 0.f;
#pragma unroll
                for (int di = 0; di < 3; ++di) a += w0[di][i] * wt[di * 3][i] + w1[di][i] * wt[di * 3 + 1][i] + w2[di][i] * wt[di * 3 + 2][i];
                v[i] *= a * sigm(a); }
            u32x4 w; w.x = pk(v[0], v[1]); w.y = pk(v[2], v[3]); w.z = pk(v[4], v[5]); w.w = pk(v[6], v[7]);
            *(u32x4*)vp = w;
#pragma unroll
            for (int di = 0; di < 3; ++di)
#pragma unroll
                for (int i = 0; i < 8; ++i) { w0[di][i] = w1[di][i]; w1[di][i] = w2[di][i]; }
        }
    }
}

DEV void phase_final_norm(const Params& p) {
    const int tid = tidx(), wid = tid >> 6, lane = tid & 63; const float* g = p.in[13];
    for (int row = blockIdx.x * 8 + wid; row < NTOK; row += gridDim.x * 8) {
        float4* xr = (float4*)(p.out + (size_t)row * DM);
        float4 v[8]; float ss = 0.f;
#pragma unroll
        for (int j = 0; j < 8; ++j) { v[j] = xr[lane + 64 * j]; ss += v[j].x * v[j].x + v[j].y * v[j].y + v[j].z * v[j].z + v[j].w * v[j].w; }
        ss = wave_sum(ss); const float rstd = rsqrtf(ss * (1.f / 2048.f) + 1e-6f);
#pragma unroll
        for (int j = 0; j < 8; ++j) { const float4 gg = *(const float4*)(g + (lane + 64 * j) * 4);
            xr[lane + 64 * j] = make_float4(v[j].x * rstd * gg.x, v[j].y * rstd * gg.y, v[j].z * rstd * gg.z, v[j].w * rstd * gg.w); }
    }
}


#define XB_TMO      128
#define XB_XCNT(j)  (256  + 64 * (j))
#define XB_XSUB(j)  (1280 + 64 * (j))
#define XB_XGEN(j)  (2304 + 64 * (j))
#define XB_TOP      3328
#define XB_TOPGEN   3392
#define XCD_BAR_WORDS 3456
#define XB_SPIN_CAP (1u << 18)
DEV unsigned xb_ld(unsigned* p)              { return __hip_atomic_load(p, __ATOMIC_RELAXED, __HIP_MEMORY_SCOPE_AGENT); }
DEV unsigned xb_add(unsigned* p, unsigned v) { return __hip_atomic_fetch_add(p, v, __ATOMIC_RELAXED, __HIP_MEMORY_SCOPE_AGENT); }
DEV unsigned xb_xcc_id() { return (unsigned)__builtin_amdgcn_s_getreg((3 << 11) | 20) & 0xFu; }
#define XB_SPIN(cond, bar) do { unsigned _sp = 0; while (cond) { __builtin_amdgcn_s_sleep(1); \
    if ((++_sp & 255u) == 0u) { if (xb_ld(&(bar)[XB_TMO])) break; if (_sp > XB_SPIN_CAP) { atomicAdd(&(bar)[XB_TMO], 1u); break; } } } } while (0)
struct XcdBarrier { unsigned* bar; unsigned x; volatile LAS unsigned* st; };
DEV XcdBarrier xcd_barrier_post(unsigned* bar, volatile LAS unsigned* st) {
    XcdBarrier b; b.bar = bar; b.x = xb_xcc_id(); b.st = st;
    if (threadIdx.x == 0) (void)xb_add(&bar[XB_XCNT(b.x)], 1u);
    return b;
}
DEV void xcd_barrier_complete(unsigned* bar, unsigned x, unsigned& nloc, unsigned& nx) {
    const unsigned G = gridDim.x * gridDim.y * gridDim.z;
    unsigned sum, cnt, mine, sp = 0u;
    for (;;) {
        sum = 0u; cnt = 0u; mine = 0u;
#pragma unroll
        for (unsigned j = 0; j < 16; ++j) { const unsigned c = xb_ld(&bar[XB_XCNT(j)]); sum += c; cnt += (c > 0u) ? 1u : 0u; mine = (j == x) ? c : mine; }
        if (sum == G) break;
        __builtin_amdgcn_s_sleep(1);
        if ((++sp & 255u) == 0u) { if (xb_ld(&bar[XB_TMO])) break; if (sp > XB_SPIN_CAP) { atomicAdd(&bar[XB_TMO], 1u); break; } }
    }
    nloc = mine > 0u ? mine : 1u; nx = cnt > 0u ? cnt : 1u;
}
DEV void xcd_barrier(const XcdBarrier& b) {
    asm volatile("s_waitcnt vmcnt(0)" ::: "memory");
    __syncthreads();
    if (threadIdx.x == 0) {
        unsigned* bar = b.bar;
        __builtin_amdgcn_s_waitcnt(0);
        unsigned nloc = b.st[0], nx = b.st[1];
        if (nloc == 0u) { xcd_barrier_complete(bar, b.x, nloc, nx); b.st[0] = nloc; b.st[1] = nx; }
        const unsigned old = xb_add(&bar[XB_XSUB(b.x)], 1u);
        const unsigned gen = old / nloc;
        if (old + 1u == (gen + 1u) * nloc) {
            __builtin_amdgcn_fence(__ATOMIC_RELEASE, "agent");
            asm volatile("s_waitcnt vmcnt(0)" ::: "memory");
            const unsigned og = xb_add(&bar[XB_TOP], 1u);
            const unsigned tg = og / nx;
            if (og + 1u == (tg + 1u) * nx) xb_add(&bar[XB_TOPGEN], 1u);
            else XB_SPIN(xb_ld(&bar[XB_TOPGEN]) == tg, bar);
            __builtin_amdgcn_fence(__ATOMIC_ACQUIRE, "agent");
            xb_add(&bar[XB_XGEN(b.x)], 1u);
            asm volatile("s_waitcnt vmcnt(0)" ::: "memory");
        } else {
            XB_SPIN(xb_ld(&bar[XB_XGEN(b.x)]) == gen, bar);
            __builtin_amdgcn_fence(__ATOMIC_ACQUIRE, "agent");
            asm volatile("s_waitcnt vmcnt(0)" ::: "memory");
        }
    }
    __syncthreads();
}

__global__ void __launch_bounds__(512, 2) mega(Params p0) {
    extern __shared__ __attribute__((aligned(16))) unsigned char shm[];
    cg::grid_group grid = cg::this_grid();
    __shared__ uint4 xb_words;
    if (threadIdx.x == 0) xb_words = make_uint4(0u, 0u, 0u, 0u);
    __syncthreads();
    (void)xcd_barrier_post((unsigned*)(p0.ws + OFF_SMALL + SMALL_BYTES + 256), (volatile LAS unsigned*)&xb_words);
#define XBAR() do { XcdBarrier xb_; xb_.bar = (unsigned*)(launder(p0).ws + OFF_SMALL + SMALL_BYTES + 256); xb_.x = xb_xcc_id(); xb_.st = (volatile LAS unsigned*)&xb_words; xcd_barrier(xb_); } while (0)
    float* sm = (float*)shm;
    const int G = (int)gridDim.x, B = (int)blockIdx.x;

#ifndef SK_PREP
    phase_prep(launder(p0), shm);
#ifdef PROBE_MISC
    __syncthreads(); phase_prep(launder(p0), shm);
#endif
#endif
    grid.sync();
    phase_reduce(launder(p0));
    XBAR();
#pragma unroll 1
    for (int layer = 0; layer < 2; ++layer) {
#ifndef SK_NORM
        phase_norm(launder(p0), layer, 0, shm);
#ifdef PROBE_MISC
        __syncthreads(); phase_norm(launder(p0), layer, 0, shm);
#endif
#endif
        XBAR();
        { const Params p = launder(p0); const u16* A = (const u16*)(p.ws + OFF_A); pg8::EpiBf16 E; E.O = (u16*)(p.ws + OFF_P); E.ldc = layer ? LDP1 : LDP0;
#if !defined(SK_GEMM) && !defined(SK_GBF)
            run_gemm(shm, A, DM, (const u16*)(p.ws + OFF_WIN), DM, layer ? LDP1 : LDP0, DM, E);
#ifdef PROBE_GEMM
            __syncthreads(); run_gemm(shm, A, DM, (const u16*)(p.ws + OFF_WIN), DM, layer ? LDP1 : LDP0, DM, E);
#endif
#endif
        }
        XBAR();
        if (layer == 0) {
#ifndef SK_PRE
            { const Params p = launder(p0); for (int t = B; t < 6144 + 768; t += G) { if (t < 6144) hy_pre_tile(p, t, sm); else rwkv_lora_tile(p, t - 6144, shm); } }
#ifdef PROBE_MISC
            { const Params p = launder(p0); for (int t = B; t < 6144 + 768; t += G) { if (t < 6144) hy_pre_tile(p, t, sm); else rwkv_lora_tile(p, t - 6144, shm); } }
#endif
#endif
            XBAR();
            { const Params p = launder(p0); unsigned* ctr = (unsigned*)(p.ws + OFF_SMALL + SMALL_BYTES);
                if (B < 128) rwkv_scan_task(p, B, sm);
                for (;;) { if (tidx() == 0) *(volatile unsigned*)shm = atomicAdd(ctr, 1u); __syncthreads(); const unsigned t = *(volatile unsigned*)shm; __syncthreads();
                    if (t >= 1024u + 2048u) break;
                    if (t < 1024u) rwkv_scan_task(p, 128 + (int)t, sm); else hyconv_task(p, (int)t - 1024, shm); } }
            XBAR();
#ifndef SK_POST
            { const Params p = launder(p0); for (int t = B; t < 6144 + 768; t += G) { if (t < 6144) hy_post_tile(p, t, sm); else rwkv_post_tile(p, t - 6144, sm); } }
#ifdef PROBE_MISC
            { const Params p = launder(p0); for (int t = B; t < 6144 + 768; t += G) { if (t < 6144) hy_post_tile(p, t, sm); else rwkv_post_tile(p, t - 6144, sm); } }
#endif
#endif
            XBAR();
        } else {
#ifndef SK_GLA
            { const Params p = launder(p0); for (int t = B; t < 1536; t += G) gla_intra_task(p, t, shm); }
            XBAR();
            { const Params p = launder(p0); for (int t = B; t < 256 + 2048; t += G) gla_inter_task(p, t, shm); }
#endif
            XBAR();
#ifndef SK_GLAP
            phase_gla_post(launder(p0));
#ifdef PROBE_MISC
            phase_gla_post(launder(p0));
#endif
#endif
            XBAR();
        }
        { const Params p = launder(p0); const u16* A = (const u16*)(p.ws + OFF_A); const float* mods = (const float*)(p.ws + OFF_SMALL); pg8::EpiRes E; E.X = p.out; E.gm = mods + (size_t)layer * 5 * 12288 + 2 * 2048; E.gb = p.in[7] + layer * 12288 + 2 * 2048;
#if !defined(SK_GEMM) && !defined(SK_GRES)
            run_gemm(shm, A, DM, (const u16*)(p.ws + OFF_WOUT), DM, DM, DM, E);
#endif
        }
        XBAR();
#ifndef SK_NORM
        phase_norm(launder(p0), layer, 1, shm);
#ifdef PROBE_MISC
        __syncthreads(); phase_norm(launder(p0), layer, 1, shm);
#endif
#endif
        XBAR();
        { const Params p = launder(p0); const u16* A = (const u16*)(p.ws + OFF_A); pg8::EpiBf16 E; E.O = (u16*)(p.ws + OFF_U); E.ldc = LDU;
#if !defined(SK_GEMM) && !defined(SK_GBF)
            run_gemm(shm, A, DM, (const u16*)(p.ws + OFF_WUP), DM, LDU, DM, E);
#ifdef PROBE_GEMM
            __syncthreads(); run_gemm(shm, A, DM, (const u16*)(p.ws + OFF_WUP), DM, LDU, DM, E);
#endif
#endif
        }
        XBAR();
#ifndef SK_GATE
        phase_ffn_gate(launder(p0), layer);
#endif
        XBAR();
        { const Params p = launder(p0); const float* mods = (const float*)(p.ws + OFF_SMALL); pg8::EpiRes E; E.X = p.out; E.gm = mods + (size_t)layer * 5 * 12288 + 5 * 2048; E.gb = p.in[7] + layer * 12288 + 5 * 2048;
#if !defined(SK_GEMM) && !defined(SK_GRES)
            run_gemm(shm, (const u16*)(p.ws + OFF_U) + DFF, LDU, (const u16*)(p.ws + OFF_WDN), DFF, DM, DFF, E);
#endif
        }
        XBAR();
    }
    phase_final_norm(launder(p0));
}

extern "C" void kernel_launch(void* const* d_in, const int* in_sizes, int n_in, void* d_out, int out_size, void* d_ws, size_t ws_size, hipStream_t stream) {
    constexpr size_t kDynLds = 131072;
    static int grid_blocks = 0;
    if (!grid_blocks) {
        int dev = 0, cus = 0, per_cu = 0;
        hipGetDevice(&dev);
        hipDeviceGetAttribute(&cus, hipDeviceAttributeMultiprocessorCount, dev);
        hipFuncSetAttribute((const void*)mega, hipFuncAttributeMaxDynamicSharedMemorySize, (int)kDynLds);
        hipOccupancyMaxActiveBlocksPerMultiprocessor(&per_cu, mega, 512, kDynLds);
        if (per_cu < 1) per_cu = 1;
        grid_blocks = cus * per_cu;
        if (grid_blocks > 256) grid_blocks = 256;
    }
    if (ws_size < WS_NEED || n_in < 41) { fprintf(stderr, "workspace too small: %zu < %zu\n", ws_size, WS_NEED); return; }
    Params p{};
    for (int i = 0; i < 41; ++i) p.in[i] = (const float*)d_in[i];
    p.out = (float*)d_out; p.ws = (unsigned char*)d_ws;
    hipMemsetAsync((unsigned char*)d_ws + OFF_SMALL + SMALL_BYTES, 0, 256 + XCD_BAR_BYTES, stream);
    void* args[] = {&p};
    hipError_t e = hipLaunchCooperativeKernel((const void*)mega, dim3(grid_blocks), dim3(512), args, kDynLds, stream);
    if (e != hipSuccess) fprintf(stderr, "cooperative launch failed: %s (grid %d)\n", hipGetErrorString(e), grid_blocks);
}
```

```cpp
#include <hip/hip_runtime.h>
#include <hip/hip_cooperative_groups.h>
#include <cstdio>
namespace cg = cooperative_groups;

#define DEV __device__ __forceinline__
#define LAS __attribute__((address_space(3)))
typedef unsigned short u16;
typedef short bf16x8 __attribute__((ext_vector_type(8)));
typedef float f32x4 __attribute__((ext_vector_type(4)));
typedef float f32x2 __attribute__((ext_vector_type(2)));
typedef float f32x16 __attribute__((ext_vector_type(16)));
typedef unsigned u32x2 __attribute__((ext_vector_type(2)));
typedef unsigned u32x4 __attribute__((ext_vector_type(4)));

constexpr int NTOK = 24576, NTP = 8192, DM = 2048;
constexpr int LDP0 = 6656, LDP1 = 6400, LDU = 11264, DFF = 5632;
constexpr size_t OFF_WIN = 0, OFF_WOUT = 27262976, OFF_WUP = 35651584, OFF_WDN = OFF_WUP + 46137344;
constexpr size_t OFF_A = 104857600, OFF_BIG = 205520896;
constexpr size_t OFF_P = OFF_BIG, OFF_RW = OFF_BIG + 327155712, OFF_UT = OFF_RW + 201326592, OFF_GS = OFF_UT + 50331648, OFF_GP = OFF_GS + 16777216;
constexpr size_t OFF_U = OFF_BIG, OFF_OF = OFF_BIG + 314572800, OFF_OB = OFF_OF + 100663296, OFF_DB = OFF_OB + 100663296;
constexpr size_t OFF_SMALL = OFF_BIG + 600000000, SMALL_BYTES = 491520 + 8192;
constexpr size_t XCD_BAR_BYTES = 3456 * 4;
constexpr size_t OFF_LW = OFF_SMALL + SMALL_BYTES + 256 + XCD_BAR_BYTES;
constexpr size_t OFF_G2T = OFF_LW + 524288;
constexpr size_t WS_NEED = OFF_G2T + 262144;
constexpr size_t OUT_RWST = 50331648, OUT_GLAST = 54525952;

struct Params {
    const float* in[41];
    float* out;
    unsigned char* ws;
};

DEV int tidx() { int t = threadIdx.x; asm volatile("" : "+v"(t)); return t; }
DEV Params launder(const Params& p) { Params q = p; asm volatile("" : "+s"(q.ws), "+s"(q.out)); return q; }
DEV float bf2f(unsigned b) { return __uint_as_float(b << 16); }
DEV float bflo(unsigned w) { return __uint_as_float(w << 16); }
DEV float bfhi(unsigned w) { return __uint_as_float(w & 0xffff0000u); }
DEV unsigned pk(float lo, float hi) { unsigned r; asm("v_cvt_pk_bf16_f32 %0, %1, %2" : "=v"(r) : "v"(lo), "v"(hi)); return r; }
DEV u16 f2bf(float f) { return (u16)(pk(f, 0.f) & 0xffffu); }
DEV float wave_sum(float v) {
#pragma unroll
    for (int o = 32; o > 0; o >>= 1) v += __shfl_xor(v, o);
    return v;
}
template <int CTRL> DEV float dppf(float x) { return __builtin_bit_cast(float, __builtin_amdgcn_update_dpp(0, __builtin_bit_cast(int, x), CTRL, 0xf, 0xf, true)); }
DEV float sum8(float v) { v += dppf<0xB1>(v); v += dppf<0x4E>(v); v += dppf<0x141>(v); return v; }
DEV float sum16(float v) { v = sum8(v); v += dppf<0x140>(v); return v; }
DEV f32x4 mfma16(bf16x8 a, bf16x8 b, f32x4 c) { return __builtin_amdgcn_mfma_f32_16x16x32_bf16(a, b, c, 0, 0, 0); }
DEV float sigm(float x) { return __builtin_amdgcn_rcpf(1.f + __expf(-x)); }
DEV int tok_cond(int tok) { return tok < NTP ? 4 : ((tok - NTP) >> 12); }
DEV void tok_tl(int tok, int& t, int& L) { if (tok < NTP) { t = tok & 255; L = 256; } else { t = (tok - NTP) & 4095; L = 4096; } }
DEV void unpack8(u32x4 w, float* o) { o[0] = bflo(w.x); o[1] = bfhi(w.x); o[2] = bflo(w.y); o[3] = bfhi(w.y); o[4] = bflo(w.z); o[5] = bfhi(w.z); o[6] = bflo(w.w); o[7] = bfhi(w.w); }
DEV void unpack4(u32x2 w, float* o) { o[0] = bflo(w.x); o[1] = bfhi(w.x); o[2] = bflo(w.y); o[3] = bfhi(w.y); }

namespace pg8 {
constexpr int BM = 256, BK = 64, HALF = 128, HTB = HALF * BK * 2, NXCD = 8, WGM = 8;
DEV int lds_byte(int r, int c) { const int st = (r >> 4) * 2 + (c >> 5), rr = r & 15, cc = c & 31, ob = rr * 64 + cc * 2; return st * 1024 + (ob ^ (((ob >> 9) & 1) << 5)); }
DEV void stage_rc(int b, int& R, int& C) { const int st = b / 1024, sb = b % 1024, swz = sb ^ (((sb >> 9) & 1) << 5); R = (st >> 1) * 16 + swz / 64; C = (st & 1) * 32 + (swz % 64) / 2; }
DEV int perm32(int rho) { const int n = rho >> 4, i = rho & 15; return 8 * (i >> 2) + 4 * n + (i & 3); }
struct Unit { int pm, pn; };
struct Gemm { const u16* A; const u16* Bt; int M, N, K, lda, ldb; };
struct StaticOrder {
    int nM, nN, nwg, G, c;
    DEV void init(int M, int N, int G_, int c_) { nM = M / BM; nN = N / BM; nwg = nM * nN; G = G_; c = c_; }
    DEV bool next(int i, Unit& u) const {
        const long L = (long)i * G + c; if (L >= nwg) return false;
        int wgid = (int)L; { const int q = nwg / NXCD, r = nwg % NXCD, xcd = wgid % NXCD, off = wgid / NXCD; wgid = (xcd < r ? xcd * (q + 1) : r * (q + 1) + (xcd - r) * q) + off; }
        const int nig = WGM * nN, gid = wgid / nig, fm = gid * WGM, gsz = (nM - fm) < WGM ? (nM - fm) : WGM;
        u.pm = fm + ((wgid % nig) % gsz); u.pn = (wgid % nig) / gsz; return true;
    }
};
struct EpiBf16 {
    static constexpr bool PERM = true;
    u16* O; int ldc;
    DEV void operator()(const f32x4 (&acc)[2][2][4][2], const Unit& u, int wr, int wc, int fr, int fq) const {
        const int row0 = u.pm * BM + wr * 64 + fr; const int col0 = u.pn * BM + wc * 32 + 8 * fq;
#pragma unroll
        for (int ai = 0; ai < 2; ++ai)
#pragma unroll
            for (int m = 0; m < 4; ++m) { u16* rowp = O + (size_t)(row0 + ai * HALF + m * 16) * ldc + col0;
#pragma unroll
                for (int bj = 0; bj < 2; ++bj) { const f32x4 v0 = acc[ai][bj][m][0], v1 = acc[ai][bj][m][1];
                    u32x4 w; w.x = pk(v0[0], v0[1]); w.y = pk(v0[2], v0[3]); w.z = pk(v1[0], v1[1]); w.w = pk(v1[2], v1[3]);
                    *(u32x4*)(rowp + bj * HALF) = w; } }
    }
};
struct EpiRes {
    static constexpr bool PERM = false;
    float* X; const float* gm; const float* gb;
    DEV void operator()(const f32x4 (&acc)[2][2][4][2], const Unit& u, int wr, int wc, int fr, int fq) const {
        const int row0 = u.pm * BM + wr * 64 + fr, col0 = u.pn * BM + wc * 32 + 4 * fq;
        const int cond = u.pm < 32 ? 4 : ((u.pm - 32) >> 4);
        const float* gmc = gm + (size_t)cond * 12288 + col0; const float* gbc = gb + col0;
#pragma unroll
        for (int ai = 0; ai < 2; ++ai)
#pragma unroll
            for (int m = 0; m < 4; ++m) { float* rowp = X + (size_t)(row0 + ai * HALF + m * 16) * DM + col0;
#pragma unroll
                for (int bj = 0; bj < 2; ++bj) {
#pragma unroll
                    for (int n = 0; n < 2; ++n) { f32x4* q = (f32x4*)(rowp + bj * HALF + n * 16);
                        const f32x4 gvv = *(const f32x4*)(gmc + bj * HALF + n * 16) + *(const f32x4*)(gbc + bj * HALF + n * 16);
                        *q = *q + gvv * acc[ai][bj][m][n]; }
                    asm volatile("" ::: "memory"); } }
    }
};

template <class Epi>
DEV void gemm_phase(LAS unsigned char* lds, const Gemm g, const StaticOrder& S, const Epi& E) {
    const int tid = tidx(), wid = __builtin_amdgcn_readfirstlane(tid >> 6), lane = tid & 63, wr = wid >> 2, wc = wid & 3, fr = lane & 15, fq = lane >> 4;
    const int K = g.K, nt = K / BK;
    unsigned voffA[2], voffB[2];
#pragma unroll
    for (int i = 0; i < 2; ++i) { int R, C; stage_rc(tid * 16 + i * 8192, R, C); const int Rb = Epi::PERM ? ((R & ~31) + perm32(R & 31)) : R;
        voffA[i] = (unsigned)(R * g.lda + C) * 2u; voffB[i] = (unsigned)(Rb * g.ldb + C) * 2u; }
    const size_t kstep = (size_t)(BK * 2);
    const size_t hstepA = (size_t)HALF * g.lda * 2, hstepB = (size_t)HALF * g.ldb * 2;
    const size_t tstepA = 2 * hstepA, tstepB = 2 * hstepB;
    const unsigned ldsw = (unsigned)wid * 1024u;
    const int aoff = lds_byte(wr * 64 + fr, fq * 8), boff = lds_byte(wc * 32 + fr, fq * 8);
#define PG8_SA(b, h) (((b) * 2 + (h)) * HTB)
#define PG8_SB(b, h) ((4 + (b) * 2 + (h)) * HTB)
#define PG8_STAGE(bufoff, gbase, voff) do { _Pragma("unroll") for (int _i = 0; _i < 2; ++_i) \
        __builtin_amdgcn_global_load_lds((const unsigned*)((const char*)(gbase) + (voff)[_i]), (LAS unsigned*)(lds + (bufoff) + ldsw + _i * 8192), 16, 0, 0); } while (0)
#define PG8_LDA(dst, b, h) do { _Pragma("unroll") for (int m = 0; m < 4; ++m) _Pragma("unroll") for (int k = 0; k < 2; ++k) dst[m][k] = *(const LAS bf16x8*)(lds + PG8_SA(b, h) + aoff + m * 2048 + k * 1024); } while (0)
#define PG8_LDB(dst, b, h) do { _Pragma("unroll") for (int n = 0; n < 2; ++n) _Pragma("unroll") for (int k = 0; k < 2; ++k) dst[n][k] = *(const LAS bf16x8*)(lds + PG8_SB(b, h) + boff + n * 2048 + k * 1024); } while (0)
#define PG8_MMA(ai, bj, At, Bt) do { __builtin_amdgcn_s_setprio(1); _Pragma("unroll") for (int m = 0; m < 4; ++m) _Pragma("unroll") for (int n = 0; n < 2; ++n) _Pragma("unroll") for (int k = 0; k < 2; ++k) \
        acc[ai][bj][m][n] = __builtin_amdgcn_mfma_f32_16x16x32_bf16(Bt[n][k], At[m][k], acc[ai][bj][m][n], 0, 0, 0); __builtin_amdgcn_s_setprio(0); } while (0)
#define PG8_WAIT_V(n) asm volatile("s_waitcnt vmcnt(" #n ")" ::: "memory")
#define PG8_WAIT_L(n) asm volatile("s_waitcnt lgkmcnt(" #n ")" ::: "memory")
#define PG8_BAR __builtin_amdgcn_s_barrier()
#define PG8_SCHED __builtin_amdgcn_sched_barrier(0)
    Unit cur, nxt; int ui = 0;
    if (!S.next(0, cur)) return;
    f32x4 acc[2][2][4][2];
#pragma unroll
    for (int a = 0; a < 2; ++a)
#pragma unroll
        for (int b = 0; b < 2; ++b)
#pragma unroll
            for (int m = 0; m < 4; ++m)
#pragma unroll
                for (int n = 0; n < 2; ++n) acc[a][b][m][n] = (f32x4){0.f, 0.f, 0.f, 0.f};
    bf16x8 At[4][2], B0[2][2], B1[2][2];
    const char* cA = (const char*)g.A + (size_t)cur.pm * tstepA; const char* cB = (const char*)g.Bt + (size_t)cur.pn * tstepB;
    PG8_STAGE(PG8_SB(0, 0), cB, voffB); PG8_STAGE(PG8_SA(0, 0), cA, voffA); PG8_STAGE(PG8_SB(0, 1), cB + hstepB, voffB); PG8_STAGE(PG8_SA(0, 1), cA + hstepA, voffA);
    if (wr == 1) PG8_BAR;
    PG8_WAIT_V(4); PG8_BAR;
    PG8_STAGE(PG8_SB(1, 0), cB + kstep, voffB); PG8_STAGE(PG8_SA(1, 0), cA + kstep, voffA); PG8_STAGE(PG8_SB(1, 1), cB + hstepB + kstep, voffB);
    PG8_WAIT_V(6); PG8_BAR;
    for (;;) {
        const bool has_next = S.next(ui + 1, nxt);
        const char* nA = has_next ? (const char*)g.A + (size_t)nxt.pm * tstepA : cA; const char* nB = has_next ? (const char*)g.Bt + (size_t)nxt.pn * tstepB : cB;
        for (int t = 0; t < nt; t += 2) {
            const bool last = (t == nt - 2);
            const char* a1 = cA + (size_t)(t + 1) * kstep;
            const char* a2 = last ? nA : cA + (size_t)(t + 2) * kstep; const char* b2 = last ? nB : cB + (size_t)(t + 2) * kstep;
            const char* a3 = a2 + kstep; const char* b3 = b2 + kstep;
            PG8_LDB(B0, 0, 0); PG8_SCHED; PG8_LDA(At, 0, 0); PG8_STAGE(PG8_SA(1, 1), a1 + hstepA, voffA);
            PG8_WAIT_L(8); PG8_BAR; PG8_WAIT_L(0); PG8_MMA(0, 0, At, B0); PG8_BAR; PG8_SCHED;
            PG8_LDB(B1, 0, 1); PG8_STAGE(PG8_SB(0, 0), b2, voffB);
            PG8_BAR; PG8_WAIT_L(0); PG8_MMA(0, 1, At, B1); PG8_BAR;
            PG8_LDA(At, 0, 1); PG8_STAGE(PG8_SA(0, 0), a2, voffA);
            PG8_BAR; PG8_WAIT_L(0); PG8_MMA(1, 0, At, B0); PG8_BAR; PG8_SCHED;
            PG8_STAGE(PG8_SB(0, 1), b2 + hstepB, voffB);
            PG8_WAIT_V(6); PG8_BAR; PG8_MMA(1, 1, At, B1); PG8_BAR;
            PG8_LDB(B0, 1, 0); PG8_SCHED; PG8_LDA(At, 1, 0); PG8_STAGE(PG8_SA(0, 1), a2 + hstepA, voffA);
            PG8_WAIT_L(8); PG8_BAR; PG8_WAIT_L(0); PG8_MMA(0, 0, At, B0); PG8_BAR; PG8_SCHED;
            PG8_LDB(B1, 1, 1); PG8_STAGE(PG8_SB(1, 0), b3, voffB);
            PG8_BAR; PG8_WAIT_L(0); PG8_MMA(0, 1, At, B1); PG8_BAR;
            PG8_LDA(At, 1, 1); PG8_STAGE(PG8_SA(1, 0), a3, voffA);
            PG8_BAR; PG8_WAIT_L(0); PG8_MMA(1, 0, At, B0); PG8_BAR; PG8_SCHED;
            PG8_STAGE(PG8_SB(1, 1), b3 + hstepB, voffB);
            PG8_WAIT_V(6); PG8_BAR; PG8_MMA(1, 1, At, B1); PG8_BAR;
        }
        E(acc, cur, wr, wc, fr, fq);
        if (!has_next) break;
#pragma unroll
        for (int a = 0; a < 2; ++a)
#pragma unroll
            for (int b = 0; b < 2; ++b)
#pragma unroll
                for (int m = 0; m < 4; ++m)
#pragma unroll
                    for (int n = 0; n < 2; ++n) acc[a][b][m][n] = (f32x4){0.f, 0.f, 0.f, 0.f};
        cur = nxt; cA = nA; cB = nB; ++ui;
    }
    PG8_WAIT_V(0);
    if (wr == 0) PG8_BAR;
    PG8_BAR;
#undef PG8_SA
#undef PG8_SB
#undef PG8_STAGE
#undef PG8_LDA
#undef PG8_LDB
#undef PG8_MMA
#undef PG8_WAIT_V
#undef PG8_WAIT_L
#undef PG8_BAR
#undef PG8_SCHED
}
}

template <class Epi>
DEV void run_gemm(unsigned char* shm, const u16* A, int lda, const u16* Bt, int ldb, int N, int K, const Epi& E) {
    asm volatile("" : "+s"(A), "+s"(Bt));
    pg8::Gemm g; g.A = A; g.Bt = Bt; g.M = NTOK; g.N = N; g.K = K; g.lda = lda; g.ldb = ldb;
    pg8::StaticOrder S; S.init(NTOK, N, (int)gridDim.x, (int)blockIdx.x);
    pg8::gemm_phase<Epi>((LAS unsigned char*)shm, g, S, E);
}

DEV void convT_tile(const float* __restrict__ src, u16* __restrict__ dst, int K, int N, int Npad, int tile, float* T) {
    const int tid = tidx(); const int ntn = Npad >> 6; const int k0 = (tile / ntn) << 6, n0 = (tile % ntn) << 6;
#pragma unroll
    for (int j = 0; j < 2; ++j) { const int idx = tid + j * 512; const int r = idx >> 4, c4 = (idx & 15) << 2;
        float4 v = make_float4(0.f, 0.f, 0.f, 0.f); if (n0 + c4 < N) v = *(const float4*)(src + (size_t)(k0 + r) * N + n0 + c4);
        float* t = T + r * 65 + c4; t[0] = v.x; t[1] = v.y; t[2] = v.z; t[3] = v.w; }
    __syncthreads();
    { const int nn = tid >> 3, kq = (tid & 7) << 3; const float* t = T + kq * 65 + nn;
        u32x4 o; o.x = pk(t[0], t[65]); o.y = pk(t[130], t[195]); o.z = pk(t[260], t[325]); o.w = pk(t[390], t[455]);
        *(u32x4*)(dst + (size_t)(n0 + nn) * K + k0 + kq) = o; }
    __syncthreads();
}
DEV int conv_ntiles(int job, int layer) { return job == 0 ? (layer ? 3200 : 3328) : job == 1 ? 1024 : job == 2 ? 5632 : 2816; }
DEV void conv_job(const Params& p, int job, int layer, int tile, float* T) {
    if (job == 0) convT_tile(layer ? p.in[36] : p.in[14], (u16*)(p.ws + OFF_WIN), 2048, layer ? 6176 : 6528, layer ? LDP1 : LDP0, tile, T);
    else if (job == 1) convT_tile(layer ? p.in[37] : p.in[15], (u16*)(p.ws + OFF_WOUT), 2048, 2048, 2048, tile, T);
    else if (job == 2) convT_tile(p.in[10] + (size_t)layer * 2048 * 11264, (u16*)(p.ws + OFF_WUP), 2048, 11264, 11264, tile, T);
    else convT_tile(p.in[12] + (size_t)layer * 5632 * 2048, (u16*)(p.ws + OFF_WDN), 5632, 2048, 2048, tile, T);
}

DEV void adaln_tile(const Params& p, int tile, float* sl) {
    const int tid = tidx(); const int nt = tile % 6, kc = (tile / 6) & 31, layer = tile / 192;
    if (tid < 320) { const int j = tid >> 6, kk = tid & 63; const float cv = (j < 4) ? p.in[4][j * 2048 + kc * 64 + kk] : p.in[5][kc * 64 + kk]; sl[tid] = cv / (1.f + expf(-cv)); }
    __syncthreads();
    const float* w = p.in[6] + ((size_t)layer * 2048 + kc * 64) * 12288 + nt * 2048 + tid * 4;
    float acc[5][4];
#pragma unroll
    for (int j = 0; j < 5; ++j) { acc[j][0] = 0.f; acc[j][1] = 0.f; acc[j][2] = 0.f; acc[j][3] = 0.f; }
#pragma unroll 8
    for (int kk = 0; kk < 64; ++kk) { const float4 wv = *(const float4*)(w + (size_t)kk * 12288);
#pragma unroll
        for (int j = 0; j < 5; ++j) { const float s = sl[j * 64 + kk]; acc[j][0] += s * wv.x; acc[j][1] += s * wv.y; acc[j][2] += s * wv.z; acc[j][3] += s * wv.w; } }
    float* m = (float*)(p.ws + OFF_A) + (size_t)kc * 122880 + (size_t)layer * 5 * 12288 + nt * 2048 + tid * 4;
#pragma unroll
    for (int j = 0; j < 5; ++j) *(float4*)(m + j * 12288) = make_float4(acc[j][0], acc[j][1], acc[j][2], acc[j][3]);
    __syncthreads();
}

DEV void hyfilt_tile(const Params& p, int tile, float* sm) {
    const int tid = tidx();
    int L, p0; u16* G; float* nrm = (float*)(p.ws + OFF_A) + 32 * 122880 + (size_t)tile * 2048;
    if (tile < 128) { L = 4096; p0 = tile * 32; G = (u16*)(p.ws + OFF_GS); }
    else { L = 256; p0 = (tile - 128) * 32; G = (u16*)(p.ws + OFF_GP); }
    float* z = sm; float* h1 = sm + 32 * 33; float* h2 = h1 + 2048;
    const float cang = (float)(6.283185307179586 / (double)L);
    for (int i = tid; i < 32 * 33; i += 512) { const int pp = i / 33, e = i % 33; const float pos = (float)(p0 + pp); float val;
        if (e == 0) val = pos / (float)(L - 1);
        else { const int bi = (e - 1) & 15; const float fb = 1e-4f + (float)bi * ((15.f - 1e-4f) / 15.f); const float ang = (cang * pos) * fb; val = (e <= 16) ? cosf(ang) : -sinf(ang); }
        z[i] = val; }
    __syncthreads();
    for (int i = tid; i < 2048; i += 512) { const int pp = i >> 6, j = i & 63; float a = p.in[19][j];
        for (int e = 0; e < 33; ++e) a += z[pp * 33 + e] * p.in[18][e * 64 + j];
        h1[i] = sinf(p.in[23][j] * a); }
    __syncthreads();
    for (int i = tid; i < 2048; i += 512) { const int pp = i >> 6, j = i & 63; float a = p.in[21][j];
        for (int e = 0; e < 64; ++e) a += h1[pp * 64 + e] * p.in[20][e * 64 + j];
        h2[i] = sinf(p.in[23][64 + j] * a); }
    __syncthreads();
    const float dlo = 3.0701134573253946f, dhi = 15.350567286626973f;
    for (int q = 0; q < 4; ++q) { const int n = tid + 512 * q; const int c = n & 1023; const int back = n >> 10;
        float wcol[64];
#pragma unroll
        for (int e = 0; e < 64; ++e) wcol[e] = p.in[22][e * 2048 + n];
        const float delta = dlo + (dhi - dlo) * ((float)c / 1023.f);
        float asum = 0.f;
        for (int pp = 0; pp < 32; ++pp) { float a = 0.f;
#pragma unroll
            for (int e = 0; e < 64; ++e) a += h2[pp * 64 + e] * wcol[e];
            const int pos = p0 + pp; const float t = (float)pos / (float)(L - 1); a *= expf(-t * delta);
            if (!(back && pos == 0)) { asum += fabsf(a); const int lag = back ? -pos : pos; G[(size_t)c * (2 * L) + (L - lag)] = f2bf(a); } }
        nrm[n] = asum; }
    if (p0 == 0) for (int c = tid; c < 1024; c += 512) G[(size_t)c * (2 * L)] = 0;
    __syncthreads();
}

DEV void phase_prep(const Params& p, unsigned char* shm) {
    const int tid = tidx(); float* sm = (float*)shm;
    if (blockIdx.x == 0 && tid == 0) *(unsigned*)(p.ws + OFF_SMALL + SMALL_BYTES) = 0u;
    { u16* LW = (u16*)(p.ws + OFF_LW); u16* G2T = (u16*)(p.ws + OFF_G2T);
        for (int i = blockIdx.x * 512 + tid; i < 4 * 1024 * 64 + 1024 * 128; i += gridDim.x * 512) {
            if (i < 262144) { const int mi = i >> 16, n = (i >> 6) & 1023, r = i & 63; LW[i] = f2bf((mi < 2 ? p.in[27] : p.in[29])[((size_t)(mi & 1) * 64 + r) * 1024 + n]); }
            else { const int j = i - 262144; const int n = j >> 7, r = j & 127; G2T[j] = f2bf(p.in[30][(size_t)r * 1024 + n]); } } }
    const int n0 = 136, n1 = n0 + 384, n2 = n1 + 3328, n3 = n2 + 1024, n4 = n3 + 5632, n5 = n4 + 2816;
    for (int t = blockIdx.x; t < n5; t += gridDim.x) {
        if (t < n0) hyfilt_tile(p, t, sm);
        else if (t < n1) adaln_tile(p, t - n0, sm);
        else if (t < n2) conv_job(p, 0, 0, t - n1, sm);
        else if (t < n3) conv_job(p, 1, 0, t - n2, sm);
        else if (t < n4) conv_job(p, 2, 0, t - n3, sm);
        else conv_job(p, 3, 0, t - n4, sm);
    }
}

DEV void phase_reduce(const Params& p) {
    const float* part = (const float*)(p.ws + OFF_A); float* mods = (float*)(p.ws + OFF_SMALL); float* hn = (float*)(p.ws + OFF_SMALL + 491520);
    for (int i = blockIdx.x * 512 + tidx(); i < 122880 + 2048; i += gridDim.x * 512) {
        if (i < 122880) { float a = 0.f; for (int kc = 0; kc < 32; ++kc) a += part[(size_t)kc * 122880 + i]; mods[i] = a; }
        else { const int j = i - 122880; const int c = j & 1023; const float* hp = part + 32 * 122880; float a = 0.f;
            if (j < 1024) { for (int t = 0; t < 128; ++t) a += hp[(size_t)t * 2048 + c] + hp[(size_t)t * 2048 + 1024 + c]; }
            else { for (int t = 128; t < 136; ++t) a += hp[(size_t)t * 2048 + c] + hp[(size_t)t * 2048 + 1024 + c]; }
            hn[j] = a; }
    }
}

DEV void phase_norm(const Params& p, int layer, int which, unsigned char* shm) {
    const int tid = tidx(), wid = tid >> 6, lane = tid & 63;
    const float* g = p.in[which ? 9 : 8] + layer * 2048;
    const float* X = p.out; u16* A = (u16*)(p.ws + OFF_A);
    const float* mods = (const float*)(p.ws + OFF_SMALL) + (size_t)layer * 5 * 12288; const float* bb = p.in[7] + layer * 12288;
    const int shi = which ? 3 : 0;
    for (int row = blockIdx.x * 8 + wid; row < NTOK; row += gridDim.x * 8) {
        const bool first = (layer == 0 && which == 0);
        const float* xsrc = X + (size_t)row * DM; if (first) xsrc = row < NTP ? p.in[0] + (size_t)row * DM : p.in[1] + (size_t)(row - NTP) * DM;
        const float4* xr = (const float4*)xsrc;
        float4 v[8]; float ss = 0.f;
#pragma unroll
        for (int j = 0; j < 8; ++j) { v[j] = xr[lane + 64 * j]; ss += v[j].x * v[j].x + v[j].y * v[j].y + v[j].z * v[j].z + v[j].w * v[j].w; }
        if (first) {
#pragma unroll
            for (int j = 0; j < 8; ++j) ((float4*)(p.out + (size_t)row * DM))[lane + 64 * j] = v[j]; }
        ss = wave_sum(ss);
        const float rstd = rsqrtf(ss * (1.f / 2048.f) + 1e-6f);
        const float* md = mods + (size_t)tok_cond(row) * 12288;
#pragma unroll
        for (int j = 0; j < 8; ++j) { const int col = (lane + 64 * j) * 4;
            const float4 gg = *(const float4*)(g + col);
            const float4 s1 = *(const float4*)(md + shi * 2048 + col), s2 = *(const float4*)(bb + shi * 2048 + col);
            const float4 c1 = *(const float4*)(md + (shi + 1) * 2048 + col), c2 = *(const float4*)(bb + (shi + 1) * 2048 + col);
            const float o0 = v[j].x * rstd * gg.x * (1.f + c1.x + c2.x) + s1.x + s2.x;
            const float o1 = v[j].y * rstd * gg.y * (1.f + c1.y + c2.y) + s1.y + s2.y;
            const float o2 = v[j].z * rstd * gg.z * (1.f + c1.z + c2.z) + s1.z + s2.z;
            const float o3 = v[j].w * rstd * gg.w * (1.f + c1.w + c2.w) + s1.w + s2.w;
            u32x2 o; o.x = pk(o0, o1); o.y = pk(o2, o3);
            *(u32x2*)(A + (size_t)row * DM + col) = o; }
    }
    if (layer == 0 && which == 1) { const int na = conv_ntiles(0, 1), nb = na + conv_ntiles(1, 1);
        for (int t = blockIdx.x; t < nb; t += gridDim.x) { if (t < na) conv_job(p, 0, 1, t, (float*)shm); else conv_job(p, 1, 1, t - na, (float*)shm); } }
    if (layer == 1 && which == 0) { const int na = conv_ntiles(2, 1), nb = na + conv_ntiles(3, 1);
        for (int t = blockIdx.x; t < nb; t += gridDim.x) { if (t < na) conv_job(p, 2, 1, t, (float*)shm); else conv_job(p, 3, 1, t - na, (float*)shm); } }
}

DEV void sconv8(const u16* prow, bool hm, bool hp, const float* sw, const float* sb, int ch, float* o) {
    float c[8], m[8], q[8];
    unpack8(*(const u32x4*)(prow + ch), c);
    if (hm) unpack8(*(const u32x4*)(prow - LDP0 + ch), m); else { for (int i = 0; i < 8; ++i) m[i] = 0.f; }
    if (hp) unpack8(*(const u32x4*)(prow + LDP0 + ch), q); else { for (int i = 0; i < 8; ++i) q[i] = 0.f; }
#pragma unroll
    for (int i = 0; i < 8; ++i) o[i] = m[i] * sw[ch + i] + c[i] * sw[3072 + ch + i] + q[i] * sw[6144 + ch + i] + sb[ch + i];
}
DEV void hy_pre_tile(const Params& p, int tile, float* T) {
    const int tid = tidx(); const int tok0 = (tile >> 4) << 6, c0 = (tile & 15) << 6;
    const u16* P = (const u16*)(p.ws + OFF_P); u16* uT = (u16*)(p.ws + OFF_UT);
    { const int tk = tid >> 3, c8 = (tid & 7) << 3; const int tok = tok0 + tk; int t, L; tok_tl(tok, t, L);
        const u16* prow = P + (size_t)tok * LDP0; float x1[8], vv[8];
        sconv8(prow, t > 0, t < L - 1, p.in[16], p.in[17], 1024 + c0 + c8, x1);
        sconv8(prow, t > 0, t < L - 1, p.in[16], p.in[17], 2048 + c0 + c8, vv);
#pragma unroll
        for (int i = 0; i < 8; ++i) T[tk * 65 + c8 + i] = x1[i] * vv[i]; }
    __syncthreads();
    { const int ch = tid >> 3, t8 = (tid & 7) << 3; const float* t = T + t8 * 65 + ch;
        u32x4 o; o.x = pk(t[0], t[65]); o.y = pk(t[130], t[195]); o.z = pk(t[260], t[325]); o.w = pk(t[390], t[455]);
        *(u32x4*)(uT + (size_t)(c0 + ch) * NTOK + tok0 + t8) = o; }
    __syncthreads();
}
DEV void hy_post_tile(const Params& p, int tile, float* T) {
    const int tid = tidx(); const int tok0 = (tile >> 4) << 6, c0 = (tile & 15) << 6;
    const u16* P = (const u16*)(p.ws + OFF_P); const u16* uT = (const u16*)(p.ws + OFF_UT); u16* ycat = (u16*)(p.ws + OFF_A);
    { const int ch = tid >> 3, t8 = (tid & 7) << 3; float y[8]; unpack8(*(const u32x4*)(uT + (size_t)(c0 + ch) * NTOK + tok0 + t8), y);
#pragma unroll
        for (int i = 0; i < 8; ++i) T[(t8 + i) * 65 + ch] = y[i]; }
    __syncthreads();
    { const int tk = tid >> 3, c8 = (tid & 7) << 3; const int tok = tok0 + tk; int t, L; tok_tl(tok, t, L);
        const u16* prow = P + (size_t)tok * LDP0; float x0[8], x1[8], vv[8], o[8];
        sconv8(prow, t > 0, t < L - 1, p.in[16], p.in[17], c0 + c8, x0);
        sconv8(prow, t > 0, t < L - 1, p.in[16], p.in[17], 1024 + c0 + c8, x1);
        sconv8(prow, t > 0, t < L - 1, p.in[16], p.in[17], 2048 + c0 + c8, vv);
        const float* nrm = (const float*)(p.ws + OFF_SMALL + 491520) + (tok < NTP ? 1024 : 0);
#pragma unroll
        for (int i = 0; i < 8; ++i) { const int c = c0 + c8 + i; o[i] = x0[i] * (T[tk * 65 + c8 + i] * __builtin_amdgcn_rcpf(nrm[c]) + x1[i] * vv[i] * p.in[24][c]); }
        u32x4 w; w.x = pk(o[0], o[1]); w.y = pk(o[2], o[3]); w.z = pk(o[4], o[5]); w.w = pk(o[6], o[7]);
        *(u32x4*)(ycat + (size_t)tok * DM + c0 + c8) = w; }
    __syncthreads();
}
DEV void hyconv_task(const Params& p, int task, unsigned char* shm) {
    const int tid = tidx(), wid = tid >> 6, lane = tid & 63;
    const bool sample = task < 1024; const int c = sample ? task : task - 1024;
    const int L = sample ? 4096 : 256, NB = sample ? 4 : 32, lgNB = sample ? 2 : 5, LP = L + 8;
    u16* uL = (u16*)shm; u16* gL = uL + NB * LP; u16* gS = gL + 2 * L;
    const u16* G = sample ? (const u16*)(p.ws + OFF_GS) + (size_t)c * 8192 : (const u16*)(p.ws + OFF_GP) + (size_t)c * 512;
    u16* uT = (u16*)(p.ws + OFF_UT) + (size_t)c * NTOK + (sample ? NTP : 0);
    for (int i = tid * 8; i < NB * L; i += 4096) { const int b = i / L, s = i % L; *(u32x4*)(uL + b * LP + s) = *(const u32x4*)(uT + i); }
    for (int i = tid * 8; i < 2 * L; i += 4096) { const u32x4 w = *(const u32x4*)(G + i); *(u32x4*)(gL + i) = w;
        const unsigned nx = (i + 8 < 2 * L) ? (unsigned)G[i + 8] : 0u;
        u32x4 sft; sft.x = (w.x >> 16) | (w.y << 16); sft.y = (w.y >> 16) | (w.z << 16); sft.z = (w.z >> 16) | (w.w << 16); sft.w = (w.w >> 16) | (nx << 16);
        *(u32x4*)(gS + i) = sft; }
    __syncthreads();
    const int ntile = (NB * (L >> 5)) >> 5;
    const int npair = sample ? 8 : 8; const bool two = sample;
    const int r = lane & 31, half = lane >> 5;
    {
        const int ct0 = two ? 2 * wid : wid;
        const int colA = ct0 * 32 + r, colB = colA + 32;
        const int bA = colA & (NB - 1), iA = colA >> lgNB, bB = colB & (NB - 1), iB = colB >> lgNB; const int tA = iA * 32, tB = iB * 32;
        const int i_lo = (ct0 * 32) >> lgNB, i_hi = ((two ? ct0 + 1 : ct0) * 32 + 31) >> lgNB;
        const int d_lo = 32 * i_lo - (L - 16), d_hi = 32 * i_hi;
        f32x16 accA, accB;
#pragma unroll
        for (int j = 0; j < 16; ++j) { accA[j] = 0.f; accB[j] = 0.f; }
        const u16* ubA = uL + bA * LP + 8 * half; const u16* ubB = uL + bB * LP + 8 * half;
        const u16* gsel = (r & 1) ? gS : gL;
        const int qb = (L - r + 8 * half) & ~1;
#pragma unroll 4
        for (int dl = d_lo; dl <= d_hi; dl += 16) {
            const unsigned* gq = (const unsigned*)(gsel + (qb - dl));
            u32x4 aw; aw.x = gq[0]; aw.y = gq[1]; aw.z = gq[2]; aw.w = gq[3];
            const bf16x8 a = __builtin_bit_cast(bf16x8, aw);
            const int sA = tA - dl, sB = tB - dl;
            bf16x8 bvA = (bf16x8){0, 0, 0, 0, 0, 0, 0, 0}, bvB = bvA;
            if (sA >= 0 && sA <= L - 16) bvA = *(const bf16x8*)(ubA + sA);
            accA = __builtin_amdgcn_mfma_f32_32x32x16_bf16(a, bvA, accA, 0, 0, 0);
            if (two) { if (sB >= 0 && sB <= L - 16) bvB = *(const bf16x8*)(ubB + sB);
                accB = __builtin_amdgcn_mfma_f32_32x32x16_bf16(a, bvB, accB, 0, 0, 0); }
        }
#pragma unroll
        for (int g = 0; g < 4; ++g) { u32x2 w; w.x = pk(accA[4 * g], accA[4 * g + 1]); w.y = pk(accA[4 * g + 2], accA[4 * g + 3]);
            *(u32x2*)(uT + (size_t)bA * L + tA + 8 * g + 4 * half) = w; }
        if (two) {
#pragma unroll
            for (int g = 0; g < 4; ++g) { u32x2 w; w.x = pk(accB[4 * g], accB[4 * g + 1]); w.y = pk(accB[4 * g + 2], accB[4 * g + 3]);
                *(u32x2*)(uT + (size_t)bB * L + tB + 8 * g + 4 * half) = w; } }
    }
    (void)ntile; (void)npair;
    __syncthreads();
}

DEV void rwkv_lora_tile(const Params& p, int tile, unsigned char* shm) {
    const int tid = tidx(), wid = tid >> 6, lane = tid & 63, l15 = lane & 15, quad = lane >> 4; const int tok0 = tile * 32;
    const u16* P = (const u16*)(p.ws + OFF_P); u16* RW = (u16*)(p.ws + OFF_RW); const u16* LW = (const u16*)(p.ws + OFF_LW);
    u16* Ain = (u16*)shm;
    u16* Ol = (u16*)(shm + 18432);
    for (int i = tid; i < 32 * 256; i += 512) { const int tk = i >> 8, cc = i & 255; const int tok = tok0 + tk; int t, L; tok_tl(tok, t, L);
        const u16* pp = P + (size_t)tok * LDP0 + 6144 + cc; float x = bf2f(*pp); const float xm = t > 0 ? bf2f(pp[-LDP0]) : 0.f; const float xp = t < L - 1 ? bf2f(pp[LDP0]) : 0.f;
        const float mu = p.in[25][3072 + cc]; x = x + mu * (0.5f * (xm + xp) - x); if (cc < 128) x = tanhf(x);
        Ain[((cc >> 6) * 32 + tk) * 72 + (cc & 63)] = f2bf(x); }
    __syncthreads();
#pragma unroll 1
    for (int mi = 0; mi < 4; ++mi) {
        const float* bias = (mi < 2 ? p.in[26] : p.in[28]) + (mi & 1) * 1024;
        const float osc = mi < 2 ? 0.6065306597f : 1.f;
        bf16x8 af[2][2];
#pragma unroll
        for (int tt = 0; tt < 2; ++tt)
#pragma unroll
            for (int ks = 0; ks < 2; ++ks) af[tt][ks] = *(const bf16x8*)(Ain + (mi * 32 + tt * 16 + l15) * 72 + ks * 32 + quad * 8);
#pragma unroll 2
        for (int q = 0; q < 8; ++q) { const int nt = wid * 8 + q; const int n = nt * 16 + l15;
            const bf16x8 b0 = *(const bf16x8*)(LW + ((size_t)mi * 1024 + n) * 64 + quad * 8), b1 = *(const bf16x8*)(LW + ((size_t)mi * 1024 + n) * 64 + 32 + quad * 8);
            const float bs = bias[n];
#pragma unroll
            for (int tt = 0; tt < 2; ++tt) { f32x4 acc = (f32x4){0.f, 0.f, 0.f, 0.f}; acc = mfma16(af[tt][0], b0, acc); acc = mfma16(af[tt][1], b1, acc);
#pragma unroll
                for (int r = 0; r < 4; ++r) Ol[(tt * 16 + quad * 4 + r) * 1032 + n] = f2bf(osc * sigm(acc[r] + bs)); } }
        __syncthreads();
#pragma unroll
        for (int i = 0; i < 8; ++i) { const int piece = tid + 512 * i; const int tk = piece >> 7, c8 = (piece & 127) * 8;
            *(u32x4*)(RW + (size_t)(tok0 + tk) * 4096 + mi * 1024 + c8) = *(const u32x4*)(Ol + tk * 1032 + c8); }
        __syncthreads();
    }
}
DEV float mixf(float c, float m, float q, float mu) { return c + mu * (0.5f * (m + q) - c); }
DEV void rwkv_scan_task(const Params& p, int task, float* sm) {
    const bool sample = task < 128; const int tt_ = sample ? task : task - 128;
    const int b = tt_ >> 5, h = (tt_ >> 1) & 15, dir = tt_ & 1;
    const int L = sample ? 4096 : 256; const int tok0 = sample ? NTP + b * 4096 : b * 256;
    const int tid = tidx(), wid = tid >> 6, lane = tid & 63;
    const int kl = lane & 7;
    const int row2 = (wid & 3) * 16 + (lane >> 3) * 2;
    float S[8], T[8];
    const size_t so2 = ((((size_t)b * 2 + dir) * 16 + h) * 64 + row2) * 64 + kl * 8;
    if (sample) {
        const float4 a = *(const float4*)(p.in[2] + so2), c = *(const float4*)(p.in[2] + so2 + 4), d = *(const float4*)(p.in[2] + so2 + 64), e = *(const float4*)(p.in[2] + so2 + 68);
        S[0] = a.x; S[1] = a.y; S[2] = a.z; S[3] = a.w; S[4] = c.x; S[5] = c.y; S[6] = c.z; S[7] = c.w;
        T[0] = d.x; T[1] = d.y; T[2] = d.z; T[3] = d.w; T[4] = e.x; T[5] = e.y; T[6] = e.z; T[7] = e.w; }
    else {
#pragma unroll
        for (int i = 0; i < 8; ++i) { S[i] = 0.f; T[i] = 0.f; } }
    f32x2 S2[4], T2[4];
#pragma unroll
    for (int i = 0; i < 4; ++i) { S2[i] = (f32x2){S[2 * i], S[2 * i + 1]}; T2[i] = (f32x2){T[2 * i], T[2 * i + 1]}; }
    const int pk4 = (tid & 15) * 4; const int ch = h * 64 + pk4; const int plt = (tid & 255) >> 4;
    const float4 mur = *(const float4*)(p.in[25] + ch), muk = *(const float4*)(p.in[25] + 1024 + ch), muv = *(const float4*)(p.in[25] + 2048 + ch);
    const float4 kkw = *(const float4*)(p.in[31] + ch), kaw = *(const float4*)(p.in[32] + ch);
    const float murA[4] = {mur.x, mur.y, mur.z, mur.w}, mukA[4] = {muk.x, muk.y, muk.z, muk.w}, muvA[4] = {muv.x, muv.y, muv.z, muv.w};
    const float kkwA[4] = {kkw.x, kkw.y, kkw.z, kkw.w}, kawA[4] = {kaw.x, kaw.y, kaw.z, kaw.w};
    const u16* P = (const u16*)(p.ws + OFF_P); const u16* RW = (const u16*)(p.ws + OFF_RW);
    u16* Y = (u16*)(p.out + OUT_GLAST) + (dir ? (size_t)NTOK * 1024 : 0);
#define RW_PREP(c0_, buf_) do { float* vec_ = sm + (buf_) * 14336; float* vvs_ = vec_ + 10240; \
        _Pragma("unroll 1") for (int ps = 0; ps < 2; ++ps) { const int ptt = plt + 16 * ps; \
            const int t = dir ? (L - 1 - ((c0_) + ptt)) : ((c0_) + ptt); const size_t tok = (size_t)tok0 + t; \
            const u16* pr = P + tok * LDP0 + 3072 + ch; \
            float rc[4], kc[4], vc[4], rm[4], km[4], vm[4], rp[4], kp[4], vp[4], ee[4], aa[4]; \
            unpack4(*(const u32x2*)(pr), rc); unpack4(*(const u32x2*)(pr + 1024), kc); unpack4(*(const u32x2*)(pr + 2048), vc); \
            if (t > 0) { const u16* pm = P + (tok - 1) * LDP0 + 3072 + ch; unpack4(*(const u32x2*)(pm), rm); unpack4(*(const u32x2*)(pm + 1024), km); unpack4(*(const u32x2*)(pm + 2048), vm); } \
            else { for (int i = 0; i < 4; ++i) { rm[i] = 0.f; km[i] = 0.f; vm[i] = 0.f; } } \
            if (t < L - 1) { unpack4(*(const u32x2*)(pr + LDP0), rp); unpack4(*(const u32x2*)(pr + LDP0 + 1024), kp); unpack4(*(const u32x2*)(pr + LDP0 + 2048), vp); } \
            else { for (int i = 0; i < 4; ++i) { rp[i] = 0.f; kp[i] = 0.f; vp[i] = 0.f; } } \
            unpack4(*(const u32x2*)(RW + tok * 4096 + dir * 1024 + ch), ee); unpack4(*(const u32x2*)(RW + tok * 4096 + (2 + dir) * 1024 + ch), aa); \
            float r4[4], k4[4], v4[4], kr[4]; float ss = 0.f; \
            _Pragma("unroll") for (int i = 0; i < 4; ++i) { r4[i] = mixf(rc[i], rm[i], rp[i], murA[i]); k4[i] = mixf(kc[i], km[i], kp[i], mukA[i]); v4[i] = mixf(vc[i], vm[i], vp[i], muvA[i]); \
                kr[i] = k4[i] * kkwA[i]; ss += kr[i] * kr[i]; } \
            ss = sum16(ss); const float inv = rsqrtf(ss + 1e-12f); \
            float tkk[4], tw[4], tkka[4], tkd[4]; \
            _Pragma("unroll") for (int i = 0; i < 4; ++i) { tkk[i] = kr[i] * inv; tw[i] = __expf(-ee[i]); tkka[i] = tkk[i] * aa[i]; tkd[i] = k4[i] * (1.f + (aa[i] - 1.f) * kawA[i]); } \
            float* vj = vec_ + ptt * 320 + pk4; \
            *(float4*)(vj) = make_float4(tkk[0], tkk[1], tkk[2], tkk[3]); *(float4*)(vj + 64) = make_float4(tw[0], tw[1], tw[2], tw[3]); *(float4*)(vj + 128) = make_float4(tkka[0], tkka[1], tkka[2], tkka[3]); \
            *(float4*)(vj + 192) = make_float4(tkd[0], tkd[1], tkd[2], tkd[3]); *(float4*)(vj + 256) = make_float4(r4[0], r4[1], r4[2], r4[3]); \
            *(float4*)(vvs_ + ptt * 64 + pk4) = make_float4(v4[0], v4[1], v4[2], v4[3]); } } while (0)
#define RW_YOUT(c0_, buf_) do { const float* yb_ = sm + (buf_) * 14336 + 12288; \
        _Pragma("unroll 1") for (int ps = 0; ps < 2; ++ps) { const int ptt = plt + 16 * ps; const int t = dir ? (L - 1 - ((c0_) + ptt)) : ((c0_) + ptt); \
            const float4 yv = *(const float4*)(yb_ + ptt * 64 + pk4); u32x2 w; w.x = pk(yv.x, yv.y); w.y = pk(yv.z, yv.w); \
            *(u32x2*)(Y + ((size_t)tok0 + t) * 1024 + ch) = w; } } while (0)
    const int nchunk = L >> 5;
    if (wid >= 4) RW_PREP(0, 0);
    __syncthreads();
#pragma unroll 1
    for (int c = 0; c < nchunk; ++c) {
        if (wid < 4) {
            const float* vec = sm + (c & 1) * 14336; const float* vvs = vec + 10240; float* yb = sm + (c & 1) * 14336 + 12288;
#pragma unroll
            for (int j = 0; j < 32; ++j) {
                const float* vj = vec + j * 320 + kl * 8;
                const f32x4 a0 = *(const f32x4*)(vj), a1 = *(const f32x4*)(vj + 4);
                const f32x4 w0 = *(const f32x4*)(vj + 64), w1 = *(const f32x4*)(vj + 68);
                const f32x4 b0 = *(const f32x4*)(vj + 128), b1 = *(const f32x4*)(vj + 132);
                const f32x4 d0 = *(const f32x4*)(vj + 192), d1 = *(const f32x4*)(vj + 196);
                const f32x4 r0 = *(const f32x4*)(vj + 256), r1 = *(const f32x4*)(vj + 260);
                const float2 vr = *(const float2*)(vvs + j * 64 + row2);
                const f32x2 kk0 = a0.lo, kk1 = a0.hi, kk2 = a1.lo, kk3 = a1.hi;
                f32x2 pa = S2[0] * kk0; pa += S2[1] * kk1; pa += S2[2] * kk2; pa += S2[3] * kk3;
                f32x2 pb = T2[0] * kk0; pb += T2[1] * kk1; pb += T2[2] * kk2; pb += T2[3] * kk3;
                const float sa = -sum8(pa.x + pa.y), sb = -sum8(pb.x + pb.y);
                const f32x2 sa2 = (f32x2){sa, sa}, sb2 = (f32x2){sb, sb}, vx2 = (f32x2){vr.x, vr.x}, vy2 = (f32x2){vr.y, vr.y};
                S2[0] = S2[0] * w0.lo + (sa2 * b0.lo + vx2 * d0.lo); S2[1] = S2[1] * w0.hi + (sa2 * b0.hi + vx2 * d0.hi);
                S2[2] = S2[2] * w1.lo + (sa2 * b1.lo + vx2 * d1.lo); S2[3] = S2[3] * w1.hi + (sa2 * b1.hi + vx2 * d1.hi);
                T2[0] = T2[0] * w0.lo + (sb2 * b0.lo + vy2 * d0.lo); T2[1] = T2[1] * w0.hi + (sb2 * b0.hi + vy2 * d0.hi);
                T2[2] = T2[2] * w1.lo + (sb2 * b1.lo + vy2 * d1.lo); T2[3] = T2[3] * w1.hi + (sb2 * b1.hi + vy2 * d1.hi);
                f32x2 qa = S2[0] * r0.lo; qa += S2[1] * r0.hi; qa += S2[2] * r1.lo; qa += S2[3] * r1.hi;
                f32x2 qb = T2[0] * r0.lo; qb += T2[1] * r0.hi; qb += T2[2] * r1.lo; qb += T2[3] * r1.hi;
                const float y0 = sum8(qa.x + qa.y), y1 = sum8(qb.x + qb.y);
                if (kl == 0) *(float2*)(yb + j * 64 + row2) = make_float2(y0, y1);
            }
        } else {
            if (c > 0) RW_YOUT((c - 1) * 32, (c - 1) & 1);
            if (c + 1 < nchunk) RW_PREP((c + 1) * 32, (c + 1) & 1);
        }
        __syncthreads();
    }
    if (wid >= 4) RW_YOUT((nchunk - 1) * 32, (nchunk - 1) & 1);
#undef RW_PREP
#undef RW_YOUT
#pragma unroll
    for (int i = 0; i < 4; ++i) { S[2 * i] = S2[i].x; S[2 * i + 1] = S2[i].y; T[2 * i] = T2[i].x; T[2 * i + 1] = T2[i].y; }
    if (!sample && wid < 4) { float* so = p.out + OUT_RWST + so2;
        *(float4*)(so) = make_float4(S[0], S[1], S[2], S[3]); *(float4*)(so + 4) = make_float4(S[4], S[5], S[6], S[7]);
        *(float4*)(so + 64) = make_float4(T[0], T[1], T[2], T[3]); *(float4*)(so + 68) = make_float4(T[4], T[5], T[6], T[7]); }
    __syncthreads();
}
DEV void rwkv_post_tile(const Params& p, int tile, float* sm) {
    const int tid = tidx(); const int tok0 = tile * 32;
    const u16* P = (const u16*)(p.ws + OFF_P); const u16* RW = (const u16*)(p.ws + OFF_RW); u16* ycat = (u16*)(p.ws + OFF_A);
    const u16* YF = (const u16*)(p.out + OUT_GLAST); const u16* YB = YF + (size_t)NTOK * 1024;
    u16* Gh = (u16*)(sm + 4096);
    for (int i = tid; i < 32 * 128; i += 512) { const int tk = i >> 7, r = i & 127; const int tok = tok0 + tk; int t, L; tok_tl(tok, t, L);
        const u16* pp = P + (size_t)tok * LDP0 + 6400 + r; const float x = bf2f(*pp); const float xm = t > 0 ? bf2f(pp[-LDP0]) : 0.f; const float xp = t < L - 1 ? bf2f(pp[LDP0]) : 0.f;
        sm[i] = sigm(mixf(x, xm, xp, p.in[25][3328 + r])); }
    __syncthreads();
    { float g0[32], g1[32];
#pragma unroll
        for (int k = 0; k < 32; ++k) { g0[k] = 0.f; g1[k] = 0.f; }
        const float* g2 = p.in[30];
        for (int r = 0; r < 128; r += 4) {
            float wa[4], wb[4];
#pragma unroll
            for (int q = 0; q < 4; ++q) { wa[q] = g2[(r + q) * 1024 + tid]; wb[q] = g2[(r + q) * 1024 + 512 + tid]; }
#pragma unroll
            for (int k = 0; k < 32; ++k) { const float4 s4 = *(const float4*)(sm + k * 128 + r);
                g0[k] += s4.x * wa[0] + s4.y * wa[1] + s4.z * wa[2] + s4.w * wa[3]; g1[k] += s4.x * wb[0] + s4.y * wb[1] + s4.z * wb[2] + s4.w * wb[3]; } }
#pragma unroll
        for (int k = 0; k < 32; ++k) { Gh[k * 1024 + tid] = f2bf(g0[k]); Gh[k * 1024 + 512 + tid] = f2bf(g1[k]); } }
    __syncthreads();
    const int c8 = (tid & 127) * 8;
    float mur[8], muk[8], muv[8], ka[8], rk[8], lw[8], lb[8];
#pragma unroll
    for (int i = 0; i < 8; ++i) { mur[i] = p.in[25][c8 + i]; muk[i] = p.in[25][1024 + c8 + i]; muv[i] = p.in[25][2048 + c8 + i]; ka[i] = p.in[32][c8 + i]; rk[i] = p.in[33][c8 + i]; lw[i] = p.in[34][c8 + i]; lb[i] = p.in[35][c8 + i]; }
#pragma unroll 1
    for (int it = 0; it < 8; ++it) { const int tk = (tid >> 7) + 4 * it; const int tok = tok0 + tk; int t, L; tok_tl(tok, t, L);
        const u16* pr = P + (size_t)tok * LDP0 + 3072 + c8; const bool hm = t > 0, hp = t < L - 1;
        float rc[8], rm[8], rp[8], kc[8], km[8], kp[8], vc[8], vm[8], vp[8], a0[8], a1[8], yf[8], yb[8], gg[8];
        unpack8(*(const u32x4*)pr, rc); unpack8(*(const u32x4*)(pr + 1024), kc); unpack8(*(const u32x4*)(pr + 2048), vc);
        if (hm) { const u16* pm = P + (size_t)(tok - 1) * LDP0 + 3072 + c8; unpack8(*(const u32x4*)(pm), rm); unpack8(*(const u32x4*)(pm + 1024), km); unpack8(*(const u32x4*)(pm + 2048), vm); }
        else { for (int i = 0; i < 8; ++i) { rm[i] = 0.f; km[i] = 0.f; vm[i] = 0.f; } }
        if (hp) { unpack8(*(const u32x4*)(pr + LDP0), rp); unpack8(*(const u32x4*)(pr + LDP0 + 1024), kp); unpack8(*(const u32x4*)(pr + LDP0 + 2048), vp); }
        else { for (int i = 0; i < 8; ++i) { rp[i] = 0.f; kp[i] = 0.f; vp[i] = 0.f; } }
        unpack8(*(const u32x4*)(RW + (size_t)tok * 4096 + 2048 + c8), a0); unpack8(*(const u32x4*)(RW + (size_t)tok * 4096 + 3072 + c8), a1);
        unpack8(*(const u32x4*)(YF + (size_t)tok * 1024 + c8), yf); unpack8(*(const u32x4*)(YB + (size_t)tok * 1024 + c8), yb);
        unpack8(*(const u32x4*)(Gh + tk * 1024 + c8), gg);
        float y[8], v_[8]; float bon = 0.f, sy = 0.f;
#pragma unroll
        for (int i = 0; i < 8; ++i) { const float r_ = mixf(rc[i], rm[i], rp[i], mur[i]), k_ = mixf(kc[i], km[i], kp[i], muk[i]); v_[i] = mixf(vc[i], vm[i], vp[i], muv[i]);
            bon += r_ * k_ * (2.f + (a0[i] + a1[i] - 2.f) * ka[i]) * rk[i]; y[i] = yf[i] + yb[i]; sy += y[i]; }
        bon = sum8(bon); const float mean = sum8(sy) * (1.f / 64.f);
        float sv = 0.f;
#pragma unroll
        for (int i = 0; i < 8; ++i) { y[i] -= mean; sv += y[i] * y[i]; }
        const float rstd = rsqrtf(sum8(sv) * (1.f / 64.f) + 64e-5f);
        float o[8];
#pragma unroll
        for (int i = 0; i < 8; ++i) o[i] = (y[i] * rstd * lw[i] + lb[i] + bon * v_[i]) * gg[i];
        u32x4 w; w.x = pk(o[0], o[1]); w.y = pk(o[2], o[3]); w.z = pk(o[4], o[5]); w.w = pk(o[6], o[7]);
        *(u32x4*)(ycat + (size_t)tok * DM + 1024 + c8) = w; }
    __syncthreads();
}

DEV float logsig(float x) { return fminf(x, 0.f) - __logf(1.f + __expf(-fabsf(x))); }
DEV void gla_intra_task(const Params& p, int task, unsigned char* shm) {
    const int tid = tidx(), wid = tid >> 6, lane = tid & 63, l15 = lane & 15, quad = lane >> 4;
    const int cidx = task >> 2, h = task & 3; const int tok0 = cidx * 64;
    u16* P = (u16*)(p.ws + OFF_P); u16* QB = (u16*)(p.ws + OFF_A); float* Dbuf = (float*)(p.ws + OFF_DB);
    u16* qi = (u16*)shm; u16* ki = qi + 64 * 264; u16* vl = (u16*)shm; u16* Pl = (u16*)(shm + 67584); float* gl = (float*)(shm + 76800); float* tot = (float*)(shm + 84992);
    for (int i = tid; i < 2048; i += 512) { const int tl = i >> 5, c = i & 31; gl[i] = bf2f(P[(size_t)(tok0 + tl) * LDP1 + 6144 + c]); }
    __syncthreads();
    const int k = tid & 255, jh = tid >> 8;
#pragma unroll 1
    for (int dd = 0; dd < 2; ++dd) { const int dir = 1 - dd;
        float g2r[16];
#pragma unroll
        for (int r = 0; r < 16; ++r) g2r[r] = p.in[38][(size_t)(dir * 16 + r) * 1024 + h * 256 + k];
        const float gb = p.in[39][dir * 1024 + h * 256 + k];
        float bl[32]; float run = 0.f;
#pragma unroll
        for (int jj = 0; jj < 32; ++jj) { const int j = jh * 32 + jj; const int tl = dir ? 63 - j : j; const float* gr = gl + tl * 32 + dir * 16;
            float x = gb;
#pragma unroll
            for (int r = 0; r < 16; r += 4) { const float4 g4 = *(const float4*)(gr + r); x += g4.x * g2r[r] + g4.y * g2r[r + 1] + g4.z * g2r[r + 2] + g4.w * g2r[r + 3]; }
            run += logsig(x) * 0.0625f; bl[jj] = run; }
        tot[jh * 256 + k] = run;
        __syncthreads();
        const float t0v = tot[k], t1v = tot[256 + k]; const float off = jh ? t0v : 0.f; const float bref = t0v, blast = t0v + t1v;
        if (jh == 0) Dbuf[((size_t)cidx * 2 + dir) * 1024 + h * 256 + k] = __expf(blast);
        u16* qdst; u16* kdst; size_t ldd;
        if (dir == 0) { qdst = P + h * 256 + k; kdst = P + 1024 + h * 256 + k; ldd = LDP1; } else { qdst = QB + h * 256 + k; kdst = QB + 1024 + h * 256 + k; ldd = 2048; }
#pragma unroll
        for (int jj = 0; jj < 32; ++jj) { const int j = jh * 32 + jj; const int tl = dir ? 63 - j : j; const size_t tok = (size_t)tok0 + tl;
            const float qv = bf2f(P[tok * LDP1 + h * 256 + k]) * 0.0625f, kv = bf2f(P[tok * LDP1 + 1024 + h * 256 + k]);
            const float b = bl[jj] + off;
            qi[j * 264 + k] = f2bf(qv * __expf(b - bref)); ki[j * 264 + k] = f2bf(kv * __expf(bref - b));
            qdst[tok * ldd] = f2bf(qv * __expf(b)); kdst[tok * ldd] = f2bf(kv * __expf(blast - b)); }
        __syncthreads();
        { const int tt = wid >> 1;
#pragma unroll
            for (int q2 = 0; q2 < 2; ++q2) { const int st = (wid & 1) * 2 + q2; f32x4 acc = (f32x4){0.f, 0.f, 0.f, 0.f};
                if (st <= tt) {
#pragma unroll
                    for (int ks = 0; ks < 8; ++ks) { const bf16x8 a = *(const bf16x8*)(qi + (tt * 16 + l15) * 264 + ks * 32 + quad * 8); const bf16x8 b = *(const bf16x8*)(ki + (st * 16 + l15) * 264 + ks * 32 + quad * 8);
                        acc = mfma16(a, b, acc); } }
#pragma unroll
                for (int r = 0; r < 4; ++r) { const int t = tt * 16 + quad * 4 + r, s_ = st * 16 + l15; Pl[t * 72 + s_] = f2bf(s_ <= t ? acc[r] : 0.f); } } }
        __syncthreads();
#pragma unroll
        for (int i = 0; i < 8; ++i) { const int piece = tid + 512 * i; const int j = piece >> 6, c8 = (piece & 63) * 8; const int tl = dir ? 63 - j : j;
            *(u32x4*)(vl + j * 520 + c8) = *(const u32x4*)(P + (size_t)(tok0 + tl) * LDP1 + 2048 + h * 512 + c8); }
        __syncthreads();
        u16* O = (u16*)(p.ws + (dir ? OFF_OB : OFF_OF)) + h * 512;
#pragma unroll 1
        for (int q4 = 0; q4 < 4; ++q4) { const int vt = wid * 4 + q4; f32x4 acc[4];
#pragma unroll
            for (int tt = 0; tt < 4; ++tt) acc[tt] = (f32x4){0.f, 0.f, 0.f, 0.f};
#pragma unroll
            for (int ss = 0; ss < 2; ++ss) { bf16x8 bfr;
#pragma unroll
                for (int jj = 0; jj < 8; ++jj) bfr[jj] = (short)vl[(ss * 32 + quad * 8 + jj) * 520 + vt * 16 + l15];
#pragma unroll
                for (int tt = 0; tt < 4; ++tt) { if (ss * 32 <= tt * 16 + 15) { const bf16x8 a = *(const bf16x8*)(Pl + (tt * 16 + l15) * 72 + ss * 32 + quad * 8); acc[tt] = mfma16(a, bfr, acc[tt]); } } }
#pragma unroll
            for (int tt = 0; tt < 4; ++tt)
#pragma unroll
                for (int r = 0; r < 4; ++r) { const int t = tt * 16 + quad * 4 + r; const int tl = dir ? 63 - t : t; O[(size_t)(tok0 + tl) * DM + vt * 16 + l15] = f2bf(acc[tt][r]); } }
        __syncthreads();
    }
}
DEV void gla_inter_task(const Params& p, int task, unsigned char* shm) {
    const bool sample = task < 256; const int tt_ = sample ? task : task - 256;
    const int seq = tt_ >> 3, vs = tt_ & 7; const int b = seq >> 3, h = (seq >> 1) & 3, dir = seq & 1;
    const int L = sample ? 4096 : 256; const int tok0 = sample ? NTP + b * 4096 : b * 256;
    const int nch = L >> 6, cbase = tok0 >> 6;
    const int tid = tidx(), wid = tid >> 6, lane = tid & 63, l15 = lane & 15, quad = lane >> 4;
    const u16* P = (const u16*)(p.ws + OFF_P); const u16* QB = (const u16*)(p.ws + OFF_A); const float* Dbuf = (const float*)(p.ws + OFF_DB);
    u16* ST = (u16*)shm; u16* qdl = (u16*)(shm + 33792); u16* kdl = (u16*)(shm + 67584); u16* vl = (u16*)(shm + 101376); float* dl = (float*)(shm + 110592);
    f32x4 S[2][4];
    const size_t sbase = (((size_t)b * 2 + dir) * 4 + h) * 256 * 512 + vs * 64;
#pragma unroll
    for (int kt = 0; kt < 2; ++kt)
#pragma unroll
        for (int vt = 0; vt < 4; ++vt)
#pragma unroll
            for (int r = 0; r < 4; ++r) { const int kk = wid * 32 + kt * 16 + quad * 4 + r; S[kt][vt][r] = sample ? p.in[3][sbase + (size_t)kk * 512 + vt * 16 + l15] : 0.f; }
    const u16* qsrc; const u16* ksrc; size_t lds_;
    if (dir == 0) { qsrc = P + h * 256; ksrc = P + 1024 + h * 256; lds_ = LDP1; } else { qsrc = QB + h * 256; ksrc = QB + 1024 + h * 256; lds_ = 2048; }
    const u16* vsrc = P + 2048 + h * 512 + vs * 64;
    u16* O = (u16*)(p.ws + (dir ? OFF_OB : OFF_OF)) + h * 512 + vs * 64;
    u32x4 rq[4], rk[4], rv; float rd = 0.f;
    const int vrow = tid >> 3, vc8 = (tid & 7) * 8;
#define GLA_ISSUE(n_) do { const int cidx_ = cbase + (dir ? nch - 1 - (n_) : (n_)); \
        _Pragma("unroll") for (int i = 0; i < 4; ++i) { const int piece = tid + 512 * i; const int j = piece >> 5, c8 = (piece & 31) * 8; const size_t tok = (size_t)cidx_ * 64 + (dir ? 63 - j : j); \
            rq[i] = *(const u32x4*)(qsrc + tok * lds_ + c8); rk[i] = *(const u32x4*)(ksrc + tok * lds_ + c8); } \
        { const size_t tok = (size_t)cidx_ * 64 + (dir ? 63 - vrow : vrow); rv = *(const u32x4*)(vsrc + tok * LDP1 + vc8); } \
        if (tid < 256) rd = Dbuf[((size_t)cidx_ * 2 + dir) * 1024 + h * 256 + tid]; } while (0)
#define GLA_WRITE_ST() do { _Pragma("unroll") for (int kt = 0; kt < 2; ++kt) _Pragma("unroll") for (int vt = 0; vt < 4; ++vt) { u32x2 w; w.x = pk(S[kt][vt][0], S[kt][vt][1]); w.y = pk(S[kt][vt][2], S[kt][vt][3]); \
            *(u32x2*)(ST + (vt * 16 + l15) * 264 + wid * 32 + kt * 16 + quad * 4) = w; } } while (0)
    GLA_WRITE_ST();
    GLA_ISSUE(0);
    const int tt = wid >> 1, vb = (wid & 1) * 2;
#pragma unroll 1
    for (int n = 0; n < nch; ++n) {
        const int cidx = cbase + (dir ? nch - 1 - n : n);
#pragma unroll
        for (int i = 0; i < 4; ++i) { const int piece = tid + 512 * i; const int j = piece >> 5, c8 = (piece & 31) * 8; *(u32x4*)(qdl + j * 264 + c8) = rq[i]; *(u32x4*)(kdl + j * 264 + c8) = rk[i]; }
        *(u32x4*)(vl + vrow * 72 + vc8) = rv; if (tid < 256) dl[tid] = rd;
        __syncthreads();
        if (n + 1 < nch) GLA_ISSUE(n + 1);
        float oi[2][4];
#pragma unroll
        for (int q2 = 0; q2 < 2; ++q2)
#pragma unroll
            for (int r = 0; r < 4; ++r) { const int j = tt * 16 + quad * 4 + r; const size_t tok = (size_t)cidx * 64 + (dir ? 63 - j : j); oi[q2][r] = bf2f(O[tok * DM + (vb + q2) * 16 + l15]); }
        f32x4 oacc[2]; oacc[0] = (f32x4){0.f, 0.f, 0.f, 0.f}; oacc[1] = oacc[0];
#pragma unroll
        for (int ks = 0; ks < 8; ++ks) { const bf16x8 a = *(const bf16x8*)(qdl + (tt * 16 + l15) * 264 + ks * 32 + quad * 8);
#pragma unroll
            for (int q2 = 0; q2 < 2; ++q2) { const bf16x8 bfr = *(const bf16x8*)(ST + ((vb + q2) * 16 + l15) * 264 + ks * 32 + quad * 8); oacc[q2] = mfma16(a, bfr, oacc[q2]); } }
#pragma unroll
        for (int kt = 0; kt < 2; ++kt) { const f32x4 dv = *(const f32x4*)(dl + wid * 32 + kt * 16 + quad * 4);
#pragma unroll
            for (int vt = 0; vt < 4; ++vt) S[kt][vt] = S[kt][vt] * dv; }
#pragma unroll
        for (int ts = 0; ts < 2; ++ts) { bf16x8 af[2];
#pragma unroll
            for (int kt = 0; kt < 2; ++kt)
#pragma unroll
                for (int jj = 0; jj < 8; ++jj) af[kt][jj] = (short)kdl[(ts * 32 + quad * 8 + jj) * 264 + wid * 32 + kt * 16 + l15];
#pragma unroll
            for (int vt = 0; vt < 4; ++vt) { bf16x8 bfr;
#pragma unroll
                for (int jj = 0; jj < 8; ++jj) bfr[jj] = (short)vl[(ts * 32 + quad * 8 + jj) * 72 + vt * 16 + l15];
#pragma unroll
                for (int kt = 0; kt < 2; ++kt) S[kt][vt] = mfma16(af[kt], bfr, S[kt][vt]); } }
#pragma unroll
        for (int q2 = 0; q2 < 2; ++q2)
#pragma unroll
            for (int r = 0; r < 4; ++r) { const int j = tt * 16 + quad * 4 + r; const size_t tok = (size_t)cidx * 64 + (dir ? 63 - j : j); O[tok * DM + (vb + q2) * 16 + l15] = f2bf(oi[q2][r] + oacc[q2][r]); }
        __syncthreads();
        GLA_WRITE_ST();
        __syncthreads();
    }
#undef GLA_ISSUE
#undef GLA_WRITE_ST
    if (!sample) { float* so = p.out + OUT_GLAST + sbase;
#pragma unroll
        for (int kt = 0; kt < 2; ++kt)
#pragma unroll
            for (int vt = 0; vt < 4; ++vt)
#pragma unroll
                for (int r = 0; r < 4; ++r) { const int kk = wid * 32 + kt * 16 + quad * 4 + r; so[(size_t)kk * 512 + vt * 16 + l15] = S[kt][vt][r]; } }
    __syncthreads();
}
DEV void phase_gla_post(const Params& p) {
    const int tid = tidx(), wid = tid >> 6, lane = tid & 63;
    const u16* P = (const u16*)(p.ws + OFF_P); const u16* OF = (const u16*)(p.ws + OFF_OF); const u16* OB = (const u16*)(p.ws + OFF_OB); u16* ycat = (u16*)(p.ws + OFF_A);
    for (int it = blockIdx.x * 8 + wid; it < NTOK * 4; it += gridDim.x * 8) { const int tok = it >> 2, h = it & 3; const int v8 = lane * 8;
        float a[8], b[8], g[8]; unpack8(*(const u32x4*)(OF + (size_t)tok * DM + h * 512 + v8), a); unpack8(*(const u32x4*)(OB + (size_t)tok * DM + h * 512 + v8), b);
        unpack8(*(const u32x4*)(P + (size_t)tok * LDP1 + 4096 + h * 512 + v8), g);
        float ss = 0.f;
#pragma unroll
        for (int i = 0; i < 8; ++i) { a[i] += b[i]; ss += a[i] * a[i]; }
        ss = wave_sum(ss); const float sc = rsqrtf(ss * (1.f / 512.f) + 1e-6f);
        float o[8];
#pragma unroll
        for (int i = 0; i < 8; ++i) o[i] = a[i] * sc * p.in[40][v8 + i] * (g[i] * sigm(g[i]));
        u32x4 w; w.x = pk(o[0], o[1]); w.y = pk(o[2], o[3]); w.z = pk(o[4], o[5]); w.w = pk(o[6], o[7]);
        *(u32x4*)(ycat + (size_t)tok * DM + h * 512 + v8) = w; }
}

DEV void gate_loadcol(const u16* U, long tokc, int c8, bool colok, bool up, bool dn, int W, float (*dst)[8]) {
    if (colok && up) unpack8(*(const u32x4*)(U + (size_t)(tokc - W) * LDU + c8), dst[0]); else { for (int i = 0; i < 8; ++i) dst[0][i] = 0.f; }
    if (colok) unpack8(*(const u32x4*)(U + (size_t)tokc * LDU + c8), dst[1]); else { for (int i = 0; i < 8; ++i) dst[1][i] = 0.f; }
    if (colok && dn) unpack8(*(const u32x4*)(U + (size_t)(tokc + W) * LDU + c8), dst[2]); else { for (int i = 0; i < 8; ++i) dst[2][i] = 0.f; }
}
DEV void phase_ffn_gate(const Params& p, int layer) {
    u16* U = (u16*)(p.ws + OFF_U); const float* cw = p.in[11] + (size_t)layer * 9 * DFF;
    const int tid_ = tidx(), wid_ = tid_ >> 6, lane_ = tid_ & 63;
    for (int bu = blockIdx.x; bu < 704 + 352; bu += gridDim.x) {
        int tokS, c8;
        if (bu < 704) { const int rg = bu / 22, rem = bu % 22; const int half = rem / 11, cgg = rem % 11; tokS = NTP + (rg * 8 + wid_) * 64 + half * 32; c8 = (cgg * 64 + lane_) * 8; }
        else { const int pu = bu - 704; const int sg = pu / 11, cgg = pu % 11; tokS = (sg * 8 + wid_) * 32; c8 = (cgg * 64 + lane_) * 8; }
        int W, colS; bool up, dn;
        if (tokS < NTP) { W = 256; colS = tokS & 255; up = false; dn = false; }
        else { W = 64; colS = tokS & 63; const int rr = ((tokS - NTP) >> 6) & 63; up = rr > 0; dn = rr < 63; }
        float wt[9][8];
#pragma unroll
        for (int q = 0; q < 9; ++q) { const float4 a = *(const float4*)(cw + q * DFF + c8), b = *(const float4*)(cw + q * DFF + c8 + 4);
            wt[q][0] = a.x; wt[q][1] = a.y; wt[q][2] = a.z; wt[q][3] = a.w; wt[q][4] = b.x; wt[q][5] = b.y; wt[q][6] = b.z; wt[q][7] = b.w; }
        float w0[3][8], w1[3][8], w2[3][8];
        gate_loadcol(U, (long)tokS - 1, c8, colS > 0, up, dn, W, w0);
        gate_loadcol(U, (long)tokS, c8, true, up, dn, W, w1);
#pragma unroll 8
        for (int s_ = 0; s_ < 32; ++s_) {
            const long tok = (long)tokS + s_;
            gate_loadcol(U, tok + 1, c8, colS + s_ + 1 < W, up, dn, W, w2);
            u16* vp = U + (size_t)tok * LDU + DFF + c8; float v[8]; unpack8(*(const u32x4*)vp, v);
#pragma unroll
            for (int i = 0; i < 8; ++i) { float a = 0.f;
#pragma unroll
                for (int di = 0; di < 3; ++di) a += w0[di][i] * wt[di * 3][i] + w1[di][i] * wt[di * 3 + 1][i] + w2[di][i] * wt[di * 3 + 2][i];
                v[i] *= a * sigm(a); }
            u32x4 w; w.x = pk(v[0], v[1]); w.y = pk(v[2], v[3]); w.z = pk(v[4], v[5]); w.w = pk(v[6], v[7]);
            *(u32x4*)vp = w;
#pragma unroll
            for (int di = 0; di < 3; ++di)
#pragma unroll
                for (int i = 0; i < 8; ++i) { w0[di][i] = w1[di][i]; w1[di][i] = w2[di][i]; }
        }
    }
}

DEV void phase_final_norm(const Params& p) {
    const int tid = tidx(), wid = tid >> 6, lane = tid & 63; const float* g = p.in[13];
    for (int row = blockIdx.x * 8 + wid; row < NTOK; row += gridDim.x * 8) {
        float4* xr = (float4*)(p.out + (size_t)row * DM);
        float4 v[8]; float ss = 0.f;
#pragma unroll
        for (int j = 0; j < 8; ++j) { v[j] = xr[lane + 64 * j]; ss += v[j].x * v[j].x + v[j].y * v[j].y + v[j].z * v[j].z + v[j].w * v[j].w; }
        ss = wave_sum(ss); const float rstd = rsqrtf(ss * (1.f / 2048.f) + 1e-6f);
#pragma unroll
        for (int j = 0; j < 8; ++j) { const float4 gg = *(const float4*)(g + (lane + 64 * j) * 4);
            xr[lane + 64 * j] = make_float4(v[j].x * rstd * gg.x, v[j].y * rstd * gg.y, v[j].z * rstd * gg.z, v[j].w * rstd * gg.w); }
    }
}


#define XB_TMO      128
#define XB_XCNT(j)  (256  + 64 * (j))
#define XB_XSUB(j)  (1280 + 64 * (j))
#define XB_XGEN(j)  (2304 + 64 * (j))
#define XB_TOP      3328
#define XB_TOPGEN   3392
#define XCD_BAR_WORDS 3456
#define XB_SPIN_CAP (1u << 18)
DEV unsigned xb_ld(unsigned* p)              { return __hip_atomic_load(p, __ATOMIC_RELAXED, __HIP_MEMORY_SCOPE_AGENT); }
DEV unsigned xb_add(unsigned* p, unsigned v) { return __hip_atomic_fetch_add(p, v, __ATOMIC_RELAXED, __HIP_MEMORY_SCOPE_AGENT); }
DEV unsigned xb_xcc_id() { return (unsigned)__builtin_amdgcn_s_getreg((3 << 11) | 20) & 0xFu; }
#define XB_SPIN(cond, bar) do { unsigned _sp = 0; while (cond) { __builtin_amdgcn_s_sleep(1); \
    if ((++_sp & 255u) == 0u) { if (xb_ld(&(bar)[XB_TMO])) break; if (_sp > XB_SPIN_CAP) { atomicAdd(&(bar)[XB_TMO], 1u); break; } } } } while (0)
struct XcdBarrier { unsigned* bar; unsigned x; volatile LAS unsigned* st; };
DEV XcdBarrier xcd_barrier_post(unsigned* bar, volatile LAS unsigned* st) {
    XcdBarrier b; b.bar = bar; b.x = xb_xcc_id(); b.st = st;
    if (threadIdx.x == 0) (void)xb_add(&bar[XB_XCNT(b.x)], 1u);
    return b;
}
DEV void xcd_barrier_complete(unsigned* bar, unsigned x, unsigned& nloc, unsigned& nx) {
    const unsigned G = gridDim.x * gridDim.y * gridDim.z;
    unsigned sum, cnt, mine, sp = 0u;
    for (;;) {
        sum = 0u; cnt = 0u; mine = 0u;
#pragma unroll
        for (unsigned j = 0; j < 16; ++j) { const unsigned c = xb_ld(&bar[XB_XCNT(j)]); sum += c; cnt += (c > 0u) ? 1u : 0u; mine = (j == x) ? c : mine; }
        if (sum == G) break;
        __builtin_amdgcn_s_sleep(1);
        if ((++sp & 255u) == 0u) { if (xb_ld(&bar[XB_TMO])) break; if (sp > XB_SPIN_CAP) { atomicAdd(&bar[XB_TMO], 1u); break; } }
    }
    nloc = mine > 0u ? mine : 1u; nx = cnt > 0u ? cnt : 1u;
}
DEV void xcd_barrier(const XcdBarrier& b) {
    asm volatile("s_waitcnt vmcnt(0)" ::: "memory");
    __syncthreads();
    if (threadIdx.x == 0) {
        unsigned* bar = b.bar;
        __builtin_amdgcn_s_waitcnt(0);
        unsigned nloc = b.st[0], nx = b.st[1];
        if (nloc == 0u) { xcd_barrier_complete(bar, b.x, nloc, nx); b.st[0] = nloc; b.st[1] = nx; }
        const unsigned old = xb_add(&bar[XB_XSUB(b.x)], 1u);
        const unsigned gen = old / nloc;
        if (old + 1u == (gen + 1u) * nloc) {
            __builtin_amdgcn_fence(__ATOMIC_RELEASE, "agent");
            asm volatile("s_waitcnt vmcnt(0)" ::: "memory");
            const unsigned og = xb_add(&bar[XB_TOP], 1u);
            const unsigned tg = og / nx;
            if (og + 1u == (tg + 1u) * nx) xb_add(&bar[XB_TOPGEN], 1u);
            else XB_SPIN(xb_ld(&bar[XB_TOPGEN]) == tg, bar);
            __builtin_amdgcn_fence(__ATOMIC_ACQUIRE, "agent");
            xb_add(&bar[XB_XGEN(b.x)], 1u);
            asm volatile("s_waitcnt vmcnt(0)" ::: "memory");
        } else {
            XB_SPIN(xb_ld(&bar[XB_XGEN(b.x)]) == gen, bar);
            __builtin_amdgcn_fence(__ATOMIC_ACQUIRE, "agent");
            asm volatile("s_waitcnt vmcnt(0)" ::: "memory");
        }
    }
    __syncthreads();
}

__global__ void __launch_bounds__(512, 2) mega(Params p0) {
    extern __shared__ __attribute__((aligned(16))) unsigned char shm[];
    cg::grid_group grid = cg::this_grid();
    __shared__ uint4 xb_words;
    if (threadIdx.x == 0) xb_words = make_uint4(0u, 0u, 0u, 0u);
    __syncthreads();
    (void)xcd_barrier_post((unsigned*)(p0.ws + OFF_SMALL + SMALL_BYTES + 256), (volatile LAS unsigned*)&xb_words);
#define XBAR() do { XcdBarrier xb_; xb_.bar = (unsigned*)(launder(p0).ws + OFF_SMALL + SMALL_BYTES + 256); xb_.x = xb_xcc_id(); xb_.st = (volatile LAS unsigned*)&xb_words; xcd_barrier(xb_); } while (0)
    float* sm = (float*)shm;
    const int G = (int)gridDim.x, B = (int)blockIdx.x;

#ifndef SK_PREP
    phase_prep(launder(p0), shm);
#ifdef PROBE_MISC
    __syncthreads(); phase_prep(launder(p0), shm);
#endif
#endif
    grid.sync();
    phase_reduce(launder(p0));
    XBAR();
#pragma unroll 1
    for (int layer = 0; layer < 2; ++layer) {
#ifndef SK_NORM
        phase_norm(launder(p0), layer, 0, shm);
#ifdef PROBE_MISC
        __syncthreads(); phase_norm(launder(p0), layer, 0, shm);
#endif
#endif
        XBAR();
        { const Params p = launder(p0); const u16* A = (const u16*)(p.ws + OFF_A); pg8::EpiBf16 E; E.O = (u16*)(p.ws + OFF_P); E.ldc = layer ? LDP1 : LDP0;
#if !defined(SK_GEMM) && !defined(SK_GBF)
            run_gemm(shm, A, DM, (const u16*)(p.ws + OFF_WIN), DM, layer ? LDP1 : LDP0, DM, E);
#ifdef PROBE_GEMM
            __syncthreads(); run_gemm(shm, A, DM, (const u16*)(p.ws + OFF_WIN), DM, layer ? LDP1 : LDP0, DM, E);
#endif
#endif
        }
        XBAR();
        if (layer == 0) {
#ifndef SK_PRE
            { const Params p = launder(p0); for (int t = B; t < 6144 + 768; t += G) { if (t < 6144) hy_pre_tile(p, t, sm); else rwkv_lora_tile(p, t - 6144, shm); } }
#ifdef PROBE_MISC
            { const Params p = launder(p0); for (int t = B; t < 6144 + 768; t += G) { if (t < 6144) hy_pre_tile(p, t, sm); else rwkv_lora_tile(p, t - 6144, shm); } }
#endif
#endif
            XBAR();
            { const Params p = launder(p0); unsigned* ctr = (unsigned*)(p.ws + OFF_SMALL + SMALL_BYTES);
                for (int t = B; t < 128; t += G) rwkv_scan_task(p, t, sm);
                for (;;) { if (tidx() == 0) *(volatile unsigned*)shm = atomicAdd(ctr, 1u); __syncthreads(); const unsigned t = *(volatile unsigned*)shm; __syncthreads();
                    if (t >= 1024u + 2048u) break;
                    if (t < 1024u) rwkv_scan_task(p, 128 + (int)t, sm); else hyconv_task(p, (int)t - 1024, shm); } }
            XBAR();
#ifndef SK_POST
            { const Params p = launder(p0); for (int t = B; t < 6144 + 768; t += G) { if (t < 6144) hy_post_tile(p, t, sm); else rwkv_post_tile(p, t - 6144, sm); } }
#ifdef PROBE_MISC
            { const Params p = launder(p0); for (int t = B; t < 6144 + 768; t += G) { if (t < 6144) hy_post_tile(p, t, sm); else rwkv_post_tile(p, t - 6144, sm); } }
#endif
#endif
            XBAR();
        } else {
#ifndef SK_GLA
            { const Params p = launder(p0); for (int t = B; t < 1536; t += G) gla_intra_task(p, t, shm); }
            XBAR();
            { const Params p = launder(p0); for (int t = B; t < 256 + 2048; t += G) gla_inter_task(p, t, shm); }
#endif
            XBAR();
#ifndef SK_GLAP
            phase_gla_post(launder(p0));
#ifdef PROBE_MISC
            phase_gla_post(launder(p0));
#endif
#endif
            XBAR();
        }
        { const Params p = launder(p0); const u16* A = (const u16*)(p.ws + OFF_A); const float* mods = (const float*)(p.ws + OFF_SMALL); pg8::EpiRes E; E.X = p.out; E.gm = mods + (size_t)layer * 5 * 12288 + 2 * 2048; E.gb = p.in[7] + layer * 12288 + 2 * 2048;
#if !defined(SK_GEMM) && !defined(SK_GRES)
            run_gemm(shm, A, DM, (const u16*)(p.ws + OFF_WOUT), DM, DM, DM, E);
#endif
        }
        XBAR();
#ifndef SK_NORM
        phase_norm(launder(p0), layer, 1, shm);
#ifdef PROBE_MISC
        __syncthreads(); phase_norm(launder(p0), layer, 1, shm);
#endif
#endif
        XBAR();
        { const Params p = launder(p0); const u16* A = (const u16*)(p.ws + OFF_A); pg8::EpiBf16 E; E.O = (u16*)(p.ws + OFF_U); E.ldc = LDU;
#if !defined(SK_GEMM) && !defined(SK_GBF)
            run_gemm(shm, A, DM, (const u16*)(p.ws + OFF_WUP), DM, LDU, DM, E);
#ifdef PROBE_GEMM
            __syncthreads(); run_gemm(shm, A, DM, (const u16*)(p.ws + OFF_WUP), DM, LDU, DM, E);
#endif
#endif
        }
        XBAR();
#ifndef SK_GATE
        phase_ffn_gate(launder(p0), layer);
#endif
        XBAR();
        { const Params p = launder(p0); const float* mods = (const float*)(p.ws + OFF_SMALL); pg8::EpiRes E; E.X = p.out; E.gm = mods + (size_t)layer * 5 * 12288 + 5 * 2048; E.gb = p.in[7] + layer * 12288 + 5 * 2048;
#if !defined(SK_GEMM) && !defined(SK_GRES)
            run_gemm(shm, (const u16*)(p.ws + OFF_U) + DFF, LDU, (const u16*)(p.ws + OFF_WDN), DFF, DM, DFF, E);
#endif
        }
        XBAR();
    }
    phase_final_norm(launder(p0));
}

extern "C" void kernel_launch(void* const* d_in, const int* in_sizes, int n_in, void* d_out, int out_size, void* d_ws, size_t ws_size, hipStream_t stream) {
    constexpr size_t kDynLds = 131072;
    static int grid_blocks = 0;
    if (!grid_blocks) {
        int dev = 0, cus = 0, per_cu = 0;
        hipGetDevice(&dev);
        hipDeviceGetAttribute(&cus, hipDeviceAttributeMultiprocessorCount, dev);
        hipFuncSetAttribute((const void*)mega, hipFuncAttributeMaxDynamicSharedMemorySize, (int)kDynLds);
        hipOccupancyMaxActiveBlocksPerMultiprocessor(&per_cu, mega, 512, kDynLds);
        if (per_cu < 1) per_cu = 1;
        grid_blocks = cus * per_cu;
        if (grid_blocks > 256) grid_blocks = 256;
    }
    if (ws_size < WS_NEED || n_in < 41) { fprintf(stderr, "workspace too small: %zu < %zu\n", ws_size, WS_NEED); return; }
    Params p{};
    for (int i = 0; i < 41; ++i) p.in[i] = (const float*)d_in[i];
    p.out = (float*)d_out; p.ws = (unsigned char*)d_ws;
    hipMemsetAsync((unsigned char*)d_ws + OFF_SMALL + SMALL_BYTES, 0, 256 + XCD_BAR_BYTES, stream);
    void* args[] = {&p};
    hipError_t e = hipLaunchCooperativeKernel((const void*)mega, dim3(grid_blocks), dim3(512), args, kDynLds, stream);
    if (e != hipSuccess) fprintf(stderr, "cooperative launch failed: %s (grid %d)\n", hipGetErrorString(e), grid_blocks);
}
```

```cpp
#include <hip/hip_runtime.h>
#include <hip/hip_cooperative_groups.h>
#include <cstdio>
namespace cg = cooperative_groups;

#define DEV __device__ __forceinline__
#define LAS __attribute__((address_space(3)))
typedef unsigned short u16;
typedef short bf16x8 __attribute__((ext_vector_type(8)));
typedef float f32x4 __attribute__((ext_vector_type(4)));
typedef float f32x2 __attribute__((ext_vector_type(2)));
typedef float f32x16 __attribute__((ext_vector_type(16)));
typedef unsigned u32x2 __attribute__((ext_vector_type(2)));
typedef unsigned u32x4 __attribute__((ext_vector_type(4)));

constexpr int NTOK = 24576, NTP = 8192, DM = 2048;
constexpr int LDP0 = 6656, LDP1 = 6400, LDU = 11264, DFF = 5632;
constexpr size_t OFF_WIN = 0, OFF_WOUT = 27262976, OFF_WUP = 35651584, OFF_WDN = OFF_WUP + 46137344;
constexpr size_t OFF_A = 104857600, OFF_BIG = 205520896;
constexpr size_t OFF_P = OFF_BIG, OFF_RW = OFF_BIG + 327155712, OFF_UT = OFF_RW + 201326592, OFF_GS = OFF_UT + 50331648, OFF_GP = OFF_GS + 16777216;
constexpr size_t OFF_U = OFF_BIG, OFF_OF = OFF_BIG + 314572800, OFF_OB = OFF_OF + 100663296, OFF_DB = OFF_OB + 100663296;
constexpr size_t OFF_SMALL = OFF_BIG + 600000000, SMALL_BYTES = 491520 + 8192;
constexpr size_t XCD_BAR_BYTES = 3456 * 4;
constexpr size_t OFF_LW = OFF_SMALL + SMALL_BYTES + 256 + XCD_BAR_BYTES;
constexpr size_t OFF_G2T = OFF_LW + 524288;
constexpr size_t WS_NEED = OFF_G2T + 262144;
constexpr size_t OUT_RWST = 50331648, OUT_GLAST = 54525952;

struct Params {
    const float* in[41];
    float* out;
    unsigned char* ws;
};

DEV int tidx() { int t = threadIdx.x; asm volatile("" : "+v"(t)); return t; }
DEV Params launder(const Params& p) { Params q = p; asm volatile("" : "+s"(q.ws), "+s"(q.out)); return q; }
DEV float bf2f(unsigned b) { return __uint_as_float(b << 16); }
DEV float bflo(unsigned w) { return __uint_as_float(w << 16); }
DEV float bfhi(unsigned w) { return __uint_as_float(w & 0xffff0000u); }
DEV unsigned pk(float lo, float hi) { unsigned r; asm("v_cvt_pk_bf16_f32 %0, %1, %2" : "=v"(r) : "v"(lo), "v"(hi)); return r; }
DEV u16 f2bf(float f) { return (u16)(pk(f, 0.f) & 0xffffu); }
DEV float wave_sum(float v) {
#pragma unroll
    for (int o = 32; o > 0; o >>= 1) v += __shfl_xor(v, o);
    return v;
}
template <int CTRL> DEV float dppf(float x) { return __builtin_bit_cast(float, __builtin_amdgcn_update_dpp(0, __builtin_bit_cast(int, x), CTRL, 0xf, 0xf, true)); }
DEV float sum8(float v) { v += dppf<0xB1>(v); v += dppf<0x4E>(v); v += dppf<0x141>(v); return v; }
DEV float sum16(float v) { v = sum8(v); v += dppf<0x140>(v); return v; }
DEV f32x4 mfma16(bf16x8 a, bf16x8 b, f32x4 c) { return __builtin_amdgcn_mfma_f32_16x16x32_bf16(a, b, c, 0, 0, 0); }
DEV float sigm(float x) { return __builtin_amdgcn_rcpf(1.f + __expf(-x)); }
DEV int tok_cond(int tok) { return tok < NTP ? 4 : ((tok - NTP) >> 12); }
DEV void tok_tl(int tok, int& t, int& L) { if (tok < NTP) { t = tok & 255; L = 256; } else { t = (tok - NTP) & 4095; L = 4096; } }
DEV void unpack8(u32x4 w, float* o) { o[0] = bflo(w.x); o[1] = bfhi(w.x); o[2] = bflo(w.y); o[3] = bfhi(w.y); o[4] = bflo(w.z); o[5] = bfhi(w.z); o[6] = bflo(w.w); o[7] = bfhi(w.w); }
DEV void unpack4(u32x2 w, float* o) { o[0] = bflo(w.x); o[1] = bfhi(w.x); o[2] = bflo(w.y); o[3] = bfhi(w.y); }

namespace pg8 {
constexpr int BM = 256, BK = 64, HALF = 128, HTB = HALF * BK * 2, NXCD = 8, WGM = 8;
DEV int lds_byte(int r, int c) { const int st = (r >> 4) * 2 + (c >> 5), rr = r & 15, cc = c & 31, ob = rr * 64 + cc * 2; return st * 1024 + (ob ^ (((ob >> 9) & 1) << 5)); }
DEV void stage_rc(int b, int& R, int& C) { const int st = b / 1024, sb = b % 1024, swz = sb ^ (((sb >> 9) & 1) << 5); R = (st >> 1) * 16 + swz / 64; C = (st & 1) * 32 + (swz % 64) / 2; }
DEV int perm32(int rho) { const int n = rho >> 4, i = rho & 15; return 8 * (i >> 2) + 4 * n + (i & 3); }
struct Unit { int pm, pn; };
struct Gemm { const u16* A; const u16* Bt; int M, N, K, lda, ldb; };
struct StaticOrder {
    int nM, nN, nwg, G, c;
    DEV void init(int M, int N, int G_, int c_) { nM = M / BM; nN = N / BM; nwg = nM * nN; G = G_; c = c_; }
    DEV bool next(int i, Unit& u) const {
        const long L = (long)i * G + c; if (L >= nwg) return false;
        int wgid = (int)L; { const int q = nwg / NXCD, r = nwg % NXCD, xcd = wgid % NXCD, off = wgid / NXCD; wgid = (xcd < r ? xcd * (q + 1) : r * (q + 1) + (xcd - r) * q) + off; }
        const int nig = WGM * nN, gid = wgid / nig, fm = gid * WGM, gsz = (nM - fm) < WGM ? (nM - fm) : WGM;
        u.pm = fm + ((wgid % nig) % gsz); u.pn = (wgid % nig) / gsz; return true;
    }
};
struct EpiBf16 {
    static constexpr bool PERM = true;
    u16* O; int ldc;
    DEV void operator()(const f32x4 (&acc)[2][2][4][2], const Unit& u, int wr, int wc, int fr, int fq) const {
        const int row0 = u.pm * BM + wr * 64 + fr; const int col0 = u.pn * BM + wc * 32 + 8 * fq;
#pragma unroll
        for (int ai = 0; ai < 2; ++ai)
#pragma unroll
            for (int m = 0; m < 4; ++m) { u16* rowp = O + (size_t)(row0 + ai * HALF + m * 16) * ldc + col0;
#pragma unroll
                for (int bj = 0; bj < 2; ++bj) { const f32x4 v0 = acc[ai][bj][m][0], v1 = acc[ai][bj][m][1];
                    u32x4 w; w.x = pk(v0[0], v0[1]); w.y = pk(v0[2], v0[3]); w.z = pk(v1[0], v1[1]); w.w = pk(v1[2], v1[3]);
                    *(u32x4*)(rowp + bj * HALF) = w; } }
    }
};
struct EpiRes {
    static constexpr bool PERM = false;
    float* X; const float* gm; const float* gb;
    DEV void operator()(const f32x4 (&acc)[2][2][4][2], const Unit& u, int wr, int wc, int fr, int fq) const {
        const int row0 = u.pm * BM + wr * 64 + fr, col0 = u.pn * BM + wc * 32 + 4 * fq;
        const int cond = u.pm < 32 ? 4 : ((u.pm - 32) >> 4);
        const float* gmc = gm + (size_t)cond * 12288 + col0; const float* gbc = gb + col0;
#pragma unroll
        for (int ai = 0; ai < 2; ++ai)
#pragma unroll
            for (int m = 0; m < 4; ++m) { float* rowp = X + (size_t)(row0 + ai * HALF + m * 16) * DM + col0;
#pragma unroll
                for (int bj = 0; bj < 2; ++bj) {
#pragma unroll
                    for (int n = 0; n < 2; ++n) { f32x4* q = (f32x4*)(rowp + bj * HALF + n * 16);
                        const f32x4 gvv = *(const f32x4*)(gmc + bj * HALF + n * 16) + *(const f32x4*)(gbc + bj * HALF + n * 16);
                        *q = *q + gvv * acc[ai][bj][m][n]; }
                    asm volatile("" ::: "memory"); } }
    }
};

template <class Epi>
DEV void gemm_phase(LAS unsigned char* lds, const Gemm g, const StaticOrder& S, const Epi& E) {
    const int tid = tidx(), wid = __builtin_amdgcn_readfirstlane(tid >> 6), lane = tid & 63, wr = wid >> 2, wc = wid & 3, fr = lane & 15, fq = lane >> 4;
    const int K = g.K, nt = K / BK;
    unsigned voffA[2], voffB[2];
#pragma unroll
    for (int i = 0; i < 2; ++i) { int R, C; stage_rc(tid * 16 + i * 8192, R, C); const int Rb = Epi::PERM ? ((R & ~31) + perm32(R & 31)) : R;
        voffA[i] = (unsigned)(R * g.lda + C) * 2u; voffB[i] = (unsigned)(Rb * g.ldb + C) * 2u; }
    const size_t kstep = (size_t)(BK * 2);
    const size_t hstepA = (size_t)HALF * g.lda * 2, hstepB = (size_t)HALF * g.ldb * 2;
    const size_t tstepA = 2 * hstepA, tstepB = 2 * hstepB;
    const unsigned ldsw = (unsigned)wid * 1024u;
    const int aoff = lds_byte(wr * 64 + fr, fq * 8), boff = lds_byte(wc * 32 + fr, fq * 8);
#define PG8_SA(b, h) (((b) * 2 + (h)) * HTB)
#define PG8_SB(b, h) ((4 + (b) * 2 + (h)) * HTB)
#define PG8_STAGE(bufoff, gbase, voff) do { _Pragma("unroll") for (int _i = 0; _i < 2; ++_i) \
        __builtin_amdgcn_global_load_lds((const unsigned*)((const char*)(gbase) + (voff)[_i]), (LAS unsigned*)(lds + (bufoff) + ldsw + _i * 8192), 16, 0, 0); } while (0)
#define PG8_LDA(dst, b, h) do { _Pragma("unroll") for (int m = 0; m < 4; ++m) _Pragma("unroll") for (int k = 0; k < 2; ++k) dst[m][k] = *(const LAS bf16x8*)(lds + PG8_SA(b, h) + aoff + m * 2048 + k * 1024); } while (0)
#define PG8_LDB(dst, b, h) do { _Pragma("unroll") for (int n = 0; n < 2; ++n) _Pragma("unroll") for (int k = 0; k < 2; ++k) dst[n][k] = *(const LAS bf16x8*)(lds + PG8_SB(b, h) + boff + n * 2048 + k * 1024); } while (0)
#define PG8_MMA(ai, bj, At, Bt) do { __builtin_amdgcn_s_setprio(1); _Pragma("unroll") for (int m = 0; m < 4; ++m) _Pragma("unroll") for (int n = 0; n < 2; ++n) _Pragma("unroll") for (int k = 0; k < 2; ++k) \
        acc[ai][bj][m][n] = __builtin_amdgcn_mfma_f32_16x16x32_bf16(Bt[n][k], At[m][k], acc[ai][bj][m][n], 0, 0, 0); __builtin_amdgcn_s_setprio(0); } while (0)
#define PG8_WAIT_V(n) asm volatile("s_waitcnt vmcnt(" #n ")" ::: "memory")
#define PG8_WAIT_L(n) asm volatile("s_waitcnt lgkmcnt(" #n ")" ::: "memory")
#define PG8_BAR __builtin_amdgcn_s_barrier()
#define PG8_SCHED __builtin_amdgcn_sched_barrier(0)
    Unit cur, nxt; int ui = 0;
    if (!S.next(0, cur)) return;
    f32x4 acc[2][2][4][2];
#pragma unroll
    for (int a = 0; a < 2; ++a)
#pragma unroll
        for (int b = 0; b < 2; ++b)
#pragma unroll
            for (int m = 0; m < 4; ++m)
#pragma unroll
                for (int n = 0; n < 2; ++n) acc[a][b][m][n] = (f32x4){0.f, 0.f, 0.f, 0.f};
    bf16x8 At[4][2], B0[2][2], B1[2][2];
    const char* cA = (const char*)g.A + (size_t)cur.pm * tstepA; const char* cB = (const char*)g.Bt + (size_t)cur.pn * tstepB;
    PG8_STAGE(PG8_SB(0, 0), cB, voffB); PG8_STAGE(PG8_SA(0, 0), cA, voffA); PG8_STAGE(PG8_SB(0, 1), cB + hstepB, voffB); PG8_STAGE(PG8_SA(0, 1), cA + hstepA, voffA);
    if (wr == 1) PG8_BAR;
    PG8_WAIT_V(4); PG8_BAR;
    PG8_STAGE(PG8_SB(1, 0), cB + kstep, voffB); PG8_STAGE(PG8_SA(1, 0), cA + kstep, voffA); PG8_STAGE(PG8_SB(1, 1), cB + hstepB + kstep, voffB);
    PG8_WAIT_V(6); PG8_BAR;
    for (;;) {
        const bool has_next = S.next(ui + 1, nxt);
        const char* nA = has_next ? (const char*)g.A + (size_t)nxt.pm * tstepA : cA; const char* nB = has_next ? (const char*)g.Bt + (size_t)nxt.pn * tstepB : cB;
        for (int t = 0; t < nt; t += 2) {
            const bool last = (t == nt - 2);
            const char* a1 = cA + (size_t)(t + 1) * kstep;
            const char* a2 = last ? nA : cA + (size_t)(t + 2) * kstep; const char* b2 = last ? nB : cB + (size_t)(t + 2) * kstep;
            const char* a3 = a2 + kstep; const char* b3 = b2 + kstep;
            PG8_LDB(B0, 0, 0); PG8_SCHED; PG8_LDA(At, 0, 0); PG8_STAGE(PG8_SA(1, 1), a1 + hstepA, voffA);
            PG8_WAIT_L(8); PG8_BAR; PG8_WAIT_L(0); PG8_MMA(0, 0, At, B0); PG8_BAR; PG8_SCHED;
            PG8_LDB(B1, 0, 1); PG8_STAGE(PG8_SB(0, 0), b2, voffB);
            PG8_BAR; PG8_WAIT_L(0); PG8_MMA(0, 1, At, B1); PG8_BAR;
            PG8_LDA(At, 0, 1); PG8_STAGE(PG8_SA(0, 0), a2, voffA);
            PG8_BAR; PG8_WAIT_L(0); PG8_MMA(1, 0, At, B0); PG8_BAR; PG8_SCHED;
            PG8_STAGE(PG8_SB(0, 1), b2 + hstepB, voffB);
            PG8_WAIT_V(6); PG8_BAR; PG8_MMA(1, 1, At, B1); PG8_BAR;
            PG8_LDB(B0, 1, 0); PG8_SCHED; PG8_LDA(At, 1, 0); PG8_STAGE(PG8_SA(0, 1), a2 + hstepA, voffA);
            PG8_WAIT_L(8); PG8_BAR; PG8_WAIT_L(0); PG8_MMA(0, 0, At, B0); PG8_BAR; PG8_SCHED;
            PG8_LDB(B1, 1, 1); PG8_STAGE(PG8_SB(1, 0), b3, voffB);
            PG8_BAR; PG8_WAIT_L(0); PG8_MMA(0, 1, At, B1); PG8_BAR;
            PG8_LDA(At, 1, 1); PG8_STAGE(PG8_SA(1, 0), a3, voffA);
            PG8_BAR; PG8_WAIT_L(0); PG8_MMA(1, 0, At, B0); PG8_BAR; PG8_SCHED;
            PG8_STAGE(PG8_SB(1, 1), b3 + hstepB, voffB);
            PG8_WAIT_V(6); PG8_BAR; PG8_MMA(1, 1, At, B1); PG8_BAR;
        }
        E(acc, cur, wr, wc, fr, fq);
        if (!has_next) break;
#pragma unroll
        for (int a = 0; a < 2; ++a)
#pragma unroll
            for (int b = 0; b < 2; ++b)
#pragma unroll
                for (int m = 0; m < 4; ++m)
#pragma unroll
                    for (int n = 0; n < 2; ++n) acc[a][b][m][n] = (f32x4){0.f, 0.f, 0.f, 0.f};
        cur = nxt; cA = nA; cB = nB; ++ui;
    }
    PG8_WAIT_V(0);
    if (wr == 0) PG8_BAR;
    PG8_BAR;
#undef PG8_SA
#undef PG8_SB
#undef PG8_STAGE
#undef PG8_LDA
#undef PG8_LDB
#undef PG8_MMA
#undef PG8_WAIT_V
#undef PG8_WAIT_L
#undef PG8_BAR
#undef PG8_SCHED
}
}

template <class Epi>
DEV void run_gemm(unsigned char* shm, const u16* A, int lda, const u16* Bt, int ldb, int N, int K, const Epi& E) {
    asm volatile("" : "+s"(A), "+s"(Bt));
    pg8::Gemm g; g.A = A; g.Bt = Bt; g.M = NTOK; g.N = N; g.K = K; g.lda = lda; g.ldb = ldb;
    pg8::StaticOrder S; S.init(NTOK, N, (int)gridDim.x, (int)blockIdx.x);
    pg8::gemm_phase<Epi>((LAS unsigned char*)shm, g, S, E);
}

DEV void convT_tile(const float* __restrict__ src, u16* __restrict__ dst, int K, int N, int Npad, int tile, float* T) {
    const int tid = tidx(); const int ntn = Npad >> 6; const int k0 = (tile / ntn) << 6, n0 = (tile % ntn) << 6;
#pragma unroll
    for (int j = 0; j < 2; ++j) { const int idx = tid + j * 512; const int r = idx >> 4, c4 = (idx & 15) << 2;
        float4 v = make_float4(0.f, 0.f, 0.f, 0.f); if (n0 + c4 < N) v = *(const float4*)(src + (size_t)(k0 + r) * N + n0 + c4);
        float* t = T + r * 65 + c4; t[0] = v.x; t[1] = v.y; t[2] = v.z; t[3] = v.w; }
    __syncthreads();
    { const int nn = tid >> 3, kq = (tid & 7) << 3; const float* t = T + kq * 65 + nn;
        u32x4 o; o.x = pk(t[0], t[65]); o.y = pk(t[130], t[195]); o.z = pk(t[260], t[325]); o.w = pk(t[390], t[455]);
        *(u32x4*)(dst + (size_t)(n0 + nn) * K + k0 + kq) = o; }
    __syncthreads();
}
DEV int conv_ntiles(int job, int layer) { return job == 0 ? (layer ? 3200 : 3328) : job == 1 ? 1024 : job == 2 ? 5632 : 2816; }
DEV void conv_job(const Params& p, int job, int layer, int tile, float* T) {
    if (job == 0) convT_tile(layer ? p.in[36] : p.in[14], (u16*)(p.ws + OFF_WIN), 2048, layer ? 6176 : 6528, layer ? LDP1 : LDP0, tile, T);
    else if (job == 1) convT_tile(layer ? p.in[37] : p.in[15], (u16*)(p.ws + OFF_WOUT), 2048, 2048, 2048, tile, T);
    else if (job == 2) convT_tile(p.in[10] + (size_t)layer * 2048 * 11264, (u16*)(p.ws + OFF_WUP), 2048, 11264, 11264, tile, T);
    else convT_tile(p.in[12] + (size_t)layer * 5632 * 2048, (u16*)(p.ws + OFF_WDN), 5632, 2048, 2048, tile, T);
}

DEV void adaln_tile(const Params& p, int tile, float* sl) {
    const int tid = tidx(); const int nt = tile % 6, kc = (tile / 6) & 31, layer = tile / 192;
    if (tid < 320) { const int j = tid >> 6, kk = tid & 63; const float cv = (j < 4) ? p.in[4][j * 2048 + kc * 64 + kk] : p.in[5][kc * 64 + kk]; sl[tid] = cv / (1.f + expf(-cv)); }
    __syncthreads();
    const float* w = p.in[6] + ((size_t)layer * 2048 + kc * 64) * 12288 + nt * 2048 + tid * 4;
    float acc[5][4];
#pragma unroll
    for (int j = 0; j < 5; ++j) { acc[j][0] = 0.f; acc[j][1] = 0.f; acc[j][2] = 0.f; acc[j][3] = 0.f; }
#pragma unroll 8
    for (int kk = 0; kk < 64; ++kk) { const float4 wv = *(const float4*)(w + (size_t)kk * 12288);
#pragma unroll
        for (int j = 0; j < 5; ++j) { const float s = sl[j * 64 + kk]; acc[j][0] += s * wv.x; acc[j][1] += s * wv.y; acc[j][2] += s * wv.z; acc[j][3] += s * wv.w; } }
    float* m = (float*)(p.ws + OFF_A) + (size_t)kc * 122880 + (size_t)layer * 5 * 12288 + nt * 2048 + tid * 4;
#pragma unroll
    for (int j = 0; j < 5; ++j) *(float4*)(m + j * 12288) = make_float4(acc[j][0], acc[j][1], acc[j][2], acc[j][3]);
    __syncthreads();
}

DEV void hyfilt_tile(const Params& p, int tile, float* sm) {
    const int tid = tidx();
    int L, p0; u16* G; float* nrm = (float*)(p.ws + OFF_A) + 32 * 122880 + (size_t)tile * 2048;
    if (tile < 128) { L = 4096; p0 = tile * 32; G = (u16*)(p.ws + OFF_GS); }
    else { L = 256; p0 = (tile - 128) * 32; G = (u16*)(p.ws + OFF_GP); }
    float* z = sm; float* h1 = sm + 32 * 33; float* h2 = h1 + 2048;
    const float cang = (float)(6.283185307179586 / (double)L);
    for (int i = tid; i < 32 * 33; i += 512) { const int pp = i / 33, e = i % 33; const float pos = (float)(p0 + pp); float val;
        if (e == 0) val = pos / (float)(L - 1);
        else { const int bi = (e - 1) & 15; const float fb = 1e-4f + (float)bi * ((15.f - 1e-4f) / 15.f); const float ang = (cang * pos) * fb; val = (e <= 16) ? cosf(ang) : -sinf(ang); }
        z[i] = val; }
    __syncthreads();
    for (int i = tid; i < 2048; i += 512) { const int pp = i >> 6, j = i & 63; float a = p.in[19][j];
        for (int e = 0; e < 33; ++e) a += z[pp * 33 + e] * p.in[18][e * 64 + j];
        h1[i] = sinf(p.in[23][j] * a); }
    __syncthreads();
    for (int i = tid; i < 2048; i += 512) { const int pp = i >> 6, j = i & 63; float a = p.in[21][j];
        for (int e = 0; e < 64; ++e) a += h1[pp * 64 + e] * p.in[20][e * 64 + j];
        h2[i] = sinf(p.in[23][64 + j] * a); }
    __syncthreads();
    const float dlo = 3.0701134573253946f, dhi = 15.350567286626973f;
    for (int q = 0; q < 4; ++q) { const int n = tid + 512 * q; const int c = n & 1023; const int back = n >> 10;
        float wcol[64];
#pragma unroll
        for (int e = 0; e < 64; ++e) wcol[e] = p.in[22][e * 2048 + n];
        const float delta = dlo + (dhi - dlo) * ((float)c / 1023.f);
        float asum = 0.f;
        for (int pp = 0; pp < 32; ++pp) { float a = 0.f;
#pragma unroll
            for (int e = 0; e < 64; ++e) a += h2[pp * 64 + e] * wcol[e];
            const int pos = p0 + pp; const float t = (float)pos / (float)(L - 1); a *= expf(-t * delta);
            if (!(back && pos == 0)) { asum += fabsf(a); const int lag = back ? -pos : pos; G[(size_t)c * (2 * L) + (L - lag)] = f2bf(a); } }
        nrm[n] = asum; }
    if (p0 == 0) for (int c = tid; c < 1024; c += 512) G[(size_t)c * (2 * L)] = 0;
    __syncthreads();
}

DEV void phase_prep(const Params& p, unsigned char* shm) {
    const int tid = tidx(); float* sm = (float*)shm;
    if (blockIdx.x == 0 && tid == 0) *(unsigned*)(p.ws + OFF_SMALL + SMALL_BYTES) = 0u;
    { u16* LW = (u16*)(p.ws + OFF_LW); u16* G2T = (u16*)(p.ws + OFF_G2T);
        for (int i = blockIdx.x * 512 + tid; i < 4 * 1024 * 64 + 1024 * 128; i += gridDim.x * 512) {
            if (i < 262144) { const int mi = i >> 16, n = (i >> 6) & 1023, r = i & 63; LW[i] = f2bf((mi < 2 ? p.in[27] : p.in[29])[((size_t)(mi & 1) * 64 + r) * 1024 + n]); }
            else { const int j = i - 262144; const int n = j >> 7, r = j & 127; G2T[j] = f2bf(p.in[30][(size_t)r * 1024 + n]); } } }
    const int n0 = 136, n1 = n0 + 384, n2 = n1 + 3328, n3 = n2 + 1024, n4 = n3 + 5632, n5 = n4 + 2816;
    for (int t = blockIdx.x; t < n5; t += gridDim.x) {
        if (t < n0) hyfilt_tile(p, t, sm);
        else if (t < n1) adaln_tile(p, t - n0, sm);
        else if (t < n2) conv_job(p, 0, 0, t - n1, sm);
        else if (t < n3) conv_job(p, 1, 0, t - n2, sm);
        else if (t < n4) conv_job(p, 2, 0, t - n3, sm);
        else conv_job(p, 3, 0, t - n4, sm);
    }
}

DEV void phase_reduce(const Params& p) {
    const float* part = (const float*)(p.ws + OFF_A); float* mods = (float*)(p.ws + OFF_SMALL); float* hn = (float*)(p.ws + OFF_SMALL + 491520);
    for (int i = blockIdx.x * 512 + tidx(); i < 122880 + 2048; i += gridDim.x * 512) {
        if (i < 122880) { float a = 0.f; for (int kc = 0; kc < 32; ++kc) a += part[(size_t)kc * 122880 + i]; mods[i] = a; }
        else { const int j = i - 122880; const int c = j & 1023; const float* hp = part + 32 * 122880; float a = 0.f;
            if (j < 1024) { for (int t = 0; t < 128; ++t) a += hp[(size_t)t * 2048 + c] + hp[(size_t)t * 2048 + 1024 + c]; }
            else { for (int t = 128; t < 136; ++t) a += hp[(size_t)t * 2048 + c] + hp[(size_t)t * 2048 + 1024 + c]; }
            hn[j] = a; }
    }
}

DEV void phase_norm(const Params& p, int layer, int which, unsigned char* shm) {
    const int tid = tidx(), wid = tid >> 6, lane = tid & 63;
    const float* g = p.in[which ? 9 : 8] + layer * 2048;
    const float* X = p.out; u16* A = (u16*)(p.ws + OFF_A);
    const float* mods = (const float*)(p.ws + OFF_SMALL) + (size_t)layer * 5 * 12288; const float* bb = p.in[7] + layer * 12288;
    const int shi = which ? 3 : 0;
    for (int row = blockIdx.x * 8 + wid; row < NTOK; row += gridDim.x * 8) {
        const bool first = (layer == 0 && which == 0);
        const float* xsrc = X + (size_t)row * DM; if (first) xsrc = row < NTP ? p.in[0] + (size_t)row * DM : p.in[1] + (size_t)(row - NTP) * DM;
        const float4* xr = (const float4*)xsrc;
        float4 v[8]; float ss = 0.f;
#pragma unroll
        for (int j = 0; j < 8; ++j) { v[j] = xr[lane + 64 * j]; ss += v[j].x * v[j].x + v[j].y * v[j].y + v[j].z * v[j].z + v[j].w * v[j].w; }
        if (first) {
#pragma unroll
            for (int j = 0; j < 8; ++j) ((float4*)(p.out + (size_t)row * DM))[lane + 64 * j] = v[j]; }
        ss = wave_sum(ss);
        const float rstd = rsqrtf(ss * (1.f / 2048.f) + 1e-6f);
        const float* md = mods + (size_t)tok_cond(row) * 12288;
#pragma unroll
        for (int j = 0; j < 8; ++j) { const int col = (lane + 64 * j) * 4;
            const float4 gg = *(const float4*)(g + col);
            const float4 s1 = *(const float4*)(md + shi * 2048 + col), s2 = *(const float4*)(bb + shi * 2048 + col);
            const float4 c1 = *(const float4*)(md + (shi + 1) * 2048 + col), c2 = *(const float4*)(bb + (shi + 1) * 2048 + col);
            const float o0 = v[j].x * rstd * gg.x * (1.f + c1.x + c2.x) + s1.x + s2.x;
            const float o1 = v[j].y * rstd * gg.y * (1.f + c1.y + c2.y) + s1.y + s2.y;
            const float o2 = v[j].z * rstd * gg.z * (1.f + c1.z + c2.z) + s1.z + s2.z;
            const float o3 = v[j].w * rstd * gg.w * (1.f + c1.w + c2.w) + s1.w + s2.w;
            u32x2 o; o.x = pk(o0, o1); o.y = pk(o2, o3);
            *(u32x2*)(A + (size_t)row * DM + col) = o; }
    }
    if (layer == 0 && which == 1) { const int na = conv_ntiles(0, 1), nb = na + conv_ntiles(1, 1);
        for (int t = blockIdx.x; t < nb; t += gridDim.x) { if (t < na) conv_job(p, 0, 1, t, (float*)shm); else conv_job(p, 1, 1, t - na, (float*)shm); } }
    if (layer == 1 && which == 0) { const int na = conv_ntiles(2, 1), nb = na + conv_ntiles(3, 1);
        for (int t = blockIdx.x; t < nb; t += gridDim.x) { if (t < na) conv_job(p, 2, 1, t, (float*)shm); else conv_job(p, 3, 1, t - na, (float*)shm); } }
}

DEV void sconv8(const u16* prow, bool hm, bool hp, const float* sw, const float* sb, int ch, float* o) {
    float c[8], m[8], q[8];
    unpack8(*(const u32x4*)(prow + ch), c);
    if (hm) unpack8(*(const u32x4*)(prow - LDP0 + ch), m); else { for (int i = 0; i < 8; ++i) m[i] = 0.f; }
    if (hp) unpack8(*(const u32x4*)(prow + LDP0 + ch), q); else { for (int i = 0; i < 8; ++i) q[i] = 0.f; }
#pragma unroll
    for (int i = 0; i < 8; ++i) o[i] = m[i] * sw[ch + i] + c[i] * sw[3072 + ch + i] + q[i] * sw[6144 + ch + i] + sb[ch + i];
}
DEV void hy_pre_tile(const Params& p, int tile, float* T) {
    const int tid = tidx(); const int tok0 = (tile >> 4) << 6, c0 = (tile & 15) << 6;
    const u16* P = (const u16*)(p.ws + OFF_P); u16* uT = (u16*)(p.ws + OFF_UT);
    { const int tk = tid >> 3, c8 = (tid & 7) << 3; const int tok = tok0 + tk; int t, L; tok_tl(tok, t, L);
        const u16* prow = P + (size_t)tok * LDP0; float x1[8], vv[8];
        sconv8(prow, t > 0, t < L - 1, p.in[16], p.in[17], 1024 + c0 + c8, x1);
        sconv8(prow, t > 0, t < L - 1, p.in[16], p.in[17], 2048 + c0 + c8, vv);
#pragma unroll
        for (int i = 0; i < 8; ++i) T[tk * 65 + c8 + i] = x1[i] * vv[i]; }
    __syncthreads();
    { const int ch = tid >> 3, t8 = (tid & 7) << 3; const float* t = T + t8 * 65 + ch;
        u32x4 o; o.x = pk(t[0], t[65]); o.y = pk(t[130], t[195]); o.z = pk(t[260], t[325]); o.w = pk(t[390], t[455]);
        *(u32x4*)(uT + (size_t)(c0 + ch) * NTOK + tok0 + t8) = o; }
    __syncthreads();
}
DEV void hy_post_tile(const Params& p, int tile, float* T) {
    const int tid = tidx(); const int tok0 = (tile >> 4) << 6, c0 = (tile & 15) << 6;
    const u16* P = (const u16*)(p.ws + OFF_P); const u16* uT = (const u16*)(p.ws + OFF_UT); u16* ycat = (u16*)(p.ws + OFF_A);
    { const int ch = tid >> 3, t8 = (tid & 7) << 3; float y[8]; unpack8(*(const u32x4*)(uT + (size_t)(c0 + ch) * NTOK + tok0 + t8), y);
#pragma unroll
        for (int i = 0; i < 8; ++i) T[(t8 + i) * 65 + ch] = y[i]; }
    __syncthreads();
    { const int tk = tid >> 3, c8 = (tid & 7) << 3; const int tok = tok0 + tk; int t, L; tok_tl(tok, t, L);
        const u16* prow = P + (size_t)tok * LDP0; float x0[8], x1[8], vv[8], o[8];
        sconv8(prow, t > 0, t < L - 1, p.in[16], p.in[17], c0 + c8, x0);
        sconv8(prow, t > 0, t < L - 1, p.in[16], p.in[17], 1024 + c0 + c8, x1);
        sconv8(prow, t > 0, t < L - 1, p.in[16], p.in[17], 2048 + c0 + c8, vv);
        const float* nrm = (const float*)(p.ws + OFF_SMALL + 491520) + (tok < NTP ? 1024 : 0);
#pragma unroll
        for (int i = 0; i < 8; ++i) { const int c = c0 + c8 + i; o[i] = x0[i] * (T[tk * 65 + c8 + i] * __builtin_amdgcn_rcpf(nrm[c]) + x1[i] * vv[i] * p.in[24][c]); }
        u32x4 w; w.x = pk(o[0], o[1]); w.y = pk(o[2], o[3]); w.z = pk(o[4], o[5]); w.w = pk(o[6], o[7]);
        *(u32x4*)(ycat + (size_t)tok * DM + c0 + c8) = w; }
    __syncthreads();
}
DEV void hyconv_task(const Params& p, int task, unsigned char* shm) {
    const int tid = tidx(), wid = tid >> 6, lane = tid & 63;
    const bool sample = task < 1024; const int c = sample ? task : task - 1024;
    const int L = sample ? 4096 : 256, NB = sample ? 4 : 32, lgNB = sample ? 2 : 5, LP = L + 8;
    u16* uL = (u16*)shm; u16* gL = uL + NB * LP; u16* gS = gL + 2 * L;
    const u16* G = sample ? (const u16*)(p.ws + OFF_GS) + (size_t)c * 8192 : (const u16*)(p.ws + OFF_GP) + (size_t)c * 512;
    u16* uT = (u16*)(p.ws + OFF_UT) + (size_t)c * NTOK + (sample ? NTP : 0);
    for (int i = tid * 8; i < NB * L; i += 4096) { const int b = i / L, s = i % L; *(u32x4*)(uL + b * LP + s) = *(const u32x4*)(uT + i); }
    for (int i = tid * 8; i < 2 * L; i += 4096) { const u32x4 w = *(const u32x4*)(G + i); *(u32x4*)(gL + i) = w;
        const unsigned nx = (i + 8 < 2 * L) ? (unsigned)G[i + 8] : 0u;
        u32x4 sft; sft.x = (w.x >> 16) | (w.y << 16); sft.y = (w.y >> 16) | (w.z << 16); sft.z = (w.z >> 16) | (w.w << 16); sft.w = (w.w >> 16) | (nx << 16);
        *(u32x4*)(gS + i) = sft; }
    __syncthreads();
    const int ntile = (NB * (L >> 5)) >> 5;
    const int npair = sample ? 8 : 8; const bool two = sample;
    const int r = lane & 31, half = lane >> 5;
    {
        const int ct0 = two ? 2 * wid : wid;
        const int colA = ct0 * 32 + r, colB = colA + 32;
        const int bA = colA & (NB - 1), iA = colA >> lgNB, bB = colB & (NB - 1), iB = colB >> lgNB; const int tA = iA * 32, tB = iB * 32;
        const int i_lo = (ct0 * 32) >> lgNB, i_hi = ((two ? ct0 + 1 : ct0) * 32 + 31) >> lgNB;
        const int d_lo = 32 * i_lo - (L - 16), d_hi = 32 * i_hi;
        f32x16 accA, accB;
#pragma unroll
        for (int j = 0; j < 16; ++j) { accA[j] = 0.f; accB[j] = 0.f; }
        const u16* ubA = uL + bA * LP + 8 * half; const u16* ubB = uL + bB * LP + 8 * half;
        const u16* gsel = (r & 1) ? gS : gL;
        const int qb = (L - r + 8 * half) & ~1;
#pragma unroll 4
        for (int dl = d_lo; dl <= d_hi; dl += 16) {
            const unsigned* gq = (const unsigned*)(gsel + (qb - dl));
            u32x4 aw; aw.x = gq[0]; aw.y = gq[1]; aw.z = gq[2]; aw.w = gq[3];
            const bf16x8 a = __builtin_bit_cast(bf16x8, aw);
            const int sA = tA - dl, sB = tB - dl;
            bf16x8 bvA = (bf16x8){0, 0, 0, 0, 0, 0, 0, 0}, bvB = bvA;
            if (sA >= 0 && sA <= L - 16) bvA = *(const bf16x8*)(ubA + sA);
            accA = __builtin_amdgcn_mfma_f32_32x32x16_bf16(a, bvA, accA, 0, 0, 0);
            if (two) { if (sB >= 0 && sB <= L - 16) bvB = *(const bf16x8*)(ubB + sB);
                accB = __builtin_amdgcn_mfma_f32_32x32x16_bf16(a, bvB, accB, 0, 0, 0); }
        }
#pragma unroll
        for (int g = 0; g < 4; ++g) { u32x2 w; w.x = pk(accA[4 * g], accA[4 * g + 1]); w.y = pk(accA[4 * g + 2], accA[4 * g + 3]);
            *(u32x2*)(uT + (size_t)bA * L + tA + 8 * g + 4 * half) = w; }
        if (two) {
#pragma unroll
            for (int g = 0; g < 4; ++g) { u32x2 w; w.x = pk(accB[4 * g], accB[4 * g + 1]); w.y = pk(accB[4 * g + 2], accB[4 * g + 3]);
                *(u32x2*)(uT + (size_t)bB * L + tB + 8 * g + 4 * half) = w; } }
    }
    (void)ntile; (void)npair;
    __syncthreads();
}

DEV void rwkv_lora_tile(const Params& p, int tile, unsigned char* shm) {
    const int tid = tidx(), wid = tid >> 6, lane = tid & 63, l15 = lane & 15, quad = lane >> 4; const int tok0 = tile * 32;
    const u16* P = (const u16*)(p.ws + OFF_P); u16* RW = (u16*)(p.ws + OFF_RW); const u16* LW = (const u16*)(p.ws + OFF_LW);
    u16* Ain = (u16*)shm;
    u16* Ol = (u16*)(shm + 18432);
    for (int i = tid; i < 32 * 256; i += 512) { const int tk = i >> 8, cc = i & 255; const int tok = tok0 + tk; int t, L; tok_tl(tok, t, L);
        const u16* pp = P + (size_t)tok * LDP0 + 6144 + cc; float x = bf2f(*pp); const float xm = t > 0 ? bf2f(pp[-LDP0]) : 0.f; const float xp = t < L - 1 ? bf2f(pp[LDP0]) : 0.f;
        const float mu = p.in[25][3072 + cc]; x = x + mu * (0.5f * (xm + xp) - x); if (cc < 128) x = tanhf(x);
        Ain[((cc >> 6) * 32 + tk) * 72 + (cc & 63)] = f2bf(x); }
    __syncthreads();
#pragma unroll 1
    for (int mi = 0; mi < 4; ++mi) {
        const float* bias = (mi < 2 ? p.in[26] : p.in[28]) + (mi & 1) * 1024;
        const float osc = mi < 2 ? 0.6065306597f : 1.f;
        bf16x8 af[2][2];
#pragma unroll
        for (int tt = 0; tt < 2; ++tt)
#pragma unroll
            for (int ks = 0; ks < 2; ++ks) af[tt][ks] = *(const bf16x8*)(Ain + (mi * 32 + tt * 16 + l15) * 72 + ks * 32 + quad * 8);
#pragma unroll 2
        for (int q = 0; q < 8; ++q) { const int nt = wid * 8 + q; const int n = nt * 16 + l15;
            const bf16x8 b0 = *(const bf16x8*)(LW + ((size_t)mi * 1024 + n) * 64 + quad * 8), b1 = *(const bf16x8*)(LW + ((size_t)mi * 1024 + n) * 64 + 32 + quad * 8);
            const float bs = bias[n];
#pragma unroll
            for (int tt = 0; tt < 2; ++tt) { f32x4 acc = (f32x4){0.f, 0.f, 0.f, 0.f}; acc = mfma16(af[tt][0], b0, acc); acc = mfma16(af[tt][1], b1, acc);
#pragma unroll
                for (int r = 0; r < 4; ++r) Ol[(tt * 16 + quad * 4 + r) * 1032 + n] = f2bf(osc * sigm(acc[r] + bs)); } }
        __syncthreads();
#pragma unroll
        for (int i = 0; i < 8; ++i) { const int piece = tid + 512 * i; const int tk = piece >> 7, c8 = (piece & 127) * 8;
            *(u32x4*)(RW + (size_t)(tok0 + tk) * 4096 + mi * 1024 + c8) = *(const u32x4*)(Ol + tk * 1032 + c8); }
        __syncthreads();
    }
}
DEV float mixf(float c, float m, float q, float mu) { return c + mu * (0.5f * (m + q) - c); }
DEV void rwkv_scan_task(const Params& p, int task, float* sm) {
    const bool sample = task < 128; const int tt_ = sample ? task : task - 128;
    const int b = tt_ >> 5, h = (tt_ >> 1) & 15, dir = tt_ & 1;
    const int L = sample ? 4096 : 256; const int tok0 = sample ? NTP + b * 4096 : b * 256;
    const int tid = tidx(), wid = tid >> 6, lane = tid & 63;
    const int kl = lane & 7;
    const int row2 = (wid & 3) * 16 + (lane >> 3) * 2;
    float S[8], T[8];
    const size_t so2 = ((((size_t)b * 2 + dir) * 16 + h) * 64 + row2) * 64 + kl * 8;
    if (sample) {
        const float4 a = *(const float4*)(p.in[2] + so2), c = *(const float4*)(p.in[2] + so2 + 4), d = *(const float4*)(p.in[2] + so2 + 64), e = *(const float4*)(p.in[2] + so2 + 68);
        S[0] = a.x; S[1] = a.y; S[2] = a.z; S[3] = a.w; S[4] = c.x; S[5] = c.y; S[6] = c.z; S[7] = c.w;
        T[0] = d.x; T[1] = d.y; T[2] = d.z; T[3] = d.w; T[4] = e.x; T[5] = e.y; T[6] = e.z; T[7] = e.w; }
    else {
#pragma unroll
        for (int i = 0; i < 8; ++i) { S[i] = 0.f; T[i] = 0.f; } }
    f32x2 S2[4], T2[4];
#pragma unroll
    for (int i = 0; i < 4; ++i) { S2[i] = (f32x2){S[2 * i], S[2 * i + 1]}; T2[i] = (f32x2){T[2 * i], T[2 * i + 1]}; }
    const int pk4 = (tid & 15) * 4; const int ch = h * 64 + pk4; const int plt = (tid & 255) >> 4;
    const float4 mur = *(const float4*)(p.in[25] + ch), muk = *(const float4*)(p.in[25] + 1024 + ch), muv = *(const float4*)(p.in[25] + 2048 + ch);
    const float4 kkw = *(const float4*)(p.in[31] + ch), kaw = *(const float4*)(p.in[32] + ch);
    const float murA[4] = {mur.x, mur.y, mur.z, mur.w}, mukA[4] = {muk.x, muk.y, muk.z, muk.w}, muvA[4] = {muv.x, muv.y, muv.z, muv.w};
    const float kkwA[4] = {kkw.x, kkw.y, kkw.z, kkw.w}, kawA[4] = {kaw.x, kaw.y, kaw.z, kaw.w};
    const u16* P = (const u16*)(p.ws + OFF_P); const u16* RW = (const u16*)(p.ws + OFF_RW);
    u16* Y = (u16*)(p.out + OUT_GLAST) + (dir ? (size_t)NTOK * 1024 : 0);
#define RW_PREP(c0_, buf_) do { float* vec_ = sm + (buf_) * 14336; float* vvs_ = vec_ + 10240; \
        _Pragma("unroll 1") for (int ps = 0; ps < 2; ++ps) { const int ptt = plt + 16 * ps; \
            const int t = dir ? (L - 1 - ((c0_) + ptt)) : ((c0_) + ptt); const size_t tok = (size_t)tok0 + t; \
            const u16* pr = P + tok * LDP0 + 3072 + ch; \
            float rc[4], kc[4], vc[4], rm[4], km[4], vm[4], rp[4], kp[4], vp[4], ee[4], aa[4]; \
            unpack4(*(const u32x2*)(pr), rc); unpack4(*(const u32x2*)(pr + 1024), kc); unpack4(*(const u32x2*)(pr + 2048), vc); \
            if (t > 0) { const u16* pm = P + (tok - 1) * LDP0 + 3072 + ch; unpack4(*(const u32x2*)(pm), rm); unpack4(*(const u32x2*)(pm + 1024), km); unpack4(*(const u32x2*)(pm + 2048), vm); } \
            else { for (int i = 0; i < 4; ++i) { rm[i] = 0.f; km[i] = 0.f; vm[i] = 0.f; } } \
            if (t < L - 1) { unpack4(*(const u32x2*)(pr + LDP0), rp); unpack4(*(const u32x2*)(pr + LDP0 + 1024), kp); unpack4(*(const u32x2*)(pr + LDP0 + 2048), vp); } \
            else { for (int i = 0; i < 4; ++i) { rp[i] = 0.f; kp[i] = 0.f; vp[i] = 0.f; } } \
            unpack4(*(const u32x2*)(RW + tok * 4096 + dir * 1024 + ch), ee); unpack4(*(const u32x2*)(RW + tok * 4096 + (2 + dir) * 1024 + ch), aa); \
            float r4[4], k4[4], v4[4], kr[4]; float ss = 0.f; \
            _Pragma("unroll") for (int i = 0; i < 4; ++i) { r4[i] = mixf(rc[i], rm[i], rp[i], murA[i]); k4[i] = mixf(kc[i], km[i], kp[i], mukA[i]); v4[i] = mixf(vc[i], vm[i], vp[i], muvA[i]); \
                kr[i] = k4[i] * kkwA[i]; ss += kr[i] * kr[i]; } \
            ss = sum16(ss); const float inv = rsqrtf(ss + 1e-12f); \
            float tkk[4], tw[4], tkka[4], tkd[4]; \
            _Pragma("unroll") for (int i = 0; i < 4; ++i) { tkk[i] = kr[i] * inv; tw[i] = __expf(-ee[i]); tkka[i] = tkk[i] * aa[i]; tkd[i] = k4[i] * (1.f + (aa[i] - 1.f) * kawA[i]); } \
            float* vj = vec_ + ptt * 320 + pk4; \
            *(float4*)(vj) = make_float4(tkk[0], tkk[1], tkk[2], tkk[3]); *(float4*)(vj + 64) = make_float4(tw[0], tw[1], tw[2], tw[3]); *(float4*)(vj + 128) = make_float4(tkka[0], tkka[1], tkka[2], tkka[3]); \
            *(float4*)(vj + 192) = make_float4(tkd[0], tkd[1], tkd[2], tkd[3]); *(float4*)(vj + 256) = make_float4(r4[0], r4[1], r4[2], r4[3]); \
            *(float4*)(vvs_ + ptt * 64 + pk4) = make_float4(v4[0], v4[1], v4[2], v4[3]); } } while (0)
#define RW_YOUT(c0_, buf_) do { const float* yb_ = sm + (buf_) * 14336 + 12288; \
        _Pragma("unroll 1") for (int ps = 0; ps < 2; ++ps) { const int ptt = plt + 16 * ps; const int t = dir ? (L - 1 - ((c0_) + ptt)) : ((c0_) + ptt); \
            const float4 yv = *(const float4*)(yb_ + ptt * 64 + pk4); u32x2 w; w.x = pk(yv.x, yv.y); w.y = pk(yv.z, yv.w); \
            *(u32x2*)(Y + ((size_t)tok0 + t) * 1024 + ch) = w; } } while (0)
    const int nchunk = L >> 5;
    if (wid >= 4) RW_PREP(0, 0);
    __syncthreads();
#pragma unroll 1
    for (int c = 0; c < nchunk; ++c) {
        if (wid < 4) {
            const float* vec = sm + (c & 1) * 14336; const float* vvs = vec + 10240; float* yb = sm + (c & 1) * 14336 + 12288;
#pragma unroll
            for (int j = 0; j < 32; ++j) {
                const float* vj = vec + j * 320 + kl * 8;
                const f32x4 a0 = *(const f32x4*)(vj), a1 = *(const f32x4*)(vj + 4);
                const f32x4 w0 = *(const f32x4*)(vj + 64), w1 = *(const f32x4*)(vj + 68);
                const f32x4 b0 = *(const f32x4*)(vj + 128), b1 = *(const f32x4*)(vj + 132);
                const f32x4 d0 = *(const f32x4*)(vj + 192), d1 = *(const f32x4*)(vj + 196);
                const f32x4 r0 = *(const f32x4*)(vj + 256), r1 = *(const f32x4*)(vj + 260);
                const float2 vr = *(const float2*)(vvs + j * 64 + row2);
                const f32x2 kk0 = a0.lo, kk1 = a0.hi, kk2 = a1.lo, kk3 = a1.hi;
                f32x2 pa = S2[0] * kk0; pa += S2[1] * kk1; pa += S2[2] * kk2; pa += S2[3] * kk3;
                f32x2 pb = T2[0] * kk0; pb += T2[1] * kk1; pb += T2[2] * kk2; pb += T2[3] * kk3;
                const float sa = -sum8(pa.x + pa.y), sb = -sum8(pb.x + pb.y);
                const f32x2 sa2 = (f32x2){sa, sa}, sb2 = (f32x2){sb, sb}, vx2 = (f32x2){vr.x, vr.x}, vy2 = (f32x2){vr.y, vr.y};
                S2[0] = S2[0] * w0.lo + (sa2 * b0.lo + vx2 * d0.lo); S2[1] = S2[1] * w0.hi + (sa2 * b0.hi + vx2 * d0.hi);
                S2[2] = S2[2] * w1.lo + (sa2 * b1.lo + vx2 * d1.lo); S2[3] = S2[3] * w1.hi + (sa2 * b1.hi + vx2 * d1.hi);
                T2[0] = T2[0] * w0.lo + (sb2 * b0.lo + vy2 * d0.lo); T2[1] = T2[1] * w0.hi + (sb2 * b0.hi + vy2 * d0.hi);
                T2[2] = T2[2] * w1.lo + (sb2 * b1.lo + vy2 * d1.lo); T2[3] = T2[3] * w1.hi + (sb2 * b1.hi + vy2 * d1.hi);
                f32x2 qa = S2[0] * r0.lo; qa += S2[1] * r0.hi; qa += S2[2] * r1.lo; qa += S2[3] * r1.hi;
                f32x2 qb = T2[0] * r0.lo; qb += T2[1] * r0.hi; qb += T2[2] * r1.lo; qb += T2[3] * r1.hi;
                const float y0 = sum8(qa.x + qa.y), y1 = sum8(qb.x + qb.y);
                if (kl == 0) *(float2*)(yb + j * 64 + row2) = make_float2(y0, y1);
            }
        } else {
            if (c > 0) RW_YOUT((c - 1) * 32, (c - 1) & 1);
            if (c + 1 < nchunk) RW_PREP((c + 1) * 32, (c + 1) & 1);
        }
        __syncthreads();
    }
    if (wid >= 4) RW_YOUT((nchunk - 1) * 32, (nchunk - 1) & 1);
#undef RW_PREP
#undef RW_YOUT
#pragma unroll
    for (int i = 0; i < 4; ++i) { S[2 * i] = S2[i].x; S[2 * i + 1] = S2[i].y; T[2 * i] = T2[i].x; T[2 * i + 1] = T2[i].y; }
    if (!sample && wid < 4) { float* so = p.out + OUT_RWST + so2;
        *(float4*)(so) = make_float4(S[0], S[1], S[2], S[3]); *(float4*)(so + 4) = make_float4(S[4], S[5], S[6], S[7]);
        *(float4*)(so + 64) = make_float4(T[0], T[1], T[2], T[3]); *(float4*)(so + 68) = make_float4(T[4], T[5], T[6], T[7]); }
    __syncthreads();
}
DEV void rwkv_post_tile(const Params& p, int tile, float* sm) {
    const int tid = tidx(); const int tok0 = tile * 32;
    const u16* P = (const u16*)(p.ws + OFF_P); const u16* RW = (const u16*)(p.ws + OFF_RW); u16* ycat = (u16*)(p.ws + OFF_A);
    const u16* YF = (const u16*)(p.out + OUT_GLAST); const u16* YB = YF + (size_t)NTOK * 1024;
    u16* Gh = (u16*)(sm + 4096);
    for (int i = tid; i < 32 * 128; i += 512) { const int tk = i >> 7, r = i & 127; const int tok = tok0 + tk; int t, L; tok_tl(tok, t, L);
        const u16* pp = P + (size_t)tok * LDP0 + 6400 + r; const float x = bf2f(*pp); const float xm = t > 0 ? bf2f(pp[-LDP0]) : 0.f; const float xp = t < L - 1 ? bf2f(pp[LDP0]) : 0.f;
        sm[i] = sigm(mixf(x, xm, xp, p.in[25][3328 + r])); }
    __syncthreads();
    { float g0[32], g1[32];
#pragma unroll
        for (int k = 0; k < 32; ++k) { g0[k] = 0.f; g1[k] = 0.f; }
        const float* g2 = p.in[30];
        for (int r = 0; r < 128; r += 4) {
            float wa[4], wb[4];
#pragma unroll
            for (int q = 0; q < 4; ++q) { wa[q] = g2[(r + q) * 1024 + tid]; wb[q] = g2[(r + q) * 1024 + 512 + tid]; }
#pragma unroll
            for (int k = 0; k < 32; ++k) { const float4 s4 = *(const float4*)(sm + k * 128 + r);
                g0[k] += s4.x * wa[0] + s4.y * wa[1] + s4.z * wa[2] + s4.w * wa[3]; g1[k] += s4.x * wb[0] + s4.y * wb[1] + s4.z * wb[2] + s4.w * wb[3]; } }
#pragma unroll
        for (int k = 0; k < 32; ++k) { Gh[k * 1024 + tid] = f2bf(g0[k]); Gh[k * 1024 + 512 + tid] = f2bf(g1[k]); } }
    __syncthreads();
    const int c8 = (tid & 127) * 8;
    float mur[8], muk[8], muv[8], ka[8], rk[8], lw[8], lb[8];
#pragma unroll
    for (int i = 0; i < 8; ++i) { mur[i] = p.in[25][c8 + i]; muk[i] = p.in[25][1024 + c8 + i]; muv[i] = p.in[25][2048 + c8 + i]; ka[i] = p.in[32][c8 + i]; rk[i] = p.in[33][c8 + i]; lw[i] = p.in[34][c8 + i]; lb[i] = p.in[35][c8 + i]; }
#pragma unroll 1
    for (int it = 0; it < 8; ++it) { const int tk = (tid >> 7) + 4 * it; const int tok = tok0 + tk; int t, L; tok_tl(tok, t, L);
        const u16* pr = P + (size_t)tok * LDP0 + 3072 + c8; const bool hm = t > 0, hp = t < L - 1;
        float rc[8], rm[8], rp[8], kc[8], km[8], kp[8], vc[8], vm[8], vp[8], a0[8], a1[8], yf[8], yb[8], gg[8];
        unpack8(*(const u32x4*)pr, rc); unpack8(*(const u32x4*)(pr + 1024), kc); unpack8(*(const u32x4*)(pr + 2048), vc);
        if (hm) { const u16* pm = P + (size_t)(tok - 1) * LDP0 + 3072 + c8; unpack8(*(const u32x4*)(pm), rm); unpack8(*(const u32x4*)(pm + 1024), km); unpack8(*(const u32x4*)(pm + 2048), vm); }
        else { for (int i = 0; i < 8; ++i) { rm[i] = 0.f; km[i] = 0.f; vm[i] = 0.f; } }
        if (hp) { unpack8(*(const u32x4*)(pr + LDP0), rp); unpack8(*(const u32x4*)(pr + LDP0 + 1024), kp); unpack8(*(const u32x4*)(pr + LDP0 + 2048), vp); }
        else { for (int i = 0; i < 8; ++i) { rp[i] = 0.f; kp[i] = 0.f; vp[i] = 0.f; } }
        unpack8(*(const u32x4*)(RW + (size_t)tok * 4096 + 2048 + c8), a0); unpack8(*(const u32x4*)(RW + (size_t)tok * 4096 + 3072 + c8), a1);
        unpack8(*(const u32x4*)(YF + (size_t)tok * 1024 + c8), yf); unpack8(*(const u32x4*)(YB + (size_t)tok * 1024 + c8), yb);
        unpack8(*(const u32x4*)(Gh + tk * 1024 + c8), gg);
        float y[8], v_[8]; float bon = 0.f, sy = 0.f;
#pragma unroll
        for (int i = 0; i < 8; ++i) { const float r_ = mixf(rc[i], rm[i], rp[i], mur[i]), k_ = mixf(kc[i], km[i], kp[i], muk[i]); v_[i] = mixf(vc[i], vm[i], vp[i], muv[i]);
            bon += r_ * k_ * (2.f + (a0[i] + a1[i] - 2.f) * ka[i]) * rk[i]; y[i] = yf[i] + yb[i]; sy += y[i]; }
        bon = sum8(bon); const float mean = sum8(sy) * (1.f / 64.f);
        float sv = 0.f;
#pragma unroll
        for (int i = 0; i < 8; ++i) { y[i] -= mean; sv += y[i] * y[i]; }
        const float rstd = rsqrtf(sum8(sv) * (1.f / 64.f) + 64e-5f);
        float o[8];
#pragma unroll
        for (int i = 0; i < 8; ++i) o[i] = (y[i] * rstd * lw[i] + lb[i] + bon * v_[i]) * gg[i];
        u32x4 w; w.x = pk(o[0], o[1]); w.y = pk(o[2], o[3]); w.z = pk(o[4], o[5]); w.w = pk(o[6], o[7]);
        *(u32x4*)(ycat + (size_t)tok * DM + 1024 + c8) = w; }
    __syncthreads();
}

DEV float logsig(float x) { return fminf(x, 0.f) - __logf(1.f + __expf(-fabsf(x))); }
DEV void gla_intra_task(const Params& p, int task, unsigned char* shm) {
    const int tid = tidx(), wid = tid >> 6, lane = tid & 63, l15 = lane & 15, quad = lane >> 4;
    const int cidx = task >> 2, h = task & 3; const int tok0 = cidx * 64;
    u16* P = (u16*)(p.ws + OFF_P); u16* QB = (u16*)(p.ws + OFF_A); float* Dbuf = (float*)(p.ws + OFF_DB);
    u16* qi = (u16*)shm; u16* ki = qi + 64 * 264; u16* vl = (u16*)shm; u16* Pl = (u16*)(shm + 67584); float* gl = (float*)(shm + 76800); float* tot = (float*)(shm + 84992);
    for (int i = tid; i < 2048; i += 512) { const int tl = i >> 5, c = i & 31; gl[i] = bf2f(P[(size_t)(tok0 + tl) * LDP1 + 6144 + c]); }
    __syncthreads();
    const int k = tid & 255, jh = tid >> 8;
#pragma unroll 1
    for (int dd = 0; dd < 2; ++dd) { const int dir = 1 - dd;
        float g2r[16];
#pragma unroll
        for (int r = 0; r < 16; ++r) g2r[r] = p.in[38][(size_t)(dir * 16 + r) * 1024 + h * 256 + k];
        const float gb = p.in[39][dir * 1024 + h * 256 + k];
        float bl[32]; float run = 0.f;
#pragma unroll
        for (int jj = 0; jj < 32; ++jj) { const int j = jh * 32 + jj; const int tl = dir ? 63 - j : j; const float* gr = gl + tl * 32 + dir * 16;
            float x = gb;
#pragma unroll
            for (int r = 0; r < 16; r += 4) { const float4 g4 = *(const float4*)(gr + r); x += g4.x * g2r[r] + g4.y * g2r[r + 1] + g4.z * g2r[r + 2] + g4.w * g2r[r + 3]; }
            run += logsig(x) * 0.0625f; bl[jj] = run; }
        tot[jh * 256 + k] = run;
        __syncthreads();
        const float t0v = tot[k], t1v = tot[256 + k]; const float off = jh ? t0v : 0.f; const float bref = t0v, blast = t0v + t1v;
        if (jh == 0) Dbuf[((size_t)cidx * 2 + dir) * 1024 + h * 256 + k] = __expf(blast);
        u16* qdst; u16* kdst; size_t ldd;
        if (dir == 0) { qdst = P + h * 256 + k; kdst = P + 1024 + h * 256 + k; ldd = LDP1; } else { qdst = QB + h * 256 + k; kdst = QB + 1024 + h * 256 + k; ldd = 2048; }
#pragma unroll
        for (int jj = 0; jj < 32; ++jj) { const int j = jh * 32 + jj; const int tl = dir ? 63 - j : j; const size_t tok = (size_t)tok0 + tl;
            const float qv = bf2f(P[tok * LDP1 + h * 256 + k]) * 0.0625f, kv = bf2f(P[tok * LDP1 + 1024 + h * 256 + k]);
            const float b = bl[jj] + off;
            qi[j * 264 + k] = f2bf(qv * __expf(b - bref)); ki[j * 264 + k] = f2bf(kv * __expf(bref - b));
            qdst[tok * ldd] = f2bf(qv * __expf(b)); kdst[tok * ldd] = f2bf(kv * __expf(blast - b)); }
        __syncthreads();
        { const int tt = wid >> 1;
#pragma unroll
            for (int q2 = 0; q2 < 2; ++q2) { const int st = (wid & 1) * 2 + q2; f32x4 acc = (f32x4){0.f, 0.f, 0.f, 0.f};
                if (st <= tt) {
#pragma unroll
                    for (int ks = 0; ks < 8; ++ks) { const bf16x8 a = *(const bf16x8*)(qi + (tt * 16 + l15) * 264 + ks * 32 + quad * 8); const bf16x8 b = *(const bf16x8*)(ki + (st * 16 + l15) * 264 + ks * 32 + quad * 8);
                        acc = mfma16(a, b, acc); } }
#pragma unroll
                for (int r = 0; r < 4; ++r) { const int t = tt * 16 + quad * 4 + r, s_ = st * 16 + l15; Pl[t * 72 + s_] = f2bf(s_ <= t ? acc[r] : 0.f); } } }
        __syncthreads();
#pragma unroll
        for (int i = 0; i < 8; ++i) { const int piece = tid + 512 * i; const int j = piece >> 6, c8 = (piece & 63) * 8; const int tl = dir ? 63 - j : j;
            *(u32x4*)(vl + j * 520 + c8) = *(const u32x4*)(P + (size_t)(tok0 + tl) * LDP1 + 2048 + h * 512 + c8); }
        __syncthreads();
        u16* O = (u16*)(p.ws + (dir ? OFF_OB : OFF_OF)) + h * 512;
#pragma unroll 1
        for (int q4 = 0; q4 < 4; ++q4) { const int vt = wid * 4 + q4; f32x4 acc[4];
#pragma unroll
            for (int tt = 0; tt < 4; ++tt) acc[tt] = (f32x4){0.f, 0.f, 0.f, 0.f};
#pragma unroll
            for (int ss = 0; ss < 2; ++ss) { bf16x8 bfr;
#pragma unroll
                for (int jj = 0; jj < 8; ++jj) bfr[jj] = (short)vl[(ss * 32 + quad * 8 + jj) * 520 + vt * 16 + l15];
#pragma unroll
                for (int tt = 0; tt < 4; ++tt) { if (ss * 32 <= tt * 16 + 15) { const bf16x8 a = *(const bf16x8*)(Pl + (tt * 16 + l15) * 72 + ss * 32 + quad * 8); acc[tt] = mfma16(a, bfr, acc[tt]); } } }
#pragma unroll
            for (int tt = 0; tt < 4; ++tt)
#pragma unroll
                for (int r = 0; r < 4; ++r) { const int t = tt * 16 + quad * 4 + r; const int tl = dir ? 63 - t : t; O[(size_t)(tok0 + tl) * DM + vt * 16 + l15] = f2bf(acc[tt][r]); } }
        __syncthreads();
    }
}
DEV void gla_inter_task(const Params& p, int task, unsigned char* shm) {
    const bool sample = task < 256; const int tt_ = sample ? task : task - 256;
    const int seq = tt_ >> 3, vs = tt_ & 7; const int b = seq >> 3, h = (seq >> 1) & 3, dir = seq & 1;
    const int L = sample ? 4096 : 256; const int tok0 = sample ? NTP + b * 4096 : b * 256;
    const int nch = L >> 6, cbase = tok0 >> 6;
    const int tid = tidx(), wid = tid >> 6, lane = tid & 63, l15 = lane & 15, quad = lane >> 4;
    const u16* P = (const u16*)(p.ws + OFF_P); const u16* QB = (const u16*)(p.ws + OFF_A); const float* Dbuf = (const float*)(p.ws + OFF_DB);
    u16* ST = (u16*)shm; u16* qdl = (u16*)(shm + 33792); u16* kdl = (u16*)(shm + 67584); u16* vl = (u16*)(shm + 101376); float* dl = (float*)(shm + 110592);
    f32x4 S[2][4];
    const size_t sbase = (((size_t)b * 2 + dir) * 4 + h) * 256 * 512 + vs * 64;
#pragma unroll
    for (int kt = 0; kt < 2; ++kt)
#pragma unroll
        for (int vt = 0; vt < 4; ++vt)
#pragma unroll
            for (int r = 0; r < 4; ++r) { const int kk = wid * 32 + kt * 16 + quad * 4 + r; S[kt][vt][r] = sample ? p.in[3][sbase + (size_t)kk * 512 + vt * 16 + l15] : 0.f; }
    const u16* qsrc; const u16* ksrc; size_t lds_;
    if (dir == 0) { qsrc = P + h * 256; ksrc = P + 1024 + h * 256; lds_ = LDP1; } else { qsrc = QB + h * 256; ksrc = QB + 1024 + h * 256; lds_ = 2048; }
    const u16* vsrc = P + 2048 + h * 512 + vs * 64;
    u16* O = (u16*)(p.ws + (dir ? OFF_OB : OFF_OF)) + h * 512 + vs * 64;
    u32x4 rq[4], rk[4], rv; float rd = 0.f;
    const int vrow = tid >> 3, vc8 = (tid & 7) * 8;
#define GLA_ISSUE(n_) do { const int cidx_ = cbase + (dir ? nch - 1 - (n_) : (n_)); \
        _Pragma("unroll") for (int i = 0; i < 4; ++i) { const int piece = tid + 512 * i; const int j = piece >> 5, c8 = (piece & 31) * 8; const size_t tok = (size_t)cidx_ * 64 + (dir ? 63 - j : j); \
            rq[i] = *(const u32x4*)(qsrc + tok * lds_ + c8); rk[i] = *(const u32x4*)(ksrc + tok * lds_ + c8); } \
        { const size_t tok = (size_t)cidx_ * 64 + (dir ? 63 - vrow : vrow); rv = *(const u32x4*)(vsrc + tok * LDP1 + vc8); } \
        if (tid < 256) rd = Dbuf[((size_t)cidx_ * 2 + dir) * 1024 + h * 256 + tid]; } while (0)
#define GLA_WRITE_ST() do { _Pragma("unroll") for (int kt = 0; kt < 2; ++kt) _Pragma("unroll") for (int vt = 0; vt < 4; ++vt) { u32x2 w; w.x = pk(S[kt][vt][0], S[kt][vt][1]); w.y = pk(S[kt][vt][2], S[kt][vt][3]); \
            *(u32x2*)(ST + (vt * 16 + l15) * 264 + wid * 32 + kt * 16 + quad * 4) = w; } } while (0)
    GLA_WRITE_ST();
    GLA_ISSUE(0);
    const int tt = wid >> 1, vb = (wid & 1) * 2;
#pragma unroll 1
    for (int n = 0; n < nch; ++n) {
        const int cidx = cbase + (dir ? nch - 1 - n : n);
#pragma unroll
        for (int i = 0; i < 4; ++i) { const int piece = tid + 512 * i; const int j = piece >> 5, c8 = (piece & 31) * 8; *(u32x4*)(qdl + j * 264 + c8) = rq[i]; *(u32x4*)(kdl + j * 264 + c8) = rk[i]; }
        *(u32x4*)(vl + vrow * 72 + vc8) = rv; if (tid < 256) dl[tid] = rd;
        __syncthreads();
        if (n + 1 < nch) GLA_ISSUE(n + 1);
        float oi[2][4];
#pragma unroll
        for (int q2 = 0; q2 < 2; ++q2)
#pragma unroll
            for (int r = 0; r < 4; ++r) { const int j = tt * 16 + quad * 4 + r; const size_t tok = (size_t)cidx * 64 + (dir ? 63 - j : j); oi[q2][r] = bf2f(O[tok * DM + (vb + q2) * 16 + l15]); }
        f32x4 oacc[2]; oacc[0] = (f32x4){0.f, 0.f, 0.f, 0.f}; oacc[1] = oacc[0];
#pragma unroll
        for (int ks = 0; ks < 8; ++ks) { const bf16x8 a = *(const bf16x8*)(qdl + (tt * 16 + l15) * 264 + ks * 32 + quad * 8);
#pragma unroll
            for (int q2 = 0; q2 < 2; ++q2) { const bf16x8 bfr = *(const bf16x8*)(ST + ((vb + q2) * 16 + l15) * 264 + ks * 32 + quad * 8); oacc[q2] = mfma16(a, bfr, oacc[q2]); } }
#pragma unroll
        for (int kt = 0; kt < 2; ++kt) { const f32x4 dv = *(const f32x4*)(dl + wid * 32 + kt * 16 + quad * 4);
#pragma unroll
            for (int vt = 0; vt < 4; ++vt) S[kt][vt] = S[kt][vt] * dv; }
#pragma unroll
        for (int ts = 0; ts < 2; ++ts) { bf16x8 af[2];
#pragma unroll
            for (int kt = 0; kt < 2; ++kt)
#pragma unroll
                for (int jj = 0; jj < 8; ++jj) af[kt][jj] = (short)kdl[(ts * 32 + quad * 8 + jj) * 264 + wid * 32 + kt * 16 + l15];
#pragma unroll
            for (int vt = 0; vt < 4; ++vt) { bf16x8 bfr;
#pragma unroll
                for (int jj = 0; jj < 8; ++jj) bfr[jj] = (short)vl[(ts * 32 + quad * 8 + jj) * 72 + vt * 16 + l15];
#pragma unroll
                for (int kt = 0; kt < 2; ++kt) S[kt][vt] = mfma16(af[kt], bfr, S[kt][vt]); } }
#pragma unroll
        for (int q2 = 0; q2 < 2; ++q2)
#pragma unroll
            for (int r = 0; r < 4; ++r) { const int j = tt * 16 + quad * 4 + r; const size_t tok = (size_t)cidx * 64 + (dir ? 63 - j : j); O[tok * DM + (vb + q2) * 16 + l15] = f2bf(oi[q2][r] + oacc[q2][r]); }
        __syncthreads();
        GLA_WRITE_ST();
        __syncthreads();
    }
#undef GLA_ISSUE
#undef GLA_WRITE_ST
    if (!sample) { float* so = p.out + OUT_GLAST + sbase;
#pragma unroll
        for (int kt = 0; kt < 2; ++kt)
#pragma unroll
            for (int vt = 0; vt < 4; ++vt)
#pragma unroll
                for (int r = 0; r < 4; ++r) { const int kk = wid * 32 + kt * 16 + quad * 4 + r; so[(size_t)kk * 512 + vt * 16 + l15] = S[kt][vt][r]; } }
    __syncthreads();
}
DEV void phase_gla_post(const Params& p) {
    const int tid = tidx(), wid = tid >> 6, lane = tid & 63;
    const u16* P = (const u16*)(p.ws + OFF_P); const u16* OF = (const u16*)(p.ws + OFF_OF); const u16* OB = (const u16*)(p.ws + OFF_OB); u16* ycat = (u16*)(p.ws + OFF_A);
    for (int it = blockIdx.x * 8 + wid; it < NTOK * 4; it += gridDim.x * 8) { const int tok = it >> 2, h = it & 3; const int v8 = lane * 8;
        float a[8], b[8], g[8]; unpack8(*(const u32x4*)(OF + (size_t)tok * DM + h * 512 + v8), a); unpack8(*(const u32x4*)(OB + (size_t)tok * DM + h * 512 + v8), b);
        unpack8(*(const u32x4*)(P + (size_t)tok * LDP1 + 4096 + h * 512 + v8), g);
        float ss = 0.f;
#pragma unroll
        for (int i = 0; i < 8; ++i) { a[i] += b[i]; ss += a[i] * a[i]; }
        ss = wave_sum(ss); const float sc = rsqrtf(ss * (1.f / 512.f) + 1e-6f);
        float o[8];
#pragma unroll
        for (int i = 0; i < 8; ++i) o[i] = a[i] * sc * p.in[40][v8 + i] * (g[i] * sigm(g[i]));
        u32x4 w; w.x = pk(o[0], o[1]); w.y = pk(o[2], o[3]); w.z = pk(o[4], o[5]); w.w = pk(o[6], o[7]);
        *(u32x4*)(ycat + (size_t)tok * DM + h * 512 + v8) = w; }
}

DEV void gate_loadcol(const u16* U, long tokc, int c8, bool colok, bool up, bool dn, int W, float (*dst)[8]) {
    if (colok && up) unpack8(*(const u32x4*)(U + (size_t)(tokc - W) * LDU + c8), dst[0]); else { for (int i = 0; i < 8; ++i) dst[0][i] = 0.f; }
    if (colok) unpack8(*(const u32x4*)(U + (size_t)tokc * LDU + c8), dst[1]); else { for (int i = 0; i < 8; ++i) dst[1][i] = 0.f; }
    if (colok && dn) unpack8(*(const u32x4*)(U + (size_t)(tokc + W) * LDU + c8), dst[2]); else { for (int i = 0; i < 8; ++i) dst[2][i] = 0.f; }
}
DEV void phase_ffn_gate(const Params& p, int layer) {
    u16* U = (u16*)(p.ws + OFF_U); const float* cw = p.in[11] + (size_t)layer * 9 * DFF;
    const int tid_ = tidx(), wid_ = tid_ >> 6, lane_ = tid_ & 63;
    for (int bu = blockIdx.x; bu < 1408 + 704; bu += gridDim.x) {
        int tokS, c8;
        if (bu < 1408) { const int rg = bu / 44, rem = bu % 44; const int qtr = rem / 11, cgg = rem % 11; tokS = NTP + (rg * 8 + wid_) * 64 + qtr * 16; c8 = (cgg * 64 + lane_) * 8; }
        else { const int pu = bu - 1408; const int sg = pu / 11, cgg = pu % 11; tokS = (sg * 8 + wid_) * 16; c8 = (cgg * 64 + lane_) * 8; }
        int W, colS; bool up, dn;
        if (tokS < NTP) { W = 256; colS = tokS & 255; up = false; dn = false; }
        else { W = 64; colS = tokS & 63; const int rr = ((tokS - NTP) >> 6) & 63; up = rr > 0; dn = rr < 63; }
        float wt[9][8];
#pragma unroll
        for (int q = 0; q < 9; ++q) { const float4 a = *(const float4*)(cw + q * DFF + c8), b = *(const float4*)(cw + q * DFF + c8 + 4);
            wt[q][0] = a.x; wt[q][1] = a.y; wt[q][2] = a.z; wt[q][3] = a.w; wt[q][4] = b.x; wt[q][5] = b.y; wt[q][6] = b.z; wt[q][7] = b.w; }
        float w0[3][8], w1[3][8], w2[3][8];
        gate_loadcol(U, (long)tokS - 1, c8, colS > 0, up, dn, W, w0);
        gate_loadcol(U, (long)tokS, c8, true, up, dn, W, w1);
#pragma unroll 8
        for (int s_ = 0; s_ < 16; ++s_) {
            const long tok = (long)tokS + s_;
            gate_loadcol(U, tok + 1, c8, colS + s_ + 1 < W, up, dn, W, w2);
            u16* vp = U + (size_t)tok * LDU + DFF + c8; float v[8]; unpack8(*(const u32x4*)vp, v);
#pragma unroll
            for (int i = 0; i < 8; ++i) { float a = 0.f;
#pragma unroll
                for (int di = 0; di < 3; ++di) a += w0[di][i] * wt[di * 3][i] + w1[di][i] * wt[di * 3 + 1][i] + w2[di][i] * wt[di * 3 + 2][i];
                v[i] *= a * sigm(a); }
            u32x4 w; w.x = pk(v[0], v[1]); w.y = pk(v[2], v[3]); w.z = pk(v[4], v[5]); w.w = pk(v[6], v[7]);
            *(u32x4*)vp = w;
#pragma unroll
            for (int di = 0; di < 3; ++di)
#pragma unroll
                for (int i = 0; i < 8; ++i) { w0[di][i] = w1[di][i]; w1[di][i] = w2[di][i]; }
        }
    }
}

DEV void phase_final_norm(const Params& p) {
    const int tid = tidx(), wid = tid >> 6, lane = tid & 63; const float* g = p.in[13];
    for (int row = blockIdx.x * 8 + wid; row < NTOK; row += gridDim.x * 8) {
        float4* xr = (float4*)(p.out + (size_t)row * DM);
        float4 v[8]; float ss = 0.f;
#pragma unroll
        for (int j = 0; j < 8; ++j) { v[j] = xr[lane + 64 * j]; ss += v[j].x * v[j].x + v[j].y * v[j].y + v[j].z * v[j].z + v[j].w * v[j].w; }
        ss = wave_sum(ss); const float rstd = rsqrtf(ss * (1.f / 2048.f) + 1e-6f);
#pragma unroll
        for (int j = 0; j < 8; ++j) { const float4 gg = *(const float4*)(g + (lane + 64 * j) * 4);
            xr[lane + 64 * j] = make_float4(v[j].x * rstd * gg.x, v[j].y * rstd * gg.y, v[j].z * rstd * gg.z, v[j].w * rstd * gg.w); }
    }
}


#define XB_TMO      128
#define XB_XCNT(j)  (256  + 64 * (j))
#define XB_XSUB(j)  (1280 + 64 * (j))
#define XB_XGEN(j)  (2304 + 64 * (j))
#define XB_TOP      3328
#define XB_TOPGEN   3392
#define XCD_BAR_WORDS 3456
#define XB_SPIN_CAP (1u << 18)
DEV unsigned xb_ld(unsigned* p)              { return __hip_atomic_load(p, __ATOMIC_RELAXED, __HIP_MEMORY_SCOPE_AGENT); }
DEV unsigned xb_add(unsigned* p, unsigned v) { return __hip_atomic_fetch_add(p, v, __ATOMIC_RELAXED, __HIP_MEMORY_SCOPE_AGENT); }
DEV unsigned xb_xcc_id() { return (unsigned)__builtin_amdgcn_s_getreg((3 << 11) | 20) & 0xFu; }
#define XB_SPIN(cond, bar) do { unsigned _sp = 0; while (cond) { __builtin_amdgcn_s_sleep(1); \
    if ((++_sp & 255u) == 0u) { if (xb_ld(&(bar)[XB_TMO])) break; if (_sp > XB_SPIN_CAP) { atomicAdd(&(bar)[XB_TMO], 1u); break; } } } } while (0)
struct XcdBarrier { unsigned* bar; unsigned x; volatile LAS unsigned* st; };
DEV XcdBarrier xcd_barrier_post(unsigned* bar, volatile LAS unsigned* st) {
    XcdBarrier b; b.bar = bar; b.x = xb_xcc_id(); b.st = st;
    if (threadIdx.x == 0) (void)xb_add(&bar[XB_XCNT(b.x)], 1u);
    return b;
}
DEV void xcd_barrier_complete(unsigned* bar, unsigned x, unsigned& nloc, unsigned& nx) {
    const unsigned G = gridDim.x * gridDim.y * gridDim.z;
    unsigned sum, cnt, mine, sp = 0u;
    for (;;) {
        sum = 0u; cnt = 0u; mine = 0u;
#pragma unroll
        for (unsigned j = 0; j < 16; ++j) { const unsigned c = xb_ld(&bar[XB_XCNT(j)]); sum += c; cnt += (c > 0u) ? 1u : 0u; mine = (j == x) ? c : mine; }
        if (sum == G) break;
        __builtin_amdgcn_s_sleep(1);
        if ((++sp & 255u) == 0u) { if (xb_ld(&bar[XB_TMO])) break; if (sp > XB_SPIN_CAP) { atomicAdd(&bar[XB_TMO], 1u); break; } }
    }
    nloc = mine > 0u ? mine : 1u; nx = cnt > 0u ? cnt : 1u;
}
DEV void xcd_barrier(const XcdBarrier& b) {
    asm volatile("s_waitcnt vmcnt(0)" ::: "memory");
    __syncthreads();
    if (threadIdx.x == 0) {
        unsigned* bar = b.bar;
        __builtin_amdgcn_s_waitcnt(0);
        unsigned nloc = b.st[0], nx = b.st[1];
        if (nloc == 0u) { xcd_barrier_complete(bar, b.x, nloc, nx); b.st[0] = nloc; b.st[1] = nx; }
        const unsigned old = xb_add(&bar[XB_XSUB(b.x)], 1u);
        const unsigned gen = old / nloc;
        if (old + 1u == (gen + 1u) * nloc) {
            __builtin_amdgcn_fence(__ATOMIC_RELEASE, "agent");
            asm volatile("s_waitcnt vmcnt(0)" ::: "memory");
            const unsigned og = xb_add(&bar[XB_TOP], 1u);
            const unsigned tg = og / nx;
            if (og + 1u == (tg + 1u) * nx) xb_add(&bar[XB_TOPGEN], 1u);
            else XB_SPIN(xb_ld(&bar[XB_TOPGEN]) == tg, bar);
            __builtin_amdgcn_fence(__ATOMIC_ACQUIRE, "agent");
            xb_add(&bar[XB_XGEN(b.x)], 1u);
            asm volatile("s_waitcnt vmcnt(0)" ::: "memory");
        } else {
            XB_SPIN(xb_ld(&bar[XB_XGEN(b.x)]) == gen, bar);
            __builtin_amdgcn_fence(__ATOMIC_ACQUIRE, "agent");
            asm volatile("s_waitcnt vmcnt(0)" ::: "memory");
        }
    }
    __syncthreads();
}

__global__ void __launch_bounds__(512, 2) mega(Params p0) {
    extern __shared__ __attribute__((aligned(16))) unsigned char shm[];
    cg::grid_group grid = cg::this_grid();
    __shared__ uint4 xb_words;
    if (threadIdx.x == 0) xb_words = make_uint4(0u, 0u, 0u, 0u);
    __syncthreads();
    (void)xcd_barrier_post((unsigned*)(p0.ws + OFF_SMALL + SMALL_BYTES + 256), (volatile LAS unsigned*)&xb_words);
#define XBAR() do { XcdBarrier xb_; xb_.bar = (unsigned*)(launder(p0).ws + OFF_SMALL + SMALL_BYTES + 256); xb_.x = xb_xcc_id(); xb_.st = (volatile LAS unsigned*)&xb_words; xcd_barrier(xb_); } while (0)
    float* sm = (float*)shm;
    const int G = (int)gridDim.x, B = (int)blockIdx.x;

#ifndef SK_PREP
    phase_prep(launder(p0), shm);
#ifdef PROBE_MISC
    __syncthreads(); phase_prep(launder(p0), shm);
#endif
#endif
    grid.sync();
    phase_reduce(launder(p0));
    XBAR();
#pragma unroll 1
    for (int layer = 0; layer < 2; ++layer) {
#ifndef SK_NORM
        phase_norm(launder(p0), layer, 0, shm);
#ifdef PROBE_MISC
        __syncthreads(); phase_norm(launder(p0), layer, 0, shm);
#endif
#endif
        XBAR();
        { const Params p = launder(p0); const u16* A = (const u16*)(p.ws + OFF_A); pg8::EpiBf16 E; E.O = (u16*)(p.ws + OFF_P); E.ldc = layer ? LDP1 : LDP0;
#if !defined(SK_GEMM) && !defined(SK_GBF)
            run_gemm(shm, A, DM, (const u16*)(p.ws + OFF_WIN), DM, layer ? LDP1 : LDP0, DM, E);
#ifdef PROBE_GEMM
            __syncthreads(); run_gemm(shm, A, DM, (const u16*)(p.ws + OFF_WIN), DM, layer ? LDP1 : LDP0, DM, E);
#endif
#endif
        }
        XBAR();
        if (layer == 0) {
#ifndef SK_PRE
            { const Params p = launder(p0); for (int t = B; t < 6144 + 768; t += G) { if (t < 6144) hy_pre_tile(p, t, sm); else rwkv_lora_tile(p, t - 6144, shm); } }
#ifdef PROBE_MISC
            { const Params p = launder(p0); for (int t = B; t < 6144 + 768; t += G) { if (t < 6144) hy_pre_tile(p, t, sm); else rwkv_lora_tile(p, t - 6144, shm); } }
#endif
#endif
            XBAR();
            { const Params p = launder(p0); unsigned* ctr = (unsigned*)(p.ws + OFF_SMALL + SMALL_BYTES);
                for (int t = B; t < 128; t += G) rwkv_scan_task(p, t, sm);
                for (;;) { if (tidx() == 0) *(volatile unsigned*)shm = atomicAdd(ctr, 1u); __syncthreads(); const unsigned t = *(volatile unsigned*)shm; __syncthreads();
                    if (t >= 1024u + 2048u) break;
                    if (t < 1024u) rwkv_scan_task(p, 128 + (int)t, sm); else hyconv_task(p, (int)t - 1024, shm); } }
            XBAR();
#ifndef SK_POST
            { const Params p = launder(p0); for (int t = B; t < 6144 + 768; t += G) { if (t < 6144) hy_post_tile(p, t, sm); else rwkv_post_tile(p, t - 6144, sm); } }
#ifdef PROBE_MISC
            { const Params p = launder(p0); for (int t = B; t < 6144 + 768; t += G) { if (t < 6144) hy_post_tile(p, t, sm); else rwkv_post_tile(p, t - 6144, sm); } }
#endif
#endif
            XBAR();
        } else {
#ifndef SK_GLA
            { const Params p = launder(p0); for (int t = B; t < 1536; t += G) gla_intra_task(p, t, shm); }
            XBAR();
            { const Params p = launder(p0); for (int t = B; t < 256 + 2048; t += G) gla_inter_task(p, t, shm); }
#endif
            XBAR();
#ifndef SK_GLAP
            phase_gla_post(launder(p0));
#ifdef PROBE_MISC
            phase_gla_post(launder(p0));
#endif
#endif
            XBAR();
        }
        { const Params p = launder(p0); const u16* A = (const u16*)(p.ws + OFF_A); const float* mods = (const float*)(p.ws + OFF_SMALL); pg8::EpiRes E; E.X = p.out; E.gm = mods + (size_t)layer * 5 * 12288 + 2 * 2048; E.gb = p.in[7] + layer * 12288 + 2 * 2048;
#if !defined(SK_GEMM) && !defined(SK_GRES)
            run_gemm(shm, A, DM, (const u16*)(p.ws + OFF_WOUT), DM, DM, DM, E);
#endif
        }
        XBAR();
#ifndef SK_NORM
        phase_norm(launder(p0), layer, 1, shm);
#ifdef PROBE_MISC
        __syncthreads(); phase_norm(launder(p0), layer, 1, shm);
#endif
#endif
        XBAR();
        { const Params p = launder(p0); const u16* A = (const u16*)(p.ws + OFF_A); pg8::EpiBf16 E; E.O = (u16*)(p.ws + OFF_U); E.ldc = LDU;
#if !defined(SK_GEMM) && !defined(SK_GBF)
            run_gemm(shm, A, DM, (const u16*)(p.ws + OFF_WUP), DM, LDU, DM, E);
#ifdef PROBE_GEMM
            __syncthreads(); run_gemm(shm, A, DM, (const u16*)(p.ws + OFF_WUP), DM, LDU, DM, E);
#endif
#endif
        }
        XBAR();
#ifndef SK_GATE
        phase_ffn_gate(launder(p0), layer);
#endif
        XBAR();
        { const Params p = launder(p0); const float* mods = (const float*)(p.ws + OFF_SMALL); pg8::EpiRes E; E.X = p.out; E.gm = mods + (size_t)layer * 5 * 12288 + 5 * 2048; E.gb = p.in[7] + layer * 12288 + 5 * 2048;
#if !defined(SK_GEMM) && !defined(SK_GRES)
            run_gemm(shm, (const u16*)(p.ws + OFF_U) + DFF, LDU, (const u16*)(p.ws + OFF_WDN), DFF, DM, DFF, E);
#endif
        }
        XBAR();
    }
    phase_final_norm(launder(p0));
}

extern "C" void kernel_launch(void* const* d_in, const int* in_sizes, int n_in, void* d_out, int out_size, void* d_ws, size_t ws_size, hipStream_t stream) {
    constexpr size_t kDynLds = 131072;
    static int grid_blocks = 0;
    if (!grid_blocks) {
        int dev = 0, cus = 0, per_cu = 0;
        hipGetDevice(&dev);
        hipDeviceGetAttribute(&cus, hipDeviceAttributeMultiprocessorCount, dev);
        hipFuncSetAttribute((const void*)mega, hipFuncAttributeMaxDynamicSharedMemorySize, (int)kDynLds);
        hipOccupancyMaxActiveBlocksPerMultiprocessor(&per_cu, mega, 512, kDynLds);
        if (per_cu < 1) per_cu = 1;
        grid_blocks = cus * per_cu;
        if (grid_blocks > 256) grid_blocks = 256;
    }
    if (ws_size < WS_NEED || n_in < 41) { fprintf(stderr, "workspace too small: %zu < %zu\n", ws_size, WS_NEED); return; }
    Params p{};
    for (int i = 0; i < 41; ++i) p.in[i] = (const float*)d_in[i];
    p.out = (float*)d_out; p.ws = (unsigned char*)d_ws;
    hipMemsetAsync((unsigned char*)d_ws + OFF_SMALL + SMALL_BYTES, 0, 256 + XCD_BAR_BYTES, stream);
    void* args[] = {&p};
    hipError_t e = hipLaunchCooperativeKernel((const void*)mega, dim3(grid_blocks), dim3(512), args, kDynLds, stream);
    if (e != hipSuccess) fprintf(stderr, "cooperative launch failed: %s (grid %d)\n", hipGetErrorString(e), grid_blocks);
}
```

```cpp
#include <hip/hip_runtime.h>
#include <hip/hip_cooperative_groups.h>
#include <cstdio>
namespace cg = cooperative_groups;

#define DEV __device__ __forceinline__
#define LAS __attribute__((address_space(3)))
typedef unsigned short u16;
typedef short bf16x8 __attribute__((ext_vector_type(8)));
typedef float f32x4 __attribute__((ext_vector_type(4)));
typedef float f32x2 __attribute__((ext_vector_type(2)));
typedef float f32x16 __attribute__((ext_vector_type(16)));
typedef unsigned u32x2 __attribute__((ext_vector_type(2)));
typedef unsigned u32x4 __attribute__((ext_vector_type(4)));

constexpr int NTOK = 24576, NTP = 8192, DM = 2048;
constexpr int LDP0 = 6656, LDP1 = 6400, LDU = 11264, DFF = 5632;
constexpr size_t OFF_WIN = 0, OFF_WOUT = 27262976, OFF_WUP = 35651584, OFF_WDN = OFF_WUP + 46137344;
constexpr size_t OFF_A = 104857600, OFF_BIG = 205520896;
constexpr size_t OFF_P = OFF_BIG, OFF_RW = OFF_BIG + 327155712, OFF_UT = OFF_RW + 201326592, OFF_GS = OFF_UT + 50331648, OFF_GP = OFF_GS + 16777216;
constexpr size_t OFF_U = OFF_BIG, OFF_OF = OFF_BIG + 314572800, OFF_OB = OFF_OF + 100663296, OFF_DB = OFF_OB + 100663296;
constexpr size_t OFF_SMALL = OFF_BIG + 600000000, SMALL_BYTES = 491520 + 8192;
constexpr size_t XCD_BAR_BYTES = 3456 * 4;
constexpr size_t OFF_LW = OFF_SMALL + SMALL_BYTES + 256 + XCD_BAR_BYTES;
constexpr size_t OFF_G2T = OFF_LW + 524288;
constexpr size_t WS_NEED = OFF_G2T + 262144;
constexpr size_t OUT_RWST = 50331648, OUT_GLAST = 54525952;

struct Params {
    const float* in[41];
    float* out;
    unsigned char* ws;
};

DEV int tidx() { int t = threadIdx.x; asm volatile("" : "+v"(t)); return t; }
DEV Params launder(const Params& p) { Params q = p; asm volatile("" : "+s"(q.ws), "+s"(q.out)); return q; }
DEV float bf2f(unsigned b) { return __uint_as_float(b << 16); }
DEV float bflo(unsigned w) { return __uint_as_float(w << 16); }
DEV float bfhi(unsigned w) { return __uint_as_float(w & 0xffff0000u); }
DEV unsigned pk(float lo, float hi) { unsigned r; asm("v_cvt_pk_bf16_f32 %0, %1, %2" : "=v"(r) : "v"(lo), "v"(hi)); return r; }
DEV u16 f2bf(float f) { return (u16)(pk(f, 0.f) & 0xffffu); }
DEV float wave_sum(float v) {
#pragma unroll
    for (int o = 32; o > 0; o >>= 1) v += __shfl_xor(v, o);
    return v;
}
template <int CTRL> DEV float dppf(float x) { return __builtin_bit_cast(float, __builtin_amdgcn_update_dpp(0, __builtin_bit_cast(int, x), CTRL, 0xf, 0xf, true)); }
DEV float sum8(float v) { v += dppf<0xB1>(v); v += dppf<0x4E>(v); v += dppf<0x141>(v); return v; }
DEV float sum16(float v) { v = sum8(v); v += dppf<0x140>(v); return v; }
DEV f32x4 mfma16(bf16x8 a, bf16x8 b, f32x4 c) { return __builtin_amdgcn_mfma_f32_16x16x32_bf16(a, b, c, 0, 0, 0); }
DEV float sigm(float x) { return __builtin_amdgcn_rcpf(1.f + __expf(-x)); }
DEV int tok_cond(int tok) { return tok < NTP ? 4 : ((tok - NTP) >> 12); }
DEV void tok_tl(int tok, int& t, int& L) { if (tok < NTP) { t = tok & 255; L = 256; } else { t = (tok - NTP) & 4095; L = 4096; } }
DEV void unpack8(u32x4 w, float* o) { o[0] = bflo(w.x); o[1] = bfhi(w.x); o[2] = bflo(w.y); o[3] = bfhi(w.y); o[4] = bflo(w.z); o[5] = bfhi(w.z); o[6] = bflo(w.w); o[7] = bfhi(w.w); }
DEV void unpack4(u32x2 w, float* o) { o[0] = bflo(w.x); o[1] = bfhi(w.x); o[2] = bflo(w.y); o[3] = bfhi(w.y); }

namespace pg8 {
constexpr int BM = 256, BK = 64, HALF = 128, HTB = HALF * BK * 2, NXCD = 8, WGM = 8;
DEV int lds_byte(int r, int c) { const int st = (r >> 4) * 2 + (c >> 5), rr = r & 15, cc = c & 31, ob = rr * 64 + cc * 2; return st * 1024 + (ob ^ (((ob >> 9) & 1) << 5)); }
DEV void stage_rc(int b, int& R, int& C) { const int st = b / 1024, sb = b % 1024, swz = sb ^ (((sb >> 9) & 1) << 5); R = (st >> 1) * 16 + swz / 64; C = (st & 1) * 32 + (swz % 64) / 2; }
DEV int perm32(int rho) { const int n = rho >> 4, i = rho & 15; return 8 * (i >> 2) + 4 * n + (i & 3); }
struct Unit { int pm, pn; };
struct Gemm { const u16* A; const u16* Bt; int M, N, K, lda, ldb; };
struct StaticOrder {
    int nM, nN, nwg, G, c;
    DEV void init(int M, int N, int G_, int c_) { nM = M / BM; nN = N / BM; nwg = nM * nN; G = G_; c = c_; }
    DEV bool next(int i, Unit& u) const {
        const long L = (long)i * G + c; if (L >= nwg) return false;
        int wgid = (int)L; { const int q = nwg / NXCD, r = nwg % NXCD, xcd = wgid % NXCD, off = wgid / NXCD; wgid = (xcd < r ? xcd * (q + 1) : r * (q + 1) + (xcd - r) * q) + off; }
        const int nig = WGM * nN, gid = wgid / nig, fm = gid * WGM, gsz = (nM - fm) < WGM ? (nM - fm) : WGM;
        u.pm = fm + ((wgid % nig) % gsz); u.pn = (wgid % nig) / gsz; return true;
    }
};
struct EpiBf16 {
    static constexpr bool PERM = true;
    u16* O; int ldc;
    DEV void operator()(const f32x4 (&acc)[2][2][4][2], const Unit& u, int wr, int wc, int fr, int fq) const {
        const int row0 = u.pm * BM + wr * 64 + fr; const int col0 = u.pn * BM + wc * 32 + 8 * fq;
#pragma unroll
        for (int ai = 0; ai < 2; ++ai)
#pragma unroll
            for (int m = 0; m < 4; ++m) { u16* rowp = O + (size_t)(row0 + ai * HALF + m * 16) * ldc + col0;
#pragma unroll
                for (int bj = 0; bj < 2; ++bj) { const f32x4 v0 = acc[ai][bj][m][0], v1 = acc[ai][bj][m][1];
                    u32x4 w; w.x = pk(v0[0], v0[1]); w.y = pk(v0[2], v0[3]); w.z = pk(v1[0], v1[1]); w.w = pk(v1[2], v1[3]);
                    *(u32x4*)(rowp + bj * HALF) = w; } }
    }
};
struct EpiRes {
    static constexpr bool PERM = false;
    float* X; const float* gm; const float* gb;
    DEV void operator()(const f32x4 (&acc)[2][2][4][2], const Unit& u, int wr, int wc, int fr, int fq) const {
        const int row0 = u.pm * BM + wr * 64 + fr, col0 = u.pn * BM + wc * 32 + 4 * fq;
        const int cond = u.pm < 32 ? 4 : ((u.pm - 32) >> 4);
        const float* gmc = gm + (size_t)cond * 12288 + col0; const float* gbc = gb + col0;
#pragma unroll
        for (int ai = 0; ai < 2; ++ai)
#pragma unroll
            for (int m = 0; m < 4; ++m) { float* rowp = X + (size_t)(row0 + ai * HALF + m * 16) * DM + col0;
#pragma unroll
                for (int bj = 0; bj < 2; ++bj) {
#pragma unroll
                    for (int n = 0; n < 2; ++n) { f32x4* q = (f32x4*)(rowp + bj * HALF + n * 16);
                        const f32x4 gvv = *(const f32x4*)(gmc + bj * HALF + n * 16) + *(const f32x4*)(gbc + bj * HALF + n * 16);
                        *q = *q + gvv * acc[ai][bj][m][n]; }
                    asm volatile("" ::: "memory"); } }
    }
};

template <class Epi>
DEV void gemm_phase(LAS unsigned char* lds, const Gemm g, const StaticOrder& S, const Epi& E) {
    const int tid = tidx(), wid = __builtin_amdgcn_readfirstlane(tid >> 6), lane = tid & 63, wr = wid >> 2, wc = wid & 3, fr = lane & 15, fq = lane >> 4;
    const int K = g.K, nt = K / BK;
    unsigned voffA[2], voffB[2];
#pragma unroll
    for (int i = 0; i < 2; ++i) { int R, C; stage_rc(tid * 16 + i * 8192, R, C); const int Rb = Epi::PERM ? ((R & ~31) + perm32(R & 31)) : R;
        voffA[i] = (unsigned)(R * g.lda + C) * 2u; voffB[i] = (unsigned)(Rb * g.ldb + C) * 2u; }
    const size_t kstep = (size_t)(BK * 2);
    const size_t hstepA = (size_t)HALF * g.lda * 2, hstepB = (size_t)HALF * g.ldb * 2;
    const size_t tstepA = 2 * hstepA, tstepB = 2 * hstepB;
    const unsigned ldsw = (unsigned)wid * 1024u;
    const int aoff = lds_byte(wr * 64 + fr, fq * 8), boff = lds_byte(wc * 32 + fr, fq * 8);
#define PG8_SA(b, h) (((b) * 2 + (h)) * HTB)
#define PG8_SB(b, h) ((4 + (b) * 2 + (h)) * HTB)
#define PG8_STAGE(bufoff, gbase, voff) do { _Pragma("unroll") for (int _i = 0; _i < 2; ++_i) \
        __builtin_amdgcn_global_load_lds((const unsigned*)((const char*)(gbase) + (voff)[_i]), (LAS unsigned*)(lds + (bufoff) + ldsw + _i * 8192), 16, 0, 0); } while (0)
#define PG8_LDA(dst, b, h) do { _Pragma("unroll") for (int m = 0; m < 4; ++m) _Pragma("unroll") for (int k = 0; k < 2; ++k) dst[m][k] = *(const LAS bf16x8*)(lds + PG8_SA(b, h) + aoff + m * 2048 + k * 1024); } while (0)
#define PG8_LDB(dst, b, h) do { _Pragma("unroll") for (int n = 0; n < 2; ++n) _Pragma("unroll") for (int k = 0; k < 2; ++k) dst[n][k] = *(const LAS bf16x8*)(lds + PG8_SB(b, h) + boff + n * 2048 + k * 1024); } while (0)
#define PG8_MMA(ai, bj, At, Bt) do { __builtin_amdgcn_s_setprio(1); _Pragma("unroll") for (int m = 0; m < 4; ++m) _Pragma("unroll") for (int n = 0; n < 2; ++n) _Pragma("unroll") for (int k = 0; k < 2; ++k) \
        acc[ai][bj][m][n] = __builtin_amdgcn_mfma_f32_16x16x32_bf16(Bt[n][k], At[m][k], acc[ai][bj][m][n], 0, 0, 0); __builtin_amdgcn_s_setprio(0); } while (0)
#define PG8_WAIT_V(n) asm volatile("s_waitcnt vmcnt(" #n ")" ::: "memory")
#define PG8_WAIT_L(n) asm volatile("s_waitcnt lgkmcnt(" #n ")" ::: "memory")
#define PG8_BAR __builtin_amdgcn_s_barrier()
#define PG8_SCHED __builtin_amdgcn_sched_barrier(0)
    Unit cur, nxt; int ui = 0;
    if (!S.next(0, cur)) return;
    f32x4 acc[2][2][4][2];
#pragma unroll
    for (int a = 0; a < 2; ++a)
#pragma unroll
        for (int b = 0; b < 2; ++b)
#pragma unroll
            for (int m = 0; m < 4; ++m)
#pragma unroll
                for (int n = 0; n < 2; ++n) acc[a][b][m][n] = (f32x4){0.f, 0.f, 0.f, 0.f};
    bf16x8 At[4][2], B0[2][2], B1[2][2];
    const char* cA = (const char*)g.A + (size_t)cur.pm * tstepA; const char* cB = (const char*)g.Bt + (size_t)cur.pn * tstepB;
    PG8_STAGE(PG8_SB(0, 0), cB, voffB); PG8_STAGE(PG8_SA(0, 0), cA, voffA); PG8_STAGE(PG8_SB(0, 1), cB + hstepB, voffB); PG8_STAGE(PG8_SA(0, 1), cA + hstepA, voffA);
    if (wr == 1) PG8_BAR;
    PG8_WAIT_V(4); PG8_BAR;
    PG8_STAGE(PG8_SB(1, 0), cB + kstep, voffB); PG8_STAGE(PG8_SA(1, 0), cA + kstep, voffA); PG8_STAGE(PG8_SB(1, 1), cB + hstepB + kstep, voffB);
    PG8_WAIT_V(6); PG8_BAR;
    for (;;) {
        const bool has_next = S.next(ui + 1, nxt);
        const char* nA = has_next ? (const char*)g.A + (size_t)nxt.pm * tstepA : cA; const char* nB = has_next ? (const char*)g.Bt + (size_t)nxt.pn * tstepB : cB;
        for (int t = 0; t < nt; t += 2) {
            const bool last = (t == nt - 2);
            const char* a1 = cA + (size_t)(t + 1) * kstep;
            const char* a2 = last ? nA : cA + (size_t)(t + 2) * kstep; const char* b2 = last ? nB : cB + (size_t)(t + 2) * kstep;
            const char* a3 = a2 + kstep; const char* b3 = b2 + kstep;
            PG8_LDB(B0, 0, 0); PG8_SCHED; PG8_LDA(At, 0, 0); PG8_STAGE(PG8_SA(1, 1), a1 + hstepA, voffA);
            PG8_WAIT_L(8); PG8_BAR; PG8_WAIT_L(0); PG8_MMA(0, 0, At, B0); PG8_BAR; PG8_SCHED;
            PG8_LDB(B1, 0, 1); PG8_STAGE(PG8_SB(0, 0), b2, voffB);
            PG8_BAR; PG8_WAIT_L(0); PG8_MMA(0, 1, At, B1); PG8_BAR;
            PG8_LDA(At, 0, 1); PG8_STAGE(PG8_SA(0, 0), a2, voffA);
            PG8_BAR; PG8_WAIT_L(0); PG8_MMA(1, 0, At, B0); PG8_BAR; PG8_SCHED;
            PG8_STAGE(PG8_SB(0, 1), b2 + hstepB, voffB);
            PG8_WAIT_V(6); PG8_BAR; PG8_MMA(1, 1, At, B1); PG8_BAR;
            PG8_LDB(B0, 1, 0); PG8_SCHED; PG8_LDA(At, 1, 0); PG8_STAGE(PG8_SA(0, 1), a2 + hstepA, voffA);
            PG8_WAIT_L(8); PG8_BAR; PG8_WAIT_L(0); PG8_MMA(0, 0, At, B0); PG8_BAR; PG8_SCHED;
            PG8_LDB(B1, 1, 1); PG8_STAGE(PG8_SB(1, 0), b3, voffB);
            PG8_BAR; PG8_WAIT_L(0); PG8_MMA(0, 1, At, B1); PG8_BAR;
            PG8_LDA(At, 1, 1); PG8_STAGE(PG8_SA(1, 0), a3, voffA);
            PG8_BAR; PG8_WAIT_L(0); PG8_MMA(1, 0, At, B0); PG8_BAR; PG8_SCHED;
            PG8_STAGE(PG8_SB(1, 1), b3 + hstepB, voffB);
            PG8_WAIT_V(6); PG8_BAR; PG8_MMA(1, 1, At, B1); PG8_BAR;
        }
        E(acc, cur, wr, wc, fr, fq);
        if (!has_next) break;
#pragma unroll
        for (int a = 0; a < 2; ++a)
#pragma unroll
            for (int b = 0; b < 2; ++b)
#pragma unroll
                for (int m = 0; m < 4; ++m)
#pragma unroll
                    for (int n = 0; n < 2; ++n) acc[a][b][m][n] = (f32x4){0.f, 0.f, 0.f, 0.f};
        cur = nxt; cA = nA; cB = nB; ++ui;
    }
    PG8_WAIT_V(0);
    if (wr == 0) PG8_BAR;
    PG8_BAR;
#undef PG8_SA
#undef PG8_SB
#undef PG8_STAGE
#undef PG8_LDA
#undef PG8_LDB
#undef PG8_MMA
#undef PG8_WAIT_V
#undef PG8_WAIT_L
#undef PG8_BAR
#undef PG8_SCHED
}
}

template <class Epi>
DEV void run_gemm(unsigned char* shm, const u16* A, int lda, const u16* Bt, int ldb, int N, int K, const Epi& E) {
    asm volatile("" : "+s"(A), "+s"(Bt));
    pg8::Gemm g; g.A = A; g.Bt = Bt; g.M = NTOK; g.N = N; g.K = K; g.lda = lda; g.ldb = ldb;
    pg8::StaticOrder S; S.init(NTOK, N, (int)gridDim.x, (int)blockIdx.x);
    pg8::gemm_phase<Epi>((LAS unsigned char*)shm, g, S, E);
}

DEV void convT_tile(const float* __restrict__ src, u16* __restrict__ dst, int K, int N, int Npad, int tile, float* T) {
    const int tid = tidx(); const int ntn = Npad >> 6; const int k0 = (tile / ntn) << 6, n0 = (tile % ntn) << 6;
#pragma unroll
    for (int j = 0; j < 2; ++j) { const int idx = tid + j * 512; const int r = idx >> 4, c4 = (idx & 15) << 2;
        float4 v = make_float4(0.f, 0.f, 0.f, 0.f); if (n0 + c4 < N) v = *(const float4*)(src + (size_t)(k0 + r) * N + n0 + c4);
        float* t = T + r * 65 + c4; t[0] = v.x; t[1] = v.y; t[2] = v.z; t[3] = v.w; }
    __syncthreads();
    { const int nn = tid >> 3, kq = (tid & 7) << 3; const float* t = T + kq * 65 + nn;
        u32x4 o; o.x = pk(t[0], t[65]); o.y = pk(t[130], t[195]); o.z = pk(t[260], t[325]); o.w = pk(t[390], t[455]);
        *(u32x4*)(dst + (size_t)(n0 + nn) * K + k0 + kq) = o; }
    __syncthreads();
}
DEV int conv_ntiles(int job, int layer) { return job == 0 ? (layer ? 3200 : 3328) : job == 1 ? 1024 : job == 2 ? 5632 : 2816; }
DEV void conv_job(const Params& p, int job, int layer, int tile, float* T) {
    if (job == 0) convT_tile(layer ? p.in[36] : p.in[14], (u16*)(p.ws + OFF_WIN), 2048, layer ? 6176 : 6528, layer ? LDP1 : LDP0, tile, T);
    else if (job == 1) convT_tile(layer ? p.in[37] : p.in[15], (u16*)(p.ws + OFF_WOUT), 2048, 2048, 2048, tile, T);
    else if (job == 2) convT_tile(p.in[10] + (size_t)layer * 2048 * 11264, (u16*)(p.ws + OFF_WUP), 2048, 11264, 11264, tile, T);
    else convT_tile(p.in[12] + (size_t)layer * 5632 * 2048, (u16*)(p.ws + OFF_WDN), 5632, 2048, 2048, tile, T);
}

DEV void adaln_tile(const Params& p, int tile, float* sl) {
    const int tid = tidx(); const int nt = tile % 6, kc = (tile / 6) & 31, layer = tile / 192;
    if (tid < 320) { const int j = tid >> 6, kk = tid & 63; const float cv = (j < 4) ? p.in[4][j * 2048 + kc * 64 + kk] : p.in[5][kc * 64 + kk]; sl[tid] = cv / (1.f + expf(-cv)); }
    __syncthreads();
    const float* w = p.in[6] + ((size_t)layer * 2048 + kc * 64) * 12288 + nt * 2048 + tid * 4;
    float acc[5][4];
#pragma unroll
    for (int j = 0; j < 5; ++j) { acc[j][0] = 0.f; acc[j][1] = 0.f; acc[j][2] = 0.f; acc[j][3] = 0.f; }
#pragma unroll 8
    for (int kk = 0; kk < 64; ++kk) { const float4 wv = *(const float4*)(w + (size_t)kk * 12288);
#pragma unroll
        for (int j = 0; j < 5; ++j) { const float s = sl[j * 64 + kk]; acc[j][0] += s * wv.x; acc[j][1] += s * wv.y; acc[j][2] += s * wv.z; acc[j][3] += s * wv.w; } }
    float* m = (float*)(p.ws + OFF_A) + (size_t)kc * 122880 + (size_t)layer * 5 * 12288 + nt * 2048 + tid * 4;
#pragma unroll
    for (int j = 0; j < 5; ++j) *(float4*)(m + j * 12288) = make_float4(acc[j][0], acc[j][1], acc[j][2], acc[j][3]);
    __syncthreads();
}

DEV void hyfilt_tile(const Params& p, int tile, float* sm) {
    const int tid = tidx();
    int L, p0; u16* G; float* nrm = (float*)(p.ws + OFF_A) + 32 * 122880 + (size_t)tile * 2048;
    if (tile < 128) { L = 4096; p0 = tile * 32; G = (u16*)(p.ws + OFF_GS); }
    else { L = 256; p0 = (tile - 128) * 32; G = (u16*)(p.ws + OFF_GP); }
    float* z = sm; float* h1 = sm + 32 * 33; float* h2 = h1 + 2048;
    const float cang = (float)(6.283185307179586 / (double)L);
    for (int i = tid; i < 32 * 33; i += 512) { const int pp = i / 33, e = i % 33; const float pos = (float)(p0 + pp); float val;
        if (e == 0) val = pos / (float)(L - 1);
        else { const int bi = (e - 1) & 15; const float fb = 1e-4f + (float)bi * ((15.f - 1e-4f) / 15.f); const float ang = (cang * pos) * fb; val = (e <= 16) ? cosf(ang) : -sinf(ang); }
        z[i] = val; }
    __syncthreads();
    for (int i = tid; i < 2048; i += 512) { const int pp = i >> 6, j = i & 63; float a = p.in[19][j];
        for (int e = 0; e < 33; ++e) a += z[pp * 33 + e] * p.in[18][e * 64 + j];
        h1[i] = sinf(p.in[23][j] * a); }
    __syncthreads();
    for (int i = tid; i < 2048; i += 512) { const int pp = i >> 6, j = i & 63; float a = p.in[21][j];
        for (int e = 0; e < 64; ++e) a += h1[pp * 64 + e] * p.in[20][e * 64 + j];
        h2[i] = sinf(p.in[23][64 + j] * a); }
    __syncthreads();
    const float dlo = 3.0701134573253946f, dhi = 15.350567286626973f;
    for (int q = 0; q < 4; ++q) { const int n = tid + 512 * q; const int c = n & 1023; const int back = n >> 10;
        float wcol[64];
#pragma unroll
        for (int e = 0; e < 64; ++e) wcol[e] = p.in[22][e * 2048 + n];
        const float delta = dlo + (dhi - dlo) * ((float)c / 1023.f);
        float asum = 0.f;
        for (int pp = 0; pp < 32; ++pp) { float a = 0.f;
#pragma unroll
            for (int e = 0; e < 64; ++e) a += h2[pp * 64 + e] * wcol[e];
            const int pos = p0 + pp; const float t = (float)pos / (float)(L - 1); a *= expf(-t * delta);
            if (!(back && pos == 0)) { asum += fabsf(a); const int lag = back ? -pos : pos; G[(size_t)c * (2 * L) + (L - lag)] = f2bf(a); } }
        nrm[n] = asum; }
    if (p0 == 0) for (int c = tid; c < 1024; c += 512) G[(size_t)c * (2 * L)] = 0;
    __syncthreads();
}

DEV void phase_prep(const Params& p, unsigned char* shm) {
    const int tid = tidx(); float* sm = (float*)shm;
    if (blockIdx.x == 0 && tid == 0) *(unsigned*)(p.ws + OFF_SMALL + SMALL_BYTES) = 0u;
    { u16* LW = (u16*)(p.ws + OFF_LW); u16* G2T = (u16*)(p.ws + OFF_G2T);
        for (int i = blockIdx.x * 512 + tid; i < 4 * 1024 * 64 + 1024 * 128; i += gridDim.x * 512) {
            if (i < 262144) { const int mi = i >> 16, n = (i >> 6) & 1023, r = i & 63; LW[i] = f2bf((mi < 2 ? p.in[27] : p.in[29])[((size_t)(mi & 1) * 64 + r) * 1024 + n]); }
            else { const int j = i - 262144; const int n = j >> 7, r = j & 127; G2T[j] = f2bf(p.in[30][(size_t)r * 1024 + n]); } } }
    const int n0 = 136, n1 = n0 + 384, n2 = n1 + 3328, n3 = n2 + 1024, n4 = n3 + 5632, n5 = n4 + 2816;
    for (int t = blockIdx.x; t < n5; t += gridDim.x) {
        if (t < n0) hyfilt_tile(p, t, sm);
        else if (t < n1) adaln_tile(p, t - n0, sm);
        else if (t < n2) conv_job(p, 0, 0, t - n1, sm);
        else if (t < n3) conv_job(p, 1, 0, t - n2, sm);
        else if (t < n4) conv_job(p, 2, 0, t - n3, sm);
        else conv_job(p, 3, 0, t - n4, sm);
    }
}

DEV void phase_reduce(const Params& p) {
    const float* part = (const float*)(p.ws + OFF_A); float* mods = (float*)(p.ws + OFF_SMALL); float* hn = (float*)(p.ws + OFF_SMALL + 491520);
    for (int i = blockIdx.x * 512 + tidx(); i < 122880 + 2048; i += gridDim.x * 512) {
        if (i < 122880) { float a = 0.f; for (int kc = 0; kc < 32; ++kc) a += part[(size_t)kc * 122880 + i]; mods[i] = a; }
        else { const int j = i - 122880; const int c = j & 1023; const float* hp = part + 32 * 122880; float a = 0.f;
            if (j < 1024) { for (int t = 0; t < 128; ++t) a += hp[(size_t)t * 2048 + c] + hp[(size_t)t * 2048 + 1024 + c]; }
            else { for (int t = 128; t < 136; ++t) a += hp[(size_t)t * 2048 + c] + hp[(size_t)t * 2048 + 1024 + c]; }
            hn[j] = a; }
    }
}

DEV void phase_norm(const Params& p, int layer, int which, unsigned char* shm) {
    const int tid = tidx(), wid = tid >> 6, lane = tid & 63;
    const float* g = p.in[which ? 9 : 8] + layer * 2048;
    const float* X = p.out; u16* A = (u16*)(p.ws + OFF_A);
    const float* mods = (const float*)(p.ws + OFF_SMALL) + (size_t)layer * 5 * 12288; const float* bb = p.in[7] + layer * 12288;
    const int shi = which ? 3 : 0;
    const int nw = gridDim.x * 8, wv = blockIdx.x * 8 + wid; const int per = (NTOK + nw - 1) / nw; const int r0 = wv * per, r1 = (r0 + per < NTOK) ? r0 + per : NTOK;
    const bool first = (layer == 0 && which == 0);
    int cur = -1; float4 Am[8], Bm[8];
    for (int row = r0; row < r1; ++row) {
        const int cond = tok_cond(row);
        if (cond != cur) { cur = cond; const float* md = mods + (size_t)cond * 12288;
#pragma unroll
            for (int j = 0; j < 8; ++j) { const int col = (lane + 64 * j) * 4;
                const float4 gg = *(const float4*)(g + col);
                const float4 s1 = *(const float4*)(md + shi * 2048 + col), s2 = *(const float4*)(bb + shi * 2048 + col);
                const float4 c1 = *(const float4*)(md + (shi + 1) * 2048 + col), c2 = *(const float4*)(bb + (shi + 1) * 2048 + col);
                Am[j] = make_float4(gg.x * (1.f + c1.x + c2.x), gg.y * (1.f + c1.y + c2.y), gg.z * (1.f + c1.z + c2.z), gg.w * (1.f + c1.w + c2.w));
                Bm[j] = make_float4(s1.x + s2.x, s1.y + s2.y, s1.z + s2.z, s1.w + s2.w); } }
        const float* xsrc = X + (size_t)row * DM; if (first) xsrc = row < NTP ? p.in[0] + (size_t)row * DM : p.in[1] + (size_t)(row - NTP) * DM;
        const float4* xr = (const float4*)xsrc;
        float4 v[8]; float ss = 0.f;
#pragma unroll
        for (int j = 0; j < 8; ++j) { v[j] = xr[lane + 64 * j]; ss += v[j].x * v[j].x + v[j].y * v[j].y + v[j].z * v[j].z + v[j].w * v[j].w; }
        if (first) {
#pragma unroll
            for (int j = 0; j < 8; ++j) ((float4*)(p.out + (size_t)row * DM))[lane + 64 * j] = v[j]; }
        ss = wave_sum(ss);
        const float rstd = rsqrtf(ss * (1.f / 2048.f) + 1e-6f);
#pragma unroll
        for (int j = 0; j < 8; ++j) { const int col = (lane + 64 * j) * 4;
            u32x2 o; o.x = pk(v[j].x * rstd * Am[j].x + Bm[j].x, v[j].y * rstd * Am[j].y + Bm[j].y); o.y = pk(v[j].z * rstd * Am[j].z + Bm[j].z, v[j].w * rstd * Am[j].w + Bm[j].w);
            *(u32x2*)(A + (size_t)row * DM + col) = o; }
    }
    if (layer == 0 && which == 1) { const int na = conv_ntiles(0, 1), nb = na + conv_ntiles(1, 1);
        for (int t = blockIdx.x; t < nb; t += gridDim.x) { if (t < na) conv_job(p, 0, 1, t, (float*)shm); else conv_job(p, 1, 1, t - na, (float*)shm); } }
    if (layer == 1 && which == 0) { const int na = conv_ntiles(2, 1), nb = na + conv_ntiles(3, 1);
        for (int t = blockIdx.x; t < nb; t += gridDim.x) { if (t < na) conv_job(p, 2, 1, t, (float*)shm); else conv_job(p, 3, 1, t - na, (float*)shm); } }
}

DEV void sconv8(const u16* prow, bool hm, bool hp, const float* sw, const float* sb, int ch, float* o) {
    float c[8], m[8], q[8];
    unpack8(*(const u32x4*)(prow + ch), c);
    if (hm) unpack8(*(const u32x4*)(prow - LDP0 + ch), m); else { for (int i = 0; i < 8; ++i) m[i] = 0.f; }
    if (hp) unpack8(*(const u32x4*)(prow + LDP0 + ch), q); else { for (int i = 0; i < 8; ++i) q[i] = 0.f; }
#pragma unroll
    for (int i = 0; i < 8; ++i) o[i] = m[i] * sw[ch + i] + c[i] * sw[3072 + ch + i] + q[i] * sw[6144 + ch + i] + sb[ch + i];
}
DEV void hy_pre_tile(const Params& p, int tile, float* T) {
    const int tid = tidx(); const int tok0 = (tile >> 4) << 6, c0 = (tile & 15) << 6;
    const u16* P = (const u16*)(p.ws + OFF_P); u16* uT = (u16*)(p.ws + OFF_UT);
    { const int tk = tid >> 3, c8 = (tid & 7) << 3; const int tok = tok0 + tk; int t, L; tok_tl(tok, t, L);
        const u16* prow = P + (size_t)tok * LDP0; float x1[8], vv[8];
        sconv8(prow, t > 0, t < L - 1, p.in[16], p.in[17], 1024 + c0 + c8, x1);
        sconv8(prow, t > 0, t < L - 1, p.in[16], p.in[17], 2048 + c0 + c8, vv);
#pragma unroll
        for (int i = 0; i < 8; ++i) T[tk * 65 + c8 + i] = x1[i] * vv[i]; }
    __syncthreads();
    { const int ch = tid >> 3, t8 = (tid & 7) << 3; const float* t = T + t8 * 65 + ch;
        u32x4 o; o.x = pk(t[0], t[65]); o.y = pk(t[130], t[195]); o.z = pk(t[260], t[325]); o.w = pk(t[390], t[455]);
        *(u32x4*)(uT + (size_t)(c0 + ch) * NTOK + tok0 + t8) = o; }
    __syncthreads();
}
DEV void hy_post_tile(const Params& p, int tile, float* T) {
    const int tid = tidx(); const int tok0 = (tile >> 4) << 6, c0 = (tile & 15) << 6;
    const u16* P = (const u16*)(p.ws + OFF_P); const u16* uT = (const u16*)(p.ws + OFF_UT); u16* ycat = (u16*)(p.ws + OFF_A);
    { const int ch = tid >> 3, t8 = (tid & 7) << 3; float y[8]; unpack8(*(const u32x4*)(uT + (size_t)(c0 + ch) * NTOK + tok0 + t8), y);
#pragma unroll
        for (int i = 0; i < 8; ++i) T[(t8 + i) * 65 + ch] = y[i]; }
    __syncthreads();
    { const int tk = tid >> 3, c8 = (tid & 7) << 3; const int tok = tok0 + tk; int t, L; tok_tl(tok, t, L);
        const u16* prow = P + (size_t)tok * LDP0; float x0[8], x1[8], vv[8], o[8];
        sconv8(prow, t > 0, t < L - 1, p.in[16], p.in[17], c0 + c8, x0);
        sconv8(prow, t > 0, t < L - 1, p.in[16], p.in[17], 1024 + c0 + c8, x1);
        sconv8(prow, t > 0, t < L - 1, p.in[16], p.in[17], 2048 + c0 + c8, vv);
        const float* nrm = (const float*)(p.ws + OFF_SMALL + 491520) + (tok < NTP ? 1024 : 0);
#pragma unroll
        for (int i = 0; i < 8; ++i) { const int c = c0 + c8 + i; o[i] = x0[i] * (T[tk * 65 + c8 + i] * __builtin_amdgcn_rcpf(nrm[c]) + x1[i] * vv[i] * p.in[24][c]); }
        u32x4 w; w.x = pk(o[0], o[1]); w.y = pk(o[2], o[3]); w.z = pk(o[4], o[5]); w.w = pk(o[6], o[7]);
        *(u32x4*)(ycat + (size_t)tok * DM + c0 + c8) = w; }
    __syncthreads();
}
DEV void hyconv_task(const Params& p, int task, unsigned char* shm) {
    const int tid = tidx(), wid = tid >> 6, lane = tid & 63;
    const bool sample = task < 1024; const int c = sample ? task : task - 1024;
    const int L = sample ? 4096 : 256, NB = sample ? 4 : 32, lgNB = sample ? 2 : 5, LP = L + 8;
    u16* uL = (u16*)shm; u16* gL = uL + NB * LP; u16* gS = gL + 2 * L;
    const u16* G = sample ? (const u16*)(p.ws + OFF_GS) + (size_t)c * 8192 : (const u16*)(p.ws + OFF_GP) + (size_t)c * 512;
    u16* uT = (u16*)(p.ws + OFF_UT) + (size_t)c * NTOK + (sample ? NTP : 0);
    for (int i = tid * 8; i < NB * L; i += 4096) { const int b = i / L, s = i % L; *(u32x4*)(uL + b * LP + s) = *(const u32x4*)(uT + i); }
    for (int i = tid * 8; i < 2 * L; i += 4096) { const u32x4 w = *(const u32x4*)(G + i); *(u32x4*)(gL + i) = w;
        const unsigned nx = (i + 8 < 2 * L) ? (unsigned)G[i + 8] : 0u;
        u32x4 sft; sft.x = (w.x >> 16) | (w.y << 16); sft.y = (w.y >> 16) | (w.z << 16); sft.z = (w.z >> 16) | (w.w << 16); sft.w = (w.w >> 16) | (nx << 16);
        *(u32x4*)(gS + i) = sft; }
    __syncthreads();
    const int ntile = (NB * (L >> 5)) >> 5;
    const int npair = sample ? 8 : 8; const bool two = sample;
    const int r = lane & 31, half = lane >> 5;
    {
        const int ct0 = two ? 2 * wid : wid;
        const int colA = ct0 * 32 + r, colB = colA + 32;
        const int bA = colA & (NB - 1), iA = colA >> lgNB, bB = colB & (NB - 1), iB = colB >> lgNB; const int tA = iA * 32, tB = iB * 32;
        const int i_lo = (ct0 * 32) >> lgNB, i_hi = ((two ? ct0 + 1 : ct0) * 32 + 31) >> lgNB;
        const int d_lo = 32 * i_lo - (L - 16), d_hi = 32 * i_hi;
        f32x16 accA, accB;
#pragma unroll
        for (int j = 0; j < 16; ++j) { accA[j] = 0.f; accB[j] = 0.f; }
        const u16* ubA = uL + bA * LP + 8 * half; const u16* ubB = uL + bB * LP + 8 * half;
        const u16* gsel = (r & 1) ? gS : gL;
        const int qb = (L - r + 8 * half) & ~1;
#pragma unroll 4
        for (int dl = d_lo; dl <= d_hi; dl += 16) {
            const unsigned* gq = (const unsigned*)(gsel + (qb - dl));
            u32x4 aw; aw.x = gq[0]; aw.y = gq[1]; aw.z = gq[2]; aw.w = gq[3];
            const bf16x8 a = __builtin_bit_cast(bf16x8, aw);
            const int sA = tA - dl, sB = tB - dl;
            bf16x8 bvA = (bf16x8){0, 0, 0, 0, 0, 0, 0, 0}, bvB = bvA;
            if (sA >= 0 && sA <= L - 16) bvA = *(const bf16x8*)(ubA + sA);
            accA = __builtin_amdgcn_mfma_f32_32x32x16_bf16(a, bvA, accA, 0, 0, 0);
            if (two) { if (sB >= 0 && sB <= L - 16) bvB = *(const bf16x8*)(ubB + sB);
                accB = __builtin_amdgcn_mfma_f32_32x32x16_bf16(a, bvB, accB, 0, 0, 0); }
        }
#pragma unroll
        for (int g = 0; g < 4; ++g) { u32x2 w; w.x = pk(accA[4 * g], accA[4 * g + 1]); w.y = pk(accA[4 * g + 2], accA[4 * g + 3]);
            *(u32x2*)(uT + (size_t)bA * L + tA + 8 * g + 4 * half) = w; }
        if (two) {
#pragma unroll
            for (int g = 0; g < 4; ++g) { u32x2 w; w.x = pk(accB[4 * g], accB[4 * g + 1]); w.y = pk(accB[4 * g + 2], accB[4 * g + 3]);
                *(u32x2*)(uT + (size_t)bB * L + tB + 8 * g + 4 * half) = w; } }
    }
    (void)ntile; (void)npair;
    __syncthreads();
}

DEV void rwkv_lora_tile(const Params& p, int tile, unsigned char* shm) {
    const int tid = tidx(), wid = tid >> 6, lane = tid & 63, l15 = lane & 15, quad = lane >> 4; const int tok0 = tile * 32;
    const u16* P = (const u16*)(p.ws + OFF_P); u16* RW = (u16*)(p.ws + OFF_RW); const u16* LW = (const u16*)(p.ws + OFF_LW);
    u16* Ain = (u16*)shm;
    u16* Ol = (u16*)(shm + 18432);
    for (int i = tid; i < 32 * 256; i += 512) { const int tk = i >> 8, cc = i & 255; const int tok = tok0 + tk; int t, L; tok_tl(tok, t, L);
        const u16* pp = P + (size_t)tok * LDP0 + 6144 + cc; float x = bf2f(*pp); const float xm = t > 0 ? bf2f(pp[-LDP0]) : 0.f; const float xp = t < L - 1 ? bf2f(pp[LDP0]) : 0.f;
        const float mu = p.in[25][3072 + cc]; x = x + mu * (0.5f * (xm + xp) - x); if (cc < 128) x = tanhf(x);
        Ain[((cc >> 6) * 32 + tk) * 72 + (cc & 63)] = f2bf(x); }
    __syncthreads();
#pragma unroll 1
    for (int mi = 0; mi < 4; ++mi) {
        const float* bias = (mi < 2 ? p.in[26] : p.in[28]) + (mi & 1) * 1024;
        const float osc = mi < 2 ? 0.6065306597f : 1.f;
        bf16x8 af[2][2];
#pragma unroll
        for (int tt = 0; tt < 2; ++tt)
#pragma unroll
            for (int ks = 0; ks < 2; ++ks) af[tt][ks] = *(const bf16x8*)(Ain + (mi * 32 + tt * 16 + l15) * 72 + ks * 32 + quad * 8);
#pragma unroll 2
        for (int q = 0; q < 8; ++q) { const int nt = wid * 8 + q; const int n = nt * 16 + l15;
            const bf16x8 b0 = *(const bf16x8*)(LW + ((size_t)mi * 1024 + n) * 64 + quad * 8), b1 = *(const bf16x8*)(LW + ((size_t)mi * 1024 + n) * 64 + 32 + quad * 8);
            const float bs = bias[n];
#pragma unroll
            for (int tt = 0; tt < 2; ++tt) { f32x4 acc = (f32x4){0.f, 0.f, 0.f, 0.f}; acc = mfma16(af[tt][0], b0, acc); acc = mfma16(af[tt][1], b1, acc);
#pragma unroll
                for (int r = 0; r < 4; ++r) Ol[(tt * 16 + quad * 4 + r) * 1032 + n] = f2bf(osc * sigm(acc[r] + bs)); } }
        __syncthreads();
#pragma unroll
        for (int i = 0; i < 8; ++i) { const int piece = tid + 512 * i; const int tk = piece >> 7, c8 = (piece & 127) * 8;
            *(u32x4*)(RW + (size_t)(tok0 + tk) * 4096 + mi * 1024 + c8) = *(const u32x4*)(Ol + tk * 1032 + c8); }
        __syncthreads();
    }
}
DEV float mixf(float c, float m, float q, float mu) { return c + mu * (0.5f * (m + q) - c); }
DEV void rwkv_scan_task(const Params& p, int task, float* sm) {
    const bool sample = task < 128; const int tt_ = sample ? task : task - 128;
    const int b = tt_ >> 5, h = (tt_ >> 1) & 15, dir = tt_ & 1;
    const int L = sample ? 4096 : 256; const int tok0 = sample ? NTP + b * 4096 : b * 256;
    const int tid = tidx(), wid = tid >> 6, lane = tid & 63;
    const int kl = lane & 7;
    const int row2 = (wid & 3) * 16 + (lane >> 3) * 2;
    float S[8], T[8];
    const size_t so2 = ((((size_t)b * 2 + dir) * 16 + h) * 64 + row2) * 64 + kl * 8;
    if (sample) {
        const float4 a = *(const float4*)(p.in[2] + so2), c = *(const float4*)(p.in[2] + so2 + 4), d = *(const float4*)(p.in[2] + so2 + 64), e = *(const float4*)(p.in[2] + so2 + 68);
        S[0] = a.x; S[1] = a.y; S[2] = a.z; S[3] = a.w; S[4] = c.x; S[5] = c.y; S[6] = c.z; S[7] = c.w;
        T[0] = d.x; T[1] = d.y; T[2] = d.z; T[3] = d.w; T[4] = e.x; T[5] = e.y; T[6] = e.z; T[7] = e.w; }
    else {
#pragma unroll
        for (int i = 0; i < 8; ++i) { S[i] = 0.f; T[i] = 0.f; } }
    f32x2 S2[4], T2[4];
#pragma unroll
    for (int i = 0; i < 4; ++i) { S2[i] = (f32x2){S[2 * i], S[2 * i + 1]}; T2[i] = (f32x2){T[2 * i], T[2 * i + 1]}; }
    const int pk4 = (tid & 15) * 4; const int ch = h * 64 + pk4; const int plt = (tid & 255) >> 4;
    const float4 mur = *(const float4*)(p.in[25] + ch), muk = *(const float4*)(p.in[25] + 1024 + ch), muv = *(const float4*)(p.in[25] + 2048 + ch);
    const float4 kkw = *(const float4*)(p.in[31] + ch), kaw = *(const float4*)(p.in[32] + ch);
    const float murA[4] = {mur.x, mur.y, mur.z, mur.w}, mukA[4] = {muk.x, muk.y, muk.z, muk.w}, muvA[4] = {muv.x, muv.y, muv.z, muv.w};
    const float kkwA[4] = {kkw.x, kkw.y, kkw.z, kkw.w}, kawA[4] = {kaw.x, kaw.y, kaw.z, kaw.w};
    const u16* P = (const u16*)(p.ws + OFF_P); const u16* RW = (const u16*)(p.ws + OFF_RW);
    u16* Y = (u16*)(p.out + OUT_GLAST) + (dir ? (size_t)NTOK * 1024 : 0);
#define RW_PREP(c0_, buf_) do { float* vec_ = sm + (buf_) * 14336; float* vvs_ = vec_ + 10240; \
        _Pragma("unroll 1") for (int ps = 0; ps < 2; ++ps) { const int ptt = plt + 16 * ps; \
            const int t = dir ? (L - 1 - ((c0_) + ptt)) : ((c0_) + ptt); const size_t tok = (size_t)tok0 + t; \
            const u16* pr = P + tok * LDP0 + 3072 + ch; \
            float rc[4], kc[4], vc[4], rm[4], km[4], vm[4], rp[4], kp[4], vp[4], ee[4], aa[4]; \
            unpack4(*(const u32x2*)(pr), rc); unpack4(*(const u32x2*)(pr + 1024), kc); unpack4(*(const u32x2*)(pr + 2048), vc); \
            if (t > 0) { const u16* pm = P + (tok - 1) * LDP0 + 3072 + ch; unpack4(*(const u32x2*)(pm), rm); unpack4(*(const u32x2*)(pm + 1024), km); unpack4(*(const u32x2*)(pm + 2048), vm); } \
            else { for (int i = 0; i < 4; ++i) { rm[i] = 0.f; km[i] = 0.f; vm[i] = 0.f; } } \
            if (t < L - 1) { unpack4(*(const u32x2*)(pr + LDP0), rp); unpack4(*(const u32x2*)(pr + LDP0 + 1024), kp); unpack4(*(const u32x2*)(pr + LDP0 + 2048), vp); } \
            else { for (int i = 0; i < 4; ++i) { rp[i] = 0.f; kp[i] = 0.f; vp[i] = 0.f; } } \
            unpack4(*(const u32x2*)(RW + tok * 4096 + dir * 1024 + ch), ee); unpack4(*(const u32x2*)(RW + tok * 4096 + (2 + dir) * 1024 + ch), aa); \
            float r4[4], k4[4], v4[4], kr[4]; float ss = 0.f; \
            _Pragma("unroll") for (int i = 0; i < 4; ++i) { r4[i] = mixf(rc[i], rm[i], rp[i], murA[i]); k4[i] = mixf(kc[i], km[i], kp[i], mukA[i]); v4[i] = mixf(vc[i], vm[i], vp[i], muvA[i]); \
                kr[i] = k4[i] * kkwA[i]; ss += kr[i] * kr[i]; } \
            ss = sum16(ss); const float inv = rsqrtf(ss + 1e-12f); \
            float tkk[4], tw[4], tkka[4], tkd[4]; \
            _Pragma("unroll") for (int i = 0; i < 4; ++i) { tkk[i] = kr[i] * inv; tw[i] = __expf(-ee[i]); tkka[i] = tkk[i] * aa[i]; tkd[i] = k4[i] * (1.f + (aa[i] - 1.f) * kawA[i]); } \
            float* vj = vec_ + ptt * 320 + pk4; \
            *(float4*)(vj) = make_float4(tkk[0], tkk[1], tkk[2], tkk[3]); *(float4*)(vj + 64) = make_float4(tw[0], tw[1], tw[2], tw[3]); *(float4*)(vj + 128) = make_float4(tkka[0], tkka[1], tkka[2], tkka[3]); \
            *(float4*)(vj + 192) = make_float4(tkd[0], tkd[1], tkd[2], tkd[3]); *(float4*)(vj + 256) = make_float4(r4[0], r4[1], r4[2], r4[3]); \
            *(float4*)(vvs_ + ptt * 64 + pk4) = make_float4(v4[0], v4[1], v4[2], v4[3]); } } while (0)
#define RW_YOUT(c0_, buf_) do { const float* yb_ = sm + (buf_) * 14336 + 12288; \
        _Pragma("unroll 1") for (int ps = 0; ps < 2; ++ps) { const int ptt = plt + 16 * ps; const int t = dir ? (L - 1 - ((c0_) + ptt)) : ((c0_) + ptt); \
            const float4 yv = *(const float4*)(yb_ + ptt * 64 + pk4); u32x2 w; w.x = pk(yv.x, yv.y); w.y = pk(yv.z, yv.w); \
            *(u32x2*)(Y + ((size_t)tok0 + t) * 1024 + ch) = w; } } while (0)
    const int nchunk = L >> 5;
    if (wid >= 4) RW_PREP(0, 0);
    __syncthreads();
#pragma unroll 1
    for (int c = 0; c < nchunk; ++c) {
        if (wid < 4) {
            const float* vec = sm + (c & 1) * 14336; const float* vvs = vec + 10240; float* yb = sm + (c & 1) * 14336 + 12288;
#pragma unroll
            for (int j = 0; j < 32; ++j) {
                const float* vj = vec + j * 320 + kl * 8;
                const f32x4 a0 = *(const f32x4*)(vj), a1 = *(const f32x4*)(vj + 4);
                const f32x4 w0 = *(const f32x4*)(vj + 64), w1 = *(const f32x4*)(vj + 68);
                const f32x4 b0 = *(const f32x4*)(vj + 128), b1 = *(const f32x4*)(vj + 132);
                const f32x4 d0 = *(const f32x4*)(vj + 192), d1 = *(const f32x4*)(vj + 196);
                const f32x4 r0 = *(const f32x4*)(vj + 256), r1 = *(const f32x4*)(vj + 260);
                const float2 vr = *(const float2*)(vvs + j * 64 + row2);
                const f32x2 kk0 = a0.lo, kk1 = a0.hi, kk2 = a1.lo, kk3 = a1.hi;
                f32x2 pa = S2[0] * kk0; pa += S2[1] * kk1; pa += S2[2] * kk2; pa += S2[3] * kk3;
                f32x2 pb = T2[0] * kk0; pb += T2[1] * kk1; pb += T2[2] * kk2; pb += T2[3] * kk3;
                const float sa = -sum8(pa.x + pa.y), sb = -sum8(pb.x + pb.y);
                const f32x2 sa2 = (f32x2){sa, sa}, sb2 = (f32x2){sb, sb}, vx2 = (f32x2){vr.x, vr.x}, vy2 = (f32x2){vr.y, vr.y};
                S2[0] = S2[0] * w0.lo + (sa2 * b0.lo + vx2 * d0.lo); S2[1] = S2[1] * w0.hi + (sa2 * b0.hi + vx2 * d0.hi);
                S2[2] = S2[2] * w1.lo + (sa2 * b1.lo + vx2 * d1.lo); S2[3] = S2[3] * w1.hi + (sa2 * b1.hi + vx2 * d1.hi);
                T2[0] = T2[0] * w0.lo + (sb2 * b0.lo + vy2 * d0.lo); T2[1] = T2[1] * w0.hi + (sb2 * b0.hi + vy2 * d0.hi);
                T2[2] = T2[2] * w1.lo + (sb2 * b1.lo + vy2 * d1.lo); T2[3] = T2[3] * w1.hi + (sb2 * b1.hi + vy2 * d1.hi);
                f32x2 qa = S2[0] * r0.lo; qa += S2[1] * r0.hi; qa += S2[2] * r1.lo; qa += S2[3] * r1.hi;
                f32x2 qb = T2[0] * r0.lo; qb += T2[1] * r0.hi; qb += T2[2] * r1.lo; qb += T2[3] * r1.hi;
                const float y0 = sum8(qa.x + qa.y), y1 = sum8(qb.x + qb.y);
                if (kl == 0) *(float2*)(yb + j * 64 + row2) = make_float2(y0, y1);
            }
        } else {
            if (c > 0) RW_YOUT((c - 1) * 32, (c - 1) & 1);
            if (c + 1 < nchunk) RW_PREP((c + 1) * 32, (c + 1) & 1);
        }
        __syncthreads();
    }
    if (wid >= 4) RW_YOUT((nchunk - 1) * 32, (nchunk - 1) & 1);
#undef RW_PREP
#undef RW_YOUT
#pragma unroll
    for (int i = 0; i < 4; ++i) { S[2 * i] = S2[i].x; S[2 * i + 1] = S2[i].y; T[2 * i] = T2[i].x; T[2 * i + 1] = T2[i].y; }
    if (!sample && wid < 4) { float* so = p.out + OUT_RWST + so2;
        *(float4*)(so) = make_float4(S[0], S[1], S[2], S[3]); *(float4*)(so + 4) = make_float4(S[4], S[5], S[6], S[7]);
        *(float4*)(so + 64) = make_float4(T[0], T[1], T[2], T[3]); *(float4*)(so + 68) = make_float4(T[4], T[5], T[6], T[7]); }
    __syncthreads();
}
DEV void rwkv_post_tile(const Params& p, int tile, float* sm) {
    const int tid = tidx(); const int tok0 = tile * 32;
    const u16* P = (const u16*)(p.ws + OFF_P); const u16* RW = (const u16*)(p.ws + OFF_RW); u16* ycat = (u16*)(p.ws + OFF_A);
    const u16* YF = (const u16*)(p.out + OUT_GLAST); const u16* YB = YF + (size_t)NTOK * 1024;
    u16* Gh = (u16*)(sm + 4096);
    for (int i = tid; i < 32 * 128; i += 512) { const int tk = i >> 7, r = i & 127; const int tok = tok0 + tk; int t, L; tok_tl(tok, t, L);
        const u16* pp = P + (size_t)tok * LDP0 + 6400 + r; const float x = bf2f(*pp); const float xm = t > 0 ? bf2f(pp[-LDP0]) : 0.f; const float xp = t < L - 1 ? bf2f(pp[LDP0]) : 0.f;
        sm[i] = sigm(mixf(x, xm, xp, p.in[25][3328 + r])); }
    __syncthreads();
    { float g0[32], g1[32];
#pragma unroll
        for (int k = 0; k < 32; ++k) { g0[k] = 0.f; g1[k] = 0.f; }
        const float* g2 = p.in[30];
        for (int r = 0; r < 128; r += 4) {
            float wa[4], wb[4];
#pragma unroll
            for (int q = 0; q < 4; ++q) { wa[q] = g2[(r + q) * 1024 + tid]; wb[q] = g2[(r + q) * 1024 + 512 + tid]; }
#pragma unroll
            for (int k = 0; k < 32; ++k) { const float4 s4 = *(const float4*)(sm + k * 128 + r);
                g0[k] += s4.x * wa[0] + s4.y * wa[1] + s4.z * wa[2] + s4.w * wa[3]; g1[k] += s4.x * wb[0] + s4.y * wb[1] + s4.z * wb[2] + s4.w * wb[3]; } }
#pragma unroll
        for (int k = 0; k < 32; ++k) { Gh[k * 1024 + tid] = f2bf(g0[k]); Gh[k * 1024 + 512 + tid] = f2bf(g1[k]); } }
    __syncthreads();
    const int c8 = (tid & 127) * 8;
    float mur[8], muk[8], muv[8], ka[8], rk[8], lw[8], lb[8];
#pragma unroll
    for (int i = 0; i < 8; ++i) { mur[i] = p.in[25][c8 + i]; muk[i] = p.in[25][1024 + c8 + i]; muv[i] = p.in[25][2048 + c8 + i]; ka[i] = p.in[32][c8 + i]; rk[i] = p.in[33][c8 + i]; lw[i] = p.in[34][c8 + i]; lb[i] = p.in[35][c8 + i]; }
#pragma unroll 1
    for (int it = 0; it < 8; ++it) { const int tk = (tid >> 7) + 4 * it; const int tok = tok0 + tk; int t, L; tok_tl(tok, t, L);
        const u16* pr = P + (size_t)tok * LDP0 + 3072 + c8; const bool hm = t > 0, hp = t < L - 1;
        float rc[8], rm[8], rp[8], kc[8], km[8], kp[8], vc[8], vm[8], vp[8], a0[8], a1[8], yf[8], yb[8], gg[8];
        unpack8(*(const u32x4*)pr, rc); unpack8(*(const u32x4*)(pr + 1024), kc); unpack8(*(const u32x4*)(pr + 2048), vc);
        if (hm) { const u16* pm = P + (size_t)(tok - 1) * LDP0 + 3072 + c8; unpack8(*(const u32x4*)(pm), rm); unpack8(*(const u32x4*)(pm + 1024), km); unpack8(*(const u32x4*)(pm + 2048), vm); }
        else { for (int i = 0; i < 8; ++i) { rm[i] = 0.f; km[i] = 0.f; vm[i] = 0.f; } }
        if (hp) { unpack8(*(const u32x4*)(pr + LDP0), rp); unpack8(*(const u32x4*)(pr + LDP0 + 1024), kp); unpack8(*(const u32x4*)(pr + LDP0 + 2048), vp); }
        else { for (int i = 0; i < 8; ++i) { rp[i] = 0.f; kp[i] = 0.f; vp[i] = 0.f; } }
        unpack8(*(const u32x4*)(RW + (size_t)tok * 4096 + 2048 + c8), a0); unpack8(*(const u32x4*)(RW + (size_t)tok * 4096 + 3072 + c8), a1);
        unpack8(*(const u32x4*)(YF + (size_t)tok * 1024 + c8), yf); unpack8(*(const u32x4*)(YB + (size_t)tok * 1024 + c8), yb);
        unpack8(*(const u32x4*)(Gh + tk * 1024 + c8), gg);
        float y[8], v_[8]; float bon = 0.f, sy = 0.f;
#pragma unroll
        for (int i = 0; i < 8; ++i) { const float r_ = mixf(rc[i], rm[i], rp[i], mur[i]), k_ = mixf(kc[i], km[i], kp[i], muk[i]); v_[i] = mixf(vc[i], vm[i], vp[i], muv[i]);
            bon += r_ * k_ * (2.f + (a0[i] + a1[i] - 2.f) * ka[i]) * rk[i]; y[i] = yf[i] + yb[i]; sy += y[i]; }
        bon = sum8(bon); const float mean = sum8(sy) * (1.f / 64.f);
        float sv = 0.f;
#pragma unroll
        for (int i = 0; i < 8; ++i) { y[i] -= mean; sv += y[i] * y[i]; }
        const float rstd = rsqrtf(sum8(sv) * (1.f / 64.f) + 64e-5f);
        float o[8];
#pragma unroll
        for (int i = 0; i < 8; ++i) o[i] = (y[i] * rstd * lw[i] + lb[i] + bon * v_[i]) * gg[i];
        u32x4 w; w.x = pk(o[0], o[1]); w.y = pk(o[2], o[3]); w.z = pk(o[4], o[5]); w.w = pk(o[6], o[7]);
        *(u32x4*)(ycat + (size_t)tok * DM + 1024 + c8) = w; }
    __syncthreads();
}

DEV float logsig(float x) { return fminf(x, 0.f) - __logf(1.f + __expf(-fabsf(x))); }
DEV void gla_intra_task(const Params& p, int task, unsigned char* shm) {
    const int tid = tidx(), wid = tid >> 6, lane = tid & 63, l15 = lane & 15, quad = lane >> 4;
    const int cidx = task >> 2, h = task & 3; const int tok0 = cidx * 64;
    u16* P = (u16*)(p.ws + OFF_P); u16* QB = (u16*)(p.ws + OFF_A); float* Dbuf = (float*)(p.ws + OFF_DB);
    u16* qi = (u16*)shm; u16* ki = qi + 64 * 264; u16* vl = (u16*)shm; u16* Pl = (u16*)(shm + 67584); float* gl = (float*)(shm + 76800); float* tot = (float*)(shm + 84992);
    for (int i = tid; i < 2048; i += 512) { const int tl = i >> 5, c = i & 31; gl[i] = bf2f(P[(size_t)(tok0 + tl) * LDP1 + 6144 + c]); }
    __syncthreads();
    const int k = tid & 255, jh = tid >> 8;
#pragma unroll 1
    for (int dd = 0; dd < 2; ++dd) { const int dir = 1 - dd;
        float g2r[16];
#pragma unroll
        for (int r = 0; r < 16; ++r) g2r[r] = p.in[38][(size_t)(dir * 16 + r) * 1024 + h * 256 + k];
        const float gb = p.in[39][dir * 1024 + h * 256 + k];
        float bl[32]; float run = 0.f;
#pragma unroll
        for (int jj = 0; jj < 32; ++jj) { const int j = jh * 32 + jj; const int tl = dir ? 63 - j : j; const float* gr = gl + tl * 32 + dir * 16;
            float x = gb;
#pragma unroll
            for (int r = 0; r < 16; r += 4) { const float4 g4 = *(const float4*)(gr + r); x += g4.x * g2r[r] + g4.y * g2r[r + 1] + g4.z * g2r[r + 2] + g4.w * g2r[r + 3]; }
            run += logsig(x) * 0.0625f; bl[jj] = run; }
        tot[jh * 256 + k] = run;
        __syncthreads();
        const float t0v = tot[k], t1v = tot[256 + k]; const float off = jh ? t0v : 0.f; const float bref = t0v, blast = t0v + t1v;
        if (jh == 0) Dbuf[((size_t)cidx * 2 + dir) * 1024 + h * 256 + k] = __expf(blast);
        u16* qdst; u16* kdst; size_t ldd;
        if (dir == 0) { qdst = P + h * 256 + k; kdst = P + 1024 + h * 256 + k; ldd = LDP1; } else { qdst = QB + h * 256 + k; kdst = QB + 1024 + h * 256 + k; ldd = 2048; }
#pragma unroll
        for (int jj = 0; jj < 32; ++jj) { const int j = jh * 32 + jj; const int tl = dir ? 63 - j : j; const size_t tok = (size_t)tok0 + tl;
            const float qv = bf2f(P[tok * LDP1 + h * 256 + k]) * 0.0625f, kv = bf2f(P[tok * LDP1 + 1024 + h * 256 + k]);
            const float b = bl[jj] + off;
            qi[j * 264 + k] = f2bf(qv * __expf(b - bref)); ki[j * 264 + k] = f2bf(kv * __expf(bref - b));
            qdst[tok * ldd] = f2bf(qv * __expf(b)); kdst[tok * ldd] = f2bf(kv * __expf(blast - b)); }
        __syncthreads();
        { const int tt = wid >> 1;
#pragma unroll
            for (int q2 = 0; q2 < 2; ++q2) { const int st = (wid & 1) * 2 + q2; f32x4 acc = (f32x4){0.f, 0.f, 0.f, 0.f};
                if (st <= tt) {
#pragma unroll
                    for (int ks = 0; ks < 8; ++ks) { const bf16x8 a = *(const bf16x8*)(qi + (tt * 16 + l15) * 264 + ks * 32 + quad * 8); const bf16x8 b = *(const bf16x8*)(ki + (st * 16 + l15) * 264 + ks * 32 + quad * 8);
                        acc = mfma16(a, b, acc); } }
#pragma unroll
                for (int r = 0; r < 4; ++r) { const int t = tt * 16 + quad * 4 + r, s_ = st * 16 + l15; Pl[t * 72 + s_] = f2bf(s_ <= t ? acc[r] : 0.f); } } }
        __syncthreads();
#pragma unroll
        for (int i = 0; i < 8; ++i) { const int piece = tid + 512 * i; const int j = piece >> 6, c8 = (piece & 63) * 8; const int tl = dir ? 63 - j : j;
            *(u32x4*)(vl + j * 520 + c8) = *(const u32x4*)(P + (size_t)(tok0 + tl) * LDP1 + 2048 + h * 512 + c8); }
        __syncthreads();
        u16* O = (u16*)(p.ws + (dir ? OFF_OB : OFF_OF)) + h * 512;
#pragma unroll 1
        for (int q4 = 0; q4 < 4; ++q4) { const int vt = wid * 4 + q4; f32x4 acc[4];
#pragma unroll
            for (int tt = 0; tt < 4; ++tt) acc[tt] = (f32x4){0.f, 0.f, 0.f, 0.f};
#pragma unroll
            for (int ss = 0; ss < 2; ++ss) { bf16x8 bfr;
#pragma unroll
                for (int jj = 0; jj < 8; ++jj) bfr[jj] = (short)vl[(ss * 32 + quad * 8 + jj) * 520 + vt * 16 + l15];
#pragma unroll
                for (int tt = 0; tt < 4; ++tt) { if (ss * 32 <= tt * 16 + 15) { const bf16x8 a = *(const bf16x8*)(Pl + (tt * 16 + l15) * 72 + ss * 32 + quad * 8); acc[tt] = mfma16(a, bfr, acc[tt]); } } }
#pragma unroll
            for (int tt = 0; tt < 4; ++tt)
#pragma unroll
                for (int r = 0; r < 4; ++r) { const int t = tt * 16 + quad * 4 + r; const int tl = dir ? 63 - t : t; O[(size_t)(tok0 + tl) * DM + vt * 16 + l15] = f2bf(acc[tt][r]); } }
        __syncthreads();
    }
}
DEV void gla_inter_task(const Params& p, int task, unsigned char* shm) {
    const bool sample = task < 256; const int tt_ = sample ? task : task - 256;
    const int seq = tt_ >> 3, vs = tt_ & 7; const int b = seq >> 3, h = (seq >> 1) & 3, dir = seq & 1;
    const int L = sample ? 4096 : 256; const int tok0 = sample ? NTP + b * 4096 : b * 256;
    const int nch = L >> 6, cbase = tok0 >> 6;
    const int tid = tidx(), wid = tid >> 6, lane = tid & 63, l15 = lane & 15, quad = lane >> 4;
    const u16* P = (const u16*)(p.ws + OFF_P); const u16* QB = (const u16*)(p.ws + OFF_A); const float* Dbuf = (const float*)(p.ws + OFF_DB);
    u16* ST = (u16*)shm; u16* qdl = (u16*)(shm + 33792); u16* kdl = (u16*)(shm + 67584); u16* vl = (u16*)(shm + 101376); float* dl = (float*)(shm + 110592);
    f32x4 S[2][4];
    const size_t sbase = (((size_t)b * 2 + dir) * 4 + h) * 256 * 512 + vs * 64;
#pragma unroll
    for (int kt = 0; kt < 2; ++kt)
#pragma unroll
        for (int vt = 0; vt < 4; ++vt)
#pragma unroll
            for (int r = 0; r < 4; ++r) { const int kk = wid * 32 + kt * 16 + quad * 4 + r; S[kt][vt][r] = sample ? p.in[3][sbase + (size_t)kk * 512 + vt * 16 + l15] : 0.f; }
    const u16* qsrc; const u16* ksrc; size_t lds_;
    if (dir == 0) { qsrc = P + h * 256; ksrc = P + 1024 + h * 256; lds_ = LDP1; } else { qsrc = QB + h * 256; ksrc = QB + 1024 + h * 256; lds_ = 2048; }
    const u16* vsrc = P + 2048 + h * 512 + vs * 64;
    u16* O = (u16*)(p.ws + (dir ? OFF_OB : OFF_OF)) + h * 512 + vs * 64;
    u32x4 rq[4], rk[4], rv; float rd = 0.f;
    const int vrow = tid >> 3, vc8 = (tid & 7) * 8;
#define GLA_ISSUE(n_) do { const int cidx_ = cbase + (dir ? nch - 1 - (n_) : (n_)); \
        _Pragma("unroll") for (int i = 0; i < 4; ++i) { const int piece = tid + 512 * i; const int j = piece >> 5, c8 = (piece & 31) * 8; const size_t tok = (size_t)cidx_ * 64 + (dir ? 63 - j : j); \
            rq[i] = *(const u32x4*)(qsrc + tok * lds_ + c8); rk[i] = *(const u32x4*)(ksrc + tok * lds_ + c8); } \
        { const size_t tok = (size_t)cidx_ * 64 + (dir ? 63 - vrow : vrow); rv = *(const u32x4*)(vsrc + tok * LDP1 + vc8); } \
        if (tid < 256) rd = Dbuf[((size_t)cidx_ * 2 + dir) * 1024 + h * 256 + tid]; } while (0)
#define GLA_WRITE_ST() do { _Pragma("unroll") for (int kt = 0; kt < 2; ++kt) _Pragma("unroll") for (int vt = 0; vt < 4; ++vt) { u32x2 w; w.x = pk(S[kt][vt][0], S[kt][vt][1]); w.y = pk(S[kt][vt][2], S[kt][vt][3]); \
            *(u32x2*)(ST + (vt * 16 + l15) * 264 + wid * 32 + kt * 16 + quad * 4) = w; } } while (0)
    GLA_WRITE_ST();
    GLA_ISSUE(0);
    const int tt = wid >> 1, vb = (wid & 1) * 2;
#pragma unroll 1
    for (int n = 0; n < nch; ++n) {
        const int cidx = cbase + (dir ? nch - 1 - n : n);
#pragma unroll
        for (int i = 0; i < 4; ++i) { const int piece = tid + 512 * i; const int j = piece >> 5, c8 = (piece & 31) * 8; *(u32x4*)(qdl + j * 264 + c8) = rq[i]; *(u32x4*)(kdl + j * 264 + c8) = rk[i]; }
        *(u32x4*)(vl + vrow * 72 + vc8) = rv; if (tid < 256) dl[tid] = rd;
        __syncthreads();
        if (n + 1 < nch) GLA_ISSUE(n + 1);
        float oi[2][4];
#pragma unroll
        for (int q2 = 0; q2 < 2; ++q2)
#pragma unroll
            for (int r = 0; r < 4; ++r) { const int j = tt * 16 + quad * 4 + r; const size_t tok = (size_t)cidx * 64 + (dir ? 63 - j : j); oi[q2][r] = bf2f(O[tok * DM + (vb + q2) * 16 + l15]); }
        f32x4 oacc[2]; oacc[0] = (f32x4){0.f, 0.f, 0.f, 0.f}; oacc[1] = oacc[0];
#pragma unroll
        for (int ks = 0; ks < 8; ++ks) { const bf16x8 a = *(const bf16x8*)(qdl + (tt * 16 + l15) * 264 + ks * 32 + quad * 8);
#pragma unroll
            for (int q2 = 0; q2 < 2; ++q2) { const bf16x8 bfr = *(const bf16x8*)(ST + ((vb + q2) * 16 + l15) * 264 + ks * 32 + quad * 8); oacc[q2] = mfma16(a, bfr, oacc[q2]); } }
#pragma unroll
        for (int kt = 0; kt < 2; ++kt) { const f32x4 dv = *(const f32x4*)(dl + wid * 32 + kt * 16 + quad * 4);
#pragma unroll
            for (int vt = 0; vt < 4; ++vt) S[kt][vt] = S[kt][vt] * dv; }
#pragma unroll
        for (int ts = 0; ts < 2; ++ts) { bf16x8 af[2];
#pragma unroll
            for (int kt = 0; kt < 2; ++kt)
#pragma unroll
                for (int jj = 0; jj < 8; ++jj) af[kt][jj] = (short)kdl[(ts * 32 + quad * 8 + jj) * 264 + wid * 32 + kt * 16 + l15];
#pragma unroll
            for (int vt = 0; vt < 4; ++vt) { bf16x8 bfr;
#pragma unroll
                for (int jj = 0; jj < 8; ++jj) bfr[jj] = (short)vl[(ts * 32 + quad * 8 + jj) * 72 + vt * 16 + l15];
#pragma unroll
                for (int kt = 0; kt < 2; ++kt) S[kt][vt] = mfma16(af[kt], bfr, S[kt][vt]); } }
#pragma unroll
        for (int q2 = 0; q2 < 2; ++q2)
#pragma unroll
            for (int r = 0; r < 4; ++r) { const int j = tt * 16 + quad * 4 + r; const size_t tok = (size_t)cidx * 64 + (dir ? 63 - j : j); O[tok * DM + (vb + q2) * 16 + l15] = f2bf(oi[q2][r] + oacc[q2][r]); }
        __syncthreads();
        GLA_WRITE_ST();
        __syncthreads();
    }
#undef GLA_ISSUE
#undef GLA_WRITE_ST
    if (!sample) { float* so = p.out + OUT_GLAST + sbase;
#pragma unroll
        for (int kt = 0; kt < 2; ++kt)
#pragma unroll
            for (int vt = 0; vt < 4; ++vt)
#pragma unroll
                for (int r = 0; r < 4; ++r) { const int kk = wid * 32 + kt * 16 + quad * 4 + r; so[(size_t)kk * 512 + vt * 16 + l15] = S[kt][vt][r]; } }
    __syncthreads();
}
DEV void phase_gla_post(const Params& p) {
    const int tid = tidx(), wid = tid >> 6, lane = tid & 63;
    const u16* P = (const u16*)(p.ws + OFF_P); const u16* OF = (const u16*)(p.ws + OFF_OF); const u16* OB = (const u16*)(p.ws + OFF_OB); u16* ycat = (u16*)(p.ws + OFF_A);
    for (int it = blockIdx.x * 8 + wid; it < NTOK * 4; it += gridDim.x * 8) { const int tok = it >> 2, h = it & 3; const int v8 = lane * 8;
        float a[8], b[8], g[8]; unpack8(*(const u32x4*)(OF + (size_t)tok * DM + h * 512 + v8), a); unpack8(*(const u32x4*)(OB + (size_t)tok * DM + h * 512 + v8), b);
        unpack8(*(const u32x4*)(P + (size_t)tok * LDP1 + 4096 + h * 512 + v8), g);
        float ss = 0.f;
#pragma unroll
        for (int i = 0; i < 8; ++i) { a[i] += b[i]; ss += a[i] * a[i]; }
        ss = wave_sum(ss); const float sc = rsqrtf(ss * (1.f / 512.f) + 1e-6f);
        float o[8];
#pragma unroll
        for (int i = 0; i < 8; ++i) o[i] = a[i] * sc * p.in[40][v8 + i] * (g[i] * sigm(g[i]));
        u32x4 w; w.x = pk(o[0], o[1]); w.y = pk(o[2], o[3]); w.z = pk(o[4], o[5]); w.w = pk(o[6], o[7]);
        *(u32x4*)(ycat + (size_t)tok * DM + h * 512 + v8) = w; }
}

DEV void gate_loadcol(const u16* U, long tokc, int c8, bool colok, bool up, bool dn, int W, float (*dst)[8]) {
    if (colok && up) unpack8(*(const u32x4*)(U + (size_t)(tokc - W) * LDU + c8), dst[0]); else { for (int i = 0; i < 8; ++i) dst[0][i] = 0.f; }
    if (colok) unpack8(*(const u32x4*)(U + (size_t)tokc * LDU + c8), dst[1]); else { for (int i = 0; i < 8; ++i) dst[1][i] = 0.f; }
    if (colok && dn) unpack8(*(const u32x4*)(U + (size_t)(tokc + W) * LDU + c8), dst[2]); else { for (int i = 0; i < 8; ++i) dst[2][i] = 0.f; }
}
DEV void phase_ffn_gate(const Params& p, int layer) {
    u16* U = (u16*)(p.ws + OFF_U); const float* cw = p.in[11] + (size_t)layer * 9 * DFF;
    const int tid_ = tidx(), wid_ = tid_ >> 6, lane_ = tid_ & 63;
    for (int bu = blockIdx.x; bu < 1408 + 704; bu += gridDim.x) {
        int tokS, c8;
        if (bu < 1408) { const int rg = bu / 44, rem = bu % 44; const int qtr = rem / 11, cgg = rem % 11; tokS = NTP + (rg * 8 + wid_) * 64 + qtr * 16; c8 = (cgg * 64 + lane_) * 8; }
        else { const int pu = bu - 1408; const int sg = pu / 11, cgg = pu % 11; tokS = (sg * 8 + wid_) * 16; c8 = (cgg * 64 + lane_) * 8; }
        int W, colS; bool up, dn;
        if (tokS < NTP) { W = 256; colS = tokS & 255; up = false; dn = false; }
        else { W = 64; colS = tokS & 63; const int rr = ((tokS - NTP) >> 6) & 63; up = rr > 0; dn = rr < 63; }
        float wt[9][8];
#pragma unroll
        for (int q = 0; q < 9; ++q) { const float4 a = *(const float4*)(cw + q * DFF + c8), b = *(const float4*)(cw + q * DFF + c8 + 4);
            wt[q][0] = a.x; wt[q][1] = a.y; wt[q][2] = a.z; wt[q][3] = a.w; wt[q][4] = b.x; wt[q][5] = b.y; wt[q][6] = b.z; wt[q][7] = b.w; }
        float w0[3][8], w1[3][8], w2[3][8];
        gate_loadcol(U, (long)tokS - 1, c8, colS > 0, up, dn, W, w0);
        gate_loadcol(U, (long)tokS, c8, true, up, dn, W, w1);
#pragma unroll 8
        for (int s_ = 0; s_ < 16; ++s_) {
            const long tok = (long)tokS + s_;
            gate_loadcol(U, tok + 1, c8, colS + s_ + 1 < W, up, dn, W, w2);
            u16* vp = U + (size_t)tok * LDU + DFF + c8; float v[8]; unpack8(*(const u32x4*)vp, v);
#pragma unroll
            for (int i = 0; i < 8; ++i) { float a = 0.f;
#pragma unroll
                for (int di = 0; di < 3; ++di) a += w0[di][i] * wt[di * 3][i] + w1[di][i] * wt[di * 3 + 1][i] + w2[di][i] * wt[di * 3 + 2][i];
                v[i] *= a * sigm(a); }
            u32x4 w; w.x = pk(v[0], v[1]); w.y = pk(v[2], v[3]); w.z = pk(v[4], v[5]); w.w = pk(v[6], v[7]);
            *(u32x4*)vp = w;
#pragma unroll
            for (int di = 0; di < 3; ++di)
#pragma unroll
                for (int i = 0; i < 8; ++i) { w0[di][i] = w1[di][i]; w1[di][i] = w2[di][i]; }
        }
    }
}

DEV void phase_final_norm(const Params& p) {
    const int tid = tidx(), wid = tid >> 6, lane = tid & 63; const float* g = p.in[13];
    for (int row = blockIdx.x * 8 + wid; row < NTOK; row += gridDim.x * 8) {
        float4* xr = (float4*)(p.out + (size_t)row * DM);
        float4 v[8]; float ss = 0.f;
#pragma unroll
        for (int j = 0; j < 8; ++j) { v[j] = xr[lane + 64 * j]; ss += v[j].x * v[j].x + v[j].y * v[j].y + v[j].z * v[j].z + v[j].w * v[j].w; }
        ss = wave_sum(ss); const float rstd = rsqrtf(ss * (1.f / 2048.f) + 1e-6f);
#pragma unroll
        for (int j = 0; j < 8; ++j) { const float4 gg = *(const float4*)(g + (lane + 64 * j) * 4);
            xr[lane + 64 * j] = make_float4(v[j].x * rstd * gg.x, v[j].y * rstd * gg.y, v[j].z * rstd * gg.z, v[j].w * rstd * gg.w); }
    }
}


#define XB_TMO      128
#define XB_XCNT(j)  (256  + 64 * (j))
#define XB_XSUB(j)  (1280 + 64 * (j))
#define XB_XGEN(j)  (2304 + 64 * (j))
#define XB_TOP      3328
#define XB_TOPGEN   3392
#define XCD_BAR_WORDS 3456
#define XB_SPIN_CAP (1u << 18)
DEV unsigned xb_ld(unsigned* p)              { return __hip_atomic_load(p, __ATOMIC_RELAXED, __HIP_MEMORY_SCOPE_AGENT); }
DEV unsigned xb_add(unsigned* p, unsigned v) { return __hip_atomic_fetch_add(p, v, __ATOMIC_RELAXED, __HIP_MEMORY_SCOPE_AGENT); }
DEV unsigned xb_xcc_id() { return (unsigned)__builtin_amdgcn_s_getreg((3 << 11) | 20) & 0xFu; }
#define XB_SPIN(cond, bar) do { unsigned _sp = 0; while (cond) { __builtin_amdgcn_s_sleep(1); \
    if ((++_sp & 255u) == 0u) { if (xb_ld(&(bar)[XB_TMO])) break; if (_sp > XB_SPIN_CAP) { atomicAdd(&(bar)[XB_TMO], 1u); break; } } } } while (0)
struct XcdBarrier { unsigned* bar; unsigned x; volatile LAS unsigned* st; };
DEV XcdBarrier xcd_barrier_post(unsigned* bar, volatile LAS unsigned* st) {
    XcdBarrier b; b.bar = bar; b.x = xb_xcc_id(); b.st = st;
    if (threadIdx.x == 0) (void)xb_add(&bar[XB_XCNT(b.x)], 1u);
    return b;
}
DEV void xcd_barrier_complete(unsigned* bar, unsigned x, unsigned& nloc, unsigned& nx) {
    const unsigned G = gridDim.x * gridDim.y * gridDim.z;
    unsigned sum, cnt, mine, sp = 0u;
    for (;;) {
        sum = 0u; cnt = 0u; mine = 0u;
#pragma unroll
        for (unsigned j = 0; j < 16; ++j) { const unsigned c = xb_ld(&bar[XB_XCNT(j)]); sum += c; cnt += (c > 0u) ? 1u : 0u; mine = (j == x) ? c : mine; }
        if (sum == G) break;
        __builtin_amdgcn_s_sleep(1);
        if ((++sp & 255u) == 0u) { if (xb_ld(&bar[XB_TMO])) break; if (sp > XB_SPIN_CAP) { atomicAdd(&bar[XB_TMO], 1u); break; } }
    }
    nloc = mine > 0u ? mine : 1u; nx = cnt > 0u ? cnt : 1u;
}
DEV void xcd_barrier(const XcdBarrier& b) {
    asm volatile("s_waitcnt vmcnt(0)" ::: "memory");
    __syncthreads();
    if (threadIdx.x == 0) {
        unsigned* bar = b.bar;
        __builtin_amdgcn_s_waitcnt(0);
        unsigned nloc = b.st[0], nx = b.st[1];
        if (nloc == 0u) { xcd_barrier_complete(bar, b.x, nloc, nx); b.st[0] = nloc; b.st[1] = nx; }
        const unsigned old = xb_add(&bar[XB_XSUB(b.x)], 1u);
        const unsigned gen = old / nloc;
        if (old + 1u == (gen + 1u) * nloc) {
            __builtin_amdgcn_fence(__ATOMIC_RELEASE, "agent");
            asm volatile("s_waitcnt vmcnt(0)" ::: "memory");
            const unsigned og = xb_add(&bar[XB_TOP], 1u);
            const unsigned tg = og / nx;
            if (og + 1u == (tg + 1u) * nx) xb_add(&bar[XB_TOPGEN], 1u);
            else XB_SPIN(xb_ld(&bar[XB_TOPGEN]) == tg, bar);
            __builtin_amdgcn_fence(__ATOMIC_ACQUIRE, "agent");
            xb_add(&bar[XB_XGEN(b.x)], 1u);
            asm volatile("s_waitcnt vmcnt(0)" ::: "memory");
        } else {
            XB_SPIN(xb_ld(&bar[XB_XGEN(b.x)]) == gen, bar);
            __builtin_amdgcn_fence(__ATOMIC_ACQUIRE, "agent");
            asm volatile("s_waitcnt vmcnt(0)" ::: "memory");
        }
    }
    __syncthreads();
}

__global__ void __launch_bounds__(512, 2) mega(Params p0) {
    extern __shared__ __attribute__((aligned(16))) unsigned char shm[];
    cg::grid_group grid = cg::this_grid();
    __shared__ uint4 xb_words;
    if (threadIdx.x == 0) xb_words = make_uint4(0u, 0u, 0u, 0u);
    __syncthreads();
    (void)xcd_barrier_post((unsigned*)(p0.ws + OFF_SMALL + SMALL_BYTES + 256), (volatile LAS unsigned*)&xb_words);
#define XBAR() do { XcdBarrier xb_; xb_.bar = (unsigned*)(launder(p0).ws + OFF_SMALL + SMALL_BYTES + 256); xb_.x = xb_xcc_id(); xb_.st = (volatile LAS unsigned*)&xb_words; xcd_barrier(xb_); } while (0)
    float* sm = (float*)shm;
    const int G = (int)gridDim.x, B = (int)blockIdx.x;

#ifndef SK_PREP
    phase_prep(launder(p0), shm);
#ifdef PROBE_MISC
    __syncthreads(); phase_prep(launder(p0), shm);
#endif
#endif
    grid.sync();
    phase_reduce(launder(p0));
    XBAR();
#pragma unroll 1
    for (int layer = 0; layer < 2; ++layer) {
#ifndef SK_NORM
        phase_norm(launder(p0), layer, 0, shm);
#ifdef PROBE_MISC
        __syncthreads(); phase_norm(launder(p0), layer, 0, shm);
#endif
#endif
        XBAR();
        { const Params p = launder(p0); const u16* A = (const u16*)(p.ws + OFF_A); pg8::EpiBf16 E; E.O = (u16*)(p.ws + OFF_P); E.ldc = layer ? LDP1 : LDP0;
#if !defined(SK_GEMM) && !defined(SK_GBF)
            run_gemm(shm, A, DM, (const u16*)(p.ws + OFF_WIN), DM, layer ? LDP1 : LDP0, DM, E);
#ifdef PROBE_GEMM
            __syncthreads(); run_gemm(shm, A, DM, (const u16*)(p.ws + OFF_WIN), DM, layer ? LDP1 : LDP0, DM, E);
#endif
#endif
        }
        XBAR();
        if (layer == 0) {
#ifndef SK_PRE
            { const Params p = launder(p0); for (int t = B; t < 6144 + 768; t += G) { if (t < 6144) hy_pre_tile(p, t, sm); else rwkv_lora_tile(p, t - 6144, shm); } }
#ifdef PROBE_MISC
            { const Params p = launder(p0); for (int t = B; t < 6144 + 768; t += G) { if (t < 6144) hy_pre_tile(p, t, sm); else rwkv_lora_tile(p, t - 6144, shm); } }
#endif
#endif
            XBAR();
            { const Params p = launder(p0); unsigned* ctr = (unsigned*)(p.ws + OFF_SMALL + SMALL_BYTES);
                for (int t = B; t < 128; t += G) rwkv_scan_task(p, t, sm);
                for (;;) { if (tidx() == 0) *(volatile unsigned*)shm = atomicAdd(ctr, 1u); __syncthreads(); const unsigned t = *(volatile unsigned*)shm; __syncthreads();
                    if (t >= 1024u + 2048u) break;
                    if (t < 1024u) rwkv_scan_task(p, 128 + (int)t, sm); else hyconv_task(p, (int)t - 1024, shm); } }
            XBAR();
#ifndef SK_POST
            { const Params p = launder(p0); for (int t = B; t < 6144 + 768; t += G) { if (t < 6144) hy_post_tile(p, t, sm); else rwkv_post_tile(p, t - 6144, sm); } }
#ifdef PROBE_MISC
            { const Params p = launder(p0); for (int t = B; t < 6144 + 768; t += G) { if (t < 6144) hy_post_tile(p, t, sm); else rwkv_post_tile(p, t - 6144, sm); } }
#endif
#endif
            XBAR();
        } else {
#ifndef SK_GLA
            { const Params p = launder(p0); for (int t = B; t < 1536; t += G) gla_intra_task(p, t, shm); }
            XBAR();
            { const Params p = launder(p0); for (int t = B; t < 256 + 2048; t += G) gla_inter_task(p, t, shm); }
#endif
            XBAR();
#ifndef SK_GLAP
            phase_gla_post(launder(p0));
#ifdef PROBE_MISC
            phase_gla_post(launder(p0));
#endif
#endif
            XBAR();
        }
        { const Params p = launder(p0); const u16* A = (const u16*)(p.ws + OFF_A); const float* mods = (const float*)(p.ws + OFF_SMALL); pg8::EpiRes E; E.X = p.out; E.gm = mods + (size_t)layer * 5 * 12288 + 2 * 2048; E.gb = p.in[7] + layer * 12288 + 2 * 2048;
#if !defined(SK_GEMM) && !defined(SK_GRES)
            run_gemm(shm, A, DM, (const u16*)(p.ws + OFF_WOUT), DM, DM, DM, E);
#endif
        }
        XBAR();
#ifndef SK_NORM
        phase_norm(launder(p0), layer, 1, shm);
#ifdef PROBE_MISC
        __syncthreads(); phase_norm(launder(p0), layer, 1, shm);
#endif
#endif
        XBAR();
        { const Params p = launder(p0); const u16* A = (const u16*)(p.ws + OFF_A); pg8::EpiBf16 E; E.O = (u16*)(p.ws + OFF_U); E.ldc = LDU;
#if !defined(SK_GEMM) && !defined(SK_GBF)
            run_gemm(shm, A, DM, (const u16*)(p.ws + OFF_WUP), DM, LDU, DM, E);
#ifdef PROBE_GEMM
            __syncthreads(); run_gemm(shm, A, DM, (const u16*)(p.ws + OFF_WUP), DM, LDU, DM, E);
#endif
#endif
        }
        XBAR();
#ifndef SK_GATE
        phase_ffn_gate(launder(p0), layer);
#endif
        XBAR();
        { const Params p = launder(p0); const float* mods = (const float*)(p.ws + OFF_SMALL); pg8::EpiRes E; E.X = p.out; E.gm = mods + (size_t)layer * 5 * 12288 + 5 * 2048; E.gb = p.in[7] + layer * 12288 + 5 * 2048;
#if !defined(SK_GEMM) && !defined(SK_GRES)
            run_gemm(shm, (const u16*)(p.ws + OFF_U) + DFF, LDU, (const u16*)(p.ws + OFF_WDN), DFF, DM, DFF, E);
#endif
        }
        XBAR();
    }
    phase_final_norm(launder(p0));
}

extern "C" void kernel_launch(void* const* d_in, const int* in_sizes, int n_in, void* d_out, int out_size, void* d_ws, size_t ws_size, hipStream_t stream) {
    constexpr size_t kDynLds = 131072;
    static int grid_blocks = 0;
    if (!grid_blocks) {
        int dev = 0, cus = 0, per_cu = 0;
        hipGetDevice(&dev);
        hipDeviceGetAttribute(&cus, hipDeviceAttributeMultiprocessorCount, dev);
        hipFuncSetAttribute((const void*)mega, hipFuncAttributeMaxDynamicSharedMemorySize, (int)kDynLds);
        hipOccupancyMaxActiveBlocksPerMultiprocessor(&per_cu, mega, 512, kDynLds);
        if (per_cu < 1) per_cu = 1;
        grid_blocks = cus * per_cu;
        if (grid_blocks > 256) grid_blocks = 256;
    }
    if (ws_size < WS_NEED || n_in < 41) { fprintf(stderr, "workspace too small: %zu < %zu\n", ws_size, WS_NEED); return; }
    Params p{};
    for (int i = 0; i < 41; ++i) p.in[i] = (const float*)d_in[i];
    p.out = (float*)d_out; p.ws = (unsigned char*)d_ws;
    hipMemsetAsync((unsigned char*)d_ws + OFF_SMALL + SMALL_BYTES, 0, 256 + XCD_BAR_BYTES, stream);
    void* args[] = {&p};
    hipError_t e = hipLaunchCooperativeKernel((const void*)mega, dim3(grid_blocks), dim3(512), args, kDynLds, stream);
    if (e != hipSuccess) fprintf(stderr, "cooperative launch failed: %s (grid %d)\n", hipGetErrorString(e), grid_blocks);
}
```

```cpp
#include <hip/hip_runtime.h>
#include <hip/hip_cooperative_groups.h>
#include <cstdio>
namespace cg = cooperative_groups;

#define DEV __device__ __forceinline__
#define LAS __attribute__((address_space(3)))
typedef unsigned short u16;
typedef short bf16x8 __attribute__((ext_vector_type(8)));
typedef float f32x4 __attribute__((ext_vector_type(4)));
typedef float f32x2 __attribute__((ext_vector_type(2)));
typedef float f32x16 __attribute__((ext_vector_type(16)));
typedef unsigned u32x2 __attribute__((ext_vector_type(2)));
typedef unsigned u32x4 __attribute__((ext_vector_type(4)));

constexpr int NTOK = 24576, NTP = 8192, DM = 2048;
constexpr int LDP0 = 6656, LDP1 = 6400, LDU = 11264, DFF = 5632;
constexpr size_t OFF_WIN = 0, OFF_WOUT = 27262976, OFF_WUP = 35651584, OFF_WDN = OFF_WUP + 46137344;
constexpr size_t OFF_A = 104857600, OFF_BIG = 205520896;
constexpr size_t OFF_P = OFF_BIG, OFF_RW = OFF_BIG + 327155712, OFF_UT = OFF_RW + 201326592, OFF_GS = OFF_UT + 50331648, OFF_GP = OFF_GS + 16777216;
constexpr size_t OFF_U = OFF_BIG, OFF_OF = OFF_BIG + 314572800, OFF_OB = OFF_OF + 100663296, OFF_DB = OFF_OB + 100663296;
constexpr size_t OFF_SMALL = OFF_BIG + 600000000, SMALL_BYTES = 491520 + 8192;
constexpr size_t XCD_BAR_BYTES = 3456 * 4;
constexpr size_t OFF_LW = OFF_SMALL + SMALL_BYTES + 256 + XCD_BAR_BYTES;
constexpr size_t OFF_G2T = OFF_LW + 524288;
constexpr size_t WS_NEED = OFF_G2T + 262144;
constexpr size_t OUT_RWST = 50331648, OUT_GLAST = 54525952;

struct Params {
    const float* in[41];
    float* out;
    unsigned char* ws;
};

DEV int tidx() { int t = threadIdx.x; asm volatile("" : "+v"(t)); return t; }
DEV Params launder(const Params& p) { Params q = p; asm volatile("" : "+s"(q.ws), "+s"(q.out)); return q; }
DEV float bf2f(unsigned b) { return __uint_as_float(b << 16); }
DEV float bflo(unsigned w) { return __uint_as_float(w << 16); }
DEV float bfhi(unsigned w) { return __uint_as_float(w & 0xffff0000u); }
DEV unsigned pk(float lo, float hi) { unsigned r; asm("v_cvt_pk_bf16_f32 %0, %1, %2" : "=v"(r) : "v"(lo), "v"(hi)); return r; }
DEV u16 f2bf(float f) { return (u16)(pk(f, 0.f) & 0xffffu); }
DEV float wave_sum(float v) {
#pragma unroll
    for (int o = 32; o > 0; o >>= 1) v += __shfl_xor(v, o);
    return v;
}
template <int CTRL> DEV float dppf(float x) { return __builtin_bit_cast(float, __builtin_amdgcn_update_dpp(0, __builtin_bit_cast(int, x), CTRL, 0xf, 0xf, true)); }
DEV float sum8(float v) { v += dppf<0xB1>(v); v += dppf<0x4E>(v); v += dppf<0x141>(v); return v; }
DEV float sum16(float v) { v = sum8(v); v += dppf<0x140>(v); return v; }
DEV f32x4 mfma16(bf16x8 a, bf16x8 b, f32x4 c) { return __builtin_amdgcn_mfma_f32_16x16x32_bf16(a, b, c, 0, 0, 0); }
DEV float sigm(float x) { return __builtin_amdgcn_rcpf(1.f + __expf(-x)); }
DEV int tok_cond(int tok) { return tok < NTP ? 4 : ((tok - NTP) >> 12); }
DEV void tok_tl(int tok, int& t, int& L) { if (tok < NTP) { t = tok & 255; L = 256; } else { t = (tok - NTP) & 4095; L = 4096; } }
DEV void unpack8(u32x4 w, float* o) { o[0] = bflo(w.x); o[1] = bfhi(w.x); o[2] = bflo(w.y); o[3] = bfhi(w.y); o[4] = bflo(w.z); o[5] = bfhi(w.z); o[6] = bflo(w.w); o[7] = bfhi(w.w); }
DEV void unpack4(u32x2 w, float* o) { o[0] = bflo(w.x); o[1] = bfhi(w.x); o[2] = bflo(w.y); o[3] = bfhi(w.y); }

namespace pg8 {
constexpr int BM = 256, BK = 64, HALF = 128, HTB = HALF * BK * 2, NXCD = 8, WGM = 8;
DEV int lds_byte(int r, int c) { const int st = (r >> 4) * 2 + (c >> 5), rr = r & 15, cc = c & 31, ob = rr * 64 + cc * 2; return st * 1024 + (ob ^ (((ob >> 9) & 1) << 5)); }
DEV void stage_rc(int b, int& R, int& C) { const int st = b / 1024, sb = b % 1024, swz = sb ^ (((sb >> 9) & 1) << 5); R = (st >> 1) * 16 + swz / 64; C = (st & 1) * 32 + (swz % 64) / 2; }
DEV int perm32(int rho) { const int n = rho >> 4, i = rho & 15; return 8 * (i >> 2) + 4 * n + (i & 3); }
struct Unit { int pm, pn; };
struct Gemm { const u16* A; const u16* Bt; int M, N, K, lda, ldb; };
struct StaticOrder {
    int nM, nN, nwg, G, c;
    DEV void init(int M, int N, int G_, int c_) { nM = M / BM; nN = N / BM; nwg = nM * nN; G = G_; c = c_; }
    DEV bool next(int i, Unit& u) const {
        const long L = (long)i * G + c; if (L >= nwg) return false;
        int wgid = (int)L; { const int q = nwg / NXCD, r = nwg % NXCD, xcd = wgid % NXCD, off = wgid / NXCD; wgid = (xcd < r ? xcd * (q + 1) : r * (q + 1) + (xcd - r) * q) + off; }
        const int nig = WGM * nN, gid = wgid / nig, fm = gid * WGM, gsz = (nM - fm) < WGM ? (nM - fm) : WGM;
        u.pm = fm + ((wgid % nig) % gsz); u.pn = (wgid % nig) / gsz; return true;
    }
};
struct EpiBf16 {
    static constexpr bool PERM = true;
    u16* O; int ldc;
    DEV void operator()(const f32x4 (&acc)[2][2][4][2], const Unit& u, int wr, int wc, int fr, int fq) const {
        const int row0 = u.pm * BM + wr * 64 + fr; const int col0 = u.pn * BM + wc * 32 + 8 * fq;
#pragma unroll
        for (int ai = 0; ai < 2; ++ai)
#pragma unroll
            for (int m = 0; m < 4; ++m) { u16* rowp = O + (size_t)(row0 + ai * HALF + m * 16) * ldc + col0;
#pragma unroll
                for (int bj = 0; bj < 2; ++bj) { const f32x4 v0 = acc[ai][bj][m][0], v1 = acc[ai][bj][m][1];
                    u32x4 w; w.x = pk(v0[0], v0[1]); w.y = pk(v0[2], v0[3]); w.z = pk(v1[0], v1[1]); w.w = pk(v1[2], v1[3]);
                    *(u32x4*)(rowp + bj * HALF) = w; } }
    }
};
struct EpiRes {
    static constexpr bool PERM = false;
    float* X; const float* gm; const float* gb;
    DEV void operator()(const f32x4 (&acc)[2][2][4][2], const Unit& u, int wr, int wc, int fr, int fq) const {
        const int row0 = u.pm * BM + wr * 64 + fr, col0 = u.pn * BM + wc * 32 + 4 * fq;
        const int cond = u.pm < 32 ? 4 : ((u.pm - 32) >> 4);
        const float* gmc = gm + (size_t)cond * 12288 + col0; const float* gbc = gb + col0;
#pragma unroll
        for (int ai = 0; ai < 2; ++ai)
#pragma unroll
            for (int m = 0; m < 4; ++m) { float* rowp = X + (size_t)(row0 + ai * HALF + m * 16) * DM + col0;
#pragma unroll
                for (int bj = 0; bj < 2; ++bj) {
#pragma unroll
                    for (int n = 0; n < 2; ++n) { f32x4* q = (f32x4*)(rowp + bj * HALF + n * 16);
                        const f32x4 gvv = *(const f32x4*)(gmc + bj * HALF + n * 16) + *(const f32x4*)(gbc + bj * HALF + n * 16);
                        *q = *q + gvv * acc[ai][bj][m][n]; }
                    asm volatile("" ::: "memory"); } }
    }
};

template <class Epi>
DEV void gemm_phase(LAS unsigned char* lds, const Gemm g, const StaticOrder& S, const Epi& E) {
    const int tid = tidx(), wid = __builtin_amdgcn_readfirstlane(tid >> 6), lane = tid & 63, wr = wid >> 2, wc = wid & 3, fr = lane & 15, fq = lane >> 4;
    const int K = g.K, nt = K / BK;
    unsigned voffA[2], voffB[2];
#pragma unroll
    for (int i = 0; i < 2; ++i) { int R, C; stage_rc(tid * 16 + i * 8192, R, C); const int Rb = Epi::PERM ? ((R & ~31) + perm32(R & 31)) : R;
        voffA[i] = (unsigned)(R * g.lda + C) * 2u; voffB[i] = (unsigned)(Rb * g.ldb + C) * 2u; }
    const size_t kstep = (size_t)(BK * 2);
    const size_t hstepA = (size_t)HALF * g.lda * 2, hstepB = (size_t)HALF * g.ldb * 2;
    const size_t tstepA = 2 * hstepA, tstepB = 2 * hstepB;
    const unsigned ldsw = (unsigned)wid * 1024u;
    const int aoff = lds_byte(wr * 64 + fr, fq * 8), boff = lds_byte(wc * 32 + fr, fq * 8);
#define PG8_SA(b, h) (((b) * 2 + (h)) * HTB)
#define PG8_SB(b, h) ((4 + (b) * 2 + (h)) * HTB)
#define PG8_STAGE(bufoff, gbase, voff) do { _Pragma("unroll") for (int _i = 0; _i < 2; ++_i) \
        __builtin_amdgcn_global_load_lds((const unsigned*)((const char*)(gbase) + (voff)[_i]), (LAS unsigned*)(lds + (bufoff) + ldsw + _i * 8192), 16, 0, 0); } while (0)
#define PG8_LDA(dst, b, h) do { _Pragma("unroll") for (int m = 0; m < 4; ++m) _Pragma("unroll") for (int k = 0; k < 2; ++k) dst[m][k] = *(const LAS bf16x8*)(lds + PG8_SA(b, h) + aoff + m * 2048 + k * 1024); } while (0)
#define PG8_LDB(dst, b, h) do { _Pragma("unroll") for (int n = 0; n < 2; ++n) _Pragma("unroll") for (int k = 0; k < 2; ++k) dst[n][k] = *(const LAS bf16x8*)(lds + PG8_SB(b, h) + boff + n * 2048 + k * 1024); } while (0)
#define PG8_MMA(ai, bj, At, Bt) do { __builtin_amdgcn_s_setprio(1); _Pragma("unroll") for (int m = 0; m < 4; ++m) _Pragma("unroll") for (int n = 0; n < 2; ++n) _Pragma("unroll") for (int k = 0; k < 2; ++k) \
        acc[ai][bj][m][n] = __builtin_amdgcn_mfma_f32_16x16x32_bf16(Bt[n][k], At[m][k], acc[ai][bj][m][n], 0, 0, 0); __builtin_amdgcn_s_setprio(0); } while (0)
#define PG8_WAIT_V(n) asm volatile("s_waitcnt vmcnt(" #n ")" ::: "memory")
#define PG8_WAIT_L(n) asm volatile("s_waitcnt lgkmcnt(" #n ")" ::: "memory")
#define PG8_BAR __builtin_amdgcn_s_barrier()
#define PG8_SCHED __builtin_amdgcn_sched_barrier(0)
    Unit cur, nxt; int ui = 0;
    if (!S.next(0, cur)) return;
    f32x4 acc[2][2][4][2];
#pragma unroll
    for (int a = 0; a < 2; ++a)
#pragma unroll
        for (int b = 0; b < 2; ++b)
#pragma unroll
            for (int m = 0; m < 4; ++m)
#pragma unroll
                for (int n = 0; n < 2; ++n) acc[a][b][m][n] = (f32x4){0.f, 0.f, 0.f, 0.f};
    bf16x8 At[4][2], B0[2][2], B1[2][2];
    const char* cA = (const char*)g.A + (size_t)cur.pm * tstepA; const char* cB = (const char*)g.Bt + (size_t)cur.pn * tstepB;
    PG8_STAGE(PG8_SB(0, 0), cB, voffB); PG8_STAGE(PG8_SA(0, 0), cA, voffA); PG8_STAGE(PG8_SB(0, 1), cB + hstepB, voffB); PG8_STAGE(PG8_SA(0, 1), cA + hstepA, voffA);
    if (wr == 1) PG8_BAR;
    PG8_WAIT_V(4); PG8_BAR;
    PG8_STAGE(PG8_SB(1, 0), cB + kstep, voffB); PG8_STAGE(PG8_SA(1, 0), cA + kstep, voffA); PG8_STAGE(PG8_SB(1, 1), cB + hstepB + kstep, voffB);
    PG8_WAIT_V(6); PG8_BAR;
    for (;;) {
        const bool has_next = S.next(ui + 1, nxt);
        const char* nA = has_next ? (const char*)g.A + (size_t)nxt.pm * tstepA : cA; const char* nB = has_next ? (const char*)g.Bt + (size_t)nxt.pn * tstepB : cB;
        for (int t = 0; t < nt; t += 2) {
            const bool last = (t == nt - 2);
            const char* a1 = cA + (size_t)(t + 1) * kstep;
            const char* a2 = last ? nA : cA + (size_t)(t + 2) * kstep; const char* b2 = last ? nB : cB + (size_t)(t + 2) * kstep;
            const char* a3 = a2 + kstep; const char* b3 = b2 + kstep;
            PG8_LDB(B0, 0, 0); PG8_SCHED; PG8_LDA(At, 0, 0); PG8_STAGE(PG8_SA(1, 1), a1 + hstepA, voffA);
            PG8_WAIT_L(8); PG8_BAR; PG8_WAIT_L(0); PG8_MMA(0, 0, At, B0); PG8_BAR; PG8_SCHED;
            PG8_LDB(B1, 0, 1); PG8_STAGE(PG8_SB(0, 0), b2, voffB);
            PG8_BAR; PG8_WAIT_L(0); PG8_MMA(0, 1, At, B1); PG8_BAR;
            PG8_LDA(At, 0, 1); PG8_STAGE(PG8_SA(0, 0), a2, voffA);
            PG8_BAR; PG8_WAIT_L(0); PG8_MMA(1, 0, At, B0); PG8_BAR; PG8_SCHED;
            PG8_STAGE(PG8_SB(0, 1), b2 + hstepB, voffB);
            PG8_WAIT_V(6); PG8_BAR; PG8_MMA(1, 1, At, B1); PG8_BAR;
            PG8_LDB(B0, 1, 0); PG8_SCHED; PG8_LDA(At, 1, 0); PG8_STAGE(PG8_SA(0, 1), a2 + hstepA, voffA);
            PG8_WAIT_L(8); PG8_BAR; PG8_WAIT_L(0); PG8_MMA(0, 0, At, B0); PG8_BAR; PG8_SCHED;
            PG8_LDB(B1, 1, 1); PG8_STAGE(PG8_SB(1, 0), b3, voffB);
            PG8_BAR; PG8_WAIT_L(0); PG8_MMA(0, 1, At, B1); PG8_BAR;
            PG8_LDA(At, 1, 1); PG8_STAGE(PG8_SA(1, 0), a3, voffA);
            PG8_BAR; PG8_WAIT_L(0); PG8_MMA(1, 0, At, B0); PG8_BAR; PG8_SCHED;
            PG8_STAGE(PG8_SB(1, 1), b3 + hstepB, voffB);
            PG8_WAIT_V(6); PG8_BAR; PG8_MMA(1, 1, At, B1); PG8_BAR;
        }
        E(acc, cur, wr, wc, fr, fq);
        if (!has_next) break;
#pragma unroll
        for (int a = 0; a < 2; ++a)
#pragma unroll
            for (int b = 0; b < 2; ++b)
#pragma unroll
                for (int m = 0; m < 4; ++m)
#pragma unroll
                    for (int n = 0; n < 2; ++n) acc[a][b][m][n] = (f32x4){0.f, 0.f, 0.f, 0.f};
        cur = nxt; cA = nA; cB = nB; ++ui;
    }
    PG8_WAIT_V(0);
    if (wr == 0) PG8_BAR;
    PG8_BAR;
#undef PG8_SA
#undef PG8_SB
#undef PG8_STAGE
#undef PG8_LDA
#undef PG8_LDB
#undef PG8_MMA
#undef PG8_WAIT_V
#undef PG8_WAIT_L
#undef PG8_BAR
#undef PG8_SCHED
}
}

template <class Epi>
DEV void run_gemm(unsigned char* shm, const u16* A, int lda, const u16* Bt, int ldb, int N, int K, const Epi& E) {
    asm volatile("" : "+s"(A), "+s"(Bt));
    pg8::Gemm g; g.A = A; g.Bt = Bt; g.M = NTOK; g.N = N; g.K = K; g.lda = lda; g.ldb = ldb;
    pg8::StaticOrder S; S.init(NTOK, N, (int)gridDim.x, (int)blockIdx.x);
    pg8::gemm_phase<Epi>((LAS unsigned char*)shm, g, S, E);
}

DEV void convT_tile(const float* __restrict__ src, u16* __restrict__ dst, int K, int N, int Npad, int tile, float* T) {
    const int tid = tidx(); const int ntn = Npad >> 6; const int k0 = (tile / ntn) << 6, n0 = (tile % ntn) << 6;
#pragma unroll
    for (int j = 0; j < 2; ++j) { const int idx = tid + j * 512; const int r = idx >> 4, c4 = (idx & 15) << 2;
        float4 v = make_float4(0.f, 0.f, 0.f, 0.f); if (n0 + c4 < N) v = *(const float4*)(src + (size_t)(k0 + r) * N + n0 + c4);
        float* t = T + r * 65 + c4; t[0] = v.x; t[1] = v.y; t[2] = v.z; t[3] = v.w; }
    __syncthreads();
    { const int nn = tid >> 3, kq = (tid & 7) << 3; const float* t = T + kq * 65 + nn;
        u32x4 o; o.x = pk(t[0], t[65]); o.y = pk(t[130], t[195]); o.z = pk(t[260], t[325]); o.w = pk(t[390], t[455]);
        *(u32x4*)(dst + (size_t)(n0 + nn) * K + k0 + kq) = o; }
    __syncthreads();
}
DEV int conv_ntiles(int job, int layer) { return job == 0 ? (layer ? 3200 : 3328) : job == 1 ? 1024 : job == 2 ? 5632 : 2816; }
DEV void conv_job(const Params& p, int job, int layer, int tile, float* T) {
    if (job == 0) convT_tile(layer ? p.in[36] : p.in[14], (u16*)(p.ws + OFF_WIN), 2048, layer ? 6176 : 6528, layer ? LDP1 : LDP0, tile, T);
    else if (job == 1) convT_tile(layer ? p.in[37] : p.in[15], (u16*)(p.ws + OFF_WOUT), 2048, 2048, 2048, tile, T);
    else if (job == 2) convT_tile(p.in[10] + (size_t)layer * 2048 * 11264, (u16*)(p.ws + OFF_WUP), 2048, 11264, 11264, tile, T);
    else convT_tile(p.in[12] + (size_t)layer * 5632 * 2048, (u16*)(p.ws + OFF_WDN), 5632, 2048, 2048, tile, T);
}

DEV void adaln_tile(const Params& p, int tile, float* sl) {
    const int tid = tidx(); const int nt = tile % 6, kc = (tile / 6) & 31, layer = tile / 192;
    if (tid < 320) { const int j = tid >> 6, kk = tid & 63; const float cv = (j < 4) ? p.in[4][j * 2048 + kc * 64 + kk] : p.in[5][kc * 64 + kk]; sl[tid] = cv / (1.f + expf(-cv)); }
    __syncthreads();
    const float* w = p.in[6] + ((size_t)layer * 2048 + kc * 64) * 12288 + nt * 2048 + tid * 4;
    float acc[5][4];
#pragma unroll
    for (int j = 0; j < 5; ++j) { acc[j][0] = 0.f; acc[j][1] = 0.f; acc[j][2] = 0.f; acc[j][3] = 0.f; }
#pragma unroll 8
    for (int kk = 0; kk < 64; ++kk) { const float4 wv = *(const float4*)(w + (size_t)kk * 12288);
#pragma unroll
        for (int j = 0; j < 5; ++j) { const float s = sl[j * 64 + kk]; acc[j][0] += s * wv.x; acc[j][1] += s * wv.y; acc[j][2] += s * wv.z; acc[j][3] += s * wv.w; } }
    float* m = (float*)(p.ws + OFF_A) + (size_t)kc * 122880 + (size_t)layer * 5 * 12288 + nt * 2048 + tid * 4;
#pragma unroll
    for (int j = 0; j < 5; ++j) *(float4*)(m + j * 12288) = make_float4(acc[j][0], acc[j][1], acc[j][2], acc[j][3]);
    __syncthreads();
}

DEV void hyfilt_tile(const Params& p, int tile, float* sm) {
    const int tid = tidx();
    int L, p0; u16* G; float* nrm = (float*)(p.ws + OFF_A) + 32 * 122880 + (size_t)tile * 2048;
    if (tile < 128) { L = 4096; p0 = tile * 32; G = (u16*)(p.ws + OFF_GS); }
    else { L = 256; p0 = (tile - 128) * 32; G = (u16*)(p.ws + OFF_GP); }
    float* z = sm; float* h1 = sm + 32 * 33; float* h2 = h1 + 2048;
    const float cang = (float)(6.283185307179586 / (double)L);
    for (int i = tid; i < 32 * 33; i += 512) { const int pp = i / 33, e = i % 33; const float pos = (float)(p0 + pp); float val;
        if (e == 0) val = pos / (float)(L - 1);
        else { const int bi = (e - 1) & 15; const float fb = 1e-4f + (float)bi * ((15.f - 1e-4f) / 15.f); const float ang = (cang * pos) * fb; val = (e <= 16) ? cosf(ang) : -sinf(ang); }
        z[i] = val; }
    __syncthreads();
    for (int i = tid; i < 2048; i += 512) { const int pp = i >> 6, j = i & 63; float a = p.in[19][j];
        for (int e = 0; e < 33; ++e) a += z[pp * 33 + e] * p.in[18][e * 64 + j];
        h1[i] = sinf(p.in[23][j] * a); }
    __syncthreads();
    for (int i = tid; i < 2048; i += 512) { const int pp = i >> 6, j = i & 63; float a = p.in[21][j];
        for (int e = 0; e < 64; ++e) a += h1[pp * 64 + e] * p.in[20][e * 64 + j];
        h2[i] = sinf(p.in[23][64 + j] * a); }
    __syncthreads();
    const float dlo = 3.0701134573253946f, dhi = 15.350567286626973f;
    for (int q = 0; q < 4; ++q) { const int n = tid + 512 * q; const int c = n & 1023; const int back = n >> 10;
        float wcol[64];
#pragma unroll
        for (int e = 0; e < 64; ++e) wcol[e] = p.in[22][e * 2048 + n];
        const float delta = dlo + (dhi - dlo) * ((float)c / 1023.f);
        float asum = 0.f;
        for (int pp = 0; pp < 32; ++pp) { float a = 0.f;
#pragma unroll
            for (int e = 0; e < 64; ++e) a += h2[pp * 64 + e] * wcol[e];
            const int pos = p0 + pp; const float t = (float)pos / (float)(L - 1); a *= expf(-t * delta);
            if (!(back && pos == 0)) { asum += fabsf(a); const int lag = back ? -pos : pos; G[(size_t)c * (2 * L) + (L - lag)] = f2bf(a); } }
        nrm[n] = asum; }
    if (p0 == 0) for (int c = tid; c < 1024; c += 512) G[(size_t)c * (2 * L)] = 0;
    __syncthreads();
}

DEV void phase_prep(const Params& p, unsigned char* shm) {
    const int tid = tidx(); float* sm = (float*)shm;
    if (blockIdx.x == 0 && tid == 0) *(unsigned*)(p.ws + OFF_SMALL + SMALL_BYTES) = 0u;
    { u16* LW = (u16*)(p.ws + OFF_LW); u16* G2T = (u16*)(p.ws + OFF_G2T);
        for (int i = blockIdx.x * 512 + tid; i < 4 * 1024 * 64 + 1024 * 128; i += gridDim.x * 512) {
            if (i < 262144) { const int mi = i >> 16, n = (i >> 6) & 1023, r = i & 63; LW[i] = f2bf((mi < 2 ? p.in[27] : p.in[29])[((size_t)(mi & 1) * 64 + r) * 1024 + n]); }
            else { const int j = i - 262144; const int n = j >> 7, r = j & 127; G2T[j] = f2bf(p.in[30][(size_t)r * 1024 + n]); } } }
    const int n0 = 136, n1 = n0 + 384, n2 = n1 + 3328, n3 = n2 + 1024, n4 = n3 + 5632, n5 = n4 + 2816;
    for (int t = blockIdx.x; t < n5; t += gridDim.x) {
        if (t < n0) hyfilt_tile(p, t, sm);
        else if (t < n1) adaln_tile(p, t - n0, sm);
        else if (t < n2) conv_job(p, 0, 0, t - n1, sm);
        else if (t < n3) conv_job(p, 1, 0, t - n2, sm);
        else if (t < n4) conv_job(p, 2, 0, t - n3, sm);
        else conv_job(p, 3, 0, t - n4, sm);
    }
}

DEV void phase_reduce(const Params& p) {
    const float* part = (const float*)(p.ws + OFF_A); float* mods = (float*)(p.ws + OFF_SMALL); float* hn = (float*)(p.ws + OFF_SMALL + 491520);
    for (int i = blockIdx.x * 512 + tidx(); i < 122880 + 2048; i += gridDim.x * 512) {
        if (i < 122880) { float a = 0.f; for (int kc = 0; kc < 32; ++kc) a += part[(size_t)kc * 122880 + i]; mods[i] = a; }
        else { const int j = i - 122880; const int c = j & 1023; const float* hp = part + 32 * 122880; float a = 0.f;
            if (j < 1024) { for (int t = 0; t < 128; ++t) a += hp[(size_t)t * 2048 + c] + hp[(size_t)t * 2048 + 1024 + c]; }
            else { for (int t = 128; t < 136; ++t) a += hp[(size_t)t * 2048 + c] + hp[(size_t)t * 2048 + 1024 + c]; }
            hn[j] = a; }
    }
}

DEV void phase_norm(const Params& p, int layer, int which, unsigned char* shm) {
    const int tid = tidx(), wid = tid >> 6, lane = tid & 63;
    const float* g = p.in[which ? 9 : 8] + layer * 2048;
    const float* X = p.out; u16* A = (u16*)(p.ws + OFF_A);
    const float* mods = (const float*)(p.ws + OFF_SMALL) + (size_t)layer * 5 * 12288; const float* bb = p.in[7] + layer * 12288;
    const int shi = which ? 3 : 0;
    const int nw = gridDim.x * 8, wv = blockIdx.x * 8 + wid; const int per = (NTOK + nw - 1) / nw; const int r0 = wv * per, r1 = (r0 + per < NTOK) ? r0 + per : NTOK;
    const bool first = (layer == 0 && which == 0);
    int cur = -1; float4 Am[8], Bm[8];
    for (int row = r0; row < r1; ++row) {
        const int cond = tok_cond(row);
        if (cond != cur) { cur = cond; const float* md = mods + (size_t)cond * 12288;
#pragma unroll
            for (int j = 0; j < 8; ++j) { const int col = (lane + 64 * j) * 4;
                const float4 gg = *(const float4*)(g + col);
                const float4 s1 = *(const float4*)(md + shi * 2048 + col), s2 = *(const float4*)(bb + shi * 2048 + col);
                const float4 c1 = *(const float4*)(md + (shi + 1) * 2048 + col), c2 = *(const float4*)(bb + (shi + 1) * 2048 + col);
                Am[j] = make_float4(gg.x * (1.f + c1.x + c2.x), gg.y * (1.f + c1.y + c2.y), gg.z * (1.f + c1.z + c2.z), gg.w * (1.f + c1.w + c2.w));
                Bm[j] = make_float4(s1.x + s2.x, s1.y + s2.y, s1.z + s2.z, s1.w + s2.w); } }
        const float* xsrc = X + (size_t)row * DM; if (first) xsrc = row < NTP ? p.in[0] + (size_t)row * DM : p.in[1] + (size_t)(row - NTP) * DM;
        const float4* xr = (const float4*)xsrc;
        float4 v[8]; float ss = 0.f;
#pragma unroll
        for (int j = 0; j < 8; ++j) { v[j] = xr[lane + 64 * j]; ss += v[j].x * v[j].x + v[j].y * v[j].y + v[j].z * v[j].z + v[j].w * v[j].w; }
        if (first) {
#pragma unroll
            for (int j = 0; j < 8; ++j) ((float4*)(p.out + (size_t)row * DM))[lane + 64 * j] = v[j]; }
        ss = wave_sum(ss);
        const float rstd = rsqrtf(ss * (1.f / 2048.f) + 1e-6f);
#pragma unroll
        for (int j = 0; j < 8; ++j) { const int col = (lane + 64 * j) * 4;
            u32x2 o; o.x = pk(v[j].x * rstd * Am[j].x + Bm[j].x, v[j].y * rstd * Am[j].y + Bm[j].y); o.y = pk(v[j].z * rstd * Am[j].z + Bm[j].z, v[j].w * rstd * Am[j].w + Bm[j].w);
            *(u32x2*)(A + (size_t)row * DM + col) = o; }
    }
    if (layer == 0 && which == 1) { const int na = conv_ntiles(0, 1), nb = na + conv_ntiles(1, 1);
        for (int t = blockIdx.x; t < nb; t += gridDim.x) { if (t < na) conv_job(p, 0, 1, t, (float*)shm); else conv_job(p, 1, 1, t - na, (float*)shm); } }
    if (layer == 1 && which == 0) { const int na = conv_ntiles(2, 1), nb = na + conv_ntiles(3, 1);
        for (int t = blockIdx.x; t < nb; t += gridDim.x) { if (t < na) conv_job(p, 2, 1, t, (float*)shm); else conv_job(p, 3, 1, t - na, (float*)shm); } }
}

DEV void sconv8(const u16* prow, bool hm, bool hp, const float* sw, const float* sb, int ch, float* o) {
    float c[8], m[8], q[8];
    unpack8(*(const u32x4*)(prow + ch), c);
    if (hm) unpack8(*(const u32x4*)(prow - LDP0 + ch), m); else { for (int i = 0; i < 8; ++i) m[i] = 0.f; }
    if (hp) unpack8(*(const u32x4*)(prow + LDP0 + ch), q); else { for (int i = 0; i < 8; ++i) q[i] = 0.f; }
#pragma unroll
    for (int i = 0; i < 8; ++i) o[i] = m[i] * sw[ch + i] + c[i] * sw[3072 + ch + i] + q[i] * sw[6144 + ch + i] + sb[ch + i];
}
DEV void hy_pre_tile(const Params& p, int tile, float* T) {
    const int tid = tidx(); const int tok0 = (tile >> 4) << 6, c0 = (tile & 15) << 6;
    const u16* P = (const u16*)(p.ws + OFF_P); u16* uT = (u16*)(p.ws + OFF_UT);
    { const int tk = tid >> 3, c8 = (tid & 7) << 3; const int tok = tok0 + tk; int t, L; tok_tl(tok, t, L);
        const u16* prow = P + (size_t)tok * LDP0; float x1[8], vv[8];
        sconv8(prow, t > 0, t < L - 1, p.in[16], p.in[17], 1024 + c0 + c8, x1);
        sconv8(prow, t > 0, t < L - 1, p.in[16], p.in[17], 2048 + c0 + c8, vv);
#pragma unroll
        for (int i = 0; i < 8; ++i) T[tk * 65 + c8 + i] = x1[i] * vv[i]; }
    __syncthreads();
    { const int ch = tid >> 3, t8 = (tid & 7) << 3; const float* t = T + t8 * 65 + ch;
        u32x4 o; o.x = pk(t[0], t[65]); o.y = pk(t[130], t[195]); o.z = pk(t[260], t[325]); o.w = pk(t[390], t[455]);
        *(u32x4*)(uT + (size_t)(c0 + ch) * NTOK + tok0 + t8) = o; }
    __syncthreads();
}
DEV void hy_post_tile(const Params& p, int tile, float* T) {
    const int tid = tidx(); const int tok0 = (tile >> 4) << 6, c0 = (tile & 15) << 6;
    const u16* P = (const u16*)(p.ws + OFF_P); const u16* uT = (const u16*)(p.ws + OFF_UT); u16* ycat = (u16*)(p.ws + OFF_A);
    { const int ch = tid >> 3, t8 = (tid & 7) << 3; float y[8]; unpack8(*(const u32x4*)(uT + (size_t)(c0 + ch) * NTOK + tok0 + t8), y);
#pragma unroll
        for (int i = 0; i < 8; ++i) T[(t8 + i) * 65 + ch] = y[i]; }
    __syncthreads();
    { const int tk = tid >> 3, c8 = (tid & 7) << 3; const int tok = tok0 + tk; int t, L; tok_tl(tok, t, L);
        const u16* prow = P + (size_t)tok * LDP0; float x0[8], x1[8], vv[8], o[8];
        sconv8(prow, t > 0, t < L - 1, p.in[16], p.in[17], c0 + c8, x0);
        sconv8(prow, t > 0, t < L - 1, p.in[16], p.in[17], 1024 + c0 + c8, x1);
        sconv8(prow, t > 0, t < L - 1, p.in[16], p.in[17], 2048 + c0 + c8, vv);
        const float* nrm = (const float*)(p.ws + OFF_SMALL + 491520) + (tok < NTP ? 1024 : 0);
#pragma unroll
        for (int i = 0; i < 8; ++i) { const int c = c0 + c8 + i; o[i] = x0[i] * (T[tk * 65 + c8 + i] * __builtin_amdgcn_rcpf(nrm[c]) + x1[i] * vv[i] * p.in[24][c]); }
        u32x4 w; w.x = pk(o[0], o[1]); w.y = pk(o[2], o[3]); w.z = pk(o[4], o[5]); w.w = pk(o[6], o[7]);
        *(u32x4*)(ycat + (size_t)tok * DM + c0 + c8) = w; }
    __syncthreads();
}
DEV void hyconv_task(const Params& p, int task, unsigned char* shm) {
    const int tid = tidx(), wid = tid >> 6, lane = tid & 63;
    const bool sample = task < 1024; const int c = sample ? task : task - 1024;
    const int L = sample ? 4096 : 256, NB = sample ? 4 : 32, lgNB = sample ? 2 : 5, LP = L + 8;
    u16* uL = (u16*)shm; u16* gL = uL + NB * LP; u16* gS = gL + 2 * L;
    const u16* G = sample ? (const u16*)(p.ws + OFF_GS) + (size_t)c * 8192 : (const u16*)(p.ws + OFF_GP) + (size_t)c * 512;
    u16* uT = (u16*)(p.ws + OFF_UT) + (size_t)c * NTOK + (sample ? NTP : 0);
    for (int i = tid * 8; i < NB * L; i += 4096) { const int b = i / L, s = i % L; *(u32x4*)(uL + b * LP + s) = *(const u32x4*)(uT + i); }
    for (int i = tid * 8; i < 2 * L; i += 4096) { const u32x4 w = *(const u32x4*)(G + i); *(u32x4*)(gL + i) = w;
        const unsigned nx = (i + 8 < 2 * L) ? (unsigned)G[i + 8] : 0u;
        u32x4 sft; sft.x = (w.x >> 16) | (w.y << 16); sft.y = (w.y >> 16) | (w.z << 16); sft.z = (w.z >> 16) | (w.w << 16); sft.w = (w.w >> 16) | (nx << 16);
        *(u32x4*)(gS + i) = sft; }
    __syncthreads();
    const int ntile = (NB * (L >> 5)) >> 5;
    const int npair = sample ? 8 : 8; const bool two = sample;
    const int r = lane & 31, half = lane >> 5;
    {
        const int ct0 = two ? 2 * wid : wid;
        const int colA = ct0 * 32 + r, colB = colA + 32;
        const int bA = colA & (NB - 1), iA = colA >> lgNB, bB = colB & (NB - 1), iB = colB >> lgNB; const int tA = iA * 32, tB = iB * 32;
        const int i_lo = (ct0 * 32) >> lgNB, i_hi = ((two ? ct0 + 1 : ct0) * 32 + 31) >> lgNB;
        const int d_lo = 32 * i_lo - (L - 16), d_hi = 32 * i_hi;
        f32x16 accA, accB;
#pragma unroll
        for (int j = 0; j < 16; ++j) { accA[j] = 0.f; accB[j] = 0.f; }
        const u16* ubA = uL + bA * LP + 8 * half; const u16* ubB = uL + bB * LP + 8 * half;
        const u16* gsel = (r & 1) ? gS : gL;
        const int qb = (L - r + 8 * half) & ~1;
#pragma unroll 4
        for (int dl = d_lo; dl <= d_hi; dl += 16) {
            const unsigned* gq = (const unsigned*)(gsel + (qb - dl));
            u32x4 aw; aw.x = gq[0]; aw.y = gq[1]; aw.z = gq[2]; aw.w = gq[3];
            const bf16x8 a = __builtin_bit_cast(bf16x8, aw);
            const int sA = tA - dl, sB = tB - dl;
            bf16x8 bvA = (bf16x8){0, 0, 0, 0, 0, 0, 0, 0}, bvB = bvA;
            if (sA >= 0 && sA <= L - 16) bvA = *(const bf16x8*)(ubA + sA);
            accA = __builtin_amdgcn_mfma_f32_32x32x16_bf16(a, bvA, accA, 0, 0, 0);
            if (two) { if (sB >= 0 && sB <= L - 16) bvB = *(const bf16x8*)(ubB + sB);
                accB = __builtin_amdgcn_mfma_f32_32x32x16_bf16(a, bvB, accB, 0, 0, 0); }
        }
#pragma unroll
        for (int g = 0; g < 4; ++g) { u32x2 w; w.x = pk(accA[4 * g], accA[4 * g + 1]); w.y = pk(accA[4 * g + 2], accA[4 * g + 3]);
            *(u32x2*)(uT + (size_t)bA * L + tA + 8 * g + 4 * half) = w; }
        if (two) {
#pragma unroll
            for (int g = 0; g < 4; ++g) { u32x2 w; w.x = pk(accB[4 * g], accB[4 * g + 1]); w.y = pk(accB[4 * g + 2], accB[4 * g + 3]);
                *(u32x2*)(uT + (size_t)bB * L + tB + 8 * g + 4 * half) = w; } }
    }
    (void)ntile; (void)npair;
    __syncthreads();
}

DEV void rwkv_lora_tile(const Params& p, int tile, unsigned char* shm) {
    const int tid = tidx(), wid = tid >> 6, lane = tid & 63, l15 = lane & 15, quad = lane >> 4; const int tok0 = tile * 32;
    const u16* P = (const u16*)(p.ws + OFF_P); u16* RW = (u16*)(p.ws + OFF_RW); const u16* LW = (const u16*)(p.ws + OFF_LW);
    u16* Ain = (u16*)shm;
    u16* Ol = (u16*)(shm + 18432);
    for (int i = tid; i < 32 * 256; i += 512) { const int tk = i >> 8, cc = i & 255; const int tok = tok0 + tk; int t, L; tok_tl(tok, t, L);
        const u16* pp = P + (size_t)tok * LDP0 + 6144 + cc; float x = bf2f(*pp); const float xm = t > 0 ? bf2f(pp[-LDP0]) : 0.f; const float xp = t < L - 1 ? bf2f(pp[LDP0]) : 0.f;
        const float mu = p.in[25][3072 + cc]; x = x + mu * (0.5f * (xm + xp) - x); if (cc < 128) x = tanhf(x);
        Ain[((cc >> 6) * 32 + tk) * 72 + (cc & 63)] = f2bf(x); }
    __syncthreads();
#pragma unroll 1
    for (int mi = 0; mi < 4; ++mi) {
        const float* bias = (mi < 2 ? p.in[26] : p.in[28]) + (mi & 1) * 1024;
        const float osc = mi < 2 ? 0.6065306597f : 1.f;
        bf16x8 af[2][2];
#pragma unroll
        for (int tt = 0; tt < 2; ++tt)
#pragma unroll
            for (int ks = 0; ks < 2; ++ks) af[tt][ks] = *(const bf16x8*)(Ain + (mi * 32 + tt * 16 + l15) * 72 + ks * 32 + quad * 8);
#pragma unroll 2
        for (int q = 0; q < 8; ++q) { const int nt = wid * 8 + q; const int n = nt * 16 + l15;
            const bf16x8 b0 = *(const bf16x8*)(LW + ((size_t)mi * 1024 + n) * 64 + quad * 8), b1 = *(const bf16x8*)(LW + ((size_t)mi * 1024 + n) * 64 + 32 + quad * 8);
            const float bs = bias[n];
#pragma unroll
            for (int tt = 0; tt < 2; ++tt) { f32x4 acc = (f32x4){0.f, 0.f, 0.f, 0.f}; acc = mfma16(af[tt][0], b0, acc); acc = mfma16(af[tt][1], b1, acc);
#pragma unroll
                for (int r = 0; r < 4; ++r) Ol[(tt * 16 + quad * 4 + r) * 1032 + n] = f2bf(osc * sigm(acc[r] + bs)); } }
        __syncthreads();
#pragma unroll
        for (int i = 0; i < 8; ++i) { const int piece = tid + 512 * i; const int tk = piece >> 7, c8 = (piece & 127) * 8;
            *(u32x4*)(RW + (size_t)(tok0 + tk) * 4096 + mi * 1024 + c8) = *(const u32x4*)(Ol + tk * 1032 + c8); }
        __syncthreads();
    }
}
DEV float mixf(float c, float m, float q, float mu) { return c + mu * (0.5f * (m + q) - c); }
DEV void rwkv_scan_task(const Params& p, int task, float* sm) {
    const bool sample = task < 128; const int tt_ = sample ? task : task - 128;
    const int b = tt_ >> 5, h = (tt_ >> 1) & 15, dir = tt_ & 1;
    const int L = sample ? 4096 : 256; const int tok0 = sample ? NTP + b * 4096 : b * 256;
    const int tid = tidx(), wid = tid >> 6, lane = tid & 63;
    const int kl = lane & 7;
    const int row2 = (wid & 3) * 16 + (lane >> 3) * 2;
    float S[8], T[8];
    const size_t so2 = ((((size_t)b * 2 + dir) * 16 + h) * 64 + row2) * 64 + kl * 8;
    if (sample) {
        const float4 a = *(const float4*)(p.in[2] + so2), c = *(const float4*)(p.in[2] + so2 + 4), d = *(const float4*)(p.in[2] + so2 + 64), e = *(const float4*)(p.in[2] + so2 + 68);
        S[0] = a.x; S[1] = a.y; S[2] = a.z; S[3] = a.w; S[4] = c.x; S[5] = c.y; S[6] = c.z; S[7] = c.w;
        T[0] = d.x; T[1] = d.y; T[2] = d.z; T[3] = d.w; T[4] = e.x; T[5] = e.y; T[6] = e.z; T[7] = e.w; }
    else {
#pragma unroll
        for (int i = 0; i < 8; ++i) { S[i] = 0.f; T[i] = 0.f; } }
    f32x2 S2[4], T2[4];
#pragma unroll
    for (int i = 0; i < 4; ++i) { S2[i] = (f32x2){S[2 * i], S[2 * i + 1]}; T2[i] = (f32x2){T[2 * i], T[2 * i + 1]}; }
    const int pk4 = (tid & 15) * 4; const int ch = h * 64 + pk4; const int plt = (tid & 255) >> 4;
    const float4 mur = *(const float4*)(p.in[25] + ch), muk = *(const float4*)(p.in[25] + 1024 + ch), muv = *(const float4*)(p.in[25] + 2048 + ch);
    const float4 kkw = *(const float4*)(p.in[31] + ch), kaw = *(const float4*)(p.in[32] + ch);
    const float murA[4] = {mur.x, mur.y, mur.z, mur.w}, mukA[4] = {muk.x, muk.y, muk.z, muk.w}, muvA[4] = {muv.x, muv.y, muv.z, muv.w};
    const float kkwA[4] = {kkw.x, kkw.y, kkw.z, kkw.w}, kawA[4] = {kaw.x, kaw.y, kaw.z, kaw.w};
    const u16* P = (const u16*)(p.ws + OFF_P); const u16* RW = (const u16*)(p.ws + OFF_RW);
    u16* Y = (u16*)(p.out + OUT_GLAST) + (dir ? (size_t)NTOK * 1024 : 0);
#define RW_PREP(c0_, buf_) do { float* vec_ = sm + (buf_) * 14336; float* vvs_ = vec_ + 10240; \
        _Pragma("unroll 1") for (int ps = 0; ps < 2; ++ps) { const int ptt = plt + 16 * ps; \
            const int t = dir ? (L - 1 - ((c0_) + ptt)) : ((c0_) + ptt); const size_t tok = (size_t)tok0 + t; \
            const u16* pr = P + tok * LDP0 + 3072 + ch; \
            float rc[4], kc[4], vc[4], rm[4], km[4], vm[4], rp[4], kp[4], vp[4], ee[4], aa[4]; \
            unpack4(*(const u32x2*)(pr), rc); unpack4(*(const u32x2*)(pr + 1024), kc); unpack4(*(const u32x2*)(pr + 2048), vc); \
            if (t > 0) { const u16* pm = P + (tok - 1) * LDP0 + 3072 + ch; unpack4(*(const u32x2*)(pm), rm); unpack4(*(const u32x2*)(pm + 1024), km); unpack4(*(const u32x2*)(pm + 2048), vm); } \
            else { for (int i = 0; i < 4; ++i) { rm[i] = 0.f; km[i] = 0.f; vm[i] = 0.f; } } \
            if (t < L - 1) { unpack4(*(const u32x2*)(pr + LDP0), rp); unpack4(*(const u32x2*)(pr + LDP0 + 1024), kp); unpack4(*(const u32x2*)(pr + LDP0 + 2048), vp); } \
            else { for (int i = 0; i < 4; ++i) { rp[i] = 0.f; kp[i] = 0.f; vp[i] = 0.f; } } \
            unpack4(*(const u32x2*)(RW + tok * 4096 + dir * 1024 + ch), ee); unpack4(*(const u32x2*)(RW + tok * 4096 + (2 + dir) * 1024 + ch), aa); \
            float r4[4], k4[4], v4[4], kr[4]; float ss = 0.f; \
            _Pragma("unroll") for (int i = 0; i < 4; ++i) { r4[i] = mixf(rc[i], rm[i], rp[i], murA[i]); k4[i] = mixf(kc[i], km[i], kp[i], mukA[i]); v4[i] = mixf(vc[i], vm[i], vp[i], muvA[i]); \
                kr[i] = k4[i] * kkwA[i]; ss += kr[i] * kr[i]; } \
            ss = sum16(ss); const float inv = rsqrtf(ss + 1e-12f); \
            float tkk[4], tw[4], tkka[4], tkd[4]; \
            _Pragma("unroll") for (int i = 0; i < 4; ++i) { tkk[i] = kr[i] * inv; tw[i] = __expf(-ee[i]); tkka[i] = tkk[i] * aa[i]; tkd[i] = k4[i] * (1.f + (aa[i] - 1.f) * kawA[i]); } \
            float* vj = vec_ + ptt * 320 + pk4; \
            *(float4*)(vj) = make_float4(tkk[0], tkk[1], tkk[2], tkk[3]); *(float4*)(vj + 64) = make_float4(tw[0], tw[1], tw[2], tw[3]); *(float4*)(vj + 128) = make_float4(tkka[0], tkka[1], tkka[2], tkka[3]); \
            *(float4*)(vj + 192) = make_float4(tkd[0], tkd[1], tkd[2], tkd[3]); *(float4*)(vj + 256) = make_float4(r4[0], r4[1], r4[2], r4[3]); \
            *(float4*)(vvs_ + ptt * 64 + pk4) = make_float4(v4[0], v4[1], v4[2], v4[3]); } } while (0)
#define RW_YOUT(c0_, buf_) do { const float* yb_ = sm + (buf_) * 14336 + 12288; \
        _Pragma("unroll 1") for (int ps = 0; ps < 2; ++ps) { const int ptt = plt + 16 * ps; const int t = dir ? (L - 1 - ((c0_) + ptt)) : ((c0_) + ptt); \
            const float4 yv = *(const float4*)(yb_ + ptt * 64 + pk4); u32x2 w; w.x = pk(yv.x, yv.y); w.y = pk(yv.z, yv.w); \
            *(u32x2*)(Y + ((size_t)tok0 + t) * 1024 + ch) = w; } } while (0)
    const int nchunk = L >> 5;
    if (wid >= 4) RW_PREP(0, 0);
    __syncthreads();
#pragma unroll 1
    for (int c = 0; c < nchunk; ++c) {
        if (wid < 4) {
            const float* vec = sm + (c & 1) * 14336; const float* vvs = vec + 10240; float* yb = sm + (c & 1) * 14336 + 12288;
#pragma unroll
            for (int j = 0; j < 32; ++j) {
                const float* vj = vec + j * 320 + kl * 8;
                const f32x4 a0 = *(const f32x4*)(vj), a1 = *(const f32x4*)(vj + 4);
                const f32x4 w0 = *(const f32x4*)(vj + 64), w1 = *(const f32x4*)(vj + 68);
                const f32x4 b0 = *(const f32x4*)(vj + 128), b1 = *(const f32x4*)(vj + 132);
                const f32x4 d0 = *(const f32x4*)(vj + 192), d1 = *(const f32x4*)(vj + 196);
                const f32x4 r0 = *(const f32x4*)(vj + 256), r1 = *(const f32x4*)(vj + 260);
                const float2 vr = *(const float2*)(vvs + j * 64 + row2);
                const f32x2 kk0 = a0.lo, kk1 = a0.hi, kk2 = a1.lo, kk3 = a1.hi;
                f32x2 pa = S2[0] * kk0; pa += S2[1] * kk1; pa += S2[2] * kk2; pa += S2[3] * kk3;
                f32x2 pb = T2[0] * kk0; pb += T2[1] * kk1; pb += T2[2] * kk2; pb += T2[3] * kk3;
                const float sa = -sum8(pa.x + pa.y), sb = -sum8(pb.x + pb.y);
                const f32x2 sa2 = (f32x2){sa, sa}, sb2 = (f32x2){sb, sb}, vx2 = (f32x2){vr.x, vr.x}, vy2 = (f32x2){vr.y, vr.y};
                S2[0] = S2[0] * w0.lo + (sa2 * b0.lo + vx2 * d0.lo); S2[1] = S2[1] * w0.hi + (sa2 * b0.hi + vx2 * d0.hi);
                S2[2] = S2[2] * w1.lo + (sa2 * b1.lo + vx2 * d1.lo); S2[3] = S2[3] * w1.hi + (sa2 * b1.hi + vx2 * d1.hi);
                T2[0] = T2[0] * w0.lo + (sb2 * b0.lo + vy2 * d0.lo); T2[1] = T2[1] * w0.hi + (sb2 * b0.hi + vy2 * d0.hi);
                T2[2] = T2[2] * w1.lo + (sb2 * b1.lo + vy2 * d1.lo); T2[3] = T2[3] * w1.hi + (sb2 * b1.hi + vy2 * d1.hi);
                f32x2 qa = S2[0] * r0.lo; qa += S2[1] * r0.hi; qa += S2[2] * r1.lo; qa += S2[3] * r1.hi;
                f32x2 qb = T2[0] * r0.lo; qb += T2[1] * r0.hi; qb += T2[2] * r1.lo; qb += T2[3] * r1.hi;
                const float y0 = sum8(qa.x + qa.y), y1 = sum8(qb.x + qb.y);
                if (kl == 0) *(float2*)(yb + j * 64 + row2) = make_float2(y0, y1);
            }
        } else {
            if (c > 0) RW_YOUT((c - 1) * 32, (c - 1) & 1);
            if (c + 1 < nchunk) RW_PREP((c + 1) * 32, (c + 1) & 1);
        }
        __syncthreads();
    }
    if (wid >= 4) RW_YOUT((nchunk - 1) * 32, (nchunk - 1) & 1);
#undef RW_PREP
#undef RW_YOUT
#pragma unroll
    for (int i = 0; i < 4; ++i) { S[2 * i] = S2[i].x; S[2 * i + 1] = S2[i].y; T[2 * i] = T2[i].x; T[2 * i + 1] = T2[i].y; }
    if (!sample && wid < 4) { float* so = p.out + OUT_RWST + so2;
        *(float4*)(so) = make_float4(S[0], S[1], S[2], S[3]); *(float4*)(so + 4) = make_float4(S[4], S[5], S[6], S[7]);
        *(float4*)(so + 64) = make_float4(T[0], T[1], T[2], T[3]); *(float4*)(so + 68) = make_float4(T[4], T[5], T[6], T[7]); }
    __syncthreads();
}
DEV void rwkv_post_tile(const Params& p, int tile, float* sm) {
    const int tid = tidx(); const int tok0 = tile * 32;
    const u16* P = (const u16*)(p.ws + OFF_P); const u16* RW = (const u16*)(p.ws + OFF_RW); u16* ycat = (u16*)(p.ws + OFF_A);
    const u16* YF = (const u16*)(p.out + OUT_GLAST); const u16* YB = YF + (size_t)NTOK * 1024;
    u16* Gh = (u16*)(sm + 4096);
    for (int i = tid; i < 32 * 128; i += 512) { const int tk = i >> 7, r = i & 127; const int tok = tok0 + tk; int t, L; tok_tl(tok, t, L);
        const u16* pp = P + (size_t)tok * LDP0 + 6400 + r; const float x = bf2f(*pp); const float xm = t > 0 ? bf2f(pp[-LDP0]) : 0.f; const float xp = t < L - 1 ? bf2f(pp[LDP0]) : 0.f;
        sm[i] = sigm(mixf(x, xm, xp, p.in[25][3328 + r])); }
    __syncthreads();
    { float g0[32], g1[32];
#pragma unroll
        for (int k = 0; k < 32; ++k) { g0[k] = 0.f; g1[k] = 0.f; }
        const float* g2 = p.in[30];
        for (int r = 0; r < 128; r += 4) {
            float wa[4], wb[4];
#pragma unroll
            for (int q = 0; q < 4; ++q) { wa[q] = g2[(r + q) * 1024 + tid]; wb[q] = g2[(r + q) * 1024 + 512 + tid]; }
#pragma unroll
            for (int k = 0; k < 32; ++k) { const float4 s4 = *(const float4*)(sm + k * 128 + r);
                g0[k] += s4.x * wa[0] + s4.y * wa[1] + s4.z * wa[2] + s4.w * wa[3]; g1[k] += s4.x * wb[0] + s4.y * wb[1] + s4.z * wb[2] + s4.w * wb[3]; } }
#pragma unroll
        for (int k = 0; k < 32; ++k) { Gh[k * 1024 + tid] = f2bf(g0[k]); Gh[k * 1024 + 512 + tid] = f2bf(g1[k]); } }
    __syncthreads();
    const int c8 = (tid & 127) * 8;
    float mur[8], muk[8], muv[8], ka[8], rk[8], lw[8], lb[8];
#pragma unroll
    for (int i = 0; i < 8; ++i) { mur[i] = p.in[25][c8 + i]; muk[i] = p.in[25][1024 + c8 + i]; muv[i] = p.in[25][2048 + c8 + i]; ka[i] = p.in[32][c8 + i]; rk[i] = p.in[33][c8 + i]; lw[i] = p.in[34][c8 + i]; lb[i] = p.in[35][c8 + i]; }
#pragma unroll 1
    for (int it = 0; it < 8; ++it) { const int tk = (tid >> 7) + 4 * it; const int tok = tok0 + tk; int t, L; tok_tl(tok, t, L);
        const u16* pr = P + (size_t)tok * LDP0 + 3072 + c8; const bool hm = t > 0, hp = t < L - 1;
        float rc[8], rm[8], rp[8], kc[8], km[8], kp[8], vc[8], vm[8], vp[8], a0[8], a1[8], yf[8], yb[8], gg[8];
        unpack8(*(const u32x4*)pr, rc); unpack8(*(const u32x4*)(pr + 1024), kc); unpack8(*(const u32x4*)(pr + 2048), vc);
        if (hm) { const u16* pm = P + (size_t)(tok - 1) * LDP0 + 3072 + c8; unpack8(*(const u32x4*)(pm), rm); unpack8(*(const u32x4*)(pm + 1024), km); unpack8(*(const u32x4*)(pm + 2048), vm); }
        else { for (int i = 0; i < 8; ++i) { rm[i] = 0.f; km[i] = 0.f; vm[i] = 0.f; } }
        if (hp) { unpack8(*(const u32x4*)(pr + LDP0), rp); unpack8(*(const u32x4*)(pr + LDP0 + 1024), kp); unpack8(*(const u32x4*)(pr + LDP0 + 2048), vp); }
        else { for (int i = 0; i < 8; ++i) { rp[i] = 0.f; kp[i] = 0.f; vp[i] = 0.f; } }
        unpack8(*(const u32x4*)(RW + (size_t)tok * 4096 + 2048 + c8), a0); unpack8(*(const u32x4*)(RW + (size_t)tok * 4096 + 3072 + c8), a1);
        unpack8(*(const u32x4*)(YF + (size_t)tok * 1024 + c8), yf); unpack8(*(const u32x4*)(YB + (size_t)tok * 1024 + c8), yb);
        unpack8(*(const u32x4*)(Gh + tk * 1024 + c8), gg);
        float y[8], v_[8]; float bon = 0.f, sy = 0.f;
#pragma unroll
        for (int i = 0; i < 8; ++i) { const float r_ = mixf(rc[i], rm[i], rp[i], mur[i]), k_ = mixf(kc[i], km[i], kp[i], muk[i]); v_[i] = mixf(vc[i], vm[i], vp[i], muv[i]);
            bon += r_ * k_ * (2.f + (a0[i] + a1[i] - 2.f) * ka[i]) * rk[i]; y[i] = yf[i] + yb[i]; sy += y[i]; }
        bon = sum8(bon); const float mean = sum8(sy) * (1.f / 64.f);
        float sv = 0.f;
#pragma unroll
        for (int i = 0; i < 8; ++i) { y[i] -= mean; sv += y[i] * y[i]; }
        const float rstd = rsqrtf(sum8(sv) * (1.f / 64.f) + 64e-5f);
        float o[8];
#pragma unroll
        for (int i = 0; i < 8; ++i) o[i] = (y[i] * rstd * lw[i] + lb[i] + bon * v_[i]) * gg[i];
        u32x4 w; w.x = pk(o[0], o[1]); w.y = pk(o[2], o[3]); w.z = pk(o[4], o[5]); w.w = pk(o[6], o[7]);
        *(u32x4*)(ycat + (size_t)tok * DM + 1024 + c8) = w; }
    __syncthreads();
}

DEV float logsig(float x) { return fminf(x, 0.f) - __logf(1.f + __expf(-fabsf(x))); }
DEV void gla_intra_task(const Params& p, int task, unsigned char* shm) {
    const int tid = tidx(), wid = tid >> 6, lane = tid & 63, l15 = lane & 15, quad = lane >> 4;
    const int cidx = task >> 2, h = task & 3; const int tok0 = cidx * 64;
    u16* P = (u16*)(p.ws + OFF_P); u16* QB = (u16*)(p.ws + OFF_A); float* Dbuf = (float*)(p.ws + OFF_DB);
    u16* qi = (u16*)shm; u16* ki = qi + 64 * 264; u16* vl = (u16*)shm; u16* Pl = (u16*)(shm + 67584); float* gl = (float*)(shm + 76800); float* tot = (float*)(shm + 84992);
    for (int i = tid; i < 2048; i += 512) { const int tl = i >> 5, c = i & 31; gl[i] = bf2f(P[(size_t)(tok0 + tl) * LDP1 + 6144 + c]); }
    __syncthreads();
    const int k = tid & 255, jh = tid >> 8;
#pragma unroll 1
    for (int dd = 0; dd < 2; ++dd) { const int dir = 1 - dd;
        float g2r[16];
#pragma unroll
        for (int r = 0; r < 16; ++r) g2r[r] = p.in[38][(size_t)(dir * 16 + r) * 1024 + h * 256 + k];
        const float gb = p.in[39][dir * 1024 + h * 256 + k];
        float bl[32]; float run = 0.f;
#pragma unroll
        for (int jj = 0; jj < 32; ++jj) { const int j = jh * 32 + jj; const int tl = dir ? 63 - j : j; const float* gr = gl + tl * 32 + dir * 16;
            float x = gb;
#pragma unroll
            for (int r = 0; r < 16; r += 4) { const float4 g4 = *(const float4*)(gr + r); x += g4.x * g2r[r] + g4.y * g2r[r + 1] + g4.z * g2r[r + 2] + g4.w * g2r[r + 3]; }
            run += logsig(x) * 0.0625f; bl[jj] = run; }
        tot[jh * 256 + k] = run;
        __syncthreads();
        const float t0v = tot[k], t1v = tot[256 + k]; const float off = jh ? t0v : 0.f; const float bref = t0v, blast = t0v + t1v;
        if (jh == 0) Dbuf[((size_t)cidx * 2 + dir) * 1024 + h * 256 + k] = __expf(blast);
        u16* qdst; u16* kdst; size_t ldd;
        if (dir == 0) { qdst = P + h * 256 + k; kdst = P + 1024 + h * 256 + k; ldd = LDP1; } else { qdst = QB + h * 256 + k; kdst = QB + 1024 + h * 256 + k; ldd = 2048; }
#pragma unroll
        for (int jj = 0; jj < 32; ++jj) { const int j = jh * 32 + jj; const int tl = dir ? 63 - j : j; const size_t tok = (size_t)tok0 + tl;
            const float qv = bf2f(P[tok * LDP1 + h * 256 + k]) * 0.0625f, kv = bf2f(P[tok * LDP1 + 1024 + h * 256 + k]);
            const float b = bl[jj] + off;
            qi[j * 264 + k] = f2bf(qv * __expf(b - bref)); ki[j * 264 + k] = f2bf(kv * __expf(bref - b));
            qdst[tok * ldd] = f2bf(qv * __expf(b)); kdst[tok * ldd] = f2bf(kv * __expf(blast - b)); }
        __syncthreads();
        { const int tt = wid >> 1;
#pragma unroll
            for (int q2 = 0; q2 < 2; ++q2) { const int st = (wid & 1) * 2 + q2; f32x4 acc = (f32x4){0.f, 0.f, 0.f, 0.f};
                if (st <= tt) {
#pragma unroll
                    for (int ks = 0; ks < 8; ++ks) { const bf16x8 a = *(const bf16x8*)(qi + (tt * 16 + l15) * 264 + ks * 32 + quad * 8); const bf16x8 b = *(const bf16x8*)(ki + (st * 16 + l15) * 264 + ks * 32 + quad * 8);
                        acc = mfma16(a, b, acc); } }
#pragma unroll
                for (int r = 0; r < 4; ++r) { const int t = tt * 16 + quad * 4 + r, s_ = st * 16 + l15; Pl[t * 72 + s_] = f2bf(s_ <= t ? acc[r] : 0.f); } } }
        __syncthreads();
#pragma unroll
        for (int i = 0; i < 8; ++i) { const int piece = tid + 512 * i; const int j = piece >> 6, c8 = (piece & 63) * 8; const int tl = dir ? 63 - j : j;
            *(u32x4*)(vl + j * 520 + c8) = *(const u32x4*)(P + (size_t)(tok0 + tl) * LDP1 + 2048 + h * 512 + c8); }
        __syncthreads();
        u16* O = (u16*)(p.ws + (dir ? OFF_OB : OFF_OF)) + h * 512;
#pragma unroll 1
        for (int q4 = 0; q4 < 4; ++q4) { const int vt = wid * 4 + q4; f32x4 acc[4];
#pragma unroll
            for (int tt = 0; tt < 4; ++tt) acc[tt] = (f32x4){0.f, 0.f, 0.f, 0.f};
#pragma unroll
            for (int ss = 0; ss < 2; ++ss) { bf16x8 bfr;
#pragma unroll
                for (int jj = 0; jj < 8; ++jj) bfr[jj] = (short)vl[(ss * 32 + quad * 8 + jj) * 520 + vt * 16 + l15];
#pragma unroll
                for (int tt = 0; tt < 4; ++tt) { if (ss * 32 <= tt * 16 + 15) { const bf16x8 a = *(const bf16x8*)(Pl + (tt * 16 + l15) * 72 + ss * 32 + quad * 8); acc[tt] = mfma16(a, bfr, acc[tt]); } } }
#pragma unroll
            for (int tt = 0; tt < 4; ++tt)
#pragma unroll
                for (int r = 0; r < 4; ++r) { const int t = tt * 16 + quad * 4 + r; const int tl = dir ? 63 - t : t; O[(size_t)(tok0 + tl) * DM + vt * 16 + l15] = f2bf(acc[tt][r]); } }
        __syncthreads();
    }
}
DEV void gla_inter_task(const Params& p, int task, unsigned char* shm) {
    const bool sample = task < 256; const int tt_ = sample ? task : task - 256;
    const int seq = tt_ >> 3, vs = tt_ & 7; const int b = seq >> 3, h = (seq >> 1) & 3, dir = seq & 1;
    const int L = sample ? 4096 : 256; const int tok0 = sample ? NTP + b * 4096 : b * 256;
    const int nch = L >> 6, cbase = tok0 >> 6;
    const int tid = tidx(), wid = tid >> 6, lane = tid & 63, l15 = lane & 15, quad = lane >> 4;
    const u16* P = (const u16*)(p.ws + OFF_P); const u16* QB = (const u16*)(p.ws + OFF_A); const float* Dbuf = (const float*)(p.ws + OFF_DB);
    u16* ST = (u16*)shm; u16* qdl = (u16*)(shm + 33792); u16* kdl = (u16*)(shm + 67584); u16* vl = (u16*)(shm + 101376); float* dl = (float*)(shm + 110592);
    f32x4 S[2][4];
    const size_t sbase = (((size_t)b * 2 + dir) * 4 + h) * 256 * 512 + vs * 64;
#pragma unroll
    for (int kt = 0; kt < 2; ++kt)
#pragma unroll
        for (int vt = 0; vt < 4; ++vt)
#pragma unroll
            for (int r = 0; r < 4; ++r) { const int kk = wid * 32 + kt * 16 + quad * 4 + r; S[kt][vt][r] = sample ? p.in[3][sbase + (size_t)kk * 512 + vt * 16 + l15] : 0.f; }
    const u16* qsrc; const u16* ksrc; size_t lds_;
    if (dir == 0) { qsrc = P + h * 256; ksrc = P + 1024 + h * 256; lds_ = LDP1; } else { qsrc = QB + h * 256; ksrc = QB + 1024 + h * 256; lds_ = 2048; }
    const u16* vsrc = P + 2048 + h * 512 + vs * 64;
    u16* O = (u16*)(p.ws + (dir ? OFF_OB : OFF_OF)) + h * 512 + vs * 64;
    u32x4 rq[4], rk[4], rv; float rd = 0.f;
    const int vrow = tid >> 3, vc8 = (tid & 7) * 8;
#define GLA_ISSUE(n_) do { const int cidx_ = cbase + (dir ? nch - 1 - (n_) : (n_)); \
        _Pragma("unroll") for (int i = 0; i < 4; ++i) { const int piece = tid + 512 * i; const int j = piece >> 5, c8 = (piece & 31) * 8; const size_t tok = (size_t)cidx_ * 64 + (dir ? 63 - j : j); \
            rq[i] = *(const u32x4*)(qsrc + tok * lds_ + c8); rk[i] = *(const u32x4*)(ksrc + tok * lds_ + c8); } \
        { const size_t tok = (size_t)cidx_ * 64 + (dir ? 63 - vrow : vrow); rv = *(const u32x4*)(vsrc + tok * LDP1 + vc8); } \
        if (tid < 256) rd = Dbuf[((size_t)cidx_ * 2 + dir) * 1024 + h * 256 + tid]; } while (0)
#define GLA_WRITE_ST() do { _Pragma("unroll") for (int kt = 0; kt < 2; ++kt) _Pragma("unroll") for (int vt = 0; vt < 4; ++vt) { u32x2 w; w.x = pk(S[kt][vt][0], S[kt][vt][1]); w.y = pk(S[kt][vt][2], S[kt][vt][3]); \
            *(u32x2*)(ST + (vt * 16 + l15) * 264 + wid * 32 + kt * 16 + quad * 4) = w; } } while (0)
    GLA_WRITE_ST();
    GLA_ISSUE(0);
    const int tt = wid >> 1, vb = (wid & 1) * 2;
#pragma unroll 1
    for (int n = 0; n < nch; ++n) {
        const int cidx = cbase + (dir ? nch - 1 - n : n);
#pragma unroll
        for (int i = 0; i < 4; ++i) { const int piece = tid + 512 * i; const int j = piece >> 5, c8 = (piece & 31) * 8; *(u32x4*)(qdl + j * 264 + c8) = rq[i]; *(u32x4*)(kdl + j * 264 + c8) = rk[i]; }
        *(u32x4*)(vl + vrow * 72 + vc8) = rv; if (tid < 256) dl[tid] = rd;
        __syncthreads();
        if (n + 1 < nch) GLA_ISSUE(n + 1);
        float oi[2][4];
#pragma unroll
        for (int q2 = 0; q2 < 2; ++q2)
#pragma unroll
            for (int r = 0; r < 4; ++r) { const int j = tt * 16 + quad * 4 + r; const size_t tok = (size_t)cidx * 64 + (dir ? 63 - j : j); oi[q2][r] = bf2f(O[tok * DM + (vb + q2) * 16 + l15]); }
        f32x4 oacc[2]; oacc[0] = (f32x4){0.f, 0.f, 0.f, 0.f}; oacc[1] = oacc[0];
#pragma unroll
        for (int ks = 0; ks < 8; ++ks) { const bf16x8 a = *(const bf16x8*)(qdl + (tt * 16 + l15) * 264 + ks * 32 + quad * 8);
#pragma unroll
            for (int q2 = 0; q2 < 2; ++q2) { const bf16x8 bfr = *(const bf16x8*)(ST + ((vb + q2) * 16 + l15) * 264 + ks * 32 + quad * 8); oacc[q2] = mfma16(a, bfr, oacc[q2]); } }
#pragma unroll
        for (int kt = 0; kt < 2; ++kt) { const f32x4 dv = *(const f32x4*)(dl + wid * 32 + kt * 16 + quad * 4);
#pragma unroll
            for (int vt = 0; vt < 4; ++vt) S[kt][vt] = S[kt][vt] * dv; }
#pragma unroll
        for (int ts = 0; ts < 2; ++ts) { bf16x8 af[2];
#pragma unroll
            for (int kt = 0; kt < 2; ++kt)
#pragma unroll
                for (int jj = 0; jj < 8; ++jj) af[kt][jj] = (short)kdl[(ts * 32 + quad * 8 + jj) * 264 + wid * 32 + kt * 16 + l15];
#pragma unroll
            for (int vt = 0; vt < 4; ++vt) { bf16x8 bfr;
#pragma unroll
                for (int jj = 0; jj < 8; ++jj) bfr[jj] = (short)vl[(ts * 32 + quad * 8 + jj) * 72 + vt * 16 + l15];
#pragma unroll
                for (int kt = 0; kt < 2; ++kt) S[kt][vt] = mfma16(af[kt], bfr, S[kt][vt]); } }
#pragma unroll
        for (int q2 = 0; q2 < 2; ++q2)
#pragma unroll
            for (int r = 0; r < 4; ++r) { const int j = tt * 16 + quad * 4 + r; const size_t tok = (size_t)cidx * 64 + (dir ? 63 - j : j); O[tok * DM + (vb + q2) * 16 + l15] = f2bf(oi[q2][r] + oacc[q2][r]); }
        __syncthreads();
        GLA_WRITE_ST();
        __syncthreads();
    }
#undef GLA_ISSUE
#undef GLA_WRITE_ST
    if (!sample) { float* so = p.out + OUT_GLAST + sbase;
#pragma unroll
        for (int kt = 0; kt < 2; ++kt)
#pragma unroll
            for (int vt = 0; vt < 4; ++vt)
#pragma unroll
                for (int r = 0; r < 4; ++r) { const int kk = wid * 32 + kt * 16 + quad * 4 + r; so[(size_t)kk * 512 + vt * 16 + l15] = S[kt][vt][r]; } }
    __syncthreads();
}
DEV void phase_gla_post(const Params& p) {
    const int tid = tidx(), wid = tid >> 6, lane = tid & 63;
    const u16* P = (const u16*)(p.ws + OFF_P); const u16* OF = (const u16*)(p.ws + OFF_OF); const u16* OB = (const u16*)(p.ws + OFF_OB); u16* ycat = (u16*)(p.ws + OFF_A);
    for (int it = blockIdx.x * 8 + wid; it < NTOK * 4; it += gridDim.x * 8) { const int tok = it >> 2, h = it & 3; const int v8 = lane * 8;
        float a[8], b[8], g[8]; unpack8(*(const u32x4*)(OF + (size_t)tok * DM + h * 512 + v8), a); unpack8(*(const u32x4*)(OB + (size_t)tok * DM + h * 512 + v8), b);
        unpack8(*(const u32x4*)(P + (size_t)tok * LDP1 + 4096 + h * 512 + v8), g);
        float ss = 0.f;
#pragma unroll
        for (int i = 0; i < 8; ++i) { a[i] += b[i]; ss += a[i] * a[i]; }
        ss = wave_sum(ss); const float sc = rsqrtf(ss * (1.f / 512.f) + 1e-6f);
        float o[8];
#pragma unroll
        for (int i = 0; i < 8; ++i) o[i] = a[i] * sc * p.in[40][v8 + i] * (g[i] * sigm(g[i]));
        u32x4 w; w.x = pk(o[0], o[1]); w.y = pk(o[2], o[3]); w.z = pk(o[4], o[5]); w.w = pk(o[6], o[7]);
        *(u32x4*)(ycat + (size_t)tok * DM + h * 512 + v8) = w; }
}

DEV void gate_loadcol(const u16* U, long tokc, int c8, bool colok, bool up, bool dn, int W, float (*dst)[8]) {
    if (colok && up) unpack8(*(const u32x4*)(U + (size_t)(tokc - W) * LDU + c8), dst[0]); else { for (int i = 0; i < 8; ++i) dst[0][i] = 0.f; }
    if (colok) unpack8(*(const u32x4*)(U + (size_t)tokc * LDU + c8), dst[1]); else { for (int i = 0; i < 8; ++i) dst[1][i] = 0.f; }
    if (colok && dn) unpack8(*(const u32x4*)(U + (size_t)(tokc + W) * LDU + c8), dst[2]); else { for (int i = 0; i < 8; ++i) dst[2][i] = 0.f; }
}
DEV void phase_ffn_gate(const Params& p, int layer) {
    u16* U = (u16*)(p.ws + OFF_U); const float* cw = p.in[11] + (size_t)layer * 9 * DFF;
    const int tid_ = tidx(), wid_ = tid_ >> 6, lane_ = tid_ & 63;
    for (int bu = blockIdx.x; bu < 1408 + 704; bu += gridDim.x) {
        int tokS, c8;
        if (bu < 1408) { const int rg = bu / 44, rem = bu % 44; const int qtr = rem / 11, cgg = rem % 11; tokS = NTP + (rg * 8 + wid_) * 64 + qtr * 16; c8 = (cgg * 64 + lane_) * 8; }
        else { const int pu = bu - 1408; const int sg = pu / 11, cgg = pu % 11; tokS = (sg * 8 + wid_) * 16; c8 = (cgg * 64 + lane_) * 8; }
        int W, colS; bool up, dn;
        if (tokS < NTP) { W = 256; colS = tokS & 255; up = false; dn = false; }
        else { W = 64; colS = tokS & 63; const int rr = ((tokS - NTP) >> 6) & 63; up = rr > 0; dn = rr < 63; }
        float wt[9][8];
#pragma unroll
        for (int q = 0; q < 9; ++q) { const float4 a = *(const float4*)(cw + q * DFF + c8), b = *(const float4*)(cw + q * DFF + c8 + 4);
            wt[q][0] = a.x; wt[q][1] = a.y; wt[q][2] = a.z; wt[q][3] = a.w; wt[q][4] = b.x; wt[q][5] = b.y; wt[q][6] = b.z; wt[q][7] = b.w; }
        float w0[3][8], w1[3][8], w2[3][8];
        gate_loadcol(U, (long)tokS - 1, c8, colS > 0, up, dn, W, w0);
        gate_loadcol(U, (long)tokS, c8, true, up, dn, W, w1);
#pragma unroll 8
        for (int s_ = 0; s_ < 16; ++s_) {
            const long tok = (long)tokS + s_;
            gate_loadcol(U, tok + 1, c8, colS + s_ + 1 < W, up, dn, W, w2);
            u16* vp = U + (size_t)tok * LDU + DFF + c8; float v[8]; unpack8(*(const u32x4*)vp, v);
#pragma unroll
            for (int i = 0; i < 8; ++i) { float a = 0.f;
#pragma unroll
                for (int di = 0; di < 3; ++di) a += w0[di][i] * wt[di * 3][i] + w1[di][i] * wt[di * 3 + 1][i] + w2[di][i] * wt[di * 3 + 2][i];
                v[i] *= a * sigm(a); }
            u32x4 w; w.x = pk(v[0], v[1]); w.y = pk(v[2], v[3]); w.z = pk(v[4], v[5]); w.w = pk(v[6], v[7]);
            *(u32x4*)vp = w;
#pragma unroll
            for (int di = 0; di < 3; ++di)
#pragma unroll
                for (int i = 0; i < 8; ++i) { w0[di][i] = w1[di][i]; w1[di][i] = w2[di][i]; }
        }
    }
}

DEV void phase_final_norm(const Params& p) {
    const int tid = tidx(), wid = tid >> 6, lane = tid & 63; const float* g = p.in[13];
    const int nw = gridDim.x * 8, wv = blockIdx.x * 8 + wid; const int per = (NTOK + nw - 1) / nw; const int r0 = wv * per, r1 = (r0 + per < NTOK) ? r0 + per : NTOK;
    float4 gg[8];
#pragma unroll
    for (int j = 0; j < 8; ++j) gg[j] = *(const float4*)(g + (lane + 64 * j) * 4);
    for (int row = r0; row < r1; ++row) {
        float4* xr = (float4*)(p.out + (size_t)row * DM);
        float4 v[8]; float ss = 0.f;
#pragma unroll
        for (int j = 0; j < 8; ++j) { v[j] = xr[lane + 64 * j]; ss += v[j].x * v[j].x + v[j].y * v[j].y + v[j].z * v[j].z + v[j].w * v[j].w; }
        ss = wave_sum(ss); const float rstd = rsqrtf(ss * (1.f / 2048.f) + 1e-6f);
#pragma unroll
        for (int j = 0; j < 8; ++j) xr[lane + 64 * j] = make_float4(v[j].x * rstd * gg[j].x, v[j].y * rstd * gg[j].y, v[j].z * rstd * gg[j].z, v[j].w * rstd * gg[j].w);
    }
}

#define XB_TMO      128
#define XB_XCNT(j)  (256  + 64 * (j))
#define XB_XSUB(j)  (1280 + 64 * (j))
#define XB_XGEN(j)  (2304 + 64 * (j))
#define XB_TOP      3328
#define XB_TOPGEN   3392
#define XCD_BAR_WORDS 3456
#define XB_SPIN_CAP (1u << 18)
DEV unsigned xb_ld(unsigned* p)              { return __hip_atomic_load(p, __ATOMIC_RELAXED, __HIP_MEMORY_SCOPE_AGENT); }
DEV unsigned xb_add(unsigned* p, unsigned v) { return __hip_atomic_fetch_add(p, v, __ATOMIC_RELAXED, __HIP_MEMORY_SCOPE_AGENT); }
DEV unsigned xb_xcc_id() { return (unsigned)__builtin_amdgcn_s_getreg((3 << 11) | 20) & 0xFu; }
#define XB_SPIN(cond, bar) do { unsigned _sp = 0; while (cond) { __builtin_amdgcn_s_sleep(1); \
    if ((++_sp & 255u) == 0u) { if (xb_ld(&(bar)[XB_TMO])) break; if (_sp > XB_SPIN_CAP) { atomicAdd(&(bar)[XB_TMO], 1u); break; } } } } while (0)
struct XcdBarrier { unsigned* bar; unsigned x; volatile LAS unsigned* st; };
DEV XcdBarrier xcd_barrier_post(unsigned* bar, volatile LAS unsigned* st) {
    XcdBarrier b; b.bar = bar; b.x = xb_xcc_id(); b.st = st;
    if (threadIdx.x == 0) (void)xb_add(&bar[XB_XCNT(b.x)], 1u);
    return b;
}
DEV void xcd_barrier_complete(unsigned* bar, unsigned x, unsigned& nloc, unsigned& nx) {
    const unsigned G = gridDim.x * gridDim.y * gridDim.z;
    unsigned sum, cnt, mine, sp = 0u;
    for (;;) {
        sum = 0u; cnt = 0u; mine = 0u;
#pragma unroll
        for (unsigned j = 0; j < 16; ++j) { const unsigned c = xb_ld(&bar[XB_XCNT(j)]); sum += c; cnt += (c > 0u) ? 1u : 0u; mine = (j == x) ? c : mine; }
        if (sum == G) break;
        __builtin_amdgcn_s_sleep(1);
        if ((++sp & 255u) == 0u) { if (xb_ld(&bar[XB_TMO])) break; if (sp > XB_SPIN_CAP) { atomicAdd(&bar[XB_TMO], 1u); break; } }
    }
    nloc = mine > 0u ? mine : 1u; nx = cnt > 0u ? cnt : 1u;
}
DEV void xcd_barrier(const XcdBarrier& b) {
    asm volatile("s_waitcnt vmcnt(0)" ::: "memory");
    __syncthreads();
    if (threadIdx.x == 0) {
        unsigned* bar = b.bar;
        __builtin_amdgcn_s_waitcnt(0);
        unsigned nloc = b.st[0], nx = b.st[1];
        if (nloc == 0u) { xcd_barrier_complete(bar, b.x, nloc, nx); b.st[0] = nloc; b.st[1] = nx; }
        const unsigned old = xb_add(&bar[XB_XSUB(b.x)], 1u);
        const unsigned gen = old / nloc;
        if (old + 1u == (gen + 1u) * nloc) {
            __builtin_amdgcn_fence(__ATOMIC_RELEASE, "agent");
            asm volatile("s_waitcnt vmcnt(0)" ::: "memory");
            const unsigned og = xb_add(&bar[XB_TOP], 1u);
            const unsigned tg = og / nx;
            if (og + 1u == (tg + 1u) * nx) xb_add(&bar[XB_TOPGEN], 1u);
            else XB_SPIN(xb_ld(&bar[XB_TOPGEN]) == tg, bar);
            __builtin_amdgcn_fence(__ATOMIC_ACQUIRE, "agent");
            xb_add(&bar[XB_XGEN(b.x)], 1u);
            asm volatile("s_waitcnt vmcnt(0)" ::: "memory");
        } else {
            XB_SPIN(xb_ld(&bar[XB_XGEN(b.x)]) == gen, bar);
            __builtin_amdgcn_fence(__ATOMIC_ACQUIRE, "agent");
            asm volatile("s_waitcnt vmcnt(0)" ::: "memory");
        }
    }
    __syncthreads();
}

__global__ void __launch_bounds__(512, 2) mega(Params p0) {
    extern __shared__ __attribute__((aligned(16))) unsigned char shm[];
    cg::grid_group grid = cg::this_grid();
    __shared__ uint4 xb_words;
    if (threadIdx.x == 0) xb_words = make_uint4(0u, 0u, 0u, 0u);
    __syncthreads();
    (void)xcd_barrier_post((unsigned*)(p0.ws + OFF_SMALL + SMALL_BYTES + 256), (volatile LAS unsigned*)&xb_words);
#define XBAR() do { XcdBarrier xb_; xb_.bar = (unsigned*)(launder(p0).ws + OFF_SMALL + SMALL_BYTES + 256); xb_.x = xb_xcc_id(); xb_.st = (volatile LAS unsigned*)&xb_words; xcd_barrier(xb_); } while (0)
    float* sm = (float*)shm;
    const int G = (int)gridDim.x, B = (int)blockIdx.x;

#ifndef SK_PREP
    phase_prep(launder(p0), shm);
#ifdef PROBE_MISC
    __syncthreads(); phase_prep(launder(p0), shm);
#endif
#endif
    grid.sync();
    phase_reduce(launder(p0));
    XBAR();
#pragma unroll 1
    for (int layer = 0; layer < 2; ++layer) {
#ifndef SK_NORM
        phase_norm(launder(p0), layer, 0, shm);
#ifdef PROBE_MISC
        __syncthreads(); phase_norm(launder(p0), layer, 0, shm);
#endif
#endif
        XBAR();
        { const Params p = launder(p0); const u16* A = (const u16*)(p.ws + OFF_A); pg8::EpiBf16 E; E.O = (u16*)(p.ws + OFF_P); E.ldc = layer ? LDP1 : LDP0;
#if !defined(SK_GEMM) && !defined(SK_GBF)
            run_gemm(shm, A, DM, (const u16*)(p.ws + OFF_WIN), DM, layer ? LDP1 : LDP0, DM, E);
#ifdef PROBE_GEMM
            __syncthreads(); run_gemm(shm, A, DM, (const u16*)(p.ws + OFF_WIN), DM, layer ? LDP1 : LDP0, DM, E);
#endif
#endif
        }
        XBAR();
        if (layer == 0) {
#ifndef SK_PRE
            { const Params p = launder(p0); for (int t = B; t < 6144 + 768; t += G) { if (t < 6144) hy_pre_tile(p, t, sm); else rwkv_lora_tile(p, t - 6144, shm); } }
#ifdef PROBE_MISC
            { const Params p = launder(p0); for (int t = B; t < 6144 + 768; t += G) { if (t < 6144) hy_pre_tile(p, t, sm); else rwkv_lora_tile(p, t - 6144, shm); } }
#endif
#endif
            XBAR();
            { const Params p = launder(p0); unsigned* ctr = (unsigned*)(p.ws + OFF_SMALL + SMALL_BYTES);
                for (int t = B; t < 128; t += G) rwkv_scan_task(p, t, sm);
                for (;;) { if (tidx() == 0) *(volatile unsigned*)shm = atomicAdd(ctr, 1u); __syncthreads(); const unsigned t = *(volatile unsigned*)shm; __syncthreads();
                    if (t >= 1024u + 2048u) break;
                    if (t < 1024u) rwkv_scan_task(p, 128 + (int)t, sm); else hyconv_task(p, (int)t - 1024, shm); } }
            XBAR();
#ifndef SK_POST
            { const Params p = launder(p0); for (int t = B; t < 6144 + 768; t += G) { if (t < 6144) hy_post_tile(p, t, sm); else rwkv_post_tile(p, t - 6144, sm); } }
#ifdef PROBE_MISC
            { const Params p = launder(p0); for (int t = B; t < 6144 + 768; t += G) { if (t < 6144) hy_post_tile(p, t, sm); else rwkv_post_tile(p, t - 6144, sm); } }
#endif
#endif
            XBAR();
        } else {
#ifndef SK_GLA
            { const Params p = launder(p0); for (int t = B; t < 1536; t += G) gla_intra_task(p, t, shm); }
            XBAR();
            { const Params p = launder(p0); for (int t = B; t < 256 + 2048; t += G) gla_inter_task(p, t, shm); }
#endif
            XBAR();
#ifndef SK_GLAP
            phase_gla_post(launder(p0));
#ifdef PROBE_MISC
            phase_gla_post(launder(p0));
#endif
#endif
            XBAR();
        }
        { const Params p = launder(p0); const u16* A = (const u16*)(p.ws + OFF_A); const float* mods = (const float*)(p.ws + OFF_SMALL); pg8::EpiRes E; E.X = p.out; E.gm = mods + (size_t)layer * 5 * 12288 + 2 * 2048; E.gb = p.in[7] + layer * 12288 + 2 * 2048;
#if !defined(SK_GEMM) && !defined(SK_GRES)
            run_gemm(shm, A, DM, (const u16*)(p.ws + OFF_WOUT), DM, DM, DM, E);
#endif
        }
        XBAR();
#ifndef SK_NORM
        phase_norm(launder(p0), layer, 1, shm);
#ifdef PROBE_MISC
        __syncthreads(); phase_norm(launder(p0), layer, 1, shm);
#endif
#endif
        XBAR();
        { const Params p = launder(p0); const u16* A = (const u16*)(p.ws + OFF_A); pg8::EpiBf16 E; E.O = (u16*)(p.ws + OFF_U); E.ldc = LDU;
#if !defined(SK_GEMM) && !defined(SK_GBF)
            run_gemm(shm, A, DM, (const u16*)(p.ws + OFF_WUP), DM, LDU, DM, E);
#ifdef PROBE_GEMM
            __syncthreads(); run_gemm(shm, A, DM, (const u16*)(p.ws + OFF_WUP), DM, LDU, DM, E);
#endif
#endif
        }
        XBAR();
#ifndef SK_GATE
        phase_ffn_gate(launder(p0), layer);
#endif
        XBAR();
        { const Params p = launder(p0); const float* mods = (const float*)(p.ws + OFF_SMALL); pg8::EpiRes E; E.X = p.out; E.gm = mods + (size_t)layer * 5 * 12288 + 5 * 2048; E.gb = p.in[7] + layer * 12288 + 5 * 2048;
#if !defined(SK_GEMM) && !defined(SK_GRES)
            run_gemm(shm, (const u16*)(p.ws + OFF_U) + DFF, LDU, (const u16*)(p.ws + OFF_WDN), DFF, DM, DFF, E);
#endif
        }
        XBAR();
    }
    phase_final_norm(launder(p0));
}

extern "C" void kernel_launch(void* const* d_in, const int* in_sizes, int n_in, void* d_out, int out_size, void* d_ws, size_t ws_size, hipStream_t stream) {
    constexpr size_t kDynLds = 131072;
    static int grid_blocks = 0;
    if (!grid_blocks) {
        int dev = 0, cus = 0, per_cu = 0;
        hipGetDevice(&dev);
        hipDeviceGetAttribute(&cus, hipDeviceAttributeMultiprocessorCount, dev);
        hipFuncSetAttribute((const void*)mega, hipFuncAttributeMaxDynamicSharedMemorySize, (int)kDynLds);
        hipOccupancyMaxActiveBlocksPerMultiprocessor(&per_cu, mega, 512, kDynLds);
        if (per_cu < 1) per_cu = 1;
        grid_blocks = cus * per_cu;
        if (grid_blocks > 256) grid_blocks = 256;
    }
    if (ws_size < WS_NEED || n_in < 41) { fprintf(stderr, "workspace too small: %zu < %zu\n", ws_size, WS_NEED); return; }
    Params p{};
    for (int i = 0; i < 41; ++i) p.in[i] = (const float*)d_in[i];
    p.out = (float*)d_out; p.ws = (unsigned char*)d_ws;
    hipMemsetAsync((unsigned char*)d_ws + OFF_SMALL + SMALL_BYTES, 0, 256 + XCD_BAR_BYTES, stream);
    void* args[] = {&p};
    hipError_t e = hipLaunchCooperativeKernel((const void*)mega, dim3(grid_blocks), dim3(512), args, kDynLds, stream);
    if (e != hipSuccess) fprintf(stderr, "cooperative launch failed: %s (grid %d)\n", hipGetErrorString(e), grid_blocks);
}
```

```cpp
#include <hip/hip_runtime.h>
#include <hip/hip_cooperative_groups.h>
#include <cstdio>
namespace cg = cooperative_groups;

#define DEV __device__ __forceinline__
#define LAS __attribute__((address_space(3)))
typedef unsigned short u16;
typedef short bf16x8 __attribute__((ext_vector_type(8)));
typedef float f32x4 __attribute__((ext_vector_type(4)));
typedef float f32x2 __attribute__((ext_vector_type(2)));
typedef float f32x16 __attribute__((ext_vector_type(16)));
typedef unsigned u32x2 __attribute__((ext_vector_type(2)));
typedef unsigned u32x4 __attribute__((ext_vector_type(4)));

constexpr int NTOK = 24576, NTP = 8192, DM = 2048;
constexpr int LDP0 = 6656, LDP1 = 6400, LDU = 11264, DFF = 5632;
constexpr size_t OFF_WIN = 0, OFF_WOUT = 27262976, OFF_WUP = 35651584, OFF_WDN = OFF_WUP + 46137344;
constexpr size_t OFF_A = 104857600, OFF_BIG = 205520896;
constexpr size_t OFF_P = OFF_BIG, OFF_RW = OFF_BIG + 327155712, OFF_UT = OFF_RW + 201326592, OFF_GS = OFF_UT + 50331648, OFF_GP = OFF_GS + 16777216;
constexpr size_t OFF_U = OFF_BIG, OFF_OF = OFF_BIG + 314572800, OFF_OB = OFF_OF + 100663296, OFF_DB = OFF_OB + 100663296;
constexpr size_t OFF_SMALL = OFF_BIG + 600000000, SMALL_BYTES = 491520 + 8192;
constexpr size_t XCD_BAR_BYTES = 3456 * 4;
constexpr size_t OFF_LW = OFF_SMALL + SMALL_BYTES + 256 + XCD_BAR_BYTES;
constexpr size_t OFF_G2T = OFF_LW + 524288;
constexpr size_t WS_NEED = OFF_G2T + 262144;
constexpr size_t OUT_RWST = 50331648, OUT_GLAST = 54525952;

struct Params {
    const float* in[41];
    float* out;
    unsigned char* ws;
};

DEV int tidx() { int t = threadIdx.x; asm volatile("" : "+v"(t)); return t; }
DEV Params launder(const Params& p) { Params q = p; asm volatile("" : "+s"(q.ws), "+s"(q.out)); return q; }
DEV float bf2f(unsigned b) { return __uint_as_float(b << 16); }
DEV float bflo(unsigned w) { return __uint_as_float(w << 16); }
DEV float bfhi(unsigned w) { return __uint_as_float(w & 0xffff0000u); }
DEV unsigned pk(float lo, float hi) { unsigned r; asm("v_cvt_pk_bf16_f32 %0, %1, %2" : "=v"(r) : "v"(lo), "v"(hi)); return r; }
DEV u16 f2bf(float f) { return (u16)(pk(f, 0.f) & 0xffffu); }
DEV float wave_sum(float v) {
#pragma unroll
    for (int o = 32; o > 0; o >>= 1) v += __shfl_xor(v, o);
    return v;
}
template <int CTRL> DEV float dppf(float x) { return __builtin_bit_cast(float, __builtin_amdgcn_update_dpp(0, __builtin_bit_cast(int, x), CTRL, 0xf, 0xf, true)); }
DEV float sum8(float v) { v += dppf<0xB1>(v); v += dppf<0x4E>(v); v += dppf<0x141>(v); return v; }
DEV float sum16(float v) { v = sum8(v); v += dppf<0x140>(v); return v; }
DEV f32x4 mfma16(bf16x8 a, bf16x8 b, f32x4 c) { return __builtin_amdgcn_mfma_f32_16x16x32_bf16(a, b, c, 0, 0, 0); }
DEV float sigm(float x) { return __builtin_amdgcn_rcpf(1.f + __expf(-x)); }
DEV int tok_cond(int tok) { return tok < NTP ? 4 : ((tok - NTP) >> 12); }
DEV void tok_tl(int tok, int& t, int& L) { if (tok < NTP) { t = tok & 255; L = 256; } else { t = (tok - NTP) & 4095; L = 4096; } }
DEV void unpack8(u32x4 w, float* o) { o[0] = bflo(w.x); o[1] = bfhi(w.x); o[2] = bflo(w.y); o[3] = bfhi(w.y); o[4] = bflo(w.z); o[5] = bfhi(w.z); o[6] = bflo(w.w); o[7] = bfhi(w.w); }
DEV void unpack4(u32x2 w, float* o) { o[0] = bflo(w.x); o[1] = bfhi(w.x); o[2] = bflo(w.y); o[3] = bfhi(w.y); }

namespace pg8 {
constexpr int BM = 256, BK = 64, HALF = 128, HTB = HALF * BK * 2, NXCD = 8, WGM = 8;
DEV int lds_byte(int r, int c) { const int st = (r >> 4) * 2 + (c >> 5), rr = r & 15, cc = c & 31, ob = rr * 64 + cc * 2; return st * 1024 + (ob ^ (((ob >> 9) & 1) << 5)); }
DEV void stage_rc(int b, int& R, int& C) { const int st = b / 1024, sb = b % 1024, swz = sb ^ (((sb >> 9) & 1) << 5); R = (st >> 1) * 16 + swz / 64; C = (st & 1) * 32 + (swz % 64) / 2; }
DEV int perm32(int rho) { const int n = rho >> 4, i = rho & 15; return 8 * (i >> 2) + 4 * n + (i & 3); }
struct Unit { int pm, pn; };
struct Gemm { const u16* A; const u16* Bt; int M, N, K, lda, ldb; };
struct StaticOrder {
    int nM, nN, nwg, G, c;
    DEV void init(int M, int N, int G_, int c_) { nM = M / BM; nN = N / BM; nwg = nM * nN; G = G_; c = c_; }
    DEV bool next(int i, Unit& u) const {
        const long L = (long)i * G + c; if (L >= nwg) return false;
        int wgid = (int)L; { const int q = nwg / NXCD, r = nwg % NXCD, xcd = wgid % NXCD, off = wgid / NXCD; wgid = (xcd < r ? xcd * (q + 1) : r * (q + 1) + (xcd - r) * q) + off; }
        const int nig = WGM * nN, gid = wgid / nig, fm = gid * WGM, gsz = (nM - fm) < WGM ? (nM - fm) : WGM;
        u.pm = fm + ((wgid % nig) % gsz); u.pn = (wgid % nig) / gsz; return true;
    }
};
struct EpiBf16 {
    static constexpr bool PERM = true;
    u16* O; int ldc;
    DEV void operator()(const f32x4 (&acc)[2][2][4][2], const Unit& u, int wr, int wc, int fr, int fq) const {
        const int row0 = u.pm * BM + wr * 64 + fr; const int col0 = u.pn * BM + wc * 32 + 8 * fq;
#pragma unroll
        for (int ai = 0; ai < 2; ++ai)
#pragma unroll
            for (int m = 0; m < 4; ++m) { u16* rowp = O + (size_t)(row0 + ai * HALF + m * 16) * ldc + col0;
#pragma unroll
                for (int bj = 0; bj < 2; ++bj) { const f32x4 v0 = acc[ai][bj][m][0], v1 = acc[ai][bj][m][1];
                    u32x4 w; w.x = pk(v0[0], v0[1]); w.y = pk(v0[2], v0[3]); w.z = pk(v1[0], v1[1]); w.w = pk(v1[2], v1[3]);
                    *(u32x4*)(rowp + bj * HALF) = w; } }
    }
};
struct EpiRes {
    static constexpr bool PERM = false;
    float* X; const float* gm; const float* gb;
    DEV void operator()(const f32x4 (&acc)[2][2][4][2], const Unit& u, int wr, int wc, int fr, int fq) const {
        const int row0 = u.pm * BM + wr * 64 + fr, col0 = u.pn * BM + wc * 32 + 4 * fq;
        const int cond = u.pm < 32 ? 4 : ((u.pm - 32) >> 4);
        const float* gmc = gm + (size_t)cond * 12288 + col0; const float* gbc = gb + col0;
#pragma unroll
        for (int ai = 0; ai < 2; ++ai)
#pragma unroll
            for (int m = 0; m < 4; ++m) { float* rowp = X + (size_t)(row0 + ai * HALF + m * 16) * DM + col0;
#pragma unroll
                for (int bj = 0; bj < 2; ++bj) {
#pragma unroll
                    for (int n = 0; n < 2; ++n) { f32x4* q = (f32x4*)(rowp + bj * HALF + n * 16);
                        const f32x4 gvv = *(const f32x4*)(gmc + bj * HALF + n * 16) + *(const f32x4*)(gbc + bj * HALF + n * 16);
                        *q = *q + gvv * acc[ai][bj][m][n]; }
                    asm volatile("" ::: "memory"); } }
    }
};

template <class Epi>
DEV void gemm_phase(LAS unsigned char* lds, const Gemm g, const StaticOrder& S, const Epi& E) {
    const int tid = tidx(), wid = __builtin_amdgcn_readfirstlane(tid >> 6), lane = tid & 63, wr = wid >> 2, wc = wid & 3, fr = lane & 15, fq = lane >> 4;
    const int K = g.K, nt = K / BK;
    unsigned voffA[2], voffB[2];
#pragma unroll
    for (int i = 0; i < 2; ++i) { int R, C; stage_rc(tid * 16 + i * 8192, R, C); const int Rb = Epi::PERM ? ((R & ~31) + perm32(R & 31)) : R;
        voffA[i] = (unsigned)(R * g.lda + C) * 2u; voffB[i] = (unsigned)(Rb * g.ldb + C) * 2u; }
    const size_t kstep = (size_t)(BK * 2);
    const size_t hstepA = (size_t)HALF * g.lda * 2, hstepB = (size_t)HALF * g.ldb * 2;
    const size_t tstepA = 2 * hstepA, tstepB = 2 * hstepB;
    const unsigned ldsw = (unsigned)wid * 1024u;
    const int aoff = lds_byte(wr * 64 + fr, fq * 8), boff = lds_byte(wc * 32 + fr, fq * 8);
#define PG8_SA(b, h) (((b) * 2 + (h)) * HTB)
#define PG8_SB(b, h) ((4 + (b) * 2 + (h)) * HTB)
#define PG8_STAGE(bufoff, gbase, voff) do { _Pragma("unroll") for (int _i = 0; _i < 2; ++_i) \
        __builtin_amdgcn_global_load_lds((const unsigned*)((const char*)(gbase) + (voff)[_i]), (LAS unsigned*)(lds + (bufoff) + ldsw + _i * 8192), 16, 0, 0); } while (0)
#define PG8_LDA(dst, b, h) do { _Pragma("unroll") for (int m = 0; m < 4; ++m) _Pragma("unroll") for (int k = 0; k < 2; ++k) dst[m][k] = *(const LAS bf16x8*)(lds + PG8_SA(b, h) + aoff + m * 2048 + k * 1024); } while (0)
#define PG8_LDB(dst, b, h) do { _Pragma("unroll") for (int n = 0; n < 2; ++n) _Pragma("unroll") for (int k = 0; k < 2; ++k) dst[n][k] = *(const LAS bf16x8*)(lds + PG8_SB(b, h) + boff + n * 2048 + k * 1024); } while (0)
#define PG8_MMA(ai, bj, At, Bt) do { __builtin_amdgcn_s_setprio(1); _Pragma("unroll") for (int m = 0; m < 4; ++m) _Pragma("unroll") for (int n = 0; n < 2; ++n) _Pragma("unroll") for (int k = 0; k < 2; ++k) \
        acc[ai][bj][m][n] = __builtin_amdgcn_mfma_f32_16x16x32_bf16(Bt[n][k], At[m][k], acc[ai][bj][m][n], 0, 0, 0); __builtin_amdgcn_s_setprio(0); } while (0)
#define PG8_WAIT_V(n) asm volatile("s_waitcnt vmcnt(" #n ")" ::: "memory")
#define PG8_WAIT_L(n) asm volatile("s_waitcnt lgkmcnt(" #n ")" ::: "memory")
#define PG8_BAR __builtin_amdgcn_s_barrier()
#define PG8_SCHED __builtin_amdgcn_sched_barrier(0)
    Unit cur, nxt; int ui = 0;
    if (!S.next(0, cur)) return;
    f32x4 acc[2][2][4][2];
#pragma unroll
    for (int a = 0; a < 2; ++a)
#pragma unroll
        for (int b = 0; b < 2; ++b)
#pragma unroll
            for (int m = 0; m < 4; ++m)
#pragma unroll
                for (int n = 0; n < 2; ++n) acc[a][b][m][n] = (f32x4){0.f, 0.f, 0.f, 0.f};
    bf16x8 At[4][2], B0[2][2], B1[2][2];
    const char* cA = (const char*)g.A + (size_t)cur.pm * tstepA; const char* cB = (const char*)g.Bt + (size_t)cur.pn * tstepB;
    PG8_STAGE(PG8_SB(0, 0), cB, voffB); PG8_STAGE(PG8_SA(0, 0), cA, voffA); PG8_STAGE(PG8_SB(0, 1), cB + hstepB, voffB); PG8_STAGE(PG8_SA(0, 1), cA + hstepA, voffA);
    if (wr == 1) PG8_BAR;
    PG8_WAIT_V(4); PG8_BAR;
    PG8_STAGE(PG8_SB(1, 0), cB + kstep, voffB); PG8_STAGE(PG8_SA(1, 0), cA + kstep, voffA); PG8_STAGE(PG8_SB(1, 1), cB + hstepB + kstep, voffB);
    PG8_WAIT_V(6); PG8_BAR;
    for (;;) {
        const bool has_next = S.next(ui + 1, nxt);
        const char* nA = has_next ? (const char*)g.A + (size_t)nxt.pm * tstepA : cA; const char* nB = has_next ? (const char*)g.Bt + (size_t)nxt.pn * tstepB : cB;
        for (int t = 0; t < nt; t += 2) {
            const bool last = (t == nt - 2);
            const char* a1 = cA + (size_t)(t + 1) * kstep;
            const char* a2 = last ? nA : cA + (size_t)(t + 2) * kstep; const char* b2 = last ? nB : cB + (size_t)(t + 2) * kstep;
            const char* a3 = a2 + kstep; const char* b3 = b2 + kstep;
            PG8_LDB(B0, 0, 0); PG8_SCHED; PG8_LDA(At, 0, 0); PG8_STAGE(PG8_SA(1, 1), a1 + hstepA, voffA);
            PG8_WAIT_L(8); PG8_BAR; PG8_WAIT_L(0); PG8_MMA(0, 0, At, B0); PG8_BAR; PG8_SCHED;
            PG8_LDB(B1, 0, 1); PG8_STAGE(PG8_SB(0, 0), b2, voffB);
            PG8_BAR; PG8_WAIT_L(0); PG8_MMA(0, 1, At, B1); PG8_BAR;
            PG8_LDA(At, 0, 1); PG8_STAGE(PG8_SA(0, 0), a2, voffA);
            PG8_BAR; PG8_WAIT_L(0); PG8_MMA(1, 0, At, B0); PG8_BAR; PG8_SCHED;
            PG8_STAGE(PG8_SB(0, 1), b2 + hstepB, voffB);
            PG8_WAIT_V(6); PG8_BAR; PG8_MMA(1, 1, At, B1); PG8_BAR;
            PG8_LDB(B0, 1, 0); PG8_SCHED; PG8_LDA(At, 1, 0); PG8_STAGE(PG8_SA(0, 1), a2 + hstepA, voffA);
            PG8_WAIT_L(8); PG8_BAR; PG8_WAIT_L(0); PG8_MMA(0, 0, At, B0); PG8_BAR; PG8_SCHED;
            PG8_LDB(B1, 1, 1); PG8_STAGE(PG8_SB(1, 0), b3, voffB);
            PG8_BAR; PG8_WAIT_L(0); PG8_MMA(0, 1, At, B1); PG8_BAR;
            PG8_LDA(At, 1, 1); PG8_STAGE(PG8_SA(1, 0), a3, voffA);
            PG8_BAR; PG8_WAIT_L(0); PG8_MMA(1, 0, At, B0); PG8_BAR; PG8_SCHED;
            PG8_STAGE(PG8_SB(1, 1), b3 + hstepB, voffB);
            PG8_WAIT_V(6); PG8_BAR; PG8_MMA(1, 1, At, B1); PG8_BAR;
        }
        E(acc, cur, wr, wc, fr, fq);
        if (!has_next) break;
#pragma unroll
        for (int a = 0; a < 2; ++a)
#pragma unroll
            for (int b = 0; b < 2; ++b)
#pragma unroll
                for (int m = 0; m < 4; ++m)
#pragma unroll
                    for (int n = 0; n < 2; ++n) acc[a][b][m][n] = (f32x4){0.f, 0.f, 0.f, 0.f};
        cur = nxt; cA = nA; cB = nB; ++ui;
    }
    PG8_WAIT_V(0);
    if (wr == 0) PG8_BAR;
    PG8_BAR;
#undef PG8_SA
#undef PG8_SB
#undef PG8_STAGE
#undef PG8_LDA
#undef PG8_LDB
#undef PG8_MMA
#undef PG8_WAIT_V
#undef PG8_WAIT_L
#undef PG8_BAR
#undef PG8_SCHED
}
}

template <class Epi>
DEV void run_gemm(unsigned char* shm, const u16* A, int lda, const u16* Bt, int ldb, int N, int K, const Epi& E) {
    asm volatile("" : "+s"(A), "+s"(Bt));
    pg8::Gemm g; g.A = A; g.Bt = Bt; g.M = NTOK; g.N = N; g.K = K; g.lda = lda; g.ldb = ldb;
    pg8::StaticOrder S; S.init(NTOK, N, (int)gridDim.x, (int)blockIdx.x);
    pg8::gemm_phase<Epi>((LAS unsigned char*)shm, g, S, E);
}

DEV void convT_tile(const float* __restrict__ src, u16* __restrict__ dst, int K, int N, int Npad, int tile, float* T) {
    const int tid = tidx(); const int ntn = Npad >> 6; const int k0 = (tile / ntn) << 6, n0 = (tile % ntn) << 6;
#pragma unroll
    for (int j = 0; j < 2; ++j) { const int idx = tid + j * 512; const int r = idx >> 4, c4 = (idx & 15) << 2;
        float4 v = make_float4(0.f, 0.f, 0.f, 0.f); if (n0 + c4 < N) v = *(const float4*)(src + (size_t)(k0 + r) * N + n0 + c4);
        float* t = T + r * 65 + c4; t[0] = v.x; t[1] = v.y; t[2] = v.z; t[3] = v.w; }
    __syncthreads();
    { const int nn = tid >> 3, kq = (tid & 7) << 3; const float* t = T + kq * 65 + nn;
        u32x4 o; o.x = pk(t[0], t[65]); o.y = pk(t[130], t[195]); o.z = pk(t[260], t[325]); o.w = pk(t[390], t[455]);
        *(u32x4*)(dst + (size_t)(n0 + nn) * K + k0 + kq) = o; }
    __syncthreads();
}
DEV int conv_ntiles(int job, int layer) { return job == 0 ? (layer ? 3200 : 3328) : job == 1 ? 1024 : job == 2 ? 5632 : 2816; }
DEV void conv_job(const Params& p, int job, int layer, int tile, float* T) {
    if (job == 0) convT_tile(layer ? p.in[36] : p.in[14], (u16*)(p.ws + OFF_WIN), 2048, layer ? 6176 : 6528, layer ? LDP1 : LDP0, tile, T);
    else if (job == 1) convT_tile(layer ? p.in[37] : p.in[15], (u16*)(p.ws + OFF_WOUT), 2048, 2048, 2048, tile, T);
    else if (job == 2) convT_tile(p.in[10] + (size_t)layer * 2048 * 11264, (u16*)(p.ws + OFF_WUP), 2048, 11264, 11264, tile, T);
    else convT_tile(p.in[12] + (size_t)layer * 5632 * 2048, (u16*)(p.ws + OFF_WDN), 5632, 2048, 2048, tile, T);
}

DEV void adaln_tile(const Params& p, int tile, float* sl) {
    const int tid = tidx(); const int nt = tile % 6, kc = (tile / 6) & 31, layer = tile / 192;
    if (tid < 320) { const int j = tid >> 6, kk = tid & 63; const float cv = (j < 4) ? p.in[4][j * 2048 + kc * 64 + kk] : p.in[5][kc * 64 + kk]; sl[tid] = cv / (1.f + expf(-cv)); }
    __syncthreads();
    const float* w = p.in[6] + ((size_t)layer * 2048 + kc * 64) * 12288 + nt * 2048 + tid * 4;
    float acc[5][4];
#pragma unroll
    for (int j = 0; j < 5; ++j) { acc[j][0] = 0.f; acc[j][1] = 0.f; acc[j][2] = 0.f; acc[j][3] = 0.f; }
#pragma unroll 8
    for (int kk = 0; kk < 64; ++kk) { const float4 wv = *(const float4*)(w + (size_t)kk * 12288);
#pragma unroll
        for (int j = 0; j < 5; ++j) { const float s = sl[j * 64 + kk]; acc[j][0] += s * wv.x; acc[j][1] += s * wv.y; acc[j][2] += s * wv.z; acc[j][3] += s * wv.w; } }
    float* m = (float*)(p.ws + OFF_A) + (size_t)kc * 122880 + (size_t)layer * 5 * 12288 + nt * 2048 + tid * 4;
#pragma unroll
    for (int j = 0; j < 5; ++j) *(float4*)(m + j * 12288) = make_float4(acc[j][0], acc[j][1], acc[j][2], acc[j][3]);
    __syncthreads();
}

DEV void hyfilt_tile(const Params& p, int tile, float* sm) {
    const int tid = tidx();
    int L, p0; u16* G; float* nrm = (float*)(p.ws + OFF_A) + 32 * 122880 + (size_t)tile * 2048;
    if (tile < 128) { L = 4096; p0 = tile * 32; G = (u16*)(p.ws + OFF_GS); }
    else { L = 256; p0 = (tile - 128) * 32; G = (u16*)(p.ws + OFF_GP); }
    float* z = sm; float* h1 = sm + 32 * 33; float* h2 = h1 + 2048;
    const float cang = (float)(6.283185307179586 / (double)L);
    for (int i = tid; i < 32 * 33; i += 512) { const int pp = i / 33, e = i % 33; const float pos = (float)(p0 + pp); float val;
        if (e == 0) val = pos / (float)(L - 1);
        else { const int bi = (e - 1) & 15; const float fb = 1e-4f + (float)bi * ((15.f - 1e-4f) / 15.f); const float ang = (cang * pos) * fb; val = (e <= 16) ? cosf(ang) : -sinf(ang); }
        z[i] = val; }
    __syncthreads();
    for (int i = tid; i < 2048; i += 512) { const int pp = i >> 6, j = i & 63; float a = p.in[19][j];
        for (int e = 0; e < 33; ++e) a += z[pp * 33 + e] * p.in[18][e * 64 + j];
        h1[i] = sinf(p.in[23][j] * a); }
    __syncthreads();
    for (int i = tid; i < 2048; i += 512) { const int pp = i >> 6, j = i & 63; float a = p.in[21][j];
        for (int e = 0; e < 64; ++e) a += h1[pp * 64 + e] * p.in[20][e * 64 + j];
        h2[i] = sinf(p.in[23][64 + j] * a); }
    __syncthreads();
    const float dlo = 3.0701134573253946f, dhi = 15.350567286626973f;
    for (int q = 0; q < 4; ++q) { const int n = tid + 512 * q; const int c = n & 1023; const int back = n >> 10;
        float wcol[64];
#pragma unroll
        for (int e = 0; e < 64; ++e) wcol[e] = p.in[22][e * 2048 + n];
        const float delta = dlo + (dhi - dlo) * ((float)c / 1023.f);
        float asum = 0.f;
        for (int pp = 0; pp < 32; ++pp) { float a = 0.f;
#pragma unroll
            for (int e = 0; e < 64; ++e) a += h2[pp * 64 + e] * wcol[e];
            const int pos = p0 + pp; const float t = (float)pos / (float)(L - 1); a *= expf(-t * delta);
            if (!(back && pos == 0)) { asum += fabsf(a); const int lag = back ? -pos : pos; G[(size_t)c * (2 * L) + (L - lag)] = f2bf(a); } }
        nrm[n] = asum; }
    if (p0 == 0) for (int c = tid; c < 1024; c += 512) G[(size_t)c * (2 * L)] = 0;
    __syncthreads();
}

DEV void phase_prep(const Params& p, unsigned char* shm) {
    const int tid = tidx(); float* sm = (float*)shm;
    if (blockIdx.x == 0 && tid == 0) *(unsigned*)(p.ws + OFF_SMALL + SMALL_BYTES) = 0u;
    { u16* LW = (u16*)(p.ws + OFF_LW); u16* G2T = (u16*)(p.ws + OFF_G2T);
        for (int i = blockIdx.x * 512 + tid; i < 4 * 1024 * 64 + 1024 * 128; i += gridDim.x * 512) {
            if (i < 262144) { const int mi = i >> 16, n = (i >> 6) & 1023, r = i & 63; LW[i] = f2bf((mi < 2 ? p.in[27] : p.in[29])[((size_t)(mi & 1) * 64 + r) * 1024 + n]); }
            else { const int j = i - 262144; const int n = j >> 7, r = j & 127; G2T[j] = f2bf(p.in[30][(size_t)r * 1024 + n]); } } }
    const int n0 = 136, n1 = n0 + 384, n2 = n1 + 3328, n3 = n2 + 1024, n4 = n3 + 5632, n5 = n4 + 2816;
    for (int t = blockIdx.x; t < n5; t += gridDim.x) {
        if (t < n0) hyfilt_tile(p, t, sm);
        else if (t < n1) adaln_tile(p, t - n0, sm);
        else if (t < n2) conv_job(p, 0, 0, t - n1, sm);
        else if (t < n3) conv_job(p, 1, 0, t - n2, sm);
        else if (t < n4) conv_job(p, 2, 0, t - n3, sm);
        else conv_job(p, 3, 0, t - n4, sm);
    }
}

DEV void phase_reduce(const Params& p) {
    const float* part = (const float*)(p.ws + OFF_A); float* mods = (float*)(p.ws + OFF_SMALL); float* hn = (float*)(p.ws + OFF_SMALL + 491520);
    for (int i = blockIdx.x * 512 + tidx(); i < 122880 + 2048; i += gridDim.x * 512) {
        if (i < 122880) { float a = 0.f; for (int kc = 0; kc < 32; ++kc) a += part[(size_t)kc * 122880 + i]; mods[i] = a; }
        else { const int j = i - 122880; const int c = j & 1023; const float* hp = part + 32 * 122880; float a = 0.f;
            if (j < 1024) { for (int t = 0; t < 128; ++t) a += hp[(size_t)t * 2048 + c] + hp[(size_t)t * 2048 + 1024 + c]; }
            else { for (int t = 128; t < 136; ++t) a += hp[(size_t)t * 2048 + c] + hp[(size_t)t * 2048 + 1024 + c]; }
            hn[j] = a; }
    }
}

DEV void phase_norm(const Params& p, int layer, int which, unsigned char* shm) {
    const int tid = tidx(), wid = tid >> 6, lane = tid & 63;
    const float* g = p.in[which ? 9 : 8] + layer * 2048;
    const float* X = p.out; u16* A = (u16*)(p.ws + OFF_A);
    const float* mods = (const float*)(p.ws + OFF_SMALL) + (size_t)layer * 5 * 12288; const float* bb = p.in[7] + layer * 12288;
    const int shi = which ? 3 : 0;
    const int nw = gridDim.x * 8, wv = blockIdx.x * 8 + wid; const int per = (NTOK + nw - 1) / nw; const int r0 = wv * per, r1 = (r0 + per < NTOK) ? r0 + per : NTOK;
    const bool first = (layer == 0 && which == 0);
    int cur = -1; float4 Am[8], Bm[8];
    for (int row = r0; row < r1; ++row) {
        const int cond = tok_cond(row);
        if (cond != cur) { cur = cond; const float* md = mods + (size_t)cond * 12288;
#pragma unroll
            for (int j = 0; j < 8; ++j) { const int col = (lane + 64 * j) * 4;
                const float4 gg = *(const float4*)(g + col);
                const float4 s1 = *(const float4*)(md + shi * 2048 + col), s2 = *(const float4*)(bb + shi * 2048 + col);
                const float4 c1 = *(const float4*)(md + (shi + 1) * 2048 + col), c2 = *(const float4*)(bb + (shi + 1) * 2048 + col);
                Am[j] = make_float4(gg.x * (1.f + c1.x + c2.x), gg.y * (1.f + c1.y + c2.y), gg.z * (1.f + c1.z + c2.z), gg.w * (1.f + c1.w + c2.w));
                Bm[j] = make_float4(s1.x + s2.x, s1.y + s2.y, s1.z + s2.z, s1.w + s2.w); } }
        const float* xsrc = X + (size_t)row * DM; if (first) xsrc = row < NTP ? p.in[0] + (size_t)row * DM : p.in[1] + (size_t)(row - NTP) * DM;
        const float4* xr = (const float4*)xsrc;
        float4 v[8]; float ss = 0.f;
#pragma unroll
        for (int j = 0; j < 8; ++j) { v[j] = xr[lane + 64 * j]; ss += v[j].x * v[j].x + v[j].y * v[j].y + v[j].z * v[j].z + v[j].w * v[j].w; }
        if (first) {
#pragma unroll
            for (int j = 0; j < 8; ++j) ((float4*)(p.out + (size_t)row * DM))[lane + 64 * j] = v[j]; }
        ss = wave_sum(ss);
        const float rstd = rsqrtf(ss * (1.f / 2048.f) + 1e-6f);
#pragma unroll
        for (int j = 0; j < 8; ++j) { const int col = (lane + 64 * j) * 4;
            u32x2 o; o.x = pk(v[j].x * rstd * Am[j].x + Bm[j].x, v[j].y * rstd * Am[j].y + Bm[j].y); o.y = pk(v[j].z * rstd * Am[j].z + Bm[j].z, v[j].w * rstd * Am[j].w + Bm[j].w);
            *(u32x2*)(A + (size_t)row * DM + col) = o; }
    }
    if (layer == 0 && which == 1) { const int na = conv_ntiles(0, 1), nb = na + conv_ntiles(1, 1);
        for (int t = blockIdx.x; t < nb; t += gridDim.x) { if (t < na) conv_job(p, 0, 1, t, (float*)shm); else conv_job(p, 1, 1, t - na, (float*)shm); } }
    if (layer == 1 && which == 0) { const int na = conv_ntiles(2, 1), nb = na + conv_ntiles(3, 1);
        for (int t = blockIdx.x; t < nb; t += gridDim.x) { if (t < na) conv_job(p, 2, 1, t, (float*)shm); else conv_job(p, 3, 1, t - na, (float*)shm); } }
}

DEV void sconv8(const u16* prow, bool hm, bool hp, const float* sw, const float* sb, int ch, float* o) {
    float c[8], m[8], q[8];
    unpack8(*(const u32x4*)(prow + ch), c);
    if (hm) unpack8(*(const u32x4*)(prow - LDP0 + ch), m); else { for (int i = 0; i < 8; ++i) m[i] = 0.f; }
    if (hp) unpack8(*(const u32x4*)(prow + LDP0 + ch), q); else { for (int i = 0; i < 8; ++i) q[i] = 0.f; }
#pragma unroll
    for (int i = 0; i < 8; ++i) o[i] = m[i] * sw[ch + i] + c[i] * sw[3072 + ch + i] + q[i] * sw[6144 + ch + i] + sb[ch + i];
}
DEV void hy_pre_tile(const Params& p, int tile, float* T) {
    const int tid = tidx(); const int tok0 = (tile >> 4) << 6, c0 = (tile & 15) << 6;
    const u16* P = (const u16*)(p.ws + OFF_P); u16* uT = (u16*)(p.ws + OFF_UT);
    { const int tk = tid >> 3, c8 = (tid & 7) << 3; const int tok = tok0 + tk; int t, L; tok_tl(tok, t, L);
        const u16* prow = P + (size_t)tok * LDP0; float x1[8], vv[8];
        sconv8(prow, t > 0, t < L - 1, p.in[16], p.in[17], 1024 + c0 + c8, x1);
        sconv8(prow, t > 0, t < L - 1, p.in[16], p.in[17], 2048 + c0 + c8, vv);
#pragma unroll
        for (int i = 0; i < 8; ++i) T[tk * 65 + c8 + i] = x1[i] * vv[i]; }
    __syncthreads();
    { const int ch = tid >> 3, t8 = (tid & 7) << 3; const float* t = T + t8 * 65 + ch;
        u32x4 o; o.x = pk(t[0], t[65]); o.y = pk(t[130], t[195]); o.z = pk(t[260], t[325]); o.w = pk(t[390], t[455]);
        *(u32x4*)(uT + (size_t)(c0 + ch) * NTOK + tok0 + t8) = o; }
    __syncthreads();
}
DEV void hy_post_tile(const Params& p, int tile, float* T) {
    const int tid = tidx(); const int tok0 = (tile >> 4) << 6, c0 = (tile & 15) << 6;
    const u16* P = (const u16*)(p.ws + OFF_P); const u16* uT = (const u16*)(p.ws + OFF_UT); u16* ycat = (u16*)(p.ws + OFF_A);
    { const int ch = tid >> 3, t8 = (tid & 7) << 3; float y[8]; unpack8(*(const u32x4*)(uT + (size_t)(c0 + ch) * NTOK + tok0 + t8), y);
#pragma unroll
        for (int i = 0; i < 8; ++i) T[(t8 + i) * 65 + ch] = y[i]; }
    __syncthreads();
    { const int tk = tid >> 3, c8 = (tid & 7) << 3; const int tok = tok0 + tk; int t, L; tok_tl(tok, t, L);
        const u16* prow = P + (size_t)tok * LDP0; float x0[8], x1[8], vv[8], o[8];
        sconv8(prow, t > 0, t < L - 1, p.in[16], p.in[17], c0 + c8, x0);
        sconv8(prow, t > 0, t < L - 1, p.in[16], p.in[17], 1024 + c0 + c8, x1);
        sconv8(prow, t > 0, t < L - 1, p.in[16], p.in[17], 2048 + c0 + c8, vv);
        const float* nrm = (const float*)(p.ws + OFF_SMALL + 491520) + (tok < NTP ? 1024 : 0);
#pragma unroll
        for (int i = 0; i < 8; ++i) { const int c = c0 + c8 + i; o[i] = x0[i] * (T[tk * 65 + c8 + i] * __builtin_amdgcn_rcpf(nrm[c]) + x1[i] * vv[i] * p.in[24][c]); }
        u32x4 w; w.x = pk(o[0], o[1]); w.y = pk(o[2], o[3]); w.z = pk(o[4], o[5]); w.w = pk(o[6], o[7]);
        *(u32x4*)(ycat + (size_t)tok * DM + c0 + c8) = w; }
    __syncthreads();
}
DEV void hyconv_task(const Params& p, int task, unsigned char* shm) {
    const int tid = tidx(), wid = tid >> 6, lane = tid & 63;
    const bool sample = task < 1024; const int c = sample ? task : task - 1024;
    const int L = sample ? 4096 : 256, NB = sample ? 4 : 32, lgNB = sample ? 2 : 5, LP = L + 8;
    u16* uL = (u16*)shm; u16* gL = uL + NB * LP; u16* gS = gL + 2 * L;
    const u16* G = sample ? (const u16*)(p.ws + OFF_GS) + (size_t)c * 8192 : (const u16*)(p.ws + OFF_GP) + (size_t)c * 512;
    u16* uT = (u16*)(p.ws + OFF_UT) + (size_t)c * NTOK + (sample ? NTP : 0);
    for (int i = tid * 8; i < NB * L; i += 4096) { const int b = i / L, s = i % L; *(u32x4*)(uL + b * LP + s) = *(const u32x4*)(uT + i); }
    for (int i = tid * 8; i < 2 * L; i += 4096) { const u32x4 w = *(const u32x4*)(G + i); *(u32x4*)(gL + i) = w;
        const unsigned nx = (i + 8 < 2 * L) ? (unsigned)G[i + 8] : 0u;
        u32x4 sft; sft.x = (w.x >> 16) | (w.y << 16); sft.y = (w.y >> 16) | (w.z << 16); sft.z = (w.z >> 16) | (w.w << 16); sft.w = (w.w >> 16) | (nx << 16);
        *(u32x4*)(gS + i) = sft; }
    __syncthreads();
    const int ntile = (NB * (L >> 5)) >> 5;
    const int npair = sample ? 8 : 8; const bool two = sample;
    const int r = lane & 31, half = lane >> 5;
    {
        const int ct0 = two ? 2 * wid : wid;
        const int colA = ct0 * 32 + r, colB = colA + 32;
        const int bA = colA & (NB - 1), iA = colA >> lgNB, bB = colB & (NB - 1), iB = colB >> lgNB; const int tA = iA * 32, tB = iB * 32;
        const int i_lo = (ct0 * 32) >> lgNB, i_hi = ((two ? ct0 + 1 : ct0) * 32 + 31) >> lgNB;
        const int d_lo = 32 * i_lo - (L - 16), d_hi = 32 * i_hi;
        f32x16 accA, accB;
#pragma unroll
        for (int j = 0; j < 16; ++j) { accA[j] = 0.f; accB[j] = 0.f; }
        const u16* ubA = uL + bA * LP + 8 * half; const u16* ubB = uL + bB * LP + 8 * half;
        const u16* gsel = (r & 1) ? gS : gL;
        const int qb = (L - r + 8 * half) & ~1;
#pragma unroll 4
        for (int dl = d_lo; dl <= d_hi; dl += 16) {
            const unsigned* gq = (const unsigned*)(gsel + (qb - dl));
            u32x4 aw; aw.x = gq[0]; aw.y = gq[1]; aw.z = gq[2]; aw.w = gq[3];
            const bf16x8 a = __builtin_bit_cast(bf16x8, aw);
            const int sA = tA - dl, sB = tB - dl;
            bf16x8 bvA = (bf16x8){0, 0, 0, 0, 0, 0, 0, 0}, bvB = bvA;
            if (sA >= 0 && sA <= L - 16) bvA = *(const bf16x8*)(ubA + sA);
            accA = __builtin_amdgcn_mfma_f32_32x32x16_bf16(a, bvA, accA, 0, 0, 0);
            if (two) { if (sB >= 0 && sB <= L - 16) bvB = *(const bf16x8*)(ubB + sB);
                accB = __builtin_amdgcn_mfma_f32_32x32x16_bf16(a, bvB, accB, 0, 0, 0); }
        }
#pragma unroll
        for (int g = 0; g < 4; ++g) { u32x2 w; w.x = pk(accA[4 * g], accA[4 * g + 1]); w.y = pk(accA[4 * g + 2], accA[4 * g + 3]);
            *(u32x2*)(uT + (size_t)bA * L + tA + 8 * g + 4 * half) = w; }
        if (two) {
#pragma unroll
            for (int g = 0; g < 4; ++g) { u32x2 w; w.x = pk(accB[4 * g], accB[4 * g + 1]); w.y = pk(accB[4 * g + 2], accB[4 * g + 3]);
                *(u32x2*)(uT + (size_t)bB * L + tB + 8 * g + 4 * half) = w; } }
    }
    (void)ntile; (void)npair;
    __syncthreads();
}

DEV void rwkv_lora_tile(const Params& p, int tile, unsigned char* shm) {
    const int tid = tidx(), wid = tid >> 6, lane = tid & 63, l15 = lane & 15, quad = lane >> 4; const int tok0 = tile * 32;
    const u16* P = (const u16*)(p.ws + OFF_P); u16* RW = (u16*)(p.ws + OFF_RW); const u16* LW = (const u16*)(p.ws + OFF_LW);
    u16* Ain = (u16*)shm;
    u16* Ol = (u16*)(shm + 18432);
    for (int i = tid; i < 32 * 256; i += 512) { const int tk = i >> 8, cc = i & 255; const int tok = tok0 + tk; int t, L; tok_tl(tok, t, L);
        const u16* pp = P + (size_t)tok * LDP0 + 6144 + cc; float x = bf2f(*pp); const float xm = t > 0 ? bf2f(pp[-LDP0]) : 0.f; const float xp = t < L - 1 ? bf2f(pp[LDP0]) : 0.f;
        const float mu = p.in[25][3072 + cc]; x = x + mu * (0.5f * (xm + xp) - x); if (cc < 128) x = tanhf(x);
        Ain[((cc >> 6) * 32 + tk) * 72 + (cc & 63)] = f2bf(x); }
    __syncthreads();
#pragma unroll 1
    for (int mi = 0; mi < 4; ++mi) {
        const float* bias = (mi < 2 ? p.in[26] : p.in[28]) + (mi & 1) * 1024;
        const float osc = mi < 2 ? 0.6065306597f : 1.f;
        bf16x8 af[2][2];
#pragma unroll
        for (int tt = 0; tt < 2; ++tt)
#pragma unroll
            for (int ks = 0; ks < 2; ++ks) af[tt][ks] = *(const bf16x8*)(Ain + (mi * 32 + tt * 16 + l15) * 72 + ks * 32 + quad * 8);
#pragma unroll 2
        for (int q = 0; q < 8; ++q) { const int nt = wid * 8 + q; const int n = nt * 16 + l15;
            const bf16x8 b0 = *(const bf16x8*)(LW + ((size_t)mi * 1024 + n) * 64 + quad * 8), b1 = *(const bf16x8*)(LW + ((size_t)mi * 1024 + n) * 64 + 32 + quad * 8);
            const float bs = bias[n];
#pragma unroll
            for (int tt = 0; tt < 2; ++tt) { f32x4 acc = (f32x4){0.f, 0.f, 0.f, 0.f}; acc = mfma16(af[tt][0], b0, acc); acc = mfma16(af[tt][1], b1, acc);
#pragma unroll
                for (int r = 0; r < 4; ++r) Ol[(tt * 16 + quad * 4 + r) * 1032 + n] = f2bf(osc * sigm(acc[r] + bs)); } }
        __syncthreads();
#pragma unroll
        for (int i = 0; i < 8; ++i) { const int piece = tid + 512 * i; const int tk = piece >> 7, c8 = (piece & 127) * 8;
            *(u32x4*)(RW + (size_t)(tok0 + tk) * 4096 + mi * 1024 + c8) = *(const u32x4*)(Ol + tk * 1032 + c8); }
        __syncthreads();
    }
}
DEV float mixf(float c, float m, float q, float mu) { return c + mu * (0.5f * (m + q) - c); }
DEV void rwkv_scan_task(const Params& p, int task, float* sm) {
    const bool sample = task < 128; const int tt_ = sample ? task : task - 128;
    const int b = tt_ >> 5, h = (tt_ >> 1) & 15, dir = tt_ & 1;
    const int L = sample ? 4096 : 256; const int tok0 = sample ? NTP + b * 4096 : b * 256;
    const int tid = tidx(), wid = tid >> 6, lane = tid & 63;
    const int kl = lane & 7;
    const int row2 = (wid & 3) * 16 + (lane >> 3) * 2;
    float S[8], T[8];
    const size_t so2 = ((((size_t)b * 2 + dir) * 16 + h) * 64 + row2) * 64 + kl * 8;
    if (sample) {
        const float4 a = *(const float4*)(p.in[2] + so2), c = *(const float4*)(p.in[2] + so2 + 4), d = *(const float4*)(p.in[2] + so2 + 64), e = *(const float4*)(p.in[2] + so2 + 68);
        S[0] = a.x; S[1] = a.y; S[2] = a.z; S[3] = a.w; S[4] = c.x; S[5] = c.y; S[6] = c.z; S[7] = c.w;
        T[0] = d.x; T[1] = d.y; T[2] = d.z; T[3] = d.w; T[4] = e.x; T[5] = e.y; T[6] = e.z; T[7] = e.w; }
    else {
#pragma unroll
        for (int i = 0; i < 8; ++i) { S[i] = 0.f; T[i] = 0.f; } }
    f32x2 S2[4], T2[4];
#pragma unroll
    for (int i = 0; i < 4; ++i) { S2[i] = (f32x2){S[2 * i], S[2 * i + 1]}; T2[i] = (f32x2){T[2 * i], T[2 * i + 1]}; }
    const int pk4 = (tid & 15) * 4; const int ch = h * 64 + pk4; const int plt = (tid & 255) >> 4;
    const float4 mur = *(const float4*)(p.in[25] + ch), muk = *(const float4*)(p.in[25] + 1024 + ch), muv = *(const float4*)(p.in[25] + 2048 + ch);
    const float4 kkw = *(const float4*)(p.in[31] + ch), kaw = *(const float4*)(p.in[32] + ch);
    const float murA[4] = {mur.x, mur.y, mur.z, mur.w}, mukA[4] = {muk.x, muk.y, muk.z, muk.w}, muvA[4] = {muv.x, muv.y, muv.z, muv.w};
    const float kkwA[4] = {kkw.x, kkw.y, kkw.z, kkw.w}, kawA[4] = {kaw.x, kaw.y, kaw.z, kaw.w};
    const u16* P = (const u16*)(p.ws + OFF_P); const u16* RW = (const u16*)(p.ws + OFF_RW);
    u16* Y = (u16*)(p.out + OUT_GLAST) + (dir ? (size_t)NTOK * 1024 : 0);
#define RW_PREP(c0_, buf_) do { float* vec_ = sm + (buf_) * 14336; float* vvs_ = vec_ + 10240; \
        _Pragma("unroll 1") for (int ps = 0; ps < 2; ++ps) { const int ptt = plt + 16 * ps; \
            const int t = dir ? (L - 1 - ((c0_) + ptt)) : ((c0_) + ptt); const size_t tok = (size_t)tok0 + t; \
            const u16* pr = P + tok * LDP0 + 3072 + ch; \
            float rc[4], kc[4], vc[4], rm[4], km[4], vm[4], rp[4], kp[4], vp[4], ee[4], aa[4]; \
            unpack4(*(const u32x2*)(pr), rc); unpack4(*(const u32x2*)(pr + 1024), kc); unpack4(*(const u32x2*)(pr + 2048), vc); \
            if (t > 0) { const u16* pm = P + (tok - 1) * LDP0 + 3072 + ch; unpack4(*(const u32x2*)(pm), rm); unpack4(*(const u32x2*)(pm + 1024), km); unpack4(*(const u32x2*)(pm + 2048), vm); } \
            else { for (int i = 0; i < 4; ++i) { rm[i] = 0.f; km[i] = 0.f; vm[i] = 0.f; } } \
            if (t < L - 1) { unpack4(*(const u32x2*)(pr + LDP0), rp); unpack4(*(const u32x2*)(pr + LDP0 + 1024), kp); unpack4(*(const u32x2*)(pr + LDP0 + 2048), vp); } \
            else { for (int i = 0; i < 4; ++i) { rp[i] = 0.f; kp[i] = 0.f; vp[i] = 0.f; } } \
            unpack4(*(const u32x2*)(RW + tok * 4096 + dir * 1024 + ch), ee); unpack4(*(const u32x2*)(RW + tok * 4096 + (2 + dir) * 1024 + ch), aa); \
            float r4[4], k4[4], v4[4], kr[4]; float ss = 0.f; \
            _Pragma("unroll") for (int i = 0; i < 4; ++i) { r4[i] = mixf(rc[i], rm[i], rp[i], murA[i]); k4[i] = mixf(kc[i], km[i], kp[i], mukA[i]); v4[i] = mixf(vc[i], vm[i], vp[i], muvA[i]); \
                kr[i] = k4[i] * kkwA[i]; ss += kr[i] * kr[i]; } \
            ss = sum16(ss); const float inv = rsqrtf(ss + 1e-12f); \
            float tkk[4], tw[4], tkka[4], tkd[4]; \
            _Pragma("unroll") for (int i = 0; i < 4; ++i) { tkk[i] = kr[i] * inv; tw[i] = __expf(-ee[i]); tkka[i] = tkk[i] * aa[i]; tkd[i] = k4[i] * (1.f + (aa[i] - 1.f) * kawA[i]); } \
            float* vj = vec_ + ptt * 320 + pk4; \
            *(float4*)(vj) = make_float4(tkk[0], tkk[1], tkk[2], tkk[3]); *(float4*)(vj + 64) = make_float4(tw[0], tw[1], tw[2], tw[3]); *(float4*)(vj + 128) = make_float4(tkka[0], tkka[1], tkka[2], tkka[3]); \
            *(float4*)(vj + 192) = make_float4(tkd[0], tkd[1], tkd[2], tkd[3]); *(float4*)(vj + 256) = make_float4(r4[0], r4[1], r4[2], r4[3]); \
            *(float4*)(vvs_ + ptt * 64 + pk4) = make_float4(v4[0], v4[1], v4[2], v4[3]); } } while (0)
#define RW_YOUT(c0_, buf_) do { const float* yb_ = sm + (buf_) * 14336 + 12288; \
        _Pragma("unroll 1") for (int ps = 0; ps < 2; ++ps) { const int ptt = plt + 16 * ps; const int t = dir ? (L - 1 - ((c0_) + ptt)) : ((c0_) + ptt); \
            const float4 yv = *(const float4*)(yb_ + ptt * 64 + pk4); u32x2 w; w.x = pk(yv.x, yv.y); w.y = pk(yv.z, yv.w); \
            *(u32x2*)(Y + ((size_t)tok0 + t) * 1024 + ch) = w; } } while (0)
    const int nchunk = L >> 5;
    if (wid >= 4) RW_PREP(0, 0);
    __syncthreads();
#pragma unroll 1
    for (int c = 0; c < nchunk; ++c) {
        if (wid < 4) {
            const float* vec = sm + (c & 1) * 14336; const float* vvs = vec + 10240; float* yb = sm + (c & 1) * 14336 + 12288;
#pragma unroll
            for (int j = 0; j < 32; ++j) {
                const float* vj = vec + j * 320 + kl * 8;
                const f32x4 a0 = *(const f32x4*)(vj), a1 = *(const f32x4*)(vj + 4);
                const f32x4 w0 = *(const f32x4*)(vj + 64), w1 = *(const f32x4*)(vj + 68);
                const f32x4 b0 = *(const f32x4*)(vj + 128), b1 = *(const f32x4*)(vj + 132);
                const f32x4 d0 = *(const f32x4*)(vj + 192), d1 = *(const f32x4*)(vj + 196);
                const f32x4 r0 = *(const f32x4*)(vj + 256), r1 = *(const f32x4*)(vj + 260);
                const float2 vr = *(const float2*)(vvs + j * 64 + row2);
                const f32x2 kk0 = a0.lo, kk1 = a0.hi, kk2 = a1.lo, kk3 = a1.hi;
                f32x2 pa = S2[0] * kk0; pa += S2[1] * kk1; pa += S2[2] * kk2; pa += S2[3] * kk3;
                f32x2 pb = T2[0] * kk0; pb += T2[1] * kk1; pb += T2[2] * kk2; pb += T2[3] * kk3;
                const float sa = -sum8(pa.x + pa.y), sb = -sum8(pb.x + pb.y);
                const f32x2 sa2 = (f32x2){sa, sa}, sb2 = (f32x2){sb, sb}, vx2 = (f32x2){vr.x, vr.x}, vy2 = (f32x2){vr.y, vr.y};
                S2[0] = S2[0] * w0.lo + (sa2 * b0.lo + vx2 * d0.lo); S2[1] = S2[1] * w0.hi + (sa2 * b0.hi + vx2 * d0.hi);
                S2[2] = S2[2] * w1.lo + (sa2 * b1.lo + vx2 * d1.lo); S2[3] = S2[3] * w1.hi + (sa2 * b1.hi + vx2 * d1.hi);
                T2[0] = T2[0] * w0.lo + (sb2 * b0.lo + vy2 * d0.lo); T2[1] = T2[1] * w0.hi + (sb2 * b0.hi + vy2 * d0.hi);
                T2[2] = T2[2] * w1.lo + (sb2 * b1.lo + vy2 * d1.lo); T2[3] = T2[3] * w1.hi + (sb2 * b1.hi + vy2 * d1.hi);
                f32x2 qa = S2[0] * r0.lo; qa += S2[1] * r0.hi; qa += S2[2] * r1.lo; qa += S2[3] * r1.hi;
                f32x2 qb = T2[0] * r0.lo; qb += T2[1] * r0.hi; qb += T2[2] * r1.lo; qb += T2[3] * r1.hi;
                const float y0 = sum8(qa.x + qa.y), y1 = sum8(qb.x + qb.y);
                if (kl == 0) *(float2*)(yb + j * 64 + row2) = make_float2(y0, y1);
            }
        } else {
            if (c > 0) RW_YOUT((c - 1) * 32, (c - 1) & 1);
            if (c + 1 < nchunk) RW_PREP((c + 1) * 32, (c + 1) & 1);
        }
        __syncthreads();
    }
    if (wid >= 4) RW_YOUT((nchunk - 1) * 32, (nchunk - 1) & 1);
#undef RW_PREP
#undef RW_YOUT
#pragma unroll
    for (int i = 0; i < 4; ++i) { S[2 * i] = S2[i].x; S[2 * i + 1] = S2[i].y; T[2 * i] = T2[i].x; T[2 * i + 1] = T2[i].y; }
    if (!sample && wid < 4) { float* so = p.out + OUT_RWST + so2;
        *(float4*)(so) = make_float4(S[0], S[1], S[2], S[3]); *(float4*)(so + 4) = make_float4(S[4], S[5], S[6], S[7]);
        *(float4*)(so + 64) = make_float4(T[0], T[1], T[2], T[3]); *(float4*)(so + 68) = make_float4(T[4], T[5], T[6], T[7]); }
    __syncthreads();
}
DEV void rwkv_post_tile(const Params& p, int tile, float* sm) {
    const int tid = tidx(); const int tok0 = tile * 32;
    const u16* P = (const u16*)(p.ws + OFF_P); const u16* RW = (const u16*)(p.ws + OFF_RW); u16* ycat = (u16*)(p.ws + OFF_A);
    const u16* YF = (const u16*)(p.out + OUT_GLAST); const u16* YB = YF + (size_t)NTOK * 1024;
    u16* Gh = (u16*)(sm + 4096);
    for (int i = tid; i < 32 * 128; i += 512) { const int tk = i >> 7, r = i & 127; const int tok = tok0 + tk; int t, L; tok_tl(tok, t, L);
        const u16* pp = P + (size_t)tok * LDP0 + 6400 + r; const float x = bf2f(*pp); const float xm = t > 0 ? bf2f(pp[-LDP0]) : 0.f; const float xp = t < L - 1 ? bf2f(pp[LDP0]) : 0.f;
        sm[i] = sigm(mixf(x, xm, xp, p.in[25][3328 + r])); }
    __syncthreads();
    { float g0[32], g1[32];
#pragma unroll
        for (int k = 0; k < 32; ++k) { g0[k] = 0.f; g1[k] = 0.f; }
        const float* g2 = p.in[30];
        for (int r = 0; r < 128; r += 4) {
            float wa[4], wb[4];
#pragma unroll
            for (int q = 0; q < 4; ++q) { wa[q] = g2[(r + q) * 1024 + tid]; wb[q] = g2[(r + q) * 1024 + 512 + tid]; }
#pragma unroll
            for (int k = 0; k < 32; ++k) { const float4 s4 = *(const float4*)(sm + k * 128 + r);
                g0[k] += s4.x * wa[0] + s4.y * wa[1] + s4.z * wa[2] + s4.w * wa[3]; g1[k] += s4.x * wb[0] + s4.y * wb[1] + s4.z * wb[2] + s4.w * wb[3]; } }
#pragma unroll
        for (int k = 0; k < 32; ++k) { Gh[k * 1024 + tid] = f2bf(g0[k]); Gh[k * 1024 + 512 + tid] = f2bf(g1[k]); } }
    __syncthreads();
    const int c8 = (tid & 127) * 8;
    float mur[8], muk[8], muv[8], ka[8], rk[8], lw[8], lb[8];
#pragma unroll
    for (int i = 0; i < 8; ++i) { mur[i] = p.in[25][c8 + i]; muk[i] = p.in[25][1024 + c8 + i]; muv[i] = p.in[25][2048 + c8 + i]; ka[i] = p.in[32][c8 + i]; rk[i] = p.in[33][c8 + i]; lw[i] = p.in[34][c8 + i]; lb[i] = p.in[35][c8 + i]; }
#pragma unroll 1
    for (int it = 0; it < 8; ++it) { const int tk = (tid >> 7) + 4 * it; const int tok = tok0 + tk; int t, L; tok_tl(tok, t, L);
        const u16* pr = P + (size_t)tok * LDP0 + 3072 + c8; const bool hm = t > 0, hp = t < L - 1;
        float rc[8], rm[8], rp[8], kc[8], km[8], kp[8], vc[8], vm[8], vp[8], a0[8], a1[8], yf[8], yb[8], gg[8];
        unpack8(*(const u32x4*)pr, rc); unpack8(*(const u32x4*)(pr + 1024), kc); unpack8(*(const u32x4*)(pr + 2048), vc);
        if (hm) { const u16* pm = P + (size_t)(tok - 1) * LDP0 + 3072 + c8; unpack8(*(const u32x4*)(pm), rm); unpack8(*(const u32x4*)(pm + 1024), km); unpack8(*(const u32x4*)(pm + 2048), vm); }
        else { for (int i = 0; i < 8; ++i) { rm[i] = 0.f; km[i] = 0.f; vm[i] = 0.f; } }
        if (hp) { unpack8(*(const u32x4*)(pr + LDP0), rp); unpack8(*(const u32x4*)(pr + LDP0 + 1024), kp); unpack8(*(const u32x4*)(pr + LDP0 + 2048), vp); }
        else { for (int i = 0; i < 8; ++i) { rp[i] = 0.f; kp[i] = 0.f; vp[i] = 0.f; } }
        unpack8(*(const u32x4*)(RW + (size_t)tok * 4096 + 2048 + c8), a0); unpack8(*(const u32x4*)(RW + (size_t)tok * 4096 + 3072 + c8), a1);
        unpack8(*(const u32x4*)(YF + (size_t)tok * 1024 + c8), yf); unpack8(*(const u32x4*)(YB + (size_t)tok * 1024 + c8), yb);
        unpack8(*(const u32x4*)(Gh + tk * 1024 + c8), gg);
        float y[8], v_[8]; float bon = 0.f, sy = 0.f;
#pragma unroll
        for (int i = 0; i < 8; ++i) { const float r_ = mixf(rc[i], rm[i], rp[i], mur[i]), k_ = mixf(kc[i], km[i], kp[i], muk[i]); v_[i] = mixf(vc[i], vm[i], vp[i], muv[i]);
            bon += r_ * k_ * (2.f + (a0[i] + a1[i] - 2.f) * ka[i]) * rk[i]; y[i] = yf[i] + yb[i]; sy += y[i]; }
        bon = sum8(bon); const float mean = sum8(sy) * (1.f / 64.f);
        float sv = 0.f;
#pragma unroll
        for (int i = 0; i < 8; ++i) { y[i] -= mean; sv += y[i] * y[i]; }
        const float rstd = rsqrtf(sum8(sv) * (1.f / 64.f) + 64e-5f);
        float o[8];
#pragma unroll
        for (int i = 0; i < 8; ++i) o[i] = (y[i] * rstd * lw[i] + lb[i] + bon * v_[i]) * gg[i];
        u32x4 w; w.x = pk(o[0], o[1]); w.y = pk(o[2], o[3]); w.z = pk(o[4], o[5]); w.w = pk(o[6], o[7]);
        *(u32x4*)(ycat + (size_t)tok * DM + 1024 + c8) = w; }
    __syncthreads();
}

DEV float logsig(float x) { return fminf(x, 0.f) - __logf(1.f + __expf(-fabsf(x))); }
DEV void gla_intra_task(const Params& p, int task, unsigned char* shm) {
    const int tid = tidx(), wid = tid >> 6, lane = tid & 63, l15 = lane & 15, quad = lane >> 4;
    const int cidx = task >> 2, h = task & 3; const int tok0 = cidx * 64;
    u16* P = (u16*)(p.ws + OFF_P); u16* QB = (u16*)(p.ws + OFF_A); float* Dbuf = (float*)(p.ws + OFF_DB);
    u16* qi = (u16*)shm; u16* ki = qi + 64 * 264; u16* vl = (u16*)shm; u16* Pl = (u16*)(shm + 67584); float* gl = (float*)(shm + 76800); float* tot = (float*)(shm + 84992);
    for (int i = tid; i < 2048; i += 512) { const int tl = i >> 5, c = i & 31; gl[i] = bf2f(P[(size_t)(tok0 + tl) * LDP1 + 6144 + c]); }
    __syncthreads();
    const int k = tid & 255, jh = tid >> 8;
#pragma unroll 1
    for (int dd = 0; dd < 2; ++dd) { const int dir = 1 - dd;
        float g2r[16];
#pragma unroll
        for (int r = 0; r < 16; ++r) g2r[r] = p.in[38][(size_t)(dir * 16 + r) * 1024 + h * 256 + k];
        const float gb = p.in[39][dir * 1024 + h * 256 + k];
        float bl[32]; float run = 0.f;
#pragma unroll
        for (int jj = 0; jj < 32; ++jj) { const int j = jh * 32 + jj; const int tl = dir ? 63 - j : j; const float* gr = gl + tl * 32 + dir * 16;
            float x = gb;
#pragma unroll
            for (int r = 0; r < 16; r += 4) { const float4 g4 = *(const float4*)(gr + r); x += g4.x * g2r[r] + g4.y * g2r[r + 1] + g4.z * g2r[r + 2] + g4.w * g2r[r + 3]; }
            run += logsig(x) * 0.0625f; bl[jj] = run; }
        tot[jh * 256 + k] = run;
        __syncthreads();
        const float t0v = tot[k], t1v = tot[256 + k]; const float off = jh ? t0v : 0.f; const float bref = t0v, blast = t0v + t1v;
        if (jh == 0) Dbuf[((size_t)cidx * 2 + dir) * 1024 + h * 256 + k] = __expf(blast);
        u16* qdst; u16* kdst; size_t ldd;
        if (dir == 0) { qdst = P + h * 256 + k; kdst = P + 1024 + h * 256 + k; ldd = LDP1; } else { qdst = QB + h * 256 + k; kdst = QB + 1024 + h * 256 + k; ldd = 2048; }
#pragma unroll
        for (int jj = 0; jj < 32; ++jj) { const int j = jh * 32 + jj; const int tl = dir ? 63 - j : j; const size_t tok = (size_t)tok0 + tl;
            const float qv = bf2f(P[tok * LDP1 + h * 256 + k]) * 0.0625f, kv = bf2f(P[tok * LDP1 + 1024 + h * 256 + k]);
            const float b = bl[jj] + off;
            qi[j * 264 + k] = f2bf(qv * __expf(b - bref)); ki[j * 264 + k] = f2bf(kv * __expf(bref - b));
            qdst[tok * ldd] = f2bf(qv * __expf(b)); kdst[tok * ldd] = f2bf(kv * __expf(blast - b)); }
        __syncthreads();
        { const int tt = wid >> 1;
#pragma unroll
            for (int q2 = 0; q2 < 2; ++q2) { const int st = (wid & 1) * 2 + q2; f32x4 acc = (f32x4){0.f, 0.f, 0.f, 0.f};
                if (st <= tt) {
#pragma unroll
                    for (int ks = 0; ks < 8; ++ks) { const bf16x8 a = *(const bf16x8*)(qi + (tt * 16 + l15) * 264 + ks * 32 + quad * 8); const bf16x8 b = *(const bf16x8*)(ki + (st * 16 + l15) * 264 + ks * 32 + quad * 8);
                        acc = mfma16(a, b, acc); } }
#pragma unroll
                for (int r = 0; r < 4; ++r) { const int t = tt * 16 + quad * 4 + r, s_ = st * 16 + l15; Pl[t * 72 + s_] = f2bf(s_ <= t ? acc[r] : 0.f); } } }
        __syncthreads();
#pragma unroll
        for (int i = 0; i < 8; ++i) { const int piece = tid + 512 * i; const int j = piece >> 6, c8 = (piece & 63) * 8; const int tl = dir ? 63 - j : j;
            *(u32x4*)(vl + j * 520 + c8) = *(const u32x4*)(P + (size_t)(tok0 + tl) * LDP1 + 2048 + h * 512 + c8); }
        __syncthreads();
        u16* O = (u16*)(p.ws + (dir ? OFF_OB : OFF_OF)) + h * 512;
#pragma unroll 1
        for (int q4 = 0; q4 < 4; ++q4) { const int vt = wid * 4 + q4; f32x4 acc[4];
#pragma unroll
            for (int tt = 0; tt < 4; ++tt) acc[tt] = (f32x4){0.f, 0.f, 0.f, 0.f};
#pragma unroll
            for (int ss = 0; ss < 2; ++ss) { bf16x8 bfr;
#pragma unroll
                for (int jj = 0; jj < 8; ++jj) bfr[jj] = (short)vl[(ss * 32 + quad * 8 + jj) * 520 + vt * 16 + l15];
#pragma unroll
                for (int tt = 0; tt < 4; ++tt) { if (ss * 32 <= tt * 16 + 15) { const bf16x8 a = *(const bf16x8*)(Pl + (tt * 16 + l15) * 72 + ss * 32 + quad * 8); acc[tt] = mfma16(a, bfr, acc[tt]); } } }
#pragma unroll
            for (int tt = 0; tt < 4; ++tt)
#pragma unroll
                for (int r = 0; r < 4; ++r) { const int t = tt * 16 + quad * 4 + r; const int tl = dir ? 63 - t : t; O[(size_t)(tok0 + tl) * DM + vt * 16 + l15] = f2bf(acc[tt][r]); } }
        __syncthreads();
    }
}
DEV void gla_inter_task(const Params& p, int task, unsigned char* shm) {
    const bool sample = task < 256; const int tt_ = sample ? task : task - 256;
    const int seq = tt_ >> 3, vs = tt_ & 7; const int b = seq >> 3, h = (seq >> 1) & 3, dir = seq & 1;
    const int L = sample ? 4096 : 256; const int tok0 = sample ? NTP + b * 4096 : b * 256;
    const int nch = L >> 6, cbase = tok0 >> 6;
    const int tid = tidx(), wid = tid >> 6, lane = tid & 63, l15 = lane & 15, quad = lane >> 4;
    const u16* P = (const u16*)(p.ws + OFF_P); const u16* QB = (const u16*)(p.ws + OFF_A); const float* Dbuf = (const float*)(p.ws + OFF_DB);
    u16* ST = (u16*)shm; u16* qdl = (u16*)(shm + 33792); u16* kdl = (u16*)(shm + 67584); u16* vl = (u16*)(shm + 101376); float* dl = (float*)(shm + 110592);
    f32x4 S[2][4];
    const size_t sbase = (((size_t)b * 2 + dir) * 4 + h) * 256 * 512 + vs * 64;
#pragma unroll
    for (int kt = 0; kt < 2; ++kt)
#pragma unroll
        for (int vt = 0; vt < 4; ++vt)
#pragma unroll
            for (int r = 0; r < 4; ++r) { const int kk = wid * 32 + kt * 16 + quad * 4 + r; S[kt][vt][r] = sample ? p.in[3][sbase + (size_t)kk * 512 + vt * 16 + l15] : 0.f; }
    const u16* qsrc; const u16* ksrc; size_t lds_;
    if (dir == 0) { qsrc = P + h * 256; ksrc = P + 1024 + h * 256; lds_ = LDP1; } else { qsrc = QB + h * 256; ksrc = QB + 1024 + h * 256; lds_ = 2048; }
    const u16* vsrc = P + 2048 + h * 512 + vs * 64;
    u16* O = (u16*)(p.ws + (dir ? OFF_OB : OFF_OF)) + h * 512 + vs * 64;
    u32x4 rq[4], rk[4], rv; float rd = 0.f;
    const int vrow = tid >> 3, vc8 = (tid & 7) * 8;
#define GLA_ISSUE(n_) do { const int cidx_ = cbase + (dir ? nch - 1 - (n_) : (n_)); \
        _Pragma("unroll") for (int i = 0; i < 4; ++i) { const int piece = tid + 512 * i; const int j = piece >> 5, c8 = (piece & 31) * 8; const size_t tok = (size_t)cidx_ * 64 + (dir ? 63 - j : j); \
            rq[i] = *(const u32x4*)(qsrc + tok * lds_ + c8); rk[i] = *(const u32x4*)(ksrc + tok * lds_ + c8); } \
        { const size_t tok = (size_t)cidx_ * 64 + (dir ? 63 - vrow : vrow); rv = *(const u32x4*)(vsrc + tok * LDP1 + vc8); } \
        if (tid < 256) rd = Dbuf[((size_t)cidx_ * 2 + dir) * 1024 + h * 256 + tid]; } while (0)
#define GLA_WRITE_ST() do { _Pragma("unroll") for (int kt = 0; kt < 2; ++kt) _Pragma("unroll") for (int vt = 0; vt < 4; ++vt) { u32x2 w; w.x = pk(S[kt][vt][0], S[kt][vt][1]); w.y = pk(S[kt][vt][2], S[kt][vt][3]); \
            *(u32x2*)(ST + (vt * 16 + l15) * 264 + wid * 32 + kt * 16 + quad * 4) = w; } } while (0)
    GLA_WRITE_ST();
    GLA_ISSUE(0);
    const int tt = wid >> 1, vb = (wid & 1) * 2;
#pragma unroll 1
    for (int n = 0; n < nch; ++n) {
        const int cidx = cbase + (dir ? nch - 1 - n : n);
#pragma unroll
        for (int i = 0; i < 4; ++i) { const int piece = tid + 512 * i; const int j = piece >> 5, c8 = (piece & 31) * 8; *(u32x4*)(qdl + j * 264 + c8) = rq[i]; *(u32x4*)(kdl + j * 264 + c8) = rk[i]; }
        *(u32x4*)(vl + vrow * 72 + vc8) = rv; if (tid < 256) dl[tid] = rd;
        __syncthreads();
        if (n + 1 < nch) GLA_ISSUE(n + 1);
        float oi[2][4];
#pragma unroll
        for (int q2 = 0; q2 < 2; ++q2)
#pragma unroll
            for (int r = 0; r < 4; ++r) { const int j = tt * 16 + quad * 4 + r; const size_t tok = (size_t)cidx * 64 + (dir ? 63 - j : j); oi[q2][r] = bf2f(O[tok * DM + (vb + q2) * 16 + l15]); }
        f32x4 oacc[2]; oacc[0] = (f32x4){0.f, 0.f, 0.f, 0.f}; oacc[1] = oacc[0];
#pragma unroll
        for (int ks = 0; ks < 8; ++ks) { const bf16x8 a = *(const bf16x8*)(qdl + (tt * 16 + l15) * 264 + ks * 32 + quad * 8);
#pragma unroll
            for (int q2 = 0; q2 < 2; ++q2) { const bf16x8 bfr = *(const bf16x8*)(ST + ((vb + q2) * 16 + l15) * 264 + ks * 32 + quad * 8); oacc[q2] = mfma16(a, bfr, oacc[q2]); } }
#pragma unroll
        for (int kt = 0; kt < 2; ++kt) { const f32x4 dv = *(const f32x4*)(dl + wid * 32 + kt * 16 + quad * 4);
#pragma unroll
            for (int vt = 0; vt < 4; ++vt) S[kt][vt] = S[kt][vt] * dv; }
#pragma unroll
        for (int ts = 0; ts < 2; ++ts) { bf16x8 af[2];
#pragma unroll
            for (int kt = 0; kt < 2; ++kt)
#pragma unroll
                for (int jj = 0; jj < 8; ++jj) af[kt][jj] = (short)kdl[(ts * 32 + quad * 8 + jj) * 264 + wid * 32 + kt * 16 + l15];
#pragma unroll
            for (int vt = 0; vt < 4; ++vt) { bf16x8 bfr;
#pragma unroll
                for (int jj = 0; jj < 8; ++jj) bfr[jj] = (short)vl[(ts * 32 + quad * 8 + jj) * 72 + vt * 16 + l15];
#pragma unroll
                for (int kt = 0; kt < 2; ++kt) S[kt][vt] = mfma16(af[kt], bfr, S[kt][vt]); } }
#pragma unroll
        for (int q2 = 0; q2 < 2; ++q2)
#pragma unroll
            for (int r = 0; r < 4; ++r) { const int j = tt * 16 + quad * 4 + r; const size_t tok = (size_t)cidx * 64 + (dir ? 63 - j : j); O[tok * DM + (vb + q2) * 16 + l15] = f2bf(oi[q2][r] + oacc[q2][r]); }
        __syncthreads();
        GLA_WRITE_ST();
        __syncthreads();
    }
#undef GLA_ISSUE
#undef GLA_WRITE_ST
    if (!sample) { float* so = p.out + OUT_GLAST + sbase;
#pragma unroll
        for (int kt = 0; kt < 2; ++kt)
#pragma unroll
            for (int vt = 0; vt < 4; ++vt)
#pragma unroll
                for (int r = 0; r < 4; ++r) { const int kk = wid * 32 + kt * 16 + quad * 4 + r; so[(size_t)kk * 512 + vt * 16 + l15] = S[kt][vt][r]; } }
    __syncthreads();
}
DEV void phase_gla_post(const Params& p) {
    const int tid = tidx(), wid = tid >> 6, lane = tid & 63;
    const u16* P = (const u16*)(p.ws + OFF_P); const u16* OF = (const u16*)(p.ws + OFF_OF); const u16* OB = (const u16*)(p.ws + OFF_OB); u16* ycat = (u16*)(p.ws + OFF_A);
    for (int it = blockIdx.x * 8 + wid; it < NTOK * 4; it += gridDim.x * 8) { const int tok = it >> 2, h = it & 3; const int v8 = lane * 8;
        float a[8], b[8], g[8]; unpack8(*(const u32x4*)(OF + (size_t)tok * DM + h * 512 + v8), a); unpack8(*(const u32x4*)(OB + (size_t)tok * DM + h * 512 + v8), b);
        unpack8(*(const u32x4*)(P + (size_t)tok * LDP1 + 4096 + h * 512 + v8), g);
        float ss = 0.f;
#pragma unroll
        for (int i = 0; i < 8; ++i) { a[i] += b[i]; ss += a[i] * a[i]; }
        ss = wave_sum(ss); const float sc = rsqrtf(ss * (1.f / 512.f) + 1e-6f);
        float o[8];
#pragma unroll
        for (int i = 0; i < 8; ++i) o[i] = a[i] * sc * p.in[40][v8 + i] * (g[i] * sigm(g[i]));
        u32x4 w; w.x = pk(o[0], o[1]); w.y = pk(o[2], o[3]); w.z = pk(o[4], o[5]); w.w = pk(o[6], o[7]);
        *(u32x4*)(ycat + (size_t)tok * DM + h * 512 + v8) = w; }
}

DEV void gate_loadcol(const u16* U, long tokc, int c8, bool colok, bool up, bool dn, int W, float (*dst)[8]) {
    if (colok && up) unpack8(*(const u32x4*)(U + (size_t)(tokc - W) * LDU + c8), dst[0]); else { for (int i = 0; i < 8; ++i) dst[0][i] = 0.f; }
    if (colok) unpack8(*(const u32x4*)(U + (size_t)tokc * LDU + c8), dst[1]); else { for (int i = 0; i < 8; ++i) dst[1][i] = 0.f; }
    if (colok && dn) unpack8(*(const u32x4*)(U + (size_t)(tokc + W) * LDU + c8), dst[2]); else { for (int i = 0; i < 8; ++i) dst[2][i] = 0.f; }
}
DEV void gate_loadraw(const u16* U, long tokc, int c8, bool colok, bool up, bool dn, int W, u32x4* dst) {
    const u32x4 z = (u32x4){0u, 0u, 0u, 0u};
    dst[0] = z; dst[1] = z; dst[2] = z;
    if (colok && up) dst[0] = *(const u32x4*)(U + (size_t)(tokc - W) * LDU + c8);
    if (colok) dst[1] = *(const u32x4*)(U + (size_t)tokc * LDU + c8);
    if (colok && dn) dst[2] = *(const u32x4*)(U + (size_t)(tokc + W) * LDU + c8);
}
DEV void phase_ffn_gate(const Params& p, int layer) {
    u16* U = (u16*)(p.ws + OFF_U); const float* cw = p.in[11] + (size_t)layer * 9 * DFF;
    const int tid_ = tidx(), wid_ = tid_ >> 6, lane_ = tid_ & 63;
    for (int bu = blockIdx.x; bu < 1408 + 704; bu += gridDim.x) {
        int tokS, c8;
        if (bu < 1408) { const int rg = bu / 44, rem = bu % 44; const int qtr = rem / 11, cgg = rem % 11; tokS = NTP + (rg * 8 + wid_) * 64 + qtr * 16; c8 = (cgg * 64 + lane_) * 8; }
        else { const int pu = bu - 1408; const int sg = pu / 11, cgg = pu % 11; tokS = (sg * 8 + wid_) * 16; c8 = (cgg * 64 + lane_) * 8; }
        int W, colS; bool up, dn;
        if (tokS < NTP) { W = 256; colS = tokS & 255; up = false; dn = false; }
        else { W = 64; colS = tokS & 63; const int rr = ((tokS - NTP) >> 6) & 63; up = rr > 0; dn = rr < 63; }
        float wt[9][8];
#pragma unroll
        for (int q = 0; q < 9; ++q) { const float4 a = *(const float4*)(cw + q * DFF + c8), b = *(const float4*)(cw + q * DFF + c8 + 4);
            wt[q][0] = a.x; wt[q][1] = a.y; wt[q][2] = a.z; wt[q][3] = a.w; wt[q][4] = b.x; wt[q][5] = b.y; wt[q][6] = b.z; wt[q][7] = b.w; }
        float w0[3][8], w1[3][8];
        u32x4 r2[3], r3[3], vraw, vnext;
        gate_loadcol(U, (long)tokS - 1, c8, colS > 0, up, dn, W, w0);
        gate_loadcol(U, (long)tokS, c8, true, up, dn, W, w1);
        gate_loadraw(U, (long)tokS + 1, c8, colS + 1 < W, up, dn, W, r2);
        vraw = *(const u32x4*)(U + (size_t)tokS * LDU + DFF + c8); vnext = vraw;
#pragma unroll 2
        for (int s_ = 0; s_ < 16; ++s_) {
            const long tok = (long)tokS + s_;
            if (s_ + 2 <= 16) gate_loadraw(U, tok + 2, c8, colS + s_ + 2 < W, up, dn, W, r3);
            if (s_ + 1 < 16) vnext = *(const u32x4*)(U + (size_t)(tok + 1) * LDU + DFF + c8);
            float w2[3][8]; unpack8(r2[0], w2[0]); unpack8(r2[1], w2[1]); unpack8(r2[2], w2[2]);
            float v[8]; unpack8(vraw, v);
#pragma unroll
            for (int i = 0; i < 8; ++i) { float a = 0.f;
#pragma unroll
                for (int di = 0; di < 3; ++di) a += w0[di][i] * wt[di * 3][i] + w1[di][i] * wt[di * 3 + 1][i] + w2[di][i] * wt[di * 3 + 2][i];
                v[i] *= a * sigm(a); }
            u32x4 w; w.x = pk(v[0], v[1]); w.y = pk(v[2], v[3]); w.z = pk(v[4], v[5]); w.w = pk(v[6], v[7]);
            *(u32x4*)(U + (size_t)tok * LDU + DFF + c8) = w;
#pragma unroll
            for (int di = 0; di < 3; ++di) {
#pragma unroll
                for (int i = 0; i < 8; ++i) { w0[di][i] = w1[di][i]; w1[di][i] = w2[di][i]; }
                r2[di] = r3[di]; }
            vraw = vnext;
        }
    }
}

DEV void phase_final_norm(const Params& p) {
    const int tid = tidx(), wid = tid >> 6, lane = tid & 63; const float* g = p.in[13];
    const int nw = gridDim.x * 8, wv = blockIdx.x * 8 + wid; const int per = (NTOK + nw - 1) / nw; const int r0 = wv * per, r1 = (r0 + per < NTOK) ? r0 + per : NTOK;
    float4 gg[8];
#pragma unroll
    for (int j = 0; j < 8; ++j) gg[j] = *(const float4*)(g + (lane + 64 * j) * 4);
    for (int row = r0; row < r1; ++row) {
        float4* xr = (float4*)(p.out + (size_t)row * DM);
        float4 v[8]; float ss = 0.f;
#pragma unroll
        for (int j = 0; j < 8; ++j) { v[j] = xr[lane + 64 * j]; ss += v[j].x * v[j].x + v[j].y * v[j].y + v[j].z * v[j].z + v[j].w * v[j].w; }
        ss = wave_sum(ss); const float rstd = rsqrtf(ss * (1.f / 2048.f) + 1e-6f);
#pragma unroll
        for (int j = 0; j < 8; ++j) xr[lane + 64 * j] = make_float4(v[j].x * rstd * gg[j].x, v[j].y * rstd * gg[j].y, v[j].z * rstd * gg[j].z, v[j].w * rstd * gg[j].w);
    }
}

#define XB_TMO      128
#define XB_XCNT(j)  (256  + 64 * (j))
#define XB_XSUB(j)  (1280 + 64 * (j))
#define XB_XGEN(j)  (2304 + 64 * (j))
#define XB_TOP      3328
#define XB_TOPGEN   3392
#define XCD_BAR_WORDS 3456
#define XB_SPIN_CAP (1u << 18)
DEV unsigned xb_ld(unsigned* p)              { return __hip_atomic_load(p, __ATOMIC_RELAXED, __HIP_MEMORY_SCOPE_AGENT); }
DEV unsigned xb_add(unsigned* p, unsigned v) { return __hip_atomic_fetch_add(p, v, __ATOMIC_RELAXED, __HIP_MEMORY_SCOPE_AGENT); }
DEV unsigned xb_xcc_id() { return (unsigned)__builtin_amdgcn_s_getreg((3 << 11) | 20) & 0xFu; }
#define XB_SPIN(cond, bar) do { unsigned _sp = 0; while (cond) { __builtin_amdgcn_s_sleep(1); \
    if ((++_sp & 255u) == 0u) { if (xb_ld(&(bar)[XB_TMO])) break; if (_sp > XB_SPIN_CAP) { atomicAdd(&(bar)[XB_TMO], 1u); break; } } } } while (0)
struct XcdBarrier { unsigned* bar; unsigned x; volatile LAS unsigned* st; };
DEV XcdBarrier xcd_barrier_post(unsigned* bar, volatile LAS unsigned* st) {
    XcdBarrier b; b.bar = bar; b.x = xb_xcc_id(); b.st = st;
    if (threadIdx.x == 0) (void)xb_add(&bar[XB_XCNT(b.x)], 1u);
    return b;
}
DEV void xcd_barrier_complete(unsigned* bar, unsigned x, unsigned& nloc, unsigned& nx) {
    const unsigned G = gridDim.x * gridDim.y * gridDim.z;
    unsigned sum, cnt, mine, sp = 0u;
    for (;;) {
        sum = 0u; cnt = 0u; mine = 0u;
#pragma unroll
        for (unsigned j = 0; j < 16; ++j) { const unsigned c = xb_ld(&bar[XB_XCNT(j)]); sum += c; cnt += (c > 0u) ? 1u : 0u; mine = (j == x) ? c : mine; }
        if (sum == G) break;
        __builtin_amdgcn_s_sleep(1);
        if ((++sp & 255u) == 0u) { if (xb_ld(&bar[XB_TMO])) break; if (sp > XB_SPIN_CAP) { atomicAdd(&bar[XB_TMO], 1u); break; } }
    }
    nloc = mine > 0u ? mine : 1u; nx = cnt > 0u ? cnt : 1u;
}
DEV void xcd_barrier(const XcdBarrier& b) {
    asm volatile("s_waitcnt vmcnt(0)" ::: "memory");
    __syncthreads();
    if (threadIdx.x == 0) {
        unsigned* bar = b.bar;
        __builtin_amdgcn_s_waitcnt(0);
        unsigned nloc = b.st[0], nx = b.st[1];
        if (nloc == 0u) { xcd_barrier_complete(bar, b.x, nloc, nx); b.st[0] = nloc; b.st[1] = nx; }
        const unsigned old = xb_add(&bar[XB_XSUB(b.x)], 1u);
        const unsigned gen = old / nloc;
        if (old + 1u == (gen + 1u) * nloc) {
            __builtin_amdgcn_fence(__ATOMIC_RELEASE, "agent");
            asm volatile("s_waitcnt vmcnt(0)" ::: "memory");
            const unsigned og = xb_add(&bar[XB_TOP], 1u);
            const unsigned tg = og / nx;
            if (og + 1u == (tg + 1u) * nx) xb_add(&bar[XB_TOPGEN], 1u);
            else XB_SPIN(xb_ld(&bar[XB_TOPGEN]) == tg, bar);
            __builtin_amdgcn_fence(__ATOMIC_ACQUIRE, "agent");
            xb_add(&bar[XB_XGEN(b.x)], 1u);
            asm volatile("s_waitcnt vmcnt(0)" ::: "memory");
        } else {
            XB_SPIN(xb_ld(&bar[XB_XGEN(b.x)]) == gen, bar);
            __builtin_amdgcn_fence(__ATOMIC_ACQUIRE, "agent");
            asm volatile("s_waitcnt vmcnt(0)" ::: "memory");
        }
    }
    __syncthreads();
}

__global__ void __launch_bounds__(512, 2) mega(Params p0) {
    extern __shared__ __attribute__((aligned(16))) unsigned char shm[];
    cg::grid_group grid = cg::this_grid();
    __shared__ uint4 xb_words;
    if (threadIdx.x == 0) xb_words = make_uint4(0u, 0u, 0u, 0u);
    __syncthreads();
    (void)xcd_barrier_post((unsigned*)(p0.ws + OFF_SMALL + SMALL_BYTES + 256), (volatile LAS unsigned*)&xb_words);
#define XBAR() do { XcdBarrier xb_; xb_.bar = (unsigned*)(launder(p0).ws + OFF_SMALL + SMALL_BYTES + 256); xb_.x = xb_xcc_id(); xb_.st = (volatile LAS unsigned*)&xb_words; xcd_barrier(xb_); } while (0)
    float* sm = (float*)shm;
    const int G = (int)gridDim.x, B = (int)blockIdx.x;

#ifndef SK_PREP
    phase_prep(launder(p0), shm);
#ifdef PROBE_MISC
    __syncthreads(); phase_prep(launder(p0), shm);
#endif
#endif
    grid.sync();
    phase_reduce(launder(p0));
    XBAR();
#pragma unroll 1
    for (int layer = 0; layer < 2; ++layer) {
#ifndef SK_NORM
        phase_norm(launder(p0), layer, 0, shm);
#ifdef PROBE_MISC
        __syncthreads(); phase_norm(launder(p0), layer, 0, shm);
#endif
#endif
        XBAR();
        { const Params p = launder(p0); const u16* A = (const u16*)(p.ws + OFF_A); pg8::EpiBf16 E; E.O = (u16*)(p.ws + OFF_P); E.ldc = layer ? LDP1 : LDP0;
#if !defined(SK_GEMM) && !defined(SK_GBF)
            run_gemm(shm, A, DM, (const u16*)(p.ws + OFF_WIN), DM, layer ? LDP1 : LDP0, DM, E);
#ifdef PROBE_GEMM
            __syncthreads(); run_gemm(shm, A, DM, (const u16*)(p.ws + OFF_WIN), DM, layer ? LDP1 : LDP0, DM, E);
#endif
#endif
        }
        XBAR();
        if (layer == 0) {
#ifndef SK_PRE
            { const Params p = launder(p0); for (int t = B; t < 6144 + 768; t += G) { if (t < 6144) hy_pre_tile(p, t, sm); else rwkv_lora_tile(p, t - 6144, shm); } }
#ifdef PROBE_MISC
            { const Params p = launder(p0); for (int t = B; t < 6144 + 768; t += G) { if (t < 6144) hy_pre_tile(p, t, sm); else rwkv_lora_tile(p, t - 6144, shm); } }
#endif
#endif
            XBAR();
            { const Params p = launder(p0); unsigned* ctr = (unsigned*)(p.ws + OFF_SMALL + SMALL_BYTES);
                for (int t = B; t < 128; t += G) rwkv_scan_task(p, t, sm);
                for (;;) { if (tidx() == 0) *(volatile unsigned*)shm = atomicAdd(ctr, 1u); __syncthreads(); const unsigned t = *(volatile unsigned*)shm; __syncthreads();
                    if (t >= 1024u + 2048u) break;
                    if (t < 1024u) rwkv_scan_task(p, 128 + (int)t, sm); else hyconv_task(p, (int)t - 1024, shm); } }
            XBAR();
#ifndef SK_POST
            { const Params p = launder(p0); for (int t = B; t < 6144 + 768; t += G) { if (t < 6144) hy_post_tile(p, t, sm); else rwkv_post_tile(p, t - 6144, sm); } }
#ifdef PROBE_MISC
            { const Params p = launder(p0); for (int t = B; t < 6144 + 768; t += G) { if (t < 6144) hy_post_tile(p, t, sm); else rwkv_post_tile(p, t - 6144, sm); } }
#endif
#endif
            XBAR();
        } else {
#ifndef SK_GLA
            { const Params p = launder(p0); for (int t = B; t < 1536; t += G) gla_intra_task(p, t, shm); }
            XBAR();
            { const Params p = launder(p0); for (int t = B; t < 256 + 2048; t += G) gla_inter_task(p, t, shm); }
#endif
            XBAR();
#ifndef SK_GLAP
            phase_gla_post(launder(p0));
#ifdef PROBE_MISC
            phase_gla_post(launder(p0));
#endif
#endif
            XBAR();
        }
        { const Params p = launder(p0); const u16* A = (const u16*)(p.ws + OFF_A); const float* mods = (const float*)(p.ws + OFF_SMALL); pg8::EpiRes E; E.X = p.out; E.gm = mods + (size_t)layer * 5 * 12288 + 2 * 2048; E.gb = p.in[7] + layer * 12288 + 2 * 2048;
#if !defined(SK_GEMM) && !defined(SK_GRES)
            run_gemm(shm, A, DM, (const u16*)(p.ws + OFF_WOUT), DM, DM, DM, E);
#endif
        }
        XBAR();
#ifndef SK_NORM
        phase_norm(launder(p0), layer, 1, shm);
#ifdef PROBE_MISC
        __syncthreads(); phase_norm(launder(p0), layer, 1, shm);
#endif
#endif
        XBAR();
        { const Params p = launder(p0); const u16* A = (const u16*)(p.ws + OFF_A); pg8::EpiBf16 E; E.O = (u16*)(p.ws + OFF_U); E.ldc = LDU;
#if !defined(SK_GEMM) && !defined(SK_GBF)
            run_gemm(shm, A, DM, (const u16*)(p.ws + OFF_WUP), DM, LDU, DM, E);
#ifdef PROBE_GEMM
            __syncthreads(); run_gemm(shm, A, DM, (const u16*)(p.ws + OFF_WUP), DM, LDU, DM, E);
#endif
#endif
        }
        XBAR();
#ifndef SK_GATE
        phase_ffn_gate(launder(p0), layer);
#endif
        XBAR();
        { const Params p = launder(p0); const float* mods = (const float*)(p.ws + OFF_SMALL); pg8::EpiRes E; E.X = p.out; E.gm = mods + (size_t)layer * 5 * 12288 + 5 * 2048; E.gb = p.in[7] + layer * 12288 + 5 * 2048;
#if !defined(SK_GEMM) && !defined(SK_GRES)
            run_gemm(shm, (const u16*)(p.ws + OFF_U) + DFF, LDU, (const u16*)(p.ws + OFF_WDN), DFF, DM, DFF, E);
#endif
        }
        XBAR();
    }
    phase_final_norm(launder(p0));
}

extern "C" void kernel_launch(void* const* d_in, const int* in_sizes, int n_in, void* d_out, int out_size, void* d_ws, size_t ws_size, hipStream_t stream) {
    constexpr size_t kDynLds = 131072;
    static int grid_blocks = 0;
    if (!grid_blocks) {
        int dev = 0, cus = 0, per_cu = 0;
        hipGetDevice(&dev);
        hipDeviceGetAttribute(&cus, hipDeviceAttributeMultiprocessorCount, dev);
        hipFuncSetAttribute((const void*)mega, hipFuncAttributeMaxDynamicSharedMemorySize, (int)kDynLds);
        hipOccupancyMaxActiveBlocksPerMultiprocessor(&per_cu, mega, 512, kDynLds);
        if (per_cu < 1) per_cu = 1;
        grid_blocks = cus * per_cu;
        if (grid_blocks > 256) grid_blocks = 256;
    }
    if (ws_size < WS_NEED || n_in < 41) { fprintf(stderr, "workspace too small: %zu < %zu\n", ws_size, WS_NEED); return; }
    Params p{};
    for (int i = 0; i < 41; ++i) p.in[i] = (const float*)d_in[i];
    p.out = (float*)d_out; p.ws = (unsigned char*)d_ws;
    hipMemsetAsync((unsigned char*)d_ws + OFF_SMALL + SMALL_BYTES, 0, 256 + XCD_BAR_BYTES, stream);
    void* args[] = {&p};
    hipError_t e = hipLaunchCooperativeKernel((const void*)mega, dim3(grid_blocks), dim3(512), args, kDynLds, stream);
    if (e != hipSuccess) fprintf(stderr, "cooperative launch failed: %s (grid %d)\n", hipGetErrorString(e), grid_blocks);
}
```

```cpp
#include <hip/hip_runtime.h>
#include <hip/hip_cooperative_groups.h>
#include <cstdio>
namespace cg = cooperative_groups;

#define DEV __device__ __forceinline__
#define LAS __attribute__((address_space(3)))
typedef unsigned short u16;
typedef short bf16x8 __attribute__((ext_vector_type(8)));
typedef float f32x4 __attribute__((ext_vector_type(4)));
typedef float f32x2 __attribute__((ext_vector_type(2)));
typedef float f32x16 __attribute__((ext_vector_type(16)));
typedef unsigned u32x2 __attribute__((ext_vector_type(2)));
typedef unsigned u32x4 __attribute__((ext_vector_type(4)));

constexpr int NTOK = 24576, NTP = 8192, DM = 2048;
constexpr int LDP0 = 6656, LDP1 = 6400, LDU = 11264, DFF = 5632;
constexpr size_t OFF_WIN = 0, OFF_WOUT = 27262976, OFF_WUP = 35651584, OFF_WDN = OFF_WUP + 46137344;
constexpr size_t OFF_A = 104857600, OFF_BIG = 205520896;
constexpr size_t OFF_P = OFF_BIG, OFF_RW = OFF_BIG + 327155712, OFF_UT = OFF_RW + 201326592, OFF_GS = OFF_UT + 50331648, OFF_GP = OFF_GS + 16777216;
constexpr size_t OFF_U = OFF_BIG, OFF_OF = OFF_BIG + 314572800, OFF_OB = OFF_OF + 100663296, OFF_DB = OFF_OB + 100663296;
constexpr size_t OFF_SMALL = OFF_BIG + 600000000, SMALL_BYTES = 491520 + 8192;
constexpr size_t XCD_BAR_BYTES = 3456 * 4;
constexpr size_t OFF_LW = OFF_SMALL + SMALL_BYTES + 256 + XCD_BAR_BYTES;
constexpr size_t OFF_G2T = OFF_LW + 524288;
constexpr size_t WS_NEED = OFF_G2T + 262144;
constexpr size_t OUT_RWST = 50331648, OUT_GLAST = 54525952;

struct Params {
    const float* in[41];
    float* out;
    unsigned char* ws;
};

DEV int tidx() { int t = threadIdx.x; asm volatile("" : "+v"(t)); return t; }
DEV Params launder(const Params& p) { Params q = p; asm volatile("" : "+s"(q.ws), "+s"(q.out)); return q; }
DEV float bf2f(unsigned b) { return __uint_as_float(b << 16); }
DEV float bflo(unsigned w) { return __uint_as_float(w << 16); }
DEV float bfhi(unsigned w) { return __uint_as_float(w & 0xffff0000u); }
DEV unsigned pk(float lo, float hi) { unsigned r; asm("v_cvt_pk_bf16_f32 %0, %1, %2" : "=v"(r) : "v"(lo), "v"(hi)); return r; }
DEV u16 f2bf(float f) { return (u16)(pk(f, 0.f) & 0xffffu); }
DEV float wave_sum(float v) {
#pragma unroll
    for (int o = 32; o > 0; o >>= 1) v += __shfl_xor(v, o);
    return v;
}
template <int CTRL> DEV float dppf(float x) { return __builtin_bit_cast(float, __builtin_amdgcn_update_dpp(0, __builtin_bit_cast(int, x), CTRL, 0xf, 0xf, true)); }
DEV float sum8(float v) { v += dppf<0xB1>(v); v += dppf<0x4E>(v); v += dppf<0x141>(v); return v; }
DEV float sum16(float v) { v = sum8(v); v += dppf<0x140>(v); return v; }
DEV f32x4 mfma16(bf16x8 a, bf16x8 b, f32x4 c) { return __builtin_amdgcn_mfma_f32_16x16x32_bf16(a, b, c, 0, 0, 0); }
DEV float sigm(float x) { return __builtin_amdgcn_rcpf(1.f + __expf(-x)); }
DEV int tok_cond(int tok) { return tok < NTP ? 4 : ((tok - NTP) >> 12); }
DEV void tok_tl(int tok, int& t, int& L) { if (tok < NTP) { t = tok & 255; L = 256; } else { t = (tok - NTP) & 4095; L = 4096; } }
DEV void unpack8(u32x4 w, float* o) { o[0] = bflo(w.x); o[1] = bfhi(w.x); o[2] = bflo(w.y); o[3] = bfhi(w.y); o[4] = bflo(w.z); o[5] = bfhi(w.z); o[6] = bflo(w.w); o[7] = bfhi(w.w); }
DEV void unpack4(u32x2 w, float* o) { o[0] = bflo(w.x); o[1] = bfhi(w.x); o[2] = bflo(w.y); o[3] = bfhi(w.y); }

namespace pg8 {
constexpr int BM = 256, BK = 64, HALF = 128, HTB = HALF * BK * 2, NXCD = 8, WGM = 8;
DEV int lds_byte(int r, int c) { const int st = (r >> 4) * 2 + (c >> 5), rr = r & 15, cc = c & 31, ob = rr * 64 + cc * 2; return st * 1024 + (ob ^ (((ob >> 9) & 1) << 5)); }
DEV void stage_rc(int b, int& R, int& C) { const int st = b / 1024, sb = b % 1024, swz = sb ^ (((sb >> 9) & 1) << 5); R = (st >> 1) * 16 + swz / 64; C = (st & 1) * 32 + (swz % 64) / 2; }
DEV int perm32(int rho) { const int n = rho >> 4, i = rho & 15; return 8 * (i >> 2) + 4 * n + (i & 3); }
struct Unit { int pm, pn; };
struct Gemm { const u16* A; const u16* Bt; int M, N, K, lda, ldb; };
struct StaticOrder {
    int nM, nN, nwg, G, c;
    DEV void init(int M, int N, int G_, int c_) { nM = M / BM; nN = N / BM; nwg = nM * nN; G = G_; c = c_; }
    DEV bool next(int i, Unit& u) const {
        const long L = (long)i * G + c; if (L >= nwg) return false;
        int wgid = (int)L; { const int q = nwg / NXCD, r = nwg % NXCD, xcd = wgid % NXCD, off = wgid / NXCD; wgid = (xcd < r ? xcd * (q + 1) : r * (q + 1) + (xcd - r) * q) + off; }
        const int nig = WGM * nN, gid = wgid / nig, fm = gid * WGM, gsz = (nM - fm) < WGM ? (nM - fm) : WGM;
        u.pm = fm + ((wgid % nig) % gsz); u.pn = (wgid % nig) / gsz; return true;
    }
};
struct EpiBf16 {
    static constexpr bool PERM = true;
    u16* O; int ldc;
    DEV void operator()(const f32x4 (&acc)[2][2][4][2], const Unit& u, int wr, int wc, int fr, int fq) const {
        const int row0 = u.pm * BM + wr * 64 + fr; const int col0 = u.pn * BM + wc * 32 + 8 * fq;
#pragma unroll
        for (int ai = 0; ai < 2; ++ai)
#pragma unroll
            for (int m = 0; m < 4; ++m) { u16* rowp = O + (size_t)(row0 + ai * HALF + m * 16) * ldc + col0;
#pragma unroll
                for (int bj = 0; bj < 2; ++bj) { const f32x4 v0 = acc[ai][bj][m][0], v1 = acc[ai][bj][m][1];
                    u32x4 w; w.x = pk(v0[0], v0[1]); w.y = pk(v0[2], v0[3]); w.z = pk(v1[0], v1[1]); w.w = pk(v1[2], v1[3]);
                    *(u32x4*)(rowp + bj * HALF) = w; } }
    }
};
struct EpiRes {
    static constexpr bool PERM = false;
    float* X; const float* gm; const float* gb;
    DEV void operator()(const f32x4 (&acc)[2][2][4][2], const Unit& u, int wr, int wc, int fr, int fq) const {
        const int row0 = u.pm * BM + wr * 64 + fr, col0 = u.pn * BM + wc * 32 + 4 * fq;
        const int cond = u.pm < 32 ? 4 : ((u.pm - 32) >> 4);
        const float* gmc = gm + (size_t)cond * 12288 + col0; const float* gbc = gb + col0;
        f32x4 gv[2][2];
#pragma unroll
        for (int bj = 0; bj < 2; ++bj)
#pragma unroll
            for (int n = 0; n < 2; ++n) gv[bj][n] = *(const f32x4*)(gmc + bj * HALF + n * 16) + *(const f32x4*)(gbc + bj * HALF + n * 16);
        f32x4 xc[2][2], xn[2][2];
        { float* rowp = X + (size_t)row0 * DM + col0;
#pragma unroll
            for (int bj = 0; bj < 2; ++bj)
#pragma unroll
                for (int n = 0; n < 2; ++n) xc[bj][n] = *(const f32x4*)(rowp + bj * HALF + n * 16); }
#pragma unroll
        for (int gidx = 0; gidx < 8; ++gidx) { const int ai = gidx >> 2, m = gidx & 3;
            float* rowp = X + (size_t)(row0 + ai * HALF + m * 16) * DM + col0;
            if (gidx < 7) { const int ai2 = (gidx + 1) >> 2, m2 = (gidx + 1) & 3; const float* rown = X + (size_t)(row0 + ai2 * HALF + m2 * 16) * DM + col0;
#pragma unroll
                for (int bj = 0; bj < 2; ++bj)
#pragma unroll
                    for (int n = 0; n < 2; ++n) xn[bj][n] = *(const f32x4*)(rown + bj * HALF + n * 16); }
#pragma unroll
            for (int bj = 0; bj < 2; ++bj)
#pragma unroll
                for (int n = 0; n < 2; ++n) *(f32x4*)(rowp + bj * HALF + n * 16) = xc[bj][n] + gv[bj][n] * acc[ai][bj][m][n];
#pragma unroll
            for (int bj = 0; bj < 2; ++bj)
#pragma unroll
                for (int n = 0; n < 2; ++n) xc[bj][n] = xn[bj][n];
        }
    }
};

template <class Epi>
DEV void gemm_phase(LAS unsigned char* lds, const Gemm g, const StaticOrder& S, const Epi& E) {
    const int tid = tidx(), wid = __builtin_amdgcn_readfirstlane(tid >> 6), lane = tid & 63, wr = wid >> 2, wc = wid & 3, fr = lane & 15, fq = lane >> 4;
    const int K = g.K, nt = K / BK;
    unsigned voffA[2], voffB[2];
#pragma unroll
    for (int i = 0; i < 2; ++i) { int R, C; stage_rc(tid * 16 + i * 8192, R, C); const int Rb = Epi::PERM ? ((R & ~31) + perm32(R & 31)) : R;
        voffA[i] = (unsigned)(R * g.lda + C) * 2u; voffB[i] = (unsigned)(Rb * g.ldb + C) * 2u; }
    const size_t kstep = (size_t)(BK * 2);
    const size_t hstepA = (size_t)HALF * g.lda * 2, hstepB = (size_t)HALF * g.ldb * 2;
    const size_t tstepA = 2 * hstepA, tstepB = 2 * hstepB;
    const unsigned ldsw = (unsigned)wid * 1024u;
    const int aoff = lds_byte(wr * 64 + fr, fq * 8), boff = lds_byte(wc * 32 + fr, fq * 8);
#define PG8_SA(b, h) (((b) * 2 + (h)) * HTB)
#define PG8_SB(b, h) ((4 + (b) * 2 + (h)) * HTB)
#define PG8_STAGE(bufoff, gbase, voff) do { _Pragma("unroll") for (int _i = 0; _i < 2; ++_i) \
        __builtin_amdgcn_global_load_lds((const unsigned*)((const char*)(gbase) + (voff)[_i]), (LAS unsigned*)(lds + (bufoff) + ldsw + _i * 8192), 16, 0, 0); } while (0)
#define PG8_LDA(dst, b, h) do { _Pragma("unroll") for (int m = 0; m < 4; ++m) _Pragma("unroll") for (int k = 0; k < 2; ++k) dst[m][k] = *(const LAS bf16x8*)(lds + PG8_SA(b, h) + aoff + m * 2048 + k * 1024); } while (0)
#define PG8_LDB(dst, b, h) do { _Pragma("unroll") for (int n = 0; n < 2; ++n) _Pragma("unroll") for (int k = 0; k < 2; ++k) dst[n][k] = *(const LAS bf16x8*)(lds + PG8_SB(b, h) + boff + n * 2048 + k * 1024); } while (0)
#define PG8_MMA(ai, bj, At, Bt) do { __builtin_amdgcn_s_setprio(1); _Pragma("unroll") for (int m = 0; m < 4; ++m) _Pragma("unroll") for (int n = 0; n < 2; ++n) _Pragma("unroll") for (int k = 0; k < 2; ++k) \
        acc[ai][bj][m][n] = __builtin_amdgcn_mfma_f32_16x16x32_bf16(Bt[n][k], At[m][k], acc[ai][bj][m][n], 0, 0, 0); __builtin_amdgcn_s_setprio(0); } while (0)
#define PG8_WAIT_V(n) asm volatile("s_waitcnt vmcnt(" #n ")" ::: "memory")
#define PG8_WAIT_L(n) asm volatile("s_waitcnt lgkmcnt(" #n ")" ::: "memory")
#define PG8_BAR __builtin_amdgcn_s_barrier()
#define PG8_SCHED __builtin_amdgcn_sched_barrier(0)
    Unit cur, nxt; int ui = 0;
    if (!S.next(0, cur)) return;
    f32x4 acc[2][2][4][2];
#pragma unroll
    for (int a = 0; a < 2; ++a)
#pragma unroll
        for (int b = 0; b < 2; ++b)
#pragma unroll
            for (int m = 0; m < 4; ++m)
#pragma unroll
                for (int n = 0; n < 2; ++n) acc[a][b][m][n] = (f32x4){0.f, 0.f, 0.f, 0.f};
    bf16x8 At[4][2], B0[2][2], B1[2][2];
    const char* cA = (const char*)g.A + (size_t)cur.pm * tstepA; const char* cB = (const char*)g.Bt + (size_t)cur.pn * tstepB;
    PG8_STAGE(PG8_SB(0, 0), cB, voffB); PG8_STAGE(PG8_SA(0, 0), cA, voffA); PG8_STAGE(PG8_SB(0, 1), cB + hstepB, voffB); PG8_STAGE(PG8_SA(0, 1), cA + hstepA, voffA);
    if (wr == 1) PG8_BAR;
    PG8_WAIT_V(4); PG8_BAR;
    PG8_STAGE(PG8_SB(1, 0), cB + kstep, voffB); PG8_STAGE(PG8_SA(1, 0), cA + kstep, voffA); PG8_STAGE(PG8_SB(1, 1), cB + hstepB + kstep, voffB);
    PG8_WAIT_V(6); PG8_BAR;
    for (;;) {
        const bool has_next = S.next(ui + 1, nxt);
        const char* nA = has_next ? (const char*)g.A + (size_t)nxt.pm * tstepA : cA; const char* nB = has_next ? (const char*)g.Bt + (size_t)nxt.pn * tstepB : cB;
        for (int t = 0; t < nt; t += 2) {
            const bool last = (t == nt - 2);
            const char* a1 = cA + (size_t)(t + 1) * kstep;
            const char* a2 = last ? nA : cA + (size_t)(t + 2) * kstep; const char* b2 = last ? nB : cB + (size_t)(t + 2) * kstep;
            const char* a3 = a2 + kstep; const char* b3 = b2 + kstep;
            PG8_LDB(B0, 0, 0); PG8_SCHED; PG8_LDA(At, 0, 0); PG8_STAGE(PG8_SA(1, 1), a1 + hstepA, voffA);
            PG8_WAIT_L(8); PG8_BAR; PG8_WAIT_L(0); PG8_MMA(0, 0, At, B0); PG8_BAR; PG8_SCHED;
            PG8_LDB(B1, 0, 1); PG8_STAGE(PG8_SB(0, 0), b2, voffB);
            PG8_BAR; PG8_WAIT_L(0); PG8_MMA(0, 1, At, B1); PG8_BAR;
            PG8_LDA(At, 0, 1); PG8_STAGE(PG8_SA(0, 0), a2, voffA);
            PG8_BAR; PG8_WAIT_L(0); PG8_MMA(1, 0, At, B0); PG8_BAR; PG8_SCHED;
            PG8_STAGE(PG8_SB(0, 1), b2 + hstepB, voffB);
            PG8_WAIT_V(6); PG8_BAR; PG8_MMA(1, 1, At, B1); PG8_BAR;
            PG8_LDB(B0, 1, 0); PG8_SCHED; PG8_LDA(At, 1, 0); PG8_STAGE(PG8_SA(0, 1), a2 + hstepA, voffA);
            PG8_WAIT_L(8); PG8_BAR; PG8_WAIT_L(0); PG8_MMA(0, 0, At, B0); PG8_BAR; PG8_SCHED;
            PG8_LDB(B1, 1, 1); PG8_STAGE(PG8_SB(1, 0), b3, voffB);
            PG8_BAR; PG8_WAIT_L(0); PG8_MMA(0, 1, At, B1); PG8_BAR;
            PG8_LDA(At, 1, 1); PG8_STAGE(PG8_SA(1, 0), a3, voffA);
            PG8_BAR; PG8_WAIT_L(0); PG8_MMA(1, 0, At, B0); PG8_BAR; PG8_SCHED;
            PG8_STAGE(PG8_SB(1, 1), b3 + hstepB, voffB);
            PG8_WAIT_V(6); PG8_BAR; PG8_MMA(1, 1, At, B1); PG8_BAR;
        }
        E(acc, cur, wr, wc, fr, fq);
        if (!has_next) break;
#pragma unroll
        for (int a = 0; a < 2; ++a)
#pragma unroll
            for (int b = 0; b < 2; ++b)
#pragma unroll
                for (int m = 0; m < 4; ++m)
#pragma unroll
                    for (int n = 0; n < 2; ++n) acc[a][b][m][n] = (f32x4){0.f, 0.f, 0.f, 0.f};
        cur = nxt; cA = nA; cB = nB; ++ui;
    }
    PG8_WAIT_V(0);
    if (wr == 0) PG8_BAR;
    PG8_BAR;
#undef PG8_SA
#undef PG8_SB
#undef PG8_STAGE
#undef PG8_LDA
#undef PG8_LDB
#undef PG8_MMA
#undef PG8_WAIT_V
#undef PG8_WAIT_L
#undef PG8_BAR
#undef PG8_SCHED
}
}

template <class Epi>
DEV void run_gemm(unsigned char* shm, const u16* A, int lda, const u16* Bt, int ldb, int N, int K, const Epi& E) {
    asm volatile("" : "+s"(A), "+s"(Bt));
    pg8::Gemm g; g.A = A; g.Bt = Bt; g.M = NTOK; g.N = N; g.K = K; g.lda = lda; g.ldb = ldb;
    pg8::StaticOrder S; S.init(NTOK, N, (int)gridDim.x, (int)blockIdx.x);
    pg8::gemm_phase<Epi>((LAS unsigned char*)shm, g, S, E);
}

DEV void convT_tile(const float* __restrict__ src, u16* __restrict__ dst, int K, int N, int Npad, int tile, float* T) {
    const int tid = tidx(); const int ntn = Npad >> 6; const int k0 = (tile / ntn) << 6, n0 = (tile % ntn) << 6;
#pragma unroll
    for (int j = 0; j < 2; ++j) { const int idx = tid + j * 512; const int r = idx >> 4, c4 = (idx & 15) << 2;
        float4 v = make_float4(0.f, 0.f, 0.f, 0.f); if (n0 + c4 < N) v = *(const float4*)(src + (size_t)(k0 + r) * N + n0 + c4);
        float* t = T + r * 65 + c4; t[0] = v.x; t[1] = v.y; t[2] = v.z; t[3] = v.w; }
    __syncthreads();
    { const int nn = tid >> 3, kq = (tid & 7) << 3; const float* t = T + kq * 65 + nn;
        u32x4 o; o.x = pk(t[0], t[65]); o.y = pk(t[130], t[195]); o.z = pk(t[260], t[325]); o.w = pk(t[390], t[455]);
        *(u32x4*)(dst + (size_t)(n0 + nn) * K + k0 + kq) = o; }
    __syncthreads();
}
DEV int conv_ntiles(int job, int layer) { return job == 0 ? (layer ? 3200 : 3328) : job == 1 ? 1024 : job == 2 ? 5632 : 2816; }
DEV void conv_job(const Params& p, int job, int layer, int tile, float* T) {
    if (job == 0) convT_tile(layer ? p.in[36] : p.in[14], (u16*)(p.ws + OFF_WIN), 2048, layer ? 6176 : 6528, layer ? LDP1 : LDP0, tile, T);
    else if (job == 1) convT_tile(layer ? p.in[37] : p.in[15], (u16*)(p.ws + OFF_WOUT), 2048, 2048, 2048, tile, T);
    else if (job == 2) convT_tile(p.in[10] + (size_t)layer * 2048 * 11264, (u16*)(p.ws + OFF_WUP), 2048, 11264, 11264, tile, T);
    else convT_tile(p.in[12] + (size_t)layer * 5632 * 2048, (u16*)(p.ws + OFF_WDN), 5632, 2048, 2048, tile, T);
}

DEV void adaln_tile(const Params& p, int tile, float* sl) {
    const int tid = tidx(); const int nt = tile % 6, kc = (tile / 6) & 31, layer = tile / 192;
    if (tid < 320) { const int j = tid >> 6, kk = tid & 63; const float cv = (j < 4) ? p.in[4][j * 2048 + kc * 64 + kk] : p.in[5][kc * 64 + kk]; sl[tid] = cv / (1.f + expf(-cv)); }
    __syncthreads();
    const float* w = p.in[6] + ((size_t)layer * 2048 + kc * 64) * 12288 + nt * 2048 + tid * 4;
    float acc[5][4];
#pragma unroll
    for (int j = 0; j < 5; ++j) { acc[j][0] = 0.f; acc[j][1] = 0.f; acc[j][2] = 0.f; acc[j][3] = 0.f; }
#pragma unroll 8
    for (int kk = 0; kk < 64; ++kk) { const float4 wv = *(const float4*)(w + (size_t)kk * 12288);
#pragma unroll
        for (int j = 0; j < 5; ++j) { const float s = sl[j * 64 + kk]; acc[j][0] += s * wv.x; acc[j][1] += s * wv.y; acc[j][2] += s * wv.z; acc[j][3] += s * wv.w; } }
    float* m = (float*)(p.ws + OFF_A) + (size_t)kc * 122880 + (size_t)layer * 5 * 12288 + nt * 2048 + tid * 4;
#pragma unroll
    for (int j = 0; j < 5; ++j) *(float4*)(m + j * 12288) = make_float4(acc[j][0], acc[j][1], acc[j][2], acc[j][3]);
    __syncthreads();
}

DEV void hyfilt_tile(const Params& p, int tile, float* sm) {
    const int tid = tidx();
    int L, p0; u16* G; float* nrm = (float*)(p.ws + OFF_A) + 32 * 122880 + (size_t)tile * 2048;
    if (tile < 128) { L = 4096; p0 = tile * 32; G = (u16*)(p.ws + OFF_GS); }
    else { L = 256; p0 = (tile - 128) * 32; G = (u16*)(p.ws + OFF_GP); }
    float* z = sm; float* h1 = sm + 32 * 33; float* h2 = h1 + 2048;
    const float cang = (float)(6.283185307179586 / (double)L);
    for (int i = tid; i < 32 * 33; i += 512) { const int pp = i / 33, e = i % 33; const float pos = (float)(p0 + pp); float val;
        if (e == 0) val = pos / (float)(L - 1);
        else { const int bi = (e - 1) & 15; const float fb = 1e-4f + (float)bi * ((15.f - 1e-4f) / 15.f); const float ang = (cang * pos) * fb; val = (e <= 16) ? cosf(ang) : -sinf(ang); }
        z[i] = val; }
    __syncthreads();
    for (int i = tid; i < 2048; i += 512) { const int pp = i >> 6, j = i & 63; float a = p.in[19][j];
        for (int e = 0; e < 33; ++e) a += z[pp * 33 + e] * p.in[18][e * 64 + j];
        h1[i] = sinf(p.in[23][j] * a); }
    __syncthreads();
    for (int i = tid; i < 2048; i += 512) { const int pp = i >> 6, j = i & 63; float a = p.in[21][j];
        for (int e = 0; e < 64; ++e) a += h1[pp * 64 + e] * p.in[20][e * 64 + j];
        h2[i] = sinf(p.in[23][64 + j] * a); }
    __syncthreads();
    const float dlo = 3.0701134573253946f, dhi = 15.350567286626973f;
    for (int q = 0; q < 4; ++q) { const int n = tid + 512 * q; const int c = n & 1023; const int back = n >> 10;
        float wcol[64];
#pragma unroll
        for (int e = 0; e < 64; ++e) wcol[e] = p.in[22][e * 2048 + n];
        const float delta = dlo + (dhi - dlo) * ((float)c / 1023.f);
        float asum = 0.f;
        for (int pp = 0; pp < 32; ++pp) { float a = 0.f;
#pragma unroll
            for (int e = 0; e < 64; ++e) a += h2[pp * 64 + e] * wcol[e];
            const int pos = p0 + pp; const float t = (float)pos / (float)(L - 1); a *= expf(-t * delta);
            if (!(back && pos == 0)) { asum += fabsf(a); const int lag = back ? -pos : pos; G[(size_t)c * (2 * L) + (L - lag)] = f2bf(a); } }
        nrm[n] = asum; }
    if (p0 == 0) for (int c = tid; c < 1024; c += 512) G[(size_t)c * (2 * L)] = 0;
    __syncthreads();
}

DEV void phase_prep(const Params& p, unsigned char* shm) {
    const int tid = tidx(); float* sm = (float*)shm;
    if (blockIdx.x == 0 && tid == 0) *(unsigned*)(p.ws + OFF_SMALL + SMALL_BYTES) = 0u;
    { u16* LW = (u16*)(p.ws + OFF_LW); u16* G2T = (u16*)(p.ws + OFF_G2T);
        for (int i = blockIdx.x * 512 + tid; i < 4 * 1024 * 64 + 1024 * 128; i += gridDim.x * 512) {
            if (i < 262144) { const int mi = i >> 16, n = (i >> 6) & 1023, r = i & 63; LW[i] = f2bf((mi < 2 ? p.in[27] : p.in[29])[((size_t)(mi & 1) * 64 + r) * 1024 + n]); }
            else { const int j = i - 262144; const int n = j >> 7, r = j & 127; G2T[j] = f2bf(p.in[30][(size_t)r * 1024 + n]); } } }
    const int n0 = 136, n1 = n0 + 384, n2 = n1 + 3328, n3 = n2 + 1024, n4 = n3 + 5632, n5 = n4 + 2816;
    for (int t = blockIdx.x; t < n5; t += gridDim.x) {
        if (t < n0) hyfilt_tile(p, t, sm);
        else if (t < n1) adaln_tile(p, t - n0, sm);
        else if (t < n2) conv_job(p, 0, 0, t - n1, sm);
        else if (t < n3) conv_job(p, 1, 0, t - n2, sm);
        else if (t < n4) conv_job(p, 2, 0, t - n3, sm);
        else conv_job(p, 3, 0, t - n4, sm);
    }
}

DEV void phase_reduce(const Params& p) {
    const float* part = (const float*)(p.ws + OFF_A); float* mods = (float*)(p.ws + OFF_SMALL); float* hn = (float*)(p.ws + OFF_SMALL + 491520);
    for (int i = blockIdx.x * 512 + tidx(); i < 122880 + 2048; i += gridDim.x * 512) {
        if (i < 122880) { float a = 0.f; for (int kc = 0; kc < 32; ++kc) a += part[(size_t)kc * 122880 + i]; mods[i] = a; }
        else { const int j = i - 122880; const int c = j & 1023; const float* hp = part + 32 * 122880; float a = 0.f;
            if (j < 1024) { for (int t = 0; t < 128; ++t) a += hp[(size_t)t * 2048 + c] + hp[(size_t)t * 2048 + 1024 + c]; }
            else { for (int t = 128; t < 136; ++t) a += hp[(size_t)t * 2048 + c] + hp[(size_t)t * 2048 + 1024 + c]; }
            hn[j] = a; }
    }
}

DEV void phase_norm(const Params& p, int layer, int which, unsigned char* shm) {
    const int tid = tidx(), wid = tid >> 6, lane = tid & 63;
    const float* g = p.in[which ? 9 : 8] + layer * 2048;
    const float* X = p.out; u16* A = (u16*)(p.ws + OFF_A);
    const float* mods = (const float*)(p.ws + OFF_SMALL) + (size_t)layer * 5 * 12288; const float* bb = p.in[7] + layer * 12288;
    const int shi = which ? 3 : 0;
    const int nw = gridDim.x * 8, wv = blockIdx.x * 8 + wid; const int per = (NTOK + nw - 1) / nw; const int r0 = wv * per, r1 = (r0 + per < NTOK) ? r0 + per : NTOK;
    const bool first = (layer == 0 && which == 0);
    int cur = -1; float4 Am[8], Bm[8];
    for (int row = r0; row < r1; ++row) {
        const int cond = tok_cond(row);
        if (cond != cur) { cur = cond; const float* md = mods + (size_t)cond * 12288;
#pragma unroll
            for (int j = 0; j < 8; ++j) { const int col = (lane + 64 * j) * 4;
                const float4 gg = *(const float4*)(g + col);
                const float4 s1 = *(const float4*)(md + shi * 2048 + col), s2 = *(const float4*)(bb + shi * 2048 + col);
                const float4 c1 = *(const float4*)(md + (shi + 1) * 2048 + col), c2 = *(const float4*)(bb + (shi + 1) * 2048 + col);
                Am[j] = make_float4(gg.x * (1.f + c1.x + c2.x), gg.y * (1.f + c1.y + c2.y), gg.z * (1.f + c1.z + c2.z), gg.w * (1.f + c1.w + c2.w));
                Bm[j] = make_float4(s1.x + s2.x, s1.y + s2.y, s1.z + s2.z, s1.w + s2.w); } }
        const float* xsrc = X + (size_t)row * DM; if (first) xsrc = row < NTP ? p.in[0] + (size_t)row * DM : p.in[1] + (size_t)(row - NTP) * DM;
        const float4* xr = (const float4*)xsrc;
        float4 v[8]; float ss = 0.f;
#pragma unroll
        for (int j = 0; j < 8; ++j) { v[j] = xr[lane + 64 * j]; ss += v[j].x * v[j].x + v[j].y * v[j].y + v[j].z * v[j].z + v[j].w * v[j].w; }
        if (first) {
#pragma unroll
            for (int j = 0; j < 8; ++j) ((float4*)(p.out + (size_t)row * DM))[lane + 64 * j] = v[j]; }
        ss = wave_sum(ss);
        const float rstd = rsqrtf(ss * (1.f / 2048.f) + 1e-6f);
#pragma unroll
        for (int j = 0; j < 8; ++j) { const int col = (lane + 64 * j) * 4;
            u32x2 o; o.x = pk(v[j].x * rstd * Am[j].x + Bm[j].x, v[j].y * rstd * Am[j].y + Bm[j].y); o.y = pk(v[j].z * rstd * Am[j].z + Bm[j].z, v[j].w * rstd * Am[j].w + Bm[j].w);
            *(u32x2*)(A + (size_t)row * DM + col) = o; }
    }
    if (layer == 0 && which == 1) { const int na = conv_ntiles(0, 1), nb = na + conv_ntiles(1, 1);
        for (int t = blockIdx.x; t < nb; t += gridDim.x) { if (t < na) conv_job(p, 0, 1, t, (float*)shm); else conv_job(p, 1, 1, t - na, (float*)shm); } }
    if (layer == 1 && which == 0) { const int na = conv_ntiles(2, 1), nb = na + conv_ntiles(3, 1);
        for (int t = blockIdx.x; t < nb; t += gridDim.x) { if (t < na) conv_job(p, 2, 1, t, (float*)shm); else conv_job(p, 3, 1, t - na, (float*)shm); } }
}

DEV void sconv8(const u16* prow, bool hm, bool hp, const float* sw, const float* sb, int ch, float* o) {
    float c[8], m[8], q[8];
    unpack8(*(const u32x4*)(prow + ch), c);
    if (hm) unpack8(*(const u32x4*)(prow - LDP0 + ch), m); else { for (int i = 0; i < 8; ++i) m[i] = 0.f; }
    if (hp) unpack8(*(const u32x4*)(prow + LDP0 + ch), q); else { for (int i = 0; i < 8; ++i) q[i] = 0.f; }
#pragma unroll
    for (int i = 0; i < 8; ++i) o[i] = m[i] * sw[ch + i] + c[i] * sw[3072 + ch + i] + q[i] * sw[6144 + ch + i] + sb[ch + i];
}
DEV void hy_pre_tile(const Params& p, int tile, float* T) {
    const int tid = tidx(); const int tok0 = (tile >> 4) << 6, c0 = (tile & 15) << 6;
    const u16* P = (const u16*)(p.ws + OFF_P); u16* uT = (u16*)(p.ws + OFF_UT);
    { const int tk = tid >> 3, c8 = (tid & 7) << 3; const int tok = tok0 + tk; int t, L; tok_tl(tok, t, L);
        const u16* prow = P + (size_t)tok * LDP0; float x1[8], vv[8];
        sconv8(prow, t > 0, t < L - 1, p.in[16], p.in[17], 1024 + c0 + c8, x1);
        sconv8(prow, t > 0, t < L - 1, p.in[16], p.in[17], 2048 + c0 + c8, vv);
#pragma unroll
        for (int i = 0; i < 8; ++i) T[tk * 65 + c8 + i] = x1[i] * vv[i]; }
    __syncthreads();
    { const int ch = tid >> 3, t8 = (tid & 7) << 3; const float* t = T + t8 * 65 + ch;
        u32x4 o; o.x = pk(t[0], t[65]); o.y = pk(t[130], t[195]); o.z = pk(t[260], t[325]); o.w = pk(t[390], t[455]);
        *(u32x4*)(uT + (size_t)(c0 + ch) * NTOK + tok0 + t8) = o; }
    __syncthreads();
}
DEV void hy_post_tile(const Params& p, int tile, float* T) {
    const int tid = tidx(); const int tok0 = (tile >> 4) << 6, c0 = (tile & 15) << 6;
    const u16* P = (const u16*)(p.ws + OFF_P); const u16* uT = (const u16*)(p.ws + OFF_UT); u16* ycat = (u16*)(p.ws + OFF_A);
    { const int ch = tid >> 3, t8 = (tid & 7) << 3; float y[8]; unpack8(*(const u32x4*)(uT + (size_t)(c0 + ch) * NTOK + tok0 + t8), y);
#pragma unroll
        for (int i = 0; i < 8; ++i) T[(t8 + i) * 65 + ch] = y[i]; }
    __syncthreads();
    { const int tk = tid >> 3, c8 = (tid & 7) << 3; const int tok = tok0 + tk; int t, L; tok_tl(tok, t, L);
        const u16* prow = P + (size_t)tok * LDP0; float x0[8], x1[8], vv[8], o[8];
        sconv8(prow, t > 0, t < L - 1, p.in[16], p.in[17], c0 + c8, x0);
        sconv8(prow, t > 0, t < L - 1, p.in[16], p.in[17], 1024 + c0 + c8, x1);
        sconv8(prow, t > 0, t < L - 1, p.in[16], p.in[17], 2048 + c0 + c8, vv);
        const float* nrm = (const float*)(p.ws + OFF_SMALL + 491520) + (tok < NTP ? 1024 : 0);
#pragma unroll
        for (int i = 0; i < 8; ++i) { const int c = c0 + c8 + i; o[i] = x0[i] * (T[tk * 65 + c8 + i] * __builtin_amdgcn_rcpf(nrm[c]) + x1[i] * vv[i] * p.in[24][c]); }
        u32x4 w; w.x = pk(o[0], o[1]); w.y = pk(o[2], o[3]); w.z = pk(o[4], o[5]); w.w = pk(o[6], o[7]);
        *(u32x4*)(ycat + (size_t)tok * DM + c0 + c8) = w; }
    __syncthreads();
}
DEV void hyconv_task(const Params& p, int task, unsigned char* shm) {
    const int tid = tidx(), wid = tid >> 6, lane = tid & 63;
    const bool sample = task < 1024; const int c = sample ? task : task - 1024;
    const int L = sample ? 4096 : 256, NB = sample ? 4 : 32, lgNB = sample ? 2 : 5, LP = L + 8;
    u16* uL = (u16*)shm; u16* gL = uL + NB * LP; u16* gS = gL + 2 * L;
    const u16* G = sample ? (const u16*)(p.ws + OFF_GS) + (size_t)c * 8192 : (const u16*)(p.ws + OFF_GP) + (size_t)c * 512;
    u16* uT = (u16*)(p.ws + OFF_UT) + (size_t)c * NTOK + (sample ? NTP : 0);
    for (int i = tid * 8; i < NB * L; i += 4096) { const int b = i / L, s = i % L; *(u32x4*)(uL + b * LP + s) = *(const u32x4*)(uT + i); }
    for (int i = tid * 8; i < 2 * L; i += 4096) { const u32x4 w = *(const u32x4*)(G + i); *(u32x4*)(gL + i) = w;
        const unsigned nx = (i + 8 < 2 * L) ? (unsigned)G[i + 8] : 0u;
        u32x4 sft; sft.x = (w.x >> 16) | (w.y << 16); sft.y = (w.y >> 16) | (w.z << 16); sft.z = (w.z >> 16) | (w.w << 16); sft.w = (w.w >> 16) | (nx << 16);
        *(u32x4*)(gS + i) = sft; }
    __syncthreads();
    const int ntile = (NB * (L >> 5)) >> 5;
    const int npair = sample ? 8 : 8; const bool two = sample;
    const int r = lane & 31, half = lane >> 5;
    {
        const int ct0 = two ? 2 * wid : wid;
        const int colA = ct0 * 32 + r, colB = colA + 32;
        const int bA = colA & (NB - 1), iA = colA >> lgNB, bB = colB & (NB - 1), iB = colB >> lgNB; const int tA = iA * 32, tB = iB * 32;
        const int i_lo = (ct0 * 32) >> lgNB, i_hi = ((two ? ct0 + 1 : ct0) * 32 + 31) >> lgNB;
        const int d_lo = 32 * i_lo - (L - 16), d_hi = 32 * i_hi;
        f32x16 accA, accB;
#pragma unroll
        for (int j = 0; j < 16; ++j) { accA[j] = 0.f; accB[j] = 0.f; }
        const u16* ubA = uL + bA * LP + 8 * half; const u16* ubB = uL + bB * LP + 8 * half;
        const u16* gsel = (r & 1) ? gS : gL;
        const int qb = (L - r + 8 * half) & ~1;
#pragma unroll 4
        for (int dl = d_lo; dl <= d_hi; dl += 16) {
            const unsigned* gq = (const unsigned*)(gsel + (qb - dl));
            u32x4 aw; aw.x = gq[0]; aw.y = gq[1]; aw.z = gq[2]; aw.w = gq[3];
            const bf16x8 a = __builtin_bit_cast(bf16x8, aw);
            const int sA = tA - dl, sB = tB - dl;
            bf16x8 bvA = (bf16x8){0, 0, 0, 0, 0, 0, 0, 0}, bvB = bvA;
            if (sA >= 0 && sA <= L - 16) bvA = *(const bf16x8*)(ubA + sA);
            accA = __builtin_amdgcn_mfma_f32_32x32x16_bf16(a, bvA, accA, 0, 0, 0);
            if (two) { if (sB >= 0 && sB <= L - 16) bvB = *(const bf16x8*)(ubB + sB);
                accB = __builtin_amdgcn_mfma_f32_32x32x16_bf16(a, bvB, accB, 0, 0, 0); }
        }
#pragma unroll
        for (int g = 0; g < 4; ++g) { u32x2 w; w.x = pk(accA[4 * g], accA[4 * g + 1]); w.y = pk(accA[4 * g + 2], accA[4 * g + 3]);
            *(u32x2*)(uT + (size_t)bA * L + tA + 8 * g + 4 * half) = w; }
        if (two) {
#pragma unroll
            for (int g = 0; g < 4; ++g) { u32x2 w; w.x = pk(accB[4 * g], accB[4 * g + 1]); w.y = pk(accB[4 * g + 2], accB[4 * g + 3]);
                *(u32x2*)(uT + (size_t)bB * L + tB + 8 * g + 4 * half) = w; } }
    }
    (void)ntile; (void)npair;
    __syncthreads();
}

DEV void rwkv_lora_tile(const Params& p, int tile, unsigned char* shm) {
    const int tid = tidx(), wid = tid >> 6, lane = tid & 63, l15 = lane & 15, quad = lane >> 4; const int tok0 = tile * 32;
    const u16* P = (const u16*)(p.ws + OFF_P); u16* RW = (u16*)(p.ws + OFF_RW); const u16* LW = (const u16*)(p.ws + OFF_LW);
    u16* Ain = (u16*)shm;
    u16* Ol = (u16*)(shm + 18432);
    for (int i = tid; i < 32 * 256; i += 512) { const int tk = i >> 8, cc = i & 255; const int tok = tok0 + tk; int t, L; tok_tl(tok, t, L);
        const u16* pp = P + (size_t)tok * LDP0 + 6144 + cc; float x = bf2f(*pp); const float xm = t > 0 ? bf2f(pp[-LDP0]) : 0.f; const float xp = t < L - 1 ? bf2f(pp[LDP0]) : 0.f;
        const float mu = p.in[25][3072 + cc]; x = x + mu * (0.5f * (xm + xp) - x); if (cc < 128) x = tanhf(x);
        Ain[((cc >> 6) * 32 + tk) * 72 + (cc & 63)] = f2bf(x); }
    __syncthreads();
#pragma unroll 1
    for (int mi = 0; mi < 4; ++mi) {
        const float* bias = (mi < 2 ? p.in[26] : p.in[28]) + (mi & 1) * 1024;
        const float osc = mi < 2 ? 0.6065306597f : 1.f;
        bf16x8 af[2][2];
#pragma unroll
        for (int tt = 0; tt < 2; ++tt)
#pragma unroll
            for (int ks = 0; ks < 2; ++ks) af[tt][ks] = *(const bf16x8*)(Ain + (mi * 32 + tt * 16 + l15) * 72 + ks * 32 + quad * 8);
#pragma unroll 2
        for (int q = 0; q < 8; ++q) { const int nt = wid * 8 + q; const int n = nt * 16 + l15;
            const bf16x8 b0 = *(const bf16x8*)(LW + ((size_t)mi * 1024 + n) * 64 + quad * 8), b1 = *(const bf16x8*)(LW + ((size_t)mi * 1024 + n) * 64 + 32 + quad * 8);
            const float bs = bias[n];
#pragma unroll
            for (int tt = 0; tt < 2; ++tt) { f32x4 acc = (f32x4){0.f, 0.f, 0.f, 0.f}; acc = mfma16(af[tt][0], b0, acc); acc = mfma16(af[tt][1], b1, acc);
#pragma unroll
                for (int r = 0; r < 4; ++r) Ol[(tt * 16 + quad * 4 + r) * 1032 + n] = f2bf(osc * sigm(acc[r] + bs)); } }
        __syncthreads();
#pragma unroll
        for (int i = 0; i < 8; ++i) { const int piece = tid + 512 * i; const int tk = piece >> 7, c8 = (piece & 127) * 8;
            *(u32x4*)(RW + (size_t)(tok0 + tk) * 4096 + mi * 1024 + c8) = *(const u32x4*)(Ol + tk * 1032 + c8); }
        __syncthreads();
    }
}
DEV float mixf(float c, float m, float q, float mu) { return c + mu * (0.5f * (m + q) - c); }
DEV void rwkv_scan_task(const Params& p, int task, float* sm) {
    const bool sample = task < 128; const int tt_ = sample ? task : task - 128;
    const int b = tt_ >> 5, h = (tt_ >> 1) & 15, dir = tt_ & 1;
    const int L = sample ? 4096 : 256; const int tok0 = sample ? NTP + b * 4096 : b * 256;
    const int tid = tidx(), wid = tid >> 6, lane = tid & 63;
    const int kl = lane & 7;
    const int row2 = (wid & 3) * 16 + (lane >> 3) * 2;
    float S[8], T[8];
    const size_t so2 = ((((size_t)b * 2 + dir) * 16 + h) * 64 + row2) * 64 + kl * 8;
    if (sample) {
        const float4 a = *(const float4*)(p.in[2] + so2), c = *(const float4*)(p.in[2] + so2 + 4), d = *(const float4*)(p.in[2] + so2 + 64), e = *(const float4*)(p.in[2] + so2 + 68);
        S[0] = a.x; S[1] = a.y; S[2] = a.z; S[3] = a.w; S[4] = c.x; S[5] = c.y; S[6] = c.z; S[7] = c.w;
        T[0] = d.x; T[1] = d.y; T[2] = d.z; T[3] = d.w; T[4] = e.x; T[5] = e.y; T[6] = e.z; T[7] = e.w; }
    else {
#pragma unroll
        for (int i = 0; i < 8; ++i) { S[i] = 0.f; T[i] = 0.f; } }
    f32x2 S2[4], T2[4];
#pragma unroll
    for (int i = 0; i < 4; ++i) { S2[i] = (f32x2){S[2 * i], S[2 * i + 1]}; T2[i] = (f32x2){T[2 * i], T[2 * i + 1]}; }
    const int pk4 = (tid & 15) * 4; const int ch = h * 64 + pk4; const int plt = (tid & 255) >> 4;
    const float4 mur = *(const float4*)(p.in[25] + ch), muk = *(const float4*)(p.in[25] + 1024 + ch), muv = *(const float4*)(p.in[25] + 2048 + ch);
    const float4 kkw = *(const float4*)(p.in[31] + ch), kaw = *(const float4*)(p.in[32] + ch);
    const float murA[4] = {mur.x, mur.y, mur.z, mur.w}, mukA[4] = {muk.x, muk.y, muk.z, muk.w}, muvA[4] = {muv.x, muv.y, muv.z, muv.w};
    const float kkwA[4] = {kkw.x, kkw.y, kkw.z, kkw.w}, kawA[4] = {kaw.x, kaw.y, kaw.z, kaw.w};
    const u16* P = (const u16*)(p.ws + OFF_P); const u16* RW = (const u16*)(p.ws + OFF_RW);
    u16* Y = (u16*)(p.out + OUT_GLAST) + (dir ? (size_t)NTOK * 1024 : 0);
#define RW_PREP(c0_, buf_) do { float* vec_ = sm + (buf_) * 14336; float* vvs_ = vec_ + 10240; \
        _Pragma("unroll 1") for (int ps = 0; ps < 2; ++ps) { const int ptt = plt + 16 * ps; \
            const int t = dir ? (L - 1 - ((c0_) + ptt)) : ((c0_) + ptt); const size_t tok = (size_t)tok0 + t; \
            const u16* pr = P + tok * LDP0 + 3072 + ch; \
            float rc[4], kc[4], vc[4], rm[4], km[4], vm[4], rp[4], kp[4], vp[4], ee[4], aa[4]; \
            unpack4(*(const u32x2*)(pr), rc); unpack4(*(const u32x2*)(pr + 1024), kc); unpack4(*(const u32x2*)(pr + 2048), vc); \
            if (t > 0) { const u16* pm = P + (tok - 1) * LDP0 + 3072 + ch; unpack4(*(const u32x2*)(pm), rm); unpack4(*(const u32x2*)(pm + 1024), km); unpack4(*(const u32x2*)(pm + 2048), vm); } \
            else { for (int i = 0; i < 4; ++i) { rm[i] = 0.f; km[i] = 0.f; vm[i] = 0.f; } } \
            if (t < L - 1) { unpack4(*(const u32x2*)(pr + LDP0), rp); unpack4(*(const u32x2*)(pr + LDP0 + 1024), kp); unpack4(*(const u32x2*)(pr + LDP0 + 2048), vp); } \
            else { for (int i = 0; i < 4; ++i) { rp[i] = 0.f; kp[i] = 0.f; vp[i] = 0.f; } } \
            unpack4(*(const u32x2*)(RW + tok * 4096 + dir * 1024 + ch), ee); unpack4(*(const u32x2*)(RW + tok * 4096 + (2 + dir) * 1024 + ch), aa); \
            float r4[4], k4[4], v4[4], kr[4]; float ss = 0.f; \
            _Pragma("unroll") for (int i = 0; i < 4; ++i) { r4[i] = mixf(rc[i], rm[i], rp[i], murA[i]); k4[i] = mixf(kc[i], km[i], kp[i], mukA[i]); v4[i] = mixf(vc[i], vm[i], vp[i], muvA[i]); \
                kr[i] = k4[i] * kkwA[i]; ss += kr[i] * kr[i]; } \
            ss = sum16(ss); const float inv = rsqrtf(ss + 1e-12f); \
            float tkk[4], tw[4], tkka[4], tkd[4]; \
            _Pragma("unroll") for (int i = 0; i < 4; ++i) { tkk[i] = kr[i] * inv; tw[i] = __expf(-ee[i]); tkka[i] = tkk[i] * aa[i]; tkd[i] = k4[i] * (1.f + (aa[i] - 1.f) * kawA[i]); } \
            float* vj = vec_ + ptt * 320 + pk4; \
            *(float4*)(vj) = make_float4(tkk[0], tkk[1], tkk[2], tkk[3]); *(float4*)(vj + 64) = make_float4(tw[0], tw[1], tw[2], tw[3]); *(float4*)(vj + 128) = make_float4(tkka[0], tkka[1], tkka[2], tkka[3]); \
            *(float4*)(vj + 192) = make_float4(tkd[0], tkd[1], tkd[2], tkd[3]); *(float4*)(vj + 256) = make_float4(r4[0], r4[1], r4[2], r4[3]); \
            *(float4*)(vvs_ + ptt * 64 + pk4) = make_float4(v4[0], v4[1], v4[2], v4[3]); } } while (0)
#define RW_YOUT(c0_, buf_) do { const float* yb_ = sm + (buf_) * 14336 + 12288; \
        _Pragma("unroll 1") for (int ps = 0; ps < 2; ++ps) { const int ptt = plt + 16 * ps; const int t = dir ? (L - 1 - ((c0_) + ptt)) : ((c0_) + ptt); \
            const float4 yv = *(const float4*)(yb_ + ptt * 64 + pk4); u32x2 w; w.x = pk(yv.x, yv.y); w.y = pk(yv.z, yv.w); \
            *(u32x2*)(Y + ((size_t)tok0 + t) * 1024 + ch) = w; } } while (0)
    const int nchunk = L >> 5;
    if (wid >= 4) RW_PREP(0, 0);
    __syncthreads();
#pragma unroll 1
    for (int c = 0; c < nchunk; ++c) {
        if (wid < 4) {
            const float* vec = sm + (c & 1) * 14336; const float* vvs = vec + 10240; float* yb = sm + (c & 1) * 14336 + 12288;
#pragma unroll
            for (int j = 0; j < 32; ++j) {
                const float* vj = vec + j * 320 + kl * 8;
                const f32x4 a0 = *(const f32x4*)(vj), a1 = *(const f32x4*)(vj + 4);
                const f32x4 w0 = *(const f32x4*)(vj + 64), w1 = *(const f32x4*)(vj + 68);
                const f32x4 b0 = *(const f32x4*)(vj + 128), b1 = *(const f32x4*)(vj + 132);
                const f32x4 d0 = *(const f32x4*)(vj + 192), d1 = *(const f32x4*)(vj + 196);
                const f32x4 r0 = *(const f32x4*)(vj + 256), r1 = *(const f32x4*)(vj + 260);
                const float2 vr = *(const float2*)(vvs + j * 64 + row2);
                const f32x2 kk0 = a0.lo, kk1 = a0.hi, kk2 = a1.lo, kk3 = a1.hi;
                f32x2 pa = S2[0] * kk0; pa += S2[1] * kk1; pa += S2[2] * kk2; pa += S2[3] * kk3;
                f32x2 pb = T2[0] * kk0; pb += T2[1] * kk1; pb += T2[2] * kk2; pb += T2[3] * kk3;
                const float sa = -sum8(pa.x + pa.y), sb = -sum8(pb.x + pb.y);
                const f32x2 sa2 = (f32x2){sa, sa}, sb2 = (f32x2){sb, sb}, vx2 = (f32x2){vr.x, vr.x}, vy2 = (f32x2){vr.y, vr.y};
                S2[0] = S2[0] * w0.lo + (sa2 * b0.lo + vx2 * d0.lo); S2[1] = S2[1] * w0.hi + (sa2 * b0.hi + vx2 * d0.hi);
                S2[2] = S2[2] * w1.lo + (sa2 * b1.lo + vx2 * d1.lo); S2[3] = S2[3] * w1.hi + (sa2 * b1.hi + vx2 * d1.hi);
                T2[0] = T2[0] * w0.lo + (sb2 * b0.lo + vy2 * d0.lo); T2[1] = T2[1] * w0.hi + (sb2 * b0.hi + vy2 * d0.hi);
                T2[2] = T2[2] * w1.lo + (sb2 * b1.lo + vy2 * d1.lo); T2[3] = T2[3] * w1.hi + (sb2 * b1.hi + vy2 * d1.hi);
                f32x2 qa = S2[0] * r0.lo; qa += S2[1] * r0.hi; qa += S2[2] * r1.lo; qa += S2[3] * r1.hi;
                f32x2 qb = T2[0] * r0.lo; qb += T2[1] * r0.hi; qb += T2[2] * r1.lo; qb += T2[3] * r1.hi;
                const float y0 = sum8(qa.x + qa.y), y1 = sum8(qb.x + qb.y);
                if (kl == 0) *(float2*)(yb + j * 64 + row2) = make_float2(y0, y1);
            }
        } else {
            if (c > 0) RW_YOUT((c - 1) * 32, (c - 1) & 1);
            if (c + 1 < nchunk) RW_PREP((c + 1) * 32, (c + 1) & 1);
        }
        __syncthreads();
    }
    if (wid >= 4) RW_YOUT((nchunk - 1) * 32, (nchunk - 1) & 1);
#undef RW_PREP
#undef RW_YOUT
#pragma unroll
    for (int i = 0; i < 4; ++i) { S[2 * i] = S2[i].x; S[2 * i + 1] = S2[i].y; T[2 * i] = T2[i].x; T[2 * i + 1] = T2[i].y; }
    if (!sample && wid < 4) { float* so = p.out + OUT_RWST + so2;
        *(float4*)(so) = make_float4(S[0], S[1], S[2], S[3]); *(float4*)(so + 4) = make_float4(S[4], S[5], S[6], S[7]);
        *(float4*)(so + 64) = make_float4(T[0], T[1], T[2], T[3]); *(float4*)(so + 68) = make_float4(T[4], T[5], T[6], T[7]); }
    __syncthreads();
}
DEV void rwkv_post_tile(const Params& p, int tile, float* sm) {
    const int tid = tidx(); const int tok0 = tile * 32;
    const u16* P = (const u16*)(p.ws + OFF_P); const u16* RW = (const u16*)(p.ws + OFF_RW); u16* ycat = (u16*)(p.ws + OFF_A);
    const u16* YF = (const u16*)(p.out + OUT_GLAST); const u16* YB = YF + (size_t)NTOK * 1024;
    u16* Gh = (u16*)(sm + 4096);
    for (int i = tid; i < 32 * 128; i += 512) { const int tk = i >> 7, r = i & 127; const int tok = tok0 + tk; int t, L; tok_tl(tok, t, L);
        const u16* pp = P + (size_t)tok * LDP0 + 6400 + r; const float x = bf2f(*pp); const float xm = t > 0 ? bf2f(pp[-LDP0]) : 0.f; const float xp = t < L - 1 ? bf2f(pp[LDP0]) : 0.f;
        sm[i] = sigm(mixf(x, xm, xp, p.in[25][3328 + r])); }
    __syncthreads();
    { float g0[32], g1[32];
#pragma unroll
        for (int k = 0; k < 32; ++k) { g0[k] = 0.f; g1[k] = 0.f; }
        const float* g2 = p.in[30];
        for (int r = 0; r < 128; r += 4) {
            float wa[4], wb[4];
#pragma unroll
            for (int q = 0; q < 4; ++q) { wa[q] = g2[(r + q) * 1024 + tid]; wb[q] = g2[(r + q) * 1024 + 512 + tid]; }
#pragma unroll
            for (int k = 0; k < 32; ++k) { const float4 s4 = *(const float4*)(sm + k * 128 + r);
                g0[k] += s4.x * wa[0] + s4.y * wa[1] + s4.z * wa[2] + s4.w * wa[3]; g1[k] += s4.x * wb[0] + s4.y * wb[1] + s4.z * wb[2] + s4.w * wb[3]; } }
#pragma unroll
        for (int k = 0; k < 32; ++k) { Gh[k * 1024 + tid] = f2bf(g0[k]); Gh[k * 1024 + 512 + tid] = f2bf(g1[k]); } }
    __syncthreads();
    const int c8 = (tid & 127) * 8;
    float mur[8], muk[8], muv[8], ka[8], rk[8], lw[8], lb[8];
#pragma unroll
    for (int i = 0; i < 8; ++i) { mur[i] = p.in[25][c8 + i]; muk[i] = p.in[25][1024 + c8 + i]; muv[i] = p.in[25][2048 + c8 + i]; ka[i] = p.in[32][c8 + i]; rk[i] = p.in[33][c8 + i]; lw[i] = p.in[34][c8 + i]; lb[i] = p.in[35][c8 + i]; }
#pragma unroll 1
    for (int it = 0; it < 8; ++it) { const int tk = (tid >> 7) + 4 * it; const int tok = tok0 + tk; int t, L; tok_tl(tok, t, L);
        const u16* pr = P + (size_t)tok * LDP0 + 3072 + c8; const bool hm = t > 0, hp = t < L - 1;
        float rc[8], rm[8], rp[8], kc[8], km[8], kp[8], vc[8], vm[8], vp[8], a0[8], a1[8], yf[8], yb[8], gg[8];
        unpack8(*(const u32x4*)pr, rc); unpack8(*(const u32x4*)(pr + 1024), kc); unpack8(*(const u32x4*)(pr + 2048), vc);
        if (hm) { const u16* pm = P + (size_t)(tok - 1) * LDP0 + 3072 + c8; unpack8(*(const u32x4*)(pm), rm); unpack8(*(const u32x4*)(pm + 1024), km); unpack8(*(const u32x4*)(pm + 2048), vm); }
        else { for (int i = 0; i < 8; ++i) { rm[i] = 0.f; km[i] = 0.f; vm[i] = 0.f; } }
        if (hp) { unpack8(*(const u32x4*)(pr + LDP0), rp); unpack8(*(const u32x4*)(pr + LDP0 + 1024), kp); unpack8(*(const u32x4*)(pr + LDP0 + 2048), vp); }
        else { for (int i = 0; i < 8; ++i) { rp[i] = 0.f; kp[i] = 0.f; vp[i] = 0.f; } }
        unpack8(*(const u32x4*)(RW + (size_t)tok * 4096 + 2048 + c8), a0); unpack8(*(const u32x4*)(RW + (size_t)tok * 4096 + 3072 + c8), a1);
        unpack8(*(const u32x4*)(YF + (size_t)tok * 1024 + c8), yf); unpack8(*(const u32x4*)(YB + (size_t)tok * 1024 + c8), yb);
        unpack8(*(const u32x4*)(Gh + tk * 1024 + c8), gg);
        float y[8], v_[8]; float bon = 0.f, sy = 0.f;
#pragma unroll
        for (int i = 0; i < 8; ++i) { const float r_ = mixf(rc[i], rm[i], rp[i], mur[i]), k_ = mixf(kc[i], km[i], kp[i], muk[i]); v_[i] = mixf(vc[i], vm[i], vp[i], muv[i]);
            bon += r_ * k_ * (2.f + (a0[i] + a1[i] - 2.f) * ka[i]) * rk[i]; y[i] = yf[i] + yb[i]; sy += y[i]; }
        bon = sum8(bon); const float mean = sum8(sy) * (1.f / 64.f);
        float sv = 0.f;
#pragma unroll
        for (int i = 0; i < 8; ++i) { y[i] -= mean; sv += y[i] * y[i]; }
        const float rstd = rsqrtf(sum8(sv) * (1.f / 64.f) + 64e-5f);
        float o[8];
#pragma unroll
        for (int i = 0; i < 8; ++i) o[i] = (y[i] * rstd * lw[i] + lb[i] + bon * v_[i]) * gg[i];
        u32x4 w; w.x = pk(o[0], o[1]); w.y = pk(o[2], o[3]); w.z = pk(o[4], o[5]); w.w = pk(o[6], o[7]);
        *(u32x4*)(ycat + (size_t)tok * DM + 1024 + c8) = w; }
    __syncthreads();
}

DEV float logsig(float x) { return fminf(x, 0.f) - __logf(1.f + __expf(-fabsf(x))); }
DEV void gla_intra_task(const Params& p, int task, unsigned char* shm) {
    const int tid = tidx(), wid = tid >> 6, lane = tid & 63, l15 = lane & 15, quad = lane >> 4;
    const int cidx = task >> 2, h = task & 3; const int tok0 = cidx * 64;
    u16* P = (u16*)(p.ws + OFF_P); u16* QB = (u16*)(p.ws + OFF_A); float* Dbuf = (float*)(p.ws + OFF_DB);
    u16* qi = (u16*)shm; u16* ki = qi + 64 * 264; u16* vl = (u16*)shm; u16* Pl = (u16*)(shm + 67584); float* gl = (float*)(shm + 76800); float* tot = (float*)(shm + 84992);
    for (int i = tid; i < 2048; i += 512) { const int tl = i >> 5, c = i & 31; gl[i] = bf2f(P[(size_t)(tok0 + tl) * LDP1 + 6144 + c]); }
    __syncthreads();
    const int k = tid & 255, jh = tid >> 8;
#pragma unroll 1
    for (int dd = 0; dd < 2; ++dd) { const int dir = 1 - dd;
        float g2r[16];
#pragma unroll
        for (int r = 0; r < 16; ++r) g2r[r] = p.in[38][(size_t)(dir * 16 + r) * 1024 + h * 256 + k];
        const float gb = p.in[39][dir * 1024 + h * 256 + k];
        float bl[32]; float run = 0.f;
#pragma unroll
        for (int jj = 0; jj < 32; ++jj) { const int j = jh * 32 + jj; const int tl = dir ? 63 - j : j; const float* gr = gl + tl * 32 + dir * 16;
            float x = gb;
#pragma unroll
            for (int r = 0; r < 16; r += 4) { const float4 g4 = *(const float4*)(gr + r); x += g4.x * g2r[r] + g4.y * g2r[r + 1] + g4.z * g2r[r + 2] + g4.w * g2r[r + 3]; }
            run += logsig(x) * 0.0625f; bl[jj] = run; }
        tot[jh * 256 + k] = run;
        __syncthreads();
        const float t0v = tot[k], t1v = tot[256 + k]; const float off = jh ? t0v : 0.f; const float bref = t0v, blast = t0v + t1v;
        if (jh == 0) Dbuf[((size_t)cidx * 2 + dir) * 1024 + h * 256 + k] = __expf(blast);
        u16* qdst; u16* kdst; size_t ldd;
        if (dir == 0) { qdst = P + h * 256 + k; kdst = P + 1024 + h * 256 + k; ldd = LDP1; } else { qdst = QB + h * 256 + k; kdst = QB + 1024 + h * 256 + k; ldd = 2048; }
#pragma unroll
        for (int jj = 0; jj < 32; ++jj) { const int j = jh * 32 + jj; const int tl = dir ? 63 - j : j; const size_t tok = (size_t)tok0 + tl;
            const float qv = bf2f(P[tok * LDP1 + h * 256 + k]) * 0.0625f, kv = bf2f(P[tok * LDP1 + 1024 + h * 256 + k]);
            const float b = bl[jj] + off;
            qi[j * 264 + k] = f2bf(qv * __expf(b - bref)); ki[j * 264 + k] = f2bf(kv * __expf(bref - b));
            qdst[tok * ldd] = f2bf(qv * __expf(b)); kdst[tok * ldd] = f2bf(kv * __expf(blast - b)); }
        __syncthreads();
        { const int tt = wid >> 1;
#pragma unroll
            for (int q2 = 0; q2 < 2; ++q2) { const int st = (wid & 1) * 2 + q2; f32x4 acc = (f32x4){0.f, 0.f, 0.f, 0.f};
                if (st <= tt) {
#pragma unroll
                    for (int ks = 0; ks < 8; ++ks) { const bf16x8 a = *(const bf16x8*)(qi + (tt * 16 + l15) * 264 + ks * 32 + quad * 8); const bf16x8 b = *(const bf16x8*)(ki + (st * 16 + l15) * 264 + ks * 32 + quad * 8);
                        acc = mfma16(a, b, acc); } }
#pragma unroll
                for (int r = 0; r < 4; ++r) { const int t = tt * 16 + quad * 4 + r, s_ = st * 16 + l15; Pl[t * 72 + s_] = f2bf(s_ <= t ? acc[r] : 0.f); } } }
        __syncthreads();
#pragma unroll
        for (int i = 0; i < 8; ++i) { const int piece = tid + 512 * i; const int j = piece >> 6, c8 = (piece & 63) * 8; const int tl = dir ? 63 - j : j;
            *(u32x4*)(vl + j * 520 + c8) = *(const u32x4*)(P + (size_t)(tok0 + tl) * LDP1 + 2048 + h * 512 + c8); }
        __syncthreads();
        u16* O = (u16*)(p.ws + (dir ? OFF_OB : OFF_OF)) + h * 512;
#pragma unroll 1
        for (int q4 = 0; q4 < 4; ++q4) { const int vt = wid * 4 + q4; f32x4 acc[4];
#pragma unroll
            for (int tt = 0; tt < 4; ++tt) acc[tt] = (f32x4){0.f, 0.f, 0.f, 0.f};
#pragma unroll
            for (int ss = 0; ss < 2; ++ss) { bf16x8 bfr;
#pragma unroll
                for (int jj = 0; jj < 8; ++jj) bfr[jj] = (short)vl[(ss * 32 + quad * 8 + jj) * 520 + vt * 16 + l15];
#pragma unroll
                for (int tt = 0; tt < 4; ++tt) { if (ss * 32 <= tt * 16 + 15) { const bf16x8 a = *(const bf16x8*)(Pl + (tt * 16 + l15) * 72 + ss * 32 + quad * 8); acc[tt] = mfma16(a, bfr, acc[tt]); } } }
#pragma unroll
            for (int tt = 0; tt < 4; ++tt)
#pragma unroll
                for (int r = 0; r < 4; ++r) { const int t = tt * 16 + quad * 4 + r; const int tl = dir ? 63 - t : t; O[(size_t)(tok0 + tl) * DM + vt * 16 + l15] = f2bf(acc[tt][r]); } }
        __syncthreads();
    }
}
DEV void gla_inter_task(const Params& p, int task, unsigned char* shm) {
    const bool sample = task < 256; const int tt_ = sample ? task : task - 256;
    const int seq = tt_ >> 3, vs = tt_ & 7; const int b = seq >> 3, h = (seq >> 1) & 3, dir = seq & 1;
    const int L = sample ? 4096 : 256; const int tok0 = sample ? NTP + b * 4096 : b * 256;
    const int nch = L >> 6, cbase = tok0 >> 6;
    const int tid = tidx(), wid = tid >> 6, lane = tid & 63, l15 = lane & 15, quad = lane >> 4;
    const u16* P = (const u16*)(p.ws + OFF_P); const u16* QB = (const u16*)(p.ws + OFF_A); const float* Dbuf = (const float*)(p.ws + OFF_DB);
    u16* ST = (u16*)shm; u16* qdl = (u16*)(shm + 33792); u16* kdl = (u16*)(shm + 67584); u16* vl = (u16*)(shm + 101376); float* dl = (float*)(shm + 110592);
    f32x4 S[2][4];
    const size_t sbase = (((size_t)b * 2 + dir) * 4 + h) * 256 * 512 + vs * 64;
#pragma unroll
    for (int kt = 0; kt < 2; ++kt)
#pragma unroll
        for (int vt = 0; vt < 4; ++vt)
#pragma unroll
            for (int r = 0; r < 4; ++r) { const int kk = wid * 32 + kt * 16 + quad * 4 + r; S[kt][vt][r] = sample ? p.in[3][sbase + (size_t)kk * 512 + vt * 16 + l15] : 0.f; }
    const u16* qsrc; const u16* ksrc; size_t lds_;
    if (dir == 0) { qsrc = P + h * 256; ksrc = P + 1024 + h * 256; lds_ = LDP1; } else { qsrc = QB + h * 256; ksrc = QB + 1024 + h * 256; lds_ = 2048; }
    const u16* vsrc = P + 2048 + h * 512 + vs * 64;
    u16* O = (u16*)(p.ws + (dir ? OFF_OB : OFF_OF)) + h * 512 + vs * 64;
    u32x4 rq[4], rk[4], rv; float rd = 0.f;
    const int vrow = tid >> 3, vc8 = (tid & 7) * 8;
#define GLA_ISSUE(n_) do { const int cidx_ = cbase + (dir ? nch - 1 - (n_) : (n_)); \
        _Pragma("unroll") for (int i = 0; i < 4; ++i) { const int piece = tid + 512 * i; const int j = piece >> 5, c8 = (piece & 31) * 8; const size_t tok = (size_t)cidx_ * 64 + (dir ? 63 - j : j); \
            rq[i] = *(const u32x4*)(qsrc + tok * lds_ + c8); rk[i] = *(const u32x4*)(ksrc + tok * lds_ + c8); } \
        { const size_t tok = (size_t)cidx_ * 64 + (dir ? 63 - vrow : vrow); rv = *(const u32x4*)(vsrc + tok * LDP1 + vc8); } \
        if (tid < 256) rd = Dbuf[((size_t)cidx_ * 2 + dir) * 1024 + h * 256 + tid]; } while (0)
#define GLA_WRITE_ST() do { _Pragma("unroll") for (int kt = 0; kt < 2; ++kt) _Pragma("unroll") for (int vt = 0; vt < 4; ++vt) { u32x2 w; w.x = pk(S[kt][vt][0], S[kt][vt][1]); w.y = pk(S[kt][vt][2], S[kt][vt][3]); \
            *(u32x2*)(ST + (vt * 16 + l15) * 264 + wid * 32 + kt * 16 + quad * 4) = w; } } while (0)
    GLA_WRITE_ST();
    GLA_ISSUE(0);
    const int tt = wid >> 1, vb = (wid & 1) * 2;
#pragma unroll 1
    for (int n = 0; n < nch; ++n) {
        const int cidx = cbase + (dir ? nch - 1 - n : n);
#pragma unroll
        for (int i = 0; i < 4; ++i) { const int piece = tid + 512 * i; const int j = piece >> 5, c8 = (piece & 31) * 8; *(u32x4*)(qdl + j * 264 + c8) = rq[i]; *(u32x4*)(kdl + j * 264 + c8) = rk[i]; }
        *(u32x4*)(vl + vrow * 72 + vc8) = rv; if (tid < 256) dl[tid] = rd;
        __syncthreads();
        if (n + 1 < nch) GLA_ISSUE(n + 1);
        float oi[2][4];
#pragma unroll
        for (int q2 = 0; q2 < 2; ++q2)
#pragma unroll
            for (int r = 0; r < 4; ++r) { const int j = tt * 16 + quad * 4 + r; const size_t tok = (size_t)cidx * 64 + (dir ? 63 - j : j); oi[q2][r] = bf2f(O[tok * DM + (vb + q2) * 16 + l15]); }
        f32x4 oacc[2]; oacc[0] = (f32x4){0.f, 0.f, 0.f, 0.f}; oacc[1] = oacc[0];
#pragma unroll
        for (int ks = 0; ks < 8; ++ks) { const bf16x8 a = *(const bf16x8*)(qdl + (tt * 16 + l15) * 264 + ks * 32 + quad * 8);
#pragma unroll
            for (int q2 = 0; q2 < 2; ++q2) { const bf16x8 bfr = *(const bf16x8*)(ST + ((vb + q2) * 16 + l15) * 264 + ks * 32 + quad * 8); oacc[q2] = mfma16(a, bfr, oacc[q2]); } }
#pragma unroll
        for (int kt = 0; kt < 2; ++kt) { const f32x4 dv = *(const f32x4*)(dl + wid * 32 + kt * 16 + quad * 4);
#pragma unroll
            for (int vt = 0; vt < 4; ++vt) S[kt][vt] = S[kt][vt] * dv; }
#pragma unroll
        for (int ts = 0; ts < 2; ++ts) { bf16x8 af[2];
#pragma unroll
            for (int kt = 0; kt < 2; ++kt)
#pragma unroll
                for (int jj = 0; jj < 8; ++jj) af[kt][jj] = (short)kdl[(ts * 32 + quad * 8 + jj) * 264 + wid * 32 + kt * 16 + l15];
#pragma unroll
            for (int vt = 0; vt < 4; ++vt) { bf16x8 bfr;
#pragma unroll
                for (int jj = 0; jj < 8; ++jj) bfr[jj] = (short)vl[(ts * 32 + quad * 8 + jj) * 72 + vt * 16 + l15];
#pragma unroll
                for (int kt = 0; kt < 2; ++kt) S[kt][vt] = mfma16(af[kt], bfr, S[kt][vt]); } }
#pragma unroll
        for (int q2 = 0; q2 < 2; ++q2)
#pragma unroll
            for (int r = 0; r < 4; ++r) { const int j = tt * 16 + quad * 4 + r; const size_t tok = (size_t)cidx * 64 + (dir ? 63 - j : j); O[tok * DM + (vb + q2) * 16 + l15] = f2bf(oi[q2][r] + oacc[q2][r]); }
        __syncthreads();
        GLA_WRITE_ST();
        __syncthreads();
    }
#undef GLA_ISSUE
#undef GLA_WRITE_ST
    if (!sample) { float* so = p.out + OUT_GLAST + sbase;
#pragma unroll
        for (int kt = 0; kt < 2; ++kt)
#pragma unroll
            for (int vt = 0; vt < 4; ++vt)
#pragma unroll
                for (int r = 0; r < 4; ++r) { const int kk = wid * 32 + kt * 16 + quad * 4 + r; so[(size_t)kk * 512 + vt * 16 + l15] = S[kt][vt][r]; } }
    __syncthreads();
}
DEV void phase_gla_post(const Params& p) {
    const int tid = tidx(), wid = tid >> 6, lane = tid & 63;
    const u16* P = (const u16*)(p.ws + OFF_P); const u16* OF = (const u16*)(p.ws + OFF_OF); const u16* OB = (const u16*)(p.ws + OFF_OB); u16* ycat = (u16*)(p.ws + OFF_A);
    for (int it = blockIdx.x * 8 + wid; it < NTOK * 4; it += gridDim.x * 8) { const int tok = it >> 2, h = it & 3; const int v8 = lane * 8;
        float a[8], b[8], g[8]; unpack8(*(const u32x4*)(OF + (size_t)tok * DM + h * 512 + v8), a); unpack8(*(const u32x4*)(OB + (size_t)tok * DM + h * 512 + v8), b);
        unpack8(*(const u32x4*)(P + (size_t)tok * LDP1 + 4096 + h * 512 + v8), g);
        float ss = 0.f;
#pragma unroll
        for (int i = 0; i < 8; ++i) { a[i] += b[i]; ss += a[i] * a[i]; }
        ss = wave_sum(ss); const float sc = rsqrtf(ss * (1.f / 512.f) + 1e-6f);
        float o[8];
#pragma unroll
        for (int i = 0; i < 8; ++i) o[i] = a[i] * sc * p.in[40][v8 + i] * (g[i] * sigm(g[i]));
        u32x4 w; w.x = pk(o[0], o[1]); w.y = pk(o[2], o[3]); w.z = pk(o[4], o[5]); w.w = pk(o[6], o[7]);
        *(u32x4*)(ycat + (size_t)tok * DM + h * 512 + v8) = w; }
}

DEV void gate_loadcol(const u16* U, long tokc, int c8, bool colok, bool up, bool dn, int W, float (*dst)[8]) {
    if (colok && up) unpack8(*(const u32x4*)(U + (size_t)(tokc - W) * LDU + c8), dst[0]); else { for (int i = 0; i < 8; ++i) dst[0][i] = 0.f; }
    if (colok) unpack8(*(const u32x4*)(U + (size_t)tokc * LDU + c8), dst[1]); else { for (int i = 0; i < 8; ++i) dst[1][i] = 0.f; }
    if (colok && dn) unpack8(*(const u32x4*)(U + (size_t)(tokc + W) * LDU + c8), dst[2]); else { for (int i = 0; i < 8; ++i) dst[2][i] = 0.f; }
}
DEV void gate_loadraw(const u16* U, long tokc, int c8, bool colok, bool up, bool dn, int W, u32x4* dst) {
    const u32x4 z = (u32x4){0u, 0u, 0u, 0u};
    dst[0] = z; dst[1] = z; dst[2] = z;
    if (colok && up) dst[0] = *(const u32x4*)(U + (size_t)(tokc - W) * LDU + c8);
    if (colok) dst[1] = *(const u32x4*)(U + (size_t)tokc * LDU + c8);
    if (colok && dn) dst[2] = *(const u32x4*)(U + (size_t)(tokc + W) * LDU + c8);
}
DEV void phase_ffn_gate(const Params& p, int layer) {
    u16* U = (u16*)(p.ws + OFF_U); const float* cw = p.in[11] + (size_t)layer * 9 * DFF;
    const int tid_ = tidx(), wid_ = tid_ >> 6, lane_ = tid_ & 63;
    for (int bu = blockIdx.x; bu < 1408 + 704; bu += gridDim.x) {
        int tokS, c8;
        if (bu < 1408) { const int rg = bu / 44, rem = bu % 44; const int qtr = rem / 11, cgg = rem % 11; tokS = NTP + (rg * 8 + wid_) * 64 + qtr * 16; c8 = (cgg * 64 + lane_) * 8; }
        else { const int pu = bu - 1408; const int sg = pu / 11, cgg = pu % 11; tokS = (sg * 8 + wid_) * 16; c8 = (cgg * 64 + lane_) * 8; }
        int W, colS; bool up, dn;
        if (tokS < NTP) { W = 256; colS = tokS & 255; up = false; dn = false; }
        else { W = 64; colS = tokS & 63; const int rr = ((tokS - NTP) >> 6) & 63; up = rr > 0; dn = rr < 63; }
        float wt[9][8];
#pragma unroll
        for (int q = 0; q < 9; ++q) { const float4 a = *(const float4*)(cw + q * DFF + c8), b = *(const float4*)(cw + q * DFF + c8 + 4);
            wt[q][0] = a.x; wt[q][1] = a.y; wt[q][2] = a.z; wt[q][3] = a.w; wt[q][4] = b.x; wt[q][5] = b.y; wt[q][6] = b.z; wt[q][7] = b.w; }
        float w0[3][8], w1[3][8];
        u32x4 r2[3], r3[3], vraw, vnext;
        gate_loadcol(U, (long)tokS - 1, c8, colS > 0, up, dn, W, w0);
        gate_loadcol(U, (long)tokS, c8, true, up, dn, W, w1);
        gate_loadraw(U, (long)tokS + 1, c8, colS + 1 < W, up, dn, W, r2);
        vraw = *(const u32x4*)(U + (size_t)tokS * LDU + DFF + c8); vnext = vraw;
#pragma unroll 2
        for (int s_ = 0; s_ < 16; ++s_) {
            const long tok = (long)tokS + s_;
            if (s_ + 2 <= 16) gate_loadraw(U, tok + 2, c8, colS + s_ + 2 < W, up, dn, W, r3);
            if (s_ + 1 < 16) vnext = *(const u32x4*)(U + (size_t)(tok + 1) * LDU + DFF + c8);
            float w2[3][8]; unpack8(r2[0], w2[0]); unpack8(r2[1], w2[1]); unpack8(r2[2], w2[2]);
            float v[8]; unpack8(vraw, v);
#pragma unroll
            for (int i = 0; i < 8; ++i) { float a = 0.f;
#pragma unroll
                for (int di = 0; di < 3; ++di) a += w0[di][i] * wt[di * 3][i] + w1[di][i] * wt[di * 3 + 1][i] + w2[di][i] * wt[di * 3 + 2][i];
                v[i] *= a * sigm(a); }
            u32x4 w; w.x = pk(v[0], v[1]); w.y = pk(v[2], v[3]); w.z = pk(v[4], v[5]); w.w = pk(v[6], v[7]);
            *(u32x4*)(U + (size_t)tok * LDU + DFF + c8) = w;
#pragma unroll
            for (int di = 0; di < 3; ++di) {
#pragma unroll
                for (int i = 0; i < 8; ++i) { w0[di][i] = w1[di][i]; w1[di][i] = w2[di][i]; }
                r2[di] = r3[di]; }
            vraw = vnext;
        }
    }
}

DEV void phase_final_norm(const Params& p) {
    const int tid = tidx(), wid = tid >> 6, lane = tid & 63; const float* g = p.in[13];
    const int nw = gridDim.x * 8, wv = blockIdx.x * 8 + wid; const int per = (NTOK + nw - 1) / nw; const int r0 = wv * per, r1 = (r0 + per < NTOK) ? r0 + per : NTOK;
    float4 gg[8];
#pragma unroll
    for (int j = 0; j < 8; ++j) gg[j] = *(const float4*)(g + (lane + 64 * j) * 4);
    for (int row = r0; row < r1; ++row) {
        float4* xr = (float4*)(p.out + (size_t)row * DM);
        float4 v[8]; float ss = 0.f;
#pragma unroll
        for (int j = 0; j < 8; ++j) { v[j] = xr[lane + 64 * j]; ss += v[j].x * v[j].x + v[j].y * v[j].y + v[j].z * v[j].z + v[j].w * v[j].w; }
        ss = wave_sum(ss); const float rstd = rsqrtf(ss * (1.f / 2048.f) + 1e-6f);
#pragma unroll
        for (int j = 0; j < 8; ++j) xr[lane + 64 * j] = make_float4(v[j].x * rstd * gg[j].x, v[j].y * rstd * gg[j].y, v[j].z * rstd * gg[j].z, v[j].w * rstd * gg[j].w);
    }
}

#define XB_TMO      128
#define XB_XCNT(j)  (256  + 64 * (j))
#define XB_XSUB(j)  (1280 + 64 * (j))
#define XB_XGEN(j)  (2304 + 64 * (j))
#define XB_TOP      3328
#define XB_TOPGEN   3392
#define XCD_BAR_WORDS 3456
#define XB_SPIN_CAP (1u << 18)
DEV unsigned xb_ld(unsigned* p)              { return __hip_atomic_load(p, __ATOMIC_RELAXED, __HIP_MEMORY_SCOPE_AGENT); }
DEV unsigned xb_add(unsigned* p, unsigned v) { return __hip_atomic_fetch_add(p, v, __ATOMIC_RELAXED, __HIP_MEMORY_SCOPE_AGENT); }
DEV unsigned xb_xcc_id() { return (unsigned)__builtin_amdgcn_s_getreg((3 << 11) | 20) & 0xFu; }
#define XB_SPIN(cond, bar) do { unsigned _sp = 0; while (cond) { __builtin_amdgcn_s_sleep(1); \
    if ((++_sp & 255u) == 0u) { if (xb_ld(&(bar)[XB_TMO])) break; if (_sp > XB_SPIN_CAP) { atomicAdd(&(bar)[XB_TMO], 1u); break; } } } } while (0)
struct XcdBarrier { unsigned* bar; unsigned x; volatile LAS unsigned* st; };
DEV XcdBarrier xcd_barrier_post(unsigned* bar, volatile LAS unsigned* st) {
    XcdBarrier b; b.bar = bar; b.x = xb_xcc_id(); b.st = st;
    if (threadIdx.x == 0) (void)xb_add(&bar[XB_XCNT(b.x)], 1u);
    return b;
}
DEV void xcd_barrier_complete(unsigned* bar, unsigned x, unsigned& nloc, unsigned& nx) {
    const unsigned G = gridDim.x * gridDim.y * gridDim.z;
    unsigned sum, cnt, mine, sp = 0u;
    for (;;) {
        sum = 0u; cnt = 0u; mine = 0u;
#pragma unroll
        for (unsigned j = 0; j < 16; ++j) { const unsigned c = xb_ld(&bar[XB_XCNT(j)]); sum += c; cnt += (c > 0u) ? 1u : 0u; mine = (j == x) ? c : mine; }
        if (sum == G) break;
        __builtin_amdgcn_s_sleep(1);
        if ((++sp & 255u) == 0u) { if (xb_ld(&bar[XB_TMO])) break; if (sp > XB_SPIN_CAP) { atomicAdd(&bar[XB_TMO], 1u); break; } }
    }
    nloc = mine > 0u ? mine : 1u; nx = cnt > 0u ? cnt : 1u;
}
DEV void xcd_barrier(const XcdBarrier& b) {
    asm volatile("s_waitcnt vmcnt(0)" ::: "memory");
    __syncthreads();
    if (threadIdx.x == 0) {
        unsigned* bar = b.bar;
        __builtin_amdgcn_s_waitcnt(0);
        unsigned nloc = b.st[0], nx = b.st[1];
        if (nloc == 0u) { xcd_barrier_complete(bar, b.x, nloc, nx); b.st[0] = nloc; b.st[1] = nx; }
        const unsigned old = xb_add(&bar[XB_XSUB(b.x)], 1u);
        const unsigned gen = old / nloc;
        if (old + 1u == (gen + 1u) * nloc) {
            __builtin_amdgcn_fence(__ATOMIC_RELEASE, "agent");
            asm volatile("s_waitcnt vmcnt(0)" ::: "memory");
            const unsigned og = xb_add(&bar[XB_TOP], 1u);
            const unsigned tg = og / nx;
            if (og + 1u == (tg + 1u) * nx) xb_add(&bar[XB_TOPGEN], 1u);
            else XB_SPIN(xb_ld(&bar[XB_TOPGEN]) == tg, bar);
            __builtin_amdgcn_fence(__ATOMIC_ACQUIRE, "agent");
            xb_add(&bar[XB_XGEN(b.x)], 1u);
            asm volatile("s_waitcnt vmcnt(0)" ::: "memory");
        } else {
            XB_SPIN(xb_ld(&bar[XB_XGEN(b.x)]) == gen, bar);
            __builtin_amdgcn_fence(__ATOMIC_ACQUIRE, "agent");
            asm volatile("s_waitcnt vmcnt(0)" ::: "memory");
        }
    }
    __syncthreads();
}

__global__ void __launch_bounds__(512, 2) mega(Params p0) {
    extern __shared__ __attribute__((aligned(16))) unsigned char shm[];
    cg::grid_group grid = cg::this_grid();
    __shared__ uint4 xb_words;
    if (threadIdx.x == 0) xb_words = make_uint4(0u, 0u, 0u, 0u);
    __syncthreads();
    (void)xcd_barrier_post((unsigned*)(p0.ws + OFF_SMALL + SMALL_BYTES + 256), (volatile LAS unsigned*)&xb_words);
#define XBAR() do { XcdBarrier xb_; xb_.bar = (unsigned*)(launder(p0).ws + OFF_SMALL + SMALL_BYTES + 256); xb_.x = xb_xcc_id(); xb_.st = (volatile LAS unsigned*)&xb_words; xcd_barrier(xb_); } while (0)
    float* sm = (float*)shm;
    const int G = (int)gridDim.x, B = (int)blockIdx.x;

#ifndef SK_PREP
    phase_prep(launder(p0), shm);
#ifdef PROBE_MISC
    __syncthreads(); phase_prep(launder(p0), shm);
#endif
#endif
    grid.sync();
    phase_reduce(launder(p0));
    XBAR();
#pragma unroll 1
    for (int layer = 0; layer < 2; ++layer) {
#ifndef SK_NORM
        phase_norm(launder(p0), layer, 0, shm);
#ifdef PROBE_MISC
        __syncthreads(); phase_norm(launder(p0), layer, 0, shm);
#endif
#endif
        XBAR();
        { const Params p = launder(p0); const u16* A = (const u16*)(p.ws + OFF_A); pg8::EpiBf16 E; E.O = (u16*)(p.ws + OFF_P); E.ldc = layer ? LDP1 : LDP0;
#if !defined(SK_GEMM) && !defined(SK_GBF)
            run_gemm(shm, A, DM, (const u16*)(p.ws + OFF_WIN), DM, layer ? LDP1 : LDP0, DM, E);
#ifdef PROBE_GEMM
            __syncthreads(); run_gemm(shm, A, DM, (const u16*)(p.ws + OFF_WIN), DM, layer ? LDP1 : LDP0, DM, E);
#endif
#endif
        }
        XBAR();
        if (layer == 0) {
#ifndef SK_PRE
            { const Params p = launder(p0); for (int t = B; t < 6144 + 768; t += G) { if (t < 6144) hy_pre_tile(p, t, sm); else rwkv_lora_tile(p, t - 6144, shm); } }
#ifdef PROBE_MISC
            { const Params p = launder(p0); for (int t = B; t < 6144 + 768; t += G) { if (t < 6144) hy_pre_tile(p, t, sm); else rwkv_lora_tile(p, t - 6144, shm); } }
#endif
#endif
            XBAR();
            { const Params p = launder(p0); unsigned* ctr = (unsigned*)(p.ws + OFF_SMALL + SMALL_BYTES);
                for (int t = B; t < 128; t += G) rwkv_scan_task(p, t, sm);
                for (;;) { if (tidx() == 0) *(volatile unsigned*)shm = atomicAdd(ctr, 1u); __syncthreads(); const unsigned t = *(volatile unsigned*)shm; __syncthreads();
                    if (t >= 1024u + 2048u) break;
                    if (t < 1024u) rwkv_scan_task(p, 128 + (int)t, sm); else hyconv_task(p, (int)t - 1024, shm); } }
            XBAR();
#ifndef SK_POST
            { const Params p = launder(p0); for (int t = B; t < 6144 + 768; t += G) { if (t < 6144) hy_post_tile(p, t, sm); else rwkv_post_tile(p, t - 6144, sm); } }
#ifdef PROBE_MISC
            { const Params p = launder(p0); for (int t = B; t < 6144 + 768; t += G) { if (t < 6144) hy_post_tile(p, t, sm); else rwkv_post_tile(p, t - 6144, sm); } }
#endif
#endif
            XBAR();
        } else {
#ifndef SK_GLA
            { const Params p = launder(p0); for (int t = B; t < 1536; t += G) gla_intra_task(p, t, shm); }
            XBAR();
            { const Params p = launder(p0); for (int t = B; t < 256 + 2048; t += G) gla_inter_task(p, t, shm); }
#endif
            XBAR();
#ifndef SK_GLAP
            phase_gla_post(launder(p0));
#ifdef PROBE_MISC
            phase_gla_post(launder(p0));
#endif
#endif
            XBAR();
        }
        { const Params p = launder(p0); const u16* A = (const u16*)(p.ws + OFF_A); const float* mods = (const float*)(p.ws + OFF_SMALL); pg8::EpiRes E; E.X = p.out; E.gm = mods + (size_t)layer * 5 * 12288 + 2 * 2048; E.gb = p.in[7] + layer * 12288 + 2 * 2048;
#if !defined(SK_GEMM) && !defined(SK_GRES)
            run_gemm(shm, A, DM, (const u16*)(p.ws + OFF_WOUT), DM, DM, DM, E);
#endif
        }
        XBAR();
#ifndef SK_NORM
        phase_norm(launder(p0), layer, 1, shm);
#ifdef PROBE_MISC
        __syncthreads(); phase_norm(launder(p0), layer, 1, shm);
#endif
#endif
        XBAR();
        { const Params p = launder(p0); const u16* A = (const u16*)(p.ws + OFF_A); pg8::EpiBf16 E; E.O = (u16*)(p.ws + OFF_U); E.ldc = LDU;
#if !defined(SK_GEMM) && !defined(SK_GBF)
            run_gemm(shm, A, DM, (const u16*)(p.ws + OFF_WUP), DM, LDU, DM, E);
#ifdef PROBE_GEMM
            __syncthreads(); run_gemm(shm, A, DM, (const u16*)(p.ws + OFF_WUP), DM, LDU, DM, E);
#endif
#endif
        }
        XBAR();
#ifndef SK_GATE
        phase_ffn_gate(launder(p0), layer);
#endif
        XBAR();
        { const Params p = launder(p0); const float* mods = (const float*)(p.ws + OFF_SMALL); pg8::EpiRes E; E.X = p.out; E.gm = mods + (size_t)layer * 5 * 12288 + 5 * 2048; E.gb = p.in[7] + layer * 12288 + 5 * 2048;
#if !defined(SK_GEMM) && !defined(SK_GRES)
            run_gemm(shm, (const u16*)(p.ws + OFF_U) + DFF, LDU, (const u16*)(p.ws + OFF_WDN), DFF, DM, DFF, E);
#endif
        }
        XBAR();
    }
    phase_final_norm(launder(p0));
}

extern "C" void kernel_launch(void* const* d_in, const int* in_sizes, int n_in, void* d_out, int out_size, void* d_ws, size_t ws_size, hipStream_t stream) {
    constexpr size_t kDynLds = 131072;
    static int grid_blocks = 0;
    if (!grid_blocks) {
        int dev = 0, cus = 0, per_cu = 0;
        hipGetDevice(&dev);
        hipDeviceGetAttribute(&cus, hipDeviceAttributeMultiprocessorCount, dev);
        hipFuncSetAttribute((const void*)mega, hipFuncAttributeMaxDynamicSharedMemorySize, (int)kDynLds);
        hipOccupancyMaxActiveBlocksPerMultiprocessor(&per_cu, mega, 512, kDynLds);
        if (per_cu < 1) per_cu = 1;
        grid_blocks = cus * per_cu;
        if (grid_blocks > 256) grid_blocks = 256;
    }
    if (ws_size < WS_NEED || n_in < 41) { fprintf(stderr, "workspace too small: %zu < %zu\n", ws_size, WS_NEED); return; }
    Params p{};
    for (int i = 0; i < 41; ++i) p.in[i] = (const float*)d_in[i];
    p.out = (float*)d_out; p.ws = (unsigned char*)d_ws;
    hipMemsetAsync((unsigned char*)d_ws + OFF_SMALL + SMALL_BYTES, 0, 256 + XCD_BAR_BYTES, stream);
    void* args[] = {&p};
    hipError_t e = hipLaunchCooperativeKernel((const void*)mega, dim3(grid_blocks), dim3(512), args, kDynLds, stream);
    if (e != hipSuccess) fprintf(stderr, "cooperative launch failed: %s (grid %d)\n", hipGetErrorString(e), grid_blocks);
}
```

```cpp
#include <hip/hip_runtime.h>
#include <hip/hip_cooperative_groups.h>
#include <cstdio>
namespace cg = cooperative_groups;

#define DEV __device__ __forceinline__
#define LAS __attribute__((address_space(3)))
typedef unsigned short u16;
typedef short bf16x8 __attribute__((ext_vector_type(8)));
typedef float f32x4 __attribute__((ext_vector_type(4)));
typedef float f32x2 __attribute__((ext_vector_type(2)));
typedef float f32x16 __attribute__((ext_vector_type(16)));
typedef unsigned u32x2 __attribute__((ext_vector_type(2)));
typedef unsigned u32x4 __attribute__((ext_vector_type(4)));

constexpr int NTOK = 24576, NTP = 8192, DM = 2048;
constexpr int LDP0 = 6656, LDP1 = 6400, LDU = 11264, DFF = 5632;
constexpr size_t OFF_WIN = 0, OFF_WOUT = 27262976, OFF_WUP = 35651584, OFF_WDN = OFF_WUP + 46137344;
constexpr size_t OFF_A = 104857600, OFF_BIG = 205520896;
constexpr size_t OFF_P = OFF_BIG, OFF_RW = OFF_BIG + 327155712, OFF_UT = OFF_RW + 201326592, OFF_GS = OFF_UT + 50331648, OFF_GP = OFF_GS + 16777216;
constexpr size_t OFF_U = OFF_BIG, OFF_OF = OFF_BIG + 314572800, OFF_OB = OFF_OF + 100663296, OFF_DB = OFF_OB + 100663296;
constexpr size_t OFF_SMALL = OFF_BIG + 600000000, SMALL_BYTES = 491520 + 8192;
constexpr size_t XCD_BAR_BYTES = 3456 * 4;
constexpr size_t OFF_LW = OFF_SMALL + SMALL_BYTES + 256 + XCD_BAR_BYTES;
constexpr size_t OFF_G2T = OFF_LW + 524288;
constexpr size_t WS_NEED = OFF_G2T + 262144;
constexpr size_t OUT_RWST = 50331648, OUT_GLAST = 54525952;

struct Params {
    const float* in[41];
    float* out;
    unsigned char* ws;
};

DEV int tidx() { int t = threadIdx.x; asm volatile("" : "+v"(t)); return t; }
DEV Params launder(const Params& p) { Params q = p; asm volatile("" : "+s"(q.ws), "+s"(q.out)); return q; }
DEV float bf2f(unsigned b) { return __uint_as_float(b << 16); }
DEV float bflo(unsigned w) { return __uint_as_float(w << 16); }
DEV float bfhi(unsigned w) { return __uint_as_float(w & 0xffff0000u); }
DEV unsigned pk(float lo, float hi) { unsigned r; asm("v_cvt_pk_bf16_f32 %0, %1, %2" : "=v"(r) : "v"(lo), "v"(hi)); return r; }
DEV u16 f2bf(float f) { return (u16)(pk(f, 0.f) & 0xffffu); }
DEV float wave_sum(float v) {
#pragma unroll
    for (int o = 32; o > 0; o >>= 1) v += __shfl_xor(v, o);
    return v;
}
template <int CTRL> DEV float dppf(float x) { return __builtin_bit_cast(float, __builtin_amdgcn_update_dpp(0, __builtin_bit_cast(int, x), CTRL, 0xf, 0xf, true)); }
DEV float sum8(float v) { v += dppf<0xB1>(v); v += dppf<0x4E>(v); v += dppf<0x141>(v); return v; }
DEV float sum16(float v) { v = sum8(v); v += dppf<0x140>(v); return v; }
DEV f32x4 mfma16(bf16x8 a, bf16x8 b, f32x4 c) { return __builtin_amdgcn_mfma_f32_16x16x32_bf16(a, b, c, 0, 0, 0); }
DEV float sigm(float x) { return __builtin_amdgcn_rcpf(1.f + __expf(-x)); }
DEV int tok_cond(int tok) { return tok < NTP ? 4 : ((tok - NTP) >> 12); }
DEV void tok_tl(int tok, int& t, int& L) { if (tok < NTP) { t = tok & 255; L = 256; } else { t = (tok - NTP) & 4095; L = 4096; } }
DEV void unpack8(u32x4 w, float* o) { o[0] = bflo(w.x); o[1] = bfhi(w.x); o[2] = bflo(w.y); o[3] = bfhi(w.y); o[4] = bflo(w.z); o[5] = bfhi(w.z); o[6] = bflo(w.w); o[7] = bfhi(w.w); }
DEV void unpack4(u32x2 w, float* o) { o[0] = bflo(w.x); o[1] = bfhi(w.x); o[2] = bflo(w.y); o[3] = bfhi(w.y); }

namespace pg8 {
constexpr int BM = 256, BK = 64, HALF = 128, HTB = HALF * BK * 2, NXCD = 8, WGM = 8;
DEV int lds_byte(int r, int c) { const int st = (r >> 4) * 2 + (c >> 5), rr = r & 15, cc = c & 31, ob = rr * 64 + cc * 2; return st * 1024 + (ob ^ (((ob >> 9) & 1) << 5)); }
DEV void stage_rc(int b, int& R, int& C) { const int st = b / 1024, sb = b % 1024, swz = sb ^ (((sb >> 9) & 1) << 5); R = (st >> 1) * 16 + swz / 64; C = (st & 1) * 32 + (swz % 64) / 2; }
DEV int perm32(int rho) { const int n = rho >> 4, i = rho & 15; return 8 * (i >> 2) + 4 * n + (i & 3); }
struct Unit { int pm, pn; };
struct Gemm { const u16* A; const u16* Bt; int M, N, K, lda, ldb; };
struct StaticOrder {
    int nM, nN, nwg, G, c;
    DEV void init(int M, int N, int G_, int c_) { nM = M / BM; nN = N / BM; nwg = nM * nN; G = G_; c = c_; }
    DEV bool next(int i, Unit& u) const {
        const long L = (long)i * G + c; if (L >= nwg) return false;
        int wgid = (int)L; { const int q = nwg / NXCD, r = nwg % NXCD, xcd = wgid % NXCD, off = wgid / NXCD; wgid = (xcd < r ? xcd * (q + 1) : r * (q + 1) + (xcd - r) * q) + off; }
        const int nig = WGM * nN, gid = wgid / nig, fm = gid * WGM, gsz = (nM - fm) < WGM ? (nM - fm) : WGM;
        u.pm = fm + ((wgid % nig) % gsz); u.pn = (wgid % nig) / gsz; return true;
    }
};
struct EpiBf16 {
    static constexpr bool PERM = true;
    u16* O; int ldc;
    DEV void operator()(const f32x4 (&acc)[2][2][4][2], const Unit& u, int wr, int wc, int fr, int fq) const {
        const int row0 = u.pm * BM + wr * 64 + fr; const int col0 = u.pn * BM + wc * 32 + 8 * fq;
#pragma unroll
        for (int ai = 0; ai < 2; ++ai)
#pragma unroll
            for (int m = 0; m < 4; ++m) { u16* rowp = O + (size_t)(row0 + ai * HALF + m * 16) * ldc + col0;
#pragma unroll
                for (int bj = 0; bj < 2; ++bj) { const f32x4 v0 = acc[ai][bj][m][0], v1 = acc[ai][bj][m][1];
                    u32x4 w; w.x = pk(v0[0], v0[1]); w.y = pk(v0[2], v0[3]); w.z = pk(v1[0], v1[1]); w.w = pk(v1[2], v1[3]);
                    *(u32x4*)(rowp + bj * HALF) = w; } }
    }
};
struct EpiRes {
    static constexpr bool PERM = false;
    float* X; const float* gm; const float* gb;
    DEV void operator()(const f32x4 (&acc)[2][2][4][2], const Unit& u, int wr, int wc, int fr, int fq) const {
        const int row0 = u.pm * BM + wr * 64 + fr, col0 = u.pn * BM + wc * 32 + 4 * fq;
        const int cond = u.pm < 32 ? 4 : ((u.pm - 32) >> 4);
        const float* gmc = gm + (size_t)cond * 12288 + col0; const float* gbc = gb + col0;
        f32x4 gv[2][2];
#pragma unroll
        for (int bj = 0; bj < 2; ++bj)
#pragma unroll
            for (int n = 0; n < 2; ++n) gv[bj][n] = *(const f32x4*)(gmc + bj * HALF + n * 16) + *(const f32x4*)(gbc + bj * HALF + n * 16);
        f32x4 xc[2][2], xn[2][2];
        { float* rowp = X + (size_t)row0 * DM + col0;
#pragma unroll
            for (int bj = 0; bj < 2; ++bj)
#pragma unroll
                for (int n = 0; n < 2; ++n) xc[bj][n] = *(const f32x4*)(rowp + bj * HALF + n * 16); }
#pragma unroll
        for (int gidx = 0; gidx < 8; ++gidx) { const int ai = gidx >> 2, m = gidx & 3;
            float* rowp = X + (size_t)(row0 + ai * HALF + m * 16) * DM + col0;
            if (gidx < 7) { const int ai2 = (gidx + 1) >> 2, m2 = (gidx + 1) & 3; const float* rown = X + (size_t)(row0 + ai2 * HALF + m2 * 16) * DM + col0;
#pragma unroll
                for (int bj = 0; bj < 2; ++bj)
#pragma unroll
                    for (int n = 0; n < 2; ++n) xn[bj][n] = *(const f32x4*)(rown + bj * HALF + n * 16); }
#pragma unroll
            for (int bj = 0; bj < 2; ++bj)
#pragma unroll
                for (int n = 0; n < 2; ++n) *(f32x4*)(rowp + bj * HALF + n * 16) = xc[bj][n] + gv[bj][n] * acc[ai][bj][m][n];
#pragma unroll
            for (int bj = 0; bj < 2; ++bj)
#pragma unroll
                for (int n = 0; n < 2; ++n) xc[bj][n] = xn[bj][n];
        }
    }
};

template <class Epi>
DEV void gemm_phase(LAS unsigned char* lds, const Gemm g, const StaticOrder& S, const Epi& E) {
    const int tid = tidx(), wid = __builtin_amdgcn_readfirstlane(tid >> 6), lane = tid & 63, wr = wid >> 2, wc = wid & 3, fr = lane & 15, fq = lane >> 4;
    const int K = g.K, nt = K / BK;
    unsigned voffA[2], voffB[2];
#pragma unroll
    for (int i = 0; i < 2; ++i) { int R, C; stage_rc(tid * 16 + i * 8192, R, C); const int Rb = Epi::PERM ? ((R & ~31) + perm32(R & 31)) : R;
        voffA[i] = (unsigned)(R * g.lda + C) * 2u; voffB[i] = (unsigned)(Rb * g.ldb + C) * 2u; }
    const size_t kstep = (size_t)(BK * 2);
    const size_t hstepA = (size_t)HALF * g.lda * 2, hstepB = (size_t)HALF * g.ldb * 2;
    const size_t tstepA = 2 * hstepA, tstepB = 2 * hstepB;
    const unsigned ldsw = (unsigned)wid * 1024u;
    const int aoff = lds_byte(wr * 64 + fr, fq * 8), boff = lds_byte(wc * 32 + fr, fq * 8);
#define PG8_SA(b, h) (((b) * 2 + (h)) * HTB)
#define PG8_SB(b, h) ((4 + (b) * 2 + (h)) * HTB)
#define PG8_STAGE(bufoff, gbase, voff) do { _Pragma("unroll") for (int _i = 0; _i < 2; ++_i) \
        __builtin_amdgcn_global_load_lds((const unsigned*)((const char*)(gbase) + (voff)[_i]), (LAS unsigned*)(lds + (bufoff) + ldsw + _i * 8192), 16, 0, 0); } while (0)
#define PG8_LDA(dst, b, h) do { _Pragma("unroll") for (int m = 0; m < 4; ++m) _Pragma("unroll") for (int k = 0; k < 2; ++k) dst[m][k] = *(const LAS bf16x8*)(lds + PG8_SA(b, h) + aoff + m * 2048 + k * 1024); } while (0)
#define PG8_LDB(dst, b, h) do { _Pragma("unroll") for (int n = 0; n < 2; ++n) _Pragma("unroll") for (int k = 0; k < 2; ++k) dst[n][k] = *(const LAS bf16x8*)(lds + PG8_SB(b, h) + boff + n * 2048 + k * 1024); } while (0)
#define PG8_MMA(ai, bj, At, Bt) do { __builtin_amdgcn_s_setprio(1); _Pragma("unroll") for (int m = 0; m < 4; ++m) _Pragma("unroll") for (int n = 0; n < 2; ++n) _Pragma("unroll") for (int k = 0; k < 2; ++k) \
        acc[ai][bj][m][n] = __builtin_amdgcn_mfma_f32_16x16x32_bf16(Bt[n][k], At[m][k], acc[ai][bj][m][n], 0, 0, 0); __builtin_amdgcn_s_setprio(0); } while (0)
#define PG8_WAIT_V(n) asm volatile("s_waitcnt vmcnt(" #n ")" ::: "memory")
#define PG8_WAIT_L(n) asm volatile("s_waitcnt lgkmcnt(" #n ")" ::: "memory")
#define PG8_BAR __builtin_amdgcn_s_barrier()
#define PG8_SCHED __builtin_amdgcn_sched_barrier(0)
    Unit cur, nxt; int ui = 0;
    if (!S.next(0, cur)) return;
    f32x4 acc[2][2][4][2];
#pragma unroll
    for (int a = 0; a < 2; ++a)
#pragma unroll
        for (int b = 0; b < 2; ++b)
#pragma unroll
            for (int m = 0; m < 4; ++m)
#pragma unroll
                for (int n = 0; n < 2; ++n) acc[a][b][m][n] = (f32x4){0.f, 0.f, 0.f, 0.f};
    bf16x8 At[4][2], B0[2][2], B1[2][2];
    const char* cA = (const char*)g.A + (size_t)cur.pm * tstepA; const char* cB = (const char*)g.Bt + (size_t)cur.pn * tstepB;
    PG8_STAGE(PG8_SB(0, 0), cB, voffB); PG8_STAGE(PG8_SA(0, 0), cA, voffA); PG8_STAGE(PG8_SB(0, 1), cB + hstepB, voffB); PG8_STAGE(PG8_SA(0, 1), cA + hstepA, voffA);
    if (wr == 1) PG8_BAR;
    PG8_WAIT_V(4); PG8_BAR;
    PG8_STAGE(PG8_SB(1, 0), cB + kstep, voffB); PG8_STAGE(PG8_SA(1, 0), cA + kstep, voffA); PG8_STAGE(PG8_SB(1, 1), cB + hstepB + kstep, voffB);
    PG8_WAIT_V(6); PG8_BAR;
    for (;;) {
        const bool has_next = S.next(ui + 1, nxt);
        const char* nA = has_next ? (const char*)g.A + (size_t)nxt.pm * tstepA : cA; const char* nB = has_next ? (const char*)g.Bt + (size_t)nxt.pn * tstepB : cB;
        for (int t = 0; t < nt; t += 2) {
            const bool last = (t == nt - 2);
            const char* a1 = cA + (size_t)(t + 1) * kstep;
            const char* a2 = last ? nA : cA + (size_t)(t + 2) * kstep; const char* b2 = last ? nB : cB + (size_t)(t + 2) * kstep;
            const char* a3 = a2 + kstep; const char* b3 = b2 + kstep;
            PG8_LDB(B0, 0, 0); PG8_SCHED; PG8_LDA(At, 0, 0); PG8_STAGE(PG8_SA(1, 1), a1 + hstepA, voffA);
            PG8_WAIT_L(8); PG8_BAR; PG8_WAIT_L(0); PG8_MMA(0, 0, At, B0); PG8_BAR; PG8_SCHED;
            PG8_LDB(B1, 0, 1); PG8_STAGE(PG8_SB(0, 0), b2, voffB);
            PG8_BAR; PG8_WAIT_L(0); PG8_MMA(0, 1, At, B1); PG8_BAR;
            PG8_LDA(At, 0, 1); PG8_STAGE(PG8_SA(0, 0), a2, voffA);
            PG8_BAR; PG8_WAIT_L(0); PG8_MMA(1, 0, At, B0); PG8_BAR; PG8_SCHED;
            PG8_STAGE(PG8_SB(0, 1), b2 + hstepB, voffB);
            PG8_WAIT_V(6); PG8_BAR; PG8_MMA(1, 1, At, B1); PG8_BAR;
            PG8_LDB(B0, 1, 0); PG8_SCHED; PG8_LDA(At, 1, 0); PG8_STAGE(PG8_SA(0, 1), a2 + hstepA, voffA);
            PG8_WAIT_L(8); PG8_BAR; PG8_WAIT_L(0); PG8_MMA(0, 0, At, B0); PG8_BAR; PG8_SCHED;
            PG8_LDB(B1, 1, 1); PG8_STAGE(PG8_SB(1, 0), b3, voffB);
            PG8_BAR; PG8_WAIT_L(0); PG8_MMA(0, 1, At, B1); PG8_BAR;
            PG8_LDA(At, 1, 1); PG8_STAGE(PG8_SA(1, 0), a3, voffA);
            PG8_BAR; PG8_WAIT_L(0); PG8_MMA(1, 0, At, B0); PG8_BAR; PG8_SCHED;
            PG8_STAGE(PG8_SB(1, 1), b3 + hstepB, voffB);
            PG8_WAIT_V(6); PG8_BAR; PG8_MMA(1, 1, At, B1); PG8_BAR;
        }
        E(acc, cur, wr, wc, fr, fq);
        if (!has_next) break;
#pragma unroll
        for (int a = 0; a < 2; ++a)
#pragma unroll
            for (int b = 0; b < 2; ++b)
#pragma unroll
                for (int m = 0; m < 4; ++m)
#pragma unroll
                    for (int n = 0; n < 2; ++n) acc[a][b][m][n] = (f32x4){0.f, 0.f, 0.f, 0.f};
        cur = nxt; cA = nA; cB = nB; ++ui;
    }
    PG8_WAIT_V(0);
    if (wr == 0) PG8_BAR;
    PG8_BAR;
#undef PG8_SA
#undef PG8_SB
#undef PG8_STAGE
#undef PG8_LDA
#undef PG8_LDB
#undef PG8_MMA
#undef PG8_WAIT_V
#undef PG8_WAIT_L
#undef PG8_BAR
#undef PG8_SCHED
}
}

template <class Epi>
DEV void run_gemm(unsigned char* shm, const u16* A, int lda, const u16* Bt, int ldb, int N, int K, const Epi& E) {
    asm volatile("" : "+s"(A), "+s"(Bt));
    pg8::Gemm g; g.A = A; g.Bt = Bt; g.M = NTOK; g.N = N; g.K = K; g.lda = lda; g.ldb = ldb;
    pg8::StaticOrder S; S.init(NTOK, N, (int)gridDim.x, (int)blockIdx.x);
    pg8::gemm_phase<Epi>((LAS unsigned char*)shm, g, S, E);
}

DEV void convT_tile(const float* __restrict__ src, u16* __restrict__ dst, int K, int N, int Npad, int tile, float* T) {
    const int tid = tidx(); const int ntn = Npad >> 6; const int k0 = (tile / ntn) << 6, n0 = (tile % ntn) << 6;
#pragma unroll
    for (int j = 0; j < 2; ++j) { const int idx = tid + j * 512; const int r = idx >> 4, c4 = (idx & 15) << 2;
        float4 v = make_float4(0.f, 0.f, 0.f, 0.f); if (n0 + c4 < N) v = *(const float4*)(src + (size_t)(k0 + r) * N + n0 + c4);
        float* t = T + r * 65 + c4; t[0] = v.x; t[1] = v.y; t[2] = v.z; t[3] = v.w; }
    __syncthreads();
    { const int nn = tid >> 3, kq = (tid & 7) << 3; const float* t = T + kq * 65 + nn;
        u32x4 o; o.x = pk(t[0], t[65]); o.y = pk(t[130], t[195]); o.z = pk(t[260], t[325]); o.w = pk(t[390], t[455]);
        *(u32x4*)(dst + (size_t)(n0 + nn) * K + k0 + kq) = o; }
    __syncthreads();
}
DEV int conv_ntiles(int job, int layer) { return job == 0 ? (layer ? 3200 : 3328) : job == 1 ? 1024 : job == 2 ? 5632 : 2816; }
DEV void conv_job(const Params& p, int job, int layer, int tile, float* T) {
    if (job == 0) convT_tile(layer ? p.in[36] : p.in[14], (u16*)(p.ws + OFF_WIN), 2048, layer ? 6176 : 6528, layer ? LDP1 : LDP0, tile, T);
    else if (job == 1) convT_tile(layer ? p.in[37] : p.in[15], (u16*)(p.ws + OFF_WOUT), 2048, 2048, 2048, tile, T);
    else if (job == 2) convT_tile(p.in[10] + (size_t)layer * 2048 * 11264, (u16*)(p.ws + OFF_WUP), 2048, 11264, 11264, tile, T);
    else convT_tile(p.in[12] + (size_t)layer * 5632 * 2048, (u16*)(p.ws + OFF_WDN), 5632, 2048, 2048, tile, T);
}

DEV void adaln_tile(const Params& p, int tile, float* sl) {
    const int tid = tidx(); const int nt = tile % 6, kc = (tile / 6) & 31, layer = tile / 192;
    if (tid < 320) { const int j = tid >> 6, kk = tid & 63; const float cv = (j < 4) ? p.in[4][j * 2048 + kc * 64 + kk] : p.in[5][kc * 64 + kk]; sl[tid] = cv / (1.f + expf(-cv)); }
    __syncthreads();
    const float* w = p.in[6] + ((size_t)layer * 2048 + kc * 64) * 12288 + nt * 2048 + tid * 4;
    float acc[5][4];
#pragma unroll
    for (int j = 0; j < 5; ++j) { acc[j][0] = 0.f; acc[j][1] = 0.f; acc[j][2] = 0.f; acc[j][3] = 0.f; }
#pragma unroll 8
    for (int kk = 0; kk < 64; ++kk) { const float4 wv = *(const float4*)(w + (size_t)kk * 12288);
#pragma unroll
        for (int j = 0; j < 5; ++j) { const float s = sl[j * 64 + kk]; acc[j][0] += s * wv.x; acc[j][1] += s * wv.y; acc[j][2] += s * wv.z; acc[j][3] += s * wv.w; } }
    float* m = (float*)(p.ws + OFF_A) + (size_t)kc * 122880 + (size_t)layer * 5 * 12288 + nt * 2048 + tid * 4;
#pragma unroll
    for (int j = 0; j < 5; ++j) *(float4*)(m + j * 12288) = make_float4(acc[j][0], acc[j][1], acc[j][2], acc[j][3]);
    __syncthreads();
}

DEV void hyfilt_tile(const Params& p, int tile, float* sm) {
    const int tid = tidx();
    int L, p0; u16* G; float* nrm = (float*)(p.ws + OFF_A) + 32 * 122880 + (size_t)tile * 2048;
    if (tile < 128) { L = 4096; p0 = tile * 32; G = (u16*)(p.ws + OFF_GS); }
    else { L = 256; p0 = (tile - 128) * 32; G = (u16*)(p.ws + OFF_GP); }
    float* z = sm; float* h1 = sm + 32 * 33; float* h2 = h1 + 2048;
    const float cang = (float)(6.283185307179586 / (double)L);
    for (int i = tid; i < 32 * 33; i += 512) { const int pp = i / 33, e = i % 33; const float pos = (float)(p0 + pp); float val;
        if (e == 0) val = pos / (float)(L - 1);
        else { const int bi = (e - 1) & 15; const float fb = 1e-4f + (float)bi * ((15.f - 1e-4f) / 15.f); const float ang = (cang * pos) * fb; val = (e <= 16) ? cosf(ang) : -sinf(ang); }
        z[i] = val; }
    __syncthreads();
    for (int i = tid; i < 2048; i += 512) { const int pp = i >> 6, j = i & 63; float a = p.in[19][j];
        for (int e = 0; e < 33; ++e) a += z[pp * 33 + e] * p.in[18][e * 64 + j];
        h1[i] = sinf(p.in[23][j] * a); }
    __syncthreads();
    for (int i = tid; i < 2048; i += 512) { const int pp = i >> 6, j = i & 63; float a = p.in[21][j];
        for (int e = 0; e < 64; ++e) a += h1[pp * 64 + e] * p.in[20][e * 64 + j];
        h2[i] = sinf(p.in[23][64 + j] * a); }
    __syncthreads();
    const float dlo = 3.0701134573253946f, dhi = 15.350567286626973f;
    for (int q = 0; q < 4; ++q) { const int n = tid + 512 * q; const int c = n & 1023; const int back = n >> 10;
        float wcol[64];
#pragma unroll
        for (int e = 0; e < 64; ++e) wcol[e] = p.in[22][e * 2048 + n];
        const float delta = dlo + (dhi - dlo) * ((float)c / 1023.f);
        float asum = 0.f;
        for (int pp = 0; pp < 32; ++pp) { float a = 0.f;
#pragma unroll
            for (int e = 0; e < 64; ++e) a += h2[pp * 64 + e] * wcol[e];
            const int pos = p0 + pp; const float t = (float)pos / (float)(L - 1); a *= expf(-t * delta);
            if (!(back && pos == 0)) { asum += fabsf(a); const int lag = back ? -pos : pos; G[(size_t)c * (2 * L) + (L - lag)] = f2bf(a); } }
        nrm[n] = asum; }
    if (p0 == 0) for (int c = tid; c < 1024; c += 512) G[(size_t)c * (2 * L)] = 0;
    __syncthreads();
}

DEV void phase_prep(const Params& p, unsigned char* shm) {
    const int tid = tidx(); float* sm = (float*)shm;
    if (blockIdx.x == 0 && tid == 0) *(unsigned*)(p.ws + OFF_SMALL + SMALL_BYTES) = 0u;
    { u16* LW = (u16*)(p.ws + OFF_LW); u16* G2T = (u16*)(p.ws + OFF_G2T);
        for (int i = blockIdx.x * 512 + tid; i < 4 * 1024 * 64 + 1024 * 128; i += gridDim.x * 512) {
            if (i < 262144) { const int mi = i >> 16, n = (i >> 6) & 1023, r = i & 63; LW[i] = f2bf((mi < 2 ? p.in[27] : p.in[29])[((size_t)(mi & 1) * 64 + r) * 1024 + n]); }
            else { const int j = i - 262144; const int n = j >> 7, r = j & 127; G2T[j] = f2bf(p.in[30][(size_t)r * 1024 + n]); } } }
    const int n0 = 136, n1 = n0 + 384, n2 = n1 + 3328, n3 = n2 + 1024, n4 = n3 + 5632, n5 = n4 + 2816;
    for (int t = blockIdx.x; t < n5; t += gridDim.x) {
        if (t < n0) hyfilt_tile(p, t, sm);
        else if (t < n1) adaln_tile(p, t - n0, sm);
        else if (t < n2) conv_job(p, 0, 0, t - n1, sm);
        else if (t < n3) conv_job(p, 1, 0, t - n2, sm);
        else if (t < n4) conv_job(p, 2, 0, t - n3, sm);
        else conv_job(p, 3, 0, t - n4, sm);
    }
}

DEV void phase_reduce(const Params& p) {
    const float* part = (const float*)(p.ws + OFF_A); float* mods = (float*)(p.ws + OFF_SMALL); float* hn = (float*)(p.ws + OFF_SMALL + 491520);
    for (int i = blockIdx.x * 512 + tidx(); i < 122880 + 2048; i += gridDim.x * 512) {
        if (i < 122880) { float a = 0.f; for (int kc = 0; kc < 32; ++kc) a += part[(size_t)kc * 122880 + i]; mods[i] = a; }
        else { const int j = i - 122880; const int c = j & 1023; const float* hp = part + 32 * 122880; float a = 0.f;
            if (j < 1024) { for (int t = 0; t < 128; ++t) a += hp[(size_t)t * 2048 + c] + hp[(size_t)t * 2048 + 1024 + c]; }
            else { for (int t = 128; t < 136; ++t) a += hp[(size_t)t * 2048 + c] + hp[(size_t)t * 2048 + 1024 + c]; }
            hn[j] = a; }
    }
}

DEV void phase_norm(const Params& p, int layer, int which, unsigned char* shm) {
    const int tid = tidx(), wid = tid >> 6, lane = tid & 63;
    const float* g = p.in[which ? 9 : 8] + layer * 2048;
    const float* X = p.out; u16* A = (u16*)(p.ws + OFF_A);
    const float* mods = (const float*)(p.ws + OFF_SMALL) + (size_t)layer * 5 * 12288; const float* bb = p.in[7] + layer * 12288;
    const int shi = which ? 3 : 0;
    const int nw = gridDim.x * 8, wv = blockIdx.x * 8 + wid; const int per = (NTOK + nw - 1) / nw; const int r0 = wv * per, r1 = (r0 + per < NTOK) ? r0 + per : NTOK;
    const bool first = (layer == 0 && which == 0);
    int cur = -1; float4 Am[8], Bm[8];
    for (int row = r0; row < r1; ++row) {
        const int cond = tok_cond(row);
        if (cond != cur) { cur = cond; const float* md = mods + (size_t)cond * 12288;
#pragma unroll
            for (int j = 0; j < 8; ++j) { const int col = (lane + 64 * j) * 4;
                const float4 gg = *(const float4*)(g + col);
                const float4 s1 = *(const float4*)(md + shi * 2048 + col), s2 = *(const float4*)(bb + shi * 2048 + col);
                const float4 c1 = *(const float4*)(md + (shi + 1) * 2048 + col), c2 = *(const float4*)(bb + (shi + 1) * 2048 + col);
                Am[j] = make_float4(gg.x * (1.f + c1.x + c2.x), gg.y * (1.f + c1.y + c2.y), gg.z * (1.f + c1.z + c2.z), gg.w * (1.f + c1.w + c2.w));
                Bm[j] = make_float4(s1.x + s2.x, s1.y + s2.y, s1.z + s2.z, s1.w + s2.w); } }
        const float* xsrc = X + (size_t)row * DM; if (first) xsrc = row < NTP ? p.in[0] + (size_t)row * DM : p.in[1] + (size_t)(row - NTP) * DM;
        const float4* xr = (const float4*)xsrc;
        float4 v[8]; float ss = 0.f;
#pragma unroll
        for (int j = 0; j < 8; ++j) { v[j] = xr[lane + 64 * j]; ss += v[j].x * v[j].x + v[j].y * v[j].y + v[j].z * v[j].z + v[j].w * v[j].w; }
        if (first) {
#pragma unroll
            for (int j = 0; j < 8; ++j) ((float4*)(p.out + (size_t)row * DM))[lane + 64 * j] = v[j]; }
        ss = wave_sum(ss);
        const float rstd = rsqrtf(ss * (1.f / 2048.f) + 1e-6f);
#pragma unroll
        for (int j = 0; j < 8; ++j) { const int col = (lane + 64 * j) * 4;
            u32x2 o; o.x = pk(v[j].x * rstd * Am[j].x + Bm[j].x, v[j].y * rstd * Am[j].y + Bm[j].y); o.y = pk(v[j].z * rstd * Am[j].z + Bm[j].z, v[j].w * rstd * Am[j].w + Bm[j].w);
            *(u32x2*)(A + (size_t)row * DM + col) = o; }
    }
    if (layer == 0 && which == 1) { const int na = conv_ntiles(0, 1), nb = na + conv_ntiles(1, 1);
        for (int t = blockIdx.x; t < nb; t += gridDim.x) { if (t < na) conv_job(p, 0, 1, t, (float*)shm); else conv_job(p, 1, 1, t - na, (float*)shm); } }
    if (layer == 1 && which == 0) { const int na = conv_ntiles(2, 1), nb = na + conv_ntiles(3, 1);
        for (int t = blockIdx.x; t < nb; t += gridDim.x) { if (t < na) conv_job(p, 2, 1, t, (float*)shm); else conv_job(p, 3, 1, t - na, (float*)shm); } }
}

DEV void sconv8(const u16* prow, bool hm, bool hp, const float* sw, const float* sb, int ch, float* o) {
    float c[8], m[8], q[8];
    unpack8(*(const u32x4*)(prow + ch), c);
    if (hm) unpack8(*(const u32x4*)(prow - LDP0 + ch), m); else { for (int i = 0; i < 8; ++i) m[i] = 0.f; }
    if (hp) unpack8(*(const u32x4*)(prow + LDP0 + ch), q); else { for (int i = 0; i < 8; ++i) q[i] = 0.f; }
#pragma unroll
    for (int i = 0; i < 8; ++i) o[i] = m[i] * sw[ch + i] + c[i] * sw[3072 + ch + i] + q[i] * sw[6144 + ch + i] + sb[ch + i];
}
DEV void sconv_load(const u16* P, int tok, int ch, u32x4* r) {
    int t, L; tok_tl(tok, t, L); const u16* prow = P + (size_t)tok * LDP0 + ch; const u32x4 z = (u32x4){0u, 0u, 0u, 0u};
    r[1] = *(const u32x4*)prow; r[0] = z; r[2] = z;
    if (t > 0) r[0] = *(const u32x4*)(P + (size_t)(tok - 1) * LDP0 + ch);
    if (t < L - 1) r[2] = *(const u32x4*)(prow + LDP0);
}
DEV void sconv_apply(const u32x4* r, const float* sw, const float* sb, int ch, float* o) {
    float c[8], m[8], q[8]; unpack8(r[0], m); unpack8(r[1], c); unpack8(r[2], q);
#pragma unroll
    for (int i = 0; i < 8; ++i) o[i] = m[i] * sw[ch + i] + c[i] * sw[3072 + ch + i] + q[i] * sw[6144 + ch + i] + sb[ch + i];
}
DEV void hy_pre_stream(const Params& p, float* T) {
    const int tid = tidx(); const u16* P = (const u16*)(p.ws + OFF_P); u16* uT = (u16*)(p.ws + OFF_UT);
    const int tk = tid >> 3, c8 = (tid & 7) << 3;
    u32x4 ca[3], cb[3], na[3], nb[3];
    int tile = blockIdx.x;
    if (tile < 6144) { const int tok0 = (tile >> 4) << 6, c0 = (tile & 15) << 6; sconv_load(P, tok0 + tk, 1024 + c0 + c8, ca); sconv_load(P, tok0 + tk, 2048 + c0 + c8, cb); }
    while (tile < 6144) {
        const int tn = tile + gridDim.x;
        if (tn < 6144) { const int tok0 = (tn >> 4) << 6, c0 = (tn & 15) << 6; sconv_load(P, tok0 + tk, 1024 + c0 + c8, na); sconv_load(P, tok0 + tk, 2048 + c0 + c8, nb); }
        const int tok0 = (tile >> 4) << 6, c0 = (tile & 15) << 6;
        { float x1[8], vv[8]; sconv_apply(ca, p.in[16], p.in[17], 1024 + c0 + c8, x1); sconv_apply(cb, p.in[16], p.in[17], 2048 + c0 + c8, vv);
#pragma unroll
            for (int i = 0; i < 8; ++i) T[tk * 65 + c8 + i] = x1[i] * vv[i]; }
        __syncthreads();
        { const int ch = tid >> 3, t8 = (tid & 7) << 3; const float* t = T + t8 * 65 + ch;
            u32x4 o; o.x = pk(t[0], t[65]); o.y = pk(t[130], t[195]); o.z = pk(t[260], t[325]); o.w = pk(t[390], t[455]);
            *(u32x4*)(uT + (size_t)(c0 + ch) * NTOK + tok0 + t8) = o; }
        __syncthreads();
#pragma unroll
        for (int q = 0; q < 3; ++q) { ca[q] = na[q]; cb[q] = nb[q]; }
        tile = tn;
    }
}
DEV void hy_pre_tile(const Params& p, int tile, float* T) {
    const int tid = tidx(); const int tok0 = (tile >> 4) << 6, c0 = (tile & 15) << 6;
    const u16* P = (const u16*)(p.ws + OFF_P); u16* uT = (u16*)(p.ws + OFF_UT);
    { const int tk = tid >> 3, c8 = (tid & 7) << 3; const int tok = tok0 + tk; int t, L; tok_tl(tok, t, L);
        const u16* prow = P + (size_t)tok * LDP0; float x1[8], vv[8];
        sconv8(prow, t > 0, t < L - 1, p.in[16], p.in[17], 1024 + c0 + c8, x1);
        sconv8(prow, t > 0, t < L - 1, p.in[16], p.in[17], 2048 + c0 + c8, vv);
#pragma unroll
        for (int i = 0; i < 8; ++i) T[tk * 65 + c8 + i] = x1[i] * vv[i]; }
    __syncthreads();
    { const int ch = tid >> 3, t8 = (tid & 7) << 3; const float* t = T + t8 * 65 + ch;
        u32x4 o; o.x = pk(t[0], t[65]); o.y = pk(t[130], t[195]); o.z = pk(t[260], t[325]); o.w = pk(t[390], t[455]);
        *(u32x4*)(uT + (size_t)(c0 + ch) * NTOK + tok0 + t8) = o; }
    __syncthreads();
}
DEV void hy_post_tile(const Params& p, int tile, float* T) {
    const int tid = tidx(); const int tok0 = (tile >> 4) << 6, c0 = (tile & 15) << 6;
    const u16* P = (const u16*)(p.ws + OFF_P); const u16* uT = (const u16*)(p.ws + OFF_UT); u16* ycat = (u16*)(p.ws + OFF_A);
    { const int ch = tid >> 3, t8 = (tid & 7) << 3; float y[8]; unpack8(*(const u32x4*)(uT + (size_t)(c0 + ch) * NTOK + tok0 + t8), y);
#pragma unroll
        for (int i = 0; i < 8; ++i) T[(t8 + i) * 65 + ch] = y[i]; }
    __syncthreads();
    { const int tk = tid >> 3, c8 = (tid & 7) << 3; const int tok = tok0 + tk; int t, L; tok_tl(tok, t, L);
        const u16* prow = P + (size_t)tok * LDP0; float x0[8], x1[8], vv[8], o[8];
        sconv8(prow, t > 0, t < L - 1, p.in[16], p.in[17], c0 + c8, x0);
        sconv8(prow, t > 0, t < L - 1, p.in[16], p.in[17], 1024 + c0 + c8, x1);
        sconv8(prow, t > 0, t < L - 1, p.in[16], p.in[17], 2048 + c0 + c8, vv);
        const float* nrm = (const float*)(p.ws + OFF_SMALL + 491520) + (tok < NTP ? 1024 : 0);
#pragma unroll
        for (int i = 0; i < 8; ++i) { const int c = c0 + c8 + i; o[i] = x0[i] * (T[tk * 65 + c8 + i] * __builtin_amdgcn_rcpf(nrm[c]) + x1[i] * vv[i] * p.in[24][c]); }
        u32x4 w; w.x = pk(o[0], o[1]); w.y = pk(o[2], o[3]); w.z = pk(o[4], o[5]); w.w = pk(o[6], o[7]);
        *(u32x4*)(ycat + (size_t)tok * DM + c0 + c8) = w; }
    __syncthreads();
}
DEV void hy_post_stream(const Params& p, float* T) {
    const int tid = tidx(); const u16* P = (const u16*)(p.ws + OFF_P); const u16* uT = (const u16*)(p.ws + OFF_UT); u16* ycat = (u16*)(p.ws + OFF_A);
    const int tk = tid >> 3, c8 = (tid & 7) << 3;
    const int ch = tid >> 3, t8 = (tid & 7) << 3;
    u32x4 c0r[3], c1r[3], c2r[3], n0r[3], n1r[3], n2r[3], yc, yn;
    int tile = blockIdx.x;
    if (tile < 6144) { const int tok0 = (tile >> 4) << 6, c0 = (tile & 15) << 6;
        sconv_load(P, tok0 + tk, c0 + c8, c0r); sconv_load(P, tok0 + tk, 1024 + c0 + c8, c1r); sconv_load(P, tok0 + tk, 2048 + c0 + c8, c2r);
        yc = *(const u32x4*)(uT + (size_t)(c0 + ch) * NTOK + tok0 + t8); }
    while (tile < 6144) {
        const int tn = tile + gridDim.x;
        if (tn < 6144) { const int tok0 = (tn >> 4) << 6, c0 = (tn & 15) << 6;
            sconv_load(P, tok0 + tk, c0 + c8, n0r); sconv_load(P, tok0 + tk, 1024 + c0 + c8, n1r); sconv_load(P, tok0 + tk, 2048 + c0 + c8, n2r);
            yn = *(const u32x4*)(uT + (size_t)(c0 + ch) * NTOK + tok0 + t8); }
        const int tok0 = (tile >> 4) << 6, c0 = (tile & 15) << 6;
        { float y[8]; unpack8(yc, y);
#pragma unroll
            for (int i = 0; i < 8; ++i) T[(t8 + i) * 65 + ch] = y[i]; }
        __syncthreads();
        { const int tok = tok0 + tk; float x0[8], x1[8], vv[8], o[8];
            sconv_apply(c0r, p.in[16], p.in[17], c0 + c8, x0); sconv_apply(c1r, p.in[16], p.in[17], 1024 + c0 + c8, x1); sconv_apply(c2r, p.in[16], p.in[17], 2048 + c0 + c8, vv);
            const float* nrm = (const float*)(p.ws + OFF_SMALL + 491520) + (tok < NTP ? 1024 : 0);
#pragma unroll
            for (int i = 0; i < 8; ++i) { const int c = c0 + c8 + i; o[i] = x0[i] * (T[tk * 65 + c8 + i] * __builtin_amdgcn_rcpf(nrm[c]) + x1[i] * vv[i] * p.in[24][c]); }
            u32x4 w; w.x = pk(o[0], o[1]); w.y = pk(o[2], o[3]); w.z = pk(o[4], o[5]); w.w = pk(o[6], o[7]);
            *(u32x4*)(ycat + (size_t)tok * DM + c0 + c8) = w; }
        __syncthreads();
#pragma unroll
        for (int q = 0; q < 3; ++q) { c0r[q] = n0r[q]; c1r[q] = n1r[q]; c2r[q] = n2r[q]; }
        yc = yn; tile = tn;
    }
}

DEV void hyconv_task(const Params& p, int task, unsigned char* shm) {
    const int tid = tidx(), wid = tid >> 6, lane = tid & 63;
    const bool sample = task < 1024; const int c = sample ? task : task - 1024;
    const int L = sample ? 4096 : 256, NB = sample ? 4 : 32, lgNB = sample ? 2 : 5, LP = L + 8;
    u16* uL = (u16*)shm; u16* gL = uL + NB * LP; u16* gS = gL + 2 * L;
    const u16* G = sample ? (const u16*)(p.ws + OFF_GS) + (size_t)c * 8192 : (const u16*)(p.ws + OFF_GP) + (size_t)c * 512;
    u16* uT = (u16*)(p.ws + OFF_UT) + (size_t)c * NTOK + (sample ? NTP : 0);
    for (int i = tid * 8; i < NB * L; i += 4096) { const int b = i / L, s = i % L; *(u32x4*)(uL + b * LP + s) = *(const u32x4*)(uT + i); }
    for (int i = tid * 8; i < 2 * L; i += 4096) { const u32x4 w = *(const u32x4*)(G + i); *(u32x4*)(gL + i) = w;
        const unsigned nx = (i + 8 < 2 * L) ? (unsigned)G[i + 8] : 0u;
        u32x4 sft; sft.x = (w.x >> 16) | (w.y << 16); sft.y = (w.y >> 16) | (w.z << 16); sft.z = (w.z >> 16) | (w.w << 16); sft.w = (w.w >> 16) | (nx << 16);
        *(u32x4*)(gS + i) = sft; }
    __syncthreads();
    const int ntile = (NB * (L >> 5)) >> 5;
    const int npair = sample ? 8 : 8; const bool two = sample;
    const int r = lane & 31, half = lane >> 5;
    {
        const int ct0 = two ? 2 * wid : wid;
        const int colA = ct0 * 32 + r, colB = colA + 32;
        const int bA = colA & (NB - 1), iA = colA >> lgNB, bB = colB & (NB - 1), iB = colB >> lgNB; const int tA = iA * 32, tB = iB * 32;
        const int i_lo = (ct0 * 32) >> lgNB, i_hi = ((two ? ct0 + 1 : ct0) * 32 + 31) >> lgNB;
        const int d_lo = 32 * i_lo - (L - 16), d_hi = 32 * i_hi;
        f32x16 accA, accB;
#pragma unroll
        for (int j = 0; j < 16; ++j) { accA[j] = 0.f; accB[j] = 0.f; }
        const u16* ubA = uL + bA * LP + 8 * half; const u16* ubB = uL + bB * LP + 8 * half;
        const u16* gsel = (r & 1) ? gS : gL;
        const int qb = (L - r + 8 * half) & ~1;
#pragma unroll 4
        for (int dl = d_lo; dl <= d_hi; dl += 16) {
            const unsigned* gq = (const unsigned*)(gsel + (qb - dl));
            u32x4 aw; aw.x = gq[0]; aw.y = gq[1]; aw.z = gq[2]; aw.w = gq[3];
            const bf16x8 a = __builtin_bit_cast(bf16x8, aw);
            const int sA = tA - dl, sB = tB - dl;
            bf16x8 bvA = (bf16x8){0, 0, 0, 0, 0, 0, 0, 0}, bvB = bvA;
            if (sA >= 0 && sA <= L - 16) bvA = *(const bf16x8*)(ubA + sA);
            accA = __builtin_amdgcn_mfma_f32_32x32x16_bf16(a, bvA, accA, 0, 0, 0);
            if (two) { if (sB >= 0 && sB <= L - 16) bvB = *(const bf16x8*)(ubB + sB);
                accB = __builtin_amdgcn_mfma_f32_32x32x16_bf16(a, bvB, accB, 0, 0, 0); }
        }
#pragma unroll
        for (int g = 0; g < 4; ++g) { u32x2 w; w.x = pk(accA[4 * g], accA[4 * g + 1]); w.y = pk(accA[4 * g + 2], accA[4 * g + 3]);
            *(u32x2*)(uT + (size_t)bA * L + tA + 8 * g + 4 * half) = w; }
        if (two) {
#pragma unroll
            for (int g = 0; g < 4; ++g) { u32x2 w; w.x = pk(accB[4 * g], accB[4 * g + 1]); w.y = pk(accB[4 * g + 2], accB[4 * g + 3]);
                *(u32x2*)(uT + (size_t)bB * L + tB + 8 * g + 4 * half) = w; } }
    }
    (void)ntile; (void)npair;
    __syncthreads();
}

DEV void rwkv_lora_tile(const Params& p, int tile, unsigned char* shm) {
    const int tid = tidx(), wid = tid >> 6, lane = tid & 63, l15 = lane & 15, quad = lane >> 4; const int tok0 = tile * 32;
    const u16* P = (const u16*)(p.ws + OFF_P); u16* RW = (u16*)(p.ws + OFF_RW); const u16* LW = (const u16*)(p.ws + OFF_LW);
    u16* Ain = (u16*)shm;
    u16* Ol = (u16*)(shm + 18432);
    for (int i = tid; i < 32 * 256; i += 512) { const int tk = i >> 8, cc = i & 255; const int tok = tok0 + tk; int t, L; tok_tl(tok, t, L);
        const u16* pp = P + (size_t)tok * LDP0 + 6144 + cc; float x = bf2f(*pp); const float xm = t > 0 ? bf2f(pp[-LDP0]) : 0.f; const float xp = t < L - 1 ? bf2f(pp[LDP0]) : 0.f;
        const float mu = p.in[25][3072 + cc]; x = x + mu * (0.5f * (xm + xp) - x); if (cc < 128) x = tanhf(x);
        Ain[((cc >> 6) * 32 + tk) * 72 + (cc & 63)] = f2bf(x); }
    __syncthreads();
#pragma unroll 1
    for (int mi = 0; mi < 4; ++mi) {
        const float* bias = (mi < 2 ? p.in[26] : p.in[28]) + (mi & 1) * 1024;
        const float osc = mi < 2 ? 0.6065306597f : 1.f;
        bf16x8 af[2][2];
#pragma unroll
        for (int tt = 0; tt < 2; ++tt)
#pragma unroll
            for (int ks = 0; ks < 2; ++ks) af[tt][ks] = *(const bf16x8*)(Ain + (mi * 32 + tt * 16 + l15) * 72 + ks * 32 + quad * 8);
#pragma unroll 2
        for (int q = 0; q < 8; ++q) { const int nt = wid * 8 + q; const int n = nt * 16 + l15;
            const bf16x8 b0 = *(const bf16x8*)(LW + ((size_t)mi * 1024 + n) * 64 + quad * 8), b1 = *(const bf16x8*)(LW + ((size_t)mi * 1024 + n) * 64 + 32 + quad * 8);
            const float bs = bias[n];
#pragma unroll
            for (int tt = 0; tt < 2; ++tt) { f32x4 acc = (f32x4){0.f, 0.f, 0.f, 0.f}; acc = mfma16(af[tt][0], b0, acc); acc = mfma16(af[tt][1], b1, acc);
#pragma unroll
                for (int r = 0; r < 4; ++r) Ol[(tt * 16 + quad * 4 + r) * 1032 + n] = f2bf(osc * sigm(acc[r] + bs)); } }
        __syncthreads();
#pragma unroll
        for (int i = 0; i < 8; ++i) { const int piece = tid + 512 * i; const int tk = piece >> 7, c8 = (piece & 127) * 8;
            *(u32x4*)(RW + (size_t)(tok0 + tk) * 4096 + mi * 1024 + c8) = *(const u32x4*)(Ol + tk * 1032 + c8); }
        __syncthreads();
    }
}
DEV float mixf(float c, float m, float q, float mu) { return c + mu * (0.5f * (m + q) - c); }
DEV void rwkv_scan_task(const Params& p, int task, float* sm) {
    const bool sample = task < 128; const int tt_ = sample ? task : task - 128;
    const int b = tt_ >> 5, h = (tt_ >> 1) & 15, dir = tt_ & 1;
    const int L = sample ? 4096 : 256; const int tok0 = sample ? NTP + b * 4096 : b * 256;
    const int tid = tidx(), wid = tid >> 6, lane = tid & 63;
    const int kl = lane & 7;
    const int row2 = (wid & 3) * 16 + (lane >> 3) * 2;
    float S[8], T[8];
    const size_t so2 = ((((size_t)b * 2 + dir) * 16 + h) * 64 + row2) * 64 + kl * 8;
    if (sample) {
        const float4 a = *(const float4*)(p.in[2] + so2), c = *(const float4*)(p.in[2] + so2 + 4), d = *(const float4*)(p.in[2] + so2 + 64), e = *(const float4*)(p.in[2] + so2 + 68);
        S[0] = a.x; S[1] = a.y; S[2] = a.z; S[3] = a.w; S[4] = c.x; S[5] = c.y; S[6] = c.z; S[7] = c.w;
        T[0] = d.x; T[1] = d.y; T[2] = d.z; T[3] = d.w; T[4] = e.x; T[5] = e.y; T[6] = e.z; T[7] = e.w; }
    else {
#pragma unroll
        for (int i = 0; i < 8; ++i) { S[i] = 0.f; T[i] = 0.f; } }
    f32x2 S2[4], T2[4];
#pragma unroll
    for (int i = 0; i < 4; ++i) { S2[i] = (f32x2){S[2 * i], S[2 * i + 1]}; T2[i] = (f32x2){T[2 * i], T[2 * i + 1]}; }
    const int pk4 = (tid & 15) * 4; const int ch = h * 64 + pk4; const int plt = (tid & 255) >> 4;
    const float4 mur = *(const float4*)(p.in[25] + ch), muk = *(const float4*)(p.in[25] + 1024 + ch), muv = *(const float4*)(p.in[25] + 2048 + ch);
    const float4 kkw = *(const float4*)(p.in[31] + ch), kaw = *(const float4*)(p.in[32] + ch);
    const float murA[4] = {mur.x, mur.y, mur.z, mur.w}, mukA[4] = {muk.x, muk.y, muk.z, muk.w}, muvA[4] = {muv.x, muv.y, muv.z, muv.w};
    const float kkwA[4] = {kkw.x, kkw.y, kkw.z, kkw.w}, kawA[4] = {kaw.x, kaw.y, kaw.z, kaw.w};
    const u16* P = (const u16*)(p.ws + OFF_P); const u16* RW = (const u16*)(p.ws + OFF_RW);
    u16* Y = (u16*)(p.out + OUT_GLAST) + (dir ? (size_t)NTOK * 1024 : 0);
#define RW_PREP(c0_, buf_) do { float* vec_ = sm + (buf_) * 14336; float* vvs_ = vec_ + 10240; \
        _Pragma("unroll 1") for (int ps = 0; ps < 2; ++ps) { const int ptt = plt + 16 * ps; \
            const int t = dir ? (L - 1 - ((c0_) + ptt)) : ((c0_) + ptt); const size_t tok = (size_t)tok0 + t; \
            const u16* pr = P + tok * LDP0 + 3072 + ch; \
            float rc[4], kc[4], vc[4], rm[4], km[4], vm[4], rp[4], kp[4], vp[4], ee[4], aa[4]; \
            unpack4(*(const u32x2*)(pr), rc); unpack4(*(const u32x2*)(pr + 1024), kc); unpack4(*(const u32x2*)(pr + 2048), vc); \
            if (t > 0) { const u16* pm = P + (tok - 1) * LDP0 + 3072 + ch; unpack4(*(const u32x2*)(pm), rm); unpack4(*(const u32x2*)(pm + 1024), km); unpack4(*(const u32x2*)(pm + 2048), vm); } \
            else { for (int i = 0; i < 4; ++i) { rm[i] = 0.f; km[i] = 0.f; vm[i] = 0.f; } } \
            if (t < L - 1) { unpack4(*(const u32x2*)(pr + LDP0), rp); unpack4(*(const u32x2*)(pr + LDP0 + 1024), kp); unpack4(*(const u32x2*)(pr + LDP0 + 2048), vp); } \
            else { for (int i = 0; i < 4; ++i) { rp[i] = 0.f; kp[i] = 0.f; vp[i] = 0.f; } } \
            unpack4(*(const u32x2*)(RW + tok * 4096 + dir * 1024 + ch), ee); unpack4(*(const u32x2*)(RW + tok * 4096 + (2 + dir) * 1024 + ch), aa); \
            float r4[4], k4[4], v4[4], kr[4]; float ss = 0.f; \
            _Pragma("unroll") for (int i = 0; i < 4; ++i) { r4[i] = mixf(rc[i], rm[i], rp[i], murA[i]); k4[i] = mixf(kc[i], km[i], kp[i], mukA[i]); v4[i] = mixf(vc[i], vm[i], vp[i], muvA[i]); \
                kr[i] = k4[i] * kkwA[i]; ss += kr[i] * kr[i]; } \
            ss = sum16(ss); const float inv = rsqrtf(ss + 1e-12f); \
            float tkk[4], tw[4], tkka[4], tkd[4]; \
            _Pragma("unroll") for (int i = 0; i < 4; ++i) { tkk[i] = kr[i] * inv; tw[i] = __expf(-ee[i]); tkka[i] = tkk[i] * aa[i]; tkd[i] = k4[i] * (1.f + (aa[i] - 1.f) * kawA[i]); } \
            float* vj = vec_ + ptt * 320 + pk4; \
            *(float4*)(vj) = make_float4(tkk[0], tkk[1], tkk[2], tkk[3]); *(float4*)(vj + 64) = make_float4(tw[0], tw[1], tw[2], tw[3]); *(float4*)(vj + 128) = make_float4(tkka[0], tkka[1], tkka[2], tkka[3]); \
            *(float4*)(vj + 192) = make_float4(tkd[0], tkd[1], tkd[2], tkd[3]); *(float4*)(vj + 256) = make_float4(r4[0], r4[1], r4[2], r4[3]); \
            *(float4*)(vvs_ + ptt * 64 + pk4) = make_float4(v4[0], v4[1], v4[2], v4[3]); } } while (0)
#define RW_YOUT(c0_, buf_) do { const float* yb_ = sm + (buf_) * 14336 + 12288; \
        _Pragma("unroll 1") for (int ps = 0; ps < 2; ++ps) { const int ptt = plt + 16 * ps; const int t = dir ? (L - 1 - ((c0_) + ptt)) : ((c0_) + ptt); \
            const float4 yv = *(const float4*)(yb_ + ptt * 64 + pk4); u32x2 w; w.x = pk(yv.x, yv.y); w.y = pk(yv.z, yv.w); \
            *(u32x2*)(Y + ((size_t)tok0 + t) * 1024 + ch) = w; } } while (0)
    const int nchunk = L >> 5;
    if (wid >= 4) RW_PREP(0, 0);
    __syncthreads();
#pragma unroll 1
    for (int c = 0; c < nchunk; ++c) {
        if (wid < 4) {
            const float* vec = sm + (c & 1) * 14336; const float* vvs = vec + 10240; float* yb = sm + (c & 1) * 14336 + 12288;
#pragma unroll
            for (int j = 0; j < 32; ++j) {
                const float* vj = vec + j * 320 + kl * 8;
                const f32x4 a0 = *(const f32x4*)(vj), a1 = *(const f32x4*)(vj + 4);
                const f32x4 w0 = *(const f32x4*)(vj + 64), w1 = *(const f32x4*)(vj + 68);
                const f32x4 b0 = *(const f32x4*)(vj + 128), b1 = *(const f32x4*)(vj + 132);
                const f32x4 d0 = *(const f32x4*)(vj + 192), d1 = *(const f32x4*)(vj + 196);
                const f32x4 r0 = *(const f32x4*)(vj + 256), r1 = *(const f32x4*)(vj + 260);
                const float2 vr = *(const float2*)(vvs + j * 64 + row2);
                const f32x2 kk0 = a0.lo, kk1 = a0.hi, kk2 = a1.lo, kk3 = a1.hi;
                f32x2 pa = S2[0] * kk0; pa += S2[1] * kk1; pa += S2[2] * kk2; pa += S2[3] * kk3;
                f32x2 pb = T2[0] * kk0; pb += T2[1] * kk1; pb += T2[2] * kk2; pb += T2[3] * kk3;
                const float sa = -sum8(pa.x + pa.y), sb = -sum8(pb.x + pb.y);
                const f32x2 sa2 = (f32x2){sa, sa}, sb2 = (f32x2){sb, sb}, vx2 = (f32x2){vr.x, vr.x}, vy2 = (f32x2){vr.y, vr.y};
                S2[0] = S2[0] * w0.lo + (sa2 * b0.lo + vx2 * d0.lo); S2[1] = S2[1] * w0.hi + (sa2 * b0.hi + vx2 * d0.hi);
                S2[2] = S2[2] * w1.lo + (sa2 * b1.lo + vx2 * d1.lo); S2[3] = S2[3] * w1.hi + (sa2 * b1.hi + vx2 * d1.hi);
                T2[0] = T2[0] * w0.lo + (sb2 * b0.lo + vy2 * d0.lo); T2[1] = T2[1] * w0.hi + (sb2 * b0.hi + vy2 * d0.hi);
                T2[2] = T2[2] * w1.lo + (sb2 * b1.lo + vy2 * d1.lo); T2[3] = T2[3] * w1.hi + (sb2 * b1.hi + vy2 * d1.hi);
                f32x2 qa = S2[0] * r0.lo; qa += S2[1] * r0.hi; qa += S2[2] * r1.lo; qa += S2[3] * r1.hi;
                f32x2 qb = T2[0] * r0.lo; qb += T2[1] * r0.hi; qb += T2[2] * r1.lo; qb += T2[3] * r1.hi;
                const float y0 = sum8(qa.x + qa.y), y1 = sum8(qb.x + qb.y);
                if (kl == 0) *(float2*)(yb + j * 64 + row2) = make_float2(y0, y1);
            }
        } else {
            if (c > 0) RW_YOUT((c - 1) * 32, (c - 1) & 1);
            if (c + 1 < nchunk) RW_PREP((c + 1) * 32, (c + 1) & 1);
        }
        __syncthreads();
    }
    if (wid >= 4) RW_YOUT((nchunk - 1) * 32, (nchunk - 1) & 1);
#undef RW_PREP
#undef RW_YOUT
#pragma unroll
    for (int i = 0; i < 4; ++i) { S[2 * i] = S2[i].x; S[2 * i + 1] = S2[i].y; T[2 * i] = T2[i].x; T[2 * i + 1] = T2[i].y; }
    if (!sample && wid < 4) { float* so = p.out + OUT_RWST + so2;
        *(float4*)(so) = make_float4(S[0], S[1], S[2], S[3]); *(float4*)(so + 4) = make_float4(S[4], S[5], S[6], S[7]);
        *(float4*)(so + 64) = make_float4(T[0], T[1], T[2], T[3]); *(float4*)(so + 68) = make_float4(T[4], T[5], T[6], T[7]); }
    __syncthreads();
}
DEV void rwkv_post_tile(const Params& p, int tile, float* sm) {
    const int tid = tidx(); const int tok0 = tile * 32;
    const u16* P = (const u16*)(p.ws + OFF_P); const u16* RW = (const u16*)(p.ws + OFF_RW); u16* ycat = (u16*)(p.ws + OFF_A);
    const u16* YF = (const u16*)(p.out + OUT_GLAST); const u16* YB = YF + (size_t)NTOK * 1024;
    u16* Gh = (u16*)(sm + 4096);
    for (int i = tid; i < 32 * 128; i += 512) { const int tk = i >> 7, r = i & 127; const int tok = tok0 + tk; int t, L; tok_tl(tok, t, L);
        const u16* pp = P + (size_t)tok * LDP0 + 6400 + r; const float x = bf2f(*pp); const float xm = t > 0 ? bf2f(pp[-LDP0]) : 0.f; const float xp = t < L - 1 ? bf2f(pp[LDP0]) : 0.f;
        sm[i] = sigm(mixf(x, xm, xp, p.in[25][3328 + r])); }
    __syncthreads();
    { float g0[32], g1[32];
#pragma unroll
        for (int k = 0; k < 32; ++k) { g0[k] = 0.f; g1[k] = 0.f; }
        const float* g2 = p.in[30];
        for (int r = 0; r < 128; r += 4) {
            float wa[4], wb[4];
#pragma unroll
            for (int q = 0; q < 4; ++q) { wa[q] = g2[(r + q) * 1024 + tid]; wb[q] = g2[(r + q) * 1024 + 512 + tid]; }
#pragma unroll
            for (int k = 0; k < 32; ++k) { const float4 s4 = *(const float4*)(sm + k * 128 + r);
                g0[k] += s4.x * wa[0] + s4.y * wa[1] + s4.z * wa[2] + s4.w * wa[3]; g1[k] += s4.x * wb[0] + s4.y * wb[1] + s4.z * wb[2] + s4.w * wb[3]; } }
#pragma unroll
        for (int k = 0; k < 32; ++k) { Gh[k * 1024 + tid] = f2bf(g0[k]); Gh[k * 1024 + 512 + tid] = f2bf(g1[k]); } }
    __syncthreads();
    const int c8 = (tid & 127) * 8;
    float mur[8], muk[8], muv[8], ka[8], rk[8], lw[8], lb[8];
#pragma unroll
    for (int i = 0; i < 8; ++i) { mur[i] = p.in[25][c8 + i]; muk[i] = p.in[25][1024 + c8 + i]; muv[i] = p.in[25][2048 + c8 + i]; ka[i] = p.in[32][c8 + i]; rk[i] = p.in[33][c8 + i]; lw[i] = p.in[34][c8 + i]; lb[i] = p.in[35][c8 + i]; }
#pragma unroll 1
    for (int it = 0; it < 8; ++it) { const int tk = (tid >> 7) + 4 * it; const int tok = tok0 + tk; int t, L; tok_tl(tok, t, L);
        const u16* pr = P + (size_t)tok * LDP0 + 3072 + c8; const bool hm = t > 0, hp = t < L - 1;
        float rc[8], rm[8], rp[8], kc[8], km[8], kp[8], vc[8], vm[8], vp[8], a0[8], a1[8], yf[8], yb[8], gg[8];
        unpack8(*(const u32x4*)pr, rc); unpack8(*(const u32x4*)(pr + 1024), kc); unpack8(*(const u32x4*)(pr + 2048), vc);
        if (hm) { const u16* pm = P + (size_t)(tok - 1) * LDP0 + 3072 + c8; unpack8(*(const u32x4*)(pm), rm); unpack8(*(const u32x4*)(pm + 1024), km); unpack8(*(const u32x4*)(pm + 2048), vm); }
        else { for (int i = 0; i < 8; ++i) { rm[i] = 0.f; km[i] = 0.f; vm[i] = 0.f; } }
        if (hp) { unpack8(*(const u32x4*)(pr + LDP0), rp); unpack8(*(const u32x4*)(pr + LDP0 + 1024), kp); unpack8(*(const u32x4*)(pr + LDP0 + 2048), vp); }
        else { for (int i = 0; i < 8; ++i) { rp[i] = 0.f; kp[i] = 0.f; vp[i] = 0.f; } }
        unpack8(*(const u32x4*)(RW + (size_t)tok * 4096 + 2048 + c8), a0); unpack8(*(const u32x4*)(RW + (size_t)tok * 4096 + 3072 + c8), a1);
        unpack8(*(const u32x4*)(YF + (size_t)tok * 1024 + c8), yf); unpack8(*(const u32x4*)(YB + (size_t)tok * 1024 + c8), yb);
        unpack8(*(const u32x4*)(Gh + tk * 1024 + c8), gg);
        float y[8], v_[8]; float bon = 0.f, sy = 0.f;
#pragma unroll
        for (int i = 0; i < 8; ++i) { const float r_ = mixf(rc[i], rm[i], rp[i], mur[i]), k_ = mixf(kc[i], km[i], kp[i], muk[i]); v_[i] = mixf(vc[i], vm[i], vp[i], muv[i]);
            bon += r_ * k_ * (2.f + (a0[i] + a1[i] - 2.f) * ka[i]) * rk[i]; y[i] = yf[i] + yb[i]; sy += y[i]; }
        bon = sum8(bon); const float mean = sum8(sy) * (1.f / 64.f);
        float sv = 0.f;
#pragma unroll
        for (int i = 0; i < 8; ++i) { y[i] -= mean; sv += y[i] * y[i]; }
        const float rstd = rsqrtf(sum8(sv) * (1.f / 64.f) + 64e-5f);
        float o[8];
#pragma unroll
        for (int i = 0; i < 8; ++i) o[i] = (y[i] * rstd * lw[i] + lb[i] + bon * v_[i]) * gg[i];
        u32x4 w; w.x = pk(o[0], o[1]); w.y = pk(o[2], o[3]); w.z = pk(o[4], o[5]); w.w = pk(o[6], o[7]);
        *(u32x4*)(ycat + (size_t)tok * DM + 1024 + c8) = w; }
    __syncthreads();
}

DEV float logsig(float x) { return fminf(x, 0.f) - __logf(1.f + __expf(-fabsf(x))); }
DEV void gla_intra_task(const Params& p, int task, unsigned char* shm) {
    const int tid = tidx(), wid = tid >> 6, lane = tid & 63, l15 = lane & 15, quad = lane >> 4;
    const int cidx = task >> 2, h = task & 3; const int tok0 = cidx * 64;
    u16* P = (u16*)(p.ws + OFF_P); u16* QB = (u16*)(p.ws + OFF_A); float* Dbuf = (float*)(p.ws + OFF_DB);
    u16* qi = (u16*)shm; u16* ki = qi + 64 * 264; u16* vl = (u16*)shm; u16* Pl = (u16*)(shm + 67584); float* gl = (float*)(shm + 76800); float* tot = (float*)(shm + 84992);
    for (int i = tid; i < 2048; i += 512) { const int tl = i >> 5, c = i & 31; gl[i] = bf2f(P[(size_t)(tok0 + tl) * LDP1 + 6144 + c]); }
    __syncthreads();
    const int k = tid & 255, jh = tid >> 8;
#pragma unroll 1
    for (int dd = 0; dd < 2; ++dd) { const int dir = 1 - dd;
        float g2r[16];
#pragma unroll
        for (int r = 0; r < 16; ++r) g2r[r] = p.in[38][(size_t)(dir * 16 + r) * 1024 + h * 256 + k];
        const float gb = p.in[39][dir * 1024 + h * 256 + k];
        float bl[32]; float run = 0.f;
#pragma unroll
        for (int jj = 0; jj < 32; ++jj) { const int j = jh * 32 + jj; const int tl = dir ? 63 - j : j; const float* gr = gl + tl * 32 + dir * 16;
            float x = gb;
#pragma unroll
            for (int r = 0; r < 16; r += 4) { const float4 g4 = *(const float4*)(gr + r); x += g4.x * g2r[r] + g4.y * g2r[r + 1] + g4.z * g2r[r + 2] + g4.w * g2r[r + 3]; }
            run += logsig(x) * 0.0625f; bl[jj] = run; }
        tot[jh * 256 + k] = run;
        __syncthreads();
        const float t0v = tot[k], t1v = tot[256 + k]; const float off = jh ? t0v : 0.f; const float bref = t0v, blast = t0v + t1v;
        if (jh == 0) Dbuf[((size_t)cidx * 2 + dir) * 1024 + h * 256 + k] = __expf(blast);
        u16* qdst; u16* kdst; size_t ldd;
        if (dir == 0) { qdst = P + h * 256 + k; kdst = P + 1024 + h * 256 + k; ldd = LDP1; } else { qdst = QB + h * 256 + k; kdst = QB + 1024 + h * 256 + k; ldd = 2048; }
#pragma unroll
        for (int jj = 0; jj < 32; ++jj) { const int j = jh * 32 + jj; const int tl = dir ? 63 - j : j; const size_t tok = (size_t)tok0 + tl;
            const float qv = bf2f(P[tok * LDP1 + h * 256 + k]) * 0.0625f, kv = bf2f(P[tok * LDP1 + 1024 + h * 256 + k]);
            const float b = bl[jj] + off;
            qi[j * 264 + k] = f2bf(qv * __expf(b - bref)); ki[j * 264 + k] = f2bf(kv * __expf(bref - b));
            qdst[tok * ldd] = f2bf(qv * __expf(b)); kdst[tok * ldd] = f2bf(kv * __expf(blast - b)); }
        __syncthreads();
        { const int tt = wid >> 1;
#pragma unroll
            for (int q2 = 0; q2 < 2; ++q2) { const int st = (wid & 1) * 2 + q2; f32x4 acc = (f32x4){0.f, 0.f, 0.f, 0.f};
                if (st <= tt) {
#pragma unroll
                    for (int ks = 0; ks < 8; ++ks) { const bf16x8 a = *(const bf16x8*)(qi + (tt * 16 + l15) * 264 + ks * 32 + quad * 8); const bf16x8 b = *(const bf16x8*)(ki + (st * 16 + l15) * 264 + ks * 32 + quad * 8);
                        acc = mfma16(a, b, acc); } }
#pragma unroll
                for (int r = 0; r < 4; ++r) { const int t = tt * 16 + quad * 4 + r, s_ = st * 16 + l15; Pl[t * 72 + s_] = f2bf(s_ <= t ? acc[r] : 0.f); } } }
        __syncthreads();
#pragma unroll
        for (int i = 0; i < 8; ++i) { const int piece = tid + 512 * i; const int j = piece >> 6, c8 = (piece & 63) * 8; const int tl = dir ? 63 - j : j;
            *(u32x4*)(vl + j * 520 + c8) = *(const u32x4*)(P + (size_t)(tok0 + tl) * LDP1 + 2048 + h * 512 + c8); }
        __syncthreads();
        u16* O = (u16*)(p.ws + (dir ? OFF_OB : OFF_OF)) + h * 512;
#pragma unroll 1
        for (int q4 = 0; q4 < 4; ++q4) { const int vt = wid * 4 + q4; f32x4 acc[4];
#pragma unroll
            for (int tt = 0; tt < 4; ++tt) acc[tt] = (f32x4){0.f, 0.f, 0.f, 0.f};
#pragma unroll
            for (int ss = 0; ss < 2; ++ss) { bf16x8 bfr;
#pragma unroll
                for (int jj = 0; jj < 8; ++jj) bfr[jj] = (short)vl[(ss * 32 + quad * 8 + jj) * 520 + vt * 16 + l15];
#pragma unroll
                for (int tt = 0; tt < 4; ++tt) { if (ss * 32 <= tt * 16 + 15) { const bf16x8 a = *(const bf16x8*)(Pl + (tt * 16 + l15) * 72 + ss * 32 + quad * 8); acc[tt] = mfma16(a, bfr, acc[tt]); } } }
#pragma unroll
            for (int tt = 0; tt < 4; ++tt)
#pragma unroll
                for (int r = 0; r < 4; ++r) { const int t = tt * 16 + quad * 4 + r; const int tl = dir ? 63 - t : t; O[(size_t)(tok0 + tl) * DM + vt * 16 + l15] = f2bf(acc[tt][r]); } }
        __syncthreads();
    }
}
DEV void gla_inter_task(const Params& p, int task, unsigned char* shm) {
    const bool sample = task < 256; const int tt_ = sample ? task : task - 256;
    const int seq = tt_ >> 3, vs = tt_ & 7; const int b = seq >> 3, h = (seq >> 1) & 3, dir = seq & 1;
    const int L = sample ? 4096 : 256; const int tok0 = sample ? NTP + b * 4096 : b * 256;
    const int nch = L >> 6, cbase = tok0 >> 6;
    const int tid = tidx(), wid = tid >> 6, lane = tid & 63, l15 = lane & 15, quad = lane >> 4;
    const u16* P = (const u16*)(p.ws + OFF_P); const u16* QB = (const u16*)(p.ws + OFF_A); const float* Dbuf = (const float*)(p.ws + OFF_DB);
    u16* ST = (u16*)shm; u16* qdl = (u16*)(shm + 33792); u16* kdl = (u16*)(shm + 67584); u16* vl = (u16*)(shm + 101376); float* dl = (float*)(shm + 110592);
    f32x4 S[2][4];
    const size_t sbase = (((size_t)b * 2 + dir) * 4 + h) * 256 * 512 + vs * 64;
#pragma unroll
    for (int kt = 0; kt < 2; ++kt)
#pragma unroll
        for (int vt = 0; vt < 4; ++vt)
#pragma unroll
            for (int r = 0; r < 4; ++r) { const int kk = wid * 32 + kt * 16 + quad * 4 + r; S[kt][vt][r] = sample ? p.in[3][sbase + (size_t)kk * 512 + vt * 16 + l15] : 0.f; }
    const u16* qsrc; const u16* ksrc; size_t lds_;
    if (dir == 0) { qsrc = P + h * 256; ksrc = P + 1024 + h * 256; lds_ = LDP1; } else { qsrc = QB + h * 256; ksrc = QB + 1024 + h * 256; lds_ = 2048; }
    const u16* vsrc = P + 2048 + h * 512 + vs * 64;
    u16* O = (u16*)(p.ws + (dir ? OFF_OB : OFF_OF)) + h * 512 + vs * 64;
    u32x4 rq[4], rk[4], rv; float rd = 0.f;
    const int vrow = tid >> 3, vc8 = (tid & 7) * 8;
#define GLA_ISSUE(n_) do { const int cidx_ = cbase + (dir ? nch - 1 - (n_) : (n_)); \
        _Pragma("unroll") for (int i = 0; i < 4; ++i) { const int piece = tid + 512 * i; const int j = piece >> 5, c8 = (piece & 31) * 8; const size_t tok = (size_t)cidx_ * 64 + (dir ? 63 - j : j); \
            rq[i] = *(const u32x4*)(qsrc + tok * lds_ + c8); rk[i] = *(const u32x4*)(ksrc + tok * lds_ + c8); } \
        { const size_t tok = (size_t)cidx_ * 64 + (dir ? 63 - vrow : vrow); rv = *(const u32x4*)(vsrc + tok * LDP1 + vc8); } \
        if (tid < 256) rd = Dbuf[((size_t)cidx_ * 2 + dir) * 1024 + h * 256 + tid]; } while (0)
#define GLA_WRITE_ST() do { _Pragma("unroll") for (int kt = 0; kt < 2; ++kt) _Pragma("unroll") for (int vt = 0; vt < 4; ++vt) { u32x2 w; w.x = pk(S[kt][vt][0], S[kt][vt][1]); w.y = pk(S[kt][vt][2], S[kt][vt][3]); \
            *(u32x2*)(ST + (vt * 16 + l15) * 264 + wid * 32 + kt * 16 + quad * 4) = w; } } while (0)
    GLA_WRITE_ST();
    GLA_ISSUE(0);
    const int tt = wid >> 1, vb = (wid & 1) * 2;
#pragma unroll 1
    for (int n = 0; n < nch; ++n) {
        const int cidx = cbase + (dir ? nch - 1 - n : n);
#pragma unroll
        for (int i = 0; i < 4; ++i) { const int piece = tid + 512 * i; const int j = piece >> 5, c8 = (piece & 31) * 8; *(u32x4*)(qdl + j * 264 + c8) = rq[i]; *(u32x4*)(kdl + j * 264 + c8) = rk[i]; }
        *(u32x4*)(vl + vrow * 72 + vc8) = rv; if (tid < 256) dl[tid] = rd;
        __syncthreads();
        if (n + 1 < nch) GLA_ISSUE(n + 1);
        float oi[2][4];
#pragma unroll
        for (int q2 = 0; q2 < 2; ++q2)
#pragma unroll
            for (int r = 0; r < 4; ++r) { const int j = tt * 16 + quad * 4 + r; const size_t tok = (size_t)cidx * 64 + (dir ? 63 - j : j); oi[q2][r] = bf2f(O[tok * DM + (vb + q2) * 16 + l15]); }
        f32x4 oacc[2]; oacc[0] = (f32x4){0.f, 0.f, 0.f, 0.f}; oacc[1] = oacc[0];
#pragma unroll
        for (int ks = 0; ks < 8; ++ks) { const bf16x8 a = *(const bf16x8*)(qdl + (tt * 16 + l15) * 264 + ks * 32 + quad * 8);
#pragma unroll
            for (int q2 = 0; q2 < 2; ++q2) { const bf16x8 bfr = *(const bf16x8*)(ST + ((vb + q2) * 16 + l15) * 264 + ks * 32 + quad * 8); oacc[q2] = mfma16(a, bfr, oacc[q2]); } }
#pragma unroll
        for (int kt = 0; kt < 2; ++kt) { const f32x4 dv = *(const f32x4*)(dl + wid * 32 + kt * 16 + quad * 4);
#pragma unroll
            for (int vt = 0; vt < 4; ++vt) S[kt][vt] = S[kt][vt] * dv; }
#pragma unroll
        for (int ts = 0; ts < 2; ++ts) { bf16x8 af[2];
#pragma unroll
            for (int kt = 0; kt < 2; ++kt)
#pragma unroll
                for (int jj = 0; jj < 8; ++jj) af[kt][jj] = (short)kdl[(ts * 32 + quad * 8 + jj) * 264 + wid * 32 + kt * 16 + l15];
#pragma unroll
            for (int vt = 0; vt < 4; ++vt) { bf16x8 bfr;
#pragma unroll
                for (int jj = 0; jj < 8; ++jj) bfr[jj] = (short)vl[(ts * 32 + quad * 8 + jj) * 72 + vt * 16 + l15];
#pragma unroll
                for (int kt = 0; kt < 2; ++kt) S[kt][vt] = mfma16(af[kt], bfr, S[kt][vt]); } }
#pragma unroll
        for (int q2 = 0; q2 < 2; ++q2)
#pragma unroll
            for (int r = 0; r < 4; ++r) { const int j = tt * 16 + quad * 4 + r; const size_t tok = (size_t)cidx * 64 + (dir ? 63 - j : j); O[tok * DM + (vb + q2) * 16 + l15] = f2bf(oi[q2][r] + oacc[q2][r]); }
        __syncthreads();
        GLA_WRITE_ST();
        __syncthreads();
    }
#undef GLA_ISSUE
#undef GLA_WRITE_ST
    if (!sample) { float* so = p.out + OUT_GLAST + sbase;
#pragma unroll
        for (int kt = 0; kt < 2; ++kt)
#pragma unroll
            for (int vt = 0; vt < 4; ++vt)
#pragma unroll
                for (int r = 0; r < 4; ++r) { const int kk = wid * 32 + kt * 16 + quad * 4 + r; so[(size_t)kk * 512 + vt * 16 + l15] = S[kt][vt][r]; } }
    __syncthreads();
}
DEV void phase_gla_post(const Params& p) {
    const int tid = tidx(), wid = tid >> 6, lane = tid & 63;
    const u16* P = (const u16*)(p.ws + OFF_P); const u16* OF = (const u16*)(p.ws + OFF_OF); const u16* OB = (const u16*)(p.ws + OFF_OB); u16* ycat = (u16*)(p.ws + OFF_A);
    for (int it = blockIdx.x * 8 + wid; it < NTOK * 4; it += gridDim.x * 8) { const int tok = it >> 2, h = it & 3; const int v8 = lane * 8;
        float a[8], b[8], g[8]; unpack8(*(const u32x4*)(OF + (size_t)tok * DM + h * 512 + v8), a); unpack8(*(const u32x4*)(OB + (size_t)tok * DM + h * 512 + v8), b);
        unpack8(*(const u32x4*)(P + (size_t)tok * LDP1 + 4096 + h * 512 + v8), g);
        float ss = 0.f;
#pragma unroll
        for (int i = 0; i < 8; ++i) { a[i] += b[i]; ss += a[i] * a[i]; }
        ss = wave_sum(ss); const float sc = rsqrtf(ss * (1.f / 512.f) + 1e-6f);
        float o[8];
#pragma unroll
        for (int i = 0; i < 8; ++i) o[i] = a[i] * sc * p.in[40][v8 + i] * (g[i] * sigm(g[i]));
        u32x4 w; w.x = pk(o[0], o[1]); w.y = pk(o[2], o[3]); w.z = pk(o[4], o[5]); w.w = pk(o[6], o[7]);
        *(u32x4*)(ycat + (size_t)tok * DM + h * 512 + v8) = w; }
}

DEV void gate_loadcol(const u16* U, long tokc, int c8, bool colok, bool up, bool dn, int W, float (*dst)[8]) {
    if (colok && up) unpack8(*(const u32x4*)(U + (size_t)(tokc - W) * LDU + c8), dst[0]); else { for (int i = 0; i < 8; ++i) dst[0][i] = 0.f; }
    if (colok) unpack8(*(const u32x4*)(U + (size_t)tokc * LDU + c8), dst[1]); else { for (int i = 0; i < 8; ++i) dst[1][i] = 0.f; }
    if (colok && dn) unpack8(*(const u32x4*)(U + (size_t)(tokc + W) * LDU + c8), dst[2]); else { for (int i = 0; i < 8; ++i) dst[2][i] = 0.f; }
}
DEV void gate_loadraw(const u16* U, long tokc, int c8, bool colok, bool up, bool dn, int W, u32x4* dst) {
    const u32x4 z = (u32x4){0u, 0u, 0u, 0u};
    dst[0] = z; dst[1] = z; dst[2] = z;
    if (colok && up) dst[0] = *(const u32x4*)(U + (size_t)(tokc - W) * LDU + c8);
    if (colok) dst[1] = *(const u32x4*)(U + (size_t)tokc * LDU + c8);
    if (colok && dn) dst[2] = *(const u32x4*)(U + (size_t)(tokc + W) * LDU + c8);
}
DEV void phase_ffn_gate(const Params& p, int layer) {
    u16* U = (u16*)(p.ws + OFF_U); const float* cw = p.in[11] + (size_t)layer * 9 * DFF;
    const int tid_ = tidx(), wid_ = tid_ >> 6, lane_ = tid_ & 63;
    for (int bu = blockIdx.x; bu < 1408 + 704; bu += gridDim.x) {
        int tokS, c8;
        if (bu < 1408) { const int rg = bu / 44, rem = bu % 44; const int qtr = rem / 11, cgg = rem % 11; tokS = NTP + (rg * 8 + wid_) * 64 + qtr * 16; c8 = (cgg * 64 + lane_) * 8; }
        else { const int pu = bu - 1408; const int sg = pu / 11, cgg = pu % 11; tokS = (sg * 8 + wid_) * 16; c8 = (cgg * 64 + lane_) * 8; }
        int W, colS; bool up, dn;
        if (tokS < NTP) { W = 256; colS = tokS & 255; up = false; dn = false; }
        else { W = 64; colS = tokS & 63; const int rr = ((tokS - NTP) >> 6) & 63; up = rr > 0; dn = rr < 63; }
        float wt[9][8];
#pragma unroll
        for (int q = 0; q < 9; ++q) { const float4 a = *(const float4*)(cw + q * DFF + c8), b = *(const float4*)(cw + q * DFF + c8 + 4);
            wt[q][0] = a.x; wt[q][1] = a.y; wt[q][2] = a.z; wt[q][3] = a.w; wt[q][4] = b.x; wt[q][5] = b.y; wt[q][6] = b.z; wt[q][7] = b.w; }
        float w0[3][8], w1[3][8];
        u32x4 r2[3], r3[3], vraw, vnext;
        gate_loadcol(U, (long)tokS - 1, c8, colS > 0, up, dn, W, w0);
        gate_loadcol(U, (long)tokS, c8, true, up, dn, W, w1);
        gate_loadraw(U, (long)tokS + 1, c8, colS + 1 < W, up, dn, W, r2);
        vraw = *(const u32x4*)(U + (size_t)tokS * LDU + DFF + c8); vnext = vraw;
#pragma unroll 2
        for (int s_ = 0; s_ < 16; ++s_) {
            const long tok = (long)tokS + s_;
            if (s_ + 2 <= 16) gate_loadraw(U, tok + 2, c8, colS + s_ + 2 < W, up, dn, W, r3);
            if (s_ + 1 < 16) vnext = *(const u32x4*)(U + (size_t)(tok + 1) * LDU + DFF + c8);
            float w2[3][8]; unpack8(r2[0], w2[0]); unpack8(r2[1], w2[1]); unpack8(r2[2], w2[2]);
            float v[8]; unpack8(vraw, v);
#pragma unroll
            for (int i = 0; i < 8; ++i) { float a = 0.f;
#pragma unroll
                for (int di = 0; di < 3; ++di) a += w0[di][i] * wt[di * 3][i] + w1[di][i] * wt[di * 3 + 1][i] + w2[di][i] * wt[di * 3 + 2][i];
                v[i] *= a * sigm(a); }
            u32x4 w; w.x = pk(v[0], v[1]); w.y = pk(v[2], v[3]); w.z = pk(v[4], v[5]); w.w = pk(v[6], v[7]);
            *(u32x4*)(U + (size_t)tok * LDU + DFF + c8) = w;
#pragma unroll
            for (int di = 0; di < 3; ++di) {
#pragma unroll
                for (int i = 0; i < 8; ++i) { w0[di][i] = w1[di][i]; w1[di][i] = w2[di][i]; }
                r2[di] = r3[di]; }
            vraw = vnext;
        }
    }
}

DEV void phase_final_norm(const Params& p) {
    const int tid = tidx(), wid = tid >> 6, lane = tid & 63; const float* g = p.in[13];
    const int nw = gridDim.x * 8, wv = blockIdx.x * 8 + wid; const int per = (NTOK + nw - 1) / nw; const int r0 = wv * per, r1 = (r0 + per < NTOK) ? r0 + per : NTOK;
    float4 gg[8];
#pragma unroll
    for (int j = 0; j < 8; ++j) gg[j] = *(const float4*)(g + (lane + 64 * j) * 4);
    for (int row = r0; row < r1; ++row) {
        float4* xr = (float4*)(p.out + (size_t)row * DM);
        float4 v[8]; float ss = 0.f;
#pragma unroll
        for (int j = 0; j < 8; ++j) { v[j] = xr[lane + 64 * j]; ss += v[j].x * v[j].x + v[j].y * v[j].y + v[j].z * v[j].z + v[j].w * v[j].w; }
        ss = wave_sum(ss); const float rstd = rsqrtf(ss * (1.f / 2048.f) + 1e-6f);
#pragma unroll
        for (int j = 0; j < 8; ++j) xr[lane + 64 * j] = make_float4(v[j].x * rstd * gg[j].x, v[j].y * rstd * gg[j].y, v[j].z * rstd * gg[j].z, v[j].w * rstd * gg[j].w);
    }
}

#define XB_TMO      128
#define XB_XCNT(j)  (256  + 64 * (j))
#define XB_XSUB(j)  (1280 + 64 * (j))
#define XB_XGEN(j)  (2304 + 64 * (j))
#define XB_TOP      3328
#define XB_TOPGEN   3392
#define XCD_BAR_WORDS 3456
#define XB_SPIN_CAP (1u << 18)
DEV unsigned xb_ld(unsigned* p)              { return __hip_atomic_load(p, __ATOMIC_RELAXED, __HIP_MEMORY_SCOPE_AGENT); }
DEV unsigned xb_add(unsigned* p, unsigned v) { return __hip_atomic_fetch_add(p, v, __ATOMIC_RELAXED, __HIP_MEMORY_SCOPE_AGENT); }
DEV unsigned xb_xcc_id() { return (unsigned)__builtin_amdgcn_s_getreg((3 << 11) | 20) & 0xFu; }
#define XB_SPIN(cond, bar) do { unsigned _sp = 0; while (cond) { __builtin_amdgcn_s_sleep(1); \
    if ((++_sp & 255u) == 0u) { if (xb_ld(&(bar)[XB_TMO])) break; if (_sp > XB_SPIN_CAP) { atomicAdd(&(bar)[XB_TMO], 1u); break; } } } } while (0)
struct XcdBarrier { unsigned* bar; unsigned x; volatile LAS unsigned* st; };
DEV XcdBarrier xcd_barrier_post(unsigned* bar, volatile LAS unsigned* st) {
    XcdBarrier b; b.bar = bar; b.x = xb_xcc_id(); b.st = st;
    if (threadIdx.x == 0) (void)xb_add(&bar[XB_XCNT(b.x)], 1u);
    return b;
}
DEV void xcd_barrier_complete(unsigned* bar, unsigned x, unsigned& nloc, unsigned& nx) {
    const unsigned G = gridDim.x * gridDim.y * gridDim.z;
    unsigned sum, cnt, mine, sp = 0u;
    for (;;) {
        sum = 0u; cnt = 0u; mine = 0u;
#pragma unroll
        for (unsigned j = 0; j < 16; ++j) { const unsigned c = xb_ld(&bar[XB_XCNT(j)]); sum += c; cnt += (c > 0u) ? 1u : 0u; mine = (j == x) ? c : mine; }
        if (sum == G) break;
        __builtin_amdgcn_s_sleep(1);
        if ((++sp & 255u) == 0u) { if (xb_ld(&bar[XB_TMO])) break; if (sp > XB_SPIN_CAP) { atomicAdd(&bar[XB_TMO], 1u); break; } }
    }
    nloc = mine > 0u ? mine : 1u; nx = cnt > 0u ? cnt : 1u;
}
DEV void xcd_barrier(const XcdBarrier& b) {
    asm volatile("s_waitcnt vmcnt(0)" ::: "memory");
    __syncthreads();
    if (threadIdx.x == 0) {
        unsigned* bar = b.bar;
        __builtin_amdgcn_s_waitcnt(0);
        unsigned nloc = b.st[0], nx = b.st[1];
        if (nloc == 0u) { xcd_barrier_complete(bar, b.x, nloc, nx); b.st[0] = nloc; b.st[1] = nx; }
        const unsigned old = xb_add(&bar[XB_XSUB(b.x)], 1u);
        const unsigned gen = old / nloc;
        if (old + 1u == (gen + 1u) * nloc) {
            __builtin_amdgcn_fence(__ATOMIC_RELEASE, "agent");
            asm volatile("s_waitcnt vmcnt(0)" ::: "memory");
            const unsigned og = xb_add(&bar[XB_TOP], 1u);
            const unsigned tg = og / nx;
            if (og + 1u == (tg + 1u) * nx) xb_add(&bar[XB_TOPGEN], 1u);
            else XB_SPIN(xb_ld(&bar[XB_TOPGEN]) == tg, bar);
            __builtin_amdgcn_fence(__ATOMIC_ACQUIRE, "agent");
            xb_add(&bar[XB_XGEN(b.x)], 1u);
            asm volatile("s_waitcnt vmcnt(0)" ::: "memory");
        } else {
            XB_SPIN(xb_ld(&bar[XB_XGEN(b.x)]) == gen, bar);
            __builtin_amdgcn_fence(__ATOMIC_ACQUIRE, "agent");
            asm volatile("s_waitcnt vmcnt(0)" ::: "memory");
        }
    }
    __syncthreads();
}

__global__ void __launch_bounds__(512, 2) mega(Params p0) {
    extern __shared__ __attribute__((aligned(16))) unsigned char shm[];
    cg::grid_group grid = cg::this_grid();
    __shared__ uint4 xb_words;
    if (threadIdx.x == 0) xb_words = make_uint4(0u, 0u, 0u, 0u);
    __syncthreads();
    (void)xcd_barrier_post((unsigned*)(p0.ws + OFF_SMALL + SMALL_BYTES + 256), (volatile LAS unsigned*)&xb_words);
#define XBAR() do { XcdBarrier xb_; xb_.bar = (unsigned*)(launder(p0).ws + OFF_SMALL + SMALL_BYTES + 256); xb_.x = xb_xcc_id(); xb_.st = (volatile LAS unsigned*)&xb_words; xcd_barrier(xb_); } while (0)
    float* sm = (float*)shm;
    const int G = (int)gridDim.x, B = (int)blockIdx.x;

#ifndef SK_PREP
    phase_prep(launder(p0), shm);
#ifdef PROBE_MISC
    __syncthreads(); phase_prep(launder(p0), shm);
#endif
#endif
    grid.sync();
    phase_reduce(launder(p0));
    XBAR();
#pragma unroll 1
    for (int layer = 0; layer < 2; ++layer) {
#ifndef SK_NORM
        phase_norm(launder(p0), layer, 0, shm);
#ifdef PROBE_MISC
        __syncthreads(); phase_norm(launder(p0), layer, 0, shm);
#endif
#endif
        XBAR();
        { const Params p = launder(p0); const u16* A = (const u16*)(p.ws + OFF_A); pg8::EpiBf16 E; E.O = (u16*)(p.ws + OFF_P); E.ldc = layer ? LDP1 : LDP0;
#if !defined(SK_GEMM) && !defined(SK_GBF)
            run_gemm(shm, A, DM, (const u16*)(p.ws + OFF_WIN), DM, layer ? LDP1 : LDP0, DM, E);
#ifdef PROBE_GEMM
            __syncthreads(); run_gemm(shm, A, DM, (const u16*)(p.ws + OFF_WIN), DM, layer ? LDP1 : LDP0, DM, E);
#endif
#endif
        }
        XBAR();
        if (layer == 0) {
#ifndef SK_PRE
            { const Params p = launder(p0); hy_pre_stream(p, sm); }
            { const Params p = launder(p0); for (int t = B + ((6144 - B + G - 1) / G) * G; t < 6144 + 768; t += G) rwkv_lora_tile(p, t - 6144, shm); }
#ifdef PROBE_MISC
            { const Params p = launder(p0); for (int t = B; t < 6144 + 768; t += G) { if (t < 6144) hy_pre_tile(p, t, sm); else rwkv_lora_tile(p, t - 6144, shm); } }
#endif
#endif
            XBAR();
            { const Params p = launder(p0); unsigned* ctr = (unsigned*)(p.ws + OFF_SMALL + SMALL_BYTES);
                for (int t = B; t < 128; t += G) rwkv_scan_task(p, t, sm);
                for (;;) { if (tidx() == 0) *(volatile unsigned*)shm = atomicAdd(ctr, 1u); __syncthreads(); const unsigned t = *(volatile unsigned*)shm; __syncthreads();
                    if (t >= 1024u + 2048u) break;
                    if (t < 1024u) rwkv_scan_task(p, 128 + (int)t, sm); else hyconv_task(p, (int)t - 1024, shm); } }
            XBAR();
#ifndef SK_POST
            { const Params p = launder(p0); hy_post_stream(p, sm); }
            { const Params p = launder(p0); for (int t = B + ((6144 - B + G - 1) / G) * G; t < 6144 + 768; t += G) rwkv_post_tile(p, t - 6144, sm); }
#ifdef PROBE_MISC
            { const Params p = launder(p0); for (int t = B; t < 6144 + 768; t += G) { if (t < 6144) hy_post_tile(p, t, sm); else rwkv_post_tile(p, t - 6144, sm); } }
#endif
#endif
            XBAR();
        } else {
#ifndef SK_GLA
            { const Params p = launder(p0); for (int t = B; t < 1536; t += G) gla_intra_task(p, t, shm); }
            XBAR();
            { const Params p = launder(p0); for (int t = B; t < 256 + 2048; t += G) gla_inter_task(p, t, shm); }
#endif
            XBAR();
#ifndef SK_GLAP
            phase_gla_post(launder(p0));
#ifdef PROBE_MISC
            phase_gla_post(launder(p0));
#endif
#endif
            XBAR();
        }
        { const Params p = launder(p0); const u16* A = (const u16*)(p.ws + OFF_A); const float* mods = (const float*)(p.ws + OFF_SMALL); pg8::EpiRes E; E.X = p.out; E.gm = mods + (size_t)layer * 5 * 12288 + 2 * 2048; E.gb = p.in[7] + layer * 12288 + 2 * 2048;
#if !defined(SK_GEMM) && !defined(SK_GRES)
            run_gemm(shm, A, DM, (const u16*)(p.ws + OFF_WOUT), DM, DM, DM, E);
#endif
        }
        XBAR();
#ifndef SK_NORM
        phase_norm(launder(p0), layer, 1, shm);
#ifdef PROBE_MISC
        __syncthreads(); phase_norm(launder(p0), layer, 1, shm);
#endif
#endif
        XBAR();
        { const Params p = launder(p0); const u16* A = (const u16*)(p.ws + OFF_A); pg8::EpiBf16 E; E.O = (u16*)(p.ws + OFF_U); E.ldc = LDU;
#if !defined(SK_GEMM) && !defined(SK_GBF)
            run_gemm(shm, A, DM, (const u16*)(p.ws + OFF_WUP), DM, LDU, DM, E);
#ifdef PROBE_GEMM
            __syncthreads(); run_gemm(shm, A, DM, (const u16*)(p.ws + OFF_WUP), DM, LDU, DM, E);
#endif
#endif
        }
        XBAR();
#ifndef SK_GATE
        phase_ffn_gate(launder(p0), layer);
#endif
        XBAR();
        { const Params p = launder(p0); const float* mods = (const float*)(p.ws + OFF_SMALL); pg8::EpiRes E; E.X = p.out; E.gm = mods + (size_t)layer * 5 * 12288 + 5 * 2048; E.gb = p.in[7] + layer * 12288 + 5 * 2048;
#if !defined(SK_GEMM) && !defined(SK_GRES)
            run_gemm(shm, (const u16*)(p.ws + OFF_U) + DFF, LDU, (const u16*)(p.ws + OFF_WDN), DFF, DM, DFF, E);
#endif
        }
        XBAR();
    }
    phase_final_norm(launder(p0));
}

extern "C" void kernel_launch(void* const* d_in, const int* in_sizes, int n_in, void* d_out, int out_size, void* d_ws, size_t ws_size, hipStream_t stream) {
    constexpr size_t kDynLds = 131072;
    static int grid_blocks = 0;
    if (!grid_blocks) {
        int dev = 0, cus = 0, per_cu = 0;
        hipGetDevice(&dev);
        hipDeviceGetAttribute(&cus, hipDeviceAttributeMultiprocessorCount, dev);
        hipFuncSetAttribute((const void*)mega, hipFuncAttributeMaxDynamicSharedMemorySize, (int)kDynLds);
        hipOccupancyMaxActiveBlocksPerMultiprocessor(&per_cu, mega, 512, kDynLds);
        if (per_cu < 1) per_cu = 1;
        grid_blocks = cus * per_cu;
        if (grid_blocks > 256) grid_blocks = 256;
    }
    if (ws_size < WS_NEED || n_in < 41) { fprintf(stderr, "workspace too small: %zu < %zu\n", ws_size, WS_NEED); return; }
    Params p{};
    for (int i = 0; i < 41; ++i) p.in[i] = (const float*)d_in[i];
    p.out = (float*)d_out; p.ws = (unsigned char*)d_ws;
    hipMemsetAsync((unsigned char*)d_ws + OFF_SMALL + SMALL_BYTES, 0, 256 + XCD_BAR_BYTES, stream);
    void* args[] = {&p};
    hipError_t e = hipLaunchCooperativeKernel((const void*)mega, dim3(grid_blocks), dim3(512), args, kDynLds, stream);
    if (e != hipSuccess) fprintf(stderr, "cooperative launch failed: %s (grid %d)\n", hipGetErrorString(e), grid_blocks);
}
```

```cpp
#include <hip/hip_runtime.h>
#include <hip/hip_cooperative_groups.h>
#include <cstdio>
namespace cg = cooperative_groups;

#define DEV __device__ __forceinline__
#define LAS __attribute__((address_space(3)))
typedef unsigned short u16;
typedef short bf16x8 __attribute__((ext_vector_type(8)));
typedef float f32x4 __attribute__((ext_vector_type(4)));
typedef float f32x2 __attribute__((ext_vector_type(2)));
typedef float f32x16 __attribute__((ext_vector_type(16)));
typedef unsigned u32x2 __attribute__((ext_vector_type(2)));
typedef unsigned u32x4 __attribute__((ext_vector_type(4)));

constexpr int NTOK = 24576, NTP = 8192, DM = 2048;
constexpr int LDP0 = 6656, LDP1 = 6400, LDU = 11264, DFF = 5632;
constexpr size_t OFF_WIN = 0, OFF_WOUT = 27262976, OFF_WUP = 35651584, OFF_WDN = OFF_WUP + 46137344;
constexpr size_t OFF_A = 104857600, OFF_BIG = 205520896;
constexpr size_t OFF_P = OFF_BIG, OFF_RW = OFF_BIG + 327155712, OFF_UT = OFF_RW + 201326592, OFF_GS = OFF_UT + 50331648, OFF_GP = OFF_GS + 16777216;
constexpr size_t OFF_U = OFF_BIG, OFF_OF = OFF_BIG + 314572800, OFF_OB = OFF_OF + 100663296, OFF_DB = OFF_OB + 100663296;
constexpr size_t OFF_SMALL = OFF_BIG + 600000000, SMALL_BYTES = 491520 + 8192;
constexpr size_t XCD_BAR_BYTES = 3456 * 4;
constexpr size_t OFF_LW = OFF_SMALL + SMALL_BYTES + 256 + XCD_BAR_BYTES;
constexpr size_t OFF_G2T = OFF_LW + 524288;
constexpr size_t WS_NEED = OFF_G2T + 262144;
constexpr size_t OUT_RWST = 50331648, OUT_GLAST = 54525952;

struct Params {
    const float* in[41];
    float* out;
    unsigned char* ws;
};

DEV int tidx() { int t = threadIdx.x; asm volatile("" : "+v"(t)); return t; }
DEV Params launder(const Params& p) { Params q = p; asm volatile("" : "+s"(q.ws), "+s"(q.out)); return q; }
DEV float bf2f(unsigned b) { return __uint_as_float(b << 16); }
DEV float bflo(unsigned w) { return __uint_as_float(w << 16); }
DEV float bfhi(unsigned w) { return __uint_as_float(w & 0xffff0000u); }
DEV unsigned pk(float lo, float hi) { unsigned r; asm("v_cvt_pk_bf16_f32 %0, %1, %2" : "=v"(r) : "v"(lo), "v"(hi)); return r; }
DEV u16 f2bf(float f) { return (u16)(pk(f, 0.f) & 0xffffu); }
DEV float wave_sum(float v) {
#pragma unroll
    for (int o = 32; o > 0; o >>= 1) v += __shfl_xor(v, o);
    return v;
}
template <int CTRL> DEV float dppf(float x) { return __builtin_bit_cast(float, __builtin_amdgcn_update_dpp(0, __builtin_bit_cast(int, x), CTRL, 0xf, 0xf, true)); }
DEV float sum8(float v) { v += dppf<0xB1>(v); v += dppf<0x4E>(v); v += dppf<0x141>(v); return v; }
DEV float sum16(float v) { v = sum8(v); v += dppf<0x140>(v); return v; }
DEV f32x4 mfma16(bf16x8 a, bf16x8 b, f32x4 c) { return __builtin_amdgcn_mfma_f32_16x16x32_bf16(a, b, c, 0, 0, 0); }
DEV float sigm(float x) { return __builtin_amdgcn_rcpf(1.f + __expf(-x)); }
DEV int tok_cond(int tok) { return tok < NTP ? 4 : ((tok - NTP) >> 12); }
DEV void tok_tl(int tok, int& t, int& L) { if (tok < NTP) { t = tok & 255; L = 256; } else { t = (tok - NTP) & 4095; L = 4096; } }
DEV void unpack8(u32x4 w, float* o) { o[0] = bflo(w.x); o[1] = bfhi(w.x); o[2] = bflo(w.y); o[3] = bfhi(w.y); o[4] = bflo(w.z); o[5] = bfhi(w.z); o[6] = bflo(w.w); o[7] = bfhi(w.w); }
DEV void unpack4(u32x2 w, float* o) { o[0] = bflo(w.x); o[1] = bfhi(w.x); o[2] = bflo(w.y); o[3] = bfhi(w.y); }

namespace pg8 {
constexpr int BM = 256, BK = 64, HALF = 128, HTB = HALF * BK * 2, NXCD = 8, WGM = 8;
DEV int lds_byte(int r, int c) { const int st = (r >> 4) * 2 + (c >> 5), rr = r & 15, cc = c & 31, ob = rr * 64 + cc * 2; return st * 1024 + (ob ^ (((ob >> 9) & 1) << 5)); }
DEV void stage_rc(int b, int& R, int& C) { const int st = b / 1024, sb = b % 1024, swz = sb ^ (((sb >> 9) & 1) << 5); R = (st >> 1) * 16 + swz / 64; C = (st & 1) * 32 + (swz % 64) / 2; }
DEV int perm32(int rho) { const int n = rho >> 4, i = rho & 15; return 8 * (i >> 2) + 4 * n + (i & 3); }
struct Unit { int pm, pn; };
struct Gemm { const u16* A; const u16* Bt; int M, N, K, lda, ldb; };
struct StaticOrder {
    int nM, nN, nwg, G, c;
    DEV void init(int M, int N, int G_, int c_) { nM = M / BM; nN = N / BM; nwg = nM * nN; G = G_; c = c_; }
    DEV bool next(int i, Unit& u) const {
        const long L = (long)i * G + c; if (L >= nwg) return false;
        int wgid = (int)L; { const int q = nwg / NXCD, r = nwg % NXCD, xcd = wgid % NXCD, off = wgid / NXCD; wgid = (xcd < r ? xcd * (q + 1) : r * (q + 1) + (xcd - r) * q) + off; }
        const int nig = WGM * nN, gid = wgid / nig, fm = gid * WGM, gsz = (nM - fm) < WGM ? (nM - fm) : WGM;
        u.pm = fm + ((wgid % nig) % gsz); u.pn = (wgid % nig) / gsz; return true;
    }
};
struct EpiBf16 {
    static constexpr bool PERM = true;
    u16* O; int ldc;
    DEV void operator()(const f32x4 (&acc)[2][2][4][2], const Unit& u, int wr, int wc, int fr, int fq) const {
        const int row0 = u.pm * BM + wr * 64 + fr; const int col0 = u.pn * BM + wc * 32 + 8 * fq;
#pragma unroll
        for (int ai = 0; ai < 2; ++ai)
#pragma unroll
            for (int m = 0; m < 4; ++m) { u16* rowp = O + (size_t)(row0 + ai * HALF + m * 16) * ldc + col0;
#pragma unroll
                for (int bj = 0; bj < 2; ++bj) { const f32x4 v0 = acc[ai][bj][m][0], v1 = acc[ai][bj][m][1];
                    u32x4 w; w.x = pk(v0[0], v0[1]); w.y = pk(v0[2], v0[3]); w.z = pk(v1[0], v1[1]); w.w = pk(v1[2], v1[3]);
                    *(u32x4*)(rowp + bj * HALF) = w; } }
    }
};
struct EpiRes {
    static constexpr bool PERM = false;
    float* X; const float* gm; const float* gb;
    DEV void operator()(const f32x4 (&acc)[2][2][4][2], const Unit& u, int wr, int wc, int fr, int fq) const {
        const int row0 = u.pm * BM + wr * 64 + fr, col0 = u.pn * BM + wc * 32 + 4 * fq;
        const int cond = u.pm < 32 ? 4 : ((u.pm - 32) >> 4);
        const float* gmc = gm + (size_t)cond * 12288 + col0; const float* gbc = gb + col0;
        f32x4 gv[2][2];
#pragma unroll
        for (int bj = 0; bj < 2; ++bj)
#pragma unroll
            for (int n = 0; n < 2; ++n) gv[bj][n] = *(const f32x4*)(gmc + bj * HALF + n * 16) + *(const f32x4*)(gbc + bj * HALF + n * 16);
        f32x4 xb[3][2][2];
#pragma unroll
        for (int pre = 0; pre < 2; ++pre) { const float* rown = X + (size_t)(row0 + (pre >> 2) * HALF + (pre & 3) * 16) * DM + col0;
#pragma unroll
            for (int bj = 0; bj < 2; ++bj)
#pragma unroll
                for (int n = 0; n < 2; ++n) xb[pre][bj][n] = *(const f32x4*)(rown + bj * HALF + n * 16); }
#pragma unroll
        for (int gidx = 0; gidx < 8; ++gidx) { const int ai = gidx >> 2, m = gidx & 3;
            float* rowp = X + (size_t)(row0 + ai * HALF + m * 16) * DM + col0;
            if (gidx + 2 < 8) { const int g2 = gidx + 2; const float* rown = X + (size_t)(row0 + (g2 >> 2) * HALF + (g2 & 3) * 16) * DM + col0;
#pragma unroll
                for (int bj = 0; bj < 2; ++bj)
#pragma unroll
                    for (int n = 0; n < 2; ++n) xb[g2 % 3][bj][n] = *(const f32x4*)(rown + bj * HALF + n * 16); }
#pragma unroll
            for (int bj = 0; bj < 2; ++bj)
#pragma unroll
                for (int n = 0; n < 2; ++n) *(f32x4*)(rowp + bj * HALF + n * 16) = xb[gidx % 3][bj][n] + gv[bj][n] * acc[ai][bj][m][n];
        }
    }
};

template <class Epi>
DEV void gemm_phase(LAS unsigned char* lds, const Gemm g, const StaticOrder& S, const Epi& E) {
    const int tid = tidx(), wid = __builtin_amdgcn_readfirstlane(tid >> 6), lane = tid & 63, wr = wid >> 2, wc = wid & 3, fr = lane & 15, fq = lane >> 4;
    const int K = g.K, nt = K / BK;
    unsigned voffA[2], voffB[2];
#pragma unroll
    for (int i = 0; i < 2; ++i) { int R, C; stage_rc(tid * 16 + i * 8192, R, C); const int Rb = Epi::PERM ? ((R & ~31) + perm32(R & 31)) : R;
        voffA[i] = (unsigned)(R * g.lda + C) * 2u; voffB[i] = (unsigned)(Rb * g.ldb + C) * 2u; }
    const size_t kstep = (size_t)(BK * 2);
    const size_t hstepA = (size_t)HALF * g.lda * 2, hstepB = (size_t)HALF * g.ldb * 2;
    const size_t tstepA = 2 * hstepA, tstepB = 2 * hstepB;
    const unsigned ldsw = (unsigned)wid * 1024u;
    const int aoff = lds_byte(wr * 64 + fr, fq * 8), boff = lds_byte(wc * 32 + fr, fq * 8);
#define PG8_SA(b, h) (((b) * 2 + (h)) * HTB)
#define PG8_SB(b, h) ((4 + (b) * 2 + (h)) * HTB)
#define PG8_STAGE(bufoff, gbase, voff) do { _Pragma("unroll") for (int _i = 0; _i < 2; ++_i) \
        __builtin_amdgcn_global_load_lds((const unsigned*)((const char*)(gbase) + (voff)[_i]), (LAS unsigned*)(lds + (bufoff) + ldsw + _i * 8192), 16, 0, 0); } while (0)
#define PG8_LDA(dst, b, h) do { _Pragma("unroll") for (int m = 0; m < 4; ++m) _Pragma("unroll") for (int k = 0; k < 2; ++k) dst[m][k] = *(const LAS bf16x8*)(lds + PG8_SA(b, h) + aoff + m * 2048 + k * 1024); } while (0)
#define PG8_LDB(dst, b, h) do { _Pragma("unroll") for (int n = 0; n < 2; ++n) _Pragma("unroll") for (int k = 0; k < 2; ++k) dst[n][k] = *(const LAS bf16x8*)(lds + PG8_SB(b, h) + boff + n * 2048 + k * 1024); } while (0)
#define PG8_MMA(ai, bj, At, Bt) do { __builtin_amdgcn_s_setprio(1); _Pragma("unroll") for (int m = 0; m < 4; ++m) _Pragma("unroll") for (int n = 0; n < 2; ++n) _Pragma("unroll") for (int k = 0; k < 2; ++k) \
        acc[ai][bj][m][n] = __builtin_amdgcn_mfma_f32_16x16x32_bf16(Bt[n][k], At[m][k], acc[ai][bj][m][n], 0, 0, 0); __builtin_amdgcn_s_setprio(0); } while (0)
#define PG8_WAIT_V(n) asm volatile("s_waitcnt vmcnt(" #n ")" ::: "memory")
#define PG8_WAIT_L(n) asm volatile("s_waitcnt lgkmcnt(" #n ")" ::: "memory")
#define PG8_BAR __builtin_amdgcn_s_barrier()
#define PG8_SCHED __builtin_amdgcn_sched_barrier(0)
    Unit cur, nxt; int ui = 0;
    if (!S.next(0, cur)) return;
    f32x4 acc[2][2][4][2];
#pragma unroll
    for (int a = 0; a < 2; ++a)
#pragma unroll
        for (int b = 0; b < 2; ++b)
#pragma unroll
            for (int m = 0; m < 4; ++m)
#pragma unroll
                for (int n = 0; n < 2; ++n) acc[a][b][m][n] = (f32x4){0.f, 0.f, 0.f, 0.f};
    bf16x8 At[4][2], B0[2][2], B1[2][2];
    const char* cA = (const char*)g.A + (size_t)cur.pm * tstepA; const char* cB = (const char*)g.Bt + (size_t)cur.pn * tstepB;
    PG8_STAGE(PG8_SB(0, 0), cB, voffB); PG8_STAGE(PG8_SA(0, 0), cA, voffA); PG8_STAGE(PG8_SB(0, 1), cB + hstepB, voffB); PG8_STAGE(PG8_SA(0, 1), cA + hstepA, voffA);
    if (wr == 1) PG8_BAR;
    PG8_WAIT_V(4); PG8_BAR;
    PG8_STAGE(PG8_SB(1, 0), cB + kstep, voffB); PG8_STAGE(PG8_SA(1, 0), cA + kstep, voffA); PG8_STAGE(PG8_SB(1, 1), cB + hstepB + kstep, voffB);
    PG8_WAIT_V(6); PG8_BAR;
    for (;;) {
        const bool has_next = S.next(ui + 1, nxt);
        const char* nA = has_next ? (const char*)g.A + (size_t)nxt.pm * tstepA : cA; const char* nB = has_next ? (const char*)g.Bt + (size_t)nxt.pn * tstepB : cB;
        for (int t = 0; t < nt; t += 2) {
            const bool last = (t == nt - 2);
            const char* a1 = cA + (size_t)(t + 1) * kstep;
            const char* a2 = last ? nA : cA + (size_t)(t + 2) * kstep; const char* b2 = last ? nB : cB + (size_t)(t + 2) * kstep;
            const char* a3 = a2 + kstep; const char* b3 = b2 + kstep;
            PG8_LDB(B0, 0, 0); PG8_SCHED; PG8_LDA(At, 0, 0); PG8_STAGE(PG8_SA(1, 1), a1 + hstepA, voffA);
            PG8_WAIT_L(8); PG8_BAR; PG8_WAIT_L(0); PG8_MMA(0, 0, At, B0); PG8_BAR; PG8_SCHED;
            PG8_LDB(B1, 0, 1); PG8_STAGE(PG8_SB(0, 0), b2, voffB);
            PG8_BAR; PG8_WAIT_L(0); PG8_MMA(0, 1, At, B1); PG8_BAR;
            PG8_LDA(At, 0, 1); PG8_STAGE(PG8_SA(0, 0), a2, voffA);
            PG8_BAR; PG8_WAIT_L(0); PG8_MMA(1, 0, At, B0); PG8_BAR; PG8_SCHED;
            PG8_STAGE(PG8_SB(0, 1), b2 + hstepB, voffB);
            PG8_WAIT_V(6); PG8_BAR; PG8_MMA(1, 1, At, B1); PG8_BAR;
            PG8_LDB(B0, 1, 0); PG8_SCHED; PG8_LDA(At, 1, 0); PG8_STAGE(PG8_SA(0, 1), a2 + hstepA, voffA);
            PG8_WAIT_L(8); PG8_BAR; PG8_WAIT_L(0); PG8_MMA(0, 0, At, B0); PG8_BAR; PG8_SCHED;
            PG8_LDB(B1, 1, 1); PG8_STAGE(PG8_SB(1, 0), b3, voffB);
            PG8_BAR; PG8_WAIT_L(0); PG8_MMA(0, 1, At, B1); PG8_BAR;
            PG8_LDA(At, 1, 1); PG8_STAGE(PG8_SA(1, 0), a3, voffA);
            PG8_BAR; PG8_WAIT_L(0); PG8_MMA(1, 0, At, B0); PG8_BAR; PG8_SCHED;
            PG8_STAGE(PG8_SB(1, 1), b3 + hstepB, voffB);
            PG8_WAIT_V(6); PG8_BAR; PG8_MMA(1, 1, At, B1); PG8_BAR;
        }
        E(acc, cur, wr, wc, fr, fq);
        if (!has_next) break;
#pragma unroll
        for (int a = 0; a < 2; ++a)
#pragma unroll
            for (int b = 0; b < 2; ++b)
#pragma unroll
                for (int m = 0; m < 4; ++m)
#pragma unroll
                    for (int n = 0; n < 2; ++n) acc[a][b][m][n] = (f32x4){0.f, 0.f, 0.f, 0.f};
        cur = nxt; cA = nA; cB = nB; ++ui;
    }
    PG8_WAIT_V(0);
    if (wr == 0) PG8_BAR;
    PG8_BAR;
#undef PG8_SA
#undef PG8_SB
#undef PG8_STAGE
#undef PG8_LDA
#undef PG8_LDB
#undef PG8_MMA
#undef PG8_WAIT_V
#undef PG8_WAIT_L
#undef PG8_BAR
#undef PG8_SCHED
}
}

template <class Epi>
DEV void run_gemm(unsigned char* shm, const u16* A, int lda, const u16* Bt, int ldb, int N, int K, const Epi& E) {
    asm volatile("" : "+s"(A), "+s"(Bt));
    pg8::Gemm g; g.A = A; g.Bt = Bt; g.M = NTOK; g.N = N; g.K = K; g.lda = lda; g.ldb = ldb;
    pg8::StaticOrder S; S.init(NTOK, N, (int)gridDim.x, (int)blockIdx.x);
    pg8::gemm_phase<Epi>((LAS unsigned char*)shm, g, S, E);
}

DEV void convT_tile(const float* __restrict__ src, u16* __restrict__ dst, int K, int N, int Npad, int tile, float* T) {
    const int tid = tidx(); const int ntn = Npad >> 6; const int k0 = (tile / ntn) << 6, n0 = (tile % ntn) << 6;
#pragma unroll
    for (int j = 0; j < 2; ++j) { const int idx = tid + j * 512; const int r = idx >> 4, c4 = (idx & 15) << 2;
        float4 v = make_float4(0.f, 0.f, 0.f, 0.f); if (n0 + c4 < N) v = *(const float4*)(src + (size_t)(k0 + r) * N + n0 + c4);
        float* t = T + r * 65 + c4; t[0] = v.x; t[1] = v.y; t[2] = v.z; t[3] = v.w; }
    __syncthreads();
    { const int nn = tid >> 3, kq = (tid & 7) << 3; const float* t = T + kq * 65 + nn;
        u32x4 o; o.x = pk(t[0], t[65]); o.y = pk(t[130], t[195]); o.z = pk(t[260], t[325]); o.w = pk(t[390], t[455]);
        *(u32x4*)(dst + (size_t)(n0 + nn) * K + k0 + kq) = o; }
    __syncthreads();
}
DEV int conv_ntiles(int job, int layer) { return job == 0 ? (layer ? 3200 : 3328) : job == 1 ? 1024 : job == 2 ? 5632 : 2816; }
DEV void conv_job(const Params& p, int job, int layer, int tile, float* T) {
    if (job == 0) convT_tile(layer ? p.in[36] : p.in[14], (u16*)(p.ws + OFF_WIN), 2048, layer ? 6176 : 6528, layer ? LDP1 : LDP0, tile, T);
    else if (job == 1) convT_tile(layer ? p.in[37] : p.in[15], (u16*)(p.ws + OFF_WOUT), 2048, 2048, 2048, tile, T);
    else if (job == 2) convT_tile(p.in[10] + (size_t)layer * 2048 * 11264, (u16*)(p.ws + OFF_WUP), 2048, 11264, 11264, tile, T);
    else convT_tile(p.in[12] + (size_t)layer * 5632 * 2048, (u16*)(p.ws + OFF_WDN), 5632, 2048, 2048, tile, T);
}

DEV void adaln_tile(const Params& p, int tile, float* sl) {
    const int tid = tidx(); const int nt = tile % 6, kc = (tile / 6) & 31, layer = tile / 192;
    if (tid < 320) { const int j = tid >> 6, kk = tid & 63; const float cv = (j < 4) ? p.in[4][j * 2048 + kc * 64 + kk] : p.in[5][kc * 64 + kk]; sl[tid] = cv / (1.f + expf(-cv)); }
    __syncthreads();
    const float* w = p.in[6] + ((size_t)layer * 2048 + kc * 64) * 12288 + nt * 2048 + tid * 4;
    float acc[5][4];
#pragma unroll
    for (int j = 0; j < 5; ++j) { acc[j][0] = 0.f; acc[j][1] = 0.f; acc[j][2] = 0.f; acc[j][3] = 0.f; }
#pragma unroll 8
    for (int kk = 0; kk < 64; ++kk) { const float4 wv = *(const float4*)(w + (size_t)kk * 12288);
#pragma unroll
        for (int j = 0; j < 5; ++j) { const float s = sl[j * 64 + kk]; acc[j][0] += s * wv.x; acc[j][1] += s * wv.y; acc[j][2] += s * wv.z; acc[j][3] += s * wv.w; } }
    float* m = (float*)(p.ws + OFF_A) + (size_t)kc * 122880 + (size_t)layer * 5 * 12288 + nt * 2048 + tid * 4;
#pragma unroll
    for (int j = 0; j < 5; ++j) *(float4*)(m + j * 12288) = make_float4(acc[j][0], acc[j][1], acc[j][2], acc[j][3]);
    __syncthreads();
}

DEV void hyfilt_tile(const Params& p, int tile, float* sm) {
    const int tid = tidx();
    int L, p0; u16* G; float* nrm = (float*)(p.ws + OFF_A) + 32 * 122880 + (size_t)tile * 2048;
    if (tile < 128) { L = 4096; p0 = tile * 32; G = (u16*)(p.ws + OFF_GS); }
    else { L = 256; p0 = (tile - 128) * 32; G = (u16*)(p.ws + OFF_GP); }
    float* z = sm; float* h1 = sm + 32 * 33; float* h2 = h1 + 2048;
    const float cang = (float)(6.283185307179586 / (double)L);
    for (int i = tid; i < 32 * 33; i += 512) { const int pp = i / 33, e = i % 33; const float pos = (float)(p0 + pp); float val;
        if (e == 0) val = pos / (float)(L - 1);
        else { const int bi = (e - 1) & 15; const float fb = 1e-4f + (float)bi * ((15.f - 1e-4f) / 15.f); const float ang = (cang * pos) * fb; val = (e <= 16) ? cosf(ang) : -sinf(ang); }
        z[i] = val; }
    __syncthreads();
    for (int i = tid; i < 2048; i += 512) { const int pp = i >> 6, j = i & 63; float a = p.in[19][j];
        for (int e = 0; e < 33; ++e) a += z[pp * 33 + e] * p.in[18][e * 64 + j];
        h1[i] = sinf(p.in[23][j] * a); }
    __syncthreads();
    for (int i = tid; i < 2048; i += 512) { const int pp = i >> 6, j = i & 63; float a = p.in[21][j];
        for (int e = 0; e < 64; ++e) a += h1[pp * 64 + e] * p.in[20][e * 64 + j];
        h2[i] = sinf(p.in[23][64 + j] * a); }
    __syncthreads();
    const float dlo = 3.0701134573253946f, dhi = 15.350567286626973f;
    for (int q = 0; q < 4; ++q) { const int n = tid + 512 * q; const int c = n & 1023; const int back = n >> 10;
        float wcol[64];
#pragma unroll
        for (int e = 0; e < 64; ++e) wcol[e] = p.in[22][e * 2048 + n];
        const float delta = dlo + (dhi - dlo) * ((float)c / 1023.f);
        float asum = 0.f;
        for (int pp = 0; pp < 32; ++pp) { float a = 0.f;
#pragma unroll
            for (int e = 0; e < 64; ++e) a += h2[pp * 64 + e] * wcol[e];
            const int pos = p0 + pp; const float t = (float)pos / (float)(L - 1); a *= expf(-t * delta);
            if (!(back && pos == 0)) { asum += fabsf(a); const int lag = back ? -pos : pos; G[(size_t)c * (2 * L) + (L - lag)] = f2bf(a); } }
        nrm[n] = asum; }
    if (p0 == 0) for (int c = tid; c < 1024; c += 512) G[(size_t)c * (2 * L)] = 0;
    __syncthreads();
}

DEV void phase_prep(const Params& p, unsigned char* shm) {
    const int tid = tidx(); float* sm = (float*)shm;
    if (blockIdx.x == 0 && tid == 0) *(unsigned*)(p.ws + OFF_SMALL + SMALL_BYTES) = 0u;
    { u16* LW = (u16*)(p.ws + OFF_LW); u16* G2T = (u16*)(p.ws + OFF_G2T);
        for (int i = blockIdx.x * 512 + tid; i < 4 * 1024 * 64 + 1024 * 128; i += gridDim.x * 512) {
            if (i < 262144) { const int mi = i >> 16, n = (i >> 6) & 1023, r = i & 63; LW[i] = f2bf((mi < 2 ? p.in[27] : p.in[29])[((size_t)(mi & 1) * 64 + r) * 1024 + n]); }
            else { const int j = i - 262144; const int n = j >> 7, r = j & 127; G2T[j] = f2bf(p.in[30][(size_t)r * 1024 + n]); } } }
    const int n0 = 136, n1 = n0 + 384, n2 = n1 + 3328, n3 = n2 + 1024, n4 = n3 + 5632, n5 = n4 + 2816;
    for (int t = blockIdx.x; t < n5; t += gridDim.x) {
        if (t < n0) hyfilt_tile(p, t, sm);
        else if (t < n1) adaln_tile(p, t - n0, sm);
        else if (t < n2) conv_job(p, 0, 0, t - n1, sm);
        else if (t < n3) conv_job(p, 1, 0, t - n2, sm);
        else if (t < n4) conv_job(p, 2, 0, t - n3, sm);
        else conv_job(p, 3, 0, t - n4, sm);
    }
}

DEV void phase_reduce(const Params& p) {
    const float* part = (const float*)(p.ws + OFF_A); float* mods = (float*)(p.ws + OFF_SMALL); float* hn = (float*)(p.ws + OFF_SMALL + 491520);
    for (int i = blockIdx.x * 512 + tidx(); i < 122880 + 2048; i += gridDim.x * 512) {
        if (i < 122880) { float a = 0.f; for (int kc = 0; kc < 32; ++kc) a += part[(size_t)kc * 122880 + i]; mods[i] = a; }
        else { const int j = i - 122880; const int c = j & 1023; const float* hp = part + 32 * 122880; float a = 0.f;
            if (j < 1024) { for (int t = 0; t < 128; ++t) a += hp[(size_t)t * 2048 + c] + hp[(size_t)t * 2048 + 1024 + c]; }
            else { for (int t = 128; t < 136; ++t) a += hp[(size_t)t * 2048 + c] + hp[(size_t)t * 2048 + 1024 + c]; }
            hn[j] = a; }
    }
}

DEV void phase_norm(const Params& p, int layer, int which, unsigned char* shm) {
    const int tid = tidx(), wid = tid >> 6, lane = tid & 63;
    const float* g = p.in[which ? 9 : 8] + layer * 2048;
    const float* X = p.out; u16* A = (u16*)(p.ws + OFF_A);
    const float* mods = (const float*)(p.ws + OFF_SMALL) + (size_t)layer * 5 * 12288; const float* bb = p.in[7] + layer * 12288;
    const int shi = which ? 3 : 0;
    const int nw = gridDim.x * 8, wv = blockIdx.x * 8 + wid; const int per = (NTOK + nw - 1) / nw; const int r0 = wv * per, r1 = (r0 + per < NTOK) ? r0 + per : NTOK;
    const bool first = (layer == 0 && which == 0);
    int cur = -1; float4 Am[8], Bm[8];
    for (int row = r0; row < r1; ++row) {
        const int cond = tok_cond(row);
        if (cond != cur) { cur = cond; const float* md = mods + (size_t)cond * 12288;
#pragma unroll
            for (int j = 0; j < 8; ++j) { const int col = (lane + 64 * j) * 4;
                const float4 gg = *(const float4*)(g + col);
                const float4 s1 = *(const float4*)(md + shi * 2048 + col), s2 = *(const float4*)(bb + shi * 2048 + col);
                const float4 c1 = *(const float4*)(md + (shi + 1) * 2048 + col), c2 = *(const float4*)(bb + (shi + 1) * 2048 + col);
                Am[j] = make_float4(gg.x * (1.f + c1.x + c2.x), gg.y * (1.f + c1.y + c2.y), gg.z * (1.f + c1.z + c2.z), gg.w * (1.f + c1.w + c2.w));
                Bm[j] = make_float4(s1.x + s2.x, s1.y + s2.y, s1.z + s2.z, s1.w + s2.w); } }
        const float* xsrc = X + (size_t)row * DM; if (first) xsrc = row < NTP ? p.in[0] + (size_t)row * DM : p.in[1] + (size_t)(row - NTP) * DM;
        const float4* xr = (const float4*)xsrc;
        float4 v[8]; float ss = 0.f;
#pragma unroll
        for (int j = 0; j < 8; ++j) { v[j] = xr[lane + 64 * j]; ss += v[j].x * v[j].x + v[j].y * v[j].y + v[j].z * v[j].z + v[j].w * v[j].w; }
        if (first) {
#pragma unroll
            for (int j = 0; j < 8; ++j) ((float4*)(p.out + (size_t)row * DM))[lane + 64 * j] = v[j]; }
        ss = wave_sum(ss);
        const float rstd = rsqrtf(ss * (1.f / 2048.f) + 1e-6f);
#pragma unroll
        for (int j = 0; j < 8; ++j) { const int col = (lane + 64 * j) * 4;
            u32x2 o; o.x = pk(v[j].x * rstd * Am[j].x + Bm[j].x, v[j].y * rstd * Am[j].y + Bm[j].y); o.y = pk(v[j].z * rstd * Am[j].z + Bm[j].z, v[j].w * rstd * Am[j].w + Bm[j].w);
            *(u32x2*)(A + (size_t)row * DM + col) = o; }
    }
    if (layer == 0 && which == 1) { const int na = conv_ntiles(0, 1), nb = na + conv_ntiles(1, 1);
        for (int t = blockIdx.x; t < nb; t += gridDim.x) { if (t < na) conv_job(p, 0, 1, t, (float*)shm); else conv_job(p, 1, 1, t - na, (float*)shm); } }
    if (layer == 1 && which == 0) { const int na = conv_ntiles(2, 1), nb = na + conv_ntiles(3, 1);
        for (int t = blockIdx.x; t < nb; t += gridDim.x) { if (t < na) conv_job(p, 2, 1, t, (float*)shm); else conv_job(p, 3, 1, t - na, (float*)shm); } }
}

DEV void sconv8(const u16* prow, bool hm, bool hp, const float* sw, const float* sb, int ch, float* o) {
    float c[8], m[8], q[8];
    unpack8(*(const u32x4*)(prow + ch), c);
    if (hm) unpack8(*(const u32x4*)(prow - LDP0 + ch), m); else { for (int i = 0; i < 8; ++i) m[i] = 0.f; }
    if (hp) unpack8(*(const u32x4*)(prow + LDP0 + ch), q); else { for (int i = 0; i < 8; ++i) q[i] = 0.f; }
#pragma unroll
    for (int i = 0; i < 8; ++i) o[i] = m[i] * sw[ch + i] + c[i] * sw[3072 + ch + i] + q[i] * sw[6144 + ch + i] + sb[ch + i];
}
DEV void sconv_load(const u16* P, int tok, int ch, u32x4* r) {
    int t, L; tok_tl(tok, t, L); const u16* prow = P + (size_t)tok * LDP0 + ch; const u32x4 z = (u32x4){0u, 0u, 0u, 0u};
    r[1] = *(const u32x4*)prow; r[0] = z; r[2] = z;
    if (t > 0) r[0] = *(const u32x4*)(P + (size_t)(tok - 1) * LDP0 + ch);
    if (t < L - 1) r[2] = *(const u32x4*)(prow + LDP0);
}
DEV void sconv_apply(const u32x4* r, const float* sw, const float* sb, int ch, float* o) {
    float c[8], m[8], q[8]; unpack8(r[0], m); unpack8(r[1], c); unpack8(r[2], q);
#pragma unroll
    for (int i = 0; i < 8; ++i) o[i] = m[i] * sw[ch + i] + c[i] * sw[3072 + ch + i] + q[i] * sw[6144 + ch + i] + sb[ch + i];
}
DEV void hy_pre_stream(const Params& p, float* T) {
    const int tid = tidx(); const u16* P = (const u16*)(p.ws + OFF_P); u16* uT = (u16*)(p.ws + OFF_UT);
    const int tk = tid >> 3, c8 = (tid & 7) << 3;
    u32x4 ca[3], cb[3], na[3], nb[3];
    int tile = blockIdx.x;
    if (tile < 6144) { const int tok0 = (tile >> 4) << 6, c0 = (tile & 15) << 6; sconv_load(P, tok0 + tk, 1024 + c0 + c8, ca); sconv_load(P, tok0 + tk, 2048 + c0 + c8, cb); }
    while (tile < 6144) {
        const int tn = tile + gridDim.x;
        if (tn < 6144) { const int tok0 = (tn >> 4) << 6, c0 = (tn & 15) << 6; sconv_load(P, tok0 + tk, 1024 + c0 + c8, na); sconv_load(P, tok0 + tk, 2048 + c0 + c8, nb); }
        const int tok0 = (tile >> 4) << 6, c0 = (tile & 15) << 6;
        { float x1[8], vv[8]; sconv_apply(ca, p.in[16], p.in[17], 1024 + c0 + c8, x1); sconv_apply(cb, p.in[16], p.in[17], 2048 + c0 + c8, vv);
#pragma unroll
            for (int i = 0; i < 8; ++i) T[tk * 65 + c8 + i] = x1[i] * vv[i]; }
        __syncthreads();
        { const int ch = tid >> 3, t8 = (tid & 7) << 3; const float* t = T + t8 * 65 + ch;
            u32x4 o; o.x = pk(t[0], t[65]); o.y = pk(t[130], t[195]); o.z = pk(t[260], t[325]); o.w = pk(t[390], t[455]);
            *(u32x4*)(uT + (size_t)(c0 + ch) * NTOK + tok0 + t8) = o; }
        __syncthreads();
#pragma unroll
        for (int q = 0; q < 3; ++q) { ca[q] = na[q]; cb[q] = nb[q]; }
        tile = tn;
    }
}
DEV void hy_pre_tile(const Params& p, int tile, float* T) {
    const int tid = tidx(); const int tok0 = (tile >> 4) << 6, c0 = (tile & 15) << 6;
    const u16* P = (const u16*)(p.ws + OFF_P); u16* uT = (u16*)(p.ws + OFF_UT);
    { const int tk = tid >> 3, c8 = (tid & 7) << 3; const int tok = tok0 + tk; int t, L; tok_tl(tok, t, L);
        const u16* prow = P + (size_t)tok * LDP0; float x1[8], vv[8];
        sconv8(prow, t > 0, t < L - 1, p.in[16], p.in[17], 1024 + c0 + c8, x1);
        sconv8(prow, t > 0, t < L - 1, p.in[16], p.in[17], 2048 + c0 + c8, vv);
#pragma unroll
        for (int i = 0; i < 8; ++i) T[tk * 65 + c8 + i] = x1[i] * vv[i]; }
    __syncthreads();
    { const int ch = tid >> 3, t8 = (tid & 7) << 3; const float* t = T + t8 * 65 + ch;
        u32x4 o; o.x = pk(t[0], t[65]); o.y = pk(t[130], t[195]); o.z = pk(t[260], t[325]); o.w = pk(t[390], t[455]);
        *(u32x4*)(uT + (size_t)(c0 + ch) * NTOK + tok0 + t8) = o; }
    __syncthreads();
}
DEV void hy_post_tile(const Params& p, int tile, float* T) {
    const int tid = tidx(); const int tok0 = (tile >> 4) << 6, c0 = (tile & 15) << 6;
    const u16* P = (const u16*)(p.ws + OFF_P); const u16* uT = (const u16*)(p.ws + OFF_UT); u16* ycat = (u16*)(p.ws + OFF_A);
    { const int ch = tid >> 3, t8 = (tid & 7) << 3; float y[8]; unpack8(*(const u32x4*)(uT + (size_t)(c0 + ch) * NTOK + tok0 + t8), y);
#pragma unroll
        for (int i = 0; i < 8; ++i) T[(t8 + i) * 65 + ch] = y[i]; }
    __syncthreads();
    { const int tk = tid >> 3, c8 = (tid & 7) << 3; const int tok = tok0 + tk; int t, L; tok_tl(tok, t, L);
        const u16* prow = P + (size_t)tok * LDP0; float x0[8], x1[8], vv[8], o[8];
        sconv8(prow, t > 0, t < L - 1, p.in[16], p.in[17], c0 + c8, x0);
        sconv8(prow, t > 0, t < L - 1, p.in[16], p.in[17], 1024 + c0 + c8, x1);
        sconv8(prow, t > 0, t < L - 1, p.in[16], p.in[17], 2048 + c0 + c8, vv);
        const float* nrm = (const float*)(p.ws + OFF_SMALL + 491520) + (tok < NTP ? 1024 : 0);
#pragma unroll
        for (int i = 0; i < 8; ++i) { const int c = c0 + c8 + i; o[i] = x0[i] * (T[tk * 65 + c8 + i] * __builtin_amdgcn_rcpf(nrm[c]) + x1[i] * vv[i] * p.in[24][c]); }
        u32x4 w; w.x = pk(o[0], o[1]); w.y = pk(o[2], o[3]); w.z = pk(o[4], o[5]); w.w = pk(o[6], o[7]);
        *(u32x4*)(ycat + (size_t)tok * DM + c0 + c8) = w; }
    __syncthreads();
}
DEV void hy_post_stream(const Params& p, float* T) {
    const int tid = tidx(); const u16* P = (const u16*)(p.ws + OFF_P); const u16* uT = (const u16*)(p.ws + OFF_UT); u16* ycat = (u16*)(p.ws + OFF_A);
    const int tk = tid >> 3, c8 = (tid & 7) << 3;
    const int ch = tid >> 3, t8 = (tid & 7) << 3;
    u32x4 c0r[3], c1r[3], c2r[3], n0r[3], n1r[3], n2r[3], yc, yn;
    int tile = blockIdx.x;
    if (tile < 6144) { const int tok0 = (tile >> 4) << 6, c0 = (tile & 15) << 6;
        sconv_load(P, tok0 + tk, c0 + c8, c0r); sconv_load(P, tok0 + tk, 1024 + c0 + c8, c1r); sconv_load(P, tok0 + tk, 2048 + c0 + c8, c2r);
        yc = *(const u32x4*)(uT + (size_t)(c0 + ch) * NTOK + tok0 + t8); }
    while (tile < 6144) {
        const int tn = tile + gridDim.x;
        if (tn < 6144) { const int tok0 = (tn >> 4) << 6, c0 = (tn & 15) << 6;
            sconv_load(P, tok0 + tk, c0 + c8, n0r); sconv_load(P, tok0 + tk, 1024 + c0 + c8, n1r); sconv_load(P, tok0 + tk, 2048 + c0 + c8, n2r);
            yn = *(const u32x4*)(uT + (size_t)(c0 + ch) * NTOK + tok0 + t8); }
        const int tok0 = (tile >> 4) << 6, c0 = (tile & 15) << 6;
        { float y[8]; unpack8(yc, y);
#pragma unroll
            for (int i = 0; i < 8; ++i) T[(t8 + i) * 65 + ch] = y[i]; }
        __syncthreads();
        { const int tok = tok0 + tk; float x0[8], x1[8], vv[8], o[8];
            sconv_apply(c0r, p.in[16], p.in[17], c0 + c8, x0); sconv_apply(c1r, p.in[16], p.in[17], 1024 + c0 + c8, x1); sconv_apply(c2r, p.in[16], p.in[17], 2048 + c0 + c8, vv);
            const float* nrm = (const float*)(p.ws + OFF_SMALL + 491520) + (tok < NTP ? 1024 : 0);
#pragma unroll
            for (int i = 0; i < 8; ++i) { const int c = c0 + c8 + i; o[i] = x0[i] * (T[tk * 65 + c8 + i] * __builtin_amdgcn_rcpf(nrm[c]) + x1[i] * vv[i] * p.in[24][c]); }
            u32x4 w; w.x = pk(o[0], o[1]); w.y = pk(o[2], o[3]); w.z = pk(o[4], o[5]); w.w = pk(o[6], o[7]);
            *(u32x4*)(ycat + (size_t)tok * DM + c0 + c8) = w; }
        __syncthreads();
#pragma unroll
        for (int q = 0; q < 3; ++q) { c0r[q] = n0r[q]; c1r[q] = n1r[q]; c2r[q] = n2r[q]; }
        yc = yn; tile = tn;
    }
}

DEV void hyconv_task(const Params& p, int task, unsigned char* shm) {
    const int tid = tidx(), wid = tid >> 6, lane = tid & 63;
    const bool sample = task < 1024; const int c = sample ? task : task - 1024;
    const int L = sample ? 4096 : 256, NB = sample ? 4 : 32, lgNB = sample ? 2 : 5, LP = L + 8;
    u16* uL = (u16*)shm; u16* gL = uL + NB * LP; u16* gS = gL + 2 * L;
    const u16* G = sample ? (const u16*)(p.ws + OFF_GS) + (size_t)c * 8192 : (const u16*)(p.ws + OFF_GP) + (size_t)c * 512;
    u16* uT = (u16*)(p.ws + OFF_UT) + (size_t)c * NTOK + (sample ? NTP : 0);
    for (int i = tid * 8; i < NB * L; i += 4096) { const int b = i / L, s = i % L; *(u32x4*)(uL + b * LP + s) = *(const u32x4*)(uT + i); }
    for (int i = tid * 8; i < 2 * L; i += 4096) { const u32x4 w = *(const u32x4*)(G + i); *(u32x4*)(gL + i) = w;
        const unsigned nx = (i + 8 < 2 * L) ? (unsigned)G[i + 8] : 0u;
        u32x4 sft; sft.x = (w.x >> 16) | (w.y << 16); sft.y = (w.y >> 16) | (w.z << 16); sft.z = (w.z >> 16) | (w.w << 16); sft.w = (w.w >> 16) | (nx << 16);
        *(u32x4*)(gS + i) = sft; }
    __syncthreads();
    const int ntile = (NB * (L >> 5)) >> 5;
    const int npair = sample ? 8 : 8; const bool two = sample;
    const int r = lane & 31, half = lane >> 5;
    {
        const int ct0 = two ? 2 * wid : wid;
        const int colA = ct0 * 32 + r, colB = colA + 32;
        const int bA = colA & (NB - 1), iA = colA >> lgNB, bB = colB & (NB - 1), iB = colB >> lgNB; const int tA = iA * 32, tB = iB * 32;
        const int i_lo = (ct0 * 32) >> lgNB, i_hi = ((two ? ct0 + 1 : ct0) * 32 + 31) >> lgNB;
        const int d_lo = 32 * i_lo - (L - 16), d_hi = 32 * i_hi;
        f32x16 accA, accB;
#pragma unroll
        for (int j = 0; j < 16; ++j) { accA[j] = 0.f; accB[j] = 0.f; }
        const u16* ubA = uL + bA * LP + 8 * half; const u16* ubB = uL + bB * LP + 8 * half;
        const u16* gsel = (r & 1) ? gS : gL;
        const int qb = (L - r + 8 * half) & ~1;
#pragma unroll 4
        for (int dl = d_lo; dl <= d_hi; dl += 16) {
            const unsigned* gq = (const unsigned*)(gsel + (qb - dl));
            u32x4 aw; aw.x = gq[0]; aw.y = gq[1]; aw.z = gq[2]; aw.w = gq[3];
            const bf16x8 a = __builtin_bit_cast(bf16x8, aw);
            const int sA = tA - dl, sB = tB - dl;
            bf16x8 bvA = (bf16x8){0, 0, 0, 0, 0, 0, 0, 0}, bvB = bvA;
            if (sA >= 0 && sA <= L - 16) bvA = *(const bf16x8*)(ubA + sA);
            accA = __builtin_amdgcn_mfma_f32_32x32x16_bf16(a, bvA, accA, 0, 0, 0);
            if (two) { if (sB >= 0 && sB <= L - 16) bvB = *(const bf16x8*)(ubB + sB);
                accB = __builtin_amdgcn_mfma_f32_32x32x16_bf16(a, bvB, accB, 0, 0, 0); }
        }
#pragma unroll
        for (int g = 0; g < 4; ++g) { u32x2 w; w.x = pk(accA[4 * g], accA[4 * g + 1]); w.y = pk(accA[4 * g + 2], accA[4 * g + 3]);
            *(u32x2*)(uT + (size_t)bA * L + tA + 8 * g + 4 * half) = w; }
        if (two) {
#pragma unroll
            for (int g = 0; g < 4; ++g) { u32x2 w; w.x = pk(accB[4 * g], accB[4 * g + 1]); w.y = pk(accB[4 * g + 2], accB[4 * g + 3]);
                *(u32x2*)(uT + (size_t)bB * L + tB + 8 * g + 4 * half) = w; } }
    }
    (void)ntile; (void)npair;
    __syncthreads();
}

DEV void rwkv_lora_tile(const Params& p, int tile, unsigned char* shm) {
    const int tid = tidx(), wid = tid >> 6, lane = tid & 63, l15 = lane & 15, quad = lane >> 4; const int tok0 = tile * 32;
    const u16* P = (const u16*)(p.ws + OFF_P); u16* RW = (u16*)(p.ws + OFF_RW); const u16* LW = (const u16*)(p.ws + OFF_LW);
    u16* Ain = (u16*)shm;
    u16* Ol = (u16*)(shm + 18432);
    for (int i = tid; i < 32 * 256; i += 512) { const int tk = i >> 8, cc = i & 255; const int tok = tok0 + tk; int t, L; tok_tl(tok, t, L);
        const u16* pp = P + (size_t)tok * LDP0 + 6144 + cc; float x = bf2f(*pp); const float xm = t > 0 ? bf2f(pp[-LDP0]) : 0.f; const float xp = t < L - 1 ? bf2f(pp[LDP0]) : 0.f;
        const float mu = p.in[25][3072 + cc]; x = x + mu * (0.5f * (xm + xp) - x); if (cc < 128) x = tanhf(x);
        Ain[((cc >> 6) * 32 + tk) * 72 + (cc & 63)] = f2bf(x); }
    __syncthreads();
#pragma unroll 1
    for (int mi = 0; mi < 4; ++mi) {
        const float* bias = (mi < 2 ? p.in[26] : p.in[28]) + (mi & 1) * 1024;
        const float osc = mi < 2 ? 0.6065306597f : 1.f;
        bf16x8 af[2][2];
#pragma unroll
        for (int tt = 0; tt < 2; ++tt)
#pragma unroll
            for (int ks = 0; ks < 2; ++ks) af[tt][ks] = *(const bf16x8*)(Ain + (mi * 32 + tt * 16 + l15) * 72 + ks * 32 + quad * 8);
#pragma unroll 2
        for (int q = 0; q < 8; ++q) { const int nt = wid * 8 + q; const int n = nt * 16 + l15;
            const bf16x8 b0 = *(const bf16x8*)(LW + ((size_t)mi * 1024 + n) * 64 + quad * 8), b1 = *(const bf16x8*)(LW + ((size_t)mi * 1024 + n) * 64 + 32 + quad * 8);
            const float bs = bias[n];
#pragma unroll
            for (int tt = 0; tt < 2; ++tt) { f32x4 acc = (f32x4){0.f, 0.f, 0.f, 0.f}; acc = mfma16(af[tt][0], b0, acc); acc = mfma16(af[tt][1], b1, acc);
#pragma unroll
                for (int r = 0; r < 4; ++r) Ol[(tt * 16 + quad * 4 + r) * 1032 + n] = f2bf(osc * sigm(acc[r] + bs)); } }
        __syncthreads();
#pragma unroll
        for (int i = 0; i < 8; ++i) { const int piece = tid + 512 * i; const int tk = piece >> 7, c8 = (piece & 127) * 8;
            *(u32x4*)(RW + (size_t)(tok0 + tk) * 4096 + mi * 1024 + c8) = *(const u32x4*)(Ol + tk * 1032 + c8); }
        __syncthreads();
    }
}
DEV float mixf(float c, float m, float q, float mu) { return c + mu * (0.5f * (m + q) - c); }
DEV void rwkv_scan_task(const Params& p, int task, float* sm) {
    const bool sample = task < 128; const int tt_ = sample ? task : task - 128;
    const int b = tt_ >> 5, h = (tt_ >> 1) & 15, dir = tt_ & 1;
    const int L = sample ? 4096 : 256; const int tok0 = sample ? NTP + b * 4096 : b * 256;
    const int tid = tidx(), wid = tid >> 6, lane = tid & 63;
    const int kl = lane & 7;
    const int row2 = (wid & 3) * 16 + (lane >> 3) * 2;
    float S[8], T[8];
    const size_t so2 = ((((size_t)b * 2 + dir) * 16 + h) * 64 + row2) * 64 + kl * 8;
    if (sample) {
        const float4 a = *(const float4*)(p.in[2] + so2), c = *(const float4*)(p.in[2] + so2 + 4), d = *(const float4*)(p.in[2] + so2 + 64), e = *(const float4*)(p.in[2] + so2 + 68);
        S[0] = a.x; S[1] = a.y; S[2] = a.z; S[3] = a.w; S[4] = c.x; S[5] = c.y; S[6] = c.z; S[7] = c.w;
        T[0] = d.x; T[1] = d.y; T[2] = d.z; T[3] = d.w; T[4] = e.x; T[5] = e.y; T[6] = e.z; T[7] = e.w; }
    else {
#pragma unroll
        for (int i = 0; i < 8; ++i) { S[i] = 0.f; T[i] = 0.f; } }
    f32x2 S2[4], T2[4];
#pragma unroll
    for (int i = 0; i < 4; ++i) { S2[i] = (f32x2){S[2 * i], S[2 * i + 1]}; T2[i] = (f32x2){T[2 * i], T[2 * i + 1]}; }
    const int pk4 = (tid & 15) * 4; const int ch = h * 64 + pk4; const int plt = (tid & 255) >> 4;
    const float4 mur = *(const float4*)(p.in[25] + ch), muk = *(const float4*)(p.in[25] + 1024 + ch), muv = *(const float4*)(p.in[25] + 2048 + ch);
    const float4 kkw = *(const float4*)(p.in[31] + ch), kaw = *(const float4*)(p.in[32] + ch);
    const float murA[4] = {mur.x, mur.y, mur.z, mur.w}, mukA[4] = {muk.x, muk.y, muk.z, muk.w}, muvA[4] = {muv.x, muv.y, muv.z, muv.w};
    const float kkwA[4] = {kkw.x, kkw.y, kkw.z, kkw.w}, kawA[4] = {kaw.x, kaw.y, kaw.z, kaw.w};
    const u16* P = (const u16*)(p.ws + OFF_P); const u16* RW = (const u16*)(p.ws + OFF_RW);
    u16* Y = (u16*)(p.out + OUT_GLAST) + (dir ? (size_t)NTOK * 1024 : 0);
#define RW_PREP(c0_, buf_) do { float* vec_ = sm + (buf_) * 14336; float* vvs_ = vec_ + 10240; \
        _Pragma("unroll 1") for (int ps = 0; ps < 2; ++ps) { const int ptt = plt + 16 * ps; \
            const int t = dir ? (L - 1 - ((c0_) + ptt)) : ((c0_) + ptt); const size_t tok = (size_t)tok0 + t; \
            const u16* pr = P + tok * LDP0 + 3072 + ch; \
            float rc[4], kc[4], vc[4], rm[4], km[4], vm[4], rp[4], kp[4], vp[4], ee[4], aa[4]; \
            unpack4(*(const u32x2*)(pr), rc); unpack4(*(const u32x2*)(pr + 1024), kc); unpack4(*(const u32x2*)(pr + 2048), vc); \
            if (t > 0) { const u16* pm = P + (tok - 1) * LDP0 + 3072 + ch; unpack4(*(const u32x2*)(pm), rm); unpack4(*(const u32x2*)(pm + 1024), km); unpack4(*(const u32x2*)(pm + 2048), vm); } \
            else { for (int i = 0; i < 4; ++i) { rm[i] = 0.f; km[i] = 0.f; vm[i] = 0.f; } } \
            if (t < L - 1) { unpack4(*(const u32x2*)(pr + LDP0), rp); unpack4(*(const u32x2*)(pr + LDP0 + 1024), kp); unpack4(*(const u32x2*)(pr + LDP0 + 2048), vp); } \
            else { for (int i = 0; i < 4; ++i) { rp[i] = 0.f; kp[i] = 0.f; vp[i] = 0.f; } } \
            unpack4(*(const u32x2*)(RW + tok * 4096 + dir * 1024 + ch), ee); unpack4(*(const u32x2*)(RW + tok * 4096 + (2 + dir) * 1024 + ch), aa); \
            float r4[4], k4[4], v4[4], kr[4]; float ss = 0.f; \
            _Pragma("unroll") for (int i = 0; i < 4; ++i) { r4[i] = mixf(rc[i], rm[i], rp[i], murA[i]); k4[i] = mixf(kc[i], km[i], kp[i], mukA[i]); v4[i] = mixf(vc[i], vm[i], vp[i], muvA[i]); \
                kr[i] = k4[i] * kkwA[i]; ss += kr[i] * kr[i]; } \
            ss = sum16(ss); const float inv = rsqrtf(ss + 1e-12f); \
            float tkk[4], tw[4], tkka[4], tkd[4]; \
            _Pragma("unroll") for (int i = 0; i < 4; ++i) { tkk[i] = kr[i] * inv; tw[i] = __expf(-ee[i]); tkka[i] = tkk[i] * aa[i]; tkd[i] = k4[i] * (1.f + (aa[i] - 1.f) * kawA[i]); } \
            float* vj = vec_ + ptt * 320 + pk4; \
            *(float4*)(vj) = make_float4(tkk[0], tkk[1], tkk[2], tkk[3]); *(float4*)(vj + 64) = make_float4(tw[0], tw[1], tw[2], tw[3]); *(float4*)(vj + 128) = make_float4(tkka[0], tkka[1], tkka[2], tkka[3]); \
            *(float4*)(vj + 192) = make_float4(tkd[0], tkd[1], tkd[2], tkd[3]); *(float4*)(vj + 256) = make_float4(r4[0], r4[1], r4[2], r4[3]); \
            *(float4*)(vvs_ + ptt * 64 + pk4) = make_float4(v4[0], v4[1], v4[2], v4[3]); } } while (0)
#define RW_YOUT(c0_, buf_) do { const float* yb_ = sm + (buf_) * 14336 + 12288; \
        _Pragma("unroll 1") for (int ps = 0; ps < 2; ++ps) { const int ptt = plt + 16 * ps; const int t = dir ? (L - 1 - ((c0_) + ptt)) : ((c0_) + ptt); \
            const float4 yv = *(const float4*)(yb_ + ptt * 64 + pk4); u32x2 w; w.x = pk(yv.x, yv.y); w.y = pk(yv.z, yv.w); \
            *(u32x2*)(Y + ((size_t)tok0 + t) * 1024 + ch) = w; } } while (0)
    const int nchunk = L >> 5;
    if (wid >= 4) RW_PREP(0, 0);
    __syncthreads();
#pragma unroll 1
    for (int c = 0; c < nchunk; ++c) {
        if (wid < 4) {
            const float* vec = sm + (c & 1) * 14336; const float* vvs = vec + 10240; float* yb = sm + (c & 1) * 14336 + 12288;
#pragma unroll
            for (int j = 0; j < 32; ++j) {
                const float* vj = vec + j * 320 + kl * 8;
                const f32x4 a0 = *(const f32x4*)(vj), a1 = *(const f32x4*)(vj + 4);
                const f32x4 w0 = *(const f32x4*)(vj + 64), w1 = *(const f32x4*)(vj + 68);
                const f32x4 b0 = *(const f32x4*)(vj + 128), b1 = *(const f32x4*)(vj + 132);
                const f32x4 d0 = *(const f32x4*)(vj + 192), d1 = *(const f32x4*)(vj + 196);
                const f32x4 r0 = *(const f32x4*)(vj + 256), r1 = *(const f32x4*)(vj + 260);
                const float2 vr = *(const float2*)(vvs + j * 64 + row2);
                const f32x2 kk0 = a0.lo, kk1 = a0.hi, kk2 = a1.lo, kk3 = a1.hi;
                f32x2 pa = S2[0] * kk0; pa += S2[1] * kk1; pa += S2[2] * kk2; pa += S2[3] * kk3;
                f32x2 pb = T2[0] * kk0; pb += T2[1] * kk1; pb += T2[2] * kk2; pb += T2[3] * kk3;
                const float sa = -sum8(pa.x + pa.y), sb = -sum8(pb.x + pb.y);
                const f32x2 sa2 = (f32x2){sa, sa}, sb2 = (f32x2){sb, sb}, vx2 = (f32x2){vr.x, vr.x}, vy2 = (f32x2){vr.y, vr.y};
                S2[0] = S2[0] * w0.lo + (sa2 * b0.lo + vx2 * d0.lo); S2[1] = S2[1] * w0.hi + (sa2 * b0.hi + vx2 * d0.hi);
                S2[2] = S2[2] * w1.lo + (sa2 * b1.lo + vx2 * d1.lo); S2[3] = S2[3] * w1.hi + (sa2 * b1.hi + vx2 * d1.hi);
                T2[0] = T2[0] * w0.lo + (sb2 * b0.lo + vy2 * d0.lo); T2[1] = T2[1] * w0.hi + (sb2 * b0.hi + vy2 * d0.hi);
                T2[2] = T2[2] * w1.lo + (sb2 * b1.lo + vy2 * d1.lo); T2[3] = T2[3] * w1.hi + (sb2 * b1.hi + vy2 * d1.hi);
                f32x2 qa = S2[0] * r0.lo; qa += S2[1] * r0.hi; qa += S2[2] * r1.lo; qa += S2[3] * r1.hi;
                f32x2 qb = T2[0] * r0.lo; qb += T2[1] * r0.hi; qb += T2[2] * r1.lo; qb += T2[3] * r1.hi;
                const float y0 = sum8(qa.x + qa.y), y1 = sum8(qb.x + qb.y);
                if (kl == 0) *(float2*)(yb + j * 64 + row2) = make_float2(y0, y1);
            }
        } else {
            if (c > 0) RW_YOUT((c - 1) * 32, (c - 1) & 1);
            if (c + 1 < nchunk) RW_PREP((c + 1) * 32, (c + 1) & 1);
        }
        __syncthreads();
    }
    if (wid >= 4) RW_YOUT((nchunk - 1) * 32, (nchunk - 1) & 1);
#undef RW_PREP
#undef RW_YOUT
#pragma unroll
    for (int i = 0; i < 4; ++i) { S[2 * i] = S2[i].x; S[2 * i + 1] = S2[i].y; T[2 * i] = T2[i].x; T[2 * i + 1] = T2[i].y; }
    if (!sample && wid < 4) { float* so = p.out + OUT_RWST + so2;
        *(float4*)(so) = make_float4(S[0], S[1], S[2], S[3]); *(float4*)(so + 4) = make_float4(S[4], S[5], S[6], S[7]);
        *(float4*)(so + 64) = make_float4(T[0], T[1], T[2], T[3]); *(float4*)(so + 68) = make_float4(T[4], T[5], T[6], T[7]); }
    __syncthreads();
}
DEV void rwkv_post_tile(const Params& p, int tile, float* sm) {
    const int tid = tidx(); const int tok0 = tile * 32;
    const u16* P = (const u16*)(p.ws + OFF_P); const u16* RW = (const u16*)(p.ws + OFF_RW); u16* ycat = (u16*)(p.ws + OFF_A);
    const u16* YF = (const u16*)(p.out + OUT_GLAST); const u16* YB = YF + (size_t)NTOK * 1024;
    u16* Gh = (u16*)(sm + 4096);
    for (int i = tid; i < 32 * 128; i += 512) { const int tk = i >> 7, r = i & 127; const int tok = tok0 + tk; int t, L; tok_tl(tok, t, L);
        const u16* pp = P + (size_t)tok * LDP0 + 6400 + r; const float x = bf2f(*pp); const float xm = t > 0 ? bf2f(pp[-LDP0]) : 0.f; const float xp = t < L - 1 ? bf2f(pp[LDP0]) : 0.f;
        sm[i] = sigm(mixf(x, xm, xp, p.in[25][3328 + r])); }
    __syncthreads();
    { float g0[32], g1[32];
#pragma unroll
        for (int k = 0; k < 32; ++k) { g0[k] = 0.f; g1[k] = 0.f; }
        const float* g2 = p.in[30];
        for (int r = 0; r < 128; r += 4) {
            float wa[4], wb[4];
#pragma unroll
            for (int q = 0; q < 4; ++q) { wa[q] = g2[(r + q) * 1024 + tid]; wb[q] = g2[(r + q) * 1024 + 512 + tid]; }
#pragma unroll
            for (int k = 0; k < 32; ++k) { const float4 s4 = *(const float4*)(sm + k * 128 + r);
                g0[k] += s4.x * wa[0] + s4.y * wa[1] + s4.z * wa[2] + s4.w * wa[3]; g1[k] += s4.x * wb[0] + s4.y * wb[1] + s4.z * wb[2] + s4.w * wb[3]; } }
#pragma unroll
        for (int k = 0; k < 32; ++k) { Gh[k * 1024 + tid] = f2bf(g0[k]); Gh[k * 1024 + 512 + tid] = f2bf(g1[k]); } }
    __syncthreads();
    const int c8 = (tid & 127) * 8;
    float mur[8], muk[8], muv[8], ka[8], rk[8], lw[8], lb[8];
#pragma unroll
    for (int i = 0; i < 8; ++i) { mur[i] = p.in[25][c8 + i]; muk[i] = p.in[25][1024 + c8 + i]; muv[i] = p.in[25][2048 + c8 + i]; ka[i] = p.in[32][c8 + i]; rk[i] = p.in[33][c8 + i]; lw[i] = p.in[34][c8 + i]; lb[i] = p.in[35][c8 + i]; }
#pragma unroll 1
    for (int it = 0; it < 8; ++it) { const int tk = (tid >> 7) + 4 * it; const int tok = tok0 + tk; int t, L; tok_tl(tok, t, L);
        const u16* pr = P + (size_t)tok * LDP0 + 3072 + c8; const bool hm = t > 0, hp = t < L - 1;
        float rc[8], rm[8], rp[8], kc[8], km[8], kp[8], vc[8], vm[8], vp[8], a0[8], a1[8], yf[8], yb[8], gg[8];
        unpack8(*(const u32x4*)pr, rc); unpack8(*(const u32x4*)(pr + 1024), kc); unpack8(*(const u32x4*)(pr + 2048), vc);
        if (hm) { const u16* pm = P + (size_t)(tok - 1) * LDP0 + 3072 + c8; unpack8(*(const u32x4*)(pm), rm); unpack8(*(const u32x4*)(pm + 1024), km); unpack8(*(const u32x4*)(pm + 2048), vm); }
        else { for (int i = 0; i < 8; ++i) { rm[i] = 0.f; km[i] = 0.f; vm[i] = 0.f; } }
        if (hp) { unpack8(*(const u32x4*)(pr + LDP0), rp); unpack8(*(const u32x4*)(pr + LDP0 + 1024), kp); unpack8(*(const u32x4*)(pr + LDP0 + 2048), vp); }
        else { for (int i = 0; i < 8; ++i) { rp[i] = 0.f; kp[i] = 0.f; vp[i] = 0.f; } }
        unpack8(*(const u32x4*)(RW + (size_t)tok * 4096 + 2048 + c8), a0); unpack8(*(const u32x4*)(RW + (size_t)tok * 4096 + 3072 + c8), a1);
        unpack8(*(const u32x4*)(YF + (size_t)tok * 1024 + c8), yf); unpack8(*(const u32x4*)(YB + (size_t)tok * 1024 + c8), yb);
        unpack8(*(const u32x4*)(Gh + tk * 1024 + c8), gg);
        float y[8], v_[8]; float bon = 0.f, sy = 0.f;
#pragma unroll
        for (int i = 0; i < 8; ++i) { const float r_ = mixf(rc[i], rm[i], rp[i], mur[i]), k_ = mixf(kc[i], km[i], kp[i], muk[i]); v_[i] = mixf(vc[i], vm[i], vp[i], muv[i]);
            bon += r_ * k_ * (2.f + (a0[i] + a1[i] - 2.f) * ka[i]) * rk[i]; y[i] = yf[i] + yb[i]; sy += y[i]; }
        bon = sum8(bon); const float mean = sum8(sy) * (1.f / 64.f);
        float sv = 0.f;
#pragma unroll
        for (int i = 0; i < 8; ++i) { y[i] -= mean; sv += y[i] * y[i]; }
        const float rstd = rsqrtf(sum8(sv) * (1.f / 64.f) + 64e-5f);
        float o[8];
#pragma unroll
        for (int i = 0; i < 8; ++i) o[i] = (y[i] * rstd * lw[i] + lb[i] + bon * v_[i]) * gg[i];
        u32x4 w; w.x = pk(o[0], o[1]); w.y = pk(o[2], o[3]); w.z = pk(o[4], o[5]); w.w = pk(o[6], o[7]);
        *(u32x4*)(ycat + (size_t)tok * DM + 1024 + c8) = w; }
    __syncthreads();
}

DEV float logsig(float x) { return fminf(x, 0.f) - __logf(1.f + __expf(-fabsf(x))); }
DEV void gla_intra_task(const Params& p, int task, unsigned char* shm) {
    const int tid = tidx(), wid = tid >> 6, lane = tid & 63, l15 = lane & 15, quad = lane >> 4;
    const int cidx = task >> 2, h = task & 3; const int tok0 = cidx * 64;
    u16* P = (u16*)(p.ws + OFF_P); u16* QB = (u16*)(p.ws + OFF_A); float* Dbuf = (float*)(p.ws + OFF_DB);
    u16* qi = (u16*)shm; u16* ki = qi + 64 * 264; u16* vl = (u16*)shm; u16* Pl = (u16*)(shm + 67584); float* gl = (float*)(shm + 76800); float* tot = (float*)(shm + 84992);
    for (int i = tid; i < 2048; i += 512) { const int tl = i >> 5, c = i & 31; gl[i] = bf2f(P[(size_t)(tok0 + tl) * LDP1 + 6144 + c]); }
    __syncthreads();
    const int k = tid & 255, jh = tid >> 8;
#pragma unroll 1
    for (int dd = 0; dd < 2; ++dd) { const int dir = 1 - dd;
        float g2r[16];
#pragma unroll
        for (int r = 0; r < 16; ++r) g2r[r] = p.in[38][(size_t)(dir * 16 + r) * 1024 + h * 256 + k];
        const float gb = p.in[39][dir * 1024 + h * 256 + k];
        float bl[32]; float run = 0.f;
#pragma unroll
        for (int jj = 0; jj < 32; ++jj) { const int j = jh * 32 + jj; const int tl = dir ? 63 - j : j; const float* gr = gl + tl * 32 + dir * 16;
            float x = gb;
#pragma unroll
            for (int r = 0; r < 16; r += 4) { const float4 g4 = *(const float4*)(gr + r); x += g4.x * g2r[r] + g4.y * g2r[r + 1] + g4.z * g2r[r + 2] + g4.w * g2r[r + 3]; }
            run += logsig(x) * 0.0625f; bl[jj] = run; }
        tot[jh * 256 + k] = run;
        __syncthreads();
        const float t0v = tot[k], t1v = tot[256 + k]; const float off = jh ? t0v : 0.f; const float bref = t0v, blast = t0v + t1v;
        if (jh == 0) Dbuf[((size_t)cidx * 2 + dir) * 1024 + h * 256 + k] = __expf(blast);
        u16* qdst; u16* kdst; size_t ldd;
        if (dir == 0) { qdst = P + h * 256 + k; kdst = P + 1024 + h * 256 + k; ldd = LDP1; } else { qdst = QB + h * 256 + k; kdst = QB + 1024 + h * 256 + k; ldd = 2048; }
#pragma unroll
        for (int jj = 0; jj < 32; ++jj) { const int j = jh * 32 + jj; const int tl = dir ? 63 - j : j; const size_t tok = (size_t)tok0 + tl;
            const float qv = bf2f(P[tok * LDP1 + h * 256 + k]) * 0.0625f, kv = bf2f(P[tok * LDP1 + 1024 + h * 256 + k]);
            const float b = bl[jj] + off;
            qi[j * 264 + k] = f2bf(qv * __expf(b - bref)); ki[j * 264 + k] = f2bf(kv * __expf(bref - b));
            qdst[tok * ldd] = f2bf(qv * __expf(b)); kdst[tok * ldd] = f2bf(kv * __expf(blast - b)); }
        __syncthreads();
        { const int tt = wid >> 1;
#pragma unroll
            for (int q2 = 0; q2 < 2; ++q2) { const int st = (wid & 1) * 2 + q2; f32x4 acc = (f32x4){0.f, 0.f, 0.f, 0.f};
                if (st <= tt) {
#pragma unroll
                    for (int ks = 0; ks < 8; ++ks) { const bf16x8 a = *(const bf16x8*)(qi + (tt * 16 + l15) * 264 + ks * 32 + quad * 8); const bf16x8 b = *(const bf16x8*)(ki + (st * 16 + l15) * 264 + ks * 32 + quad * 8);
                        acc = mfma16(a, b, acc); } }
#pragma unroll
                for (int r = 0; r < 4; ++r) { const int t = tt * 16 + quad * 4 + r, s_ = st * 16 + l15; Pl[t * 72 + s_] = f2bf(s_ <= t ? acc[r] : 0.f); } } }
        __syncthreads();
#pragma unroll
        for (int i = 0; i < 8; ++i) { const int piece = tid + 512 * i; const int j = piece >> 6, c8 = (piece & 63) * 8; const int tl = dir ? 63 - j : j;
            *(u32x4*)(vl + j * 520 + c8) = *(const u32x4*)(P + (size_t)(tok0 + tl) * LDP1 + 2048 + h * 512 + c8); }
        __syncthreads();
        u16* O = (u16*)(p.ws + (dir ? OFF_OB : OFF_OF)) + h * 512;
#pragma unroll 1
        for (int q4 = 0; q4 < 4; ++q4) { const int vt = wid * 4 + q4; f32x4 acc[4];
#pragma unroll
            for (int tt = 0; tt < 4; ++tt) acc[tt] = (f32x4){0.f, 0.f, 0.f, 0.f};
#pragma unroll
            for (int ss = 0; ss < 2; ++ss) { bf16x8 bfr;
#pragma unroll
                for (int jj = 0; jj < 8; ++jj) bfr[jj] = (short)vl[(ss * 32 + quad * 8 + jj) * 520 + vt * 16 + l15];
#pragma unroll
                for (int tt = 0; tt < 4; ++tt) { if (ss * 32 <= tt * 16 + 15) { const bf16x8 a = *(const bf16x8*)(Pl + (tt * 16 + l15) * 72 + ss * 32 + quad * 8); acc[tt] = mfma16(a, bfr, acc[tt]); } } }
#pragma unroll
            for (int tt = 0; tt < 4; ++tt)
#pragma unroll
                for (int r = 0; r < 4; ++r) { const int t = tt * 16 + quad * 4 + r; const int tl = dir ? 63 - t : t; O[(size_t)(tok0 + tl) * DM + vt * 16 + l15] = f2bf(acc[tt][r]); } }
        __syncthreads();
    }
}
DEV void gla_inter_task(const Params& p, int task, unsigned char* shm) {
    const bool sample = task < 256; const int tt_ = sample ? task : task - 256;
    const int seq = tt_ >> 3, vs = tt_ & 7; const int b = seq >> 3, h = (seq >> 1) & 3, dir = seq & 1;
    const int L = sample ? 4096 : 256; const int tok0 = sample ? NTP + b * 4096 : b * 256;
    const int nch = L >> 6, cbase = tok0 >> 6;
    const int tid = tidx(), wid = tid >> 6, lane = tid & 63, l15 = lane & 15, quad = lane >> 4;
    const u16* P = (const u16*)(p.ws + OFF_P); const u16* QB = (const u16*)(p.ws + OFF_A); const float* Dbuf = (const float*)(p.ws + OFF_DB);
    u16* ST = (u16*)shm; u16* qdl = (u16*)(shm + 33792); u16* kdl = (u16*)(shm + 67584); u16* vl = (u16*)(shm + 101376); float* dl = (float*)(shm + 110592);
    f32x4 S[2][4];
    const size_t sbase = (((size_t)b * 2 + dir) * 4 + h) * 256 * 512 + vs * 64;
#pragma unroll
    for (int kt = 0; kt < 2; ++kt)
#pragma unroll
        for (int vt = 0; vt < 4; ++vt)
#pragma unroll
            for (int r = 0; r < 4; ++r) { const int kk = wid * 32 + kt * 16 + quad * 4 + r; S[kt][vt][r] = sample ? p.in[3][sbase + (size_t)kk * 512 + vt * 16 + l15] : 0.f; }
    const u16* qsrc; const u16* ksrc; size_t lds_;
    if (dir == 0) { qsrc = P + h * 256; ksrc = P + 1024 + h * 256; lds_ = LDP1; } else { qsrc = QB + h * 256; ksrc = QB + 1024 + h * 256; lds_ = 2048; }
    const u16* vsrc = P + 2048 + h * 512 + vs * 64;
    u16* O = (u16*)(p.ws + (dir ? OFF_OB : OFF_OF)) + h * 512 + vs * 64;
    u32x4 rq[4], rk[4], rv; float rd = 0.f;
    const int vrow = tid >> 3, vc8 = (tid & 7) * 8;
#define GLA_ISSUE(n_) do { const int cidx_ = cbase + (dir ? nch - 1 - (n_) : (n_)); \
        _Pragma("unroll") for (int i = 0; i < 4; ++i) { const int piece = tid + 512 * i; const int j = piece >> 5, c8 = (piece & 31) * 8; const size_t tok = (size_t)cidx_ * 64 + (dir ? 63 - j : j); \
            rq[i] = *(const u32x4*)(qsrc + tok * lds_ + c8); rk[i] = *(const u32x4*)(ksrc + tok * lds_ + c8); } \
        { const size_t tok = (size_t)cidx_ * 64 + (dir ? 63 - vrow : vrow); rv = *(const u32x4*)(vsrc + tok * LDP1 + vc8); } \
        if (tid < 256) rd = Dbuf[((size_t)cidx_ * 2 + dir) * 1024 + h * 256 + tid]; } while (0)
#define GLA_WRITE_ST() do { _Pragma("unroll") for (int kt = 0; kt < 2; ++kt) _Pragma("unroll") for (int vt = 0; vt < 4; ++vt) { u32x2 w; w.x = pk(S[kt][vt][0], S[kt][vt][1]); w.y = pk(S[kt][vt][2], S[kt][vt][3]); \
            *(u32x2*)(ST + (vt * 16 + l15) * 264 + wid * 32 + kt * 16 + quad * 4) = w; } } while (0)
    GLA_WRITE_ST();
    GLA_ISSUE(0);
    const int tt = wid >> 1, vb = (wid & 1) * 2;
#pragma unroll 1
    for (int n = 0; n < nch; ++n) {
        const int cidx = cbase + (dir ? nch - 1 - n : n);
#pragma unroll
        for (int i = 0; i < 4; ++i) { const int piece = tid + 512 * i; const int j = piece >> 5, c8 = (piece & 31) * 8; *(u32x4*)(qdl + j * 264 + c8) = rq[i]; *(u32x4*)(kdl + j * 264 + c8) = rk[i]; }
        *(u32x4*)(vl + vrow * 72 + vc8) = rv; if (tid < 256) dl[tid] = rd;
        __syncthreads();
        if (n + 1 < nch) GLA_ISSUE(n + 1);
        float oi[2][4];
#pragma unroll
        for (int q2 = 0; q2 < 2; ++q2)
#pragma unroll
            for (int r = 0; r < 4; ++r) { const int j = tt * 16 + quad * 4 + r; const size_t tok = (size_t)cidx * 64 + (dir ? 63 - j : j); oi[q2][r] = bf2f(O[tok * DM + (vb + q2) * 16 + l15]); }
        f32x4 oacc[2]; oacc[0] = (f32x4){0.f, 0.f, 0.f, 0.f}; oacc[1] = oacc[0];
#pragma unroll
        for (int ks = 0; ks < 8; ++ks) { const bf16x8 a = *(const bf16x8*)(qdl + (tt * 16 + l15) * 264 + ks * 32 + quad * 8);
#pragma unroll
            for (int q2 = 0; q2 < 2; ++q2) { const bf16x8 bfr = *(const bf16x8*)(ST + ((vb + q2) * 16 + l15) * 264 + ks * 32 + quad * 8); oacc[q2] = mfma16(a, bfr, oacc[q2]); } }
#pragma unroll
        for (int kt = 0; kt < 2; ++kt) { const f32x4 dv = *(const f32x4*)(dl + wid * 32 + kt * 16 + quad * 4);
#pragma unroll
            for (int vt = 0; vt < 4; ++vt) S[kt][vt] = S[kt][vt] * dv; }
#pragma unroll
        for (int ts = 0; ts < 2; ++ts) { bf16x8 af[2];
#pragma unroll
            for (int kt = 0; kt < 2; ++kt)
#pragma unroll
                for (int jj = 0; jj < 8; ++jj) af[kt][jj] = (short)kdl[(ts * 32 + quad * 8 + jj) * 264 + wid * 32 + kt * 16 + l15];
#pragma unroll
            for (int vt = 0; vt < 4; ++vt) { bf16x8 bfr;
#pragma unroll
                for (int jj = 0; jj < 8; ++jj) bfr[jj] = (short)vl[(ts * 32 + quad * 8 + jj) * 72 + vt * 16 + l15];
#pragma unroll
                for (int kt = 0; kt < 2; ++kt) S[kt][vt] = mfma16(af[kt], bfr, S[kt][vt]); } }
#pragma unroll
        for (int q2 = 0; q2 < 2; ++q2)
#pragma unroll
            for (int r = 0; r < 4; ++r) { const int j = tt * 16 + quad * 4 + r; const size_t tok = (size_t)cidx * 64 + (dir ? 63 - j : j); O[tok * DM + (vb + q2) * 16 + l15] = f2bf(oi[q2][r] + oacc[q2][r]); }
        __syncthreads();
        GLA_WRITE_ST();
        __syncthreads();
    }
#undef GLA_ISSUE
#undef GLA_WRITE_ST
    if (!sample) { float* so = p.out + OUT_GLAST + sbase;
#pragma unroll
        for (int kt = 0; kt < 2; ++kt)
#pragma unroll
            for (int vt = 0; vt < 4; ++vt)
#pragma unroll
                for (int r = 0; r < 4; ++r) { const int kk = wid * 32 + kt * 16 + quad * 4 + r; so[(size_t)kk * 512 + vt * 16 + l15] = S[kt][vt][r]; } }
    __syncthreads();
}
DEV void phase_gla_post(const Params& p) {
    const int tid = tidx(), wid = tid >> 6, lane = tid & 63;
    const u16* P = (const u16*)(p.ws + OFF_P); const u16* OF = (const u16*)(p.ws + OFF_OF); const u16* OB = (const u16*)(p.ws + OFF_OB); u16* ycat = (u16*)(p.ws + OFF_A);
    for (int it = blockIdx.x * 8 + wid; it < NTOK * 4; it += gridDim.x * 8) { const int tok = it >> 2, h = it & 3; const int v8 = lane * 8;
        float a[8], b[8], g[8]; unpack8(*(const u32x4*)(OF + (size_t)tok * DM + h * 512 + v8), a); unpack8(*(const u32x4*)(OB + (size_t)tok * DM + h * 512 + v8), b);
        unpack8(*(const u32x4*)(P + (size_t)tok * LDP1 + 4096 + h * 512 + v8), g);
        float ss = 0.f;
#pragma unroll
        for (int i = 0; i < 8; ++i) { a[i] += b[i]; ss += a[i] * a[i]; }
        ss = wave_sum(ss); const float sc = rsqrtf(ss * (1.f / 512.f) + 1e-6f);
        float o[8];
#pragma unroll
        for (int i = 0; i < 8; ++i) o[i] = a[i] * sc * p.in[40][v8 + i] * (g[i] * sigm(g[i]));
        u32x4 w; w.x = pk(o[0], o[1]); w.y = pk(o[2], o[3]); w.z = pk(o[4], o[5]); w.w = pk(o[6], o[7]);
        *(u32x4*)(ycat + (size_t)tok * DM + h * 512 + v8) = w; }
}

DEV void gate_loadcol(const u16* U, long tokc, int c8, bool colok, bool up, bool dn, int W, float (*dst)[8]) {
    if (colok && up) unpack8(*(const u32x4*)(U + (size_t)(tokc - W) * LDU + c8), dst[0]); else { for (int i = 0; i < 8; ++i) dst[0][i] = 0.f; }
    if (colok) unpack8(*(const u32x4*)(U + (size_t)tokc * LDU + c8), dst[1]); else { for (int i = 0; i < 8; ++i) dst[1][i] = 0.f; }
    if (colok && dn) unpack8(*(const u32x4*)(U + (size_t)(tokc + W) * LDU + c8), dst[2]); else { for (int i = 0; i < 8; ++i) dst[2][i] = 0.f; }
}
DEV void gate_loadraw(const u16* U, long tokc, int c8, bool colok, bool up, bool dn, int W, u32x4* dst) {
    const u32x4 z = (u32x4){0u, 0u, 0u, 0u};
    dst[0] = z; dst[1] = z; dst[2] = z;
    if (colok && up) dst[0] = *(const u32x4*)(U + (size_t)(tokc - W) * LDU + c8);
    if (colok) dst[1] = *(const u32x4*)(U + (size_t)tokc * LDU + c8);
    if (colok && dn) dst[2] = *(const u32x4*)(U + (size_t)(tokc + W) * LDU + c8);
}
DEV void phase_ffn_gate(const Params& p, int layer) {
    u16* U = (u16*)(p.ws + OFF_U); const float* cw = p.in[11] + (size_t)layer * 9 * DFF;
    const int tid_ = tidx(), wid_ = tid_ >> 6, lane_ = tid_ & 63;
    for (int bu = blockIdx.x; bu < 1408 + 704; bu += gridDim.x) {
        int tokS, c8;
        if (bu < 1408) { const int rg = bu / 44, rem = bu % 44; const int qtr = rem / 11, cgg = rem % 11; tokS = NTP + (rg * 8 + wid_) * 64 + qtr * 16; c8 = (cgg * 64 + lane_) * 8; }
        else { const int pu = bu - 1408; const int sg = pu / 11, cgg = pu % 11; tokS = (sg * 8 + wid_) * 16; c8 = (cgg * 64 + lane_) * 8; }
        int W, colS; bool up, dn;
        if (tokS < NTP) { W = 256; colS = tokS & 255; up = false; dn = false; }
        else { W = 64; colS = tokS & 63; const int rr = ((tokS - NTP) >> 6) & 63; up = rr > 0; dn = rr < 63; }
        float wt[9][8];
#pragma unroll
        for (int q = 0; q < 9; ++q) { const float4 a = *(const float4*)(cw + q * DFF + c8), b = *(const float4*)(cw + q * DFF + c8 + 4);
            wt[q][0] = a.x; wt[q][1] = a.y; wt[q][2] = a.z; wt[q][3] = a.w; wt[q][4] = b.x; wt[q][5] = b.y; wt[q][6] = b.z; wt[q][7] = b.w; }
        float w0[3][8], w1[3][8];
        u32x4 r2[3], r3[3], vraw, vnext;
        gate_loadcol(U, (long)tokS - 1, c8, colS > 0, up, dn, W, w0);
        gate_loadcol(U, (long)tokS, c8, true, up, dn, W, w1);
        gate_loadraw(U, (long)tokS + 1, c8, colS + 1 < W, up, dn, W, r2);
        vraw = *(const u32x4*)(U + (size_t)tokS * LDU + DFF + c8); vnext = vraw;
#pragma unroll 2
        for (int s_ = 0; s_ < 16; ++s_) {
            const long tok = (long)tokS + s_;
            if (s_ + 2 <= 16) gate_loadraw(U, tok + 2, c8, colS + s_ + 2 < W, up, dn, W, r3);
            if (s_ + 1 < 16) vnext = *(const u32x4*)(U + (size_t)(tok + 1) * LDU + DFF + c8);
            float w2[3][8]; unpack8(r2[0], w2[0]); unpack8(r2[1], w2[1]); unpack8(r2[2], w2[2]);
            float v[8]; unpack8(vraw, v);
#pragma unroll
            for (int i = 0; i < 8; ++i) { float a = 0.f;
#pragma unroll
                for (int di = 0; di < 3; ++di) a += w0[di][i] * wt[di * 3][i] + w1[di][i] * wt[di * 3 + 1][i] + w2[di][i] * wt[di * 3 + 2][i];
                v[i] *= a * sigm(a); }
            u32x4 w; w.x = pk(v[0], v[1]); w.y = pk(v[2], v[3]); w.z = pk(v[4], v[5]); w.w = pk(v[6], v[7]);
            *(u32x4*)(U + (size_t)tok * LDU + DFF + c8) = w;
#pragma unroll
            for (int di = 0; di < 3; ++di) {
#pragma unroll
                for (int i = 0; i < 8; ++i) { w0[di][i] = w1[di][i]; w1[di][i] = w2[di][i]; }
                r2[di] = r3[di]; }
            vraw = vnext;
        }
    }
}

DEV void phase_final_norm(const Params& p) {
    const int tid = tidx(), wid = tid >> 6, lane = tid & 63; const float* g = p.in[13];
    const int nw = gridDim.x * 8, wv = blockIdx.x * 8 + wid; const int per = (NTOK + nw - 1) / nw; const int r0 = wv * per, r1 = (r0 + per < NTOK) ? r0 + per : NTOK;
    float4 gg[8];
#pragma unroll
    for (int j = 0; j < 8; ++j) gg[j] = *(const float4*)(g + (lane + 64 * j) * 4);
    for (int row = r0; row < r1; ++row) {
        float4* xr = (float4*)(p.out + (size_t)row * DM);
        float4 v[8]; float ss = 0.f;
#pragma unroll
        for (int j = 0; j < 8; ++j) { v[j] = xr[lane + 64 * j]; ss += v[j].x * v[j].x + v[j].y * v[j].y + v[j].z * v[j].z + v[j].w * v[j].w; }
        ss = wave_sum(ss); const float rstd = rsqrtf(ss * (1.f / 2048.f) + 1e-6f);
#pragma unroll
        for (int j = 0; j < 8; ++j) xr[lane + 64 * j] = make_float4(v[j].x * rstd * gg[j].x, v[j].y * rstd * gg[j].y, v[j].z * rstd * gg[j].z, v[j].w * rstd * gg[j].w);
    }
}

#define XB_TMO      128
#define XB_XCNT(j)  (256  + 64 * (j))
#define XB_XSUB(j)  (1280 + 64 * (j))
#define XB_XGEN(j)  (2304 + 64 * (j))
#define XB_TOP      3328
#define XB_TOPGEN   3392
#define XCD_BAR_WORDS 3456
#define XB_SPIN_CAP (1u << 18)
DEV unsigned xb_ld(unsigned* p)              { return __hip_atomic_load(p, __ATOMIC_RELAXED, __HIP_MEMORY_SCOPE_AGENT); }
DEV unsigned xb_add(unsigned* p, unsigned v) { return __hip_atomic_fetch_add(p, v, __ATOMIC_RELAXED, __HIP_MEMORY_SCOPE_AGENT); }
DEV unsigned xb_xcc_id() { return (unsigned)__builtin_amdgcn_s_getreg((3 << 11) | 20) & 0xFu; }
#define XB_SPIN(cond, bar) do { unsigned _sp = 0; while (cond) { __builtin_amdgcn_s_sleep(1); \
    if ((++_sp & 255u) == 0u) { if (xb_ld(&(bar)[XB_TMO])) break; if (_sp > XB_SPIN_CAP) { atomicAdd(&(bar)[XB_TMO], 1u); break; } } } } while (0)
struct XcdBarrier { unsigned* bar; unsigned x; volatile LAS unsigned* st; };
DEV XcdBarrier xcd_barrier_post(unsigned* bar, volatile LAS unsigned* st) {
    XcdBarrier b; b.bar = bar; b.x = xb_xcc_id(); b.st = st;
    if (threadIdx.x == 0) (void)xb_add(&bar[XB_XCNT(b.x)], 1u);
    return b;
}
DEV void xcd_barrier_complete(unsigned* bar, unsigned x, unsigned& nloc, unsigned& nx) {
    const unsigned G = gridDim.x * gridDim.y * gridDim.z;
    unsigned sum, cnt, mine, sp = 0u;
    for (;;) {
        sum = 0u; cnt = 0u; mine = 0u;
#pragma unroll
        for (unsigned j = 0; j < 16; ++j) { const unsigned c = xb_ld(&bar[XB_XCNT(j)]); sum += c; cnt += (c > 0u) ? 1u : 0u; mine = (j == x) ? c : mine; }
        if (sum == G) break;
        __builtin_amdgcn_s_sleep(1);
        if ((++sp & 255u) == 0u) { if (xb_ld(&bar[XB_TMO])) break; if (sp > XB_SPIN_CAP) { atomicAdd(&bar[XB_TMO], 1u); break; } }
    }
    nloc = mine > 0u ? mine : 1u; nx = cnt > 0u ? cnt : 1u;
}
DEV void xcd_barrier(const XcdBarrier& b) {
    asm volatile("s_waitcnt vmcnt(0)" ::: "memory");
    __syncthreads();
    if (threadIdx.x == 0) {
        unsigned* bar = b.bar;
        __builtin_amdgcn_s_waitcnt(0);
        unsigned nloc = b.st[0], nx = b.st[1];
        if (nloc == 0u) { xcd_barrier_complete(bar, b.x, nloc, nx); b.st[0] = nloc; b.st[1] = nx; }
        const unsigned old = xb_add(&bar[XB_XSUB(b.x)], 1u);
        const unsigned gen = old / nloc;
        if (old + 1u == (gen + 1u) * nloc) {
            __builtin_amdgcn_fence(__ATOMIC_RELEASE, "agent");
            asm volatile("s_waitcnt vmcnt(0)" ::: "memory");
            const unsigned og = xb_add(&bar[XB_TOP], 1u);
            const unsigned tg = og / nx;
            if (og + 1u == (tg + 1u) * nx) xb_add(&bar[XB_TOPGEN], 1u);
            else XB_SPIN(xb_ld(&bar[XB_TOPGEN]) == tg, bar);
            __builtin_amdgcn_fence(__ATOMIC_ACQUIRE, "agent");
            xb_add(&bar[XB_XGEN(b.x)], 1u);
            asm volatile("s_waitcnt vmcnt(0)" ::: "memory");
        } else {
            XB_SPIN(xb_ld(&bar[XB_XGEN(b.x)]) == gen, bar);
            __builtin_amdgcn_fence(__ATOMIC_ACQUIRE, "agent");
            asm volatile("s_waitcnt vmcnt(0)" ::: "memory");
        }
    }
    __syncthreads();
}

__global__ void __launch_bounds__(512, 2) mega(Params p0) {
    extern __shared__ __attribute__((aligned(16))) unsigned char shm[];
    cg::grid_group grid = cg::this_grid();
    __shared__ uint4 xb_words;
    if (threadIdx.x == 0) xb_words = make_uint4(0u, 0u, 0u, 0u);
    __syncthreads();
    (void)xcd_barrier_post((unsigned*)(p0.ws + OFF_SMALL + SMALL_BYTES + 256), (volatile LAS unsigned*)&xb_words);
#define XBAR() do { XcdBarrier xb_; xb_.bar = (unsigned*)(launder(p0).ws + OFF_SMALL + SMALL_BYTES + 256); xb_.x = xb_xcc_id(); xb_.st = (volatile LAS unsigned*)&xb_words; xcd_barrier(xb_); } while (0)
    float* sm = (float*)shm;
    const int G = (int)gridDim.x, B = (int)blockIdx.x;

#ifndef SK_PREP
    phase_prep(launder(p0), shm);
#ifdef PROBE_MISC
    __syncthreads(); phase_prep(launder(p0), shm);
#endif
#endif
    grid.sync();
    phase_reduce(launder(p0));
    XBAR();
#pragma unroll 1
    for (int layer = 0; layer < 2; ++layer) {
#ifndef SK_NORM
        phase_norm(launder(p0), layer, 0, shm);
#ifdef PROBE_MISC
        __syncthreads(); phase_norm(launder(p0), layer, 0, shm);
#endif
#endif
        XBAR();
        { const Params p = launder(p0); const u16* A = (const u16*)(p.ws + OFF_A); pg8::EpiBf16 E; E.O = (u16*)(p.ws + OFF_P); E.ldc = layer ? LDP1 : LDP0;
#if !defined(SK_GEMM) && !defined(SK_GBF)
            run_gemm(shm, A, DM, (const u16*)(p.ws + OFF_WIN), DM, layer ? LDP1 : LDP0, DM, E);
#ifdef PROBE_GEMM
            __syncthreads(); run_gemm(shm, A, DM, (const u16*)(p.ws + OFF_WIN), DM, layer ? LDP1 : LDP0, DM, E);
#endif
#endif
        }
        XBAR();
        if (layer == 0) {
#ifndef SK_PRE
            { const Params p = launder(p0); hy_pre_stream(p, sm); }
            { const Params p = launder(p0); for (int t = B + ((6144 - B + G - 1) / G) * G; t < 6144 + 768; t += G) rwkv_lora_tile(p, t - 6144, shm); }
#ifdef PROBE_MISC
            { const Params p = launder(p0); for (int t = B; t < 6144 + 768; t += G) { if (t < 6144) hy_pre_tile(p, t, sm); else rwkv_lora_tile(p, t - 6144, shm); } }
#endif
#endif
            XBAR();
            { const Params p = launder(p0); unsigned* ctr = (unsigned*)(p.ws + OFF_SMALL + SMALL_BYTES);
                for (int t = B; t < 128; t += G) rwkv_scan_task(p, t, sm);
                for (;;) { if (tidx() == 0) *(volatile unsigned*)shm = atomicAdd(ctr, 1u); __syncthreads(); const unsigned t = *(volatile unsigned*)shm; __syncthreads();
                    if (t >= 1024u + 2048u) break;
                    if (t < 1024u) rwkv_scan_task(p, 128 + (int)t, sm); else hyconv_task(p, (int)t - 1024, shm); } }
            XBAR();
#ifndef SK_POST
            { const Params p = launder(p0); hy_post_stream(p, sm); }
            { const Params p = launder(p0); for (int t = B + ((6144 - B + G - 1) / G) * G; t < 6144 + 768; t += G) rwkv_post_tile(p, t - 6144, sm); }
#ifdef PROBE_MISC
            { const Params p = launder(p0); for (int t = B; t < 6144 + 768; t += G) { if (t < 6144) hy_post_tile(p, t, sm); else rwkv_post_tile(p, t - 6144, sm); } }
#endif
#endif
            XBAR();
        } else {
#ifndef SK_GLA
            { const Params p = launder(p0); for (int t = B; t < 1536; t += G) gla_intra_task(p, t, shm); }
            XBAR();
            { const Params p = launder(p0); for (int t = B; t < 256 + 2048; t += G) gla_inter_task(p, t, shm); }
#endif
            XBAR();
#ifndef SK_GLAP
            phase_gla_post(launder(p0));
#ifdef PROBE_MISC
            phase_gla_post(launder(p0));
#endif
#endif
            XBAR();
        }
        { const Params p = launder(p0); const u16* A = (const u16*)(p.ws + OFF_A); const float* mods = (const float*)(p.ws + OFF_SMALL); pg8::EpiRes E; E.X = p.out; E.gm = mods + (size_t)layer * 5 * 12288 + 2 * 2048; E.gb = p.in[7] + layer * 12288 + 2 * 2048;
#if !defined(SK_GEMM) && !defined(SK_GRES)
            run_gemm(shm, A, DM, (const u16*)(p.ws + OFF_WOUT), DM, DM, DM, E);
#endif
        }
        XBAR();
#ifndef SK_NORM
        phase_norm(launder(p0), layer, 1, shm);
#ifdef PROBE_MISC
        __syncthreads(); phase_norm(launder(p0), layer, 1, shm);
#endif
#endif
        XBAR();
        { const Params p = launder(p0); const u16* A = (const u16*)(p.ws + OFF_A); pg8::EpiBf16 E; E.O = (u16*)(p.ws + OFF_U); E.ldc = LDU;
#if !defined(SK_GEMM) && !defined(SK_GBF)
            run_gemm(shm, A, DM, (const u16*)(p.ws + OFF_WUP), DM, LDU, DM, E);
#ifdef PROBE_GEMM
            __syncthreads(); run_gemm(shm, A, DM, (const u16*)(p.ws + OFF_WUP), DM, LDU, DM, E);
#endif
#endif
        }
        XBAR();
#ifndef SK_GATE
        phase_ffn_gate(launder(p0), layer);
#endif
        XBAR();
        { const Params p = launder(p0); const float* mods = (const float*)(p.ws + OFF_SMALL); pg8::EpiRes E; E.X = p.out; E.gm = mods + (size_t)layer * 5 * 12288 + 5 * 2048; E.gb = p.in[7] + layer * 12288 + 5 * 2048;
#if !defined(SK_GEMM) && !defined(SK_GRES)
            run_gemm(shm, (const u16*)(p.ws + OFF_U) + DFF, LDU, (const u16*)(p.ws + OFF_WDN), DFF, DM, DFF, E);
#endif
        }
        XBAR();
    }
    phase_final_norm(launder(p0));
}

extern "C" void kernel_launch(void* const* d_in, const int* in_sizes, int n_in, void* d_out, int out_size, void* d_ws, size_t ws_size, hipStream_t stream) {
    constexpr size_t kDynLds = 131072;
    static int grid_blocks = 0;
    if (!grid_blocks) {
        int dev = 0, cus = 0, per_cu = 0;
        hipGetDevice(&dev);
        hipDeviceGetAttribute(&cus, hipDeviceAttributeMultiprocessorCount, dev);
        hipFuncSetAttribute((const void*)mega, hipFuncAttributeMaxDynamicSharedMemorySize, (int)kDynLds);
        hipOccupancyMaxActiveBlocksPerMultiprocessor(&per_cu, mega, 512, kDynLds);
        if (per_cu < 1) per_cu = 1;
        grid_blocks = cus * per_cu;
        if (grid_blocks > 256) grid_blocks = 256;
    }
    if (ws_size < WS_NEED || n_in < 41) { fprintf(stderr, "workspace too small: %zu < %zu\n", ws_size, WS_NEED); return; }
    Params p{};
    for (int i = 0; i < 41; ++i) p.in[i] = (const float*)d_in[i];
    p.out = (float*)d_out; p.ws = (unsigned char*)d_ws;
    hipMemsetAsync((unsigned char*)d_ws + OFF_SMALL + SMALL_BYTES, 0, 256 + XCD_BAR_BYTES, stream);
    void* args[] = {&p};
    hipError_t e = hipLaunchCooperativeKernel((const void*)mega, dim3(grid_blocks), dim3(512), args, kDynLds, stream);
    if (e != hipSuccess) fprintf(stderr, "cooperative launch failed: %s (grid %d)\n", hipGetErrorString(e), grid_blocks);
}
```
